# Optimizing an MI355X kernel written in HIP

```python
import jax, jax.numpy as jnp
from jax import lax
import numpy as np

D_MODEL = 2048
BATCH = 2
SEQ = 8192
DEPTH = 1

A_HEADS = 16
A_HEAD_DIM = 128
IDX_HEADS = 16
IDX_DIM = 64
INDEX_TOPK_MAX = 256
B_HEADS = 16
Q_LORA = 512
KV_LORA = 512
QK_NOPE = 128
QK_ROPE = 64
V_HEAD = 128
ROPE_THETA = 10000.0
D_FF = 5632
CONV_W = 3
PLE_DIM = 256
N_BRANCH = 2
Q_BLOCK = 128
DEEPNORM_ALPHA = (2.0 * DEPTH) ** 0.25
DEEPNORM_BETA = (8.0 * DEPTH) ** -0.25
LN_EPS = 1e-5
RMS_EPS = 1e-6
NEG = -1e30

SPLITS = (
    A_HEADS * A_HEAD_DIM,
    A_HEAD_DIM,
    A_HEAD_DIM,
    IDX_HEADS * IDX_DIM,
    IDX_DIM,
    IDX_HEADS,
    Q_LORA,
    KV_LORA,
    QK_ROPE,
    N_BRANCH * D_MODEL,
)
D_IN = sum(SPLITS)

kernel_name = "hybrid_dsa_mla_convffn_deepnorm_block"


def layer_norm(x, g, b):
    xf = x.astype(jnp.float32)
    mu = xf.mean(-1, keepdims=True)
    var = jnp.square(xf - mu).mean(-1, keepdims=True)
    return ((xf - mu) * lax.rsqrt(var + LN_EPS) * g + b).astype(x.dtype)


def rms_norm(x, g):
    xf = x.astype(jnp.float32)
    y = xf * lax.rsqrt(jnp.mean(xf * xf, -1, keepdims=True) + RMS_EPS)
    return (y * g).astype(x.dtype)


def rope_tables(S, dtype):
    pos = jnp.arange(S, dtype=jnp.float32)
    inv_freq = jnp.power(ROPE_THETA, -jnp.arange(0, QK_ROPE, 2, dtype=jnp.float32) / QK_ROPE)
    ang = pos[:, None] * inv_freq[None, :]
    return jnp.cos(ang).astype(dtype), jnp.sin(ang).astype(dtype)


def apply_rope(x, cos, sin):
    x1, x2 = jnp.split(x, 2, axis=-1)
    return jnp.concatenate([x1 * cos - x2 * sin, x1 * sin + x2 * cos], axis=-1)


def alibi_slopes(n_heads):
    return jnp.exp2(-8.0 * jnp.arange(1, n_heads + 1, dtype=jnp.float32) / n_heads)


def to_blocks(a, nb):
    return a.reshape(a.shape[0], nb, Q_BLOCK, *a.shape[2:]).swapaxes(0, 1)


def dsa_attention(q, k, v, q_idx, k_idx, w_idx, topk):
    B, S, H, Dh = q.shape
    nb = S // Q_BLOCK
    slopes = alibi_slopes(H)
    key_pos = jnp.arange(S)
    gather = jax.vmap(lambda a, i: a[i])
    scale = Dh ** -0.5

    def block(args):
        qb, qib, wib, blk = args
        t = blk * Q_BLOCK + jnp.arange(Q_BLOCK)
        s = jax.nn.relu(jnp.einsum('bqhd,bsd->bqhs', qib, k_idx))
        score = jnp.einsum('bqhs,bqh->bqs', s, wib).astype(jnp.float32)
        causal = key_pos[None, :] <= t[:, None]
        score = jnp.where(causal[None], score, NEG)
        _, idx = lax.top_k(score, topk)
        k_sel = gather(k, idx)
        v_sel = gather(v, idx)
        dist = (t[None, :, None] - idx).astype(jnp.float32)
        logits = jnp.einsum('bqhd,bqkd->bqhk', qb, k_sel).astype(jnp.float32) * scale
        logits = logits - slopes[:, None] * dist[:, :, None, :]
        logits = jnp.where((dist >= 0.0)[:, :, None, :], logits, NEG)
        probs = jax.nn.softmax(logits, axis=-1).astype(v.dtype)
        return jnp.einsum('bqhk,bqkd->bqhd', probs, v_sel)

    out = lax.map(block, (to_blocks(q, nb), to_blocks(q_idx, nb), to_blocks(w_idx, nb), jnp.arange(nb)))
    return out.swapaxes(0, 1).reshape(B, S, H * Dh)


def mla_attention(q_nope, q_pe, k_nope, k_pe, v):
    B, S, H, _ = q_nope.shape
    nb = S // Q_BLOCK
    key_pos = jnp.arange(S)
    scale = (QK_NOPE + QK_ROPE) ** -0.5

    def block(args):
        qn, qr, blk = args
        t = blk * Q_BLOCK + jnp.arange(Q_BLOCK)
        logits = (jnp.einsum('bqhd,bshd->bhqs', qn, k_nope)
                  + jnp.einsum('bqhr,bsr->bhqs', qr, k_pe)).astype(jnp.float32) * scale
        causal = key_pos[None, :] <= t[:, None]
        logits = jnp.where(causal[None, None], logits, NEG)
        probs = jax.nn.softmax(logits, axis=-1).astype(v.dtype)
        return jnp.einsum('bhqs,bshd->bqhd', probs, v)

    out = lax.map(block, (to_blocks(q_nope, nb), to_blocks(q_pe, nb), jnp.arange(nb)))
    return out.swapaxes(0, 1).reshape(B, S, H * V_HEAD)


def causal_dwconv(u, w, b):
    S = u.shape[1]
    up = jnp.pad(u, ((0, 0), (CONV_W - 1, 0), (0, 0)))
    y = up[:, 0:S] * w[0]
    for j in range(1, CONV_W):
        y = y + up[:, j:j + S] * w[j]
    return y + b


def setup_inputs(seed: int = 0) -> dict:
    key = jax.random.key(seed)
    ks = jax.random.split(key, 24)
    f32 = jnp.float32
    nrm = lambda k, shape, fan_in, gain=1.0: jax.random.normal(k, shape, f32) * (gain * fan_in ** -0.5)
    L = DEPTH
    return {
        'x': jax.random.normal(ks[0], (BATCH, SEQ, D_MODEL), f32),
        'p': jax.random.normal(ks[1], (DEPTH, BATCH, SEQ, PLE_DIM), f32),
        'w_in': nrm(ks[2], (L, D_MODEL, D_IN), D_MODEL),
        'q_a_norm': 1.0 + 0.02 * jax.random.normal(ks[3], (L, Q_LORA), f32),
        'kv_a_norm': 1.0 + 0.02 * jax.random.normal(ks[4], (L, KV_LORA), f32),
        'w_uq': nrm(ks[5], (L, Q_LORA, B_HEADS, QK_NOPE + QK_ROPE), Q_LORA),
        'w_uk': nrm(ks[6], (L, KV_LORA, B_HEADS, QK_NOPE), KV_LORA),
        'w_uv': nrm(ks[7], (L, KV_LORA, B_HEADS, V_HEAD), KV_LORA),
        'w_branch_a': nrm(ks[8], (L, A_HEADS * A_HEAD_DIM, D_MODEL), A_HEADS * A_HEAD_DIM),
        'w_branch_b': nrm(ks[9], (L, B_HEADS * V_HEAD, D_MODEL), B_HEADS * V_HEAD),
        'w_o': nrm(ks[10], (L, D_MODEL, D_MODEL), D_MODEL, DEEPNORM_BETA),
        'ln1_g': 1.0 + 0.02 * jax.random.normal(ks[11], (L, D_MODEL), f32),
        'ln1_b': 0.02 * jax.random.normal(ks[12], (L, D_MODEL), f32),
        'w_up': nrm(ks[13], (L, D_MODEL, 2 * D_FF), D_MODEL),
        'conv_w': nrm(ks[14], (L, CONV_W, 2 * D_FF), CONV_W),
        'conv_b': 0.02 * jax.random.normal(ks[15], (L, 2 * D_FF), f32),
        'w_down': nrm(ks[16], (L, D_FF, D_MODEL), D_FF, DEEPNORM_BETA),
        'w_pg': nrm(ks[17], (L, D_MODEL, D_MODEL), D_MODEL),
        'b_pg': 0.02 * jax.random.normal(ks[18], (L, D_MODEL), f32),
        'w_pe': nrm(ks[19], (L, PLE_DIM, D_MODEL), PLE_DIM),
        'ln2_g': 1.0 + 0.02 * jax.random.normal(ks[20], (L, D_MODEL), f32),
        'ln2_b': 0.02 * jax.random.normal(ks[21], (L, D_MODEL), f32),
    }


def reference(x, p, w_in, q_a_norm, kv_a_norm, w_uq, w_uk, w_uv, w_branch_a, w_branch_b, w_o,
              ln1_g, ln1_b, w_up, conv_w, conv_b, w_down, w_pg, b_pg, w_pe, ln2_g, ln2_b):
    B, S, _ = x.shape
    topk = min(INDEX_TOPK_MAX, S // 4)
    cos, sin = rope_tables(S, x.dtype)
    split_points = np.cumsum(SPLITS)[:-1].tolist()
    for i in range(DEPTH):
        u = x @ w_in[i]
        (q_a, k_a, v_a, q_idx, k_idx, w_idx, c_q, c_kv, k_pe, gate_logits) = jnp.split(u, split_points, axis=-1)
        attn_a = dsa_attention(q_a.reshape(B, S, A_HEADS, A_HEAD_DIM), k_a, v_a,
                               q_idx.reshape(B, S, IDX_HEADS, IDX_DIM), k_idx, w_idx, topk)
        c_q = rms_norm(c_q, q_a_norm[i])
        q_b = jnp.einsum('bsc,chd->bshd', c_q, w_uq[i])
        q_nope, q_pe = q_b[..., :QK_NOPE], q_b[..., QK_NOPE:]
        q_pe = apply_rope(q_pe, cos[:, None, :], sin[:, None, :])
        k_pe = apply_rope(k_pe, cos, sin)
        c_kv = rms_norm(c_kv, kv_a_norm[i])
        k_nope = jnp.einsum('bsc,chd->bshd', c_kv, w_uk[i])
        v_b = jnp.einsum('bsc,chd->bshd', c_kv, w_uv[i])
        attn_b = mla_attention(q_nope, q_pe, k_nope, k_pe, v_b)
        gates = jax.nn.sigmoid(gate_logits.reshape(B, S, N_BRANCH, D_MODEL))
        merged = gates[:, :, 0] * (attn_a @ w_branch_a[i]) + gates[:, :, 1] * (attn_b @ w_branch_b[i])
        x = layer_norm(DEEPNORM_ALPHA * x + merged @ w_o[i], ln1_g[i], ln1_b[i])
        hid = causal_dwconv(x @ w_up[i], conv_w[i], conv_b[i])
        h_gate, h_val = hid[..., :D_FF], hid[..., D_FF:]
        ffn = (jax.nn.silu(h_gate) * h_val) @ w_down[i]
        ple = jax.nn.sigmoid(x @ w_pg[i] + b_pg[i]) * (p[i] @ w_pe[i])
        x = layer_norm(DEEPNORM_ALPHA * x + ffn + ple, ln2_g[i], ln2_b[i])
    return x
```

```cpp
#define DBG_DMA_WAIT0 1
#include <hip/hip_runtime.h>
#include <cstdio>
#include <cstdint>
namespace pg8 {
#define PG8_LAS __attribute__((address_space(3)))
typedef unsigned short bf16_t;
typedef short bf16x8 __attribute__((ext_vector_type(8)));
typedef float f32x4 __attribute__((ext_vector_type(4)));
typedef unsigned u32x4 __attribute__((ext_vector_type(4)));
constexpr int BM = 256, BK = 64, HALF = 128, HTB = HALF * BK * 2  , STAGE_BYTES = 8 * HTB, NXCD = 8, WGM = 8;

__host__ __device__ __forceinline__ int lds_byte(int r, int c) { const int st = (r >> 4) * 2 + (c >> 5), rr = r & 15, cc = c & 31, ob = rr * 64 + cc * 2; return st * 1024 + (ob ^ (((ob >> 9) & 1) << 5)); }
__host__ __device__ __forceinline__ void stage_rc(int b, int& R, int& C) { const int st = b / 1024, sb = b % 1024, swz = sb ^ (((sb >> 9) & 1) << 5); R = (st >> 1) * 16 + swz / 64; C = (st & 1) * 32 + (swz % 64) / 2; }
__host__ __device__ __forceinline__ int perm32(int rho) { const int n = rho >> 4, i = rho & 15; return 8 * (i >> 2) + 4 * n + (i & 3); }

struct Unit { int pm, pn; };
struct Gemm { const bf16_t* A; const bf16_t* Bt; int M, N, K; };

struct StaticOrder {
    int nM, nN, nwg, G, c;
    __host__ __device__ void init(int M, int N, int G_, int c_) { nM = M / BM; nN = N / BM; nwg = nM * nN; G = G_; c = c_; }
    __host__ __device__ bool next(int i, Unit& u) const {
        const long L = (long)i * G + c; if (L >= nwg) return false;
        int wgid = (int)L; { const int q = nwg / NXCD, r = nwg % NXCD, xcd = wgid % NXCD, off = wgid / NXCD; wgid = (xcd < r ? xcd * (q + 1) : r * (q + 1) + (xcd - r) * q) + off; }
        const int nig = WGM * nN, gid = wgid / nig, fm = gid * WGM, gsz = (nM - fm) < WGM ? (nM - fm) : WGM;
        u.pm = fm + ((wgid % nig) % gsz); u.pn = (wgid % nig) / gsz; return true;
    }
    __device__ __forceinline__ void a_ready(const Unit&) const {}
    __device__ __forceinline__ void done(const Unit&) const {}
};

__device__ __forceinline__ unsigned cvt_pk_bf16(float lo, float hi) { unsigned r; asm volatile("v_cvt_pk_bf16_f32 %0, %1, %2" : "=v"(r) : "v"(lo), "v"(hi)); return r; }
typedef float f32x2 __attribute__((ext_vector_type(2)));
template <class Epi, class Sched, bool ALIGN_EPI = false, bool SP2 = false>
__device__ __forceinline__ void gemm_phase(PG8_LAS unsigned char* lds, const Gemm g, const Sched& S, const Epi& E) {
    int tid_o_ = threadIdx.x; asm volatile("" : "+v"(tid_o_));
    const int tid = tid_o_, wid = __builtin_amdgcn_readfirstlane(tid >> 6), lane = tid & 63, wr = wid >> 2, wc = wid & 3, fr = lane & 15, fq = lane >> 4;
    const int K = g.K, nt = K / BK;
    unsigned voffA[2], voffB[2];
#pragma unroll
    for (int i = 0; i < 2; ++i) { int R, C; stage_rc(tid * 16 + i * 8192, R, C); const int Rb = Epi::PERM ? ((R & ~31) + perm32(R & 31)) : R;
        voffA[i] = (unsigned)(R * K + C) * 2u; voffB[i] = (unsigned)(Rb * K + C) * 2u; }
    const size_t kstep = (size_t)(BK * 2);
    const size_t hstep = (size_t)HALF * K * 2;
    const size_t tstep = 2 * hstep;
    const unsigned ldsw = (unsigned)wid * 1024u;
    const int aoff = lds_byte(wr * 64 + fr, fq * 8), boff = lds_byte(wc * 32 + fr, fq * 8);
#define PG8_SA(b, h) (((b) * 2 + (h)) * HTB)
#define PG8_SB(b, h) ((4 + (b) * 2 + (h)) * HTB)
#define PG8_STAGE(bufoff, gbase, voff) do { _Pragma("unroll") for (int _i = 0; _i < 2; ++_i) \
        __builtin_amdgcn_global_load_lds((const unsigned*)((const char*)(gbase) + (voff)[_i]), (PG8_LAS unsigned*)(lds + (bufoff) + ldsw + _i * 8192), 16, 0, 0); } while (0)
#define PG8_LDA(dst, b, h) do { _Pragma("unroll") for (int m = 0; m < 4; ++m) _Pragma("unroll") for (int k = 0; k < 2; ++k) dst[m][k] = *(const PG8_LAS bf16x8*)(lds + PG8_SA(b, h) + aoff + m * 2048 + k * 1024); } while (0)
#define PG8_LDB(dst, b, h) do { _Pragma("unroll") for (int n = 0; n < 2; ++n) _Pragma("unroll") for (int k = 0; k < 2; ++k) dst[n][k] = *(const PG8_LAS bf16x8*)(lds + PG8_SB(b, h) + boff + n * 2048 + k * 1024); } while (0)
#define PG8_MMA(ai, bj, At, Bt) do { __builtin_amdgcn_s_setprio(1); _Pragma("unroll") for (int m = 0; m < 4; ++m) _Pragma("unroll") for (int n = 0; n < 2; ++n) _Pragma("unroll") for (int k = 0; k < 2; ++k) \
        acc[ai][bj][m][n] = __builtin_amdgcn_mfma_f32_16x16x32_bf16(Bt[n][k], At[m][k], acc[ai][bj][m][n], 0, 0, 0); __builtin_amdgcn_s_setprio(0); } while (0)
#define PG8_WAIT_V(n) asm volatile("s_waitcnt vmcnt(" #n ")" ::: "memory")
#define PG8_WAIT_L(n) asm volatile("s_waitcnt lgkmcnt(" #n ")" ::: "memory")
#define PG8_BAR __builtin_amdgcn_s_barrier()
#define PG8_SCHED __builtin_amdgcn_sched_barrier(0)
    Unit cur, nxt; int ui = 0;
    if (!S.next(0, cur)) return;
    f32x4 acc[2][2][4][2];
#pragma unroll
    for (int a = 0; a < 2; ++a)
#pragma unroll
        for (int b = 0; b < 2; ++b)
#pragma unroll
            for (int m = 0; m < 4; ++m)
#pragma unroll
                for (int n = 0; n < 2; ++n) acc[a][b][m][n] = (f32x4){0.f, 0.f, 0.f, 0.f};
    bf16x8 At[4][2], B0[2][2], B1[2][2];
    const char* cA = (const char*)g.A + (size_t)cur.pm * tstep; const char* cB = (const char*)g.Bt + (size_t)cur.pn * tstep;
    S.a_ready(cur);
    if constexpr (SP2) {
        PG8_STAGE(PG8_SB(0, 0), cB, voffB); PG8_STAGE(PG8_SB(0, 1), cB + hstep, voffB); PG8_STAGE(PG8_SA(0, 0), cA, voffA); PG8_STAGE(PG8_SA(0, 1), cA + hstep, voffA);
        if (wr == 1) PG8_BAR;
        PG8_WAIT_V(2); PG8_BAR;
        PG8_STAGE(PG8_SB(1, 0), cB + kstep, voffB); PG8_STAGE(PG8_SA(1, 0), cA + kstep, voffA); PG8_STAGE(PG8_SB(1, 1), cB + hstep + kstep, voffB);
        PG8_WAIT_V(6); PG8_BAR;
    } else {
        PG8_STAGE(PG8_SB(0, 0), cB, voffB); PG8_STAGE(PG8_SA(0, 0), cA, voffA); PG8_STAGE(PG8_SB(0, 1), cB + hstep, voffB); PG8_STAGE(PG8_SA(0, 1), cA + hstep, voffA);
        if (wr == 1) PG8_BAR;
        PG8_WAIT_V(4); PG8_BAR;
        PG8_STAGE(PG8_SB(1, 0), cB + kstep, voffB); PG8_STAGE(PG8_SA(1, 0), cA + kstep, voffA); PG8_STAGE(PG8_SB(1, 1), cB + hstep + kstep, voffB);
        PG8_WAIT_V(6); PG8_BAR;
    }
    for (;;) {
        const bool has_next = S.next(ui + 1, nxt);
        const char* nA = has_next ? (const char*)g.A + (size_t)nxt.pm * tstep : cA; const char* nB = has_next ? (const char*)g.Bt + (size_t)nxt.pn * tstep : cB;
        for (int t = 0; t < nt; t += 2) {
            const bool last = (t == nt - 2);
            const char* a1 = cA + (size_t)(t + 1) * kstep;
            const char* a2 = last ? nA : cA + (size_t)(t + 2) * kstep; const char* b2 = last ? nB : cB + (size_t)(t + 2) * kstep;
            const char* a3 = a2 + kstep; const char* b3 = b2 + kstep;
            if (last && has_next) S.a_ready(nxt);
            if constexpr (SP2) {
            PG8_LDB(B0, 0, 0); PG8_LDB(B1, 0, 1); PG8_SCHED; PG8_LDA(At, 0, 0); PG8_STAGE(PG8_SA(1, 1), a1 + hstep, voffA);
            PG8_WAIT_V(8); PG8_WAIT_L(0); PG8_BAR; PG8_MMA(0, 0, At, B0); PG8_MMA(0, 1, At, B1); PG8_BAR; PG8_SCHED;
            PG8_LDA(At, 0, 1); PG8_STAGE(PG8_SB(0, 0), b2, voffB); PG8_STAGE(PG8_SB(0, 1), b2 + hstep, voffB); PG8_STAGE(PG8_SA(0, 0), a2, voffA);
            PG8_WAIT_V(8); PG8_WAIT_L(0); PG8_BAR; PG8_MMA(1, 0, At, B0); PG8_MMA(1, 1, At, B1); PG8_BAR; PG8_SCHED;
            PG8_LDB(B0, 1, 0); PG8_LDB(B1, 1, 1); PG8_SCHED; PG8_LDA(At, 1, 0); PG8_STAGE(PG8_SA(0, 1), a2 + hstep, voffA);
            PG8_WAIT_V(8); PG8_WAIT_L(0); PG8_BAR; PG8_MMA(0, 0, At, B0); PG8_MMA(0, 1, At, B1); PG8_BAR; PG8_SCHED;
            PG8_LDA(At, 1, 1); PG8_STAGE(PG8_SB(1, 0), b3, voffB); PG8_STAGE(PG8_SB(1, 1), b3 + hstep, voffB); PG8_STAGE(PG8_SA(1, 0), a3, voffA);
            PG8_WAIT_V(8); PG8_WAIT_L(0); PG8_BAR; PG8_MMA(1, 0, At, B0); PG8_MMA(1, 1, At, B1); PG8_BAR; PG8_SCHED;
            } else {
            PG8_LDB(B0, 0, 0); PG8_SCHED; PG8_LDA(At, 0, 0); PG8_STAGE(PG8_SA(1, 1), a1 + hstep, voffA);
            PG8_WAIT_L(8); PG8_BAR; PG8_WAIT_L(0); PG8_MMA(0, 0, At, B0); PG8_BAR; PG8_SCHED;
            PG8_LDB(B1, 0, 1); PG8_STAGE(PG8_SB(0, 0), b2, voffB);
            PG8_BAR; PG8_WAIT_L(0); PG8_MMA(0, 1, At, B1); PG8_BAR;
            PG8_LDA(At, 0, 1); PG8_STAGE(PG8_SA(0, 0), a2, voffA);
            PG8_BAR; PG8_WAIT_L(0); PG8_MMA(1, 0, At, B0); PG8_BAR; PG8_SCHED;
            PG8_STAGE(PG8_SB(0, 1), b2 + hstep, voffB);
            PG8_WAIT_V(6); PG8_BAR; PG8_MMA(1, 1, At, B1); PG8_BAR;
            PG8_LDB(B0, 1, 0); PG8_SCHED; PG8_LDA(At, 1, 0); PG8_STAGE(PG8_SA(0, 1), a2 + hstep, voffA);
            PG8_WAIT_L(8); PG8_BAR; PG8_WAIT_L(0); PG8_MMA(0, 0, At, B0); PG8_BAR; PG8_SCHED;
            PG8_LDB(B1, 1, 1); PG8_STAGE(PG8_SB(1, 0), b3, voffB);
            PG8_BAR; PG8_WAIT_L(0); PG8_MMA(0, 1, At, B1); PG8_BAR;
            PG8_LDA(At, 1, 1); PG8_STAGE(PG8_SA(1, 0), a3, voffA);
            PG8_BAR; PG8_WAIT_L(0); PG8_MMA(1, 0, At, B0); PG8_BAR; PG8_SCHED;
            PG8_STAGE(PG8_SB(1, 1), b3 + hstep, voffB);
            PG8_WAIT_V(6); PG8_BAR; PG8_MMA(1, 1, At, B1); PG8_BAR;
            }
        }
        if constexpr (ALIGN_EPI) { if (wr == 0) PG8_BAR; }
        if constexpr (!Epi::AFTER_DRAIN) { E(acc, cur, wr, wc, fr, fq); S.done(cur); }
        if (!has_next) break;
#pragma unroll
        for (int a = 0; a < 2; ++a)
#pragma unroll
            for (int b = 0; b < 2; ++b)
#pragma unroll
                for (int m = 0; m < 4; ++m)
#pragma unroll
                    for (int n = 0; n < 2; ++n) acc[a][b][m][n] = (f32x4){0.f, 0.f, 0.f, 0.f};
        cur = nxt; cA = nA; cB = nB; ++ui;
        if constexpr (ALIGN_EPI) { if (wr == 1) PG8_BAR; }
    }
    PG8_WAIT_V(0);
    if constexpr (!ALIGN_EPI) { if (wr == 0) PG8_BAR; }
    PG8_BAR;
    if constexpr (Epi::AFTER_DRAIN) { E.fused(acc, cur, wr, wc, fr, fq, lds, wid, lane); S.done(cur); }
#undef PG8_SA
#undef PG8_SB
#undef PG8_STAGE
#undef PG8_LDA
#undef PG8_LDB
#undef PG8_MMA
#undef PG8_WAIT_V
#undef PG8_WAIT_L
#undef PG8_BAR
#undef PG8_SCHED
}
}

constexpr int NWAVES = 8;
constexpr int BATCH = 2, SEQ = 8192, DM = 2048, M = BATCH * SEQ;
constexpr int DIN = 8592, NU = 8704, NU1 = 4608;
constexpr int DFF = 5632, NUP = 2 * DFF, PLE_DIM = 256;
constexpr float LN_EPS = 1e-5f, RMS_EPS = 1e-6f;
constexpr float ALPHA = 1.189207115002721f;
constexpr float LOG2E = 1.4426950408889634f;
constexpr float QA_SCALE = 0.08838834764831845f * LOG2E;
constexpr float QB_SCALE = 0.07216878364870323f * LOG2E;
constexpr int U_QA = 0, U_KA = 2048, U_VA = 2176, U_QI = 2304, U_KI = 3328, U_WI = 3392, U_CQ = 3408, U_CKV = 3920, U_KPE = 4432, U_G = 4496;

constexpr size_t MiB = 1u << 20;
constexpr size_t WS_CTL = 0, CTL_ZERO_BYTES = 1 * MiB;
constexpr size_t WS_ROPE = 2 * MiB;
constexpr size_t WS_WIN = 4 * MiB;
constexpr size_t WS_WUQ = 38 * MiB;
constexpr size_t WS_WKV = 41 * MiB;
constexpr size_t WS_WPE = 45 * MiB;
constexpr size_t WS_PB = 46 * MiB;
constexpr size_t WS_XB = 54 * MiB;
constexpr size_t WS_QA = 118 * MiB;
constexpr size_t WS_QI = 182 * MiB;
constexpr size_t WS_CQ = 214 * MiB, WS_CKV = 230 * MiB;
constexpr size_t WS_KA = 246 * MiB, WS_VA = 250 * MiB, WS_KI = 254 * MiB, WS_WI = 256 * MiB, WS_KR = 257 * MiB;
constexpr size_t WS_QN = 260 * MiB;
constexpr size_t WS_QR = 324 * MiB;
constexpr size_t WS_KN = 356 * MiB, WS_VB = 420 * MiB;
constexpr size_t WS_G = 356 * MiB;
constexpr size_t WS_WUP = 182 * MiB, WS_WDN = 226 * MiB, WS_WPG = 248 * MiB;
constexpr size_t WS_WA = 324 * MiB, WS_WB = 332 * MiB, WS_WO = 340 * MiB;
constexpr size_t WS_MT = WS_XB, WS_X1B = WS_QA, WS_PEO = WS_XB;
constexpr size_t WS_ACT = 308 * MiB;
constexpr size_t WS_HEAD = 260 * MiB, WS_TAIL = 282 * MiB;
constexpr size_t WS_END = 484 * MiB;
constexpr int CW_TMO = 0, CW_CODE = 1, CW_BAR = 4096, CW_SSQ = 65536;

constexpr int RING_OFF = 0, RING_BYTES = 131072;
constexpr int IDL_OFF = 131072;
constexpr int LDSCTL_OFF = 147456, MISC_OFF = LDSCTL_OFF + 320;
constexpr int LDS_BYTES = 148480;
static_assert(MISC_OFF + 128 <= LDS_BYTES, "LDS map");
#define GAS __attribute__((address_space(1)))
#define LAS __attribute__((address_space(3)))
typedef unsigned short bf16;
typedef unsigned v4u __attribute__((ext_vector_type(4)));
typedef float f32x4 __attribute__((ext_vector_type(4)));
typedef short bf16x8 __attribute__((ext_vector_type(8)));
typedef GAS unsigned gu32;
typedef GAS unsigned long long gu64;
#define RLX_AGENT __ATOMIC_RELAXED, __HIP_MEMORY_SCOPE_AGENT
#define LDS_WAIT() asm volatile("s_waitcnt lgkmcnt(0)" ::: "memory")
#define VM_WAIT() asm volatile("s_waitcnt vmcnt(0)" ::: "memory")
__device__ __forceinline__ unsigned long long rt() { return __builtin_amdgcn_s_memrealtime(); }
__device__ __forceinline__ unsigned f2bf(float f) { unsigned u = __builtin_bit_cast(unsigned, f); return (u + 0x7fffu + ((u >> 16) & 1u)) >> 16; }
__device__ __forceinline__ unsigned pk2(float lo, float hi) { return f2bf(lo) | (f2bf(hi) << 16); }

#define XB_TMO      128
#define XB_XCNT(j)  (256  + 64 * (j))
#define XB_XSUB(j)  (1280 + 64 * (j))
#define XB_XGEN(j)  (2304 + 64 * (j))
#define XB_TOP      3328
#define XB_TOPGEN   3392
#define XCD_BAR_WORDS 3456
#define XB_SPIN_CAP (1u << 18)

__device__ __forceinline__ unsigned xb_ld(unsigned* p)              { return __hip_atomic_load(p, __ATOMIC_RELAXED, __HIP_MEMORY_SCOPE_AGENT); }
__device__ __forceinline__ unsigned xb_add(unsigned* p, unsigned v) { return __hip_atomic_fetch_add(p, v, __ATOMIC_RELAXED, __HIP_MEMORY_SCOPE_AGENT); }
__device__ __forceinline__ unsigned xb_xcc_id() { return (unsigned)__builtin_amdgcn_s_getreg((3 << 11) | 20) & 0xFu; }
#define XB_SPIN(cond, bar) do { unsigned _sp = 0; while (cond) { __builtin_amdgcn_s_sleep(1); \
    if ((++_sp & 255u) == 0u) { if (xb_ld(&(bar)[XB_TMO])) break; if (_sp > XB_SPIN_CAP) { atomicAdd(&(bar)[XB_TMO], 1u); break; } } } } while (0)

struct XcdBarrier {
    unsigned* bar; unsigned x;
    volatile LAS unsigned* st;
};

__device__ __forceinline__ XcdBarrier xcd_barrier_post(unsigned* bar, volatile LAS unsigned* st) {
    XcdBarrier b; b.bar = bar; b.x = xb_xcc_id(); b.st = st;
    if (threadIdx.x == 0) (void)xb_add(&bar[XB_XCNT(b.x)], 1u);
    return b;
}
__device__ __forceinline__ void xcd_barrier_complete(unsigned* bar, unsigned x, unsigned& nloc, unsigned& nx) {
    const unsigned G = gridDim.x * gridDim.y * gridDim.z;
    unsigned sum, cnt, mine, sp = 0u;
    for (;;) {
        sum = 0u; cnt = 0u; mine = 0u;
#pragma unroll
        for (unsigned j = 0; j < 16; ++j) { const unsigned c = xb_ld(&bar[XB_XCNT(j)]); sum += c; cnt += (c > 0u) ? 1u : 0u; mine = (j == x) ? c : mine; }
        if (sum == G) break;
        __builtin_amdgcn_s_sleep(1);
        if ((++sp & 255u) == 0u) { if (xb_ld(&bar[XB_TMO])) break; if (sp > XB_SPIN_CAP) { atomicAdd(&bar[XB_TMO], 1u); break; } }
    }
    nloc = mine > 0u ? mine : 1u; nx = cnt > 0u ? cnt : 1u;
}

__device__ __forceinline__ void xcd_barrier(const XcdBarrier& b) {
    asm volatile("s_waitcnt vmcnt(0)" ::: "memory");
    __syncthreads();
    if (threadIdx.x == 0) {
        unsigned* bar = b.bar;
        __builtin_amdgcn_s_waitcnt(0);
        unsigned nloc = b.st[0], nx = b.st[1];
        if (nloc == 0u) { xcd_barrier_complete(bar, b.x, nloc, nx); b.st[0] = nloc; b.st[1] = nx; }
        const unsigned old = xb_add(&bar[XB_XSUB(b.x)], 1u);
        const unsigned gen = old / nloc;
        if (old + 1u == (gen + 1u) * nloc) {
            __builtin_amdgcn_fence(__ATOMIC_RELEASE, "agent");
            asm volatile("s_waitcnt vmcnt(0)" ::: "memory");
            const unsigned og = xb_add(&bar[XB_TOP], 1u);
            const unsigned tg = og / nx;
            if (og + 1u == (tg + 1u) * nx) xb_add(&bar[XB_TOPGEN], 1u);
            else XB_SPIN(xb_ld(&bar[XB_TOPGEN]) == tg, bar);
            __builtin_amdgcn_fence(__ATOMIC_ACQUIRE, "agent");
            xb_add(&bar[XB_XGEN(b.x)], 1u);
            asm volatile("s_waitcnt vmcnt(0)" ::: "memory");
        } else {
            XB_SPIN(xb_ld(&bar[XB_XGEN(b.x)]) == gen, bar);
            __builtin_amdgcn_fence(__ATOMIC_ACQUIRE, "agent");
            asm volatile("s_waitcnt vmcnt(0)" ::: "memory");
        }
    }
    __syncthreads();
}

typedef unsigned u32x2 __attribute__((ext_vector_type(2)));
typedef float f32x16 __attribute__((ext_vector_type(16)));
typedef short s16x4 __attribute__((ext_vector_type(4)));
using pg8::cvt_pk_bf16;
__device__ __forceinline__ v4u pack8(f32x4 a, f32x4 b) { v4u w; w.x = cvt_pk_bf16(a[0], a[1]); w.y = cvt_pk_bf16(a[2], a[3]); w.z = cvt_pk_bf16(b[0], b[1]); w.w = cvt_pk_bf16(b[2], b[3]); return w; }
__device__ __forceinline__ u32x2 pack4(f32x4 a) { u32x2 w; w.x = cvt_pk_bf16(a[0], a[1]); w.y = cvt_pk_bf16(a[2], a[3]); return w; }
__device__ __forceinline__ float bflo(unsigned u) { return __uint_as_float(u << 16); }
__device__ __forceinline__ float bfhi(unsigned u) { return __uint_as_float(u & 0xffff0000u); }
__device__ __forceinline__ void unpack8(v4u w, f32x4& a, f32x4& b) { a = (f32x4){bflo(w.x), bfhi(w.x), bflo(w.y), bfhi(w.y)}; b = (f32x4){bflo(w.z), bfhi(w.z), bflo(w.w), bfhi(w.w)}; }
__device__ __forceinline__ float sigmoidf_(float x) { return __builtin_amdgcn_rcpf(1.0f + __builtin_amdgcn_exp2f(-LOG2E * x)); }
__device__ __forceinline__ f32x4 sigmoid4(f32x4 x) { return (f32x4){sigmoidf_(x[0]), sigmoidf_(x[1]), sigmoidf_(x[2]), sigmoidf_(x[3])}; }
__device__ __forceinline__ float sum_x16(float v) { auto r = __builtin_amdgcn_permlane16_swap(__float_as_uint(v), __float_as_uint(v), false, false); return __uint_as_float(r[0]) + __uint_as_float(r[1]); }
__device__ __forceinline__ float sum_x32(float v) { auto r = __builtin_amdgcn_permlane32_swap(__float_as_uint(v), __float_as_uint(v), false, false); return __uint_as_float(r[0]) + __uint_as_float(r[1]); }
__device__ __forceinline__ float max_x16(float v) { auto r = __builtin_amdgcn_permlane16_swap(__float_as_uint(v), __float_as_uint(v), false, false); return fmaxf(__uint_as_float(r[0]), __uint_as_float(r[1])); }
__device__ __forceinline__ float max_x32(float v) { auto r = __builtin_amdgcn_permlane32_swap(__float_as_uint(v), __float_as_uint(v), false, false); return fmaxf(__uint_as_float(r[0]), __uint_as_float(r[1])); }
template <int CTRL> __device__ __forceinline__ float dppf(float v) { return __int_as_float(__builtin_amdgcn_update_dpp(0, __float_as_int(v), CTRL, 0xf, 0xf, false)); }
__device__ __forceinline__ float wave_sum(float v) {
    v += dppf<0xB1>(v); v += dppf<0x4E>(v); v += dppf<0x141>(v); v += dppf<0x140>(v);
    return sum_x32(sum_x16(v));
}
__device__ __forceinline__ int rope_perm(int pc) { const int g = pc >> 3, e = pc & 7; return e < 4 ? 4 * g + e : 32 + 4 * g + (e - 4); }
template <int MAP> __device__ __forceinline__ int srcmap(int n) {
    if (MAP == 0) return n;
    if (MAP == 1) {
        if (n < 2048) return U_QA + n;
        if (n < 3072) return U_QI + (n - 2048);
        if (n < 3200) return U_KA + (n - 3072);
        if (n < 3328) return U_VA + (n - 3200);
        if (n < 3584) { const int o = n - 3328; if (o < 64) return U_KI + o; if (o < 128) return U_KPE + rope_perm(o - 64); if (o < 144) return U_WI + (o - 128); return -1; }
        if (n < 4096) return U_CQ + (n - 3584);
        if (n < 4608) return U_CKV + (n - 4096);
        return U_G + (n - 4608);
    }
    if (MAP == 2) {
        if (n < 2048) return (n >> 7) * 192 + (n & 127);
        const int o = n - 2048; return (o >> 6) * 192 + 128 + rope_perm(o & 63);
    }
    { const int pn = n >> 8, o = n & 255; return o < 128 ? pn * 128 + o : DFF + pn * 128 + (o - 128); }
}
__device__ __forceinline__ void tr_item(const float* W, int ldw, const float* gk, bf16* WT, int K, int k0, int drow0, int srccol, LAS float* scr, int lane) {
#pragma unroll 8
    for (int i = 0; i < 32; ++i) { const int kk = 2 * i + (lane >> 5); float v = 0.f;
        if (srccol >= 0) { v = W[(size_t)(k0 + kk) * ldw + srccol]; if (gk) v *= gk[k0 + kk]; }
        scr[kk * 33 + (lane & 31)] = v; }
    LDS_WAIT(); asm volatile("" ::: "memory");
    const int c = lane & 7;
#pragma unroll
    for (int j = 0; j < 4; ++j) { const int n = (lane >> 3) + 8 * j; const LAS float* s = scr + (8 * c) * 33 + n;
        v4u o; o.x = pk2(s[0 * 33], s[1 * 33]); o.y = pk2(s[2 * 33], s[3 * 33]); o.z = pk2(s[4 * 33], s[5 * 33]); o.w = pk2(s[6 * 33], s[7 * 33]);
        *(GAS v4u*)(WT + (size_t)(drow0 + n) * K + k0 + 8 * c) = o; }
    LDS_WAIT(); asm volatile("" ::: "memory");
}
template <int MAP> __device__ __forceinline__ void tr_matrix(const float* W, int ldw, const float* gk, bf16* WT, int K, int N, LAS float* scr, int gw, int NGW, int lane) {
    const int nblk = N / 32, items = (K / 64) * nblk;
    for (int it = gw; it < items; it += NGW) { const int kb = it / nblk, nb = it % nblk;
        tr_item(W, ldw, gk, WT, K, kb * 64, nb * 32, srcmap<MAP>(nb * 32 + (lane & 31)), scr, lane); }
}
__device__ __forceinline__ void cvt_flat(const float* src, bf16* dst, size_t n8, size_t gt, size_t NT) {
    for (size_t i = gt; i < n8; i += NT) { const f32x4 a = *(const GAS f32x4*)(src + i * 8), b = *(const GAS f32x4*)(src + i * 8 + 4); *(GAS v4u*)(dst + i * 8) = pack8(a, b); }
}

typedef const pg8::f32x4 (&AccRef)[2][2][4][2];
using pg8::f32x2;
using pg8::Unit;
#define EPI_ROWS(ai, m) for (int ai = 0; ai < 2; ++ai) _Pragma("unroll") for (int m = 0; m < 4; ++m)

struct EpiU {
    static constexpr bool PERM = true, AFTER_DRAIN = false;
    bf16 *QA, *QI, *KA, *VA, *KI, *KR, *CQ, *CKV; float* WI; float* SSQ; const float* ROPE;
    __device__ __forceinline__ void operator()(AccRef acc, const Unit& u, int wr, int wc, int fr, int fq) const {
        asm volatile("" : "+v"(fr), "+v"(fq));
        const int pn = u.pn, rowb = u.pm * 256 + wr * 64 + fr, cw = wc * 32 + 8 * fq;
        if (pn < 12) {
            bf16* base = pn < 8 ? QA : QI; const int ldc = pn < 8 ? 2048 : 1024, colt = (pn < 8 ? pn : pn - 8) * 256; const float sc = pn < 8 ? QA_SCALE : 1.f;
#pragma unroll
            EPI_ROWS(ai, m) { bf16* rp = base + (size_t)(rowb + ai * 128 + m * 16) * ldc + colt + cw;
#pragma unroll
                for (int bj = 0; bj < 2; ++bj) *(GAS v4u*)(rp + bj * 128) = pack8(acc[ai][bj][m][0] * sc, acc[ai][bj][m][1] * sc); }
        } else if (pn == 12) {
#pragma unroll
            EPI_ROWS(ai, m) { const size_t row = rowb + ai * 128 + m * 16;
                *(GAS v4u*)(KA + row * 128 + cw) = pack8(acc[ai][0][m][0], acc[ai][0][m][1]);
                *(GAS v4u*)(VA + row * 128 + cw) = pack8(acc[ai][1][m][0], acc[ai][1][m][1]); }
        } else if (pn == 13) {
#pragma unroll
            EPI_ROWS(ai, m) { const size_t row = rowb + ai * 128 + m * 16; const int pos = (int)(row & (SEQ - 1));
                const f32x4 v0 = acc[ai][0][m][0], v1 = acc[ai][0][m][1];
                if (wc < 2) { *(GAS v4u*)(KI + row * 64 + cw) = pack8(v0, v1); }
                else { const int g = 4 * (wc - 2) + fq; const f32x4 c4 = *(const GAS f32x4*)(ROPE + pos * 32 + 4 * g), s4 = *(const GAS f32x4*)(ROPE + SEQ * 32 + pos * 32 + 4 * g);
                    *(GAS u32x2*)(KR + row * 64 + 4 * g) = pack4(v0 * c4 - v1 * s4); *(GAS u32x2*)(KR + row * 64 + 32 + 4 * g) = pack4(v0 * s4 + v1 * c4); }
                if (wc == 0 && fq < 2) { *(GAS f32x4*)(WI + row * 16 + 8 * fq) = acc[ai][1][m][0]; *(GAS f32x4*)(WI + row * 16 + 8 * fq + 4) = acc[ai][1][m][1]; } }
        } else {
            const int t = pn - 14; bf16* base = t < 2 ? CQ : CKV; float* ssq = SSQ + (t < 2 ? 0 : M); const int colt = (t & 1) * 256;
#pragma unroll
            EPI_ROWS(ai, m) { const size_t row = rowb + ai * 128 + m * 16; float s = 0.f;
#pragma unroll
                for (int bj = 0; bj < 2; ++bj) { const f32x4 v0 = acc[ai][bj][m][0], v1 = acc[ai][bj][m][1];
                    *(GAS v4u*)(base + row * 512 + colt + bj * 128 + cw) = pack8(v0, v1);
                    s += (v0[0] * v0[0] + v0[1] * v0[1]) + (v0[2] * v0[2] + v0[3] * v0[3]) + (v1[0] * v1[0] + v1[1] * v1[1]) + (v1[2] * v1[2] + v1[3] * v1[3]); }
                s = sum_x32(sum_x16(s));
                if (fq == 0) atomicAdd(ssq + row, s); }
        }
    }
};
struct EpiQ {
    static constexpr bool PERM = true, AFTER_DRAIN = false;
    bf16 *QN, *QR; const float* SSQ; const float* ROPE;
    __device__ __forceinline__ void operator()(AccRef acc, const Unit& u, int wr, int wc, int fr, int fq) const {
        asm volatile("" : "+v"(fr), "+v"(fq));
        const int pn = u.pn, rowb = u.pm * 256 + wr * 64 + fr, cw = wc * 32 + 8 * fq;
#pragma unroll
        EPI_ROWS(ai, m) { const size_t row = rowb + ai * 128 + m * 16; const float r = QB_SCALE / sqrtf(SSQ[row] * (1.f / 512.f) + RMS_EPS);
            if (pn < 8) {
#pragma unroll
                for (int bj = 0; bj < 2; ++bj) *(GAS v4u*)(QN + row * 2048 + pn * 256 + bj * 128 + cw) = pack8(acc[ai][bj][m][0] * r, acc[ai][bj][m][1] * r);
            } else { const int pos = (int)(row & (SEQ - 1)), g = 4 * (wc & 1) + fq;
                const f32x4 c4 = *(const GAS f32x4*)(ROPE + pos * 32 + 4 * g) * r, s4 = *(const GAS f32x4*)(ROPE + SEQ * 32 + pos * 32 + 4 * g) * r;
#pragma unroll
                for (int bj = 0; bj < 2; ++bj) { const int head = (pn - 8) * 4 + bj * 2 + (wc >> 1); const f32x4 v0 = acc[ai][bj][m][0], v1 = acc[ai][bj][m][1];
                    *(GAS u32x2*)(QR + row * 1024 + head * 64 + 4 * g) = pack4(v0 * c4 - v1 * s4); *(GAS u32x2*)(QR + row * 1024 + head * 64 + 32 + 4 * g) = pack4(v0 * s4 + v1 * c4); } } }
    }
};
struct EpiKV {
    static constexpr bool PERM = true, AFTER_DRAIN = false;
    bf16 *KN, *VB; const float* SSQ;
    __device__ __forceinline__ void operator()(AccRef acc, const Unit& u, int wr, int wc, int fr, int fq) const {
        asm volatile("" : "+v"(fr), "+v"(fq));
        const int pn = u.pn, rowb = u.pm * 256 + wr * 64 + fr, cw = wc * 32 + 8 * fq; bf16* base = pn < 8 ? KN : VB; const int colt = (pn & 7) * 256;
#pragma unroll
        EPI_ROWS(ai, m) { const size_t row = rowb + ai * 128 + m * 16; const float r = 1.0f / sqrtf(SSQ[row] * (1.f / 512.f) + RMS_EPS);
#pragma unroll
            for (int bj = 0; bj < 2; ++bj) *(GAS v4u*)(base + row * 2048 + colt + bj * 128 + cw) = pack8(acc[ai][bj][m][0] * r, acc[ai][bj][m][1] * r); }
    }
};
template <int MODE> struct EpiB {
    static constexpr bool PERM = true, AFTER_DRAIN = false;
    bf16* O; int ldc; const bf16* gp; const float* bias;
    __device__ __forceinline__ void operator()(AccRef acc, const Unit& u, int wr, int wc, int fr, int fq) const {
        asm volatile("" : "+v"(fr), "+v"(fq));
        const int rowb = u.pm * 256 + wr * 64 + fr, colb = u.pn * 256 + wc * 32 + 8 * fq;
#pragma unroll
        EPI_ROWS(ai, m) { const size_t row = rowb + ai * 128 + m * 16;
#pragma unroll
            for (int bj = 0; bj < 2; ++bj) { const int col = colb + bj * 128; f32x4 v0 = acc[ai][bj][m][0], v1 = acc[ai][bj][m][1]; bf16* op = O + row * ldc + col;
                if (MODE == 1) { v0 = sigmoid4(v0); v1 = sigmoid4(v1); }
                if (MODE == 2 || MODE == 3) { f32x4 g0, g1; unpack8(*(const GAS v4u*)(gp + row * 4096 + col), g0, g1); v0 = v0 * g0; v1 = v1 * g1; }
                if (MODE == 3) { f32x4 o0, o1; unpack8(*(const GAS v4u*)op, o0, o1); v0 = v0 + o0; v1 = v1 + o1; }
                if (MODE == 4) { f32x4 o0, o1; unpack8(*(const GAS v4u*)op, o0, o1); const f32x4 b0 = *(const GAS f32x4*)(bias + col), b1 = *(const GAS f32x4*)(bias + col + 4);
                    v0 = sigmoid4(v0 + b0) * o0; v1 = sigmoid4(v1 + b1) * o1; }
                *(GAS v4u*)op = pack8(v0, v1); }
            if (MODE >= 2) asm volatile("" ::: "memory"); }
    }
};
template <int MODE> struct EpiF {
    static constexpr bool PERM = true, AFTER_DRAIN = false;
    float* out; const float* xin; const bf16* ple;
    __device__ __forceinline__ void operator()(AccRef acc, const Unit& u, int wr, int wc, int fr, int fq) const {
        asm volatile("" : "+v"(fr), "+v"(fq));
        const int rowb = u.pm * 256 + wr * 64 + fr, colb = u.pn * 256 + wc * 32 + 8 * fq;
#pragma unroll
        EPI_ROWS(ai, m) { const size_t row = rowb + ai * 128 + m * 16;
#pragma unroll
            for (int bj = 0; bj < 2; ++bj) { const size_t off = row * 2048 + colb + bj * 128; f32x4 v0 = acc[ai][bj][m][0], v1 = acc[ai][bj][m][1];
                const float* rp = MODE == 0 ? xin : out; const f32x4 x0 = *(const GAS f32x4*)(rp + off), x1 = *(const GAS f32x4*)(rp + off + 4);
                v0 = v0 + x0 * ALPHA; v1 = v1 + x1 * ALPHA;
                if (MODE == 1) { f32x4 p0, p1; unpack8(*(const GAS v4u*)(ple + off), p0, p1); v0 = v0 + p0; v1 = v1 + p1; }
                *(GAS f32x4*)(out + off) = v0; *(GAS f32x4*)(out + off + 4) = v1; }
            asm volatile("" ::: "memory"); }
    }
};
template <int CTRL> __device__ __forceinline__ f32x4 dpp4(f32x4 v) { return (f32x4){dppf<CTRL>(v[0]), dppf<CTRL>(v[1]), dppf<CTRL>(v[2]), dppf<CTRL>(v[3])}; }
__device__ __forceinline__ f32x4 sel4(bool c, f32x4 a, f32x4 b) { return (f32x4){c ? a[0] : b[0], c ? a[1] : b[1], c ? a[2] : b[2], c ? a[3] : b[3]}; }
struct EpiUp {
    static constexpr bool PERM = true, AFTER_DRAIN = false;
    bf16* ACT; float* HEADB; float* TAILB; const float* cw; const float* cb;
    __device__ __forceinline__ void operator()(AccRef acc, const Unit& u, int wr, int wc, int fr, int fq) const {
        asm volatile("" : "+v"(fr), "+v"(fq));
        const int ch0 = u.pn * 128 + wc * 32 + 8 * fq, cp0 = u.pn * 256 + wc * 32 + 8 * fq;
        const bool f1 = fr >= 1, f2 = fr >= 2;
#pragma unroll
        for (int ai = 0; ai < 2; ++ai) {
            const int g = u.pm * 4 + ai * 2 + wr; const int row0 = g * 64 + fr;
            if (fr < 2 || fr >= 14) {
                float* hp = (fr < 2 ? HEADB + (g * 2 + fr) * NUP : TAILB + (g * 2 + (fr - 14)) * NUP) + cp0;
#pragma unroll
                for (int bj = 0; bj < 2; ++bj)
#pragma unroll
                    for (int n = 0; n < 2; ++n) *(GAS f32x4*)(hp + bj * 128 + 4 * n) = fr < 2 ? acc[ai][bj][0][n] : acc[ai][bj][3][n];
            }
            asm volatile("" ::: "memory");
#pragma unroll
            for (int n = 0; n < 2; ++n) {
                unsigned pk[4];
#pragma unroll
                for (int hf = 0; hf < 2; ++hf) {
                    f32x2 yg[4];
#pragma unroll
                    for (int bj = 0; bj < 2; ++bj) { const int c = ch0 + 4 * n + 2 * hf + bj * DFF;
                        const f32x2 w0 = *(const GAS f32x2*)(cw + c), w1 = *(const GAS f32x2*)(cw + NUP + c), w2 = *(const GAS f32x2*)(cw + 2 * NUP + c), bb = *(const GAS f32x2*)(cb + c);
                        f32x2 pr1 = (f32x2){0.f, 0.f}, pr2 = pr1;
#pragma unroll
                        for (int m = 0; m < 4; ++m) { const f32x4 v4 = acc[ai][bj][m][n]; const f32x2 v = hf ? (f32x2){v4[2], v4[3]} : (f32x2){v4[0], v4[1]};
                            const f32x2 r1 = (f32x2){dppf<0x121>(v[0]), dppf<0x121>(v[1])}, r2 = (f32x2){dppf<0x122>(v[0]), dppf<0x122>(v[1])};
                            const f32x2 p1 = fr >= 1 ? r1 : pr1, p2 = fr >= 2 ? r2 : pr2;
                            const f32x2 y = bb + w2 * v + w1 * p1 + w0 * p2; pr1 = r1; pr2 = r2;
                            if (bj == 0) yg[m] = y;
                            else { const f32x2 sg = (f32x2){sigmoidf_(yg[m][0]), sigmoidf_(yg[m][1])}; const f32x2 a = yg[m] * sg * y; const unsigned pa = cvt_pk_bf16(a[0], a[1]);
                                if (hf == 0) pk[m] = pa;
                                else if (!(m == 0 && fr < 2)) { u32x2 w; w.x = pk[m]; w.y = pa; *(GAS u32x2*)(ACT + (size_t)(row0 + m * 16) * DFF + ch0 + 4 * n) = w; } } }
                        asm volatile("" ::: "memory"); }
                }
            }
        }
    }
};

namespace dsa {
constexpr int CAP = 512, TOPK = 256;
typedef unsigned long long u64;
typedef unsigned short u16;
__device__ __forceinline__ unsigned fkey(float f) { const unsigned u = __float_as_uint(f); return u ^ ((unsigned)((int)u >> 31) | 0x80000000u); }
__device__ __forceinline__ float keyf(unsigned k) { const unsigned u = (k & 0x80000000u) ? (k ^ 0x80000000u) : ~k; return __uint_as_float(u); }
__device__ __forceinline__ int mbcnt64(u64 m) { return (int)__builtin_amdgcn_mbcnt_hi((unsigned)(m >> 32), __builtin_amdgcn_mbcnt_lo((unsigned)m, 0u)); }

__device__ __forceinline__ unsigned compact(LAS u64* buf, int n, int lane) {
    unsigned key[8], idx[8];
#pragma unroll
    for (int e = 0; e < 8; ++e) { const int i = lane + 64 * e; u64 v = 0ull; if (i < n) v = buf[i]; key[e] = (unsigned)(v >> 32); idx[e] = (unsigned)v; }
    unsigned P = 0u;
#pragma unroll 1
    for (int b = 31; b >= 0; --b) { const unsigned cand = P | (1u << b); int c = 0;
#pragma unroll
        for (int e = 0; e < 8; ++e) c += __builtin_popcountll(__ballot(key[e] >= cand));
        if (c >= TOPK) P = cand; }
    int cgt = 0;
#pragma unroll
    for (int e = 0; e < 8; ++e) cgt += __builtin_popcountll(__ballot(key[e] > P));
    const int need = TOPK - cgt; int base = 0, eqbase = 0;
#pragma unroll
    for (int e = 0; e < 8; ++e) { const bool gt = key[e] > P, eq = key[e] == P; const u64 beq = __ballot(eq); const bool sel = gt || (eq && (eqbase + mbcnt64(beq)) < need);
        const u64 bs = __ballot(sel); const int pos = base + mbcnt64(bs);
        if (sel) buf[pos] = ((u64)key[e] << 32) | idx[e];
        base += __builtin_popcountll(bs); eqbase += __builtin_popcountll(beq); }
    asm volatile("s_waitcnt lgkmcnt(0)" ::: "memory");
    return P;
}

struct Ptrs { const bf16 *QI, *KI, *KA, *VA; const float* WI; bf16* QA; };

__device__ __forceinline__ void attend(const Ptrs& P, int b, int t, const LAS u16* idl, LAS unsigned char* vbuf, int lane) {
    const int head = lane & 15, g = lane >> 4; const size_t m = (size_t)b * SEQ + t;
    bf16x8 Bq[4];
#pragma unroll
    for (int ks = 0; ks < 4; ++ks) Bq[ks] = *(const GAS bf16x8*)(P.QA + m * 2048 + head * 128 + 32 * ks + 8 * g);
    const float slope2 = __builtin_amdgcn_exp2f(-0.5f * (float)(head + 1)) * LOG2E;
    const bf16* vab = P.VA + (size_t)b * SEQ * 128;
#if defined(DBG_NO_DMA)
#define DSA_CP16(src_, dst_) do { const v4u t_ = *(const GAS v4u*)(src_); *(LAS v4u*)((dst_) + lane * 16) = t_; } while (0)
#else
#define DSA_CP16(src_, dst_) __builtin_amdgcn_global_load_lds((const unsigned*)(src_), (LAS unsigned*)(dst_), 16, 0, 0)
#endif
#define DSA_VDMA(kk) do { _Pragma("unroll") for (int u_ = 0; u_ < 8; ++u_) { const int row_ = 4 * u_ + g; unsigned s_ = idl[32 * (kk) + row_]; s_ = s_ == 0xFFFFu ? 0u : s_; \
        const int cl_ = (lane & 15) ^ ((row_ & 7) << 1); \
        DSA_CP16((vab + (size_t)s_ * 128 + cl_ * 8), (vbuf + ((kk) & 1) * 8192 + u_ * 1024)); } } while (0)
    DSA_VDMA(0); DSA_VDMA(1);
    const bf16* kab = P.KA + (size_t)b * SEQ * 128 + 8 * g;
    f32x4 L[16];
#pragma unroll
    for (int i = 0; i < 16; ++i) {
        unsigned s = idl[16 * i + head]; s = s == 0xFFFFu ? 0u : s;
        const bf16* kp = kab + (size_t)s * 128;
        bf16x8 Af[4];
#pragma unroll
        for (int ks = 0; ks < 4; ++ks) Af[ks] = *(const GAS bf16x8*)(kp + 32 * ks);
        f32x4 C = (f32x4){0.f, 0.f, 0.f, 0.f};
#pragma unroll
        for (int ks = 0; ks < 4; ++ks) C = __builtin_amdgcn_mfma_f32_16x16x32_bf16(Af[ks], Bq[ks], C, 0, 0, 0);
        const u32x2 idw = *(const LAS u32x2*)(idl + 16 * i + 4 * g);
        const unsigned i0 = idw.x & 0xffffu, i1 = idw.x >> 16, i2 = idw.y & 0xffffu, i3 = idw.y >> 16;
        L[i][0] = i0 == 0xFFFFu ? -__builtin_inff() : C[0] - slope2 * (float)(t - (int)i0);
        L[i][1] = i1 == 0xFFFFu ? -__builtin_inff() : C[1] - slope2 * (float)(t - (int)i1);
        L[i][2] = i2 == 0xFFFFu ? -__builtin_inff() : C[2] - slope2 * (float)(t - (int)i2);
        L[i][3] = i3 == 0xFFFFu ? -__builtin_inff() : C[3] - slope2 * (float)(t - (int)i3);
    }
    float mx = -__builtin_inff();
#pragma unroll
    for (int i = 0; i < 16; ++i) mx = fmaxf(fmaxf(mx, fmaxf(L[i][0], L[i][1])), fmaxf(L[i][2], L[i][3]));
    mx = max_x32(max_x16(mx));
    float sum = 0.f;
#pragma unroll
    for (int i = 0; i < 16; ++i) {
#pragma unroll
        for (int r = 0; r < 4; ++r) { const float p = __builtin_amdgcn_exp2f(L[i][r] - mx); L[i][r] = p; sum += p; } }
    sum = sum_x32(sum_x16(sum));
    f32x4 O[8];
#pragma unroll
    for (int dt = 0; dt < 8; ++dt) O[dt] = (f32x4){0.f, 0.f, 0.f, 0.f};
    const int q4 = (lane >> 2) & 3, p4 = lane & 3, row1 = 4 * g + q4;
#pragma unroll
    for (int kk = 0; kk < 8; ++kk) {
        const v4u pw = pack8(L[2 * kk], L[2 * kk + 1]); const bf16x8 Pf = __builtin_bit_cast(bf16x8, pw);
#if defined(DBG_DMA_WAIT0)
        asm volatile("s_waitcnt vmcnt(0)" ::: "memory");
#else
        if (kk < 7) asm volatile("s_waitcnt vmcnt(8)" ::: "memory"); else asm volatile("s_waitcnt vmcnt(0)" ::: "memory");
#endif
#if defined(DBG_DMA_SLEEP)
        asm volatile("s_sleep 4" ::: "memory");
#endif
        const unsigned vb = (unsigned)(uintptr_t)(vbuf + (kk & 1) * 8192) + row1 * 256 + 8 * p4;
#pragma unroll
        for (int dt = 0; dt < 8; ++dt) { s16x4 lo, hi2;
            const unsigned a1 = vb + (((unsigned)(dt ^ (row1 & 7))) << 5);
            asm volatile("ds_read_b64_tr_b16 %0, %1" : "=&v"(lo) : "v"(a1) : "memory");
            asm volatile("ds_read_b64_tr_b16 %0, %1 offset:4096" : "=&v"(hi2) : "v"(a1) : "memory");
            asm volatile("s_waitcnt lgkmcnt(0)" : "+v"(lo), "+v"(hi2) :: "memory");
            const bf16x8 Av = (bf16x8){lo[0], lo[1], lo[2], lo[3], hi2[0], hi2[1], hi2[2], hi2[3]};
            O[dt] = __builtin_amdgcn_mfma_f32_16x16x32_bf16(Av, Pf, O[dt], 0, 0, 0); }
        if (kk + 2 < 8) DSA_VDMA(kk + 2);
    }
#undef DSA_VDMA
    const float inv = 1.0f / sum;
    bf16* op = P.QA + m * 2048 + head * 128 + 4 * g;
#pragma unroll
    for (int dt = 0; dt < 8; ++dt) *(GAS u32x2*)(op + 16 * dt) = pack4(O[dt] * inv);
}

__device__ __forceinline__ void job(const Ptrs& P, int b, int t0, LAS unsigned char* wl, LAS u16* idl, int lane) {
    const int r32 = lane & 31, hi = lane >> 5;
    const int qsel = (r32 >> 2) & 1, headA = (r32 & 3) + 4 * (r32 >> 3);
    bf16x8 A[2][4]; float sg[2][16];
#pragma unroll
    for (int a = 0; a < 2; ++a) {
        const size_t mA = (size_t)b * SEQ + t0 + 2 * a + qsel; const float aw = fabsf(P.WI[mA * 16 + headA]);
#pragma unroll
        for (int d0 = 0; d0 < 4; ++d0) { f32x4 x0, x1; unpack8(*(const GAS v4u*)(P.QI + mA * 1024 + headA * 64 + 16 * d0 + 8 * hi), x0, x1); A[a][d0] = __builtin_bit_cast(bf16x8, pack8(x0 * aw, x1 * aw)); }
        const size_t mC = (size_t)b * SEQ + t0 + 2 * a + hi;
#pragma unroll
        for (int r4 = 0; r4 < 4; ++r4) { const f32x4 w4 = *(const GAS f32x4*)(P.WI + mC * 16 + 4 * r4);
#pragma unroll
            for (int j = 0; j < 4; ++j) sg[a][4 * r4 + j] = w4[j] < 0.f ? -1.f : 1.f; }
    }
    LAS u64* cand = (LAS u64*)wl;
    int c0 = 0, c1 = 0, c2 = 0, c3 = 0; float tau0 = -__builtin_inff(), tau1 = -__builtin_inff();
    const int ntile = (t0 + 3) / 32 + 1;
    const bf16* kib = P.KI + (size_t)b * SEQ * 64 + 8 * hi;
    bf16x8 Bn[4];
#pragma unroll
    for (int d0 = 0; d0 < 4; ++d0) Bn[d0] = *(const GAS bf16x8*)(kib + (size_t)r32 * 64 + 16 * d0);
#pragma unroll 1
    for (int jt = 0; jt < ntile; ++jt) {
        bf16x8 Bf[4];
#pragma unroll
        for (int d0 = 0; d0 < 4; ++d0) Bf[d0] = Bn[d0];
        { const int jn = jt + 1 < ntile ? jt + 1 : jt;
#pragma unroll
          for (int d0 = 0; d0 < 4; ++d0) Bn[d0] = *(const GAS bf16x8*)(kib + (size_t)(jn * 32 + r32) * 64 + 16 * d0); }
        const int s = jt * 32 + r32;
#pragma unroll
        for (int a = 0; a < 2; ++a) {
            f32x16 C = {};
#pragma unroll
            for (int d0 = 0; d0 < 4; ++d0) C = __builtin_amdgcn_mfma_f32_32x32x16_bf16(A[a][d0], Bf[d0], C, 0, 0, 0);
            float sc = 0.f;
#pragma unroll
            for (int r = 0; r < 16; ++r) sc = fmaf(fmaxf(C[r], 0.f), sg[a][r], sc);
            const int tq = t0 + 2 * a + hi; const float tau = a == 0 ? tau0 : tau1;
            const bool pass = (s <= tq) && (sc > tau);
            const u64 bal = __ballot(pass);
            if (bal) { const unsigned blo = (unsigned)bal, bhi = (unsigned)(bal >> 32);
                const int pre = hi ? (int)__builtin_amdgcn_mbcnt_hi(bhi, 0u) : (int)__builtin_amdgcn_mbcnt_lo(blo, 0u);
                const int cq = a == 0 ? (hi ? c1 : c0) : (hi ? c3 : c2);
                if (pass) cand[(2 * a + hi) * CAP + cq + pre] = ((u64)fkey(sc) << 32) | (unsigned)s;
                if (a == 0) { c0 += __builtin_popcount(blo); c1 += __builtin_popcount(bhi); } else { c2 += __builtin_popcount(blo); c3 += __builtin_popcount(bhi); } }
        }
        const int lim = (jt == ntile - 1) ? TOPK : CAP - 32;
#pragma unroll 1
        for (;;) {
            const int q = c0 > lim ? 0 : c1 > lim ? 1 : c2 > lim ? 2 : c3 > lim ? 3 : -1;
            if (q < 0) break;
            const int n = q == 0 ? c0 : q == 1 ? c1 : q == 2 ? c2 : c3;
            asm volatile("s_waitcnt lgkmcnt(0)" ::: "memory");
            const float tf = keyf(compact(cand + q * CAP, n, lane));
            if (q == 0) c0 = TOPK; else if (q == 1) c1 = TOPK; else if (q == 2) c2 = TOPK; else c3 = TOPK;
            if ((q >> 1) == 0) { if (hi == (q & 1)) tau0 = tf; } else { if (hi == (q & 1)) tau1 = tf; }
        }
    }
    asm volatile("s_waitcnt lgkmcnt(0)" ::: "memory");
#pragma unroll
    for (int q = 0; q < 4; ++q) { const int n = q == 0 ? c0 : q == 1 ? c1 : q == 2 ? c2 : c3;
#pragma unroll
        for (int e = 0; e < 4; ++e) { const int i = lane + 64 * e; unsigned v = 0xFFFFu; if (i < n) v = (unsigned)cand[q * CAP + i] & 0xFFFFu;
#if defined(DBG_FIXED_SEL)
            v = (t0 + q - i) >= 0 ? (unsigned)(t0 + q - i) : 0xFFFFu;
#endif
            idl[q * TOPK + i] = (u16)v; } }
    asm volatile("s_waitcnt lgkmcnt(0)" ::: "memory");
#pragma unroll 1
    for (int q = 0; q < 4; ++q) attend(P, b, t0 + q, idl + q * TOPK, wl, lane);
}
}

namespace mla {
constexpr int NW = 8, QBLK = 32, KVBLK = 64, QB = 256;
constexpr int SHM_V = 16384, SHM_K = 16384, SHM_R = 8192;
constexpr int OFF_V = 0, OFF_K = 2 * SHM_V, OFF_R = OFF_K + 2 * SHM_K, OFF_WS = OFF_R + 2 * SHM_R, LDS_NEED = OFF_WS + NW * 64 * 4;
constexpr float THR = 8.f;
#define MLA_KSWZ(row, colB) ((row) * 256 + ((colB) ^ (((row) & 7) << 4)))
#define MLA_RSWZ(row, colB) ((row) * 128 + ((colB) ^ ((((row) >> 1) & 7) << 4)))
#define MLA_SBAR() __builtin_amdgcn_sched_barrier(0)
__device__ __forceinline__ int v_st(int k, int c) { const int kk = (k & ~0xC) | ((k & 4) << 1) | ((k & 8) >> 1); return ((kk >> 3) * 4 + (c >> 5)) * 512 + ((kk & 7) * 32 + (c & 31)) * 2; }
__device__ __forceinline__ int v_rd_base(int lane) { return ((lane & 3) << 3) | (((lane >> 2) & 3) << 6) | (((lane >> 4) & 1) << 5) | (((lane >> 5) & 1) << 8); }
constexpr int v_rd_off(int d0, int ks, int half) { return d0 * 512 + ks * 4096 + half * 2048; }
__device__ __forceinline__ int crow(int r, int hi) { return (r & 3) + 8 * (r >> 2) + 4 * hi; }
__device__ __forceinline__ unsigned cvtpk(float lo, float hi) { unsigned r; asm volatile("v_cvt_pk_bf16_f32 %0, %1, %2" : "=v"(r) : "v"(lo), "v"(hi)); return r; }

__device__ __forceinline__ void mask_tile(f32x16& p0, f32x16& p1, int dq) {
    const float NEG = -__builtin_inff();
#pragma unroll
    for (int r = 0; r < 16; ++r) { const int c = (r & 3) + 8 * (r >> 2);
        if (dq - c < 0) p0[r] = NEG;
        if (dq - c - 32 < 0) p1[r] = NEG; }
}
__device__ __forceinline__ void softmax_tile(f32x16& p0, f32x16& p1, float& m_reg, float& l_reg, float& alpha, bf16x8& pa0, bf16x8& pa1, bf16x8& pa2, bf16x8& pa3) {
    float pmax = p0[0];
#pragma unroll
    for (int r = 1; r < 16; ++r) pmax = fmaxf(pmax, p0[r]);
#pragma unroll
    for (int r = 0; r < 16; ++r) pmax = fmaxf(pmax, p1[r]);
    { auto rr = __builtin_amdgcn_permlane32_swap(__float_as_uint(pmax), __float_as_uint(pmax), false, false); pmax = fmaxf(__uint_as_float(rr[0]), __uint_as_float(rr[1])); }
    float mn;
    if (__builtin_expect(__all((pmax - m_reg) <= THR), 1)) { mn = m_reg; alpha = 1.f; }
    else { mn = fmaxf(m_reg, pmax); alpha = __builtin_amdgcn_exp2f(m_reg - mn); m_reg = mn; }
#pragma unroll
    for (int r = 0; r < 16; ++r) { p0[r] = __builtin_amdgcn_exp2f(p0[r] - mn); p1[r] = __builtin_amdgcn_exp2f(p1[r] - mn); }
    float ps = 0.f;
#pragma unroll
    for (int r = 0; r < 16; ++r) ps += p0[r];
#pragma unroll
    for (int r = 0; r < 16; ++r) ps += p1[r];
    { auto rr = __builtin_amdgcn_permlane32_swap(__float_as_uint(ps), __float_as_uint(ps), false, false); ps = __uint_as_float(rr[0]) + __uint_as_float(rr[1]); }
    l_reg = l_reg * alpha + ps;
#define MLA_PK4(P, B_, OUT) do { unsigned a0 = cvtpk(P[B_ + 0], P[B_ + 1]), a1 = cvtpk(P[B_ + 2], P[B_ + 3]); unsigned b0 = cvtpk(P[B_ + 4], P[B_ + 5]), b1 = cvtpk(P[B_ + 6], P[B_ + 7]); \
        auto r0 = __builtin_amdgcn_permlane32_swap(a0, b0, false, false); auto r1 = __builtin_amdgcn_permlane32_swap(a1, b1, false, false); \
        v4u w = {r0[0], r1[0], r0[1], r1[1]}; OUT = __builtin_bit_cast(bf16x8, w); } while (0)
    MLA_PK4(p0, 0, pa0); MLA_PK4(p0, 8, pa1); MLA_PK4(p1, 0, pa2); MLA_PK4(p1, 8, pa3);
#undef MLA_PK4
}
template <int KB>
__device__ __forceinline__ void qkt(f32x16& p0, f32x16& p1, const LAS unsigned char* lds, int r32, int hi, const bf16x8* qr) {
    p0 = f32x16{}; p1 = f32x16{};
    const LAS unsigned char* kb[4];
#pragma unroll
    for (int dd = 0; dd < 4; ++dd) kb[dd] = lds + OFF_K + KB * SHM_K + MLA_KSWZ(r32, (dd * 16 + hi * 8) * 2);
#pragma unroll
    for (int d0 = 0; d0 < 8; ++d0) { const LAS unsigned char* a = kb[d0 & 3] + (d0 >> 2) * 128;
        const bf16x8 b0 = *(const LAS bf16x8*)a, b1 = *(const LAS bf16x8*)(a + 32 * 256);
        p0 = __builtin_amdgcn_mfma_f32_32x32x16_bf16(b0, qr[d0], p0, 0, 0, 0);
        p1 = __builtin_amdgcn_mfma_f32_32x32x16_bf16(b1, qr[d0], p1, 0, 0, 0); }
#pragma unroll
    for (int d0 = 0; d0 < 4; ++d0) { const LAS unsigned char* a = lds + OFF_R + KB * SHM_R + MLA_RSWZ(r32, (d0 * 16 + hi * 8) * 2);
        const bf16x8 b0 = *(const LAS bf16x8*)a, b1 = *(const LAS bf16x8*)(a + 32 * 128);
        p0 = __builtin_amdgcn_mfma_f32_32x32x16_bf16(b0, qr[8 + d0], p0, 0, 0, 0);
        p1 = __builtin_amdgcn_mfma_f32_32x32x16_bf16(b1, qr[8 + d0], p1, 0, 0, 0); }
}
template <int VB>
__device__ __forceinline__ void pv_tile(f32x16* o, int vb0, bf16x8 pa0, bf16x8 pa1, bf16x8 pa2, bf16x8 pa3) {
#define MLA_TRRD(dst, off) asm volatile("ds_read_b64_tr_b16 %0, %1 offset:%2" : "=&v"(dst) : "v"(vb0), "i"(off) : "memory")
#define MLA_PV_D0(d0) do { s16x4 l0, l1, l2, l3, h0, h1, h2, h3; constexpr int b_ = OFF_V + VB * SHM_V + v_rd_off(d0, 0, 0); \
        MLA_TRRD(l0, b_); MLA_TRRD(h0, b_ + 2048); MLA_TRRD(l1, b_ + 4096); MLA_TRRD(h1, b_ + 6144); MLA_TRRD(l2, b_ + 8192); MLA_TRRD(h2, b_ + 10240); MLA_TRRD(l3, b_ + 12288); MLA_TRRD(h3, b_ + 14336); \
        asm volatile("s_waitcnt lgkmcnt(0)" ::: "memory"); MLA_SBAR(); \
        o[d0] = __builtin_amdgcn_mfma_f32_32x32x16_bf16(pa0, (bf16x8){l0[0], l0[1], l0[2], l0[3], h0[0], h0[1], h0[2], h0[3]}, o[d0], 0, 0, 0); \
        o[d0] = __builtin_amdgcn_mfma_f32_32x32x16_bf16(pa1, (bf16x8){l1[0], l1[1], l1[2], l1[3], h1[0], h1[1], h1[2], h1[3]}, o[d0], 0, 0, 0); \
        o[d0] = __builtin_amdgcn_mfma_f32_32x32x16_bf16(pa2, (bf16x8){l2[0], l2[1], l2[2], l2[3], h2[0], h2[1], h2[2], h2[3]}, o[d0], 0, 0, 0); \
        o[d0] = __builtin_amdgcn_mfma_f32_32x32x16_bf16(pa3, (bf16x8){l3[0], l3[1], l3[2], l3[3], h3[0], h3[1], h3[2], h3[3]}, o[d0], 0, 0, 0); } while (0)
    MLA_PV_D0(0); MLA_PV_D0(1); MLA_PV_D0(2); MLA_PV_D0(3);
#undef MLA_PV_D0
#undef MLA_TRRD
}
struct Tensors { bf16* QN; const bf16* QR; const bf16* KN; const bf16* KR; const bf16* VB; };

__device__ __forceinline__ void unit(const Tensors& T, int b, int h, int qb, LAS unsigned char* lds) {
    const int tid = threadIdx.x, wid = __builtin_amdgcn_readfirstlane(tid >> 6), lane = tid & 63, r32 = lane & 31, hi = lane >> 5;
    const size_t rowq = (size_t)b * SEQ + qb * QB + wid * QBLK + r32;
    bf16x8 qr[12];
#pragma unroll
    for (int d0 = 0; d0 < 8; ++d0) qr[d0] = *(const GAS bf16x8*)(T.QN + rowq * 2048 + h * 128 + d0 * 16 + hi * 8);
#pragma unroll
    for (int d0 = 0; d0 < 4; ++d0) qr[8 + d0] = *(const GAS bf16x8*)(T.QR + rowq * 1024 + h * 64 + d0 * 16 + hi * 8);
    const int NT = 4 * (qb + 1);
    const int qlo = qb * QB + wid * QBLK, qm = qlo + r32 - 4 * hi;
    LAS float* ws = (LAS float*)(lds + OFF_WS) + wid * 64; LAS float* li_l = ws; LAS float* al_l = ws + 32;
    float m_reg = -1e30f, l_reg = 0.f; f32x16 o[4] = {};
    const int vb0 = (int)(uintptr_t)lds + v_rd_base(lane);
    int voff[2], koff[2], roff;
#pragma unroll
    for (int i = 0; i < 2; ++i) { const int G_ = (wid + 8 * i) * 64 + lane;
        { const int st = G_ >> 5, w_ = G_ & 31, kk = (st >> 2) * 8 + (w_ >> 2), c = (st & 3) * 32 + (w_ & 3) * 8, k = (kk & ~0xC) | ((kk & 4) << 1) | ((kk & 8) >> 1); voff[i] = k * 2048 + c; }
        { const int row = G_ >> 4, slot = G_ & 15; koff[i] = row * 2048 + 8 * (slot ^ (row & 7)); } }
    { const int G_ = wid * 64 + lane, row = G_ >> 3, slot = G_ & 7; roff = row * 64 + 8 * (slot ^ ((row >> 1) & 7)); }
    const bf16* Kh = T.KN + (size_t)b * SEQ * 2048 + h * 128; const bf16* Vh = T.VB + (size_t)b * SEQ * 2048 + h * 128; const bf16* Rh = T.KR + (size_t)b * SEQ * 64;
#define MLA_DMA(k0, bf) do { _Pragma("unroll") for (int i_ = 0; i_ < 2; ++i_) { \
        __builtin_amdgcn_global_load_lds((const unsigned*)(Vh + (size_t)(k0) * 2048 + voff[i_]), (LAS unsigned*)(lds + OFF_V + (bf) * SHM_V + (wid + 8 * i_) * 1024), 16, 0, 0); \
        __builtin_amdgcn_global_load_lds((const unsigned*)(Kh + (size_t)(k0) * 2048 + koff[i_]), (LAS unsigned*)(lds + OFF_K + (bf) * SHM_K + (wid + 8 * i_) * 1024), 16, 0, 0); } \
        __builtin_amdgcn_global_load_lds((const unsigned*)(Rh + (size_t)(k0) * 64 + roff), (LAS unsigned*)(lds + OFF_R + (bf) * SHM_R + wid * 1024), 16, 0, 0); } while (0)
#define MLA_RESC(a) do { if (__any((a) < 1.f)) { if (hi == 0) al_l[r32] = (a); asm volatile("s_waitcnt lgkmcnt(0)" ::: "memory"); \
        _Pragma("unroll") for (int d_ = 0; d_ < 4; ++d_) _Pragma("unroll") for (int r = 0; r < 16; ++r) o[d_][r] *= al_l[crow(r, hi)]; } } while (0)
#define MLA_STEP(t, BUF) do { \
        if ((t) + 1 < NT) MLA_DMA(((t) + 1) * KVBLK, 1 - (BUF)); \
        MLA_SBAR(); f32x16 p0, p1; qkt<BUF>(p0, p1, lds, r32, hi, qr); \
        { const int kb_ = (t) * KVBLK; if (kb_ + KVBLK - 1 > qlo) mask_tile(p0, p1, qm - kb_); } \
        float alpha; bf16x8 pa0, pa1, pa2, pa3; softmax_tile(p0, p1, m_reg, l_reg, alpha, pa0, pa1, pa2, pa3); \
        MLA_RESC(alpha); MLA_SBAR(); \
        pv_tile<BUF>(o, vb0, pa0, pa1, pa2, pa3); \
        asm volatile("s_waitcnt vmcnt(0)" ::: "memory"); \
        __syncthreads(); } while (0)
    MLA_DMA(0, 0); asm volatile("s_waitcnt vmcnt(0)" ::: "memory"); __syncthreads();
#pragma unroll 1
    for (int t = 0; t < NT; t += 2) { MLA_STEP(t, 0); MLA_STEP(t + 1, 1); }
    if (hi == 0) li_l[r32] = l_reg; asm volatile("s_waitcnt lgkmcnt(0)" ::: "memory");
    bf16* Ow = T.QN + ((size_t)b * SEQ + qb * QB + wid * QBLK) * 2048 + h * 128;
#pragma unroll
    for (int r = 0; r < 16; ++r) { const int orow = crow(r, hi); const float rl = __builtin_amdgcn_rcpf(li_l[orow]);
#pragma unroll
        for (int d0 = 0; d0 < 4; ++d0) { const float v = o[d0][r] * rl; const float vn = dppf<0xB1>(v);
            if ((r32 & 1) == 0) *(GAS unsigned*)(Ow + (size_t)orow * 2048 + d0 * 32 + r32) = cvtpk(v, vn); } }
    __syncthreads();
#undef MLA_DMA
#undef MLA_RESC
#undef MLA_STEP
}
}

__device__ __forceinline__ void ln_pass(const float* zin, float* xout, bf16* xb, const float* g, const float* b, int gw, int NGW, int lane) {
    for (int m = gw; m < M; m += NGW) {
        const GAS f32x4* zr = (const GAS f32x4*)(zin + (size_t)m * DM) + lane;
        f32x4 v[8]; float s = 0.f;
#pragma unroll
        for (int j = 0; j < 8; ++j) { v[j] = zr[64 * j]; s += (v[j][0] + v[j][1]) + (v[j][2] + v[j][3]); }
        const float mean = wave_sum(s) * (1.f / DM); float s2 = 0.f;
#pragma unroll
        for (int j = 0; j < 8; ++j) { v[j] = v[j] - mean; s2 += (v[j][0] * v[j][0] + v[j][1] * v[j][1]) + (v[j][2] * v[j][2] + v[j][3] * v[j][3]); }
        const float rstd = 1.f / sqrtf(wave_sum(s2) * (1.f / DM) + LN_EPS);
#pragma unroll
        for (int j = 0; j < 8; ++j) { const f32x4 gg = *((const GAS f32x4*)g + lane + 64 * j), bb = *((const GAS f32x4*)b + lane + 64 * j);
            const f32x4 y = v[j] * rstd * gg + bb;
            *((GAS f32x4*)(xout + (size_t)m * DM) + lane + 64 * j) = y;
            if (xb) *((GAS u32x2*)(xb + (size_t)m * DM) + lane + 64 * j) = pack4(y); }
    }
}
__device__ __forceinline__ void conv_fixup(bf16* ACT, const float* HEADB, const float* TAILB, const float* cw, const float* cb, size_t gt, size_t NT) {
    constexpr int CH8 = DFF / 8;
    for (size_t it = gt; it < (size_t)256 * 2 * CH8; it += NT) {
        const int c8 = (int)(it % CH8), rr = (int)((it / CH8) & 1), g = (int)(it / (2 * CH8));
        const int ch = 8 * c8, pg = 256 * (ch >> 7) + (ch & 127); const bool first = (g & 127) == 0;
        f32x4 res[2][2];
#pragma unroll
        for (int bj = 0; bj < 2; ++bj) { const int pc = pg + bj * 128, c = ch + bj * DFF;
#pragma unroll
            for (int n = 0; n < 2; ++n) { const f32x4 z = (f32x4){0.f, 0.f, 0.f, 0.f};
                const f32x4 u0 = *(const GAS f32x4*)(HEADB + ((size_t)g * 2 + rr) * NUP + pc + 4 * n);
                const f32x4 t1 = first ? z : *(const GAS f32x4*)(TAILB + ((size_t)(g - 1) * 2 + 1) * NUP + pc + 4 * n);
                const f32x4 t0 = first ? z : *(const GAS f32x4*)(TAILB + ((size_t)(g - 1) * 2 + 0) * NUP + pc + 4 * n);
                const f32x4 h0 = *(const GAS f32x4*)(HEADB + ((size_t)g * 2 + 0) * NUP + pc + 4 * n);
                const f32x4 u1 = rr ? h0 : t1, u2 = rr ? t1 : t0;
                const f32x4 w0 = *(const GAS f32x4*)(cw + c + 4 * n), w1 = *(const GAS f32x4*)(cw + NUP + c + 4 * n), w2 = *(const GAS f32x4*)(cw + 2 * NUP + c + 4 * n), bb = *(const GAS f32x4*)(cb + c + 4 * n);
                res[bj][n] = bb + w2 * u0 + w1 * u1 + w0 * u2; } }
        const f32x4 a0 = res[0][0] * sigmoid4(res[0][0]) * res[1][0], a1 = res[0][1] * sigmoid4(res[0][1]) * res[1][1];
        *(GAS v4u*)(ACT + ((size_t)g * 64 + rr) * DFF + ch) = pack8(a0, a1);
    }
}

struct Args { const float* in[22]; float* out; unsigned char* ws; };
#define GEMM_PHASE(EPI, A_, B_, N_, K_, E_) do { int kk_ = (K_); asm volatile("" : "+s"(kk_)); pg8::Gemm g_{(const pg8::bf16_t*)(A_), (const pg8::bf16_t*)(B_), M, (N_), kk_}; pg8::StaticOrder S_; S_.init(M, (N_), G, (int)blockIdx.x); \
        pg8::gemm_phase<EPI, pg8::StaticOrder, true, true>(lds, g_, S_, (E_)); } while (0)

__global__ void __launch_bounds__(NWAVES * 64, 2) fwd_kernel(Args args) {
    extern __shared__ __attribute__((aligned(16))) unsigned char lds_raw[];
    LAS unsigned char* lds = (LAS unsigned char*)lds_raw;
    volatile LAS unsigned* MISC = (volatile LAS unsigned*)(lds + MISC_OFF);
    const int tid0 = threadIdx.x, wave = __builtin_amdgcn_readfirstlane(tid0 >> 6);
#define TID() ({ int t_ = threadIdx.x; asm volatile("" : "+v"(t_)); t_; })
#define LANE() (TID() & 63)
#define GT() ((size_t)bx * (NWAVES * 64) + TID())
    const int G = gridDim.x, bx = blockIdx.x, vcu = (G % 8 == 0) ? (bx % 8) * (G / 8) + bx / 8 : bx;
    const int gw = vcu * NWAVES + wave, NGW = G * NWAVES; const size_t NT = (size_t)G * NWAVES * 64;
#define WSP(T_, off_) ((T_*)(wsb() + (off_)))
#define INP(k_) inb(k_)
    auto wsb = [&]() __attribute__((always_inline)) { unsigned char* w_ = args.ws; asm volatile("" : "+s"(w_)); return w_; };
    auto inb = [&](int k_) __attribute__((always_inline)) { const float* p_ = args.in[k_]; asm volatile("" : "+s"(p_)); return p_; };
    auto outb = [&]() __attribute__((always_inline)) { float* p_ = args.out; asm volatile("" : "+s"(p_)); return p_; };

    for (int u = tid0; u < (LDS_BYTES - LDSCTL_OFF) / 4; u += NWAVES * 64) ((LAS unsigned*)(lds + LDSCTL_OFF))[u] = 0u;
    __syncthreads();
    XcdBarrier bar = xcd_barrier_post((unsigned*)((gu32*)(args.ws + WS_CTL) + CW_BAR), MISC + 8);
#define SCR() ((LAS float*)(lds + RING_OFF + wave * 16384))
#define SSQP() ((float*)(WSP(unsigned, WS_CTL) + CW_SSQ))

#ifndef ONLY
#define ONLY -1
#endif
#ifndef SKIPMASK
#define SKIPMASK 0
#endif
#define PH(k) ((ONLY < 0 || ONLY == (k)) && !((SKIPMASK >> (k)) & 1))
    if (PH(0)) {
    tr_matrix<1>(INP(2), DIN, nullptr, WSP(bf16, WS_WIN), 2048, NU, SCR(), gw, NGW, LANE());
    tr_matrix<2>(INP(5), 3072, INP(3), WSP(bf16, WS_WUQ), 512, 3072, SCR(), gw, NGW, LANE());
    tr_matrix<0>(INP(6), 2048, INP(4), WSP(bf16, WS_WKV), 512, 2048, SCR(), gw, NGW, LANE());
    tr_matrix<0>(INP(7), 2048, INP(4), WSP(bf16, WS_WKV) + (size_t)2048 * 512, 512, 2048, SCR(), gw, NGW, LANE());
    tr_matrix<0>(INP(19), 2048, nullptr, WSP(bf16, WS_WPE), 256, 2048, SCR(), gw, NGW, LANE());
    cvt_flat(INP(0), WSP(bf16, WS_XB), (size_t)M * DM / 8, GT(), NT);
    cvt_flat(INP(1), WSP(bf16, WS_PB), (size_t)M * PLE_DIM / 8, GT(), NT);
    { float* ROPE = WSP(float, WS_ROPE);
    for (size_t i = GT(); i < (size_t)SEQ * 32; i += NT) { const int pos = (int)(i >> 5), j = (int)(i & 31);
        const double f = exp2(-(double)j * (13.287712379549449 / 32.0)), turns = (double)pos * f * 0.15915494309189535, fr = turns - floor(turns);
        ROPE[i] = __builtin_amdgcn_cosf((float)fr); ROPE[(size_t)SEQ * 32 + i] = __builtin_amdgcn_sinf((float)fr); } }
    }
    xcd_barrier(bar);

    if (PH(1)) { EpiU E{WSP(bf16, WS_QA), WSP(bf16, WS_QI), WSP(bf16, WS_KA), WSP(bf16, WS_VA), WSP(bf16, WS_KI), WSP(bf16, WS_KR), WSP(bf16, WS_CQ), WSP(bf16, WS_CKV), WSP(float, WS_WI), SSQP(), WSP(float, WS_ROPE)};
        GEMM_PHASE(EpiU, WSP(bf16, WS_XB), WSP(bf16, WS_WIN), NU1, 2048, E); }
    xcd_barrier(bar);

    if (PH(2)) { EpiQ E{WSP(bf16, WS_QN), WSP(bf16, WS_QR), SSQP(), WSP(float, WS_ROPE)}; GEMM_PHASE(EpiQ, WSP(bf16, WS_CQ), WSP(bf16, WS_WUQ), 3072, 512, E); }
    if (PH(2)) { EpiKV E{WSP(bf16, WS_KN), WSP(bf16, WS_VB), SSQP() + M}; GEMM_PHASE(EpiKV, WSP(bf16, WS_CKV), WSP(bf16, WS_WKV), 4096, 512, E); }
    if (PH(3)) { const dsa::Ptrs P{WSP(bf16, WS_QI), WSP(bf16, WS_KI), WSP(bf16, WS_KA), WSP(bf16, WS_VA), WSP(float, WS_WI), WSP(bf16, WS_QA)};
      LAS unsigned char* wl = lds + RING_OFF + wave * 16384; LAS dsa::u16* idl = (LAS dsa::u16*)(lds + IDL_OFF + wave * 2048);
      const int TA = vcu * NWAVES + wave;
#pragma unroll 1
      for (int jb = 0; jb < 2; ++jb) dsa::job(P, jb, jb == 0 ? 4 * TA : 4 * (2047 - TA), wl, idl, LANE()); }
    xcd_barrier(bar);

    if (PH(4)) { const mla::Tensors T{WSP(bf16, WS_QN), WSP(bf16, WS_QR), WSP(bf16, WS_KN), WSP(bf16, WS_KR), WSP(bf16, WS_VB)};
#pragma unroll 1
      for (int it = vcu; it < 512; it += G) { const int bh = it >> 4, xq = it & 15;
#pragma unroll 1
          for (int ps = 0; ps < 2; ++ps) mla::unit(T, bh >> 4, bh & 15, ps ? 31 - xq : xq, lds + RING_OFF); } }
    xcd_barrier(bar);

    if (PH(5)) { EpiB<1> E{WSP(bf16, WS_G), 4096, nullptr, nullptr}; GEMM_PHASE(EpiB<1>, WSP(bf16, WS_XB), WSP(bf16, WS_WIN) + (size_t)NU1 * 2048, 4096, 2048, E); }
    if (PH(6)) {
    tr_matrix<0>(INP(8), 2048, nullptr, WSP(bf16, WS_WA), 2048, 2048, SCR(), gw, NGW, LANE());
    tr_matrix<0>(INP(9), 2048, nullptr, WSP(bf16, WS_WB), 2048, 2048, SCR(), gw, NGW, LANE());
    tr_matrix<0>(INP(10), 2048, nullptr, WSP(bf16, WS_WO), 2048, 2048, SCR(), gw, NGW, LANE());
    tr_matrix<0>(INP(17), 2048, nullptr, WSP(bf16, WS_WPG), 2048, 2048, SCR(), gw, NGW, LANE());
    tr_matrix<3>(INP(13), NUP, nullptr, WSP(bf16, WS_WUP), 2048, NUP, SCR(), gw, NGW, LANE());
    tr_matrix<0>(INP(16), 2048, nullptr, WSP(bf16, WS_WDN), DFF, 2048, SCR(), gw, NGW, LANE());
    }
    xcd_barrier(bar);

    if (PH(7)) { EpiB<2> E{WSP(bf16, WS_MT), 2048, WSP(bf16, WS_G), nullptr}; GEMM_PHASE(EpiB<2>, WSP(bf16, WS_QA), WSP(bf16, WS_WA), 2048, 2048, E); }
    if (PH(7)) { EpiB<3> E{WSP(bf16, WS_MT), 2048, WSP(bf16, WS_G) + 2048, nullptr}; GEMM_PHASE(EpiB<3>, WSP(bf16, WS_QN), WSP(bf16, WS_WB), 2048, 2048, E); }
    xcd_barrier(bar);

    if (PH(8)) { EpiF<0> E{outb(), INP(0), nullptr}; GEMM_PHASE(EpiF<0>, WSP(bf16, WS_MT), WSP(bf16, WS_WO), 2048, 2048, E); }
    xcd_barrier(bar);
    if (PH(9)) { float* o_ = outb(); ln_pass(o_, o_, WSP(bf16, WS_X1B), INP(11), INP(12), gw, NGW, LANE()); }
    xcd_barrier(bar);

    if (PH(10)) { EpiUp E{WSP(bf16, WS_ACT), WSP(float, WS_HEAD), WSP(float, WS_TAIL), INP(14), INP(15)}; GEMM_PHASE(EpiUp, WSP(bf16, WS_X1B), WSP(bf16, WS_WUP), NUP, 2048, E); }
    xcd_barrier(bar);

    if (PH(11)) conv_fixup(WSP(bf16, WS_ACT), WSP(float, WS_HEAD), WSP(float, WS_TAIL), INP(14), INP(15), GT(), NT);
    if (PH(12)) { EpiB<0> E{WSP(bf16, WS_PEO), 2048, nullptr, nullptr}; GEMM_PHASE(EpiB<0>, WSP(bf16, WS_PB), WSP(bf16, WS_WPE), 2048, 256, E); }
    if (PH(15)) { EpiB<4> E{WSP(bf16, WS_PEO), 2048, nullptr, INP(18)}; GEMM_PHASE(EpiB<4>, WSP(bf16, WS_X1B), WSP(bf16, WS_WPG), 2048, 2048, E); }
    xcd_barrier(bar);

    if (PH(13)) { EpiF<1> E{outb(), nullptr, WSP(bf16, WS_PEO)}; GEMM_PHASE(EpiF<1>, WSP(bf16, WS_ACT), WSP(bf16, WS_WDN), 2048, DFF, E); }
    xcd_barrier(bar);
    if (PH(14)) { float* o_ = outb(); ln_pass(o_, o_, nullptr, INP(20), INP(21), gw, NGW, LANE()); }
}

extern "C" void kernel_launch(void* const* d_in, const int* in_sizes, int n_in, void* d_out, int out_size, void* d_ws, size_t ws_size, hipStream_t stream) {
    static int grid = 0;
    if (grid == 0) {
        if (n_in != 22 || in_sizes[0] != M * DM || out_size != M * DM || ws_size < WS_END) { fprintf(stderr, "kernel_launch: unexpected shapes (n_in %d, in0 %d, out %d, ws %zu); nothing launched\n", n_in, n_in > 0 ? in_sizes[0] : -1, out_size, ws_size); grid = -1; return; }
        int dev = 0, cus = 0, per_cu = 0;
        if (hipGetDevice(&dev) != hipSuccess || hipDeviceGetAttribute(&cus, hipDeviceAttributeMultiprocessorCount, dev) != hipSuccess) { grid = -1; return; }
        if (hipFuncSetAttribute((const void*)fwd_kernel, hipFuncAttributeMaxDynamicSharedMemorySize, LDS_BYTES) != hipSuccess) { fprintf(stderr, "kernel_launch: hipFuncSetAttribute failed\n"); grid = -1; return; }
        if (hipOccupancyMaxActiveBlocksPerMultiprocessor(&per_cu, (const void*)fwd_kernel, NWAVES * 64, LDS_BYTES) != hipSuccess || per_cu < 1) { fprintf(stderr, "kernel_launch: occupancy query reports %d workgroups per CU\n", per_cu); }
        (void)hipGetLastError();
        grid = cus;
    }
    if (grid < 0) return;
    if (hipMemsetAsync((char*)d_ws + WS_CTL, 0, CTL_ZERO_BYTES, stream) != hipSuccess) return;
    Args a{};
    for (int i = 0; i < 22; ++i) a.in[i] = (const float*)d_in[i];
    a.out = (float*)d_out; a.ws = (unsigned char*)d_ws;
    hipLaunchKernelGGL(fwd_kernel, dim3(grid), dim3(NWAVES * 64), LDS_BYTES, stream, a);
}
```

```cpp
#include <hip/hip_runtime.h>
#include <cstdio>
#include <cstdint>
namespace pg8 {
#define PG8_LAS __attribute__((address_space(3)))
typedef unsigned short bf16_t;
typedef short bf16x8 __attribute__((ext_vector_type(8)));
typedef float f32x4 __attribute__((ext_vector_type(4)));
typedef unsigned u32x4 __attribute__((ext_vector_type(4)));
constexpr int BM = 256, BK = 64, HALF = 128, HTB = HALF * BK * 2  , STAGE_BYTES = 8 * HTB, NXCD = 8, WGM = 8;

__host__ __device__ __forceinline__ int lds_byte(int r, int c) { const int st = (r >> 4) * 2 + (c >> 5), rr = r & 15, cc = c & 31, ob = rr * 64 + cc * 2; return st * 1024 + (ob ^ (((ob >> 9) & 1) << 5)); }
__host__ __device__ __forceinline__ void stage_rc(int b, int& R, int& C) { const int st = b / 1024, sb = b % 1024, swz = sb ^ (((sb >> 9) & 1) << 5); R = (st >> 1) * 16 + swz / 64; C = (st & 1) * 32 + (swz % 64) / 2; }
__host__ __device__ __forceinline__ int perm32(int rho) { const int n = rho >> 4, i = rho & 15; return 8 * (i >> 2) + 4 * n + (i & 3); }

struct Unit { int pm, pn; };
struct Gemm { const bf16_t* A; const bf16_t* Bt; int M, N, K; int wscale; int lda; };
typedef int i32x4 __attribute__((ext_vector_type(4))); typedef int i32x8 __attribute__((ext_vector_type(8)));
typedef _Float16 f16x8 __attribute__((ext_vector_type(8)));

struct StaticOrder {
    int nM, nN, nwg, G, c;
    __host__ __device__ void init(int M, int N, int G_, int c_) { nM = M / BM; nN = N / BM; nwg = nM * nN; G = G_; c = c_; }
    __host__ __device__ bool next(int i, Unit& u) const {
        const long L = (long)i * G + c; if (L >= nwg) return false;
        int wgid = (int)L; { const int q = nwg / NXCD, r = nwg % NXCD, xcd = wgid % NXCD, off = wgid / NXCD; wgid = (xcd < r ? xcd * (q + 1) : r * (q + 1) + (xcd - r) * q) + off; }
        const int nig = WGM * nN, gid = wgid / nig, fm = gid * WGM, gsz = (nM - fm) < WGM ? (nM - fm) : WGM;
        u.pm = fm + ((wgid % nig) % gsz); u.pn = (wgid % nig) / gsz;
        { const int x = u.pm >> 3, s = u.pm & 7; u.pm = s < 4 ? x + 8 * s : 32 + (7 - x) + 8 * (s - 4); }
        return true;
    }
    __device__ __forceinline__ void a_ready(const Unit&) const {}
    __device__ __forceinline__ void done(const Unit&) const {}
};

typedef float f32x2c_t __attribute__((ext_vector_type(2))); typedef __bf16 bf16x2c_t __attribute__((ext_vector_type(2)));
__device__ __forceinline__ unsigned cvt_pk_bf16(float lo, float hi) { const f32x2c_t v = {lo, hi}; const bf16x2c_t b = __builtin_convertvector(v, bf16x2c_t); return __builtin_bit_cast(unsigned, b); }
typedef float f32x2 __attribute__((ext_vector_type(2)));
template <class Epi, class Sched, bool ALIGN_EPI = false, bool SP2 = false, int DT = 0  >
__device__ __forceinline__ void gemm_phase(PG8_LAS unsigned char* lds, const Gemm g, const Sched& S, const Epi& E) {
    int tid_o_ = threadIdx.x; asm volatile("" : "+v"(tid_o_));
    const int tid = tid_o_, wid = __builtin_amdgcn_readfirstlane(tid >> 6), lane = tid & 63, wr = wid >> 2, wc = wid & 3, fr = lane & 15, fq = lane >> 4;
    const int K = g.K, nt = K / BK, lda = g.lda ? g.lda : g.K;
    unsigned voffA[2], voffB[2];
#pragma unroll
    for (int i = 0; i < 2; ++i) { int R, C; stage_rc(tid * 16 + i * 8192, R, C); const int Rb = Epi::PERM ? ((R & ~31) + perm32(R & 31)) : R;
        voffA[i] = (unsigned)(R * lda + C) * 2u; voffB[i] = (unsigned)(Rb * K + C) * 2u; }
    const size_t kstep = (size_t)(BK * 2);
    const size_t hstep = (size_t)HALF * K * 2;
    const size_t tstep = 2 * hstep;
    const size_t hstepA = (size_t)HALF * lda * 2, tstepA = 2 * hstepA;
    const unsigned ldsw = (unsigned)wid * 1024u;
    const int aoff = lds_byte(wr * 64 + fr, fq * 8), boff = lds_byte(wc * 32 + fr, fq * 8);
#define PG8_SA(b, h) (((b) * 2 + (h)) * HTB)
#define PG8_SB(b, h) ((4 + (b) * 2 + (h)) * HTB)
#define PG8_STAGE(bufoff, gbase, voff) do { _Pragma("unroll") for (int _i = 0; _i < 2; ++_i) \
        __builtin_amdgcn_global_load_lds((const unsigned*)((const char*)(gbase) + (voff)[_i]), (PG8_LAS unsigned*)(lds + (bufoff) + ldsw + _i * 8192), 16, 0, 0); } while (0)
#define PG8_LD16A(off_) (*(const PG8_LAS i32x4*)(abase8 + (off_)))
#define PG8_LD16B(off_) (*(const PG8_LAS i32x4*)(bbase8 + ((off_) - 65536)))
#define PG8_LDA(dst, b, h) do { if constexpr (DT == 2) { _Pragma("unroll") for (int m = 0; m < 4; ++m) dst##8[m] = __builtin_shufflevector(PG8_LD16A(PG8_SA(b, h) + m * 2048), PG8_LD16A(PG8_SA(b, h) + m * 2048 + 1024), 0, 1, 2, 3, 4, 5, 6, 7); } \
        else { _Pragma("unroll") for (int m = 0; m < 4; ++m) _Pragma("unroll") for (int k = 0; k < 2; ++k) dst[m][k] = *(const PG8_LAS bf16x8*)(lds + PG8_SA(b, h) + aoff + m * 2048 + k * 1024); } } while (0)
#define PG8_LDB(dst, b, h) do { if constexpr (DT == 2) { _Pragma("unroll") for (int n = 0; n < 2; ++n) dst##8[n] = __builtin_shufflevector(PG8_LD16B(PG8_SB(b, h) + n * 2048), PG8_LD16B(PG8_SB(b, h) + n * 2048 + 1024), 0, 1, 2, 3, 4, 5, 6, 7); } \
        else { _Pragma("unroll") for (int n = 0; n < 2; ++n) _Pragma("unroll") for (int k = 0; k < 2; ++k) dst[n][k] = *(const PG8_LAS bf16x8*)(lds + PG8_SB(b, h) + boff + n * 2048 + k * 1024); } } while (0)
#define PG8_MMA(ai, bj, At, Bt) do { __builtin_amdgcn_s_setprio(1); _Pragma("unroll") for (int m = 0; m < 4; ++m) _Pragma("unroll") for (int n = 0; n < 2; ++n) { \
        if constexpr (DT == 2) asm volatile("v_mfma_scale_f32_16x16x128_f8f6f4 %0, %1, %2, %0, %3, %4 op_sel_hi:[0,0,0]" : "+v"(acc[ai][bj][m][n]) : "v"(Bt##8[n]), "v"(At##8[m]), "v"(sclw), "v"(scla));   \
        else { _Pragma("unroll") for (int k = 0; k < 2; ++k) { \
        if constexpr (DT == 1) acc[ai][bj][m][n] = __builtin_amdgcn_mfma_f32_16x16x32_f16(__builtin_bit_cast(f16x8, Bt[n][k]), __builtin_bit_cast(f16x8, At[m][k]), acc[ai][bj][m][n], 0, 0, 0); \
        else acc[ai][bj][m][n] = __builtin_amdgcn_mfma_f32_16x16x32_bf16(Bt[n][k], At[m][k], acc[ai][bj][m][n], 0, 0, 0); } } } __builtin_amdgcn_s_setprio(0); } while (0)
#define PG8_WAIT_V(n) asm volatile("s_waitcnt vmcnt(" #n ")" ::: "memory")
#define PG8_WAIT_L(n) asm volatile("s_waitcnt lgkmcnt(" #n ")" ::: "memory")
#define PG8_BAR __builtin_amdgcn_s_barrier()
#define PG8_SCHED __builtin_amdgcn_sched_barrier(0)
    Unit cur, nxt; int ui = 0;
    if (!S.next(0, cur)) return;
    f32x4 acc[2][2][4][2];
#pragma unroll
    for (int a = 0; a < 2; ++a)
#pragma unroll
        for (int b = 0; b < 2; ++b)
#pragma unroll
            for (int m = 0; m < 4; ++m)
#pragma unroll
                for (int n = 0; n < 2; ++n) acc[a][b][m][n] = (f32x4){0.f, 0.f, 0.f, 0.f};
    const int sclw = g.wscale, scla = 127;
    unsigned abi_ = (unsigned)(uintptr_t)lds + (unsigned)aoff, bbi_ = (unsigned)(uintptr_t)lds + 65536u + (unsigned)boff; asm volatile("" : "+v"(abi_), "+v"(bbi_));
    const PG8_LAS unsigned char* abase8 = (const PG8_LAS unsigned char*)(uintptr_t)abi_; const PG8_LAS unsigned char* bbase8 = (const PG8_LAS unsigned char*)(uintptr_t)bbi_;
    bf16x8 At[4][2], B0[2][2], B1[2][2]; i32x8 At8[4], B08[2], B18[2];
    const char* cA = (const char*)g.A + (size_t)cur.pm * tstepA; const char* cB = (const char*)g.Bt + (size_t)cur.pn * tstep;
    S.a_ready(cur);
    if constexpr (SP2) {
        PG8_STAGE(PG8_SB(0, 0), cB, voffB); PG8_STAGE(PG8_SB(0, 1), cB + hstep, voffB); PG8_STAGE(PG8_SA(0, 0), cA, voffA); PG8_STAGE(PG8_SA(0, 1), cA + hstepA, voffA);
        if (wr == 1) PG8_BAR;
        PG8_WAIT_V(2); PG8_BAR;
        PG8_STAGE(PG8_SB(1, 0), cB + kstep, voffB); PG8_STAGE(PG8_SA(1, 0), cA + kstep, voffA); PG8_STAGE(PG8_SB(1, 1), cB + hstep + kstep, voffB);
        PG8_WAIT_V(6); PG8_BAR;
    } else {
        PG8_STAGE(PG8_SB(0, 0), cB, voffB); PG8_STAGE(PG8_SA(0, 0), cA, voffA); PG8_STAGE(PG8_SB(0, 1), cB + hstep, voffB); PG8_STAGE(PG8_SA(0, 1), cA + hstepA, voffA);
        if (wr == 1) PG8_BAR;
        PG8_WAIT_V(4); PG8_BAR;
        PG8_STAGE(PG8_SB(1, 0), cB + kstep, voffB); PG8_STAGE(PG8_SA(1, 0), cA + kstep, voffA); PG8_STAGE(PG8_SB(1, 1), cB + hstep + kstep, voffB);
        PG8_WAIT_V(6); PG8_BAR;
    }
    for (;;) {
        const bool has_next = S.next(ui + 1, nxt);
        const char* nA = has_next ? (const char*)g.A + (size_t)nxt.pm * tstepA : cA; const char* nB = has_next ? (const char*)g.Bt + (size_t)nxt.pn * tstep : cB;
        for (int t = 0; t < nt; t += 2) {
            const bool last = (t == nt - 2);
            const char* a1 = cA + (size_t)(t + 1) * kstep;
            const char* a2 = last ? nA : cA + (size_t)(t + 2) * kstep; const char* b2 = last ? nB : cB + (size_t)(t + 2) * kstep;
            const char* a3 = a2 + kstep; const char* b3 = b2 + kstep;
            if (last && has_next) S.a_ready(nxt);
            if constexpr (SP2) {
            PG8_LDB(B0, 0, 0); PG8_LDB(B1, 0, 1); PG8_SCHED; PG8_LDA(At, 0, 0); PG8_STAGE(PG8_SA(1, 1), a1 + hstepA, voffA);
            PG8_WAIT_V(8); PG8_WAIT_L(0); PG8_BAR; PG8_MMA(0, 0, At, B0); PG8_MMA(0, 1, At, B1); PG8_BAR; PG8_SCHED;
            PG8_LDA(At, 0, 1); PG8_STAGE(PG8_SB(0, 0), b2, voffB); PG8_STAGE(PG8_SB(0, 1), b2 + hstep, voffB); PG8_STAGE(PG8_SA(0, 0), a2, voffA);
            PG8_WAIT_V(8); PG8_WAIT_L(0); PG8_BAR; PG8_MMA(1, 0, At, B0); PG8_MMA(1, 1, At, B1); PG8_BAR; PG8_SCHED;
            PG8_LDB(B0, 1, 0); PG8_LDB(B1, 1, 1); PG8_SCHED; PG8_LDA(At, 1, 0); PG8_STAGE(PG8_SA(0, 1), a2 + hstepA, voffA);
            PG8_WAIT_V(8); PG8_WAIT_L(0); PG8_BAR; PG8_MMA(0, 0, At, B0); PG8_MMA(0, 1, At, B1); PG8_BAR; PG8_SCHED;
            PG8_LDA(At, 1, 1); PG8_STAGE(PG8_SB(1, 0), b3, voffB); PG8_STAGE(PG8_SB(1, 1), b3 + hstep, voffB); PG8_STAGE(PG8_SA(1, 0), a3, voffA);
            PG8_WAIT_V(8); PG8_WAIT_L(0); PG8_BAR; PG8_MMA(1, 0, At, B0); PG8_MMA(1, 1, At, B1); PG8_BAR; PG8_SCHED;
            } else {
            PG8_LDB(B0, 0, 0); PG8_SCHED; PG8_LDA(At, 0, 0); PG8_STAGE(PG8_SA(1, 1), a1 + hstepA, voffA);
            PG8_WAIT_L(8); PG8_BAR; PG8_WAIT_L(0); PG8_MMA(0, 0, At, B0); PG8_BAR; PG8_SCHED;
            PG8_LDB(B1, 0, 1); PG8_STAGE(PG8_SB(0, 0), b2, voffB);
            PG8_BAR; PG8_WAIT_L(0); PG8_MMA(0, 1, At, B1); PG8_BAR;
            PG8_LDA(At, 0, 1); PG8_STAGE(PG8_SA(0, 0), a2, voffA);
            PG8_BAR; PG8_WAIT_L(0); PG8_MMA(1, 0, At, B0); PG8_BAR; PG8_SCHED;
            PG8_STAGE(PG8_SB(0, 1), b2 + hstep, voffB);
            PG8_WAIT_V(6); PG8_BAR; PG8_MMA(1, 1, At, B1); PG8_BAR;
            PG8_LDB(B0, 1, 0); PG8_SCHED; PG8_LDA(At, 1, 0); PG8_STAGE(PG8_SA(0, 1), a2 + hstepA, voffA);
            PG8_WAIT_L(8); PG8_BAR; PG8_WAIT_L(0); PG8_MMA(0, 0, At, B0); PG8_BAR; PG8_SCHED;
            PG8_LDB(B1, 1, 1); PG8_STAGE(PG8_SB(1, 0), b3, voffB);
            PG8_BAR; PG8_WAIT_L(0); PG8_MMA(0, 1, At, B1); PG8_BAR;
            PG8_LDA(At, 1, 1); PG8_STAGE(PG8_SA(1, 0), a3, voffA);
            PG8_BAR; PG8_WAIT_L(0); PG8_MMA(1, 0, At, B0); PG8_BAR; PG8_SCHED;
            PG8_STAGE(PG8_SB(1, 1), b3 + hstep, voffB);
            PG8_WAIT_V(6); PG8_BAR; PG8_MMA(1, 1, At, B1); PG8_BAR;
            }
        }
        if constexpr (ALIGN_EPI) { if (wr == 0) PG8_BAR; }
        if constexpr (!Epi::AFTER_DRAIN) { E(acc, cur, wr, wc, fr, fq); S.done(cur); }
        if (!has_next) break;
#pragma unroll
        for (int a = 0; a < 2; ++a)
#pragma unroll
            for (int b = 0; b < 2; ++b)
#pragma unroll
                for (int m = 0; m < 4; ++m)
#pragma unroll
                    for (int n = 0; n < 2; ++n) acc[a][b][m][n] = (f32x4){0.f, 0.f, 0.f, 0.f};
        cur = nxt; cA = nA; cB = nB; ++ui;
        if constexpr (ALIGN_EPI) { if (wr == 1) PG8_BAR; }
    }
    PG8_WAIT_V(0);
    if constexpr (!ALIGN_EPI) { if (wr == 0) PG8_BAR; }
    PG8_BAR;
    if constexpr (Epi::AFTER_DRAIN) { E.fused(acc, cur, wr, wc, fr, fq, lds, wid, lane); S.done(cur); }
#undef PG8_SA
#undef PG8_SB
#undef PG8_STAGE
#undef PG8_LDA
#undef PG8_LD16A
#undef PG8_LD16B
#undef PG8_LDB
#undef PG8_MMA
#undef PG8_WAIT_V
#undef PG8_WAIT_L
#undef PG8_BAR
#undef PG8_SCHED
}
}

constexpr int NWAVES = 8;
constexpr int BATCH = 2, SEQ = 8192, DM = 2048, M = BATCH * SEQ;
constexpr int DIN = 8592, NU = 8704, NU1 = 4608;
constexpr int DFF = 5632, NUP = 2 * DFF, PLE_DIM = 256;
constexpr float LN_EPS = 1e-5f, RMS_EPS = 1e-6f;
constexpr float ALPHA = 1.189207115002721f;
constexpr float LOG2E = 1.4426950408889634f;
constexpr float QA_SCALE = 0.08838834764831845f * LOG2E;
constexpr float QB_SCALE = 0.07216878364870323f * LOG2E;
constexpr int U_QA = 0, U_KA = 2048, U_VA = 2176, U_QI = 2304, U_KI = 3328, U_WI = 3392, U_CQ = 3408, U_CKV = 3920, U_KPE = 4432, U_G = 4496;

constexpr size_t MiB = 1u << 20;
constexpr size_t WS_CTL = 0, CTL_ZERO_BYTES = 1 * MiB;
constexpr size_t WS_ROPE = 2 * MiB;
constexpr size_t WS_WIN = 4 * MiB;
constexpr size_t WS_WIN8 = 12 * MiB;
constexpr int NU16 = 1280, NU8 = 3328;
constexpr size_t WS_WUQ = 38 * MiB;
constexpr size_t WS_WKV = 41 * MiB;
constexpr size_t WS_WPE = 45 * MiB;
constexpr size_t WS_PB = 46 * MiB;
constexpr size_t WS_XB = 54 * MiB;
constexpr size_t WS_QA = 118 * MiB;
constexpr size_t WS_WUP = 182 * MiB, WS_WDN = 204 * MiB, WS_WPG = 215 * MiB;
constexpr size_t WS_WA = 223 * MiB, WS_WB = 227 * MiB, WS_WO = 231 * MiB, WS_WG = 235 * MiB;
constexpr size_t WS_QN = 260 * MiB;
constexpr size_t WS_XF8 = 324 * MiB;
constexpr size_t WS_MG8 = 292 * MiB;
constexpr size_t WS_KN = 356 * MiB, WS_VB = 420 * MiB;
constexpr size_t WS_G = 356 * MiB;
constexpr size_t WS_MT = WS_XB, WS_X1B = WS_QA, WS_PEO = WS_XB;
constexpr size_t WS_ACT = 320 * MiB;
constexpr size_t WS_X1F8 = 260 * MiB;
constexpr size_t WS_HEAD = 292 * MiB, WS_TAIL = 484 * MiB;
constexpr size_t DO_AB8 = 0 * MiB;
constexpr size_t DO_QI = 0 * MiB, DO_CQ = 32 * MiB, DO_CKV = 48 * MiB, DO_KA = 64 * MiB, DO_VA = 68 * MiB, DO_KI = 72 * MiB, DO_WI = 74 * MiB, DO_KR = 75 * MiB, DO_QR = 80 * MiB;
constexpr size_t WS_END = 506 * MiB;
constexpr int CW_TMO = 0, CW_CODE = 1, CW_BAR = 4096, CW_RANK = 32768, CW_JOB = 49152;
constexpr int CW_SSQ = 65536;

constexpr int RING_OFF = 0, RING_BYTES = 131072;
constexpr int IDL_OFF = 131072;
constexpr int LDSCTL_OFF = 147456, MISC_OFF = LDSCTL_OFF + 320;
constexpr int LDS_BYTES = 148480;
static_assert(MISC_OFF + 128 <= LDS_BYTES, "LDS map");
#define GAS __attribute__((address_space(1)))
#define LAS __attribute__((address_space(3)))
typedef unsigned short bf16;
typedef unsigned v4u __attribute__((ext_vector_type(4)));
typedef float f32x4 __attribute__((ext_vector_type(4)));
typedef short bf16x8 __attribute__((ext_vector_type(8)));
typedef GAS unsigned gu32;
typedef GAS unsigned long long gu64;
#define RLX_AGENT __ATOMIC_RELAXED, __HIP_MEMORY_SCOPE_AGENT
#define LDS_WAIT() asm volatile("s_waitcnt lgkmcnt(0)" ::: "memory")
#define VM_WAIT() asm volatile("s_waitcnt vmcnt(0)" ::: "memory")
__device__ __forceinline__ unsigned long long rt() { return __builtin_amdgcn_s_memrealtime(); }
__device__ __forceinline__ unsigned f2bf(float f) { unsigned u = __builtin_bit_cast(unsigned, f); return (u + 0x7fffu + ((u >> 16) & 1u)) >> 16; }
__device__ __forceinline__ unsigned pk2(float lo, float hi) { return f2bf(lo) | (f2bf(hi) << 16); }

#define XB_TMO      128
#define XB_XCNT(j)  (256  + 64 * (j))
#define XB_XSUB(j)  (1280 + 64 * (j))
#define XB_XGEN(j)  (2304 + 64 * (j))
#define XB_TOP      3328
#define XB_TOPGEN   3392
#define XCD_BAR_WORDS 3456
#define XB_SPIN_CAP (1u << 18)

__device__ __forceinline__ unsigned xb_ld(unsigned* p)              { return __hip_atomic_load(p, __ATOMIC_RELAXED, __HIP_MEMORY_SCOPE_AGENT); }
__device__ __forceinline__ unsigned xb_add(unsigned* p, unsigned v) { return __hip_atomic_fetch_add(p, v, __ATOMIC_RELAXED, __HIP_MEMORY_SCOPE_AGENT); }
__device__ __forceinline__ unsigned xb_xcc_id() { return (unsigned)__builtin_amdgcn_s_getreg((3 << 11) | 20) & 0xFu; }
#define XB_SPIN(cond, bar) do { unsigned _sp = 0; while (cond) { __builtin_amdgcn_s_sleep(1); \
    if ((++_sp & 255u) == 0u) { if (xb_ld(&(bar)[XB_TMO])) break; if (_sp > XB_SPIN_CAP) { atomicAdd(&(bar)[XB_TMO], 1u); break; } } } } while (0)

struct XcdBarrier {
    unsigned* bar; unsigned x;
    volatile LAS unsigned* st;
};

__device__ __forceinline__ XcdBarrier xcd_barrier_post(unsigned* bar, volatile LAS unsigned* st) {
    XcdBarrier b; b.bar = bar; b.x = xb_xcc_id(); b.st = st;
    if (threadIdx.x == 0) (void)xb_add(&bar[XB_XCNT(b.x)], 1u);
    return b;
}
__device__ __forceinline__ void xcd_barrier_complete(unsigned* bar, unsigned x, unsigned& nloc, unsigned& nx) {
    const unsigned G = gridDim.x * gridDim.y * gridDim.z;
    unsigned sum, cnt, mine, sp = 0u;
    for (;;) {
        sum = 0u; cnt = 0u; mine = 0u;
#pragma unroll
        for (unsigned j = 0; j < 16; ++j) { const unsigned c = xb_ld(&bar[XB_XCNT(j)]); sum += c; cnt += (c > 0u) ? 1u : 0u; mine = (j == x) ? c : mine; }
        if (sum == G) break;
        __builtin_amdgcn_s_sleep(1);
        if ((++sp & 255u) == 0u) { if (xb_ld(&bar[XB_TMO])) break; if (sp > XB_SPIN_CAP) { atomicAdd(&bar[XB_TMO], 1u); break; } }
    }
    nloc = mine > 0u ? mine : 1u; nx = cnt > 0u ? cnt : 1u;
}

__device__ __forceinline__ void xcd_barrier(const XcdBarrier& b) {
    asm volatile("s_waitcnt vmcnt(0)" ::: "memory");
    __syncthreads();
    if (threadIdx.x == 0) {
        unsigned* bar = b.bar;
        __builtin_amdgcn_s_waitcnt(0);
        unsigned nloc = b.st[0], nx = b.st[1];
        if (nloc == 0u) { xcd_barrier_complete(bar, b.x, nloc, nx); b.st[0] = nloc; b.st[1] = nx; }
        const unsigned old = xb_add(&bar[XB_XSUB(b.x)], 1u);
        const unsigned gen = old / nloc;
        if (old + 1u == (gen + 1u) * nloc) {
            __builtin_amdgcn_fence(__ATOMIC_RELEASE, "agent");
            asm volatile("s_waitcnt vmcnt(0)" ::: "memory");
            const unsigned og = xb_add(&bar[XB_TOP], 1u);
            const unsigned tg = og / nx;
            if (og + 1u == (tg + 1u) * nx) xb_add(&bar[XB_TOPGEN], 1u);
            else XB_SPIN(xb_ld(&bar[XB_TOPGEN]) == tg, bar);
            __builtin_amdgcn_fence(__ATOMIC_ACQUIRE, "agent");
            xb_add(&bar[XB_XGEN(b.x)], 1u);
            asm volatile("s_waitcnt vmcnt(0)" ::: "memory");
        } else {
            XB_SPIN(xb_ld(&bar[XB_XGEN(b.x)]) == gen, bar);
            __builtin_amdgcn_fence(__ATOMIC_ACQUIRE, "agent");
            asm volatile("s_waitcnt vmcnt(0)" ::: "memory");
        }
    }
    __syncthreads();
}

typedef unsigned u32x2 __attribute__((ext_vector_type(2)));
typedef float f32x16 __attribute__((ext_vector_type(16)));
typedef short s16x4 __attribute__((ext_vector_type(4)));
using pg8::cvt_pk_bf16;
__device__ __forceinline__ v4u pack8(f32x4 a, f32x4 b) { v4u w; w.x = cvt_pk_bf16(a[0], a[1]); w.y = cvt_pk_bf16(a[2], a[3]); w.z = cvt_pk_bf16(b[0], b[1]); w.w = cvt_pk_bf16(b[2], b[3]); return w; }
__device__ __forceinline__ u32x2 pack4(f32x4 a) { u32x2 w; w.x = cvt_pk_bf16(a[0], a[1]); w.y = cvt_pk_bf16(a[2], a[3]); return w; }
__device__ __forceinline__ float bflo(unsigned u) { return __uint_as_float(u << 16); }
__device__ __forceinline__ float bfhi(unsigned u) { return __uint_as_float(u & 0xffff0000u); }
__device__ __forceinline__ void unpack8(v4u w, f32x4& a, f32x4& b) { a = (f32x4){bflo(w.x), bfhi(w.x), bflo(w.y), bfhi(w.y)}; b = (f32x4){bflo(w.z), bfhi(w.z), bflo(w.w), bfhi(w.w)}; }
typedef _Float16 f16x2 __attribute__((ext_vector_type(2)));
using pg8::f16x8;
__device__ __forceinline__ unsigned pkh(float a, float b) { const f16x2 v = {(_Float16)a, (_Float16)b}; return __builtin_bit_cast(unsigned, v); }
__device__ __forceinline__ v4u pack8h(f32x4 a, f32x4 b) { v4u w; w.x = pkh(a[0], a[1]); w.y = pkh(a[2], a[3]); w.z = pkh(b[0], b[1]); w.w = pkh(b[2], b[3]); return w; }
__device__ __forceinline__ void unpack8h(v4u w, f32x4& a, f32x4& b) { const f16x8 h = __builtin_bit_cast(f16x8, w); a = (f32x4){(float)h[0], (float)h[1], (float)h[2], (float)h[3]}; b = (f32x4){(float)h[4], (float)h[5], (float)h[6], (float)h[7]}; }
__device__ __forceinline__ unsigned pkf8(float a, float b, float c, float d) { int w = 0; w = __builtin_amdgcn_cvt_pk_fp8_f32(a, b, w, false); w = __builtin_amdgcn_cvt_pk_fp8_f32(c, d, w, true); return (unsigned)w; }
__device__ __forceinline__ float sigmoidf_(float x) { return __builtin_amdgcn_rcpf(1.0f + __builtin_amdgcn_exp2f(-LOG2E * x)); }
__device__ __forceinline__ f32x4 sigmoid4(f32x4 x) { return (f32x4){sigmoidf_(x[0]), sigmoidf_(x[1]), sigmoidf_(x[2]), sigmoidf_(x[3])}; }
__device__ __forceinline__ float sum_x16(float v) { auto r = __builtin_amdgcn_permlane16_swap(__float_as_uint(v), __float_as_uint(v), false, false); return __uint_as_float(r[0]) + __uint_as_float(r[1]); }
__device__ __forceinline__ float sum_x32(float v) { auto r = __builtin_amdgcn_permlane32_swap(__float_as_uint(v), __float_as_uint(v), false, false); return __uint_as_float(r[0]) + __uint_as_float(r[1]); }
__device__ __forceinline__ float max_x16(float v) { auto r = __builtin_amdgcn_permlane16_swap(__float_as_uint(v), __float_as_uint(v), false, false); return fmaxf(__uint_as_float(r[0]), __uint_as_float(r[1])); }
__device__ __forceinline__ float max_x32(float v) { auto r = __builtin_amdgcn_permlane32_swap(__float_as_uint(v), __float_as_uint(v), false, false); return fmaxf(__uint_as_float(r[0]), __uint_as_float(r[1])); }
template <int CTRL> __device__ __forceinline__ float dppf(float v) { return __int_as_float(__builtin_amdgcn_update_dpp(0, __float_as_int(v), CTRL, 0xf, 0xf, false)); }
__device__ __forceinline__ float wave_sum(float v) {
    v += dppf<0xB1>(v); v += dppf<0x4E>(v); v += dppf<0x141>(v); v += dppf<0x140>(v);
    return sum_x32(sum_x16(v));
}
__device__ __forceinline__ int rope_perm(int pc) { const int g = pc >> 3, e = pc & 7; return e < 4 ? 4 * g + e : 32 + 4 * g + (e - 4); }
template <int MAP> __device__ __forceinline__ int srcmap(int n) {
    if (MAP == 0) return n;
    if (MAP == 1) {
        if (n < 2048) return U_QA + n;
        if (n < 3072) return U_QI + (n - 2048);
        if (n < 3200) return U_KA + (n - 3072);
        if (n < 3328) return U_VA + (n - 3200);
        if (n < 3584) { const int o = n - 3328; if (o < 64) return U_KI + o; if (o < 128) return U_KPE + rope_perm(o - 64); if (o < 144) return U_WI + (o - 128); return -1; }
        if (n < 4096) return U_CQ + (n - 3584);
        if (n < 4608) return U_CKV + (n - 4096);
        return U_G + (n - 4608);
    }
    if (MAP == 2) {
        if (n < 2048) return (n >> 7) * 192 + (n & 127);
        const int o = n - 2048; return (o >> 6) * 192 + 128 + rope_perm(o & 63);
    }
    { const int pn = n >> 8, o = n & 255; return o < 128 ? pn * 128 + o : DFF + pn * 128 + (o - 128); }
}
constexpr int TR_LDS = 64 * 68 * 4;
__device__ __forceinline__ void tr_item(const float* W, int ldw, const float* gk, bf16* WT, int K, int k0, int drow0, int srccol4, LAS float* scr, int lane, bool h16) {
    const int c4 = (lane & 15) * 4;
#pragma unroll 8
    for (int i = 0; i < 16; ++i) { const int kk = 4 * i + (lane >> 4); f32x4 v = (f32x4){0.f, 0.f, 0.f, 0.f};
        if (srccol4 >= 0) { v = *(const GAS f32x4*)(W + (size_t)(k0 + kk) * ldw + srccol4); if (gk) v = v * gk[k0 + kk]; }
        *(LAS f32x4*)(scr + kk * 68 + c4) = v; }
    LDS_WAIT(); asm volatile("" ::: "memory");
    bf16* orow = WT + (size_t)(drow0 + lane) * K + k0;
#pragma unroll
    for (int k8 = 0; k8 < 8; ++k8) { const LAS float* s = scr + (8 * k8) * 68 + lane;
        v4u o; if (h16) { o.x = pkh(s[0 * 68], s[1 * 68]); o.y = pkh(s[2 * 68], s[3 * 68]); o.z = pkh(s[4 * 68], s[5 * 68]); o.w = pkh(s[6 * 68], s[7 * 68]); }
        else { o.x = pk2(s[0 * 68], s[1 * 68]); o.y = pk2(s[2 * 68], s[3 * 68]); o.z = pk2(s[4 * 68], s[5 * 68]); o.w = pk2(s[6 * 68], s[7 * 68]); }
        *(GAS v4u*)(orow + 8 * k8) = o; }
    LDS_WAIT(); asm volatile("" ::: "memory");
}
struct TrIn { const float *w_in, *gq, *gkv, *w_uq, *w_uk, *w_uv, *w_a, *w_b, *w_o, *w_up, *w_dn, *w_pg, *w_pe; };
struct TrItem { const float* W; const float* gk; bf16* WT; int ldw, K, k0, drow0, srccol4, mode; float wmul; };
constexpr int TR_E0 = 32 * 72, TR_E1 = TR_E0 + 8 * 48, TR_E2 = TR_E1 + 8 * 32, TR_E3 = TR_E2 + 8 * 32, TR_E4 = TR_E3 + 4 * 32, TR_E5 = TR_E4 + 1024, TR_E6 = TR_E5 + 1024, TR_E7 = TR_E6 + 1024, TR_E8 = TR_E7 + 1024,
              TR_E9 = TR_E8 + 32 * 176, TR_E10 = TR_E9 + 88 * 32, TR_E11 = TR_E10 + 32 * 64;
__device__ __forceinline__ TrItem tr_decode(const TrIn& I, unsigned char* ws, int it, int lane) {
    TrItem t; int r, nblk, map = 0; t.gk = nullptr; t.mode = 0; t.wmul = 1.f; int rowoff = 0;
    if (it < 32 * 20) { r = it; nblk = 20; t.W = I.w_in; t.ldw = DIN; t.WT = (bf16*)(ws + WS_WIN); t.K = 2048; map = 5; t.mode = 1; }
    else if (it < TR_E0) { r = it - 32 * 20; nblk = 52; t.W = I.w_in; t.ldw = DIN; t.WT = (bf16*)(ws + WS_WIN8); t.K = 2048; map = 6; t.mode = 2; t.wmul = 64.f; }
    else if (it < TR_E1) { r = it - TR_E0; nblk = 48; t.W = I.w_uq; t.ldw = 3072; t.WT = (bf16*)(ws + WS_WUQ); t.K = 512; map = 2; t.gk = I.gq; t.mode = 2; t.wmul = 32.f; }
    else if (it < TR_E2) { r = it - TR_E1; nblk = 32; t.W = I.w_uk; t.ldw = 2048; t.WT = (bf16*)(ws + WS_WKV); t.K = 512; t.gk = I.gkv; t.mode = 2; t.wmul = 32.f; }
    else if (it < TR_E3) { r = it - TR_E2; nblk = 32; t.W = I.w_uv; t.ldw = 2048; t.WT = (bf16*)(ws + WS_WKV); t.K = 512; t.gk = I.gkv; rowoff = 2048; t.mode = 2; t.wmul = 32.f; }
    else if (it < TR_E4) { r = it - TR_E3; nblk = 32; t.W = I.w_pe; t.ldw = 2048; t.WT = (bf16*)(ws + WS_WPE); t.K = 256; }
    else if (it < TR_E5) { r = it - TR_E4; nblk = 32; t.W = I.w_a; t.ldw = 2048; t.WT = (bf16*)(ws + WS_WA); t.K = 2048; t.mode = 2; t.wmul = 64.f; }
    else if (it < TR_E6) { r = it - TR_E5; nblk = 32; t.W = I.w_b; t.ldw = 2048; t.WT = (bf16*)(ws + WS_WB); t.K = 2048; t.mode = 2; t.wmul = 64.f; }
    else if (it < TR_E7) { r = it - TR_E6; nblk = 32; t.W = I.w_o; t.ldw = 2048; t.WT = (bf16*)(ws + WS_WO); t.K = 2048; t.mode = 2; t.wmul = 64.f; }
    else if (it < TR_E8) { r = it - TR_E7; nblk = 32; t.W = I.w_pg; t.ldw = 2048; t.WT = (bf16*)(ws + WS_WPG); t.K = 2048; t.mode = 2; t.wmul = 64.f; }
    else if (it < TR_E9) { r = it - TR_E8; nblk = 176; t.W = I.w_up; t.ldw = NUP; t.WT = (bf16*)(ws + WS_WUP); t.K = 2048; map = 3; t.mode = 2; t.wmul = 64.f; }
    else if (it < TR_E10) { r = it - TR_E9; nblk = 32; t.W = I.w_dn; t.ldw = 2048; t.WT = (bf16*)(ws + WS_WDN); t.K = DFF; t.mode = 2; t.wmul = 128.f; }
    else { r = it - TR_E10; nblk = 64; t.W = I.w_in; t.ldw = DIN; t.WT = (bf16*)(ws + WS_WG); t.K = 2048; map = 4; t.mode = 2; t.wmul = 64.f; }
    const int kb = r / nblk, nb = r - kb * nblk, n0 = nb * 64, nl = n0 + 4 * (lane & 15);
    t.k0 = kb * 64; t.drow0 = rowoff + n0; t.srccol4 = map == 0 ? nl : map == 5 ? srcmap<1>(nl < 1024 ? 2048 + nl : 2304 + nl) : map == 6 ? srcmap<1>(nl < 2048 ? nl : nl < 2304 ? 1024 + nl : 1280 + nl) : map == 2 ? srcmap<2>(nl) : map == 3 ? srcmap<3>(nl) : U_G + nl;
    return t;
}
__device__ __forceinline__ void tr_load(const TrItem& t, f32x4 (&v)[16], int lane) {
#pragma unroll
    for (int i = 0; i < 16; ++i) { const int kk = 4 * i + (lane >> 4); v[i] = (f32x4){0.f, 0.f, 0.f, 0.f};
        if (t.srccol4 >= 0) { v[i] = *(const GAS f32x4*)(t.W + (size_t)(t.k0 + kk) * t.ldw + t.srccol4); if (t.gk) v[i] = v[i] * t.gk[t.k0 + kk]; } }
}
__device__ __forceinline__ void tr_all(const TrIn& I, unsigned char* ws, LAS float* scr, int gw, int NGW, int lane) {
    int it = gw; if (it >= TR_E11) return;
    TrItem cur = tr_decode(I, ws, it, lane); f32x4 v[16]; tr_load(cur, v, lane);
    for (;;) {
        const int c4 = (lane & 15) * 4;
#pragma unroll
        for (int i = 0; i < 16; ++i) *(LAS f32x4*)(scr + (4 * i + (lane >> 4)) * 68 + c4) = v[i];
        LDS_WAIT(); asm volatile("" ::: "memory");
        const int itn = it + NGW; const bool more = itn < TR_E11; TrItem nxt = cur;
        if (more) { nxt = tr_decode(I, ws, itn, lane); tr_load(nxt, v, lane); }
        if (cur.mode == 2) { unsigned char* orow = (unsigned char*)cur.WT + (size_t)(cur.drow0 + lane) * cur.K + cur.k0; const float wm = cur.wmul;
#pragma unroll
            for (int k16 = 0; k16 < 4; ++k16) { const LAS float* s = scr + (16 * k16) * 68 + lane; v4u o;
                o.x = pkf8(s[0 * 68] * wm, s[1 * 68] * wm, s[2 * 68] * wm, s[3 * 68] * wm); o.y = pkf8(s[4 * 68] * wm, s[5 * 68] * wm, s[6 * 68] * wm, s[7 * 68] * wm);
                o.z = pkf8(s[8 * 68] * wm, s[9 * 68] * wm, s[10 * 68] * wm, s[11 * 68] * wm); o.w = pkf8(s[12 * 68] * wm, s[13 * 68] * wm, s[14 * 68] * wm, s[15 * 68] * wm);
                *(GAS v4u*)(orow + 16 * k16) = o; } }
        else { bf16* orow = cur.WT + (size_t)(cur.drow0 + lane) * cur.K + cur.k0;
#pragma unroll
        for (int k8 = 0; k8 < 8; ++k8) { const LAS float* s = scr + (8 * k8) * 68 + lane;
            v4u o; if (cur.mode == 1) { o.x = pkh(s[0 * 68], s[1 * 68]); o.y = pkh(s[2 * 68], s[3 * 68]); o.z = pkh(s[4 * 68], s[5 * 68]); o.w = pkh(s[6 * 68], s[7 * 68]); }
            else { o.x = pk2(s[0 * 68], s[1 * 68]); o.y = pk2(s[2 * 68], s[3 * 68]); o.z = pk2(s[4 * 68], s[5 * 68]); o.w = pk2(s[6 * 68], s[7 * 68]); }
            *(GAS v4u*)(orow + 8 * k8) = o; } }
        LDS_WAIT(); asm volatile("" ::: "memory");
        if (!more) break;
        cur = nxt; it = itn;
    }
}
__device__ __forceinline__ void cvt_flat_h(const float* src, bf16* dst, unsigned char* dst8, size_t n8, size_t gt, size_t NT) {
    for (size_t i = gt; i < n8; i += 4 * NT) { f32x4 a[4], b[4];
#pragma unroll
        for (int u = 0; u < 4; ++u) { a[u] = *(const GAS f32x4*)(src + (i + u * NT) * 8); b[u] = *(const GAS f32x4*)(src + (i + u * NT) * 8 + 4); }
#pragma unroll
        for (int u = 0; u < 4; ++u) { *(GAS v4u*)(dst + (i + u * NT) * 8) = pack8h(a[u], b[u]);
            u32x2 w; w.x = pkf8(a[u][0], a[u][1], a[u][2], a[u][3]); w.y = pkf8(b[u][0], b[u][1], b[u][2], b[u][3]); *(GAS u32x2*)(dst8 + (i + u * NT) * 8) = w; } }
}
__device__ __forceinline__ void cvt_flat(const float* src, bf16* dst, size_t n8, size_t gt, size_t NT) {
    for (size_t i = gt; i < n8; i += 4 * NT) { f32x4 a[4], b[4];
#pragma unroll
        for (int u = 0; u < 4; ++u) { a[u] = *(const GAS f32x4*)(src + (i + u * NT) * 8); b[u] = *(const GAS f32x4*)(src + (i + u * NT) * 8 + 4); }
#pragma unroll
        for (int u = 0; u < 4; ++u) *(GAS v4u*)(dst + (i + u * NT) * 8) = pack8(a[u], b[u]); }
}

typedef const pg8::f32x4 (&AccRef)[2][2][4][2];
using pg8::f32x2;
using pg8::Unit;
#define EPI_ROWS(ai, m) for (int ai = 0; ai < 2; ++ai) _Pragma("unroll") for (int m = 0; m < 4; ++m)

template <int PM> struct EpiU {
    static constexpr bool PERM = true, AFTER_DRAIN = false;
    bf16 *QA, *QI, *KA, *VA, *KI, *KR, *CQ, *CKV; float* WI; float* SSQ; const float* ROPE;
    __device__ __forceinline__ void operator()(AccRef acc, const Unit& u, int wr, int wc, int fr, int fq) const {
        { int t_ = threadIdx.x; asm volatile("" : "+v"(t_)); fr = t_ & 15; fq = (t_ >> 4) & 3; }
        const int pn = PM == 1 ? (u.pn < 8 ? u.pn : u.pn == 8 ? 12 : u.pn + 5) : (u.pn < 4 ? 8 + u.pn : 13), rowb = u.pm * 256 + wr * 64 + fr, cw = wc * 32 + 8 * fq;
        if (pn < 12) {
            bf16* base = pn < 8 ? QA : QI; const int ldc = pn < 8 ? 2048 : 1024, colt = (pn < 8 ? pn : pn - 8) * 256; const float sc = pn < 8 ? QA_SCALE : 1.f;
#pragma unroll
            EPI_ROWS(ai, m) { bf16* rp = base + (size_t)(rowb + ai * 128 + m * 16) * ldc + colt + cw;
#pragma unroll
                for (int bj = 0; bj < 2; ++bj) *(GAS v4u*)(rp + bj * 128) = pn < 8 ? pack8(acc[ai][bj][m][0] * sc, acc[ai][bj][m][1] * sc) : pack8h(acc[ai][bj][m][0], acc[ai][bj][m][1]); }
        } else if (pn == 12) {
#pragma unroll
            EPI_ROWS(ai, m) { const size_t row = rowb + ai * 128 + m * 16;
                *(GAS v4u*)(KA + row * 128 + cw) = pack8(acc[ai][0][m][0], acc[ai][0][m][1]);
                *(GAS v4u*)(VA + row * 128 + cw) = pack8(acc[ai][1][m][0], acc[ai][1][m][1]); }
        } else if (pn == 13) {
#pragma unroll
            EPI_ROWS(ai, m) { const size_t row = rowb + ai * 128 + m * 16; const int pos = (int)(row & (SEQ - 1));
                const f32x4 v0 = acc[ai][0][m][0], v1 = acc[ai][0][m][1];
                if (wc < 2) { *(GAS v4u*)(KI + (row & ~(size_t)31) * 64 + (2 * wc + (fq >> 1)) * 512 + ((fq & 1) * 32 + (int)(row & 31)) * 8) = pack8h(v0, v1); }
                else { const int g = 4 * (wc - 2) + fq; const f32x4 c4 = *(const GAS f32x4*)(ROPE + pos * 32 + 4 * g), s4 = *(const GAS f32x4*)(ROPE + SEQ * 32 + pos * 32 + 4 * g);
                    const f32x4 y1 = v0 * c4 - v1 * s4, y2 = v0 * s4 + v1 * c4; GAS unsigned char* kr8 = (GAS unsigned char*)KR + row * 64 + 4 * g;
                    *(GAS unsigned*)kr8 = pkf8(y1[0], y1[1], y1[2], y1[3]); *(GAS unsigned*)(kr8 + 32) = pkf8(y2[0], y2[1], y2[2], y2[3]); }
                if (wc == 0 && fq < 2) { *(GAS f32x4*)(WI + row * 16 + 8 * fq) = acc[ai][1][m][0]; *(GAS f32x4*)(WI + row * 16 + 8 * fq + 4) = acc[ai][1][m][1]; } }
        } else {
            const int t = pn - 14; bf16* base = t < 2 ? CQ : CKV; float* ssq = SSQ + (t < 2 ? (size_t)0 : (size_t)M * 8); const int colt = (t & 1) * 256;
#pragma unroll
            EPI_ROWS(ai, m) { const size_t row = rowb + ai * 128 + m * 16; float s = 0.f;
#pragma unroll
                for (int bj = 0; bj < 2; ++bj) { const f32x4 v0 = acc[ai][bj][m][0], v1 = acc[ai][bj][m][1];
                    { u32x2 w8; w8.x = pkf8(v0[0], v0[1], v0[2], v0[3]); w8.y = pkf8(v1[0], v1[1], v1[2], v1[3]); *(GAS u32x2*)((GAS unsigned char*)base + row * 512 + colt + bj * 128 + cw) = w8; }
                    s += (v0[0] * v0[0] + v0[1] * v0[1]) + (v0[2] * v0[2] + v0[3] * v0[3]) + (v1[0] * v1[0] + v1[1] * v1[1]) + (v1[2] * v1[2] + v1[3] * v1[3]); }
                s = sum_x32(sum_x16(s));
                if (fq == 0) ssq[row * 8 + (t & 1) * 4 + wc] = s; }
        }
    }
};
struct EpiQ {
    static constexpr bool PERM = true, AFTER_DRAIN = false;
    bf16 *QN, *QR; const float* SSQ; const float* ROPE;
    __device__ __forceinline__ void operator()(AccRef acc, const Unit& u, int wr, int wc, int fr, int fq) const {
        { int t_ = threadIdx.x; asm volatile("" : "+v"(t_)); fr = t_ & 15; fq = (t_ >> 4) & 3; }
        const int pn = u.pn, rowb = u.pm * 256 + wr * 64 + fr, cw = wc * 32 + 8 * fq;
#pragma unroll
        EPI_ROWS(ai, m) { const size_t row = rowb + ai * 128 + m * 16;
            const f32x4 sa = *(const GAS f32x4*)(SSQ + row * 8), sb = *(const GAS f32x4*)(SSQ + row * 8 + 4); const float r = (8.f * QB_SCALE) / sqrtf((((sa[0] + sa[1]) + (sa[2] + sa[3])) + ((sb[0] + sb[1]) + (sb[2] + sb[3]))) * (1.f / 512.f) + RMS_EPS);
            if (pn < 8) {
#pragma unroll
                for (int bj = 0; bj < 2; ++bj) { const f32x4 v0 = acc[ai][bj][m][0] * r, v1 = acc[ai][bj][m][1] * r; u32x2 w; w.x = pkf8(v0[0], v0[1], v0[2], v0[3]); w.y = pkf8(v1[0], v1[1], v1[2], v1[3]);
                    *(GAS u32x2*)((GAS unsigned char*)QN + row * 2048 + pn * 256 + bj * 128 + cw) = w; }
            } else { const int pos = (int)(row & (SEQ - 1)), g = 4 * (wc & 1) + fq;
                const f32x4 c4 = *(const GAS f32x4*)(ROPE + pos * 32 + 4 * g) * r, s4 = *(const GAS f32x4*)(ROPE + SEQ * 32 + pos * 32 + 4 * g) * r;
#pragma unroll
                for (int bj = 0; bj < 2; ++bj) { const int head = (pn - 8) * 4 + bj * 2 + (wc >> 1); const f32x4 v0 = acc[ai][bj][m][0], v1 = acc[ai][bj][m][1];
                    const f32x4 y1 = v0 * c4 - v1 * s4, y2 = v0 * s4 + v1 * c4; GAS unsigned char* q8 = (GAS unsigned char*)QR + row * 1024 + head * 64 + 4 * g;
                    *(GAS unsigned*)q8 = pkf8(y1[0], y1[1], y1[2], y1[3]); *(GAS unsigned*)(q8 + 32) = pkf8(y2[0], y2[1], y2[2], y2[3]); } } }
    }
};
struct EpiKV {
    static constexpr bool PERM = true, AFTER_DRAIN = false;
    bf16 *KN, *VB; const float* SSQ;
    __device__ __forceinline__ void operator()(AccRef acc, const Unit& u, int wr, int wc, int fr, int fq) const {
        { int t_ = threadIdx.x; asm volatile("" : "+v"(t_)); fr = t_ & 15; fq = (t_ >> 4) & 3; }
        const int pn = u.pn, rowb = u.pm * 256 + wr * 64 + fr, cw = wc * 32 + 8 * fq; bf16* base = pn < 8 ? KN : VB; const int colt = (pn & 7) * 256;
#pragma unroll
        EPI_ROWS(ai, m) { const size_t row = rowb + ai * 128 + m * 16; const f32x4 sa = *(const GAS f32x4*)(SSQ + row * 8), sb = *(const GAS f32x4*)(SSQ + row * 8 + 4); const float r = 1.0f / sqrtf((((sa[0] + sa[1]) + (sa[2] + sa[3])) + ((sb[0] + sb[1]) + (sb[2] + sb[3]))) * (1.f / 512.f) + RMS_EPS);
#pragma unroll
            for (int bj = 0; bj < 2; ++bj) { const f32x4 v0 = acc[ai][bj][m][0] * r, v1 = acc[ai][bj][m][1] * r;
                if (pn < 8) { u32x2 w; w.x = pkf8(v0[0], v0[1], v0[2], v0[3]); w.y = pkf8(v1[0], v1[1], v1[2], v1[3]); *(GAS u32x2*)((GAS unsigned char*)KN + row * 2048 + colt + bj * 128 + cw) = w; }
                else *(GAS v4u*)(VB + row * 2048 + colt + bj * 128 + cw) = pack8(v0, v1); } }
    }
};
template <int MODE> struct EpiB {
    static constexpr bool PERM = true, AFTER_DRAIN = false;
    bf16* O; int ldc; const bf16* gp; const float* bias; unsigned char* O8;
    __device__ __forceinline__ void operator()(AccRef acc, const Unit& u, int wr, int wc, int fr, int fq) const {
        { int t_ = threadIdx.x; asm volatile("" : "+v"(t_)); fr = t_ & 15; fq = (t_ >> 4) & 3; }
        const int rowb = u.pm * 256 + wr * 64 + fr, colb = u.pn * 256 + wc * 32 + 8 * fq;
#pragma unroll
        EPI_ROWS(ai, m) { const size_t row = rowb + ai * 128 + m * 16;
#pragma unroll
            for (int bj = 0; bj < 2; ++bj) { const int col = colb + bj * 128; f32x4 v0 = acc[ai][bj][m][0], v1 = acc[ai][bj][m][1]; bf16* op = O + row * ldc + col;
                if (MODE == 1) { v0 = sigmoid4(v0); v1 = sigmoid4(v1); }
                if (MODE == 2 || MODE == 3 || MODE == 5) { f32x4 g0, g1; unpack8(*(const GAS v4u*)(gp + row * 4096 + col), g0, g1); v0 = v0 * g0; v1 = v1 * g1; }
                if (MODE == 3 || MODE == 5) { f32x4 o0, o1; unpack8(*(const GAS v4u*)op, o0, o1); v0 = v0 + o0; v1 = v1 + o1; }
                if (MODE == 4) { f32x4 o0, o1; unpack8(*(const GAS v4u*)op, o0, o1); const f32x4 b0 = *(const GAS f32x4*)(bias + col), b1 = *(const GAS f32x4*)(bias + col + 4);
                    v0 = sigmoid4(v0 + b0) * o0; v1 = sigmoid4(v1 + b1) * o1; }
                if (MODE == 5) { u32x2 w; w.x = pkf8(v0[0], v0[1], v0[2], v0[3]); w.y = pkf8(v1[0], v1[1], v1[2], v1[3]); *(GAS u32x2*)(O8 + row * ldc + col) = w; }
                else *(GAS v4u*)op = pack8(v0, v1); }
            if (MODE >= 2) asm volatile("" ::: "memory"); }
    }
};
template <int MODE> struct EpiF {
    static constexpr bool PERM = true, AFTER_DRAIN = false;
    bf16* zb; const float* xin; const bf16* ple;
    __device__ __forceinline__ void operator()(AccRef acc, const Unit& u, int wr, int wc, int fr, int fq) const {
        { int t_ = threadIdx.x; asm volatile("" : "+v"(t_)); fr = t_ & 15; fq = (t_ >> 4) & 3; }
        const int rowb = u.pm * 256 + wr * 64 + fr, colb = u.pn * 256 + wc * 32 + 8 * fq;
#pragma unroll
        EPI_ROWS(ai, m) { const size_t row = rowb + ai * 128 + m * 16;
#pragma unroll
            for (int bj = 0; bj < 2; ++bj) { const size_t off = row * 2048 + colb + bj * 128; f32x4 v0 = acc[ai][bj][m][0], v1 = acc[ai][bj][m][1]; f32x4 x0, x1;
                if (MODE == 0) { x0 = *(const GAS f32x4*)(xin + off); x1 = *(const GAS f32x4*)(xin + off + 4); } else unpack8(*(const GAS v4u*)(zb + off), x0, x1);
                v0 = v0 + x0 * ALPHA; v1 = v1 + x1 * ALPHA;
                if (MODE == 1) { f32x4 p0, p1; unpack8(*(const GAS v4u*)(ple + off), p0, p1); v0 = v0 + p0; v1 = v1 + p1; }
                *(GAS v4u*)(zb + off) = pack8(v0, v1); }
            asm volatile("" ::: "memory"); }
    }
};
template <int CTRL> __device__ __forceinline__ f32x4 dpp4(f32x4 v) { return (f32x4){dppf<CTRL>(v[0]), dppf<CTRL>(v[1]), dppf<CTRL>(v[2]), dppf<CTRL>(v[3])}; }
__device__ __forceinline__ f32x4 sel4(bool c, f32x4 a, f32x4 b) { return (f32x4){c ? a[0] : b[0], c ? a[1] : b[1], c ? a[2] : b[2], c ? a[3] : b[3]}; }
struct EpiUp {
    static constexpr bool PERM = true, AFTER_DRAIN = false;
    unsigned char* ACT; float* HEADB; float* TAILB; const float* cw; const float* cb;
    __device__ __forceinline__ void operator()(AccRef acc, const Unit& u, int wr, int wc, int fr, int fq) const {
        { int t_ = threadIdx.x; asm volatile("" : "+v"(t_)); fr = t_ & 15; fq = (t_ >> 4) & 3; }
        const unsigned ch0 = (unsigned)(u.pn * 128 + wc * 32 + 8 * fq), cp0 = (unsigned)(u.pn * 256 + wc * 32 + 8 * fq);
        const GAS unsigned char* cwb = (const GAS unsigned char*)cw; const GAS unsigned char* cbb = (const GAS unsigned char*)cb; GAS unsigned char* actb = (GAS unsigned char*)ACT;
#pragma unroll
        for (int ai = 0; ai < 2; ++ai) {
            const unsigned g = (unsigned)(u.pm * 4 + ai * 2 + wr), row0 = g * 64u + (unsigned)fr;
            if (fr < 2) { GAS unsigned char* hp = (GAS unsigned char*)HEADB + ((g * 2u + (unsigned)fr) * (unsigned)NUP + cp0) * 4u;
#pragma unroll
                for (int bj = 0; bj < 2; ++bj)
#pragma unroll
                    for (int n = 0; n < 2; ++n) *(GAS f32x4*)(hp + (bj * 128 + 4 * n) * 4) = acc[ai][bj][0][n]; }
            if (fr >= 14) { GAS unsigned char* hp = (GAS unsigned char*)TAILB + ((g * 2u + (unsigned)(fr - 14)) * (unsigned)NUP + cp0) * 4u;
#pragma unroll
                for (int bj = 0; bj < 2; ++bj)
#pragma unroll
                    for (int n = 0; n < 2; ++n) *(GAS f32x4*)(hp + (bj * 128 + 4 * n) * 4) = acc[ai][bj][3][n]; }
            asm volatile("" ::: "memory"); __builtin_amdgcn_sched_barrier(0);
#pragma unroll
            for (int n = 0; n < 2; ++n) {
                unsigned pk[4];
#pragma unroll
                for (int hf = 0; hf < 2; ++hf) {
                    asm volatile("" ::: "memory"); __builtin_amdgcn_sched_barrier(0);
                    f32x2 yg[4];
#pragma unroll
                    for (int bj = 0; bj < 2; ++bj) { const unsigned cB = (ch0 + (unsigned)(4 * n + 2 * hf + bj * DFF)) * 4u;
                        const f32x2 w0 = *(const GAS f32x2*)(cwb + cB), w1 = *(const GAS f32x2*)(cwb + (cB + (unsigned)NUP * 4u)), w2 = *(const GAS f32x2*)(cwb + (cB + (unsigned)NUP * 8u)), bb = *(const GAS f32x2*)(cbb + cB);
                        f32x2 pr1 = (f32x2){0.f, 0.f}, pr2 = pr1;
#pragma unroll
                        for (int m = 0; m < 4; ++m) { const f32x4 v4 = acc[ai][bj][m][n]; const f32x2 v = hf ? (f32x2){v4[2], v4[3]} : (f32x2){v4[0], v4[1]};
                            const f32x2 r1 = (f32x2){dppf<0x121>(v[0]), dppf<0x121>(v[1])}, r2 = (f32x2){dppf<0x122>(v[0]), dppf<0x122>(v[1])};
                            const f32x2 p1 = fr >= 1 ? r1 : pr1, p2 = fr >= 2 ? r2 : pr2;
                            const f32x2 y = bb + w2 * v + w1 * p1 + w0 * p2; pr1 = r1; pr2 = r2;
                            if (bj == 0) yg[m] = y;
                            else { const f32x2 sg = (f32x2){sigmoidf_(yg[m][0]), sigmoidf_(yg[m][1])}; const f32x2 a = yg[m] * sg * y;
                                if (hf == 0) pk[m] = (unsigned)__builtin_amdgcn_cvt_pk_fp8_f32(a[0], a[1], 0, false);
                                else { const unsigned w = (unsigned)__builtin_amdgcn_cvt_pk_fp8_f32(a[0], a[1], (int)pk[m], true); if (!(m == 0 && fr < 2)) *(GAS unsigned*)(actb + ((row0 + (unsigned)(m * 16)) * (unsigned)DFF + ch0 + (unsigned)(4 * n))) = w; } } }
                        asm volatile("" ::: "memory"); __builtin_amdgcn_sched_barrier(0); }
                }
            }
        }
    }
};

namespace dsa {
constexpr int CAP = 512, TOPK = 256;
typedef unsigned long long u64;
typedef unsigned short u16;
__device__ __forceinline__ unsigned fkey(float f) { const unsigned u = __float_as_uint(f); return u ^ ((unsigned)((int)u >> 31) | 0x80000000u); }
__device__ __forceinline__ float keyf(unsigned k) { const unsigned u = (k & 0x80000000u) ? (k ^ 0x80000000u) : ~k; return __uint_as_float(u); }
__device__ __forceinline__ int mbcnt64(u64 m) { return (int)__builtin_amdgcn_mbcnt_hi((unsigned)(m >> 32), __builtin_amdgcn_mbcnt_lo((unsigned)m, 0u)); }

__device__ __forceinline__ unsigned wave_umax(unsigned v) {
#define DSA_UDPP(c_) (unsigned)__builtin_amdgcn_update_dpp(0, (int)v, c_, 0xf, 0xf, false)
    v = max(v, DSA_UDPP(0xB1)); v = max(v, DSA_UDPP(0x4E)); v = max(v, DSA_UDPP(0x141)); v = max(v, DSA_UDPP(0x140));
#undef DSA_UDPP
    { auto r = __builtin_amdgcn_permlane16_swap(v, v, false, false); v = max(r[0], r[1]); }
    { auto r = __builtin_amdgcn_permlane32_swap(v, v, false, false); v = max(r[0], r[1]); }
    return v;
}
__device__ __forceinline__ unsigned compact(LAS u64* buf, int n, int lane, unsigned lowk, bool exact, int& nout) {
    unsigned key[8], idx[8];
#pragma unroll
    for (int e = 0; e < 8; ++e) { const int i = lane + 64 * e; u64 v = 0ull; if (i < n) v = buf[i]; key[e] = (unsigned)(v >> 32); idx[e] = (unsigned)v; }
    unsigned mx = key[0];
#pragma unroll
    for (int e = 1; e < 8; ++e) mx = max(mx, key[e]);
    mx = (unsigned)__builtin_amdgcn_readfirstlane((int)wave_umax(mx));
    const unsigned diff = lowk ^ mx; unsigned P = lowk;
    if (diff) { const int hb = 31 - __builtin_clz(diff); P = hb == 31 ? 0u : (lowk >> (hb + 1)) << (hb + 1); const int lob = exact ? 0 : (hb > 15 ? hb - 15 : 0);
#pragma unroll 1
        for (int b = hb; b >= lob; --b) { const unsigned cand = P | (1u << b); int c = 0;
#pragma unroll
            for (int e = 0; e < 8; ++e) c += __builtin_popcountll(__ballot(key[e] >= cand));
            if (c >= TOPK) P = cand; } }
    int cgt = 0;
#pragma unroll
    for (int e = 0; e < 8; ++e) cgt += __builtin_popcountll(__ballot(key[e] > P));
    const int need = exact ? TOPK - cgt : CAP; int base = 0, eqbase = 0;
#pragma unroll
    for (int e = 0; e < 8; ++e) { const bool gt = key[e] > P, eq = key[e] == P && key[e] != 0u; const u64 beq = __ballot(eq); const bool sel = gt || (eq && (eqbase + mbcnt64(beq)) < need);
        const u64 bs = __ballot(sel); const int pos = base + mbcnt64(bs);
        if (sel) buf[pos] = ((u64)key[e] << 32) | idx[e];
        base += __builtin_popcountll(bs); eqbase += __builtin_popcountll(beq); }
    asm volatile("s_waitcnt lgkmcnt(0)" ::: "memory");
    nout = base;
    return P;
}

struct Ptrs { const bf16 *QI, *KI, *KA, *VA; const float* WI; const bf16* QA; bf16* O; unsigned short* SEL; };

__device__ __forceinline__ void attend(const Ptrs& P, int b, int t, const LAS u16* idl, LAS unsigned char* vbuf, int lane) {
    const int head = lane & 15, g = lane >> 4; const size_t m = (size_t)b * SEQ + t;
    bf16x8 Bq[4];
#pragma unroll
    for (int ks = 0; ks < 4; ++ks) Bq[ks] = *(const GAS bf16x8*)(P.QA + m * 2048 + head * 128 + 32 * ks + 8 * g);
    const float slope2 = __builtin_amdgcn_exp2f(-0.5f * (float)(head + 1)) * LOG2E;
    const bf16* vab = P.VA + (size_t)b * SEQ * 128;
    v4u st[8];
#define DSA_VLOAD(kk) do { _Pragma("unroll") for (int u_ = 0; u_ < 8; ++u_) { const int row_ = 4 * u_ + g; unsigned s_ = idl[32 * (kk) + row_]; s_ = s_ == 0xFFFFu ? 0u : s_; \
        const int cl_ = (lane & 15) ^ ((row_ & 7) << 1); st[u_] = *(const GAS v4u*)(vab + (size_t)s_ * 128 + cl_ * 8); } } while (0)
#define DSA_VWRITE(kk) do { _Pragma("unroll") for (int u_ = 0; u_ < 8; ++u_) *(LAS v4u*)(vbuf + ((kk) & 1) * 8192 + u_ * 1024 + lane * 16) = st[u_]; } while (0)
    DSA_VLOAD(0);
    const bf16* kab = P.KA + (size_t)b * SEQ * 128 + 8 * g;
    f32x4 L[16];
    bf16x8 Af[16][4];
#define DSA_KLD(i_) do { unsigned s_ = idl[16 * (i_) + head]; s_ = s_ == 0xFFFFu ? 0u : s_; const bf16* kp_ = kab + (size_t)s_ * 128; \
        _Pragma("unroll") for (int ks = 0; ks < 4; ++ks) Af[i_][ks] = *(const GAS bf16x8*)(kp_ + 32 * ks); } while (0)
    DSA_KLD(0); __builtin_amdgcn_sched_barrier(0); DSA_KLD(1); __builtin_amdgcn_sched_barrier(0); DSA_KLD(2); __builtin_amdgcn_sched_barrier(0);
#pragma unroll
    for (int i = 0; i < 16; ++i) {
        if (i + 3 < 16) { DSA_KLD(i + 3 < 16 ? i + 3 : 15); } __builtin_amdgcn_sched_barrier(0);
        f32x4 C = (f32x4){0.f, 0.f, 0.f, 0.f};
#pragma unroll
        for (int ks = 0; ks < 4; ++ks) C = __builtin_amdgcn_mfma_f32_16x16x32_bf16(Af[i][ks], Bq[ks], C, 0, 0, 0);
        const u32x2 idw = *(const LAS u32x2*)(idl + 16 * i + 4 * g);
        const unsigned i0 = idw.x & 0xffffu, i1 = idw.x >> 16, i2 = idw.y & 0xffffu, i3 = idw.y >> 16;
        L[i][0] = i0 == 0xFFFFu ? -__builtin_inff() : C[0] - slope2 * (float)(t - (int)i0);
        L[i][1] = i1 == 0xFFFFu ? -__builtin_inff() : C[1] - slope2 * (float)(t - (int)i1);
        L[i][2] = i2 == 0xFFFFu ? -__builtin_inff() : C[2] - slope2 * (float)(t - (int)i2);
        L[i][3] = i3 == 0xFFFFu ? -__builtin_inff() : C[3] - slope2 * (float)(t - (int)i3);
        __builtin_amdgcn_sched_barrier(0);
    }
#undef DSA_KLD
    float mx = -__builtin_inff();
#pragma unroll
    for (int i = 0; i < 16; ++i) mx = fmaxf(fmaxf(mx, fmaxf(L[i][0], L[i][1])), fmaxf(L[i][2], L[i][3]));
    mx = max_x32(max_x16(mx));
    float sum = 0.f;
#pragma unroll
    for (int i = 0; i < 16; ++i) {
#pragma unroll
        for (int r = 0; r < 4; ++r) { const float p = __builtin_amdgcn_exp2f(L[i][r] - mx); L[i][r] = p; sum += p; } }
    sum = sum_x32(sum_x16(sum));
    f32x4 O[8];
#pragma unroll
    for (int dt = 0; dt < 8; ++dt) O[dt] = (f32x4){0.f, 0.f, 0.f, 0.f};
    DSA_VWRITE(0); DSA_VLOAD(1);
    const int q4 = (lane >> 2) & 3, p4 = lane & 3, row1 = 4 * g + q4;
#pragma unroll
    for (int kk = 0; kk < 8; ++kk) {
        const v4u pw = pack8(L[2 * kk], L[2 * kk + 1]); const bf16x8 Pf = __builtin_bit_cast(bf16x8, pw);
        const LAS unsigned char* vb = vbuf + (kk & 1) * 8192 + row1 * 256 + 8 * p4;
        s16x4 lo[8], hi2[8];
#pragma unroll
        for (int dt = 0; dt < 8; ++dt) { const LAS unsigned char* a1 = vb + ((dt ^ (row1 & 7)) << 5);
            lo[dt] = __builtin_bit_cast(s16x4, __builtin_amdgcn_ds_read_tr16_b64_v4i16((LAS s16x4*)a1));
            hi2[dt] = __builtin_bit_cast(s16x4, __builtin_amdgcn_ds_read_tr16_b64_v4i16((LAS s16x4*)(a1 + 4096))); }
#pragma unroll
        for (int dt = 0; dt < 8; ++dt) {
            const bf16x8 Av = (bf16x8){lo[dt][0], lo[dt][1], lo[dt][2], lo[dt][3], hi2[dt][0], hi2[dt][1], hi2[dt][2], hi2[dt][3]};
            O[dt] = __builtin_amdgcn_mfma_f32_16x16x32_bf16(Av, Pf, O[dt], 0, 0, 0); }
        if (kk + 1 < 8) { DSA_VWRITE(kk + 1); if (kk + 2 < 8) DSA_VLOAD(kk + 2); }
    }
#undef DSA_VLOAD
#undef DSA_VWRITE
    const float inv = 1.0f / sum;
    unsigned char* op = (unsigned char*)P.O + m * 4096 + head * 128 + 4 * g;
#pragma unroll
    for (int dt = 0; dt < 8; ++dt) { const f32x4 o = O[dt] * inv; *(GAS unsigned*)(op + 16 * dt) = pkf8(o[0], o[1], o[2], o[3]); }
}

__device__ __forceinline__ void job(const Ptrs& P, int b, int t0, LAS unsigned char* wl, LAS u16* idl, int lane, volatile LAS unsigned* dbgp = nullptr) {
#if defined(DBG_SPIN)
    unsigned long long tcomp = 0ull, tatt = 0ull; const unsigned long long tj0 = __builtin_amdgcn_s_memrealtime();
#endif
    const int r32 = lane & 31, hi = lane >> 5;
    const int qsel = (r32 >> 2) & 1, headA = (r32 & 3) + 4 * (r32 >> 3);
    bf16x8 A[2][4]; float sg[2][16];
#pragma unroll
    for (int a = 0; a < 2; ++a) {
        const size_t mA = (size_t)b * SEQ + t0 + 2 * a + qsel; const float aw = P.WI[mA * 16 + headA];
#pragma unroll
        for (int d0 = 0; d0 < 4; ++d0) { f32x4 x0, x1; unpack8h(*(const GAS v4u*)(P.QI + mA * 1024 + headA * 64 + 16 * d0 + 8 * hi), x0, x1); A[a][d0] = __builtin_bit_cast(bf16x8, pack8h(x0 * aw, x1 * aw)); }
        const size_t mC = (size_t)b * SEQ + t0 + 2 * a + hi;
#pragma unroll
        for (int r4 = 0; r4 < 4; ++r4) { const f32x4 w4 = *(const GAS f32x4*)(P.WI + mC * 16 + 4 * r4);
#pragma unroll
            for (int j = 0; j < 4; ++j) sg[a][4 * r4 + j] = w4[j] < 0.f ? -__builtin_inff() : __builtin_inff(); }
    }
    LAS u64* cand = (LAS u64*)wl;
    int c0 = 0, c1 = 0, c2 = 0, c3 = 0; unsigned l0 = 0u, l1 = 0u, l2 = 0u, l3 = 0u; float tau0 = -__builtin_inff(), tau1 = -__builtin_inff();
    const int ntile = (t0 + 3) / 32 + 1;
    const bf16* kib = P.KI + (size_t)b * SEQ * 64 + 8 * lane;
    bf16x8 B0[4], B1[4], B2[4], B3[4];
#define DSA_LDK(B_, JN_) do { const int jn_ = (JN_) < ntile ? (JN_) : ntile - 1; _Pragma("unroll") for (int d0 = 0; d0 < 4; ++d0) B_[d0] = *(const GAS bf16x8*)(kib + (size_t)jn_ * 2048 + 512 * d0); } while (0)
    DSA_LDK(B0, 0); asm volatile("" ::: "memory"); DSA_LDK(B1, 1); asm volatile("" ::: "memory"); DSA_LDK(B2, 2); asm volatile("" ::: "memory"); DSA_LDK(B3, 3); asm volatile("" ::: "memory");
#if defined(DBG_SPIN)
#define DSA_TC0 const unsigned long long tc0 = __builtin_amdgcn_s_memrealtime();
#define DSA_TC1 tcomp += __builtin_amdgcn_s_memrealtime() - tc0;
#else
#define DSA_TC0
#define DSA_TC1
#endif
#define DSA_TILE(JT_, Bf) do { const int jt = (JT_); const int s = jt * 32 + r32; \
        f32x16 C0 = {}, C1 = {}; \
        _Pragma("unroll") for (int d0 = 0; d0 < 4; ++d0) C0 = __builtin_amdgcn_mfma_f32_32x32x16_f16(__builtin_bit_cast(f16x8, A[0][d0]), __builtin_bit_cast(f16x8, Bf[d0]), C0, 0, 0, 0); \
        _Pragma("unroll") for (int d0 = 0; d0 < 4; ++d0) C1 = __builtin_amdgcn_mfma_f32_32x32x16_f16(__builtin_bit_cast(f16x8, A[1][d0]), __builtin_bit_cast(f16x8, Bf[d0]), C1, 0, 0, 0); \
        DSA_LDK(Bf, jt + 4); \
        float scv[2]; \
        _Pragma("unroll") for (int a = 0; a < 2; ++a) { float s_ = 0.f;                                                    \
            _Pragma("unroll") for (int r = 0; r < 16; ++r) { s_ += __builtin_amdgcn_fmed3f(a == 0 ? C0[r] : C1[r], 0.f, sg[a][r]); if ((r & 3) == 3) asm volatile("" : "+v"(s_)); } \
            scv[a] = s_; } \
        _Pragma("unroll") for (int a = 0; a < 2; ++a) { \
            const float sc = scv[a]; \
            const int tq = t0 + 2 * a + hi; const float tau = a == 0 ? tau0 : tau1; \
            const bool pass = (s <= tq) && (sc > tau); \
            const u64 bal = __ballot(pass); \
            if (bal) { const unsigned blo = (unsigned)bal, bhi = (unsigned)(bal >> 32); \
                const int pre = hi ? (int)__builtin_amdgcn_mbcnt_hi(bhi, 0u) : (int)__builtin_amdgcn_mbcnt_lo(blo, 0u); \
                const int cq = a == 0 ? (hi ? c1 : c0) : (hi ? c3 : c2); \
                if (pass) cand[(2 * a + hi) * CAP + cq + pre] = ((u64)fkey(sc) << 32) | (unsigned)s; \
                if (a == 0) { c0 += __builtin_popcount(blo); c1 += __builtin_popcount(bhi); } else { c2 += __builtin_popcount(blo); c3 += __builtin_popcount(bhi); } } \
        } \
        const int lim = (jt == ntile - 1) ? TOPK : CAP - 32; \
        _Pragma("unroll 1") for (;;) { \
            const int q = c0 > lim ? 0 : c1 > lim ? 1 : c2 > lim ? 2 : c3 > lim ? 3 : -1; \
            if (q < 0) break; \
            int n = q == 0 ? c0 : q == 1 ? c1 : q == 2 ? c2 : c3; unsigned lowk = q == 0 ? l0 : q == 1 ? l1 : q == 2 ? l2 : l3; \
            asm volatile("s_waitcnt lgkmcnt(0)" ::: "memory"); \
            DSA_TC0 \
            bool ex = jt == ntile - 1; int nout; unsigned T; \
            _Pragma("unroll 1") for (;;) { T = compact(cand + q * CAP, n, lane, lowk, ex, nout); if (ex || nout <= lim) break; ex = true; n = nout; lowk = T; } \
            const float tf = keyf(T); \
            DSA_TC1 \
            if (q == 0) { c0 = nout; l0 = T; } else if (q == 1) { c1 = nout; l1 = T; } else if (q == 2) { c2 = nout; l2 = T; } else { c3 = nout; l3 = T; } \
            if ((q >> 1) == 0) { if (hi == (q & 1)) tau0 = tf; } else { if (hi == (q & 1)) tau1 = tf; } \
        } } while (0)
#pragma unroll 1
    for (int jt0 = 0; jt0 < ntile; jt0 += 4) { DSA_TILE(jt0, B0); DSA_TILE(jt0 + 1, B1); DSA_TILE(jt0 + 2, B2); DSA_TILE(jt0 + 3, B3); }
#undef DSA_TILE
#undef DSA_LDK
#undef DSA_TC0
#undef DSA_TC1
    asm volatile("s_waitcnt lgkmcnt(0)" ::: "memory");
#pragma unroll
    for (int q = 0; q < 4; ++q) { const int n = q == 0 ? c0 : q == 1 ? c1 : q == 2 ? c2 : c3;
#pragma unroll
        for (int e = 0; e < 4; ++e) { const int i = lane + 64 * e; unsigned v = 0xFFFFu; if (i < n) v = (unsigned)cand[q * CAP + i] & 0xFFFFu;
#if defined(DBG_FIXED_SEL)
            v = (t0 + q - i) >= 0 ? (unsigned)(t0 + q - i) : 0xFFFFu;
#endif
            idl[q * TOPK + i] = (u16)v; if (P.SEL) P.SEL[((size_t)b * SEQ + t0 + q) * TOPK + i] = (u16)v; } }
    asm volatile("s_waitcnt lgkmcnt(0)" ::: "memory");
#if defined(DBG_SPIN)
    const unsigned long long ta0 = __builtin_amdgcn_s_memrealtime();
#endif
#pragma unroll 1
    for (int q = 0; q < 4; ++q) attend(P, b, t0 + q, idl + q * TOPK, wl, lane);
#if defined(DBG_SPIN)
    tatt = __builtin_amdgcn_s_memrealtime() - ta0;
    if (dbgp && lane == 0) { dbgp[0] += (unsigned)tcomp; dbgp[1] += (unsigned)tatt; dbgp[2] += (unsigned)(__builtin_amdgcn_s_memrealtime() - tj0); }
#endif
}
}

namespace mla {
constexpr int NW = 8, QBLK = 32, KVBLK = 64, QB = 256;
constexpr int SHM_V = 16384, SHM_K = 8192, SHM_R = 4096;
constexpr int OFF_V = 0, OFF_K = 3 * SHM_V, OFF_R = OFF_K + 4 * SHM_K, OFF_WS = OFF_R + 4 * SHM_R, LDS_NEED = OFF_WS + NW * 64 * 4;
constexpr float THR = 8.f;
#define MLA_KSWZ(row, colB) ((row) * 256 + ((colB) ^ (((row) & 7) << 4)))
#define MLA_RSWZ(row, colB) ((row) * 128 + ((colB) ^ ((((row) >> 1) & 7) << 4)))
#define MLA_SBAR() __builtin_amdgcn_sched_barrier(0)
__device__ __forceinline__ int v_st(int k, int c) { const int kk = (k & ~0xC) | ((k & 4) << 1) | ((k & 8) >> 1); return ((kk >> 3) * 4 + (c >> 5)) * 512 + ((kk & 7) * 32 + (c & 31)) * 2; }
__device__ __forceinline__ int v_rd_base(int lane) { return ((lane & 3) << 3) | (((lane >> 2) & 3) << 6) | (((lane >> 4) & 1) << 5) | (((lane >> 5) & 1) << 8); }
constexpr int v_rd_off(int d0, int ks, int half) { return d0 * 512 + ks * 4096 + half * 2048; }
__device__ __forceinline__ int crow(int r, int hi) { return (r & 3) + 8 * (r >> 2) + 4 * hi; }
__device__ __forceinline__ unsigned cvtpk(float lo, float hi) { return pg8::cvt_pk_bf16(lo, hi); }

__device__ __forceinline__ void mask_tile(f32x16& p0, f32x16& p1, int dq) {
    const float NEG = -__builtin_inff();
#pragma unroll
    for (int r = 0; r < 16; ++r) { const int c = (r & 3) + 8 * (r >> 2);
        if (dq - c < 0) p0[r] = NEG;
        if (dq - c - 32 < 0) p1[r] = NEG; }
}
__device__ __forceinline__ void softmax_tile(f32x16& p0, f32x16& p1, float& m_reg, float& l_reg, float& alpha, bf16x8& pa0, bf16x8& pa1, bf16x8& pa2, bf16x8& pa3) {
    float pmax = p0[0];
#pragma unroll
    for (int r = 1; r < 16; ++r) pmax = fmaxf(pmax, p0[r]);
#pragma unroll
    for (int r = 0; r < 16; ++r) pmax = fmaxf(pmax, p1[r]);
    { auto rr = __builtin_amdgcn_permlane32_swap(__float_as_uint(pmax), __float_as_uint(pmax), false, false); pmax = fmaxf(__uint_as_float(rr[0]), __uint_as_float(rr[1])); }
    float mn;
    if (__builtin_expect(__all((pmax - m_reg) <= THR), 1)) { mn = m_reg; alpha = 1.f; }
    else { mn = fmaxf(m_reg, pmax); alpha = __builtin_amdgcn_exp2f(m_reg - mn); m_reg = mn; }
#pragma unroll
    for (int r = 0; r < 16; ++r) { p0[r] = __builtin_amdgcn_exp2f(p0[r] - mn); p1[r] = __builtin_amdgcn_exp2f(p1[r] - mn); }
    float ps = 0.f;
#pragma unroll
    for (int r = 0; r < 16; ++r) ps += p0[r];
#pragma unroll
    for (int r = 0; r < 16; ++r) ps += p1[r];
    { auto rr = __builtin_amdgcn_permlane32_swap(__float_as_uint(ps), __float_as_uint(ps), false, false); ps = __uint_as_float(rr[0]) + __uint_as_float(rr[1]); }
    l_reg = l_reg * alpha + ps;
#define MLA_PK4(P, B_, OUT) do { unsigned a0 = cvtpk(P[B_ + 0], P[B_ + 1]), a1 = cvtpk(P[B_ + 2], P[B_ + 3]); unsigned b0 = cvtpk(P[B_ + 4], P[B_ + 5]), b1 = cvtpk(P[B_ + 6], P[B_ + 7]); \
        auto r0 = __builtin_amdgcn_permlane32_swap(a0, b0, false, false); auto r1 = __builtin_amdgcn_permlane32_swap(a1, b1, false, false); \
        v4u w = {r0[0], r1[0], r0[1], r1[1]}; OUT = __builtin_bit_cast(bf16x8, w); } while (0)
    MLA_PK4(p0, 0, pa0); MLA_PK4(p0, 8, pa1); MLA_PK4(p1, 0, pa2); MLA_PK4(p1, 8, pa3);
#undef MLA_PK4
}
typedef int i32x8q __attribute__((ext_vector_type(8))); typedef int i32x4q __attribute__((ext_vector_type(4)));
template <int KB>
__device__ __forceinline__ void qkt(f32x16& p0, f32x16& p1, const LAS unsigned char* lds, int r32, int hi, const i32x8q* q8) {
    p0 = f32x16{}; p1 = f32x16{};
    const LAS unsigned char* kr = lds + OFF_K + KB * SHM_K + r32 * 128; const int kx = (r32 >> 1) & 7;
    const LAS unsigned char* rr = lds + OFF_R + KB * SHM_R + r32 * 64; const int rx = (r32 >> 2) & 3;
#define MLA_LD32(base_, c_, x_, step_) __builtin_shufflevector(*(const LAS i32x4q*)((base_) + ((((c_)) ^ (x_)) << 4) + (step_)), *(const LAS i32x4q*)((base_) + ((((c_) + 1) ^ (x_)) << 4) + (step_)), 0, 1, 2, 3, 4, 5, 6, 7)
#pragma unroll
    for (int j = 0; j < 2; ++j) { const int c = 4 * j + 2 * hi;
        const i32x8q a0 = MLA_LD32(kr, c, kx, 0), a1 = MLA_LD32(kr, c, kx, 32 * 128);
        p0 = __builtin_amdgcn_mfma_scale_f32_32x32x64_f8f6f4(a0, q8[j], p0, 0, 0, 0, 127, 0, 127 - 3);
        p1 = __builtin_amdgcn_mfma_scale_f32_32x32x64_f8f6f4(a1, q8[j], p1, 0, 0, 0, 127, 0, 127 - 3); }
    { const int c = 2 * hi;
        const i32x8q a0 = MLA_LD32(rr, c, rx, 0), a1 = MLA_LD32(rr, c, rx, 32 * 64);
        p0 = __builtin_amdgcn_mfma_scale_f32_32x32x64_f8f6f4(a0, q8[2], p0, 0, 0, 0, 127, 0, 127 - 3);
        p1 = __builtin_amdgcn_mfma_scale_f32_32x32x64_f8f6f4(a1, q8[2], p1, 0, 0, 0, 127, 0, 127 - 3); }
#undef MLA_LD32
}
template <int VB>
__device__ __forceinline__ void pv_tile(f32x16* o, int vb0, bf16x8 pa0, bf16x8 pa1, bf16x8 pa2, bf16x8 pa3) {
#define MLA_TRRD(dst, off) asm volatile("ds_read_b64_tr_b16 %0, %1 offset:%2" : "=&v"(dst) : "v"(vb0), "i"(off) : "memory")
#define MLA_PV_D0(d0) do { s16x4 l0, l1, l2, l3, h0, h1, h2, h3; constexpr int b_ = OFF_V + VB * SHM_V + v_rd_off(d0, 0, 0); \
        MLA_TRRD(l0, b_); MLA_TRRD(h0, b_ + 2048); MLA_TRRD(l1, b_ + 4096); MLA_TRRD(h1, b_ + 6144); MLA_TRRD(l2, b_ + 8192); MLA_TRRD(h2, b_ + 10240); MLA_TRRD(l3, b_ + 12288); MLA_TRRD(h3, b_ + 14336); \
        asm volatile("s_waitcnt lgkmcnt(0)" ::: "memory"); MLA_SBAR(); \
        o[d0] = __builtin_amdgcn_mfma_f32_32x32x16_bf16(pa0, (bf16x8){l0[0], l0[1], l0[2], l0[3], h0[0], h0[1], h0[2], h0[3]}, o[d0], 0, 0, 0); \
        o[d0] = __builtin_amdgcn_mfma_f32_32x32x16_bf16(pa1, (bf16x8){l1[0], l1[1], l1[2], l1[3], h1[0], h1[1], h1[2], h1[3]}, o[d0], 0, 0, 0); \
        o[d0] = __builtin_amdgcn_mfma_f32_32x32x16_bf16(pa2, (bf16x8){l2[0], l2[1], l2[2], l2[3], h2[0], h2[1], h2[2], h2[3]}, o[d0], 0, 0, 0); \
        o[d0] = __builtin_amdgcn_mfma_f32_32x32x16_bf16(pa3, (bf16x8){l3[0], l3[1], l3[2], l3[3], h3[0], h3[1], h3[2], h3[3]}, o[d0], 0, 0, 0); } while (0)
    MLA_PV_D0(0); MLA_PV_D0(1); MLA_PV_D0(2); MLA_PV_D0(3);
#undef MLA_PV_D0
#undef MLA_TRRD
}
struct Tensors { const bf16* QN; const bf16* QR; const bf16* KN; const bf16* KR; const bf16* VB; bf16* O; };

__device__ __forceinline__ s16x4 vtr(const LAS unsigned char* p) { return __builtin_bit_cast(s16x4, __builtin_amdgcn_ds_read_tr16_b64_v4i16((LAS s16x4*)p)); }
template <int N> __device__ __forceinline__ i32x8q kfrag(const LAS unsigned char* kr, const LAS unsigned char* rr, int hi, int kx, int rx) {
    if (N < 4) { const int c = 4 * (N >> 1) + 2 * hi; const LAS unsigned char* b_ = kr + (N & 1) * 32 * 128;
        return __builtin_shufflevector(*(const LAS i32x4q*)(b_ + ((c ^ kx) << 4)), *(const LAS i32x4q*)(b_ + (((c + 1) ^ kx) << 4)), 0, 1, 2, 3, 4, 5, 6, 7); }
    const int c = 2 * hi; const LAS unsigned char* b_ = rr + (N & 1) * 32 * 64;
    return __builtin_shufflevector(*(const LAS i32x4q*)(b_ + ((c ^ rx) << 4)), *(const LAS i32x4q*)(b_ + (((c + 1) ^ rx) << 4)), 0, 1, 2, 3, 4, 5, 6, 7);
}
__device__ __forceinline__ float rowmax(const f32x16& p0, const f32x16& p1) {
    float pmax = p0[0];
#pragma unroll
    for (int r = 1; r < 16; ++r) pmax = fmaxf(pmax, p0[r]);
#pragma unroll
    for (int r = 0; r < 16; ++r) pmax = fmaxf(pmax, p1[r]);
    auto rr = __builtin_amdgcn_permlane32_swap(__float_as_uint(pmax), __float_as_uint(pmax), false, false); return fmaxf(__uint_as_float(rr[0]), __uint_as_float(rr[1]));
}

__device__ __forceinline__ void unit(const Tensors& T, int b, int h, int qb, LAS unsigned char* lds) {
    const int tid = threadIdx.x, wid = __builtin_amdgcn_readfirstlane(tid >> 6), lane = tid & 63, r32 = lane & 31, hi = lane >> 5;
    const size_t rowq = (size_t)b * SEQ + qb * QB + wid * QBLK + r32;
    i32x8q qr[3];
    { const GAS unsigned char* qn8 = (const GAS unsigned char*)T.QN + rowq * 2048 + h * 128 + 32 * hi; const GAS unsigned char* qr8 = (const GAS unsigned char*)T.QR + rowq * 1024 + h * 64 + 32 * hi;
#pragma unroll
      for (int j = 0; j < 2; ++j) qr[j] = __builtin_shufflevector(*(const GAS i32x4q*)(qn8 + 64 * j), *(const GAS i32x4q*)(qn8 + 64 * j + 16), 0, 1, 2, 3, 4, 5, 6, 7);
      qr[2] = __builtin_shufflevector(*(const GAS i32x4q*)qr8, *(const GAS i32x4q*)(qr8 + 16), 0, 1, 2, 3, 4, 5, 6, 7); }
    const int NT = 4 * (qb + 1);
    const int qlo = qb * QB + wid * QBLK, qm = qlo + r32 - 4 * hi;
    LAS float* ws = (LAS float*)(lds + OFF_WS) + wid * 64; LAS float* li_l = ws; LAS float* al_l = ws + 32;
    float mhat = 0.f, l_reg = 0.f; f32x16 o[4] = {}; bool resc = false;
    const LAS unsigned char* vp0 = lds + OFF_V + v_rd_base(lane);
    const LAS unsigned char* kr0 = lds + OFF_K + r32 * 128; const LAS unsigned char* rr0 = lds + OFF_R + r32 * 64; const int kx = (r32 >> 1) & 7, rx = (r32 >> 2) & 3;
    int voff[2], koff, roff;
#pragma unroll
    for (int i = 0; i < 2; ++i) { const int G_ = (wid + 8 * i) * 64 + lane;
        { const int st = G_ >> 5, w_ = G_ & 31, kk = (st >> 2) * 8 + (w_ >> 2), c = (st & 3) * 32 + (w_ & 3) * 8, k = kk; voff[i] = (k * 2048 + c) * 2; } }
    { const int G_ = wid * 64 + lane, row = G_ >> 3, slot = G_ & 7; koff = row * 2048 + 16 * (slot ^ ((row >> 1) & 7)); }
    { const int G_ = (wid & 3) * 64 + lane, row = G_ >> 2, slot = G_ & 3; roff = row * 64 + 16 * (slot ^ ((row >> 2) & 3)); }
    const unsigned char* Kh = (const unsigned char*)T.KN + (size_t)b * SEQ * 2048 + h * 128; const bf16* Vh = T.VB + (size_t)b * SEQ * 2048 + h * 128; const unsigned char* Rh = (const unsigned char*)T.KR + (size_t)b * SEQ * 64;
#define MLA_GLDS(base_, off_, dst_) do { unsigned sv_; const void* g_ = (const void*)(base_); const unsigned o_ = (unsigned)(off_); const unsigned d_ = (unsigned)__builtin_amdgcn_readfirstlane((int)(unsigned)(uintptr_t)(dst_)); \
        asm volatile("s_mov_b32 %0, m0\n\ts_mov_b32 m0, %3\n\ts_nop 0\n\tglobal_load_lds_dwordx4 %1, %2\n\ts_mov_b32 m0, %0" : "=&s"(sv_) : "v"(o_), "s"(g_), "s"(d_) : "memory"); } while (0)
#define MLA_DMA_V(k0, bf) do { _Pragma("unroll") for (int i_ = 0; i_ < 2; ++i_) MLA_GLDS((const unsigned char*)Vh + (size_t)(k0) * 4096, voff[i_], lds + OFF_V + (bf) * SHM_V + (wid + 8 * i_) * 1024); } while (0)
#define MLA_DMA_K(k0, bf) do { MLA_GLDS(Kh + (size_t)(k0) * 2048, koff, lds + OFF_K + (bf) * SHM_K + wid * 1024); \
        if (wid < 4) MLA_GLDS(Rh + (size_t)(k0) * 64, roff, lds + OFF_R + (bf) * SHM_R + wid * 1024); } while (0)
#define MLA_WAITBAR() do { asm volatile("s_waitcnt vmcnt(0)" ::: "memory"); __syncthreads(); } while (0)
#define MLA_WAITBAR_C() do { if (wid < 4) asm volatile("s_waitcnt vmcnt(4)" ::: "memory"); else asm volatile("s_waitcnt vmcnt(3)" ::: "memory"); __syncthreads(); } while (0)
#define MLA_PIN(x) asm volatile("" : "+v"(x))
#define MLA_RESC() do { if (resc) { _Pragma("unroll") for (int d_ = 0; d_ < 4; ++d_) _Pragma("unroll") for (int r = 0; r < 16; ++r) o[d_][r] *= al_l[crow(r, hi)]; } } while (0)
#define MLA_QMF(C_, a_, j_, I_) C_ = __builtin_amdgcn_mfma_scale_f32_32x32x64_f8f6f4(a_, qr[j_], I_, 0, 0, 0, 127, 0, 127 - 3)
#define MLA_KF(N_) kfrag<N_>(kr_, rr_, hi, kx, rx)
#define MLA_PK4(P, B_, OUT) do { OUT = (v4u){cvtpk(P[B_ + 0], P[B_ + 1]), cvtpk(P[B_ + 2], P[B_ + 3]), cvtpk(P[B_ + 4], P[B_ + 5]), cvtpk(P[B_ + 6], P[B_ + 7])}; } while (0)
#define MLA_S2(P, i) do { sa0 += P[i]; sa1 += P[(i) + 1]; } while (0)
#define MLA_EX2(X, i) do { const f32x2 d_ = (f32x2){X[i], X[i + 1]} - (f32x2){mhat, mhat}; X[i] = __builtin_amdgcn_exp2f(d_[0]); X[(i) + 1] = __builtin_amdgcn_exp2f(d_[1]); } while (0)
#define MLA_VRD(n) do { vlo[n] = vtr(vp_ + (((n) & 3) * 512 + ((n) >> 2) * 4096)); vhi[n] = vtr(vp_ + (((n) & 3) * 512 + ((n) >> 2) * 4096 + 2048)); } while (0)
#define MLA_VFR(n) (bf16x8){vlo[n][0], vlo[n][1], vlo[n][2], vlo[n][3], vhi[n][0], vhi[n][1], vhi[n][2], vhi[n][3]}
#define MLA_PAF(k) __builtin_bit_cast(bf16x8, pw##k)
#define MLA_GAPB(n, k, X, i) do { o[(n) & 3] = __builtin_amdgcn_mfma_f32_32x32x16_bf16(MLA_PAF(k), MLA_VFR(n), o[(n) & 3], 0, 0, 0); if ((n) + 2 < 16) MLA_VRD((n) + 2 < 16 ? (n) + 2 : 15); \
        MLA_EX2(X, i); MLA_PIN(X); MLA_SBAR(); } while (0)
    f32x16 pA0, pA1, pB0, pB1; v4u pw0, pw1, pw2, pw3; s16x4 vlo[16], vhi[16]; i32x8q kf0, kf1;
    int ks_cur = 0, ks_nxt = 1, ks_n2 = 2, ks_n3 = 3, vs_rd = 2, vs_mid = 0, vs_wr = 1;
#define MLA_ROT() do { const int o_ = ks_cur; ks_cur = ks_nxt; ks_nxt = ks_n2; ks_n2 = ks_n3; ks_n3 = o_; const int p_ = vs_rd; vs_rd = vs_mid; vs_mid = vs_wr; vs_wr = p_; } while (0)
    MLA_DMA_K(0, 0); MLA_DMA_K(KVBLK, 1); MLA_DMA_K(2 * KVBLK, 2); MLA_DMA_V(0, 0); MLA_WAITBAR();
    MLA_DMA_K(3 * KVBLK, 3); MLA_DMA_V(KVBLK, 1);
    qkt<0>(pA0, pA1, lds, r32, hi, qr);
    if (NT == 4) mask_tile(pA0, pA1, qm);
    mhat = rowmax(pA0, pA1);
#pragma unroll
    for (int r = 0; r < 16; r += 2) { MLA_EX2(pA0, r); MLA_EX2(pA1, r); }
    MLA_ROT();
    { const LAS unsigned char* kr_ = kr0 + ks_cur * SHM_K; const LAS unsigned char* rr_ = rr0 + ks_cur * SHM_R; kf0 = MLA_KF(0); kf1 = MLA_KF(1); }
    MLA_WAITBAR_C();
#define MLA_MX(X, i) fmaxf(fmaxf(X[i], X[(i) + 1]), fmaxf(X[(i) + 2], X[(i) + 3]))
#define MLA_PV(n, k) o[(n) & 3] = __builtin_amdgcn_mfma_f32_32x32x16_bf16(MLA_PAF(k), MLA_VFR(n), o[(n) & 3], 0, 0, 0)
#define MLA_VN(n) do { if ((n) + 4 < 16) MLA_VRD((n) + 4 < 16 ? (n) + 4 : 15); } while (0)
#define MLA_STEP(C0, C1, P0, P1, t, MASK, GK, GN) do { MLA_SBAR(); \
    const LAS unsigned char* kr_ = kr0 + ks_cur * SHM_K; const LAS unsigned char* rr_ = rr0 + ks_cur * SHM_R; const LAS unsigned char* vp_ = vp0 + vs_rd * SHM_V; \
    i32x8q kf2, kf3, kf4, kf5; \
    float sa0 = P0[0], sa1 = P0[1]; \
    MLA_QMF(C0, kf0, 0, (f32x16{})); kf2 = MLA_KF(2); MLA_S2(P0, 2); MLA_S2(P0, 4); MLA_S2(P0, 6); MLA_PK4(P0, 0, pw0); MLA_PIN(pw0); MLA_PIN(sa0); MLA_PIN(sa1); MLA_SBAR(); \
    MLA_QMF(C1, kf1, 0, (f32x16{})); kf3 = MLA_KF(3); MLA_S2(P0, 8); MLA_S2(P0, 10); MLA_S2(P0, 12); MLA_S2(P0, 14); MLA_PK4(P0, 8, pw1); MLA_PIN(pw1); MLA_PIN(sa0); MLA_PIN(sa1); MLA_SBAR(); \
    if (GK) MLA_DMA_K(((t) + 3) * KVBLK, ks_n3); if (GN) MLA_DMA_V(((t) + 1) * KVBLK, vs_wr); MLA_SBAR();                          \
    MLA_QMF(C0, kf2, 1, C0); kf4 = MLA_KF(4); MLA_S2(P1, 0); MLA_S2(P1, 2); MLA_S2(P1, 4); MLA_S2(P1, 6); MLA_PK4(P1, 0, pw2); MLA_PIN(pw2); MLA_PIN(sa0); MLA_PIN(sa1); MLA_SBAR(); \
    MLA_QMF(C1, kf3, 1, C1); kf5 = MLA_KF(5); MLA_VRD(0); MLA_S2(P1, 8); MLA_S2(P1, 10); MLA_S2(P1, 12); MLA_S2(P1, 14); MLA_PK4(P1, 8, pw3); MLA_PIN(pw3); MLA_PIN(sa0); MLA_PIN(sa1); MLA_SBAR(); \
    MLA_QMF(C0, kf4, 2, C0); MLA_VRD(1); MLA_VRD(2); MLA_SBAR(); \
    MLA_QMF(C1, kf5, 2, C1); MLA_VRD(3); l_reg += sa0 + sa1; MLA_SBAR(); \
      \
    MLA_PV(0, 0); MLA_VN(0); MLA_SBAR(); \
    MLA_PV(1, 0); MLA_VN(1); if (MASK) mask_tile(C0, C1, qm - (t) * KVBLK); \
    float mx0 = C0[0]; _Pragma("unroll") for (int r_ = 1; r_ < 8; ++r_) mx0 = fmaxf(mx0, C0[r_]); MLA_SBAR(); \
    MLA_PV(2, 0); MLA_VN(2); _Pragma("unroll") for (int r_ = 8; r_ < 16; ++r_) mx0 = fmaxf(mx0, C0[r_]); MLA_SBAR(); \
    MLA_PV(3, 0); MLA_VN(3); _Pragma("unroll") for (int r_ = 0; r_ < 8; ++r_) mx0 = fmaxf(mx0, C1[r_]); MLA_SBAR(); \
    MLA_PV(4, 1); MLA_VN(4); _Pragma("unroll") for (int r_ = 8; r_ < 16; ++r_) mx0 = fmaxf(mx0, C1[r_]); \
    { auto rr_x = __builtin_amdgcn_permlane32_swap(__float_as_uint(mx0), __float_as_uint(mx0), false, false); mx0 = fmaxf(__uint_as_float(rr_x[0]), __uint_as_float(rr_x[1])); } \
    { const float rm = mx0 - mhat; resc = false;                                                                         \
      if (__builtin_expect(__any(rm > THR), 0)) { const float dl = fmaxf(rm, 0.f); mhat += dl;                           \
          const float f = __builtin_amdgcn_exp2f(-dl); l_reg *= f; if (hi == 0) al_l[r32] = f; resc = true; } }            \
    MLA_SBAR(); \
    MLA_PV(5, 1);  MLA_VN(5);  MLA_EX2(C0, 0);  MLA_EX2(C0, 2);  MLA_PIN(C0); MLA_SBAR(); \
    MLA_PV(6, 1);  MLA_VN(6);  MLA_EX2(C0, 4);  MLA_EX2(C0, 6);  MLA_PIN(C0); MLA_SBAR(); \
    MLA_PV(7, 1);  MLA_VN(7);  MLA_EX2(C0, 8);  MLA_EX2(C0, 10); MLA_PIN(C0); MLA_SBAR(); \
    MLA_PV(8, 2);  MLA_VN(8);  MLA_EX2(C0, 12); MLA_EX2(C0, 14); MLA_PIN(C0); MLA_SBAR(); \
    MLA_PV(9, 2);  MLA_VN(9);  MLA_EX2(C1, 0);  MLA_EX2(C1, 2);  MLA_PIN(C1); MLA_SBAR(); \
    MLA_PV(10, 2); MLA_VN(10); MLA_EX2(C1, 4);  MLA_PIN(C1); MLA_SBAR(); \
    MLA_PV(11, 2); MLA_VN(11); MLA_EX2(C1, 6);  MLA_PIN(C1); MLA_SBAR(); \
    MLA_ROT(); \
    MLA_PV(12, 3); MLA_EX2(C1, 8);  MLA_PIN(C1); if (GN) { const LAS unsigned char* kr_ = kr0 + ks_cur * SHM_K; const LAS unsigned char* rr_ = rr0 + ks_cur * SHM_R; kf0 = MLA_KF(0); } MLA_SBAR(); \
    MLA_PV(13, 3); MLA_EX2(C1, 10); MLA_PIN(C1); if (GN) { const LAS unsigned char* kr_ = kr0 + ks_cur * SHM_K; const LAS unsigned char* rr_ = rr0 + ks_cur * SHM_R; kf1 = MLA_KF(1); } MLA_SBAR(); \
    MLA_PV(14, 3); MLA_EX2(C1, 12); MLA_PIN(C1); MLA_SBAR(); \
    MLA_PV(15, 3); MLA_EX2(C1, 14); MLA_PIN(C1); MLA_SBAR(); \
    } while (0)
    int t = 1;
#pragma unroll 1
    for (; t + 5 < NT; t += 2) {
        MLA_STEP(pB0, pB1, pA0, pA1, t, false, true, true);     MLA_WAITBAR_C(); MLA_RESC();
        MLA_STEP(pA0, pA1, pB0, pB1, t + 1, false, true, true); MLA_WAITBAR_C(); MLA_RESC(); }
#pragma unroll 1
    for (; t + 1 < NT; t += 2) {
        MLA_STEP(pB0, pB1, pA0, pA1, t, true, (t + 3 < NT), true);     MLA_WAITBAR(); MLA_RESC();
        MLA_STEP(pA0, pA1, pB0, pB1, t + 1, true, (t + 4 < NT), true); MLA_WAITBAR(); MLA_RESC(); }
    MLA_STEP(pB0, pB1, pA0, pA1, NT - 1, true, false, false); MLA_WAITBAR(); MLA_RESC();
    { float sa0 = pB0[0], sa1 = pB0[1];
#pragma unroll
      for (int r = 2; r < 16; r += 2) MLA_S2(pB0, r);
#pragma unroll
      for (int r = 0; r < 16; r += 2) MLA_S2(pB1, r);
      l_reg += sa0 + sa1;
      MLA_PK4(pB0, 0, pw0); MLA_PK4(pB0, 8, pw1); MLA_PK4(pB1, 0, pw2); MLA_PK4(pB1, 8, pw3);
      const LAS unsigned char* vp_ = vp0 + vs_rd * SHM_V;
#pragma unroll
      for (int k = 0; k < 4; ++k) {
#pragma unroll
          for (int d0 = 0; d0 < 4; ++d0) { const s16x4 lo = vtr(vp_ + (d0 * 512 + k * 4096)), hh = vtr(vp_ + (d0 * 512 + k * 4096 + 2048));
              const bf16x8 vf = (bf16x8){lo[0], lo[1], lo[2], lo[3], hh[0], hh[1], hh[2], hh[3]};
              o[d0] = __builtin_amdgcn_mfma_f32_32x32x16_bf16(k == 0 ? MLA_PAF(0) : k == 1 ? MLA_PAF(1) : k == 2 ? MLA_PAF(2) : MLA_PAF(3), vf, o[d0], 0, 0, 0); } } }
    { auto rr = __builtin_amdgcn_permlane32_swap(__float_as_uint(l_reg), __float_as_uint(l_reg), false, false); l_reg = __uint_as_float(rr[0]) + __uint_as_float(rr[1]); }
    if (hi == 0) li_l[r32] = l_reg; asm volatile("s_waitcnt lgkmcnt(0)" ::: "memory");
    unsigned char* Ow = (unsigned char*)T.O + ((size_t)b * SEQ + qb * QB + wid * QBLK) * 2048 + h * 128;
    int hi_e = hi; asm volatile("" : "+v"(hi_e));
#pragma unroll
    for (int r = 0; r < 16; ++r) { const int orow = crow(r, hi_e); const float rl = __builtin_amdgcn_rcpf(li_l[orow]);
#pragma unroll
        for (int d0 = 0; d0 < 4; ++d0) { const float v = o[d0][r] * rl; const float v1 = dppf<0xB1>(v), v2 = dppf<0x4E>(v), v3 = dppf<0x1B>(v);
            if ((r32 & 3) == 0) *(GAS unsigned*)(Ow + (size_t)orow * 2048 + d0 * 32 + r32) = pkf8(v, v1, v2, v3); } }
    __syncthreads();
#undef MLA_DMA_V
#undef MLA_GLDS
#undef MLA_DMA_K
#undef MLA_WAITBAR
#undef MLA_WAITBAR_C
#undef MLA_PIN
#undef MLA_RESC
#undef MLA_QMF
#undef MLA_KF
#undef MLA_PK4
#undef MLA_S2
#undef MLA_EX2
#undef MLA_VRD
#undef MLA_VFR
#undef MLA_PAF
#undef MLA_GAPB
#undef MLA_STEP
#undef MLA_ROT
#undef MLA_MX
#undef MLA_PV
#undef MLA_VN
}
}

#if defined(DBG_CHECK)
#ifndef DBG_WORD
#define DBG_WORD 0
#endif
namespace chk {
__device__ __forceinline__ float bsum(float v, LAS float* red, int tid) { red[tid] = v; __syncthreads(); for (int o = 256; o > 0; o >>= 1) { if (tid < o) red[tid] += red[tid + o]; __syncthreads(); } const float r = red[0]; __syncthreads(); return r; }
__device__ __forceinline__ float bmax(float v, LAS float* red, int tid) { red[tid] = v; __syncthreads(); for (int o = 256; o > 0; o >>= 1) { if (tid < o) red[tid] = fmaxf(red[tid], red[tid + o]); __syncthreads(); } const float r = red[0]; __syncthreads(); return r; }
__device__ __forceinline__ float bf(const bf16* p) { return __uint_as_float((unsigned)(*p) << 16); }
__device__ __forceinline__ float hf(const bf16* p) { return (float)__builtin_bit_cast(_Float16, *p); }
__device__ __forceinline__ int sample_t(int smp) { const int k = smp >> 5; const int edge[16] = {0, 1, 31, 32, 63, 64, 255, 256, 257, 511, 512, 4095, 4096, 8190, 8191, 300}; return k < 1 ? edge[smp & 15] : (int)(((unsigned)smp * 2654435761u) >> 13) & 8191; }
__device__ __forceinline__ void amax(float* w, float v) { if (v == v) atomicMax((int*)w, __float_as_int(v)); else atomicMax((int*)w, 0x7f000000); }
__device__ __forceinline__ void mla(const bf16* QN, const bf16* QR, const bf16* KN, const bf16* KR, const bf16* VB, const bf16* O, int smp, LAS float* lg, LAS float* red, LAS float* q, float* dbg, int tid) {
    const int b = smp & 1, h = (smp >> 1) & 15, t = sample_t(smp); const size_t row = (size_t)b * SEQ + t;
    if (tid < 128) q[tid] = bf(QN + row * 2048 + h * 128 + tid); else if (tid < 192) q[tid] = bf(QR + row * 1024 + h * 64 + (tid - 128));
    __syncthreads();
    float mx = -1e30f;
    for (int s = tid; s <= t; s += 512) { const bf16* kn = KN + ((size_t)b * SEQ + s) * 2048 + h * 128; const bf16* kr = KR + ((size_t)b * SEQ + s) * 64; float d = 0.f;
        for (int i = 0; i < 128; ++i) d += q[i] * bf(kn + i); for (int i = 0; i < 64; ++i) d += q[128 + i] * bf(kr + i); lg[s] = d; mx = fmaxf(mx, d); }
    mx = bmax(mx, red, tid); float sm = 0.f;
    for (int s = tid; s <= t; s += 512) { const float p = exp2f(lg[s] - mx); lg[s] = p; sm += p; }
    sm = bsum(sm, red, tid);
    float o = 0.f;
    if (tid < 128) { for (int s = 0; s <= t; ++s) o += lg[s] * bf(VB + ((size_t)b * SEQ + s) * 2048 + h * 128 + tid); o /= sm; }
    const float rms = sqrtf(bsum(tid < 128 ? o * o : 0.f, red, tid) / 128.f) + 1e-20f;
    const float e = tid < 128 ? fabsf(o - bf(O + row * 2048 + h * 128 + tid)) / rms : 0.f;
    const float em = bmax(e, red, tid);
    if (tid == 0) amax(dbg + 0, em);
    __syncthreads();
}
template <bool TRUE_SC> __device__ __forceinline__ void dsa(const float* x, const float* w_in, const bf16* QI, const bf16* KI, const float* WI, const bf16* QA, const bf16* KA, const bf16* VA, const bf16* O, const unsigned short* SEL, int smp, LAS float* sc, LAS float* red, LAS float* aux, float* dbg, int tid) {
    const int b = smp & 1, t = sample_t(smp >> 1 << 1 | 0) ; const size_t row = (size_t)b * SEQ + t;
    LAS float* qi = aux;
    LAS unsigned* sel = (LAS unsigned*)(aux + 1024);
    LAS float* pr = aux + 2048;
    LAS unsigned* cnt = (LAS unsigned*)(aux + 2048 + 4096);
    LAS float* wt = aux + 2048 + 4096 + 64;
    if (TRUE_SC) {
        for (int i = tid; i < 1024 + 16; i += 512) { const int c = i < 1024 ? U_QI + i : U_WI + (i - 1024); float d = 0.f; for (int k = 0; k < 2048; ++k) d += x[row * 2048 + k] * w_in[(size_t)k * DIN + c]; if (i < 1024) qi[i] = d; else wt[i - 1024] = d; }
        __syncthreads();
        for (int s = tid; s <= t; s += 512) { float kk[64];
#pragma unroll
            for (int c = 0; c < 64; ++c) kk[c] = 0.f;
            const float* xs = x + ((size_t)b * SEQ + s) * 2048;
            for (int k = 0; k < 2048; ++k) { const float xv = xs[k]; const float* wr = w_in + (size_t)k * DIN + U_KI;
#pragma unroll
                for (int c = 0; c < 64; ++c) kk[c] += xv * wr[c]; }
            float tot = 0.f;
#pragma unroll
            for (int hh = 0; hh < 16; ++hh) { float d = 0.f;
#pragma unroll
                for (int i = 0; i < 64; ++i) d += qi[hh * 64 + i] * kk[i];
                tot += wt[hh] * fmaxf(d, 0.f); }
            sc[s] = tot; }
    } else {
    for (int i = tid; i < 1024; i += 512) qi[i] = hf(QI + row * 1024 + i);
    __syncthreads();
    for (int s = tid; s <= t; s += 512) { const bf16* k = KI + ((size_t)b * SEQ + s) * 64; float tot = 0.f;
        for (int hh = 0; hh < 16; ++hh) { float d = 0.f; for (int i = 0; i < 64; ++i) d += qi[hh * 64 + i] * hf(k + i); tot += WI[row * 16 + hh] * fmaxf(d, 0.f); }
        sc[s] = tot; }
    }
    __syncthreads();
    const int n = t + 1, want = n < 256 ? n : 256;
    unsigned T = 0u;
    for (int bit = 31; bit >= 0; --bit) { const unsigned cand = T | (1u << bit); if (tid == 0) cnt[0] = 0u; __syncthreads(); unsigned c = 0u;
        for (int s = tid; s <= t; s += 512) c += (dsa::fkey(sc[s]) >= cand) ? 1u : 0u;
        if (c) atomicAdd((unsigned*)cnt, c); __syncthreads(); if (cnt[0] >= (unsigned)want) T = cand; __syncthreads(); }
    if (tid == 0) { cnt[0] = 0u; cnt[1] = 0u; } __syncthreads();
    { unsigned c = 0u; for (int s = tid; s <= t; s += 512) c += (dsa::fkey(sc[s]) > T) ? 1u : 0u; if (c) atomicAdd((unsigned*)cnt + 1, c); }
    __syncthreads();
    const unsigned cgt = cnt[1]; __syncthreads(); if (tid == 0) cnt[1] = 0u;
    for (int s = tid; s <= t; s += 512) { const unsigned ky = dsa::fkey(sc[s]); bool take = ky > T;
        if (ky == T) { unsigned rk = 0u; for (int s2 = 0; s2 < s; ++s2) rk += (dsa::fkey(sc[s2]) == T) ? 1u : 0u; take = cgt + rk < (unsigned)want; }
        if (take) { const unsigned p = atomicAdd((unsigned*)cnt, 1u); if (p < 256u) sel[p] = (unsigned)s; } }
    __syncthreads();
    const int nref = (int)(cnt[0] < 256u ? cnt[0] : 256u);
    if (tid < 256) sel[256 + tid] = SEL[row * 256 + tid];
    __syncthreads();
    { float miss = 0.f; if (tid < 256) { const unsigned s = sel[256 + tid]; if (s != 0xFFFFu) { bool found = false; for (int j = 0; j < nref; ++j) found |= (sel[j] == s); miss = found ? 0.f : 1.f; } }
      const float tm = bsum(miss, red, tid); if (tid == 0) { amax(dbg + 1, tm / (float)want); atomicAdd(dbg + 13, tm); } }
    for (int pass = 0; pass < 2; ++pass) {
        const int ns = pass == 0 ? nref : 256; LAS unsigned* sl = sel + pass * 256;
        for (int e = tid; e < 16 * 256; e += 512) { const int hh = e >> 8, j = e & 255; float v = -1e30f;
            if (j < ns && sl[j] != 0xFFFFu) { const unsigned s = sl[j]; const bf16* k = KA + ((size_t)b * SEQ + s) * 128; float d = 0.f; for (int i = 0; i < 128; ++i) d += bf(QA + row * 2048 + hh * 128 + i) * bf(k + i);
                v = d - exp2f(-0.5f * (float)(hh + 1)) * LOG2E * (float)(t - (int)s); }
            pr[e] = v; }
        __syncthreads();
        if (tid < 16) { float mx = -1e30f; for (int j = 0; j < 256; ++j) mx = fmaxf(mx, pr[tid * 256 + j]); float sm = 0.f; for (int j = 0; j < 256; ++j) { const float p = pr[tid * 256 + j] <= -1e29f ? 0.f : exp2f(pr[tid * 256 + j] - mx); pr[tid * 256 + j] = p; sm += p; }
            for (int j = 0; j < 256; ++j) pr[tid * 256 + j] /= sm; }
        __syncthreads();
        float e4 = 0.f, q4 = 0.f, s4 = 0.f;
        for (int e = tid; e < 2048; e += 512) { const int hh = e >> 7, d = e & 127; float o = 0.f;
            for (int j = 0; j < ns; ++j) { const unsigned s = sl[j]; if (s != 0xFFFFu) o += pr[hh * 256 + j] * bf(VA + ((size_t)b * SEQ + s) * 128 + d); }
            q4 += o * o; const float df = o - bf(O + row * 2048 + e); e4 = fmaxf(e4, fabsf(df)); s4 += df * df; }
        const float rms = sqrtf(bsum(q4, red, tid) / 2048.f) + 1e-20f; const float em = bmax(e4, red, tid); const float esq = bsum(s4, red, tid);
        if (tid == 0) { amax(dbg + (pass == 0 ? 0 : 2), em / rms); if (pass == 0) atomicAdd(dbg + 14, esq / (rms * rms * 2048.f)); }
        __syncthreads();
    }
}
__device__ __forceinline__ void p1(const float* x, const float* w_in, const bf16* QA, const bf16* QI, const bf16* KA, const bf16* VA, const bf16* KI, const float* WI, const bf16* CQ, const bf16* CKV, const bf16* KR, int smp, LAS float* xr, LAS float* red, LAS float* tru, float* dbg, int tid) {
    const size_t row = (size_t)(((unsigned)smp * 2654435761u) >> 9) % M; const int pos = (int)(row & (SEQ - 1));
    for (int i = tid; i < 2048; i += 512) xr[i] = x[row * 2048 + i];
    __syncthreads();
    for (int c = tid; c < U_G; c += 512) { float d = 0.f; for (int k = 0; k < 2048; ++k) d += xr[k] * w_in[(size_t)k * DIN + c]; tru[c] = d; }
    __syncthreads();
    for (int ty = 0; ty < 9; ++ty) {
        const int c0 = ty == 0 ? U_QA : ty == 1 ? U_QI : ty == 2 ? U_KA : ty == 3 ? U_VA : ty == 4 ? U_KI : ty == 5 ? U_WI : ty == 6 ? U_CQ : ty == 7 ? U_CKV : U_KPE;
        const int nc = ty == 0 ? 2048 : ty == 1 ? 1024 : ty == 2 ? 128 : ty == 3 ? 128 : ty == 4 ? 64 : ty == 5 ? 16 : ty == 6 ? 512 : ty == 7 ? 512 : 64;
        float q = 0.f, e = 0.f;
        for (int c = tid; c < nc; c += 512) { float tv = tru[c0 + c], sv;
            if (ty == 0) { tv *= QA_SCALE; sv = bf(QA + row * 2048 + c); } else if (ty == 1) sv = hf(QI + row * 1024 + c); else if (ty == 2) sv = bf(KA + row * 128 + c); else if (ty == 3) sv = bf(VA + row * 128 + c);
            else if (ty == 4) sv = hf(KI + row * 64 + c); else if (ty == 5) sv = WI[row * 16 + c]; else if (ty == 6) sv = bf(CQ + row * 512 + c); else if (ty == 7) sv = bf(CKV + row * 512 + c);
            else { const int i = c & 31; const float ang = (float)pos * exp2f(-(float)i * (13.287712379549449f / 32.f)), cs = cosf(ang), sn = sinf(ang); const float x1 = tru[c0 + i], x2 = tru[c0 + 32 + i]; tv = c < 32 ? x1 * cs - x2 * sn : x1 * sn + x2 * cs; sv = bf(KR + row * 64 + c); }
            q += tv * tv; e = fmaxf(e, fabsf(tv - sv)); }
        const float rms = sqrtf(bsum(q, red, tid) / (float)nc) + 1e-20f; const float em = bmax(e, red, tid) / rms;
        if (tid == 0) { amax(dbg + 3 + ty, em); amax(dbg + 12, em); }
        __syncthreads();
    }
}
__device__ __forceinline__ void p2(const bf16* CQ, const bf16* CKV, const float* gq, const float* gkv, const float* w_uq, const float* w_uk, const float* w_uv, const bf16* QN, const bf16* QR, const bf16* KN, const bf16* VB,
                                   int smp, LAS float* cr, LAS float* red, LAS float* tru, float* dbg, int tid) {
    const size_t row = (size_t)(((unsigned)smp * 2654435761u) >> 9) % M; const int pos = (int)(row & (SEQ - 1));
    for (int i = tid; i < 1024; i += 512) cr[i] = i < 512 ? bf(CQ + row * 512 + i) : bf(CKV + row * 512 + (i - 512));
    __syncthreads();
    const float ssq = bsum(cr[tid] * cr[tid], red, tid), ssk = bsum(cr[512 + tid] * cr[512 + tid], red, tid);
    const float rq = 1.f / sqrtf(ssq / 512.f + RMS_EPS), rk = 1.f / sqrtf(ssk / 512.f + RMS_EPS);
    for (int n = tid; n < 3072 + 4096; n += 512) { float d = 0.f;
        if (n < 3072) { for (int k = 0; k < 512; ++k) d += cr[k] * gq[k] * w_uq[(size_t)k * 3072 + n]; d *= rq * QB_SCALE; }
        else if (n < 3072 + 2048) { for (int k = 0; k < 512; ++k) d += cr[512 + k] * gkv[k] * w_uk[(size_t)k * 2048 + (n - 3072)]; d *= rk; }
        else { for (int k = 0; k < 512; ++k) d += cr[512 + k] * gkv[k] * w_uv[(size_t)k * 2048 + (n - 5120)]; d *= rk; }
        tru[n] = d; }
    __syncthreads();
    float q = 0.f, e = 0.f;
    for (int n = tid; n < 2048; n += 512) { const int h = n >> 7, d = n & 127; const float tv = tru[h * 192 + d]; q += tv * tv; e = fmaxf(e, fabsf(tv - bf(QN + row * 2048 + n))); }
    { const float rms = sqrtf(bsum(q, red, tid) / 2048.f) + 1e-20f; const float em = bmax(e, red, tid) / rms; if (tid == 0) { amax(dbg + 0, em); amax(dbg + 1, em); } }
    q = 0.f; e = 0.f;
    for (int n = tid; n < 1024; n += 512) { const int h = n >> 6, c = n & 63, i = c & 31; const float ang = (float)pos * exp2f(-(float)i * (13.287712379549449f / 32.f)), cs = cosf(ang), sn = sinf(ang);
        const float x1 = tru[h * 192 + 128 + i], x2 = tru[h * 192 + 160 + i], tv = c < 32 ? x1 * cs - x2 * sn : x1 * sn + x2 * cs; q += tv * tv; e = fmaxf(e, fabsf(tv - bf(QR + row * 1024 + n))); }
    { const float rms = sqrtf(bsum(q, red, tid) / 1024.f) + 1e-20f; const float em = bmax(e, red, tid) / rms; if (tid == 0) { amax(dbg + 0, em); amax(dbg + 2, em); } }
    q = 0.f; e = 0.f;
    for (int n = tid; n < 2048; n += 512) { const float tv = tru[3072 + n]; q += tv * tv; e = fmaxf(e, fabsf(tv - bf(KN + row * 2048 + n))); }
    { const float rms = sqrtf(bsum(q, red, tid) / 2048.f) + 1e-20f; const float em = bmax(e, red, tid) / rms; if (tid == 0) { amax(dbg + 0, em); amax(dbg + 3, em); } }
    q = 0.f; e = 0.f;
    for (int n = tid; n < 2048; n += 512) { const float tv = tru[5120 + n]; q += tv * tv; e = fmaxf(e, fabsf(tv - bf(VB + row * 2048 + n))); }
    { const float rms = sqrtf(bsum(q, red, tid) / 2048.f) + 1e-20f; const float em = bmax(e, red, tid) / rms; if (tid == 0) { amax(dbg + 0, em); amax(dbg + 4, em); } }
    __syncthreads();
}
__device__ __forceinline__ void gchk(const float* x, const float* w_in, const bf16* GS, const bf16* XHS, size_t row, LAS float* xr, LAS float* red, float* dbg, int tid) {
    for (int i = tid; i < 2048; i += 512) xr[i] = x[row * 2048 + i];
    __syncthreads();
    float eg = 0.f;
    for (int c = tid; c < 4096; c += 512) { float l0 = 0.f; for (int k = 0; k < 2048; ++k) l0 += xr[k] * w_in[(size_t)k * DIN + U_G + c]; eg = fmaxf(eg, fabsf(1.f / (1.f + expf(-l0)) - bf(GS + row * 4096 + c))); }
    const float egm = bmax(eg, red, tid);
    float ex = 0.f; for (int i = tid; i < 2048; i += 512) ex = fmaxf(ex, fabsf(xr[i] - hf(XHS + row * 2048 + i))); const float exm = bmax(ex, red, tid);
    int nb = 0; for (int c = tid; c < 4096; c += 512) { float l0 = 0.f; for (int k = 0; k < 2048; ++k) l0 += xr[k] * w_in[(size_t)k * DIN + U_G + c]; nb += fabsf(1.f / (1.f + expf(-l0)) - bf(GS + row * 4096 + c)) > 0.05f ? 1 : 0; }
    const float nbt = bsum((float)nb, red, tid);
    if (tid == 0) { amax(dbg + 0, egm); if (egm > 0.05f) { atomicAdd(dbg + 1, 1.0f); amax(dbg + 3, nbt); amax(dbg + 4, 4097.f - nbt); } amax(dbg + 2, exm); }
    __syncthreads();
}
__device__ __forceinline__ void mid(const float* x, const float* w_in, const float* wa, const float* wb, const float* wo, const bf16* AA, const bf16* AB, const bf16* GS, const bf16* MTS, const float* Z, size_t row, int vtag, LAS float* va, LAS float* red, LAS float* mg, float* dbg, int tid) {
    LAS float* vb = va + 2048; LAS float* xr = va + 4096;
    for (int i = tid; i < 2048; i += 512) { va[i] = bf(AA + row * 2048 + i); vb[i] = bf(AB + row * 2048 + i); xr[i] = x[row * 2048 + i]; }
    __syncthreads();
    float eg = 0.f, qm = 0.f, emt = 0.f; int cmx = -1, cmn = 1 << 20;
    for (int c = tid; c < 2048; c += 512) { float l0 = 0.f, l1 = 0.f, ma = 0.f, mb = 0.f;
        for (int k = 0; k < 2048; ++k) { const float xv = xr[k]; l0 += xv * w_in[(size_t)k * DIN + U_G + c]; l1 += xv * w_in[(size_t)k * DIN + U_G + 2048 + c]; ma += va[k] * wa[(size_t)k * 2048 + c]; mb += vb[k] * wb[(size_t)k * 2048 + c]; }
        const float g0 = 1.f / (1.f + expf(-l0)), g1 = 1.f / (1.f + expf(-l1)); mg[c] = ma * g0 + mb * g1;
        { const float e0 = fabsf(g0 - bf(GS + row * 4096 + c)), e1 = fabsf(g1 - bf(GS + row * 4096 + 2048 + c)); eg = fmaxf(eg, fmaxf(e0, e1)); if (e0 > 0.05f) { cmx = max(cmx, c); cmn = min(cmn, c); } if (e1 > 0.05f) { cmx = max(cmx, 2048 + c); cmn = min(cmn, 2048 + c); } } qm += mg[c] * mg[c]; emt = fmaxf(emt, fabsf(mg[c] - bf(MTS + row * 2048 + c))); }
    { const float egm = bmax(eg, red, tid); const float rm = sqrtf(bsum(qm, red, tid) / 2048.f) + 1e-20f; const float emm = bmax(emt, red, tid) / rm; if (tid == 0) { amax(dbg + 17, egm); amax(dbg + 18, emm); if (egm > 0.05f) { amax(dbg + 19, (float)(row & 255) + 1.0f); amax(dbg + 20, (float)(255 - (row & 255)) + 1.0f); atomicAdd(dbg + 21, 1.0f); amax(dbg + 22, (float)vtag + 1.0f); amax(dbg + 23, (float)(255 - vtag) + 1.0f); } }
      const float fx = bmax((float)cmx, red, tid), fn = bmax((float)(4096 - cmn), red, tid); if (tid == 0 && fx >= 0.f) { amax(dbg + 24, fx + 1.0f); amax(dbg + 25, fn + 1.0f); } }
    __syncthreads();
    float q = 0.f, e = 0.f;
    for (int c = tid; c < 2048; c += 512) { float d = 0.f; for (int k = 0; k < 2048; ++k) d += mg[k] * wo[(size_t)k * 2048 + c]; q += d * d; e = fmaxf(e, fabsf(ALPHA * xr[c] + d - Z[row * 2048 + c])); }
    const float rms = sqrtf(bsum(q, red, tid) / 2048.f) + 1e-20f; const float em = bmax(e, red, tid) / rms;
    if (tid == 0) { amax(dbg + 0, em); if (em > 0.25f) { atomicAdd(dbg + 13, 1.0f); amax(dbg + 15, (float)(row & 255) + 1.0f); amax(dbg + 16, (float)(row >> 8) + 1.0f); } }
    __syncthreads();
}
__device__ __forceinline__ void endp(const bf16* X1B, const float* x1f_unused, const float* p, const float* w_up, const float* cw, const float* cb, const float* w_down, const float* w_pg, const float* b_pg, const float* w_pe, const float* g2, const float* b2,
                                     const float* OUT, int smp, LAS float* xs, LAS float* red, LAS float* act, float* dbg, int tid) {
    const int k6 = smp & 7; const size_t rbase = (size_t)(((unsigned)smp * 2654435761u) >> 9) % M; const size_t row = k6 == 0 ? (rbase & ~(size_t)63) : k6 == 1 ? (rbase & ~(size_t)63) + 1 : k6 == 2 ? (rbase & ~(size_t)8191) : rbase; const int t = (int)(row & (SEQ - 1));
    LAS float* z = act + 5632; LAS float* pr = act + 5632 + 2048;
    for (int i = tid; i < 3 * 2048; i += 512) { const int j = i >> 11, c = i & 2047; const int tt = t - 2 + j; xs[i] = tt >= 0 ? bf(X1B + (row - 2 + j) * 2048 + c) : 0.f; }
    for (int i = tid; i < 256; i += 512) pr[i] = p[row * 256 + i];
    __syncthreads();
    for (int ch = tid; ch < DFF; ch += 512) { float hg[3] = {0.f, 0.f, 0.f}, hv[3] = {0.f, 0.f, 0.f};
        for (int k = 0; k < 2048; ++k) { const float wg = w_up[(size_t)k * NUP + ch], wv = w_up[(size_t)k * NUP + DFF + ch];
#pragma unroll
            for (int j = 0; j < 3; ++j) { hg[j] += xs[j * 2048 + k] * wg; hv[j] += xs[j * 2048 + k] * wv; } }
        float yg = cb[ch], yv = cb[DFF + ch];
#pragma unroll
        for (int j = 0; j < 3; ++j) { yg += cw[(size_t)j * NUP + ch] * hg[j]; yv += cw[(size_t)j * NUP + DFF + ch] * hv[j]; }
        act[ch] = yg / (1.f + expf(-yg)) * yv; }
    __syncthreads();
    for (int c = tid; c < 2048; c += 512) { float f = 0.f, lg = b_pg[c], pe = 0.f;
        for (int k = 0; k < DFF; ++k) f += act[k] * w_down[(size_t)k * 2048 + c];
        for (int k = 0; k < 2048; ++k) lg += xs[2 * 2048 + k] * w_pg[(size_t)k * 2048 + c];
        for (int k = 0; k < 256; ++k) pe += pr[k] * w_pe[(size_t)k * 2048 + c];
        z[c] = ALPHA * xs[2 * 2048 + c] + f + pe / (1.f + expf(-lg)); }
    __syncthreads();
    float s = 0.f; for (int c = tid; c < 2048; c += 512) s += z[c];
    const float mean = bsum(s, red, tid) / 2048.f; float s2 = 0.f; for (int c = tid; c < 2048; c += 512) s2 += (z[c] - mean) * (z[c] - mean);
    const float rstd = 1.f / sqrtf(bsum(s2, red, tid) / 2048.f + LN_EPS); float e = 0.f;
    for (int c = tid; c < 2048; c += 512) e = fmaxf(e, fabsf((z[c] - mean) * rstd * g2[c] + b2[c] - OUT[row * 2048 + c]));
    const float em = bmax(e, red, tid);
    if (tid == 0) { amax(dbg + 0, em); amax(dbg + 1 + (k6 < 3 ? k6 : 3), em); }
    __syncthreads();
}
}
#endif

__device__ __forceinline__ int own_panel(int x, int s) { return s < 4 ? x + 8 * s : 32 + (7 - x) + 8 * (s - 4); }
__device__ __forceinline__ void ln_pass(const bf16* zin, float* fout, bf16* bout, unsigned char* xf8, const float* g, const float* b, int vcu, int wave, int lane) {
#pragma unroll 1
    for (int s_ = 0; s_ < 8; ++s_) { const int m = 256 * own_panel(vcu >> 5, s_) + 8 * (vcu & 31) + wave;
        const GAS v4u* zr = (const GAS v4u*)(zin + (size_t)m * DM) + lane;
        f32x4 v[8]; float s = 0.f;
#pragma unroll
        for (int j = 0; j < 4; ++j) { unpack8(zr[64 * j], v[2 * j], v[2 * j + 1]); s += ((v[2 * j][0] + v[2 * j][1]) + (v[2 * j][2] + v[2 * j][3])) + ((v[2 * j + 1][0] + v[2 * j + 1][1]) + (v[2 * j + 1][2] + v[2 * j + 1][3])); }
        const float mean = wave_sum(s) * (1.f / DM); float s2 = 0.f;
#pragma unroll
        for (int j = 0; j < 8; ++j) { v[j] = v[j] - mean; s2 += (v[j][0] * v[j][0] + v[j][1] * v[j][1]) + (v[j][2] * v[j][2] + v[j][3] * v[j][3]); }
        const float rstd = 1.f / sqrtf(wave_sum(s2) * (1.f / DM) + LN_EPS);
#pragma unroll
        for (int j = 0; j < 4; ++j) { const int e0 = 8 * (lane + 64 * j);
            const f32x4 g0 = *(const GAS f32x4*)(g + e0), g1 = *(const GAS f32x4*)(g + e0 + 4), b0 = *(const GAS f32x4*)(b + e0), b1 = *(const GAS f32x4*)(b + e0 + 4);
            const f32x4 y0 = v[2 * j] * rstd * g0 + b0, y1 = v[2 * j + 1] * rstd * g1 + b1;
            if (fout) { *(GAS f32x4*)(fout + (size_t)m * DM + e0) = y0; *(GAS f32x4*)(fout + (size_t)m * DM + e0 + 4) = y1; }
            if (bout) *(GAS v4u*)(bout + (size_t)m * DM + e0) = pack8(y0, y1);
            if (xf8) { u32x2 w; w.x = pkf8(y0[0], y0[1], y0[2], y0[3]); w.y = pkf8(y1[0], y1[1], y1[2], y1[3]); *(GAS u32x2*)(xf8 + (size_t)m * DM + e0) = w; } }
    }
}
__device__ __forceinline__ void conv_fixup(unsigned char* ACT, const float* HEADB, const float* TAILB, const float* cw, const float* cb, int vcu, int tid) {
    constexpr int CH8 = DFF / 8;
    for (int it = (vcu & 31) * 512 + tid; it < 8 * 4 * 2 * CH8; it += 32 * 512) {
        const int c8 = it % CH8, rr = (it / CH8) & 1, g4 = (it / (2 * CH8)) & 3, s_ = it / (8 * CH8); const int g = own_panel(vcu >> 5, s_) * 4 + g4;
        const int ch = 8 * c8, pg = 256 * (ch >> 7) + (ch & 127); const bool first = (g & 127) == 0;
        f32x4 res[2][2];
#pragma unroll
        for (int bj = 0; bj < 2; ++bj) { const int pc = pg + bj * 128, c = ch + bj * DFF;
#pragma unroll
            for (int n = 0; n < 2; ++n) { const f32x4 z = (f32x4){0.f, 0.f, 0.f, 0.f};
                const f32x4 u0 = *(const GAS f32x4*)(HEADB + ((size_t)g * 2 + rr) * NUP + pc + 4 * n);
                const f32x4 t1 = first ? z : *(const GAS f32x4*)(TAILB + ((size_t)(g - 1) * 2 + 1) * NUP + pc + 4 * n);
                const f32x4 t0 = first ? z : *(const GAS f32x4*)(TAILB + ((size_t)(g - 1) * 2 + 0) * NUP + pc + 4 * n);
                const f32x4 h0 = *(const GAS f32x4*)(HEADB + ((size_t)g * 2 + 0) * NUP + pc + 4 * n);
                const f32x4 u1 = rr ? h0 : t1, u2 = rr ? t1 : t0;
                const f32x4 w0 = *(const GAS f32x4*)(cw + c + 4 * n), w1 = *(const GAS f32x4*)(cw + NUP + c + 4 * n), w2 = *(const GAS f32x4*)(cw + 2 * NUP + c + 4 * n), bb = *(const GAS f32x4*)(cb + c + 4 * n);
                res[bj][n] = bb + w2 * u0 + w1 * u1 + w0 * u2; } }
        const f32x4 a0 = res[0][0] * sigmoid4(res[0][0]) * res[1][0], a1 = res[0][1] * sigmoid4(res[0][1]) * res[1][1];
        { u32x2 w; w.x = pkf8(a0[0], a0[1], a0[2], a0[3]); w.y = pkf8(a1[0], a1[1], a1[2], a1[3]); *(GAS u32x2*)(ACT + ((size_t)g * 64 + rr) * DFF + ch) = w; }
    }
}

struct Args { const float* in[22]; float* out; unsigned char* ws; };
#define GEMM_PHASE_LC(EPI, A_, B_, N_, K_, E_, DT_, WS_, LDA_, C_) do { int kk_ = (K_); asm volatile("" : "+s"(kk_)); pg8::Gemm g_{(const pg8::bf16_t*)(A_), (const pg8::bf16_t*)(B_), M, (N_), kk_, (WS_), (LDA_)}; pg8::StaticOrder S_; S_.init(M, (N_), G, (C_)); \
        pg8::gemm_phase<EPI, pg8::StaticOrder, true, true, DT_>(lds, g_, S_, (E_)); } while (0)
#define GEMM_PHASE_L(EPI, A_, B_, N_, K_, E_, DT_, WS_, LDA_) do { int kk_ = (K_); asm volatile("" : "+s"(kk_)); pg8::Gemm g_{(const pg8::bf16_t*)(A_), (const pg8::bf16_t*)(B_), M, (N_), kk_, (WS_), (LDA_)}; pg8::StaticOrder S_; S_.init(M, (N_), G, bx); \
        pg8::gemm_phase<EPI, pg8::StaticOrder, true, true, DT_>(lds, g_, S_, (E_)); } while (0)
#define GEMM_PHASE_X(EPI, A_, B_, N_, K_, E_, DT_, WS_) GEMM_PHASE_L(EPI, A_, B_, N_, K_, E_, DT_, WS_, 0)
#define GEMM_PHASE_T(EPI, A_, B_, N_, K_, E_, F16_) GEMM_PHASE_X(EPI, A_, B_, N_, K_, E_, ((F16_) ? 1 : 0), 127)
#define GEMM_PHASE(EPI, A_, B_, N_, K_, E_) GEMM_PHASE_X(EPI, A_, B_, N_, K_, E_, 0, 127)

__global__ void __launch_bounds__(NWAVES * 64, 2) fwd_kernel(Args args) {
    extern __shared__ __attribute__((aligned(16))) unsigned char lds_raw[];
    LAS unsigned char* lds = (LAS unsigned char*)lds_raw;
    volatile LAS unsigned* MISC = (volatile LAS unsigned*)(lds + MISC_OFF);
    const int tid0 = threadIdx.x, wave = __builtin_amdgcn_readfirstlane(tid0 >> 6);
#define TID() ({ int t_ = threadIdx.x; asm volatile("" : "+v"(t_)); t_; })
#define LANE() (TID() & 63)
#define GT() ((size_t)bx * (NWAVES * 64) + TID())
    for (int u = threadIdx.x; u < (LDS_BYTES - LDSCTL_OFF) / 4; u += NWAVES * 64) ((LAS unsigned*)(lds + LDSCTL_OFF))[u] = 0u;
    __syncthreads();
    if (threadIdx.x == 0) { const unsigned xcc = xb_xcc_id() & 7u; const unsigned rk = __hip_atomic_fetch_add((gu32*)(args.ws + WS_CTL) + CW_RANK + 64 * xcc, 1u, RLX_AGENT); MISC[12] = (rk & 31u) * 8u + xcc; }
    __syncthreads();
    const int G = gridDim.x, bx = __builtin_amdgcn_readfirstlane((int)MISC[12]), vcu = (bx % 8) * (G / 8) + bx / 8;
    const int gw = vcu * NWAVES + wave, NGW = G * NWAVES; const size_t NT = (size_t)G * NWAVES * 64;
#define WSP(T_, off_) ((T_*)(wsb() + (off_)))
#define INP(k_) inb(k_)
#define DOP(T_, off_) ((T_*)((unsigned char*)outb() + (off_)))
    auto wsb = [&]() __attribute__((always_inline)) { unsigned char* w_ = args.ws; asm volatile("" : "+s"(w_)); return w_; };
    auto inb = [&](int k_) __attribute__((always_inline)) { const float* p_ = args.in[k_]; asm volatile("" : "+s"(p_)); return p_; };
    auto outb = [&]() __attribute__((always_inline)) { float* p_ = args.out; asm volatile("" : "+s"(p_)); return p_; };

    XcdBarrier bar = xcd_barrier_post((unsigned*)((gu32*)(args.ws + WS_CTL) + CW_BAR), MISC + 8);
#if defined(DBG_CKPT)
#define CKPT(id_, lo_, hi_) do { if (DBG_CKPT == (id_)) { unsigned* cw_ = WSP(unsigned, WS_CTL) + 200100; const unsigned* p_ = (const unsigned*)(wsb() + (size_t)(lo_) * MiB); unsigned c_ = 0u; \
        for (size_t i = GT(); i < (size_t)((hi_) - (lo_)) * MiB / 4; i += NT) c_ += p_[i] * 2654435761u + (unsigned)i; \
        c_ += __shfl_xor(c_, 32); c_ += __shfl_xor(c_, 16); c_ += __shfl_xor(c_, 8); c_ += __shfl_xor(c_, 4); c_ += __shfl_xor(c_, 2); c_ += __shfl_xor(c_, 1); \
        if ((TID() & 63) == 0) atomicAdd(cw_, c_); xcd_barrier(bar); \
        const float X = (float)(__hip_atomic_load(cw_, RLX_AGENT) & 0xFFFFFFu) + 1.0f; float* o_ = outb(); \
        for (size_t i = GT(); i < (size_t)M * DM / 4; i += NT) *((GAS f32x4*)o_ + i) = (f32x4){X, X, X, X}; return; } } while (0)
#else
#define CKPT(id_, lo_, hi_) do { } while (0)
#endif
#if defined(DBG_SPIN)
#define STAMP(i_) do { if (threadIdx.x == 0) { const unsigned long long t_ = __builtin_amdgcn_s_memrealtime(); MISC[16 + 2 * (i_)] = (unsigned)t_; MISC[17 + 2 * (i_)] = (unsigned)(t_ >> 32); const unsigned long long c_ = __builtin_amdgcn_s_memtime(); MISC[100 + 2 * (i_)] = (unsigned)c_; MISC[101 + 2 * (i_)] = (unsigned)(c_ >> 32); } } while (0)
#else
#define STAMP(i_) do { } while (0)
#endif
#define SCR() ((LAS float*)(lds + RING_OFF + wave * TR_LDS))
#define SSQP() ((float*)(wsb() + WS_CTL + MiB))

#if defined(DBG_CHECK)
#define DBG_OA ((DBG_CHECK == 1 || DBG_CHECK == 4) ? WS_XB : WS_QA)
#define DBG_OB (DBG_CHECK == 2 ? WS_XB : WS_QN)
#define DBG_SEL ((DBG_CHECK == 1 || DBG_CHECK == 4) ? (unsigned short*)(wsb() + WS_END) : (unsigned short*)nullptr)
#else
#define DBG_OA WS_QA
#define DBG_OB WS_QN
#define DBG_SEL ((unsigned short*)nullptr)
#endif
#ifndef ONLY
#define ONLY -1
#endif
#ifndef SKIPMASK
#define SKIPMASK 0
#endif
#define PH(k) ((ONLY < 0 || ONLY == (k)) && !((SKIPMASK >> (k)) & 1))
    STAMP(0);
    if (PH(0)) {
    { const TrIn I{INP(2), INP(3), INP(4), INP(5), INP(6), INP(7), INP(8), INP(9), INP(10), INP(13), INP(16), INP(17), INP(19)}; tr_all(I, wsb(), SCR(), gw, NGW, LANE()); }
    cvt_flat_h(INP(0), WSP(bf16, WS_XB), WSP(unsigned char, WS_XF8), (size_t)M * DM / 8, GT(), NT);
    cvt_flat(INP(1), WSP(bf16, WS_PB), (size_t)M * PLE_DIM / 8, GT(), NT);
    { float* ROPE = WSP(float, WS_ROPE);
    for (size_t i = GT(); i < (size_t)SEQ * 32; i += NT) { const int pos = (int)(i >> 5), j = (int)(i & 31);
        const double f = exp2(-(double)j * (13.287712379549449 / 32.0)), turns = (double)pos * f * 0.15915494309189535, fr = turns - floor(turns);
        ROPE[i] = __builtin_amdgcn_cosf((float)fr); ROPE[(size_t)SEQ * 32 + i] = __builtin_amdgcn_sinf((float)fr); } }
    }
    xcd_barrier(bar);

    STAMP(1);
    if (PH(1)) { EpiU<1> E{WSP(bf16, WS_QA), DOP(bf16, DO_QI), DOP(bf16, DO_KA), DOP(bf16, DO_VA), DOP(bf16, DO_KI), DOP(bf16, DO_KR), DOP(bf16, DO_CQ), DOP(bf16, DO_CKV), DOP(float, DO_WI), SSQP(), WSP(float, WS_ROPE)};
        GEMM_PHASE_X(EpiU<1>, WSP(bf16, WS_XF8), WSP(bf16, WS_WIN8), NU8, 1024, E, 2, 127 - 6); }
    if (PH(1)) { EpiU<2> E{WSP(bf16, WS_QA), DOP(bf16, DO_QI), DOP(bf16, DO_KA), DOP(bf16, DO_VA), DOP(bf16, DO_KI), DOP(bf16, DO_KR), DOP(bf16, DO_CQ), DOP(bf16, DO_CKV), DOP(float, DO_WI), SSQP(), WSP(float, WS_ROPE)};
        GEMM_PHASE_LC(EpiU<2>, WSP(bf16, WS_XB), WSP(bf16, WS_WIN), NU16, 2048, E, 1, 127, 0, (bx + 64) % G); }
    xcd_barrier(bar);
    CKPT(1, 118, 260);

#if defined(DBG_CHECK) && DBG_CHECK == 3
    {   float* dbgw = (float*)(WSP(unsigned, WS_CTL) + 200000);
        LAS float* xr = (LAS float*)lds; LAS float* red = (LAS float*)(lds + 65536); LAS float* tru = (LAS float*)(lds + 69632);
        for (int smp = bx; smp < 256; smp += G) chk::p1(INP(0), INP(2), WSP(bf16, WS_QA), DOP(bf16, DO_QI), DOP(bf16, DO_KA), DOP(bf16, DO_VA), DOP(bf16, DO_KI), DOP(float, DO_WI), DOP(bf16, DO_CQ), DOP(bf16, DO_CKV), DOP(bf16, DO_KR), smp, xr, red, tru, dbgw, TID());
        xcd_barrier(bar);
        const float X = __hip_atomic_load(dbgw + DBG_WORD, RLX_AGENT) * 1e8f; float* o_ = outb();
        for (size_t i = GT(); i < (size_t)M * DM / 4; i += NT) *((GAS f32x4*)o_ + i) = (f32x4){X, X, X, X};
        return;
    }
#endif
#if defined(DBG_CHECK) && DBG_CHECK == 5
    {
        float* dbgw = (float*)(WSP(unsigned, WS_CTL) + 200000);
        for (int rep = 0; rep < 2; ++rep) {
            const dsa::Ptrs P{DOP(bf16, DO_QI), DOP(bf16, DO_KI), DOP(bf16, DO_KA), DOP(bf16, DO_VA), DOP(float, DO_WI), WSP(bf16, WS_QA), rep == 0 ? WSP(bf16, WS_XB) : WSP(bf16, WS_QN), (unsigned short*)(wsb() + WS_END + (size_t)rep * 8 * MiB)};
            LAS unsigned char* wl = lds + RING_OFF + wave * 16384; LAS dsa::u16* idl = (LAS dsa::u16*)(lds + IDL_OFF + wave * 2048);
            const int x_ = vcu >> 5, wv = (vcu & 31) * NWAVES + wave, j_ = wv >> 6, i_ = wv & 63;
#pragma unroll 1
            for (int jb = 0; jb < 2; ++jb) dsa::job(P, jb, jb == 0 ? 256 * (x_ + 8 * j_) + 4 * i_ : 256 * ((7 - x_) + 8 * (3 - j_)) + 4 * (63 - i_), wl, idl, LANE());
            xcd_barrier(bar);
        }
        { const unsigned short* sa = (const unsigned short*)(wsb() + WS_END); const unsigned short* sb = sa + (size_t)4 * MiB; unsigned c = 0u;
          for (size_t i = GT(); i < (size_t)M * 256; i += NT) c += sa[i] != sb[i] ? 1u : 0u;
          if (c) atomicAdd((unsigned*)dbgw + 20, c);
          const unsigned* oa = (const unsigned*)WSP(bf16, WS_XB); const unsigned* ob = (const unsigned*)WSP(bf16, WS_QN); unsigned c2 = 0u;
          for (size_t i = GT(); i < (size_t)M * 1024; i += NT) c2 += oa[i] != ob[i] ? 1u : 0u;
          if (c2) atomicAdd((unsigned*)dbgw + 21, c2); }
        xcd_barrier(bar);
        const float X = ((float)__hip_atomic_load((unsigned*)dbgw + 20 + DBG_WORD, RLX_AGENT) + 1.0f) * 1e8f; float* o_ = outb();
        for (size_t i = GT(); i < (size_t)M * DM / 4; i += NT) *((GAS f32x4*)o_ + i) = (f32x4){X, X, X, X};
        return;
    }
#endif
    STAMP(2);
    if (PH(3)) { const dsa::Ptrs P{DOP(bf16, DO_QI), DOP(bf16, DO_KI), DOP(bf16, DO_KA), DOP(bf16, DO_VA), DOP(float, DO_WI), WSP(bf16, WS_QA), WSP(bf16, DBG_OA), DBG_SEL};
      LAS unsigned char* wl = lds + RING_OFF + wave * 16384; LAS dsa::u16* idl = (LAS dsa::u16*)(lds + IDL_OFF + wave * 2048);
      const int x_ = vcu >> 5, j_ = wave & 3, i_ = (vcu & 31) * 2 + (wave >> 2);
#pragma unroll 1
      for (int jb = 0; jb < 2; ++jb) dsa::job(P, jb, jb == 0 ? 256 * (x_ + 8 * j_) + 4 * i_ : 256 * ((7 - x_) + 8 * (3 - j_)) + 4 * (63 - i_), wl, idl, LANE(), wave == 0 ? MISC + 64 : nullptr); }
    __syncthreads();
    STAMP(3);
    if (PH(2)) { EpiQ E{WSP(bf16, WS_QN), DOP(bf16, DO_QR), SSQP(), WSP(float, WS_ROPE)}; GEMM_PHASE_X(EpiQ, DOP(bf16, DO_CQ), WSP(bf16, WS_WUQ), 3072, 256, E, 2, 127 - 5); }
    if (PH(2)) { EpiKV E{WSP(bf16, WS_KN), WSP(bf16, WS_VB), SSQP() + (size_t)M * 8}; GEMM_PHASE_X(EpiKV, DOP(bf16, DO_CKV), WSP(bf16, WS_WKV), 4096, 256, E, 2, 127 - 5); }
    xcd_barrier(bar);
    CKPT(2, 118, 182); CKPT(3, 260, 484);
#if defined(DBG_CHECK) && DBG_CHECK == 6
    {   float* dbgw = (float*)(WSP(unsigned, WS_CTL) + 200000);
        LAS float* cr = (LAS float*)lds; LAS float* red = (LAS float*)(lds + 65536); LAS float* tru = (LAS float*)(lds + 69632);
        for (int smp = bx; smp < 256; smp += G) chk::p2(DOP(bf16, DO_CQ), DOP(bf16, DO_CKV), INP(3), INP(4), INP(5), INP(6), INP(7), WSP(bf16, WS_QN), DOP(bf16, DO_QR), WSP(bf16, WS_KN), WSP(bf16, WS_VB), smp, cr, red, tru, dbgw, TID());
        xcd_barrier(bar);
        const float X = __hip_atomic_load(dbgw + DBG_WORD, RLX_AGENT) * 1e8f; float* o_ = outb();
        for (size_t i = GT(); i < (size_t)M * DM / 4; i += NT) *((GAS f32x4*)o_ + i) = (f32x4){X, X, X, X};
        return;
    }
#endif

    STAMP(4);
    if (PH(4)) { const mla::Tensors T{WSP(bf16, WS_QN), DOP(bf16, DO_QR), WSP(bf16, WS_KN), DOP(bf16, DO_KR), WSP(bf16, WS_VB), DOP(bf16, DO_AB8)};
#pragma unroll 1
      for (int r_ = 0; r_ < 2; ++r_) { const int x_ = vcu >> 5, q_ = (vcu & 31) * 2 + r_, j_ = q_ >> 4, h_ = q_ & 15;
#pragma unroll 1
          for (int ps = 0; ps < 2; ++ps) mla::unit(T, ps, h_, ps == 0 ? x_ + 8 * j_ : (7 - x_) + 8 * (3 - j_), lds + RING_OFF); } }
    xcd_barrier(bar);
    CKPT(4, 260, 324);

#if defined(DBG_CHECK) && (DBG_CHECK == 1 || DBG_CHECK == 2 || DBG_CHECK == 4)
    {
        float* dbgw = (float*)(WSP(unsigned, WS_CTL) + 200000);
        LAS float* lgs = (LAS float*)lds; LAS float* red = (LAS float*)(lds + 65536); LAS float* aux = (LAS float*)(lds + 69632);
        for (int smp = bx; smp < (DBG_CHECK == 4 ? 256 : 512); smp += G) {
#if DBG_CHECK == 2
            chk::mla(WSP(bf16, WS_QN), DOP(bf16, DO_QR), WSP(bf16, WS_KN), DOP(bf16, DO_KR), WSP(bf16, WS_VB), WSP(bf16, DBG_OB), smp, lgs, red, aux, dbgw, TID());
#else
            chk::dsa<(DBG_CHECK == 4)>(INP(0), INP(2), DOP(bf16, DO_QI), DOP(bf16, DO_KI), DOP(float, DO_WI), WSP(bf16, WS_QA), DOP(bf16, DO_KA), DOP(bf16, DO_VA), WSP(bf16, DBG_OA), DBG_SEL, smp, lgs, red, aux, dbgw, TID());
#endif
        }
        xcd_barrier(bar);
        const float X = __hip_atomic_load(dbgw + DBG_WORD, RLX_AGENT) * 1e8f; float* o_ = outb();
        for (size_t i = GT(); i < (size_t)M * DM / 4; i += NT) *((GAS f32x4*)o_ + i) = (f32x4){X, X, X, X};
        return;
    }
#endif
    STAMP(5);
    if (PH(5)) { EpiB<1> E{WSP(bf16, WS_G), 4096, nullptr, nullptr, nullptr}; GEMM_PHASE_X(EpiB<1>, WSP(bf16, WS_XF8), WSP(bf16, WS_WG), 4096, 1024, E, 2, 127 - 6); }
    xcd_barrier(bar);
    CKPT(5, 356, 484); CKPT(6, 182, 256); CKPT(7, 324, 348);
#if defined(DBG_CHECK) && DBG_CHECK == 10
    {
        unsigned* dw = WSP(unsigned, WS_CTL) + 200000; const bf16* Gp = WSP(bf16, WS_G);
        unsigned cntb = 0u, rmax = 0u, rmin = 255u, pnmax = 0u, pnmin = 15u, r16 = 0u, nnan = 0u, pmaxb = 0u, pminb = 63u; float vmax = 0.f;
        for (int s_ = 0; s_ < 8; ++s_) { const int pnl = own_panel(vcu >> 5, s_);
            for (int e = (vcu & 31) * 512 + (int)TID(); e < 256 * 4096 / 8; e += 32 * 512) { const int r = e / 512, c8 = e % 512; const v4u w = *(const GAS v4u*)(Gp + ((size_t)pnl * 256 + r) * 4096 + c8 * 8); f32x4 a, b; unpack8(w, a, b);
                bool bad = false;
#pragma unroll
                for (int j = 0; j < 4; ++j) { bad |= !(a[j] >= 0.f && a[j] <= 1.001f); bad |= !(b[j] >= 0.f && b[j] <= 1.001f); }
                if (bad) { for (int j = 0; j < 4; ++j) { if (a[j] == a[j] && fabsf(a[j]) < 1e30f) vmax = fmaxf(vmax, fabsf(a[j])); else ++nnan; if (b[j] == b[j] && fabsf(b[j]) < 1e30f) vmax = fmaxf(vmax, fabsf(b[j])); else ++nnan; } pmaxb = max(pmaxb, (unsigned)pnl); pminb = min(pminb, (unsigned)pnl);
                    ++cntb; rmax = max(rmax, (unsigned)r); rmin = min(rmin, (unsigned)r); pnmax = max(pnmax, (unsigned)(c8 / 32)); pnmin = min(pnmin, (unsigned)(c8 / 32)); r16 |= 1u << (r & 15); } } }
        if (cntb) { atomicAdd(dw + 0, cntb); atomicMax(dw + 1, rmax + 1u); atomicMax(dw + 2, 256u - rmin); atomicMax(dw + 3, pnmax + 1u); atomicMax(dw + 4, 16u - pnmin); atomicOr(dw + 5, r16); atomicMax(dw + 6, (unsigned)vmax); atomicAdd(dw + 7, nnan); atomicMax(dw + 8, pmaxb + 1u); atomicMax(dw + 9, 64u - pminb); }
        xcd_barrier(bar);
        const float X = (float)__hip_atomic_load(dw + DBG_WORD, RLX_AGENT) * 1e8f; float* o_ = outb();
        for (size_t i = GT(); i < (size_t)M * DM / 4; i += NT) *((GAS f32x4*)o_ + i) = (f32x4){X, X, X, X};
        return;
    }
#endif
#if defined(DBG_CHECK) && DBG_CHECK == 9
    {   float* dbgw = (float*)(WSP(unsigned, WS_CTL) + 200000);
        LAS float* xr = (LAS float*)lds; LAS float* red = (LAS float*)(lds + 65536);
        { const size_t row_ = (size_t)256 * own_panel(vcu >> 5, vcu & 7) + (((unsigned)vcu * 2654435761u) >> 9) % 256;
          chk::gchk(INP(0), INP(2), WSP(bf16, WS_G), WSP(bf16, WS_XB), row_, xr, red, dbgw, TID()); }
        xcd_barrier(bar);
        const float X = __hip_atomic_load(dbgw + DBG_WORD, RLX_AGENT) * 1e8f; float* o_ = outb();
        for (size_t i = GT(); i < (size_t)M * DM / 4; i += NT) *((GAS f32x4*)o_ + i) = (f32x4){X, X, X, X};
        return;
    }
#endif

    STAMP(6);
    if (PH(7)) { EpiB<2> E{WSP(bf16, WS_MT), 2048, WSP(bf16, WS_G), nullptr, nullptr}; GEMM_PHASE_L(EpiB<2>, WSP(bf16, WS_QA), WSP(bf16, WS_WA), 2048, 1024, E, 2, 127 - 6, 2048); }
    if (PH(7)) { EpiB<5> E{WSP(bf16, WS_MT), 2048, WSP(bf16, WS_G) + 2048, nullptr, WSP(unsigned char, WS_MG8)}; GEMM_PHASE_X(EpiB<5>, DOP(bf16, DO_AB8), WSP(bf16, WS_WB), 2048, 1024, E, 2, 127 - 6); }
    xcd_barrier(bar);
    CKPT(8, 54, 118);

    STAMP(7);
    if (PH(8)) { EpiF<0> E{WSP(bf16, WS_X1B), INP(0), nullptr}; GEMM_PHASE_X(EpiF<0>, WSP(bf16, WS_MG8), WSP(bf16, WS_WO), 2048, 1024, E, 2, 127 - 6); }
    xcd_barrier(bar);
#if defined(DBG_CHECK) && DBG_CHECK == 7
    {   float* dbgw = (float*)(WSP(unsigned, WS_CTL) + 200000);
        LAS float* va = (LAS float*)lds; LAS float* red = (LAS float*)(lds + 65536); LAS float* mg = (LAS float*)(lds + 69632);
        { const size_t row_ = (size_t)256 * own_panel(vcu >> 5, vcu & 7) + (((unsigned)vcu * 2654435761u) >> 9) % 256;
          chk::mid(INP(0), INP(2), INP(8), INP(9), INP(10), WSP(bf16, WS_QA), WSP(bf16, WS_QN), WSP(bf16, WS_G), WSP(bf16, WS_MT), outb(), row_, vcu, va, red, mg, dbgw, TID()); }
        xcd_barrier(bar);
        const float X = __hip_atomic_load(dbgw + DBG_WORD, RLX_AGENT) * 1e8f; float* o_ = outb();
        for (size_t i = GT(); i < (size_t)M * DM / 4; i += NT) *((GAS f32x4*)o_ + i) = (f32x4){X, X, X, X};
        return;
    }
#endif
    if (PH(9)) { bf16* z_ = WSP(bf16, WS_X1B); ln_pass(z_, nullptr, z_, WSP(unsigned char, WS_X1F8), INP(11), INP(12), vcu, wave, LANE()); }
    xcd_barrier(bar);
    CKPT(9, 118, 182);

    STAMP(8);
    if (PH(10)) { EpiUp E{WSP(unsigned char, WS_ACT), WSP(float, WS_HEAD), WSP(float, WS_TAIL), INP(14), INP(15)}; GEMM_PHASE_X(EpiUp, WSP(bf16, WS_X1F8), WSP(bf16, WS_WUP), NUP, 1024, E, 2, 127 - 6); }
    xcd_barrier(bar);
    CKPT(10, 260, 484);

    STAMP(9);
    if (PH(11)) conv_fixup(WSP(unsigned char, WS_ACT), WSP(float, WS_HEAD), WSP(float, WS_TAIL), INP(14), INP(15), vcu, TID());
    if (PH(12)) { EpiB<0> E{WSP(bf16, WS_PEO), 2048, nullptr, nullptr, nullptr}; GEMM_PHASE(EpiB<0>, WSP(bf16, WS_PB), WSP(bf16, WS_WPE), 2048, 256, E); }
    if (PH(15)) { EpiB<4> E{WSP(bf16, WS_PEO), 2048, nullptr, INP(18), nullptr}; GEMM_PHASE_X(EpiB<4>, WSP(bf16, WS_X1F8), WSP(bf16, WS_WPG), 2048, 1024, E, 2, 127 - 6); }
    xcd_barrier(bar);
    CKPT(11, 54, 118); CKPT(12, 308, 484);

    STAMP(10);
    if (PH(13)) { EpiF<1> E{WSP(bf16, WS_X1B), nullptr, WSP(bf16, WS_PEO)}; GEMM_PHASE_X(EpiF<1>, WSP(bf16, WS_ACT), WSP(bf16, WS_WDN), 2048, DFF / 2, E, 2, 127 - 7); }
    xcd_barrier(bar);
    if (PH(14)) { ln_pass(WSP(bf16, WS_X1B), outb(), nullptr, nullptr, INP(20), INP(21), vcu, wave, LANE()); }
#if defined(DBG_SPIN)
    STAMP(11);
    if (threadIdx.x == 0 && vcu == DBG_VCU) { const unsigned long long a_ = ((unsigned long long)MISC[17 + 2 * (DBG_SPIN % 100)] << 32) | MISC[16 + 2 * (DBG_SPIN % 100)], b_ = ((unsigned long long)MISC[17 + 2 * (DBG_SPIN % 100 + DBG_SPAN)] << 32) | MISC[16 + 2 * (DBG_SPIN % 100 + DBG_SPAN)];
        const unsigned long long ca_ = ((unsigned long long)MISC[101 + 2 * (DBG_SPIN % 100)] << 32) | MISC[100 + 2 * (DBG_SPIN % 100)], cb_ = ((unsigned long long)MISC[101 + 2 * (DBG_SPIN % 100 + DBG_SPAN)] << 32) | MISC[100 + 2 * (DBG_SPIN % 100 + DBG_SPAN)];
        const unsigned long long t0_ = __builtin_amdgcn_s_memrealtime(), w_ = DBG_SPIN >= 200 ? (cb_ - ca_) / 20ull : DBG_SPIN >= 100 ? 4ull * MISC[64 + (DBG_SPIN - 100)] : 4ull * (b_ - a_); while (__builtin_amdgcn_s_memrealtime() - t0_ < w_) __builtin_amdgcn_s_sleep(8); }
#endif
#if defined(DBG_CHECK) && DBG_CHECK == 8
    {   xcd_barrier(bar);
        float* dbgw = (float*)(WSP(unsigned, WS_CTL) + 200000);
        LAS float* xs = (LAS float*)lds; LAS float* red = (LAS float*)(lds + 65536); LAS float* act = (LAS float*)(lds + 69632);
        for (int smp = bx; smp < 256; smp += G) chk::endp(WSP(bf16, WS_X1B), nullptr, INP(1), INP(13), INP(14), INP(15), INP(16), INP(17), INP(18), INP(19), INP(20), INP(21), outb(), smp, xs, red, act, dbgw, TID());
        xcd_barrier(bar);
        const float X = __hip_atomic_load(dbgw + DBG_WORD, RLX_AGENT) * 1e8f; float* o_ = outb();
        for (size_t i = GT(); i < (size_t)M * DM / 4; i += NT) *((GAS f32x4*)o_ + i) = (f32x4){X, X, X, X};
    }
#endif
}

extern "C" void kernel_launch(void* const* d_in, const int* in_sizes, int n_in, void* d_out, int out_size, void* d_ws, size_t ws_size, hipStream_t stream) {
    static int grid = 0;
    if (grid == 0) {
        if (n_in != 22 || in_sizes[0] != M * DM || out_size != M * DM || ws_size < WS_END) { fprintf(stderr, "kernel_launch: unexpected shapes (n_in %d, in0 %d, out %d, ws %zu); nothing launched\n", n_in, n_in > 0 ? in_sizes[0] : -1, out_size, ws_size); grid = -1; return; }
        int dev = 0, cus = 0, per_cu = 0;
        if (hipGetDevice(&dev) != hipSuccess || hipDeviceGetAttribute(&cus, hipDeviceAttributeMultiprocessorCount, dev) != hipSuccess) { grid = -1; return; }
        if (hipFuncSetAttribute((const void*)fwd_kernel, hipFuncAttributeMaxDynamicSharedMemorySize, LDS_BYTES) != hipSuccess) { fprintf(stderr, "kernel_launch: hipFuncSetAttribute failed\n"); grid = -1; return; }
        if (hipOccupancyMaxActiveBlocksPerMultiprocessor(&per_cu, (const void*)fwd_kernel, NWAVES * 64, LDS_BYTES) != hipSuccess || per_cu < 1) { fprintf(stderr, "kernel_launch: occupancy query reports %d workgroups per CU\n", per_cu); }
        (void)hipGetLastError();
        grid = cus;
    }
    if (grid < 0) return;
    if (hipMemsetAsync((char*)d_ws + WS_CTL, 0, CTL_ZERO_BYTES, stream) != hipSuccess) return;
    Args a{};
    for (int i = 0; i < 22; ++i) a.in[i] = (const float*)d_in[i];
    a.out = (float*)d_out; a.ws = (unsigned char*)d_ws;
    hipLaunchKernelGGL(fwd_kernel, dim3(grid), dim3(NWAVES * 64), LDS_BYTES, stream, a);
}
```

```cpp
#include <hip/hip_runtime.h>
#include <cstdio>
#include <cstdint>
namespace pg8 {
#define PG8_LAS __attribute__((address_space(3)))
typedef unsigned short bf16_t;
typedef short bf16x8 __attribute__((ext_vector_type(8)));
typedef float f32x4 __attribute__((ext_vector_type(4)));
typedef unsigned u32x4 __attribute__((ext_vector_type(4)));
constexpr int BM = 256, BK = 64, HALF = 128, HTB = HALF * BK * 2  , STAGE_BYTES = 8 * HTB, NXCD = 8, WGM = 8;

__host__ __device__ __forceinline__ int lds_byte(int r, int c) { const int st = (r >> 4) * 2 + (c >> 5), rr = r & 15, cc = c & 31, ob = rr * 64 + cc * 2; return st * 1024 + (ob ^ (((ob >> 9) & 1) << 5)); }
__host__ __device__ __forceinline__ void stage_rc(int b, int& R, int& C) { const int st = b / 1024, sb = b % 1024, swz = sb ^ (((sb >> 9) & 1) << 5); R = (st >> 1) * 16 + swz / 64; C = (st & 1) * 32 + (swz % 64) / 2; }
__host__ __device__ __forceinline__ int perm32(int rho) { const int n = rho >> 4, i = rho & 15; return 8 * (i >> 2) + 4 * n + (i & 3); }

struct Unit { int pm, pn; };
struct Gemm { const bf16_t* A; const bf16_t* Bt; int M, N, K; int wscale; int lda; };
typedef int i32x4 __attribute__((ext_vector_type(4))); typedef int i32x8 __attribute__((ext_vector_type(8)));
typedef _Float16 f16x8 __attribute__((ext_vector_type(8)));

struct StaticOrder {
    int nM, nN, nwg, G, c;
    __host__ __device__ void init(int M, int N, int G_, int c_) { nM = M / BM; nN = N / BM; nwg = nM * nN; G = G_; c = c_; }
    __host__ __device__ bool next(int i, Unit& u) const {
        const long L = (long)i * G + c; if (L >= nwg) return false;
        int wgid = (int)L; { const int q = nwg / NXCD, r = nwg % NXCD, xcd = wgid % NXCD, off = wgid / NXCD; wgid = (xcd < r ? xcd * (q + 1) : r * (q + 1) + (xcd - r) * q) + off; }
        const int nig = WGM * nN, gid = wgid / nig, fm = gid * WGM, gsz = (nM - fm) < WGM ? (nM - fm) : WGM;
        u.pm = fm + ((wgid % nig) % gsz); u.pn = (wgid % nig) / gsz;
        { const int x = u.pm >> 3, s = u.pm & 7; u.pm = s < 4 ? x + 8 * s : 32 + (7 - x) + 8 * (s - 4); }
        return true;
    }
    __device__ __forceinline__ void a_ready(const Unit&) const {}
    __device__ __forceinline__ void done(const Unit&) const {}
};

typedef float f32x2c_t __attribute__((ext_vector_type(2))); typedef __bf16 bf16x2c_t __attribute__((ext_vector_type(2)));
__device__ __forceinline__ unsigned cvt_pk_bf16(float lo, float hi) { const f32x2c_t v = {lo, hi}; const bf16x2c_t b = __builtin_convertvector(v, bf16x2c_t); return __builtin_bit_cast(unsigned, b); }
typedef float f32x2 __attribute__((ext_vector_type(2)));
template <class Epi, class Sched, bool ALIGN_EPI = false, bool SP2 = false, int DT = 0  >
__device__ __forceinline__ void gemm_phase(PG8_LAS unsigned char* lds, const Gemm g, const Sched& S, const Epi& E) {
    int tid_o_ = threadIdx.x; asm volatile("" : "+v"(tid_o_));
    const int tid = tid_o_, wid = __builtin_amdgcn_readfirstlane(tid >> 6), lane = tid & 63, wr = wid >> 2, wc = wid & 3, fr = lane & 15, fq = lane >> 4;
    const int K = g.K, nt = K / BK, lda = g.lda ? g.lda : g.K;
    unsigned voffA[2], voffB[2];
#pragma unroll
    for (int i = 0; i < 2; ++i) { int R, C; stage_rc(tid * 16 + i * 8192, R, C); const int Rb = Epi::PERM ? ((R & ~31) + perm32(R & 31)) : R;
        voffA[i] = (unsigned)(R * lda + C) * 2u; voffB[i] = (unsigned)(Rb * K + C) * 2u; }
    const size_t kstep = (size_t)(BK * 2);
    const size_t hstep = (size_t)HALF * K * 2;
    const size_t tstep = 2 * hstep;
    const size_t hstepA = (size_t)HALF * lda * 2, tstepA = 2 * hstepA;
    const unsigned ldsw = (unsigned)wid * 1024u;
    const int aoff = lds_byte(wr * 64 + fr, fq * 8), boff = lds_byte(wc * 32 + fr, fq * 8);
#define PG8_SA(b, h) (((b) * 2 + (h)) * HTB)
#define PG8_SB(b, h) ((4 + (b) * 2 + (h)) * HTB)
#define PG8_STAGE(bufoff, gbase, voff) do { _Pragma("unroll") for (int _i = 0; _i < 2; ++_i) \
        __builtin_amdgcn_global_load_lds((const unsigned*)((const char*)(gbase) + (voff)[_i]), (PG8_LAS unsigned*)(lds + (bufoff) + ldsw + _i * 8192), 16, 0, 0); } while (0)
#define PG8_LD16A(off_) (*(const PG8_LAS i32x4*)(abase8 + (off_)))
#define PG8_LD16B(off_) (*(const PG8_LAS i32x4*)(bbase8 + ((off_) - 65536)))
#define PG8_LDA(dst, b, h) do { if constexpr (DT == 2) { _Pragma("unroll") for (int m = 0; m < 4; ++m) dst##8[m] = __builtin_shufflevector(PG8_LD16A(PG8_SA(b, h) + m * 2048), PG8_LD16A(PG8_SA(b, h) + m * 2048 + 1024), 0, 1, 2, 3, 4, 5, 6, 7); } \
        else { _Pragma("unroll") for (int m = 0; m < 4; ++m) _Pragma("unroll") for (int k = 0; k < 2; ++k) dst[m][k] = *(const PG8_LAS bf16x8*)(lds + PG8_SA(b, h) + aoff + m * 2048 + k * 1024); } } while (0)
#define PG8_LDB(dst, b, h) do { if constexpr (DT == 2) { _Pragma("unroll") for (int n = 0; n < 2; ++n) dst##8[n] = __builtin_shufflevector(PG8_LD16B(PG8_SB(b, h) + n * 2048), PG8_LD16B(PG8_SB(b, h) + n * 2048 + 1024), 0, 1, 2, 3, 4, 5, 6, 7); } \
        else { _Pragma("unroll") for (int n = 0; n < 2; ++n) _Pragma("unroll") for (int k = 0; k < 2; ++k) dst[n][k] = *(const PG8_LAS bf16x8*)(lds + PG8_SB(b, h) + boff + n * 2048 + k * 1024); } } while (0)
#define PG8_MMA(ai, bj, At, Bt) do { __builtin_amdgcn_s_setprio(1); _Pragma("unroll") for (int m = 0; m < 4; ++m) _Pragma("unroll") for (int n = 0; n < 2; ++n) { \
        if constexpr (DT == 2) asm volatile("v_mfma_scale_f32_16x16x128_f8f6f4 %0, %1, %2, %0, %3, %4 op_sel_hi:[0,0,0]" : "+v"(acc[ai][bj][m][n]) : "v"(Bt##8[n]), "v"(At##8[m]), "v"(sclw), "v"(scla));   \
        else { _Pragma("unroll") for (int k = 0; k < 2; ++k) { \
        if constexpr (DT == 1) acc[ai][bj][m][n] = __builtin_amdgcn_mfma_f32_16x16x32_f16(__builtin_bit_cast(f16x8, Bt[n][k]), __builtin_bit_cast(f16x8, At[m][k]), acc[ai][bj][m][n], 0, 0, 0); \
        else acc[ai][bj][m][n] = __builtin_amdgcn_mfma_f32_16x16x32_bf16(Bt[n][k], At[m][k], acc[ai][bj][m][n], 0, 0, 0); } } } __builtin_amdgcn_s_setprio(0); } while (0)
#define PG8_WAIT_V(n) asm volatile("s_waitcnt vmcnt(" #n ")" ::: "memory")
#define PG8_WAIT_L(n) asm volatile("s_waitcnt lgkmcnt(" #n ")" ::: "memory")
#define PG8_BAR __builtin_amdgcn_s_barrier()
#define PG8_SCHED __builtin_amdgcn_sched_barrier(0)
    Unit cur, nxt; int ui = 0;
    if (!S.next(0, cur)) return;
    f32x4 acc[2][2][4][2];
#pragma unroll
    for (int a = 0; a < 2; ++a)
#pragma unroll
        for (int b = 0; b < 2; ++b)
#pragma unroll
            for (int m = 0; m < 4; ++m)
#pragma unroll
                for (int n = 0; n < 2; ++n) acc[a][b][m][n] = (f32x4){0.f, 0.f, 0.f, 0.f};
    const int sclw = g.wscale, scla = 127;
    unsigned abi_ = (unsigned)(uintptr_t)lds + (unsigned)aoff, bbi_ = (unsigned)(uintptr_t)lds + 65536u + (unsigned)boff; asm volatile("" : "+v"(abi_), "+v"(bbi_));
    const PG8_LAS unsigned char* abase8 = (const PG8_LAS unsigned char*)(uintptr_t)abi_; const PG8_LAS unsigned char* bbase8 = (const PG8_LAS unsigned char*)(uintptr_t)bbi_;
    bf16x8 At[4][2], B0[2][2], B1[2][2]; i32x8 At8[4], B08[2], B18[2];
    const char* cA = (const char*)g.A + (size_t)cur.pm * tstepA; const char* cB = (const char*)g.Bt + (size_t)cur.pn * tstep;
    S.a_ready(cur);
    if constexpr (SP2) {
        PG8_STAGE(PG8_SB(0, 0), cB, voffB); PG8_STAGE(PG8_SB(0, 1), cB + hstep, voffB); PG8_STAGE(PG8_SA(0, 0), cA, voffA); PG8_STAGE(PG8_SA(0, 1), cA + hstepA, voffA);
        if (wr == 1) PG8_BAR;
        PG8_WAIT_V(2); PG8_BAR;
        PG8_STAGE(PG8_SB(1, 0), cB + kstep, voffB); PG8_STAGE(PG8_SA(1, 0), cA + kstep, voffA); PG8_STAGE(PG8_SB(1, 1), cB + hstep + kstep, voffB);
        PG8_WAIT_V(6); PG8_BAR;
    } else {
        PG8_STAGE(PG8_SB(0, 0), cB, voffB); PG8_STAGE(PG8_SA(0, 0), cA, voffA); PG8_STAGE(PG8_SB(0, 1), cB + hstep, voffB); PG8_STAGE(PG8_SA(0, 1), cA + hstepA, voffA);
        if (wr == 1) PG8_BAR;
        PG8_WAIT_V(4); PG8_BAR;
        PG8_STAGE(PG8_SB(1, 0), cB + kstep, voffB); PG8_STAGE(PG8_SA(1, 0), cA + kstep, voffA); PG8_STAGE(PG8_SB(1, 1), cB + hstep + kstep, voffB);
        PG8_WAIT_V(6); PG8_BAR;
    }
    for (;;) {
        const bool has_next = S.next(ui + 1, nxt);
        const char* nA = has_next ? (const char*)g.A + (size_t)nxt.pm * tstepA : cA; const char* nB = has_next ? (const char*)g.Bt + (size_t)nxt.pn * tstep : cB;
        for (int t = 0; t < nt; t += 2) {
            const bool last = (t == nt - 2);
            const char* a1 = cA + (size_t)(t + 1) * kstep;
            const char* a2 = last ? nA : cA + (size_t)(t + 2) * kstep; const char* b2 = last ? nB : cB + (size_t)(t + 2) * kstep;
            const char* a3 = a2 + kstep; const char* b3 = b2 + kstep;
            if (last && has_next) S.a_ready(nxt);
            if constexpr (SP2) {
            PG8_LDB(B0, 0, 0); PG8_LDB(B1, 0, 1); PG8_SCHED; PG8_LDA(At, 0, 0); PG8_STAGE(PG8_SA(1, 1), a1 + hstepA, voffA);
            PG8_WAIT_V(8); PG8_WAIT_L(0); PG8_BAR; PG8_MMA(0, 0, At, B0); PG8_MMA(0, 1, At, B1); PG8_BAR; PG8_SCHED;
            PG8_LDA(At, 0, 1); PG8_STAGE(PG8_SB(0, 0), b2, voffB); PG8_STAGE(PG8_SB(0, 1), b2 + hstep, voffB); PG8_STAGE(PG8_SA(0, 0), a2, voffA);
            PG8_WAIT_V(8); PG8_WAIT_L(0); PG8_BAR; PG8_MMA(1, 0, At, B0); PG8_MMA(1, 1, At, B1); PG8_BAR; PG8_SCHED;
            PG8_LDB(B0, 1, 0); PG8_LDB(B1, 1, 1); PG8_SCHED; PG8_LDA(At, 1, 0); PG8_STAGE(PG8_SA(0, 1), a2 + hstepA, voffA);
            PG8_WAIT_V(8); PG8_WAIT_L(0); PG8_BAR; PG8_MMA(0, 0, At, B0); PG8_MMA(0, 1, At, B1); PG8_BAR; PG8_SCHED;
            PG8_LDA(At, 1, 1); PG8_STAGE(PG8_SB(1, 0), b3, voffB); PG8_STAGE(PG8_SB(1, 1), b3 + hstep, voffB); PG8_STAGE(PG8_SA(1, 0), a3, voffA);
            PG8_WAIT_V(8); PG8_WAIT_L(0); PG8_BAR; PG8_MMA(1, 0, At, B0); PG8_MMA(1, 1, At, B1); PG8_BAR; PG8_SCHED;
            } else {
            PG8_LDB(B0, 0, 0); PG8_SCHED; PG8_LDA(At, 0, 0); PG8_STAGE(PG8_SA(1, 1), a1 + hstepA, voffA);
            PG8_WAIT_L(8); PG8_BAR; PG8_WAIT_L(0); PG8_MMA(0, 0, At, B0); PG8_BAR; PG8_SCHED;
            PG8_LDB(B1, 0, 1); PG8_STAGE(PG8_SB(0, 0), b2, voffB);
            PG8_BAR; PG8_WAIT_L(0); PG8_MMA(0, 1, At, B1); PG8_BAR;
            PG8_LDA(At, 0, 1); PG8_STAGE(PG8_SA(0, 0), a2, voffA);
            PG8_BAR; PG8_WAIT_L(0); PG8_MMA(1, 0, At, B0); PG8_BAR; PG8_SCHED;
            PG8_STAGE(PG8_SB(0, 1), b2 + hstep, voffB);
            PG8_WAIT_V(6); PG8_BAR; PG8_MMA(1, 1, At, B1); PG8_BAR;
            PG8_LDB(B0, 1, 0); PG8_SCHED; PG8_LDA(At, 1, 0); PG8_STAGE(PG8_SA(0, 1), a2 + hstepA, voffA);
            PG8_WAIT_L(8); PG8_BAR; PG8_WAIT_L(0); PG8_MMA(0, 0, At, B0); PG8_BAR; PG8_SCHED;
            PG8_LDB(B1, 1, 1); PG8_STAGE(PG8_SB(1, 0), b3, voffB);
            PG8_BAR; PG8_WAIT_L(0); PG8_MMA(0, 1, At, B1); PG8_BAR;
            PG8_LDA(At, 1, 1); PG8_STAGE(PG8_SA(1, 0), a3, voffA);
            PG8_BAR; PG8_WAIT_L(0); PG8_MMA(1, 0, At, B0); PG8_BAR; PG8_SCHED;
            PG8_STAGE(PG8_SB(1, 1), b3 + hstep, voffB);
            PG8_WAIT_V(6); PG8_BAR; PG8_MMA(1, 1, At, B1); PG8_BAR;
            }
        }
        if constexpr (ALIGN_EPI) { if (wr == 0) PG8_BAR; }
        if constexpr (!Epi::AFTER_DRAIN) { E(acc, cur, wr, wc, fr, fq); S.done(cur); }
        if (!has_next) break;
#pragma unroll
        for (int a = 0; a < 2; ++a)
#pragma unroll
            for (int b = 0; b < 2; ++b)
#pragma unroll
                for (int m = 0; m < 4; ++m)
#pragma unroll
                    for (int n = 0; n < 2; ++n) acc[a][b][m][n] = (f32x4){0.f, 0.f, 0.f, 0.f};
        cur = nxt; cA = nA; cB = nB; ++ui;
        if constexpr (ALIGN_EPI) { if (wr == 1) PG8_BAR; }
    }
    PG8_WAIT_V(0);
    if constexpr (!ALIGN_EPI) { if (wr == 0) PG8_BAR; }
    PG8_BAR;
    if constexpr (Epi::AFTER_DRAIN) { E.fused(acc, cur, wr, wc, fr, fq, lds, wid, lane); S.done(cur); }
#undef PG8_SA
#undef PG8_SB
#undef PG8_STAGE
#undef PG8_LDA
#undef PG8_LD16A
#undef PG8_LD16B
#undef PG8_LDB
#undef PG8_MMA
#undef PG8_WAIT_V
#undef PG8_WAIT_L
#undef PG8_BAR
#undef PG8_SCHED
}
}

constexpr int NWAVES = 8;
constexpr int BATCH = 2, SEQ = 8192, DM = 2048, M = BATCH * SEQ;
constexpr int DIN = 8592, NU = 8704, NU1 = 4608;
constexpr int DFF = 5632, NUP = 2 * DFF, PLE_DIM = 256;
constexpr float LN_EPS = 1e-5f, RMS_EPS = 1e-6f;
constexpr float ALPHA = 1.189207115002721f;
constexpr float LOG2E = 1.4426950408889634f;
constexpr float QA_SCALE = 0.08838834764831845f * LOG2E;
constexpr float QB_SCALE = 0.07216878364870323f * LOG2E;
constexpr int U_QA = 0, U_KA = 2048, U_VA = 2176, U_QI = 2304, U_KI = 3328, U_WI = 3392, U_CQ = 3408, U_CKV = 3920, U_KPE = 4432, U_G = 4496;

constexpr size_t MiB = 1u << 20;
constexpr size_t WS_CTL = 0, CTL_ZERO_BYTES = 1 * MiB;
constexpr size_t WS_ROPE = 2 * MiB;
constexpr size_t WS_WIN = 4 * MiB;
constexpr size_t WS_WIN8 = 12 * MiB;
constexpr int NU16 = 1280, NU8 = 3328;
constexpr size_t WS_WUQ = 38 * MiB;
constexpr size_t WS_WKV = 41 * MiB;
constexpr size_t WS_WPE = 45 * MiB;
constexpr size_t WS_PB = 46 * MiB;
constexpr size_t WS_XB = 54 * MiB;
constexpr size_t WS_QA = 118 * MiB;
constexpr size_t WS_WUP = 182 * MiB, WS_WDN = 204 * MiB, WS_WPG = 215 * MiB;
constexpr size_t WS_WA = 223 * MiB, WS_WB = 227 * MiB, WS_WO = 231 * MiB, WS_WG = 235 * MiB;
constexpr size_t WS_QN = 260 * MiB;
constexpr size_t WS_XF8 = 324 * MiB;
constexpr size_t WS_MG8 = 292 * MiB;
constexpr size_t WS_KN = 356 * MiB, WS_VB = 420 * MiB;
constexpr size_t WS_G = 356 * MiB;
constexpr size_t WS_MT = WS_XB, WS_X1B = WS_QA, WS_PEO = WS_XB;
constexpr size_t WS_ACT = 320 * MiB;
constexpr size_t WS_X1F8 = 260 * MiB;
constexpr size_t WS_HEAD = 292 * MiB, WS_TAIL = 484 * MiB;
constexpr size_t DO_AB8 = 0 * MiB;
constexpr size_t DO_QI = 0 * MiB, DO_CQ = 32 * MiB, DO_CKV = 48 * MiB, DO_KA = 64 * MiB, DO_VA = 68 * MiB, DO_KI = 72 * MiB, DO_WI = 74 * MiB, DO_KR = 75 * MiB, DO_QR = 80 * MiB;
constexpr size_t WS_END = 506 * MiB;
constexpr int CW_TMO = 0, CW_CODE = 1, CW_BAR = 4096, CW_RANK = 32768, CW_JOB = 49152;
constexpr int CW_SSQ = 65536;

constexpr int RING_OFF = 0, RING_BYTES = 131072;
constexpr int IDL_OFF = 131072;
constexpr int LDSCTL_OFF = 147456, MISC_OFF = LDSCTL_OFF + 320;
constexpr int LDS_BYTES = 148480;
static_assert(MISC_OFF + 128 <= LDS_BYTES, "LDS map");
#define GAS __attribute__((address_space(1)))
#define LAS __attribute__((address_space(3)))
typedef unsigned short bf16;
typedef unsigned v4u __attribute__((ext_vector_type(4)));
typedef float f32x4 __attribute__((ext_vector_type(4)));
typedef short bf16x8 __attribute__((ext_vector_type(8)));
typedef GAS unsigned gu32;
typedef GAS unsigned long long gu64;
#define RLX_AGENT __ATOMIC_RELAXED, __HIP_MEMORY_SCOPE_AGENT
#define LDS_WAIT() asm volatile("s_waitcnt lgkmcnt(0)" ::: "memory")
#define VM_WAIT() asm volatile("s_waitcnt vmcnt(0)" ::: "memory")
__device__ __forceinline__ unsigned long long rt() { return __builtin_amdgcn_s_memrealtime(); }
__device__ __forceinline__ unsigned f2bf(float f) { unsigned u = __builtin_bit_cast(unsigned, f); return (u + 0x7fffu + ((u >> 16) & 1u)) >> 16; }
__device__ __forceinline__ unsigned pk2(float lo, float hi) { return f2bf(lo) | (f2bf(hi) << 16); }

#define XB_TMO      128
#define XB_XCNT(j)  (256  + 64 * (j))
#define XB_XSUB(j)  (1280 + 64 * (j))
#define XB_XGEN(j)  (2304 + 64 * (j))
#define XB_TOP      3328
#define XB_TOPGEN   3392
#define XCD_BAR_WORDS 3456
#define XB_SPIN_CAP (1u << 18)

__device__ __forceinline__ unsigned xb_ld(unsigned* p)              { return __hip_atomic_load(p, __ATOMIC_RELAXED, __HIP_MEMORY_SCOPE_AGENT); }
__device__ __forceinline__ unsigned xb_add(unsigned* p, unsigned v) { return __hip_atomic_fetch_add(p, v, __ATOMIC_RELAXED, __HIP_MEMORY_SCOPE_AGENT); }
__device__ __forceinline__ unsigned xb_xcc_id() { return (unsigned)__builtin_amdgcn_s_getreg((3 << 11) | 20) & 0xFu; }
#define XB_SPIN(cond, bar) do { unsigned _sp = 0; while (cond) { __builtin_amdgcn_s_sleep(1); \
    if ((++_sp & 255u) == 0u) { if (xb_ld(&(bar)[XB_TMO])) break; if (_sp > XB_SPIN_CAP) { atomicAdd(&(bar)[XB_TMO], 1u); break; } } } } while (0)

struct XcdBarrier {
    unsigned* bar; unsigned x;
    volatile LAS unsigned* st;
};

__device__ __forceinline__ XcdBarrier xcd_barrier_post(unsigned* bar, volatile LAS unsigned* st) {
    XcdBarrier b; b.bar = bar; b.x = xb_xcc_id(); b.st = st;
    if (threadIdx.x == 0) (void)xb_add(&bar[XB_XCNT(b.x)], 1u);
    return b;
}
__device__ __forceinline__ void xcd_barrier_complete(unsigned* bar, unsigned x, unsigned& nloc, unsigned& nx) {
    const unsigned G = gridDim.x * gridDim.y * gridDim.z;
    unsigned sum, cnt, mine, sp = 0u;
    for (;;) {
        sum = 0u; cnt = 0u; mine = 0u;
#pragma unroll
        for (unsigned j = 0; j < 16; ++j) { const unsigned c = xb_ld(&bar[XB_XCNT(j)]); sum += c; cnt += (c > 0u) ? 1u : 0u; mine = (j == x) ? c : mine; }
        if (sum == G) break;
        __builtin_amdgcn_s_sleep(1);
        if ((++sp & 255u) == 0u) { if (xb_ld(&bar[XB_TMO])) break; if (sp > XB_SPIN_CAP) { atomicAdd(&bar[XB_TMO], 1u); break; } }
    }
    nloc = mine > 0u ? mine : 1u; nx = cnt > 0u ? cnt : 1u;
}

__device__ __forceinline__ void xcd_barrier(const XcdBarrier& b) {
    asm volatile("s_waitcnt vmcnt(0)" ::: "memory");
    __syncthreads();
    if (threadIdx.x == 0) {
        unsigned* bar = b.bar;
        __builtin_amdgcn_s_waitcnt(0);
        unsigned nloc = b.st[0], nx = b.st[1];
        if (nloc == 0u) { xcd_barrier_complete(bar, b.x, nloc, nx); b.st[0] = nloc; b.st[1] = nx; }
        const unsigned old = xb_add(&bar[XB_XSUB(b.x)], 1u);
        const unsigned gen = old / nloc;
        if (old + 1u == (gen + 1u) * nloc) {
            __builtin_amdgcn_fence(__ATOMIC_RELEASE, "agent");
            asm volatile("s_waitcnt vmcnt(0)" ::: "memory");
            const unsigned og = xb_add(&bar[XB_TOP], 1u);
            const unsigned tg = og / nx;
            if (og + 1u == (tg + 1u) * nx) xb_add(&bar[XB_TOPGEN], 1u);
            else XB_SPIN(xb_ld(&bar[XB_TOPGEN]) == tg, bar);
            __builtin_amdgcn_fence(__ATOMIC_ACQUIRE, "agent");
            xb_add(&bar[XB_XGEN(b.x)], 1u);
            asm volatile("s_waitcnt vmcnt(0)" ::: "memory");
        } else {
            XB_SPIN(xb_ld(&bar[XB_XGEN(b.x)]) == gen, bar);
            __builtin_amdgcn_fence(__ATOMIC_ACQUIRE, "agent");
            asm volatile("s_waitcnt vmcnt(0)" ::: "memory");
        }
    }
    __syncthreads();
}

typedef unsigned u32x2 __attribute__((ext_vector_type(2)));
typedef float f32x16 __attribute__((ext_vector_type(16)));
typedef short s16x4 __attribute__((ext_vector_type(4)));
using pg8::cvt_pk_bf16;
__device__ __forceinline__ v4u pack8(f32x4 a, f32x4 b) { v4u w; w.x = cvt_pk_bf16(a[0], a[1]); w.y = cvt_pk_bf16(a[2], a[3]); w.z = cvt_pk_bf16(b[0], b[1]); w.w = cvt_pk_bf16(b[2], b[3]); return w; }
__device__ __forceinline__ u32x2 pack4(f32x4 a) { u32x2 w; w.x = cvt_pk_bf16(a[0], a[1]); w.y = cvt_pk_bf16(a[2], a[3]); return w; }
__device__ __forceinline__ float bflo(unsigned u) { return __uint_as_float(u << 16); }
__device__ __forceinline__ float bfhi(unsigned u) { return __uint_as_float(u & 0xffff0000u); }
__device__ __forceinline__ void unpack8(v4u w, f32x4& a, f32x4& b) { a = (f32x4){bflo(w.x), bfhi(w.x), bflo(w.y), bfhi(w.y)}; b = (f32x4){bflo(w.z), bfhi(w.z), bflo(w.w), bfhi(w.w)}; }
typedef _Float16 f16x2 __attribute__((ext_vector_type(2)));
using pg8::f16x8;
__device__ __forceinline__ unsigned pkh(float a, float b) { const f16x2 v = {(_Float16)a, (_Float16)b}; return __builtin_bit_cast(unsigned, v); }
__device__ __forceinline__ v4u pack8h(f32x4 a, f32x4 b) { v4u w; w.x = pkh(a[0], a[1]); w.y = pkh(a[2], a[3]); w.z = pkh(b[0], b[1]); w.w = pkh(b[2], b[3]); return w; }
__device__ __forceinline__ void unpack8h(v4u w, f32x4& a, f32x4& b) { const f16x8 h = __builtin_bit_cast(f16x8, w); a = (f32x4){(float)h[0], (float)h[1], (float)h[2], (float)h[3]}; b = (f32x4){(float)h[4], (float)h[5], (float)h[6], (float)h[7]}; }
__device__ __forceinline__ unsigned pkf8(float a, float b, float c, float d) { int w = 0; w = __builtin_amdgcn_cvt_pk_fp8_f32(a, b, w, false); w = __builtin_amdgcn_cvt_pk_fp8_f32(c, d, w, true); return (unsigned)w; }
__device__ __forceinline__ float sigmoidf_(float x) { return __builtin_amdgcn_rcpf(1.0f + __builtin_amdgcn_exp2f(-LOG2E * x)); }
__device__ __forceinline__ f32x4 sigmoid4(f32x4 x) { return (f32x4){sigmoidf_(x[0]), sigmoidf_(x[1]), sigmoidf_(x[2]), sigmoidf_(x[3])}; }
__device__ __forceinline__ float sum_x16(float v) { auto r = __builtin_amdgcn_permlane16_swap(__float_as_uint(v), __float_as_uint(v), false, false); return __uint_as_float(r[0]) + __uint_as_float(r[1]); }
__device__ __forceinline__ float sum_x32(float v) { auto r = __builtin_amdgcn_permlane32_swap(__float_as_uint(v), __float_as_uint(v), false, false); return __uint_as_float(r[0]) + __uint_as_float(r[1]); }
__device__ __forceinline__ float max_x16(float v) { auto r = __builtin_amdgcn_permlane16_swap(__float_as_uint(v), __float_as_uint(v), false, false); return fmaxf(__uint_as_float(r[0]), __uint_as_float(r[1])); }
__device__ __forceinline__ float max_x32(float v) { auto r = __builtin_amdgcn_permlane32_swap(__float_as_uint(v), __float_as_uint(v), false, false); return fmaxf(__uint_as_float(r[0]), __uint_as_float(r[1])); }
template <int CTRL> __device__ __forceinline__ float dppf(float v) { return __int_as_float(__builtin_amdgcn_update_dpp(0, __float_as_int(v), CTRL, 0xf, 0xf, false)); }
__device__ __forceinline__ float wave_sum(float v) {
    v += dppf<0xB1>(v); v += dppf<0x4E>(v); v += dppf<0x141>(v); v += dppf<0x140>(v);
    return sum_x32(sum_x16(v));
}
__device__ __forceinline__ int rope_perm(int pc) { const int g = pc >> 3, e = pc & 7; return e < 4 ? 4 * g + e : 32 + 4 * g + (e - 4); }
template <int MAP> __device__ __forceinline__ int srcmap(int n) {
    if (MAP == 0) return n;
    if (MAP == 1) {
        if (n < 2048) return U_QA + n;
        if (n < 3072) return U_QI + (n - 2048);
        if (n < 3200) return U_KA + (n - 3072);
        if (n < 3328) return U_VA + (n - 3200);
        if (n < 3584) { const int o = n - 3328; if (o < 64) return U_KI + o; if (o < 128) return U_KPE + rope_perm(o - 64); if (o < 144) return U_WI + (o - 128); return -1; }
        if (n < 4096) return U_CQ + (n - 3584);
        if (n < 4608) return U_CKV + (n - 4096);
        return U_G + (n - 4608);
    }
    if (MAP == 2) {
        if (n < 2048) return (n >> 7) * 192 + (n & 127);
        const int o = n - 2048; return (o >> 6) * 192 + 128 + rope_perm(o & 63);
    }
    { const int pn = n >> 8, o = n & 255; return o < 128 ? pn * 128 + o : DFF + pn * 128 + (o - 128); }
}
constexpr int TR_LDS = 64 * 68 * 4;
__device__ __forceinline__ void tr_item(const float* W, int ldw, const float* gk, bf16* WT, int K, int k0, int drow0, int srccol4, LAS float* scr, int lane, bool h16) {
    const int c4 = (lane & 15) * 4;
#pragma unroll 8
    for (int i = 0; i < 16; ++i) { const int kk = 4 * i + (lane >> 4); f32x4 v = (f32x4){0.f, 0.f, 0.f, 0.f};
        if (srccol4 >= 0) { v = *(const GAS f32x4*)(W + (size_t)(k0 + kk) * ldw + srccol4); if (gk) v = v * gk[k0 + kk]; }
        *(LAS f32x4*)(scr + kk * 68 + c4) = v; }
    LDS_WAIT(); asm volatile("" ::: "memory");
    bf16* orow = WT + (size_t)(drow0 + lane) * K + k0;
#pragma unroll
    for (int k8 = 0; k8 < 8; ++k8) { const LAS float* s = scr + (8 * k8) * 68 + lane;
        v4u o; if (h16) { o.x = pkh(s[0 * 68], s[1 * 68]); o.y = pkh(s[2 * 68], s[3 * 68]); o.z = pkh(s[4 * 68], s[5 * 68]); o.w = pkh(s[6 * 68], s[7 * 68]); }
        else { o.x = pk2(s[0 * 68], s[1 * 68]); o.y = pk2(s[2 * 68], s[3 * 68]); o.z = pk2(s[4 * 68], s[5 * 68]); o.w = pk2(s[6 * 68], s[7 * 68]); }
        *(GAS v4u*)(orow + 8 * k8) = o; }
    LDS_WAIT(); asm volatile("" ::: "memory");
}
struct TrIn { const float *w_in, *gq, *gkv, *w_uq, *w_uk, *w_uv, *w_a, *w_b, *w_o, *w_up, *w_dn, *w_pg, *w_pe; };
struct TrItem { const float* W; const float* gk; bf16* WT; int ldw, K, k0, drow0, srccol4, mode; float wmul; };
constexpr int TR_E0 = 32 * 72, TR_E1 = TR_E0 + 8 * 48, TR_E2 = TR_E1 + 8 * 32, TR_E3 = TR_E2 + 8 * 32, TR_E4 = TR_E3 + 4 * 32, TR_E5 = TR_E4 + 1024, TR_E6 = TR_E5 + 1024, TR_E7 = TR_E6 + 1024, TR_E8 = TR_E7 + 1024,
              TR_E9 = TR_E8 + 32 * 176, TR_E10 = TR_E9 + 88 * 32, TR_E11 = TR_E10 + 32 * 64;
__device__ __forceinline__ TrItem tr_decode(const TrIn& I, unsigned char* ws, int it, int lane) {
    TrItem t; int r, nblk, map = 0; t.gk = nullptr; t.mode = 0; t.wmul = 1.f; int rowoff = 0;
    if (it < 32 * 20) { r = it; nblk = 20; t.W = I.w_in; t.ldw = DIN; t.WT = (bf16*)(ws + WS_WIN); t.K = 2048; map = 5; t.mode = 1; }
    else if (it < TR_E0) { r = it - 32 * 20; nblk = 52; t.W = I.w_in; t.ldw = DIN; t.WT = (bf16*)(ws + WS_WIN8); t.K = 2048; map = 6; t.mode = 2; t.wmul = 64.f; }
    else if (it < TR_E1) { r = it - TR_E0; nblk = 48; t.W = I.w_uq; t.ldw = 3072; t.WT = (bf16*)(ws + WS_WUQ); t.K = 512; map = 2; t.gk = I.gq; t.mode = 2; t.wmul = 32.f; }
    else if (it < TR_E2) { r = it - TR_E1; nblk = 32; t.W = I.w_uk; t.ldw = 2048; t.WT = (bf16*)(ws + WS_WKV); t.K = 512; t.gk = I.gkv; t.mode = 2; t.wmul = 32.f; }
    else if (it < TR_E3) { r = it - TR_E2; nblk = 32; t.W = I.w_uv; t.ldw = 2048; t.WT = (bf16*)(ws + WS_WKV); t.K = 512; t.gk = I.gkv; rowoff = 2048; t.mode = 2; t.wmul = 32.f; }
    else if (it < TR_E4) { r = it - TR_E3; nblk = 32; t.W = I.w_pe; t.ldw = 2048; t.WT = (bf16*)(ws + WS_WPE); t.K = 256; }
    else if (it < TR_E5) { r = it - TR_E4; nblk = 32; t.W = I.w_a; t.ldw = 2048; t.WT = (bf16*)(ws + WS_WA); t.K = 2048; t.mode = 2; t.wmul = 64.f; }
    else if (it < TR_E6) { r = it - TR_E5; nblk = 32; t.W = I.w_b; t.ldw = 2048; t.WT = (bf16*)(ws + WS_WB); t.K = 2048; t.mode = 2; t.wmul = 64.f; }
    else if (it < TR_E7) { r = it - TR_E6; nblk = 32; t.W = I.w_o; t.ldw = 2048; t.WT = (bf16*)(ws + WS_WO); t.K = 2048; t.mode = 2; t.wmul = 64.f; }
    else if (it < TR_E8) { r = it - TR_E7; nblk = 32; t.W = I.w_pg; t.ldw = 2048; t.WT = (bf16*)(ws + WS_WPG); t.K = 2048; t.mode = 2; t.wmul = 64.f; }
    else if (it < TR_E9) { r = it - TR_E8; nblk = 176; t.W = I.w_up; t.ldw = NUP; t.WT = (bf16*)(ws + WS_WUP); t.K = 2048; map = 3; t.mode = 2; t.wmul = 64.f; }
    else if (it < TR_E10) { r = it - TR_E9; nblk = 32; t.W = I.w_dn; t.ldw = 2048; t.WT = (bf16*)(ws + WS_WDN); t.K = DFF; t.mode = 2; t.wmul = 128.f; }
    else { r = it - TR_E10; nblk = 64; t.W = I.w_in; t.ldw = DIN; t.WT = (bf16*)(ws + WS_WG); t.K = 2048; map = 4; t.mode = 2; t.wmul = 64.f; }
    const int kb = r / nblk, nb = r - kb * nblk, n0 = nb * 64, nl = n0 + 4 * (lane & 15);
    t.k0 = kb * 64; t.drow0 = rowoff + n0; t.srccol4 = map == 0 ? nl : map == 5 ? srcmap<1>(nl < 1024 ? 2048 + nl : 2304 + nl) : map == 6 ? srcmap<1>(nl < 2048 ? nl : nl < 2304 ? 1024 + nl : 1280 + nl) : map == 2 ? srcmap<2>(nl) : map == 3 ? srcmap<3>(nl) : U_G + nl;
    return t;
}
__device__ __forceinline__ void tr_load(const TrItem& t, f32x4 (&v)[16], int lane) {
#pragma unroll
    for (int i = 0; i < 16; ++i) { const int kk = 4 * i + (lane >> 4); v[i] = (f32x4){0.f, 0.f, 0.f, 0.f};
        if (t.srccol4 >= 0) { v[i] = *(const GAS f32x4*)(t.W + (size_t)(t.k0 + kk) * t.ldw + t.srccol4); if (t.gk) v[i] = v[i] * t.gk[t.k0 + kk]; } }
}
__device__ __forceinline__ void tr_all(const TrIn& I, unsigned char* ws, LAS float* scr, int gw, int NGW, int lane) {
    int it = gw; if (it >= TR_E11) return;
    TrItem cur = tr_decode(I, ws, it, lane); f32x4 v[16]; tr_load(cur, v, lane);
    for (;;) {
        const int c4 = (lane & 15) * 4;
#pragma unroll
        for (int i = 0; i < 16; ++i) *(LAS f32x4*)(scr + (4 * i + (lane >> 4)) * 68 + c4) = v[i];
        LDS_WAIT(); asm volatile("" ::: "memory");
        const int itn = it + NGW; const bool more = itn < TR_E11; TrItem nxt = cur;
        if (more) { nxt = tr_decode(I, ws, itn, lane); tr_load(nxt, v, lane); }
        if (cur.mode == 2) { unsigned char* orow = (unsigned char*)cur.WT + (size_t)(cur.drow0 + lane) * cur.K + cur.k0; const float wm = cur.wmul;
#pragma unroll
            for (int k16 = 0; k16 < 4; ++k16) { const LAS float* s = scr + (16 * k16) * 68 + lane; v4u o;
                o.x = pkf8(s[0 * 68] * wm, s[1 * 68] * wm, s[2 * 68] * wm, s[3 * 68] * wm); o.y = pkf8(s[4 * 68] * wm, s[5 * 68] * wm, s[6 * 68] * wm, s[7 * 68] * wm);
                o.z = pkf8(s[8 * 68] * wm, s[9 * 68] * wm, s[10 * 68] * wm, s[11 * 68] * wm); o.w = pkf8(s[12 * 68] * wm, s[13 * 68] * wm, s[14 * 68] * wm, s[15 * 68] * wm);
                *(GAS v4u*)(orow + 16 * k16) = o; } }
        else { bf16* orow = cur.WT + (size_t)(cur.drow0 + lane) * cur.K + cur.k0;
#pragma unroll
        for (int k8 = 0; k8 < 8; ++k8) { const LAS float* s = scr + (8 * k8) * 68 + lane;
            v4u o; if (cur.mode == 1) { o.x = pkh(s[0 * 68], s[1 * 68]); o.y = pkh(s[2 * 68], s[3 * 68]); o.z = pkh(s[4 * 68], s[5 * 68]); o.w = pkh(s[6 * 68], s[7 * 68]); }
            else { o.x = pk2(s[0 * 68], s[1 * 68]); o.y = pk2(s[2 * 68], s[3 * 68]); o.z = pk2(s[4 * 68], s[5 * 68]); o.w = pk2(s[6 * 68], s[7 * 68]); }
            *(GAS v4u*)(orow + 8 * k8) = o; } }
        LDS_WAIT(); asm volatile("" ::: "memory");
        if (!more) break;
        cur = nxt; it = itn;
    }
}
__device__ __forceinline__ void cvt_flat_h(const float* src, bf16* dst, unsigned char* dst8, size_t n8, size_t gt, size_t NT) {
    for (size_t i = gt; i < n8; i += 4 * NT) { f32x4 a[4], b[4];
#pragma unroll
        for (int u = 0; u < 4; ++u) { a[u] = *(const GAS f32x4*)(src + (i + u * NT) * 8); b[u] = *(const GAS f32x4*)(src + (i + u * NT) * 8 + 4); }
#pragma unroll
        for (int u = 0; u < 4; ++u) { *(GAS v4u*)(dst + (i + u * NT) * 8) = pack8h(a[u], b[u]);
            u32x2 w; w.x = pkf8(a[u][0], a[u][1], a[u][2], a[u][3]); w.y = pkf8(b[u][0], b[u][1], b[u][2], b[u][3]); *(GAS u32x2*)(dst8 + (i + u * NT) * 8) = w; } }
}
__device__ __forceinline__ void cvt_flat(const float* src, bf16* dst, size_t n8, size_t gt, size_t NT) {
    for (size_t i = gt; i < n8; i += 4 * NT) { f32x4 a[4], b[4];
#pragma unroll
        for (int u = 0; u < 4; ++u) { a[u] = *(const GAS f32x4*)(src + (i + u * NT) * 8); b[u] = *(const GAS f32x4*)(src + (i + u * NT) * 8 + 4); }
#pragma unroll
        for (int u = 0; u < 4; ++u) *(GAS v4u*)(dst + (i + u * NT) * 8) = pack8(a[u], b[u]); }
}

typedef const pg8::f32x4 (&AccRef)[2][2][4][2];
using pg8::f32x2;
using pg8::Unit;
#define EPI_ROWS(ai, m) for (int ai = 0; ai < 2; ++ai) _Pragma("unroll") for (int m = 0; m < 4; ++m)

template <int PM> struct EpiU {
    static constexpr bool PERM = true, AFTER_DRAIN = false;
    bf16 *QA, *QI, *KA, *VA, *KI, *KR, *CQ, *CKV; float* WI; float* SSQ; const float* ROPE;
    __device__ __forceinline__ void operator()(AccRef acc, const Unit& u, int wr, int wc, int fr, int fq) const {
        { int t_ = threadIdx.x; asm volatile("" : "+v"(t_)); fr = t_ & 15; fq = (t_ >> 4) & 3; }
        const int pn = PM == 1 ? (u.pn < 8 ? u.pn : u.pn == 8 ? 12 : u.pn + 5) : (u.pn < 4 ? 8 + u.pn : 13), rowb = u.pm * 256 + wr * 64 + fr, cw = wc * 32 + 8 * fq;
        if (pn < 12) {
            bf16* base = pn < 8 ? QA : QI; const int ldc = pn < 8 ? 2048 : 1024, colt = (pn < 8 ? pn : pn - 8) * 256; const float sc = pn < 8 ? QA_SCALE : 1.f;
#pragma unroll
            EPI_ROWS(ai, m) { bf16* rp = base + (size_t)(rowb + ai * 128 + m * 16) * ldc + colt + cw;
#pragma unroll
                for (int bj = 0; bj < 2; ++bj) *(GAS v4u*)(rp + bj * 128) = pn < 8 ? pack8(acc[ai][bj][m][0] * sc, acc[ai][bj][m][1] * sc) : pack8h(acc[ai][bj][m][0], acc[ai][bj][m][1]); }
        } else if (pn == 12) {
#pragma unroll
            EPI_ROWS(ai, m) { const size_t row = rowb + ai * 128 + m * 16;
                *(GAS v4u*)(KA + row * 128 + cw) = pack8(acc[ai][0][m][0], acc[ai][0][m][1]);
                *(GAS v4u*)(VA + row * 128 + cw) = pack8(acc[ai][1][m][0], acc[ai][1][m][1]); }
        } else if (pn == 13) {
#pragma unroll
            EPI_ROWS(ai, m) { const size_t row = rowb + ai * 128 + m * 16; const int pos = (int)(row & (SEQ - 1));
                const f32x4 v0 = acc[ai][0][m][0], v1 = acc[ai][0][m][1];
                if (wc < 2) { *(GAS v4u*)(KI + (row & ~(size_t)31) * 64 + (2 * wc + (fq >> 1)) * 512 + ((fq & 1) * 32 + (int)(row & 31)) * 8) = pack8h(v0, v1); }
                else { const int g = 4 * (wc - 2) + fq; const f32x4 c4 = *(const GAS f32x4*)(ROPE + pos * 32 + 4 * g), s4 = *(const GAS f32x4*)(ROPE + SEQ * 32 + pos * 32 + 4 * g);
                    const f32x4 y1 = v0 * c4 - v1 * s4, y2 = v0 * s4 + v1 * c4; GAS unsigned char* kr8 = (GAS unsigned char*)KR + row * 64 + 4 * g;
                    *(GAS unsigned*)kr8 = pkf8(y1[0], y1[1], y1[2], y1[3]); *(GAS unsigned*)(kr8 + 32) = pkf8(y2[0], y2[1], y2[2], y2[3]); }
                if (wc == 0 && fq < 2) { *(GAS f32x4*)(WI + row * 16 + 8 * fq) = acc[ai][1][m][0]; *(GAS f32x4*)(WI + row * 16 + 8 * fq + 4) = acc[ai][1][m][1]; } }
        } else {
            const int t = pn - 14; bf16* base = t < 2 ? CQ : CKV; float* ssq = SSQ + (t < 2 ? (size_t)0 : (size_t)M * 8); const int colt = (t & 1) * 256;
#pragma unroll
            EPI_ROWS(ai, m) { const size_t row = rowb + ai * 128 + m * 16; float s = 0.f;
#pragma unroll
                for (int bj = 0; bj < 2; ++bj) { const f32x4 v0 = acc[ai][bj][m][0], v1 = acc[ai][bj][m][1];
                    { u32x2 w8; w8.x = pkf8(v0[0], v0[1], v0[2], v0[3]); w8.y = pkf8(v1[0], v1[1], v1[2], v1[3]); *(GAS u32x2*)((GAS unsigned char*)base + row * 512 + colt + bj * 128 + cw) = w8; }
                    s += (v0[0] * v0[0] + v0[1] * v0[1]) + (v0[2] * v0[2] + v0[3] * v0[3]) + (v1[0] * v1[0] + v1[1] * v1[1]) + (v1[2] * v1[2] + v1[3] * v1[3]); }
                s = sum_x32(sum_x16(s));
                if (fq == 0) ssq[row * 8 + (t & 1) * 4 + wc] = s; }
        }
    }
};
struct EpiQ {
    static constexpr bool PERM = true, AFTER_DRAIN = false;
    bf16 *QN, *QR; const float* SSQ; const float* ROPE;
    __device__ __forceinline__ void operator()(AccRef acc, const Unit& u, int wr, int wc, int fr, int fq) const {
        { int t_ = threadIdx.x; asm volatile("" : "+v"(t_)); fr = t_ & 15; fq = (t_ >> 4) & 3; }
        const int pn = u.pn, rowb = u.pm * 256 + wr * 64 + fr, cw = wc * 32 + 8 * fq;
#pragma unroll
        EPI_ROWS(ai, m) { const size_t row = rowb + ai * 128 + m * 16;
            const f32x4 sa = *(const GAS f32x4*)(SSQ + row * 8), sb = *(const GAS f32x4*)(SSQ + row * 8 + 4); const float r = (8.f * QB_SCALE) / sqrtf((((sa[0] + sa[1]) + (sa[2] + sa[3])) + ((sb[0] + sb[1]) + (sb[2] + sb[3]))) * (1.f / 512.f) + RMS_EPS);
            if (pn < 8) {
#pragma unroll
                for (int bj = 0; bj < 2; ++bj) { const f32x4 v0 = acc[ai][bj][m][0] * r, v1 = acc[ai][bj][m][1] * r; u32x2 w; w.x = pkf8(v0[0], v0[1], v0[2], v0[3]); w.y = pkf8(v1[0], v1[1], v1[2], v1[3]);
                    *(GAS u32x2*)((GAS unsigned char*)QN + row * 2048 + pn * 256 + bj * 128 + cw) = w; }
            } else { const int pos = (int)(row & (SEQ - 1)), g = 4 * (wc & 1) + fq;
                const f32x4 c4 = *(const GAS f32x4*)(ROPE + pos * 32 + 4 * g) * r, s4 = *(const GAS f32x4*)(ROPE + SEQ * 32 + pos * 32 + 4 * g) * r;
#pragma unroll
                for (int bj = 0; bj < 2; ++bj) { const int head = (pn - 8) * 4 + bj * 2 + (wc >> 1); const f32x4 v0 = acc[ai][bj][m][0], v1 = acc[ai][bj][m][1];
                    const f32x4 y1 = v0 * c4 - v1 * s4, y2 = v0 * s4 + v1 * c4; GAS unsigned char* q8 = (GAS unsigned char*)QR + row * 1024 + head * 64 + 4 * g;
                    *(GAS unsigned*)q8 = pkf8(y1[0], y1[1], y1[2], y1[3]); *(GAS unsigned*)(q8 + 32) = pkf8(y2[0], y2[1], y2[2], y2[3]); } } }
    }
};
struct EpiKV {
    static constexpr bool PERM = true, AFTER_DRAIN = false;
    bf16 *KN, *VB; const float* SSQ;
    __device__ __forceinline__ void operator()(AccRef acc, const Unit& u, int wr, int wc, int fr, int fq) const {
        { int t_ = threadIdx.x; asm volatile("" : "+v"(t_)); fr = t_ & 15; fq = (t_ >> 4) & 3; }
        const int pn = u.pn, rowb = u.pm * 256 + wr * 64 + fr, cw = wc * 32 + 8 * fq; bf16* base = pn < 8 ? KN : VB; const int colt = (pn & 7) * 256;
#pragma unroll
        EPI_ROWS(ai, m) { const size_t row = rowb + ai * 128 + m * 16; const f32x4 sa = *(const GAS f32x4*)(SSQ + row * 8), sb = *(const GAS f32x4*)(SSQ + row * 8 + 4); const float r = 1.0f / sqrtf((((sa[0] + sa[1]) + (sa[2] + sa[3])) + ((sb[0] + sb[1]) + (sb[2] + sb[3]))) * (1.f / 512.f) + RMS_EPS);
#pragma unroll
            for (int bj = 0; bj < 2; ++bj) { const f32x4 v0 = acc[ai][bj][m][0] * r, v1 = acc[ai][bj][m][1] * r;
                if (pn < 8) { u32x2 w; w.x = pkf8(v0[0], v0[1], v0[2], v0[3]); w.y = pkf8(v1[0], v1[1], v1[2], v1[3]); *(GAS u32x2*)((GAS unsigned char*)KN + row * 2048 + colt + bj * 128 + cw) = w; }
                else *(GAS v4u*)(VB + row * 2048 + colt + bj * 128 + cw) = pack8(v0, v1); } }
    }
};
__device__ __forceinline__ void unpack8f8(const u32x2 w, f32x4& a, f32x4& b) {
    const f32x2 a0 = __builtin_amdgcn_cvt_pk_f32_fp8((int)w.x, false), a1 = __builtin_amdgcn_cvt_pk_f32_fp8((int)w.x, true), b0 = __builtin_amdgcn_cvt_pk_f32_fp8((int)w.y, false), b1 = __builtin_amdgcn_cvt_pk_f32_fp8((int)w.y, true);
    a = (f32x4){a0[0], a0[1], a1[0], a1[1]}; b = (f32x4){b0[0], b0[1], b1[0], b1[1]};
}
__device__ __forceinline__ u32x2 pack8f8(const f32x4 a, const f32x4 b) { u32x2 w; w.x = pkf8(a[0], a[1], a[2], a[3]); w.y = pkf8(b[0], b[1], b[2], b[3]); return w; }
template <int MODE> struct EpiB {
    static constexpr bool PERM = true, AFTER_DRAIN = false;
    bf16* O; int ldc; const bf16* gp; const float* bias; unsigned char* O8;
    __device__ __forceinline__ void operator()(AccRef acc, const Unit& u, int wr, int wc, int fr, int fq) const {
        { int t_ = threadIdx.x; asm volatile("" : "+v"(t_)); fr = t_ & 15; fq = (t_ >> 4) & 3; }
        const int rowb = u.pm * 256 + wr * 64 + fr, colb = u.pn * 256 + wc * 32 + 8 * fq;
#pragma unroll
        EPI_ROWS(ai, m) { const size_t row = rowb + ai * 128 + m * 16;
#pragma unroll
            for (int bj = 0; bj < 2; ++bj) { const int col = colb + bj * 128; f32x4 v0 = acc[ai][bj][m][0], v1 = acc[ai][bj][m][1]; GAS unsigned char* op = (GAS unsigned char*)O + row * ldc + col;
                if (MODE == 1) { v0 = sigmoid4(v0); v1 = sigmoid4(v1); }
                if (MODE == 2 || MODE == 5) { f32x4 g0, g1; unpack8f8(*(const GAS u32x2*)((const GAS unsigned char*)gp + row * 4096 + col), g0, g1); v0 = v0 * g0; v1 = v1 * g1; }
                if (MODE == 5) { f32x4 o0, o1; unpack8f8(*(const GAS u32x2*)op, o0, o1); v0 = v0 + o0; v1 = v1 + o1; }
                if (MODE == 4) { f32x4 o0, o1; unpack8f8(*(const GAS u32x2*)op, o0, o1); const f32x4 b0 = *(const GAS f32x4*)(bias + col), b1 = *(const GAS f32x4*)(bias + col + 4);
                    v0 = sigmoid4(v0 + b0) * o0; v1 = sigmoid4(v1 + b1) * o1; }
                if (MODE == 5) *(GAS u32x2*)(O8 + row * ldc + col) = pack8f8(v0, v1);
                else *(GAS u32x2*)op = pack8f8(v0, v1); }
            if (MODE >= 2) asm volatile("" ::: "memory"); }
    }
};
template <int MODE> struct EpiF {
    static constexpr bool PERM = true, AFTER_DRAIN = false;
    bf16* zb; const float* xin; const bf16* ple;
    __device__ __forceinline__ void operator()(AccRef acc, const Unit& u, int wr, int wc, int fr, int fq) const {
        { int t_ = threadIdx.x; asm volatile("" : "+v"(t_)); fr = t_ & 15; fq = (t_ >> 4) & 3; }
        const int rowb = u.pm * 256 + wr * 64 + fr, colb = u.pn * 256 + wc * 32 + 8 * fq;
#pragma unroll
        EPI_ROWS(ai, m) { const size_t row = rowb + ai * 128 + m * 16;
#pragma unroll
            for (int bj = 0; bj < 2; ++bj) { const size_t off = row * 2048 + colb + bj * 128; f32x4 v0 = acc[ai][bj][m][0], v1 = acc[ai][bj][m][1]; f32x4 x0, x1;
                if (MODE == 0) { x0 = *(const GAS f32x4*)(xin + off); x1 = *(const GAS f32x4*)(xin + off + 4); } else unpack8(*(const GAS v4u*)(zb + off), x0, x1);
                v0 = v0 + x0 * ALPHA; v1 = v1 + x1 * ALPHA;
                if (MODE == 1) { f32x4 p0, p1; unpack8f8(*(const GAS u32x2*)((const GAS unsigned char*)ple + off), p0, p1); v0 = v0 + p0; v1 = v1 + p1; }
                *(GAS v4u*)(zb + off) = pack8(v0, v1); }
            asm volatile("" ::: "memory"); }
    }
};
template <int CTRL> __device__ __forceinline__ f32x4 dpp4(f32x4 v) { return (f32x4){dppf<CTRL>(v[0]), dppf<CTRL>(v[1]), dppf<CTRL>(v[2]), dppf<CTRL>(v[3])}; }
__device__ __forceinline__ f32x4 sel4(bool c, f32x4 a, f32x4 b) { return (f32x4){c ? a[0] : b[0], c ? a[1] : b[1], c ? a[2] : b[2], c ? a[3] : b[3]}; }
struct EpiUp {
    static constexpr bool PERM = true, AFTER_DRAIN = false;
    unsigned char* ACT; float* HEADB; float* TAILB; const float* cw; const float* cb;
    __device__ __forceinline__ void operator()(AccRef acc, const Unit& u, int wr, int wc, int fr, int fq) const {
        { int t_ = threadIdx.x; asm volatile("" : "+v"(t_)); fr = t_ & 15; fq = (t_ >> 4) & 3; }
        const unsigned ch0 = (unsigned)(u.pn * 128 + wc * 32 + 8 * fq), cp0 = (unsigned)(u.pn * 256 + wc * 32 + 8 * fq);
        const GAS unsigned char* cwb = (const GAS unsigned char*)cw; const GAS unsigned char* cbb = (const GAS unsigned char*)cb; GAS unsigned char* actb = (GAS unsigned char*)ACT;
#pragma unroll
        for (int ai = 0; ai < 2; ++ai) {
            const unsigned g = (unsigned)(u.pm * 4 + ai * 2 + wr), row0 = g * 64u + (unsigned)fr;
            if (fr < 2) { GAS unsigned char* hp = (GAS unsigned char*)HEADB + ((g * 2u + (unsigned)fr) * (unsigned)NUP + cp0) * 4u;
#pragma unroll
                for (int bj = 0; bj < 2; ++bj)
#pragma unroll
                    for (int n = 0; n < 2; ++n) *(GAS f32x4*)(hp + (bj * 128 + 4 * n) * 4) = acc[ai][bj][0][n]; }
            if (fr >= 14) { GAS unsigned char* hp = (GAS unsigned char*)TAILB + ((g * 2u + (unsigned)(fr - 14)) * (unsigned)NUP + cp0) * 4u;
#pragma unroll
                for (int bj = 0; bj < 2; ++bj)
#pragma unroll
                    for (int n = 0; n < 2; ++n) *(GAS f32x4*)(hp + (bj * 128 + 4 * n) * 4) = acc[ai][bj][3][n]; }
            asm volatile("" ::: "memory"); __builtin_amdgcn_sched_barrier(0);
#pragma unroll
            for (int n = 0; n < 2; ++n) {
                unsigned pk[4];
#pragma unroll
                for (int hf = 0; hf < 2; ++hf) {
                    asm volatile("" ::: "memory"); __builtin_amdgcn_sched_barrier(0);
                    f32x2 yg[4];
#pragma unroll
                    for (int bj = 0; bj < 2; ++bj) { const unsigned cB = (ch0 + (unsigned)(4 * n + 2 * hf + bj * DFF)) * 4u;
                        const f32x2 w0 = *(const GAS f32x2*)(cwb + cB), w1 = *(const GAS f32x2*)(cwb + (cB + (unsigned)NUP * 4u)), w2 = *(const GAS f32x2*)(cwb + (cB + (unsigned)NUP * 8u)), bb = *(const GAS f32x2*)(cbb + cB);
                        f32x2 pr1 = (f32x2){0.f, 0.f}, pr2 = pr1;
#pragma unroll
                        for (int m = 0; m < 4; ++m) { const f32x4 v4 = acc[ai][bj][m][n]; const f32x2 v = hf ? (f32x2){v4[2], v4[3]} : (f32x2){v4[0], v4[1]};
                            const f32x2 r1 = (f32x2){dppf<0x121>(v[0]), dppf<0x121>(v[1])}, r2 = (f32x2){dppf<0x122>(v[0]), dppf<0x122>(v[1])};
                            const f32x2 p1 = fr >= 1 ? r1 : pr1, p2 = fr >= 2 ? r2 : pr2;
                            const f32x2 y = bb + w2 * v + w1 * p1 + w0 * p2; pr1 = r1; pr2 = r2;
                            if (bj == 0) yg[m] = y;
                            else { const f32x2 sg = (f32x2){sigmoidf_(yg[m][0]), sigmoidf_(yg[m][1])}; const f32x2 a = yg[m] * sg * y;
                                if (hf == 0) pk[m] = (unsigned)__builtin_amdgcn_cvt_pk_fp8_f32(a[0], a[1], 0, false);
                                else { const unsigned w = (unsigned)__builtin_amdgcn_cvt_pk_fp8_f32(a[0], a[1], (int)pk[m], true); if (!(m == 0 && fr < 2)) *(GAS unsigned*)(actb + ((row0 + (unsigned)(m * 16)) * (unsigned)DFF + ch0 + (unsigned)(4 * n))) = w; } } }
                        asm volatile("" ::: "memory"); __builtin_amdgcn_sched_barrier(0); }
                }
            }
        }
    }
};

namespace dsa {
constexpr int CAP = 512, TOPK = 256;
typedef unsigned long long u64;
typedef unsigned short u16;
__device__ __forceinline__ unsigned fkey(float f) { const unsigned u = __float_as_uint(f); return u ^ ((unsigned)((int)u >> 31) | 0x80000000u); }
__device__ __forceinline__ float keyf(unsigned k) { const unsigned u = (k & 0x80000000u) ? (k ^ 0x80000000u) : ~k; return __uint_as_float(u); }
__device__ __forceinline__ int mbcnt64(u64 m) { return (int)__builtin_amdgcn_mbcnt_hi((unsigned)(m >> 32), __builtin_amdgcn_mbcnt_lo((unsigned)m, 0u)); }

__device__ __forceinline__ unsigned wave_umax(unsigned v) {
#define DSA_UDPP(c_) (unsigned)__builtin_amdgcn_update_dpp(0, (int)v, c_, 0xf, 0xf, false)
    v = max(v, DSA_UDPP(0xB1)); v = max(v, DSA_UDPP(0x4E)); v = max(v, DSA_UDPP(0x141)); v = max(v, DSA_UDPP(0x140));
#undef DSA_UDPP
    { auto r = __builtin_amdgcn_permlane16_swap(v, v, false, false); v = max(r[0], r[1]); }
    { auto r = __builtin_amdgcn_permlane32_swap(v, v, false, false); v = max(r[0], r[1]); }
    return v;
}
__device__ __forceinline__ unsigned compact(LAS u64* buf, int n, int lane, unsigned lowk, bool exact, int& nout) {
    unsigned key[8], idx[8];
#pragma unroll
    for (int e = 0; e < 8; ++e) { const int i = lane + 64 * e; u64 v = 0ull; if (i < n) v = buf[i]; key[e] = (unsigned)(v >> 32); idx[e] = (unsigned)v; }
    unsigned mx = key[0];
#pragma unroll
    for (int e = 1; e < 8; ++e) mx = max(mx, key[e]);
    mx = (unsigned)__builtin_amdgcn_readfirstlane((int)wave_umax(mx));
    const unsigned diff = lowk ^ mx; unsigned P = lowk;
    if (diff) { const int hb = 31 - __builtin_clz(diff); P = hb == 31 ? 0u : (lowk >> (hb + 1)) << (hb + 1); const int lob = exact ? 0 : (hb > 15 ? hb - 15 : 0);
#pragma unroll 1
        for (int b = hb; b >= lob; --b) { const unsigned cand = P | (1u << b); int c = 0;
#pragma unroll
            for (int e = 0; e < 8; ++e) c += __builtin_popcountll(__ballot(key[e] >= cand));
            if (c >= TOPK) P = cand; } }
    int cgt = 0;
#pragma unroll
    for (int e = 0; e < 8; ++e) cgt += __builtin_popcountll(__ballot(key[e] > P));
    const int need = exact ? TOPK - cgt : CAP; int base = 0, eqbase = 0;
#pragma unroll
    for (int e = 0; e < 8; ++e) { const bool gt = key[e] > P, eq = key[e] == P && key[e] != 0u; const u64 beq = __ballot(eq); const bool sel = gt || (eq && (eqbase + mbcnt64(beq)) < need);
        const u64 bs = __ballot(sel); const int pos = base + mbcnt64(bs);
        if (sel) buf[pos] = ((u64)key[e] << 32) | idx[e];
        base += __builtin_popcountll(bs); eqbase += __builtin_popcountll(beq); }
    asm volatile("s_waitcnt lgkmcnt(0)" ::: "memory");
    nout = base;
    return P;
}

struct Ptrs { const bf16 *QI, *KI, *KA, *VA; const float* WI; const bf16* QA; bf16* O; unsigned short* SEL; };

__device__ __forceinline__ void attend(const Ptrs& P, int b, int t, const LAS u16* idl, LAS unsigned char* vbuf, int lane) {
    const int head = lane & 15, g = lane >> 4; const size_t m = (size_t)b * SEQ + t;
    bf16x8 Bq[4];
#pragma unroll
    for (int ks = 0; ks < 4; ++ks) Bq[ks] = *(const GAS bf16x8*)(P.QA + m * 2048 + head * 128 + 32 * ks + 8 * g);
    const float slope2 = __builtin_amdgcn_exp2f(-0.5f * (float)(head + 1)) * LOG2E;
    const bf16* vab = P.VA + (size_t)b * SEQ * 128;
    v4u st[8];
#define DSA_VLOAD(kk) do { _Pragma("unroll") for (int u_ = 0; u_ < 8; ++u_) { const int row_ = 4 * u_ + g; unsigned s_ = idl[32 * (kk) + row_]; s_ = s_ == 0xFFFFu ? 0u : s_; \
        const int cl_ = (lane & 15) ^ ((row_ & 7) << 1); st[u_] = *(const GAS v4u*)(vab + (size_t)s_ * 128 + cl_ * 8); } } while (0)
#define DSA_VWRITE(kk) do { _Pragma("unroll") for (int u_ = 0; u_ < 8; ++u_) *(LAS v4u*)(vbuf + ((kk) & 1) * 8192 + u_ * 1024 + lane * 16) = st[u_]; } while (0)
    DSA_VLOAD(0);
    const bf16* kab = P.KA + (size_t)b * SEQ * 128 + 8 * g;
    f32x4 L[16];
    bf16x8 Af[16][4];
#define DSA_KLD(i_) do { unsigned s_ = idl[16 * (i_) + head]; s_ = s_ == 0xFFFFu ? 0u : s_; const bf16* kp_ = kab + (size_t)s_ * 128; \
        _Pragma("unroll") for (int ks = 0; ks < 4; ++ks) Af[i_][ks] = *(const GAS bf16x8*)(kp_ + 32 * ks); } while (0)
    DSA_KLD(0); __builtin_amdgcn_sched_barrier(0); DSA_KLD(1); __builtin_amdgcn_sched_barrier(0); DSA_KLD(2); __builtin_amdgcn_sched_barrier(0);
#pragma unroll
    for (int i = 0; i < 16; ++i) {
        if (i + 3 < 16) { DSA_KLD(i + 3 < 16 ? i + 3 : 15); } __builtin_amdgcn_sched_barrier(0);
        f32x4 C = (f32x4){0.f, 0.f, 0.f, 0.f};
#pragma unroll
        for (int ks = 0; ks < 4; ++ks) C = __builtin_amdgcn_mfma_f32_16x16x32_bf16(Af[i][ks], Bq[ks], C, 0, 0, 0);
        const u32x2 idw = *(const LAS u32x2*)(idl + 16 * i + 4 * g);
        const unsigned i0 = idw.x & 0xffffu, i1 = idw.x >> 16, i2 = idw.y & 0xffffu, i3 = idw.y >> 16;
        L[i][0] = i0 == 0xFFFFu ? -__builtin_inff() : C[0] - slope2 * (float)(t - (int)i0);
        L[i][1] = i1 == 0xFFFFu ? -__builtin_inff() : C[1] - slope2 * (float)(t - (int)i1);
        L[i][2] = i2 == 0xFFFFu ? -__builtin_inff() : C[2] - slope2 * (float)(t - (int)i2);
        L[i][3] = i3 == 0xFFFFu ? -__builtin_inff() : C[3] - slope2 * (float)(t - (int)i3);
        __builtin_amdgcn_sched_barrier(0);
    }
#undef DSA_KLD
    float mx = -__builtin_inff();
#pragma unroll
    for (int i = 0; i < 16; ++i) mx = fmaxf(fmaxf(mx, fmaxf(L[i][0], L[i][1])), fmaxf(L[i][2], L[i][3]));
    mx = max_x32(max_x16(mx));
    float sum = 0.f;
#pragma unroll
    for (int i = 0; i < 16; ++i) {
#pragma unroll
        for (int r = 0; r < 4; ++r) { const float p = __builtin_amdgcn_exp2f(L[i][r] - mx); L[i][r] = p; sum += p; } }
    sum = sum_x32(sum_x16(sum));
    f32x4 O[8];
#pragma unroll
    for (int dt = 0; dt < 8; ++dt) O[dt] = (f32x4){0.f, 0.f, 0.f, 0.f};
    DSA_VWRITE(0); DSA_VLOAD(1);
    const int q4 = (lane >> 2) & 3, p4 = lane & 3, row1 = 4 * g + q4;
#pragma unroll
    for (int kk = 0; kk < 8; ++kk) {
        const v4u pw = pack8(L[2 * kk], L[2 * kk + 1]); const bf16x8 Pf = __builtin_bit_cast(bf16x8, pw);
        const LAS unsigned char* vb = vbuf + (kk & 1) * 8192 + row1 * 256 + 8 * p4;
        s16x4 lo[8], hi2[8];
#pragma unroll
        for (int dt = 0; dt < 8; ++dt) { const LAS unsigned char* a1 = vb + ((dt ^ (row1 & 7)) << 5);
            lo[dt] = __builtin_bit_cast(s16x4, __builtin_amdgcn_ds_read_tr16_b64_v4i16((LAS s16x4*)a1));
            hi2[dt] = __builtin_bit_cast(s16x4, __builtin_amdgcn_ds_read_tr16_b64_v4i16((LAS s16x4*)(a1 + 4096))); }
#pragma unroll
        for (int dt = 0; dt < 8; ++dt) {
            const bf16x8 Av = (bf16x8){lo[dt][0], lo[dt][1], lo[dt][2], lo[dt][3], hi2[dt][0], hi2[dt][1], hi2[dt][2], hi2[dt][3]};
            O[dt] = __builtin_amdgcn_mfma_f32_16x16x32_bf16(Av, Pf, O[dt], 0, 0, 0); }
        if (kk + 1 < 8) { DSA_VWRITE(kk + 1); if (kk + 2 < 8) DSA_VLOAD(kk + 2); }
    }
#undef DSA_VLOAD
#undef DSA_VWRITE
    const float inv = 1.0f / sum;
    unsigned char* op = (unsigned char*)P.O + m * 4096 + head * 128 + 4 * g;
#pragma unroll
    for (int dt = 0; dt < 8; ++dt) { const f32x4 o = O[dt] * inv; *(GAS unsigned*)(op + 16 * dt) = pkf8(o[0], o[1], o[2], o[3]); }
}

__device__ __forceinline__ void job(const Ptrs& P, int b, int t0, LAS unsigned char* wl, LAS u16* idl, int lane, volatile LAS unsigned* dbgp = nullptr) {
#if defined(DBG_SPIN)
    unsigned long long tcomp = 0ull, tatt = 0ull; const unsigned long long tj0 = __builtin_amdgcn_s_memrealtime();
#endif
    const int r32 = lane & 31, hi = lane >> 5;
    const int qsel = (r32 >> 2) & 1, headA = (r32 & 3) + 4 * (r32 >> 3);
    bf16x8 A[2][4]; float sg[2][16];
#pragma unroll
    for (int a = 0; a < 2; ++a) {
        const size_t mA = (size_t)b * SEQ + t0 + 2 * a + qsel; const float aw = P.WI[mA * 16 + headA];
#pragma unroll
        for (int d0 = 0; d0 < 4; ++d0) { f32x4 x0, x1; unpack8h(*(const GAS v4u*)(P.QI + mA * 1024 + headA * 64 + 16 * d0 + 8 * hi), x0, x1); A[a][d0] = __builtin_bit_cast(bf16x8, pack8h(x0 * aw, x1 * aw)); }
        const size_t mC = (size_t)b * SEQ + t0 + 2 * a + hi;
#pragma unroll
        for (int r4 = 0; r4 < 4; ++r4) { const f32x4 w4 = *(const GAS f32x4*)(P.WI + mC * 16 + 4 * r4);
#pragma unroll
            for (int j = 0; j < 4; ++j) sg[a][4 * r4 + j] = w4[j] < 0.f ? -__builtin_inff() : __builtin_inff(); }
    }
    LAS u64* cand = (LAS u64*)wl;
    int c0 = 0, c1 = 0, c2 = 0, c3 = 0; unsigned l0 = 0u, l1 = 0u, l2 = 0u, l3 = 0u; float tau0 = -__builtin_inff(), tau1 = -__builtin_inff();
    const int ntile = (t0 + 3) / 32 + 1;
    const bf16* kib = P.KI + (size_t)b * SEQ * 64 + 8 * lane;
    bf16x8 B0[4], B1[4], B2[4], B3[4];
#define DSA_LDK(B_, JN_) do { const int jn_ = (JN_) < ntile ? (JN_) : ntile - 1; _Pragma("unroll") for (int d0 = 0; d0 < 4; ++d0) B_[d0] = *(const GAS bf16x8*)(kib + (size_t)jn_ * 2048 + 512 * d0); } while (0)
    DSA_LDK(B0, 0); asm volatile("" ::: "memory"); DSA_LDK(B1, 1); asm volatile("" ::: "memory"); DSA_LDK(B2, 2); asm volatile("" ::: "memory"); DSA_LDK(B3, 3); asm volatile("" ::: "memory");
#if defined(DBG_SPIN)
#define DSA_TC0 const unsigned long long tc0 = __builtin_amdgcn_s_memrealtime();
#define DSA_TC1 tcomp += __builtin_amdgcn_s_memrealtime() - tc0;
#else
#define DSA_TC0
#define DSA_TC1
#endif
#define DSA_TILE(JT_, Bf) do { const int jt = (JT_); const int s = jt * 32 + r32; \
        f32x16 C0 = {}, C1 = {}; \
        _Pragma("unroll") for (int d0 = 0; d0 < 4; ++d0) C0 = __builtin_amdgcn_mfma_f32_32x32x16_f16(__builtin_bit_cast(f16x8, A[0][d0]), __builtin_bit_cast(f16x8, Bf[d0]), C0, 0, 0, 0); \
        _Pragma("unroll") for (int d0 = 0; d0 < 4; ++d0) C1 = __builtin_amdgcn_mfma_f32_32x32x16_f16(__builtin_bit_cast(f16x8, A[1][d0]), __builtin_bit_cast(f16x8, Bf[d0]), C1, 0, 0, 0); \
        DSA_LDK(Bf, jt + 4); \
        float scv[2]; \
        _Pragma("unroll") for (int a = 0; a < 2; ++a) { float s_ = 0.f;                                                    \
            _Pragma("unroll") for (int r = 0; r < 16; ++r) { s_ += __builtin_amdgcn_fmed3f(a == 0 ? C0[r] : C1[r], 0.f, sg[a][r]); if ((r & 3) == 3) asm volatile("" : "+v"(s_)); } \
            scv[a] = s_; } \
        _Pragma("unroll") for (int a = 0; a < 2; ++a) { \
            const float sc = scv[a]; \
            const int tq = t0 + 2 * a + hi; const float tau = a == 0 ? tau0 : tau1; \
            const bool pass = (s <= tq) && (sc > tau); \
            const u64 bal = __ballot(pass); \
            if (bal) { const unsigned blo = (unsigned)bal, bhi = (unsigned)(bal >> 32); \
                const int pre = hi ? (int)__builtin_amdgcn_mbcnt_hi(bhi, 0u) : (int)__builtin_amdgcn_mbcnt_lo(blo, 0u); \
                const int cq = a == 0 ? (hi ? c1 : c0) : (hi ? c3 : c2); \
                if (pass) cand[(2 * a + hi) * CAP + cq + pre] = ((u64)fkey(sc) << 32) | (unsigned)s; \
                if (a == 0) { c0 += __builtin_popcount(blo); c1 += __builtin_popcount(bhi); } else { c2 += __builtin_popcount(blo); c3 += __builtin_popcount(bhi); } } \
        } \
        const int lim = (jt == ntile - 1) ? TOPK : CAP - 32; \
        _Pragma("unroll 1") for (;;) { \
            const int q = c0 > lim ? 0 : c1 > lim ? 1 : c2 > lim ? 2 : c3 > lim ? 3 : -1; \
            if (q < 0) break; \
            int n = q == 0 ? c0 : q == 1 ? c1 : q == 2 ? c2 : c3; unsigned lowk = q == 0 ? l0 : q == 1 ? l1 : q == 2 ? l2 : l3; \
            asm volatile("s_waitcnt lgkmcnt(0)" ::: "memory"); \
            DSA_TC0 \
            bool ex = jt == ntile - 1; int nout; unsigned T; \
            _Pragma("unroll 1") for (;;) { T = compact(cand + q * CAP, n, lane, lowk, ex, nout); if (ex || nout <= lim) break; ex = true; n = nout; lowk = T; } \
            const float tf = keyf(T); \
            DSA_TC1 \
            if (q == 0) { c0 = nout; l0 = T; } else if (q == 1) { c1 = nout; l1 = T; } else if (q == 2) { c2 = nout; l2 = T; } else { c3 = nout; l3 = T; } \
            if ((q >> 1) == 0) { if (hi == (q & 1)) tau0 = tf; } else { if (hi == (q & 1)) tau1 = tf; } \
        } } while (0)
#pragma unroll 1
    for (int jt0 = 0; jt0 < ntile; jt0 += 4) { DSA_TILE(jt0, B0); DSA_TILE(jt0 + 1, B1); DSA_TILE(jt0 + 2, B2); DSA_TILE(jt0 + 3, B3); }
#undef DSA_TILE
#undef DSA_LDK
#undef DSA_TC0
#undef DSA_TC1
    asm volatile("s_waitcnt lgkmcnt(0)" ::: "memory");
#pragma unroll
    for (int q = 0; q < 4; ++q) { const int n = q == 0 ? c0 : q == 1 ? c1 : q == 2 ? c2 : c3;
#pragma unroll
        for (int e = 0; e < 4; ++e) { const int i = lane + 64 * e; unsigned v = 0xFFFFu; if (i < n) v = (unsigned)cand[q * CAP + i] & 0xFFFFu;
#if defined(DBG_FIXED_SEL)
            v = (t0 + q - i) >= 0 ? (unsigned)(t0 + q - i) : 0xFFFFu;
#endif
            idl[q * TOPK + i] = (u16)v; if (P.SEL) P.SEL[((size_t)b * SEQ + t0 + q) * TOPK + i] = (u16)v; } }
    asm volatile("s_waitcnt lgkmcnt(0)" ::: "memory");
#if defined(DBG_SPIN)
    const unsigned long long ta0 = __builtin_amdgcn_s_memrealtime();
#endif
#pragma unroll 1
    for (int q = 0; q < 4; ++q) attend(P, b, t0 + q, idl + q * TOPK, wl, lane);
#if defined(DBG_SPIN)
    tatt = __builtin_amdgcn_s_memrealtime() - ta0;
    if (dbgp && lane == 0) { dbgp[0] += (unsigned)tcomp; dbgp[1] += (unsigned)tatt; dbgp[2] += (unsigned)(__builtin_amdgcn_s_memrealtime() - tj0); }
#endif
}
}

namespace mla {
constexpr int NW = 8, QBLK = 32, KVBLK = 64, QB = 256;
constexpr int SHM_V = 16384, SHM_K = 8192, SHM_R = 4096;
constexpr int OFF_V = 0, OFF_K = 3 * SHM_V, OFF_R = OFF_K + 4 * SHM_K, OFF_WS = OFF_R + 4 * SHM_R, LDS_NEED = OFF_WS + NW * 64 * 4;
constexpr float THR = 8.f;
#define MLA_KSWZ(row, colB) ((row) * 256 + ((colB) ^ (((row) & 7) << 4)))
#define MLA_RSWZ(row, colB) ((row) * 128 + ((colB) ^ ((((row) >> 1) & 7) << 4)))
#define MLA_SBAR() __builtin_amdgcn_sched_barrier(0)
__device__ __forceinline__ int v_st(int k, int c) { const int kk = (k & ~0xC) | ((k & 4) << 1) | ((k & 8) >> 1); return ((kk >> 3) * 4 + (c >> 5)) * 512 + ((kk & 7) * 32 + (c & 31)) * 2; }
__device__ __forceinline__ int v_rd_base(int lane) { return ((lane & 3) << 3) | (((lane >> 2) & 3) << 6) | (((lane >> 4) & 1) << 5) | (((lane >> 5) & 1) << 8); }
constexpr int v_rd_off(int d0, int ks, int half) { return d0 * 512 + ks * 4096 + half * 2048; }
__device__ __forceinline__ int crow(int r, int hi) { return (r & 3) + 8 * (r >> 2) + 4 * hi; }
__device__ __forceinline__ unsigned cvtpk(float lo, float hi) { return pg8::cvt_pk_bf16(lo, hi); }

__device__ __forceinline__ void mask_tile(f32x16& p0, f32x16& p1, int dq) {
    const float NEG = -__builtin_inff();
#pragma unroll
    for (int r = 0; r < 16; ++r) { const int c = (r & 3) + 8 * (r >> 2);
        if (dq - c < 0) p0[r] = NEG;
        if (dq - c - 32 < 0) p1[r] = NEG; }
}
__device__ __forceinline__ void softmax_tile(f32x16& p0, f32x16& p1, float& m_reg, float& l_reg, float& alpha, bf16x8& pa0, bf16x8& pa1, bf16x8& pa2, bf16x8& pa3) {
    float pmax = p0[0];
#pragma unroll
    for (int r = 1; r < 16; ++r) pmax = fmaxf(pmax, p0[r]);
#pragma unroll
    for (int r = 0; r < 16; ++r) pmax = fmaxf(pmax, p1[r]);
    { auto rr = __builtin_amdgcn_permlane32_swap(__float_as_uint(pmax), __float_as_uint(pmax), false, false); pmax = fmaxf(__uint_as_float(rr[0]), __uint_as_float(rr[1])); }
    float mn;
    if (__builtin_expect(__all((pmax - m_reg) <= THR), 1)) { mn = m_reg; alpha = 1.f; }
    else { mn = fmaxf(m_reg, pmax); alpha = __builtin_amdgcn_exp2f(m_reg - mn); m_reg = mn; }
#pragma unroll
    for (int r = 0; r < 16; ++r) { p0[r] = __builtin_amdgcn_exp2f(p0[r] - mn); p1[r] = __builtin_amdgcn_exp2f(p1[r] - mn); }
    float ps = 0.f;
#pragma unroll
    for (int r = 0; r < 16; ++r) ps += p0[r];
#pragma unroll
    for (int r = 0; r < 16; ++r) ps += p1[r];
    { auto rr = __builtin_amdgcn_permlane32_swap(__float_as_uint(ps), __float_as_uint(ps), false, false); ps = __uint_as_float(rr[0]) + __uint_as_float(rr[1]); }
    l_reg = l_reg * alpha + ps;
#define MLA_PK4(P, B_, OUT) do { unsigned a0 = cvtpk(P[B_ + 0], P[B_ + 1]), a1 = cvtpk(P[B_ + 2], P[B_ + 3]); unsigned b0 = cvtpk(P[B_ + 4], P[B_ + 5]), b1 = cvtpk(P[B_ + 6], P[B_ + 7]); \
        auto r0 = __builtin_amdgcn_permlane32_swap(a0, b0, false, false); auto r1 = __builtin_amdgcn_permlane32_swap(a1, b1, false, false); \
        v4u w = {r0[0], r1[0], r0[1], r1[1]}; OUT = __builtin_bit_cast(bf16x8, w); } while (0)
    MLA_PK4(p0, 0, pa0); MLA_PK4(p0, 8, pa1); MLA_PK4(p1, 0, pa2); MLA_PK4(p1, 8, pa3);
#undef MLA_PK4
}
typedef int i32x8q __attribute__((ext_vector_type(8))); typedef int i32x4q __attribute__((ext_vector_type(4)));
template <int KB>
__device__ __forceinline__ void qkt(f32x16& p0, f32x16& p1, const LAS unsigned char* lds, int r32, int hi, const i32x8q* q8) {
    p0 = f32x16{}; p1 = f32x16{};
    const LAS unsigned char* kr = lds + OFF_K + KB * SHM_K + r32 * 128; const int kx = (r32 >> 1) & 7;
    const LAS unsigned char* rr = lds + OFF_R + KB * SHM_R + r32 * 64; const int rx = (r32 >> 2) & 3;
#define MLA_LD32(base_, c_, x_, step_) __builtin_shufflevector(*(const LAS i32x4q*)((base_) + ((((c_)) ^ (x_)) << 4) + (step_)), *(const LAS i32x4q*)((base_) + ((((c_) + 1) ^ (x_)) << 4) + (step_)), 0, 1, 2, 3, 4, 5, 6, 7)
#pragma unroll
    for (int j = 0; j < 2; ++j) { const int c = 4 * j + 2 * hi;
        const i32x8q a0 = MLA_LD32(kr, c, kx, 0), a1 = MLA_LD32(kr, c, kx, 32 * 128);
        p0 = __builtin_amdgcn_mfma_scale_f32_32x32x64_f8f6f4(a0, q8[j], p0, 0, 0, 0, 127, 0, 127 - 3);
        p1 = __builtin_amdgcn_mfma_scale_f32_32x32x64_f8f6f4(a1, q8[j], p1, 0, 0, 0, 127, 0, 127 - 3); }
    { const int c = 2 * hi;
        const i32x8q a0 = MLA_LD32(rr, c, rx, 0), a1 = MLA_LD32(rr, c, rx, 32 * 64);
        p0 = __builtin_amdgcn_mfma_scale_f32_32x32x64_f8f6f4(a0, q8[2], p0, 0, 0, 0, 127, 0, 127 - 3);
        p1 = __builtin_amdgcn_mfma_scale_f32_32x32x64_f8f6f4(a1, q8[2], p1, 0, 0, 0, 127, 0, 127 - 3); }
#undef MLA_LD32
}
template <int VB>
__device__ __forceinline__ void pv_tile(f32x16* o, int vb0, bf16x8 pa0, bf16x8 pa1, bf16x8 pa2, bf16x8 pa3) {
#define MLA_TRRD(dst, off) asm volatile("ds_read_b64_tr_b16 %0, %1 offset:%2" : "=&v"(dst) : "v"(vb0), "i"(off) : "memory")
#define MLA_PV_D0(d0) do { s16x4 l0, l1, l2, l3, h0, h1, h2, h3; constexpr int b_ = OFF_V + VB * SHM_V + v_rd_off(d0, 0, 0); \
        MLA_TRRD(l0, b_); MLA_TRRD(h0, b_ + 2048); MLA_TRRD(l1, b_ + 4096); MLA_TRRD(h1, b_ + 6144); MLA_TRRD(l2, b_ + 8192); MLA_TRRD(h2, b_ + 10240); MLA_TRRD(l3, b_ + 12288); MLA_TRRD(h3, b_ + 14336); \
        asm volatile("s_waitcnt lgkmcnt(0)" ::: "memory"); MLA_SBAR(); \
        o[d0] = __builtin_amdgcn_mfma_f32_32x32x16_bf16(pa0, (bf16x8){l0[0], l0[1], l0[2], l0[3], h0[0], h0[1], h0[2], h0[3]}, o[d0], 0, 0, 0); \
        o[d0] = __builtin_amdgcn_mfma_f32_32x32x16_bf16(pa1, (bf16x8){l1[0], l1[1], l1[2], l1[3], h1[0], h1[1], h1[2], h1[3]}, o[d0], 0, 0, 0); \
        o[d0] = __builtin_amdgcn_mfma_f32_32x32x16_bf16(pa2, (bf16x8){l2[0], l2[1], l2[2], l2[3], h2[0], h2[1], h2[2], h2[3]}, o[d0], 0, 0, 0); \
        o[d0] = __builtin_amdgcn_mfma_f32_32x32x16_bf16(pa3, (bf16x8){l3[0], l3[1], l3[2], l3[3], h3[0], h3[1], h3[2], h3[3]}, o[d0], 0, 0, 0); } while (0)
    MLA_PV_D0(0); MLA_PV_D0(1); MLA_PV_D0(2); MLA_PV_D0(3);
#undef MLA_PV_D0
#undef MLA_TRRD
}
struct Tensors { const bf16* QN; const bf16* QR; const bf16* KN; const bf16* KR; const bf16* VB; bf16* O; };

__device__ __forceinline__ s16x4 vtr(const LAS unsigned char* p) { return __builtin_bit_cast(s16x4, __builtin_amdgcn_ds_read_tr16_b64_v4i16((LAS s16x4*)p)); }
template <int N> __device__ __forceinline__ i32x8q kfrag(const LAS unsigned char* kr, const LAS unsigned char* rr, int hi, int kx, int rx) {
    if (N < 4) { const int c = 4 * (N >> 1) + 2 * hi; const LAS unsigned char* b_ = kr + (N & 1) * 32 * 128;
        return __builtin_shufflevector(*(const LAS i32x4q*)(b_ + ((c ^ kx) << 4)), *(const LAS i32x4q*)(b_ + (((c + 1) ^ kx) << 4)), 0, 1, 2, 3, 4, 5, 6, 7); }
    const int c = 2 * hi; const LAS unsigned char* b_ = rr + (N & 1) * 32 * 64;
    return __builtin_shufflevector(*(const LAS i32x4q*)(b_ + ((c ^ rx) << 4)), *(const LAS i32x4q*)(b_ + (((c + 1) ^ rx) << 4)), 0, 1, 2, 3, 4, 5, 6, 7);
}
__device__ __forceinline__ float rowmax(const f32x16& p0, const f32x16& p1) {
    float pmax = p0[0];
#pragma unroll
    for (int r = 1; r < 16; ++r) pmax = fmaxf(pmax, p0[r]);
#pragma unroll
    for (int r = 0; r < 16; ++r) pmax = fmaxf(pmax, p1[r]);
    auto rr = __builtin_amdgcn_permlane32_swap(__float_as_uint(pmax), __float_as_uint(pmax), false, false); return fmaxf(__uint_as_float(rr[0]), __uint_as_float(rr[1]));
}

__device__ __forceinline__ void unit(const Tensors& T, int b, int h, int qb, LAS unsigned char* lds) {
    const int tid = threadIdx.x, wid = __builtin_amdgcn_readfirstlane(tid >> 6), lane = tid & 63, r32 = lane & 31, hi = lane >> 5;
    const size_t rowq = (size_t)b * SEQ + qb * QB + wid * QBLK + r32;
    i32x8q qr[3];
    { const GAS unsigned char* qn8 = (const GAS unsigned char*)T.QN + rowq * 2048 + h * 128 + 32 * hi; const GAS unsigned char* qr8 = (const GAS unsigned char*)T.QR + rowq * 1024 + h * 64 + 32 * hi;
#pragma unroll
      for (int j = 0; j < 2; ++j) qr[j] = __builtin_shufflevector(*(const GAS i32x4q*)(qn8 + 64 * j), *(const GAS i32x4q*)(qn8 + 64 * j + 16), 0, 1, 2, 3, 4, 5, 6, 7);
      qr[2] = __builtin_shufflevector(*(const GAS i32x4q*)qr8, *(const GAS i32x4q*)(qr8 + 16), 0, 1, 2, 3, 4, 5, 6, 7); }
    const int NT = 4 * (qb + 1);
    const int qlo = qb * QB + wid * QBLK, qm = qlo + r32 - 4 * hi;
    LAS float* ws = (LAS float*)(lds + OFF_WS) + wid * 64; LAS float* li_l = ws; LAS float* al_l = ws + 32;
    float mhat = 0.f, l_reg = 0.f; f32x16 o[4] = {}; bool resc = false;
    const LAS unsigned char* vp0 = lds + OFF_V + v_rd_base(lane);
    const LAS unsigned char* kr0 = lds + OFF_K + r32 * 128; const LAS unsigned char* rr0 = lds + OFF_R + r32 * 64; const int kx = (r32 >> 1) & 7, rx = (r32 >> 2) & 3;
    int voff[2], koff, roff;
#pragma unroll
    for (int i = 0; i < 2; ++i) { const int G_ = (wid + 8 * i) * 64 + lane;
        { const int st = G_ >> 5, w_ = G_ & 31, kk = (st >> 2) * 8 + (w_ >> 2), c = (st & 3) * 32 + (w_ & 3) * 8, k = (kk & ~0xC) | ((kk & 4) << 1) | ((kk & 8) >> 1); voff[i] = (k * 2048 + c) * 2; } }
    { const int G_ = wid * 64 + lane, row = G_ >> 3, slot = G_ & 7; koff = row * 2048 + 16 * (slot ^ ((row >> 1) & 7)); }
    { const int G_ = (wid & 3) * 64 + lane, row = G_ >> 2, slot = G_ & 3; roff = row * 64 + 16 * (slot ^ ((row >> 2) & 3)); }
    const unsigned char* Kh = (const unsigned char*)T.KN + (size_t)b * SEQ * 2048 + h * 128; const bf16* Vh = T.VB + (size_t)b * SEQ * 2048 + h * 128; const unsigned char* Rh = (const unsigned char*)T.KR + (size_t)b * SEQ * 64;
#define MLA_GLDS(base_, off_, dst_) do { unsigned sv_; const void* g_ = (const void*)(base_); const unsigned o_ = (unsigned)(off_); const unsigned d_ = (unsigned)__builtin_amdgcn_readfirstlane((int)(unsigned)(uintptr_t)(dst_)); \
        asm volatile("s_mov_b32 %0, m0\n\ts_mov_b32 m0, %3\n\ts_nop 0\n\tglobal_load_lds_dwordx4 %1, %2\n\ts_mov_b32 m0, %0" : "=&s"(sv_) : "v"(o_), "s"(g_), "s"(d_) : "memory"); } while (0)
#define MLA_DMA_V(k0, bf) do { _Pragma("unroll") for (int i_ = 0; i_ < 2; ++i_) MLA_GLDS((const unsigned char*)Vh + (size_t)(k0) * 4096, voff[i_], lds + OFF_V + (bf) * SHM_V + (wid + 8 * i_) * 1024); } while (0)
#define MLA_DMA_K(k0, bf) do { MLA_GLDS(Kh + (size_t)(k0) * 2048, koff, lds + OFF_K + (bf) * SHM_K + wid * 1024); \
        if (wid < 4) MLA_GLDS(Rh + (size_t)(k0) * 64, roff, lds + OFF_R + (bf) * SHM_R + wid * 1024); } while (0)
#define MLA_WAITBAR() do { asm volatile("s_waitcnt vmcnt(0)" ::: "memory"); __syncthreads(); } while (0)
#define MLA_WAITBAR_C() do { if (wid < 4) asm volatile("s_waitcnt vmcnt(4)" ::: "memory"); else asm volatile("s_waitcnt vmcnt(3)" ::: "memory"); __syncthreads(); } while (0)
#define MLA_PIN(x) asm volatile("" : "+v"(x))
#define MLA_RESC() do { if (resc) { _Pragma("unroll") for (int d_ = 0; d_ < 4; ++d_) _Pragma("unroll") for (int r = 0; r < 16; ++r) o[d_][r] *= al_l[crow(r, hi)]; } } while (0)
#define MLA_QMF(C_, a_, j_, I_) C_ = __builtin_amdgcn_mfma_scale_f32_32x32x64_f8f6f4(a_, qr[j_], I_, 0, 0, 0, 127, 0, 127 - 3)
#define MLA_KF(N_) kfrag<N_>(kr_, rr_, hi, kx, rx)
#define MLA_PK4(P, B_, OUT) do { unsigned a0 = cvtpk(P[B_ + 0], P[B_ + 1]), a1 = cvtpk(P[B_ + 2], P[B_ + 3]); unsigned b0 = cvtpk(P[B_ + 4], P[B_ + 5]), b1 = cvtpk(P[B_ + 6], P[B_ + 7]); \
        auto r0 = __builtin_amdgcn_permlane32_swap(a0, b0, false, false); auto r1 = __builtin_amdgcn_permlane32_swap(a1, b1, false, false); \
        OUT = (v4u){r0[0], r1[0], r0[1], r1[1]}; } while (0)
#define MLA_S2(P, i) do { sa0 += P[i]; sa1 += P[(i) + 1]; } while (0)
#define MLA_EX2(X, i) do { const f32x2 d_ = (f32x2){X[i], X[i + 1]} - (f32x2){mhat, mhat}; X[i] = __builtin_amdgcn_exp2f(d_[0]); X[(i) + 1] = __builtin_amdgcn_exp2f(d_[1]); } while (0)
#define MLA_VRD(n) do { vlo[n] = vtr(vp_ + (((n) & 3) * 512 + ((n) >> 2) * 4096)); vhi[n] = vtr(vp_ + (((n) & 3) * 512 + ((n) >> 2) * 4096 + 2048)); } while (0)
#define MLA_VFR(n) (bf16x8){vlo[n][0], vlo[n][1], vlo[n][2], vlo[n][3], vhi[n][0], vhi[n][1], vhi[n][2], vhi[n][3]}
#define MLA_PAF(k) __builtin_bit_cast(bf16x8, pw##k)
#define MLA_GAPB(n, k, X, i) do { o[(n) & 3] = __builtin_amdgcn_mfma_f32_32x32x16_bf16(MLA_PAF(k), MLA_VFR(n), o[(n) & 3], 0, 0, 0); if ((n) + 2 < 16) MLA_VRD((n) + 2 < 16 ? (n) + 2 : 15); \
        MLA_EX2(X, i); MLA_PIN(X); MLA_SBAR(); } while (0)
    f32x16 pA0, pA1, pB0, pB1; v4u pw0, pw1, pw2, pw3; s16x4 vlo[16], vhi[16]; i32x8q kf0, kf1;
    int ks_cur = 0, ks_nxt = 1, ks_n2 = 2, ks_n3 = 3, vs_rd = 2, vs_mid = 0, vs_wr = 1;
#define MLA_ROT() do { const int o_ = ks_cur; ks_cur = ks_nxt; ks_nxt = ks_n2; ks_n2 = ks_n3; ks_n3 = o_; const int p_ = vs_rd; vs_rd = vs_mid; vs_mid = vs_wr; vs_wr = p_; } while (0)
    MLA_DMA_K(0, 0); MLA_DMA_K(KVBLK, 1); MLA_DMA_K(2 * KVBLK, 2); MLA_DMA_V(0, 0); MLA_WAITBAR();
    MLA_DMA_K(3 * KVBLK, 3); MLA_DMA_V(KVBLK, 1);
    qkt<0>(pA0, pA1, lds, r32, hi, qr);
    if (NT == 4) mask_tile(pA0, pA1, qm);
    mhat = rowmax(pA0, pA1);
#pragma unroll
    for (int r = 0; r < 16; r += 2) { MLA_EX2(pA0, r); MLA_EX2(pA1, r); }
    MLA_ROT();
    { const LAS unsigned char* kr_ = kr0 + ks_cur * SHM_K; const LAS unsigned char* rr_ = rr0 + ks_cur * SHM_R; kf0 = MLA_KF(0); kf1 = MLA_KF(1); }
    MLA_WAITBAR_C();
#define MLA_MX(X, i) fmaxf(fmaxf(X[i], X[(i) + 1]), fmaxf(X[(i) + 2], X[(i) + 3]))
#define MLA_PV(n, k) o[(n) & 3] = __builtin_amdgcn_mfma_f32_32x32x16_bf16(MLA_PAF(k), MLA_VFR(n), o[(n) & 3], 0, 0, 0)
#define MLA_VN(n) do { if ((n) + 4 < 16) MLA_VRD((n) + 4 < 16 ? (n) + 4 : 15); } while (0)
#define MLA_STEP(C0, C1, P0, P1, t, MASK, GK, GN) do { MLA_SBAR(); \
    const LAS unsigned char* kr_ = kr0 + ks_cur * SHM_K; const LAS unsigned char* rr_ = rr0 + ks_cur * SHM_R; const LAS unsigned char* vp_ = vp0 + vs_rd * SHM_V; \
    i32x8q kf2, kf3, kf4, kf5; \
    float sa0 = P0[0], sa1 = P0[1]; \
    MLA_QMF(C0, kf0, 0, (f32x16{})); kf2 = MLA_KF(2); MLA_S2(P0, 2); MLA_S2(P0, 4); MLA_S2(P0, 6); MLA_PK4(P0, 0, pw0); MLA_PIN(pw0); MLA_PIN(sa0); MLA_PIN(sa1); MLA_SBAR(); \
    MLA_QMF(C1, kf1, 0, (f32x16{})); kf3 = MLA_KF(3); MLA_S2(P0, 8); MLA_S2(P0, 10); MLA_S2(P0, 12); MLA_S2(P0, 14); MLA_PK4(P0, 8, pw1); MLA_PIN(pw1); MLA_PIN(sa0); MLA_PIN(sa1); MLA_SBAR(); \
    if (GK) MLA_DMA_K(((t) + 3) * KVBLK, ks_n3); if (GN) MLA_DMA_V(((t) + 1) * KVBLK, vs_wr); MLA_SBAR();                          \
    MLA_QMF(C0, kf2, 1, C0); kf4 = MLA_KF(4); MLA_S2(P1, 0); MLA_S2(P1, 2); MLA_S2(P1, 4); MLA_S2(P1, 6); MLA_PK4(P1, 0, pw2); MLA_PIN(pw2); MLA_PIN(sa0); MLA_PIN(sa1); MLA_SBAR(); \
    MLA_QMF(C1, kf3, 1, C1); kf5 = MLA_KF(5); MLA_VRD(0); MLA_S2(P1, 8); MLA_S2(P1, 10); MLA_S2(P1, 12); MLA_S2(P1, 14); MLA_PK4(P1, 8, pw3); MLA_PIN(pw3); MLA_PIN(sa0); MLA_PIN(sa1); MLA_SBAR(); \
    MLA_QMF(C0, kf4, 2, C0); MLA_VRD(1); MLA_VRD(2); MLA_SBAR(); \
    MLA_QMF(C1, kf5, 2, C1); MLA_VRD(3); l_reg += sa0 + sa1; MLA_SBAR(); \
      \
    MLA_PV(0, 0); MLA_VN(0); MLA_SBAR(); \
    MLA_PV(1, 0); MLA_VN(1); if (MASK) mask_tile(C0, C1, qm - (t) * KVBLK); \
    float mx0 = C0[0]; _Pragma("unroll") for (int r_ = 1; r_ < 8; ++r_) mx0 = fmaxf(mx0, C0[r_]); MLA_SBAR(); \
    MLA_PV(2, 0); MLA_VN(2); _Pragma("unroll") for (int r_ = 8; r_ < 16; ++r_) mx0 = fmaxf(mx0, C0[r_]); MLA_SBAR(); \
    MLA_PV(3, 0); MLA_VN(3); _Pragma("unroll") for (int r_ = 0; r_ < 8; ++r_) mx0 = fmaxf(mx0, C1[r_]); MLA_SBAR(); \
    MLA_PV(4, 1); MLA_VN(4); _Pragma("unroll") for (int r_ = 8; r_ < 16; ++r_) mx0 = fmaxf(mx0, C1[r_]); \
    { auto rr_x = __builtin_amdgcn_permlane32_swap(__float_as_uint(mx0), __float_as_uint(mx0), false, false); mx0 = fmaxf(__uint_as_float(rr_x[0]), __uint_as_float(rr_x[1])); } \
    { const float rm = mx0 - mhat; resc = false;                                                                         \
      if (__builtin_expect(__any(rm > THR), 0)) { const float dl = fmaxf(rm, 0.f); mhat += dl;                           \
          const float f = __builtin_amdgcn_exp2f(-dl); l_reg *= f; if (hi == 0) al_l[r32] = f; resc = true; } }            \
    MLA_SBAR(); \
    MLA_PV(5, 1);  MLA_VN(5);  MLA_EX2(C0, 0);  MLA_EX2(C0, 2);  MLA_PIN(C0); MLA_SBAR(); \
    MLA_PV(6, 1);  MLA_VN(6);  MLA_EX2(C0, 4);  MLA_EX2(C0, 6);  MLA_PIN(C0); MLA_SBAR(); \
    MLA_PV(7, 1);  MLA_VN(7);  MLA_EX2(C0, 8);  MLA_EX2(C0, 10); MLA_PIN(C0); MLA_SBAR(); \
    MLA_PV(8, 2);  MLA_VN(8);  MLA_EX2(C0, 12); MLA_EX2(C0, 14); MLA_PIN(C0); MLA_SBAR(); \
    MLA_PV(9, 2);  MLA_VN(9);  MLA_EX2(C1, 0);  MLA_EX2(C1, 2);  MLA_PIN(C1); MLA_SBAR(); \
    MLA_PV(10, 2); MLA_VN(10); MLA_EX2(C1, 4);  MLA_PIN(C1); MLA_SBAR(); \
    MLA_PV(11, 2); MLA_VN(11); MLA_EX2(C1, 6);  MLA_PIN(C1); MLA_SBAR(); \
    MLA_ROT(); \
    MLA_PV(12, 3); MLA_EX2(C1, 8);  MLA_PIN(C1); if (GN) { const LAS unsigned char* kr_ = kr0 + ks_cur * SHM_K; const LAS unsigned char* rr_ = rr0 + ks_cur * SHM_R; kf0 = MLA_KF(0); } MLA_SBAR(); \
    MLA_PV(13, 3); MLA_EX2(C1, 10); MLA_PIN(C1); if (GN) { const LAS unsigned char* kr_ = kr0 + ks_cur * SHM_K; const LAS unsigned char* rr_ = rr0 + ks_cur * SHM_R; kf1 = MLA_KF(1); } MLA_SBAR(); \
    MLA_PV(14, 3); MLA_EX2(C1, 12); MLA_PIN(C1); MLA_SBAR(); \
    MLA_PV(15, 3); MLA_EX2(C1, 14); MLA_PIN(C1); MLA_SBAR(); \
    } while (0)
    int t = 1;
#pragma unroll 1
    for (; t + 5 < NT; t += 2) {
        MLA_STEP(pB0, pB1, pA0, pA1, t, false, true, true);     MLA_WAITBAR_C(); MLA_RESC();
        MLA_STEP(pA0, pA1, pB0, pB1, t + 1, false, true, true); MLA_WAITBAR_C(); MLA_RESC(); }
#pragma unroll 1
    for (; t + 1 < NT; t += 2) {
        MLA_STEP(pB0, pB1, pA0, pA1, t, true, (t + 3 < NT), true);     MLA_WAITBAR(); MLA_RESC();
        MLA_STEP(pA0, pA1, pB0, pB1, t + 1, true, (t + 4 < NT), true); MLA_WAITBAR(); MLA_RESC(); }
    MLA_STEP(pB0, pB1, pA0, pA1, NT - 1, true, false, false); MLA_WAITBAR(); MLA_RESC();
    { float sa0 = pB0[0], sa1 = pB0[1];
#pragma unroll
      for (int r = 2; r < 16; r += 2) MLA_S2(pB0, r);
#pragma unroll
      for (int r = 0; r < 16; r += 2) MLA_S2(pB1, r);
      l_reg += sa0 + sa1;
      MLA_PK4(pB0, 0, pw0); MLA_PK4(pB0, 8, pw1); MLA_PK4(pB1, 0, pw2); MLA_PK4(pB1, 8, pw3);
      const LAS unsigned char* vp_ = vp0 + vs_rd * SHM_V;
#pragma unroll
      for (int k = 0; k < 4; ++k) {
#pragma unroll
          for (int d0 = 0; d0 < 4; ++d0) { const s16x4 lo = vtr(vp_ + (d0 * 512 + k * 4096)), hh = vtr(vp_ + (d0 * 512 + k * 4096 + 2048));
              const bf16x8 vf = (bf16x8){lo[0], lo[1], lo[2], lo[3], hh[0], hh[1], hh[2], hh[3]};
              o[d0] = __builtin_amdgcn_mfma_f32_32x32x16_bf16(k == 0 ? MLA_PAF(0) : k == 1 ? MLA_PAF(1) : k == 2 ? MLA_PAF(2) : MLA_PAF(3), vf, o[d0], 0, 0, 0); } } }
    { auto rr = __builtin_amdgcn_permlane32_swap(__float_as_uint(l_reg), __float_as_uint(l_reg), false, false); l_reg = __uint_as_float(rr[0]) + __uint_as_float(rr[1]); }
    if (hi == 0) li_l[r32] = l_reg; asm volatile("s_waitcnt lgkmcnt(0)" ::: "memory");
    unsigned char* Ow = (unsigned char*)T.O + ((size_t)b * SEQ + qb * QB + wid * QBLK) * 2048 + h * 128;
    int hi_e = hi; asm volatile("" : "+v"(hi_e));
#pragma unroll
    for (int r = 0; r < 16; ++r) { const int orow = crow(r, hi_e); const float rl = __builtin_amdgcn_rcpf(li_l[orow]);
#pragma unroll
        for (int d0 = 0; d0 < 4; ++d0) { const float v = o[d0][r] * rl; const float v1 = dppf<0xB1>(v), v2 = dppf<0x4E>(v), v3 = dppf<0x1B>(v);
            if ((r32 & 3) == 0) *(GAS unsigned*)(Ow + (size_t)orow * 2048 + d0 * 32 + r32) = pkf8(v, v1, v2, v3); } }
    __syncthreads();
#undef MLA_DMA_V
#undef MLA_GLDS
#undef MLA_DMA_K
#undef MLA_WAITBAR
#undef MLA_WAITBAR_C
#undef MLA_PIN
#undef MLA_RESC
#undef MLA_QMF
#undef MLA_KF
#undef MLA_PK4
#undef MLA_S2
#undef MLA_EX2
#undef MLA_VRD
#undef MLA_VFR
#undef MLA_PAF
#undef MLA_GAPB
#undef MLA_STEP
#undef MLA_ROT
#undef MLA_MX
#undef MLA_PV
#undef MLA_VN
}
}

#if defined(DBG_CHECK)
#ifndef DBG_WORD
#define DBG_WORD 0
#endif
namespace chk {
__device__ __forceinline__ float bsum(float v, LAS float* red, int tid) { red[tid] = v; __syncthreads(); for (int o = 256; o > 0; o >>= 1) { if (tid < o) red[tid] += red[tid + o]; __syncthreads(); } const float r = red[0]; __syncthreads(); return r; }
__device__ __forceinline__ float bmax(float v, LAS float* red, int tid) { red[tid] = v; __syncthreads(); for (int o = 256; o > 0; o >>= 1) { if (tid < o) red[tid] = fmaxf(red[tid], red[tid + o]); __syncthreads(); } const float r = red[0]; __syncthreads(); return r; }
__device__ __forceinline__ float bf(const bf16* p) { return __uint_as_float((unsigned)(*p) << 16); }
__device__ __forceinline__ float hf(const bf16* p) { return (float)__builtin_bit_cast(_Float16, *p); }
__device__ __forceinline__ int sample_t(int smp) { const int k = smp >> 5; const int edge[16] = {0, 1, 31, 32, 63, 64, 255, 256, 257, 511, 512, 4095, 4096, 8190, 8191, 300}; return k < 1 ? edge[smp & 15] : (int)(((unsigned)smp * 2654435761u) >> 13) & 8191; }
__device__ __forceinline__ void amax(float* w, float v) { if (v == v) atomicMax((int*)w, __float_as_int(v)); else atomicMax((int*)w, 0x7f000000); }
__device__ __forceinline__ void mla(const bf16* QN, const bf16* QR, const bf16* KN, const bf16* KR, const bf16* VB, const bf16* O, int smp, LAS float* lg, LAS float* red, LAS float* q, float* dbg, int tid) {
    const int b = smp & 1, h = (smp >> 1) & 15, t = sample_t(smp); const size_t row = (size_t)b * SEQ + t;
    if (tid < 128) q[tid] = bf(QN + row * 2048 + h * 128 + tid); else if (tid < 192) q[tid] = bf(QR + row * 1024 + h * 64 + (tid - 128));
    __syncthreads();
    float mx = -1e30f;
    for (int s = tid; s <= t; s += 512) { const bf16* kn = KN + ((size_t)b * SEQ + s) * 2048 + h * 128; const bf16* kr = KR + ((size_t)b * SEQ + s) * 64; float d = 0.f;
        for (int i = 0; i < 128; ++i) d += q[i] * bf(kn + i); for (int i = 0; i < 64; ++i) d += q[128 + i] * bf(kr + i); lg[s] = d; mx = fmaxf(mx, d); }
    mx = bmax(mx, red, tid); float sm = 0.f;
    for (int s = tid; s <= t; s += 512) { const float p = exp2f(lg[s] - mx); lg[s] = p; sm += p; }
    sm = bsum(sm, red, tid);
    float o = 0.f;
    if (tid < 128) { for (int s = 0; s <= t; ++s) o += lg[s] * bf(VB + ((size_t)b * SEQ + s) * 2048 + h * 128 + tid); o /= sm; }
    const float rms = sqrtf(bsum(tid < 128 ? o * o : 0.f, red, tid) / 128.f) + 1e-20f;
    const float e = tid < 128 ? fabsf(o - bf(O + row * 2048 + h * 128 + tid)) / rms : 0.f;
    const float em = bmax(e, red, tid);
    if (tid == 0) amax(dbg + 0, em);
    __syncthreads();
}
template <bool TRUE_SC> __device__ __forceinline__ void dsa(const float* x, const float* w_in, const bf16* QI, const bf16* KI, const float* WI, const bf16* QA, const bf16* KA, const bf16* VA, const bf16* O, const unsigned short* SEL, int smp, LAS float* sc, LAS float* red, LAS float* aux, float* dbg, int tid) {
    const int b = smp & 1, t = sample_t(smp >> 1 << 1 | 0) ; const size_t row = (size_t)b * SEQ + t;
    LAS float* qi = aux;
    LAS unsigned* sel = (LAS unsigned*)(aux + 1024);
    LAS float* pr = aux + 2048;
    LAS unsigned* cnt = (LAS unsigned*)(aux + 2048 + 4096);
    LAS float* wt = aux + 2048 + 4096 + 64;
    if (TRUE_SC) {
        for (int i = tid; i < 1024 + 16; i += 512) { const int c = i < 1024 ? U_QI + i : U_WI + (i - 1024); float d = 0.f; for (int k = 0; k < 2048; ++k) d += x[row * 2048 + k] * w_in[(size_t)k * DIN + c]; if (i < 1024) qi[i] = d; else wt[i - 1024] = d; }
        __syncthreads();
        for (int s = tid; s <= t; s += 512) { float kk[64];
#pragma unroll
            for (int c = 0; c < 64; ++c) kk[c] = 0.f;
            const float* xs = x + ((size_t)b * SEQ + s) * 2048;
            for (int k = 0; k < 2048; ++k) { const float xv = xs[k]; const float* wr = w_in + (size_t)k * DIN + U_KI;
#pragma unroll
                for (int c = 0; c < 64; ++c) kk[c] += xv * wr[c]; }
            float tot = 0.f;
#pragma unroll
            for (int hh = 0; hh < 16; ++hh) { float d = 0.f;
#pragma unroll
                for (int i = 0; i < 64; ++i) d += qi[hh * 64 + i] * kk[i];
                tot += wt[hh] * fmaxf(d, 0.f); }
            sc[s] = tot; }
    } else {
    for (int i = tid; i < 1024; i += 512) qi[i] = hf(QI + row * 1024 + i);
    __syncthreads();
    for (int s = tid; s <= t; s += 512) { const bf16* k = KI + ((size_t)b * SEQ + s) * 64; float tot = 0.f;
        for (int hh = 0; hh < 16; ++hh) { float d = 0.f; for (int i = 0; i < 64; ++i) d += qi[hh * 64 + i] * hf(k + i); tot += WI[row * 16 + hh] * fmaxf(d, 0.f); }
        sc[s] = tot; }
    }
    __syncthreads();
    const int n = t + 1, want = n < 256 ? n : 256;
    unsigned T = 0u;
    for (int bit = 31; bit >= 0; --bit) { const unsigned cand = T | (1u << bit); if (tid == 0) cnt[0] = 0u; __syncthreads(); unsigned c = 0u;
        for (int s = tid; s <= t; s += 512) c += (dsa::fkey(sc[s]) >= cand) ? 1u : 0u;
        if (c) atomicAdd((unsigned*)cnt, c); __syncthreads(); if (cnt[0] >= (unsigned)want) T = cand; __syncthreads(); }
    if (tid == 0) { cnt[0] = 0u; cnt[1] = 0u; } __syncthreads();
    { unsigned c = 0u; for (int s = tid; s <= t; s += 512) c += (dsa::fkey(sc[s]) > T) ? 1u : 0u; if (c) atomicAdd((unsigned*)cnt + 1, c); }
    __syncthreads();
    const unsigned cgt = cnt[1]; __syncthreads(); if (tid == 0) cnt[1] = 0u;
    for (int s = tid; s <= t; s += 512) { const unsigned ky = dsa::fkey(sc[s]); bool take = ky > T;
        if (ky == T) { unsigned rk = 0u; for (int s2 = 0; s2 < s; ++s2) rk += (dsa::fkey(sc[s2]) == T) ? 1u : 0u; take = cgt + rk < (unsigned)want; }
        if (take) { const unsigned p = atomicAdd((unsigned*)cnt, 1u); if (p < 256u) sel[p] = (unsigned)s; } }
    __syncthreads();
    const int nref = (int)(cnt[0] < 256u ? cnt[0] : 256u);
    if (tid < 256) sel[256 + tid] = SEL[row * 256 + tid];
    __syncthreads();
    { float miss = 0.f; if (tid < 256) { const unsigned s = sel[256 + tid]; if (s != 0xFFFFu) { bool found = false; for (int j = 0; j < nref; ++j) found |= (sel[j] == s); miss = found ? 0.f : 1.f; } }
      const float tm = bsum(miss, red, tid); if (tid == 0) { amax(dbg + 1, tm / (float)want); atomicAdd(dbg + 13, tm); } }
    for (int pass = 0; pass < 2; ++pass) {
        const int ns = pass == 0 ? nref : 256; LAS unsigned* sl = sel + pass * 256;
        for (int e = tid; e < 16 * 256; e += 512) { const int hh = e >> 8, j = e & 255; float v = -1e30f;
            if (j < ns && sl[j] != 0xFFFFu) { const unsigned s = sl[j]; const bf16* k = KA + ((size_t)b * SEQ + s) * 128; float d = 0.f; for (int i = 0; i < 128; ++i) d += bf(QA + row * 2048 + hh * 128 + i) * bf(k + i);
                v = d - exp2f(-0.5f * (float)(hh + 1)) * LOG2E * (float)(t - (int)s); }
            pr[e] = v; }
        __syncthreads();
        if (tid < 16) { float mx = -1e30f; for (int j = 0; j < 256; ++j) mx = fmaxf(mx, pr[tid * 256 + j]); float sm = 0.f; for (int j = 0; j < 256; ++j) { const float p = pr[tid * 256 + j] <= -1e29f ? 0.f : exp2f(pr[tid * 256 + j] - mx); pr[tid * 256 + j] = p; sm += p; }
            for (int j = 0; j < 256; ++j) pr[tid * 256 + j] /= sm; }
        __syncthreads();
        float e4 = 0.f, q4 = 0.f, s4 = 0.f;
        for (int e = tid; e < 2048; e += 512) { const int hh = e >> 7, d = e & 127; float o = 0.f;
            for (int j = 0; j < ns; ++j) { const unsigned s = sl[j]; if (s != 0xFFFFu) o += pr[hh * 256 + j] * bf(VA + ((size_t)b * SEQ + s) * 128 + d); }
            q4 += o * o; const float df = o - bf(O + row * 2048 + e); e4 = fmaxf(e4, fabsf(df)); s4 += df * df; }
        const float rms = sqrtf(bsum(q4, red, tid) / 2048.f) + 1e-20f; const float em = bmax(e4, red, tid); const float esq = bsum(s4, red, tid);
        if (tid == 0) { amax(dbg + (pass == 0 ? 0 : 2), em / rms); if (pass == 0) atomicAdd(dbg + 14, esq / (rms * rms * 2048.f)); }
        __syncthreads();
    }
}
__device__ __forceinline__ void p1(const float* x, const float* w_in, const bf16* QA, const bf16* QI, const bf16* KA, const bf16* VA, const bf16* KI, const float* WI, const bf16* CQ, const bf16* CKV, const bf16* KR, int smp, LAS float* xr, LAS float* red, LAS float* tru, float* dbg, int tid) {
    const size_t row = (size_t)(((unsigned)smp * 2654435761u) >> 9) % M; const int pos = (int)(row & (SEQ - 1));
    for (int i = tid; i < 2048; i += 512) xr[i] = x[row * 2048 + i];
    __syncthreads();
    for (int c = tid; c < U_G; c += 512) { float d = 0.f; for (int k = 0; k < 2048; ++k) d += xr[k] * w_in[(size_t)k * DIN + c]; tru[c] = d; }
    __syncthreads();
    for (int ty = 0; ty < 9; ++ty) {
        const int c0 = ty == 0 ? U_QA : ty == 1 ? U_QI : ty == 2 ? U_KA : ty == 3 ? U_VA : ty == 4 ? U_KI : ty == 5 ? U_WI : ty == 6 ? U_CQ : ty == 7 ? U_CKV : U_KPE;
        const int nc = ty == 0 ? 2048 : ty == 1 ? 1024 : ty == 2 ? 128 : ty == 3 ? 128 : ty == 4 ? 64 : ty == 5 ? 16 : ty == 6 ? 512 : ty == 7 ? 512 : 64;
        float q = 0.f, e = 0.f;
        for (int c = tid; c < nc; c += 512) { float tv = tru[c0 + c], sv;
            if (ty == 0) { tv *= QA_SCALE; sv = bf(QA + row * 2048 + c); } else if (ty == 1) sv = hf(QI + row * 1024 + c); else if (ty == 2) sv = bf(KA + row * 128 + c); else if (ty == 3) sv = bf(VA + row * 128 + c);
            else if (ty == 4) sv = hf(KI + row * 64 + c); else if (ty == 5) sv = WI[row * 16 + c]; else if (ty == 6) sv = bf(CQ + row * 512 + c); else if (ty == 7) sv = bf(CKV + row * 512 + c);
            else { const int i = c & 31; const float ang = (float)pos * exp2f(-(float)i * (13.287712379549449f / 32.f)), cs = cosf(ang), sn = sinf(ang); const float x1 = tru[c0 + i], x2 = tru[c0 + 32 + i]; tv = c < 32 ? x1 * cs - x2 * sn : x1 * sn + x2 * cs; sv = bf(KR + row * 64 + c); }
            q += tv * tv; e = fmaxf(e, fabsf(tv - sv)); }
        const float rms = sqrtf(bsum(q, red, tid) / (float)nc) + 1e-20f; const float em = bmax(e, red, tid) / rms;
        if (tid == 0) { amax(dbg + 3 + ty, em); amax(dbg + 12, em); }
        __syncthreads();
    }
}
__device__ __forceinline__ void p2(const bf16* CQ, const bf16* CKV, const float* gq, const float* gkv, const float* w_uq, const float* w_uk, const float* w_uv, const bf16* QN, const bf16* QR, const bf16* KN, const bf16* VB,
                                   int smp, LAS float* cr, LAS float* red, LAS float* tru, float* dbg, int tid) {
    const size_t row = (size_t)(((unsigned)smp * 2654435761u) >> 9) % M; const int pos = (int)(row & (SEQ - 1));
    for (int i = tid; i < 1024; i += 512) cr[i] = i < 512 ? bf(CQ + row * 512 + i) : bf(CKV + row * 512 + (i - 512));
    __syncthreads();
    const float ssq = bsum(cr[tid] * cr[tid], red, tid), ssk = bsum(cr[512 + tid] * cr[512 + tid], red, tid);
    const float rq = 1.f / sqrtf(ssq / 512.f + RMS_EPS), rk = 1.f / sqrtf(ssk / 512.f + RMS_EPS);
    for (int n = tid; n < 3072 + 4096; n += 512) { float d = 0.f;
        if (n < 3072) { for (int k = 0; k < 512; ++k) d += cr[k] * gq[k] * w_uq[(size_t)k * 3072 + n]; d *= rq * QB_SCALE; }
        else if (n < 3072 + 2048) { for (int k = 0; k < 512; ++k) d += cr[512 + k] * gkv[k] * w_uk[(size_t)k * 2048 + (n - 3072)]; d *= rk; }
        else { for (int k = 0; k < 512; ++k) d += cr[512 + k] * gkv[k] * w_uv[(size_t)k * 2048 + (n - 5120)]; d *= rk; }
        tru[n] = d; }
    __syncthreads();
    float q = 0.f, e = 0.f;
    for (int n = tid; n < 2048; n += 512) { const int h = n >> 7, d = n & 127; const float tv = tru[h * 192 + d]; q += tv * tv; e = fmaxf(e, fabsf(tv - bf(QN + row * 2048 + n))); }
    { const float rms = sqrtf(bsum(q, red, tid) / 2048.f) + 1e-20f; const float em = bmax(e, red, tid) / rms; if (tid == 0) { amax(dbg + 0, em); amax(dbg + 1, em); } }
    q = 0.f; e = 0.f;
    for (int n = tid; n < 1024; n += 512) { const int h = n >> 6, c = n & 63, i = c & 31; const float ang = (float)pos * exp2f(-(float)i * (13.287712379549449f / 32.f)), cs = cosf(ang), sn = sinf(ang);
        const float x1 = tru[h * 192 + 128 + i], x2 = tru[h * 192 + 160 + i], tv = c < 32 ? x1 * cs - x2 * sn : x1 * sn + x2 * cs; q += tv * tv; e = fmaxf(e, fabsf(tv - bf(QR + row * 1024 + n))); }
    { const float rms = sqrtf(bsum(q, red, tid) / 1024.f) + 1e-20f; const float em = bmax(e, red, tid) / rms; if (tid == 0) { amax(dbg + 0, em); amax(dbg + 2, em); } }
    q = 0.f; e = 0.f;
    for (int n = tid; n < 2048; n += 512) { const float tv = tru[3072 + n]; q += tv * tv; e = fmaxf(e, fabsf(tv - bf(KN + row * 2048 + n))); }
    { const float rms = sqrtf(bsum(q, red, tid) / 2048.f) + 1e-20f; const float em = bmax(e, red, tid) / rms; if (tid == 0) { amax(dbg + 0, em); amax(dbg + 3, em); } }
    q = 0.f; e = 0.f;
    for (int n = tid; n < 2048; n += 512) { const float tv = tru[5120 + n]; q += tv * tv; e = fmaxf(e, fabsf(tv - bf(VB + row * 2048 + n))); }
    { const float rms = sqrtf(bsum(q, red, tid) / 2048.f) + 1e-20f; const float em = bmax(e, red, tid) / rms; if (tid == 0) { amax(dbg + 0, em); amax(dbg + 4, em); } }
    __syncthreads();
}
__device__ __forceinline__ void gchk(const float* x, const float* w_in, const bf16* GS, const bf16* XHS, size_t row, LAS float* xr, LAS float* red, float* dbg, int tid) {
    for (int i = tid; i < 2048; i += 512) xr[i] = x[row * 2048 + i];
    __syncthreads();
    float eg = 0.f;
    for (int c = tid; c < 4096; c += 512) { float l0 = 0.f; for (int k = 0; k < 2048; ++k) l0 += xr[k] * w_in[(size_t)k * DIN + U_G + c]; eg = fmaxf(eg, fabsf(1.f / (1.f + expf(-l0)) - bf(GS + row * 4096 + c))); }
    const float egm = bmax(eg, red, tid);
    float ex = 0.f; for (int i = tid; i < 2048; i += 512) ex = fmaxf(ex, fabsf(xr[i] - hf(XHS + row * 2048 + i))); const float exm = bmax(ex, red, tid);
    int nb = 0; for (int c = tid; c < 4096; c += 512) { float l0 = 0.f; for (int k = 0; k < 2048; ++k) l0 += xr[k] * w_in[(size_t)k * DIN + U_G + c]; nb += fabsf(1.f / (1.f + expf(-l0)) - bf(GS + row * 4096 + c)) > 0.05f ? 1 : 0; }
    const float nbt = bsum((float)nb, red, tid);
    if (tid == 0) { amax(dbg + 0, egm); if (egm > 0.05f) { atomicAdd(dbg + 1, 1.0f); amax(dbg + 3, nbt); amax(dbg + 4, 4097.f - nbt); } amax(dbg + 2, exm); }
    __syncthreads();
}
__device__ __forceinline__ void mid(const float* x, const float* w_in, const float* wa, const float* wb, const float* wo, const bf16* AA, const bf16* AB, const bf16* GS, const bf16* MTS, const float* Z, size_t row, int vtag, LAS float* va, LAS float* red, LAS float* mg, float* dbg, int tid) {
    LAS float* vb = va + 2048; LAS float* xr = va + 4096;
    for (int i = tid; i < 2048; i += 512) { va[i] = bf(AA + row * 2048 + i); vb[i] = bf(AB + row * 2048 + i); xr[i] = x[row * 2048 + i]; }
    __syncthreads();
    float eg = 0.f, qm = 0.f, emt = 0.f; int cmx = -1, cmn = 1 << 20;
    for (int c = tid; c < 2048; c += 512) { float l0 = 0.f, l1 = 0.f, ma = 0.f, mb = 0.f;
        for (int k = 0; k < 2048; ++k) { const float xv = xr[k]; l0 += xv * w_in[(size_t)k * DIN + U_G + c]; l1 += xv * w_in[(size_t)k * DIN + U_G + 2048 + c]; ma += va[k] * wa[(size_t)k * 2048 + c]; mb += vb[k] * wb[(size_t)k * 2048 + c]; }
        const float g0 = 1.f / (1.f + expf(-l0)), g1 = 1.f / (1.f + expf(-l1)); mg[c] = ma * g0 + mb * g1;
        { const float e0 = fabsf(g0 - bf(GS + row * 4096 + c)), e1 = fabsf(g1 - bf(GS + row * 4096 + 2048 + c)); eg = fmaxf(eg, fmaxf(e0, e1)); if (e0 > 0.05f) { cmx = max(cmx, c); cmn = min(cmn, c); } if (e1 > 0.05f) { cmx = max(cmx, 2048 + c); cmn = min(cmn, 2048 + c); } } qm += mg[c] * mg[c]; emt = fmaxf(emt, fabsf(mg[c] - bf(MTS + row * 2048 + c))); }
    { const float egm = bmax(eg, red, tid); const float rm = sqrtf(bsum(qm, red, tid) / 2048.f) + 1e-20f; const float emm = bmax(emt, red, tid) / rm; if (tid == 0) { amax(dbg + 17, egm); amax(dbg + 18, emm); if (egm > 0.05f) { amax(dbg + 19, (float)(row & 255) + 1.0f); amax(dbg + 20, (float)(255 - (row & 255)) + 1.0f); atomicAdd(dbg + 21, 1.0f); amax(dbg + 22, (float)vtag + 1.0f); amax(dbg + 23, (float)(255 - vtag) + 1.0f); } }
      const float fx = bmax((float)cmx, red, tid), fn = bmax((float)(4096 - cmn), red, tid); if (tid == 0 && fx >= 0.f) { amax(dbg + 24, fx + 1.0f); amax(dbg + 25, fn + 1.0f); } }
    __syncthreads();
    float q = 0.f, e = 0.f;
    for (int c = tid; c < 2048; c += 512) { float d = 0.f; for (int k = 0; k < 2048; ++k) d += mg[k] * wo[(size_t)k * 2048 + c]; q += d * d; e = fmaxf(e, fabsf(ALPHA * xr[c] + d - Z[row * 2048 + c])); }
    const float rms = sqrtf(bsum(q, red, tid) / 2048.f) + 1e-20f; const float em = bmax(e, red, tid) / rms;
    if (tid == 0) { amax(dbg + 0, em); if (em > 0.25f) { atomicAdd(dbg + 13, 1.0f); amax(dbg + 15, (float)(row & 255) + 1.0f); amax(dbg + 16, (float)(row >> 8) + 1.0f); } }
    __syncthreads();
}
__device__ __forceinline__ void endp(const bf16* X1B, const float* x1f_unused, const float* p, const float* w_up, const float* cw, const float* cb, const float* w_down, const float* w_pg, const float* b_pg, const float* w_pe, const float* g2, const float* b2,
                                     const float* OUT, int smp, LAS float* xs, LAS float* red, LAS float* act, float* dbg, int tid) {
    const int k6 = smp & 7; const size_t rbase = (size_t)(((unsigned)smp * 2654435761u) >> 9) % M; const size_t row = k6 == 0 ? (rbase & ~(size_t)63) : k6 == 1 ? (rbase & ~(size_t)63) + 1 : k6 == 2 ? (rbase & ~(size_t)8191) : rbase; const int t = (int)(row & (SEQ - 1));
    LAS float* z = act + 5632; LAS float* pr = act + 5632 + 2048;
    for (int i = tid; i < 3 * 2048; i += 512) { const int j = i >> 11, c = i & 2047; const int tt = t - 2 + j; xs[i] = tt >= 0 ? bf(X1B + (row - 2 + j) * 2048 + c) : 0.f; }
    for (int i = tid; i < 256; i += 512) pr[i] = p[row * 256 + i];
    __syncthreads();
    for (int ch = tid; ch < DFF; ch += 512) { float hg[3] = {0.f, 0.f, 0.f}, hv[3] = {0.f, 0.f, 0.f};
        for (int k = 0; k < 2048; ++k) { const float wg = w_up[(size_t)k * NUP + ch], wv = w_up[(size_t)k * NUP + DFF + ch];
#pragma unroll
            for (int j = 0; j < 3; ++j) { hg[j] += xs[j * 2048 + k] * wg; hv[j] += xs[j * 2048 + k] * wv; } }
        float yg = cb[ch], yv = cb[DFF + ch];
#pragma unroll
        for (int j = 0; j < 3; ++j) { yg += cw[(size_t)j * NUP + ch] * hg[j]; yv += cw[(size_t)j * NUP + DFF + ch] * hv[j]; }
        act[ch] = yg / (1.f + expf(-yg)) * yv; }
    __syncthreads();
    for (int c = tid; c < 2048; c += 512) { float f = 0.f, lg = b_pg[c], pe = 0.f;
        for (int k = 0; k < DFF; ++k) f += act[k] * w_down[(size_t)k * 2048 + c];
        for (int k = 0; k < 2048; ++k) lg += xs[2 * 2048 + k] * w_pg[(size_t)k * 2048 + c];
        for (int k = 0; k < 256; ++k) pe += pr[k] * w_pe[(size_t)k * 2048 + c];
        z[c] = ALPHA * xs[2 * 2048 + c] + f + pe / (1.f + expf(-lg)); }
    __syncthreads();
    float s = 0.f; for (int c = tid; c < 2048; c += 512) s += z[c];
    const float mean = bsum(s, red, tid) / 2048.f; float s2 = 0.f; for (int c = tid; c < 2048; c += 512) s2 += (z[c] - mean) * (z[c] - mean);
    const float rstd = 1.f / sqrtf(bsum(s2, red, tid) / 2048.f + LN_EPS); float e = 0.f;
    for (int c = tid; c < 2048; c += 512) e = fmaxf(e, fabsf((z[c] - mean) * rstd * g2[c] + b2[c] - OUT[row * 2048 + c]));
    const float em = bmax(e, red, tid);
    if (tid == 0) { amax(dbg + 0, em); amax(dbg + 1 + (k6 < 3 ? k6 : 3), em); }
    __syncthreads();
}
}
#endif

__device__ __forceinline__ int own_panel(int x, int s) { return s < 4 ? x + 8 * s : 32 + (7 - x) + 8 * (s - 4); }
__device__ __forceinline__ void ln_pass(const bf16* zin, float* fout, bf16* bout, unsigned char* xf8, const float* g, const float* b, int vcu, int wave, int lane) {
#pragma unroll 1
    for (int s_ = 0; s_ < 8; ++s_) { const int m = 256 * own_panel(vcu >> 5, s_) + 8 * (vcu & 31) + wave;
        const GAS v4u* zr = (const GAS v4u*)(zin + (size_t)m * DM) + lane;
        f32x4 v[8]; float s = 0.f;
#pragma unroll
        for (int j = 0; j < 4; ++j) { unpack8(zr[64 * j], v[2 * j], v[2 * j + 1]); s += ((v[2 * j][0] + v[2 * j][1]) + (v[2 * j][2] + v[2 * j][3])) + ((v[2 * j + 1][0] + v[2 * j + 1][1]) + (v[2 * j + 1][2] + v[2 * j + 1][3])); }
        const float mean = wave_sum(s) * (1.f / DM); float s2 = 0.f;
#pragma unroll
        for (int j = 0; j < 8; ++j) { v[j] = v[j] - mean; s2 += (v[j][0] * v[j][0] + v[j][1] * v[j][1]) + (v[j][2] * v[j][2] + v[j][3] * v[j][3]); }
        const float rstd = 1.f / sqrtf(wave_sum(s2) * (1.f / DM) + LN_EPS);
#pragma unroll
        for (int j = 0; j < 4; ++j) { const int e0 = 8 * (lane + 64 * j);
            const f32x4 g0 = *(const GAS f32x4*)(g + e0), g1 = *(const GAS f32x4*)(g + e0 + 4), b0 = *(const GAS f32x4*)(b + e0), b1 = *(const GAS f32x4*)(b + e0 + 4);
            const f32x4 y0 = v[2 * j] * rstd * g0 + b0, y1 = v[2 * j + 1] * rstd * g1 + b1;
            if (fout) { *(GAS f32x4*)(fout + (size_t)m * DM + e0) = y0; *(GAS f32x4*)(fout + (size_t)m * DM + e0 + 4) = y1; }
            if (bout) *(GAS v4u*)(bout + (size_t)m * DM + e0) = pack8(y0, y1);
            if (xf8) { u32x2 w; w.x = pkf8(y0[0], y0[1], y0[2], y0[3]); w.y = pkf8(y1[0], y1[1], y1[2], y1[3]); *(GAS u32x2*)(xf8 + (size_t)m * DM + e0) = w; } }
    }
}
__device__ __forceinline__ void conv_fixup(unsigned char* ACT, const float* HEADB, const float* TAILB, const float* cw, const float* cb, int vcu, int tid) {
    constexpr int CH8 = DFF / 8;
    for (int it = (vcu & 31) * 512 + tid; it < 8 * 4 * 2 * CH8; it += 32 * 512) {
        const int c8 = it % CH8, rr = (it / CH8) & 1, g4 = (it / (2 * CH8)) & 3, s_ = it / (8 * CH8); const int g = own_panel(vcu >> 5, s_) * 4 + g4;
        const int ch = 8 * c8, pg = 256 * (ch >> 7) + (ch & 127); const bool first = (g & 127) == 0;
        f32x4 res[2][2];
#pragma unroll
        for (int bj = 0; bj < 2; ++bj) { const int pc = pg + bj * 128, c = ch + bj * DFF;
#pragma unroll
            for (int n = 0; n < 2; ++n) { const f32x4 z = (f32x4){0.f, 0.f, 0.f, 0.f};
                const f32x4 u0 = *(const GAS f32x4*)(HEADB + ((size_t)g * 2 + rr) * NUP + pc + 4 * n);
                const f32x4 t1 = first ? z : *(const GAS f32x4*)(TAILB + ((size_t)(g - 1) * 2 + 1) * NUP + pc + 4 * n);
                const f32x4 t0 = first ? z : *(const GAS f32x4*)(TAILB + ((size_t)(g - 1) * 2 + 0) * NUP + pc + 4 * n);
                const f32x4 h0 = *(const GAS f32x4*)(HEADB + ((size_t)g * 2 + 0) * NUP + pc + 4 * n);
                const f32x4 u1 = rr ? h0 : t1, u2 = rr ? t1 : t0;
                const f32x4 w0 = *(const GAS f32x4*)(cw + c + 4 * n), w1 = *(const GAS f32x4*)(cw + NUP + c + 4 * n), w2 = *(const GAS f32x4*)(cw + 2 * NUP + c + 4 * n), bb = *(const GAS f32x4*)(cb + c + 4 * n);
                res[bj][n] = bb + w2 * u0 + w1 * u1 + w0 * u2; } }
        const f32x4 a0 = res[0][0] * sigmoid4(res[0][0]) * res[1][0], a1 = res[0][1] * sigmoid4(res[0][1]) * res[1][1];
        { u32x2 w; w.x = pkf8(a0[0], a0[1], a0[2], a0[3]); w.y = pkf8(a1[0], a1[1], a1[2], a1[3]); *(GAS u32x2*)(ACT + ((size_t)g * 64 + rr) * DFF + ch) = w; }
    }
}

struct Args { const float* in[22]; float* out; unsigned char* ws; };
#define GEMM_PHASE_LC(EPI, A_, B_, N_, K_, E_, DT_, WS_, LDA_, C_) do { int kk_ = (K_); asm volatile("" : "+s"(kk_)); pg8::Gemm g_{(const pg8::bf16_t*)(A_), (const pg8::bf16_t*)(B_), M, (N_), kk_, (WS_), (LDA_)}; pg8::StaticOrder S_; S_.init(M, (N_), G, (C_)); \
        pg8::gemm_phase<EPI, pg8::StaticOrder, true, true, DT_>(lds, g_, S_, (E_)); } while (0)
#define GEMM_PHASE_L(EPI, A_, B_, N_, K_, E_, DT_, WS_, LDA_) do { int kk_ = (K_); asm volatile("" : "+s"(kk_)); pg8::Gemm g_{(const pg8::bf16_t*)(A_), (const pg8::bf16_t*)(B_), M, (N_), kk_, (WS_), (LDA_)}; pg8::StaticOrder S_; S_.init(M, (N_), G, bx); \
        pg8::gemm_phase<EPI, pg8::StaticOrder, true, true, DT_>(lds, g_, S_, (E_)); } while (0)
#define GEMM_PHASE_X(EPI, A_, B_, N_, K_, E_, DT_, WS_) GEMM_PHASE_L(EPI, A_, B_, N_, K_, E_, DT_, WS_, 0)
#define GEMM_PHASE_T(EPI, A_, B_, N_, K_, E_, F16_) GEMM_PHASE_X(EPI, A_, B_, N_, K_, E_, ((F16_) ? 1 : 0), 127)
#define GEMM_PHASE(EPI, A_, B_, N_, K_, E_) GEMM_PHASE_X(EPI, A_, B_, N_, K_, E_, 0, 127)

__global__ void __launch_bounds__(NWAVES * 64, 2) fwd_kernel(Args args) {
    extern __shared__ __attribute__((aligned(16))) unsigned char lds_raw[];
    LAS unsigned char* lds = (LAS unsigned char*)lds_raw;
    volatile LAS unsigned* MISC = (volatile LAS unsigned*)(lds + MISC_OFF);
    const int tid0 = threadIdx.x, wave = __builtin_amdgcn_readfirstlane(tid0 >> 6);
#define TID() ({ int t_ = threadIdx.x; asm volatile("" : "+v"(t_)); t_; })
#define LANE() (TID() & 63)
#define GT() ((size_t)bx * (NWAVES * 64) + TID())
    for (int u = threadIdx.x; u < (LDS_BYTES - LDSCTL_OFF) / 4; u += NWAVES * 64) ((LAS unsigned*)(lds + LDSCTL_OFF))[u] = 0u;
    __syncthreads();
    if (threadIdx.x == 0) { const unsigned xcc = xb_xcc_id() & 7u; const unsigned rk = __hip_atomic_fetch_add((gu32*)(args.ws + WS_CTL) + CW_RANK + 64 * xcc, 1u, RLX_AGENT); MISC[12] = (rk & 31u) * 8u + xcc; }
    __syncthreads();
    const int G = gridDim.x, bx = __builtin_amdgcn_readfirstlane((int)MISC[12]), vcu = (bx % 8) * (G / 8) + bx / 8;
    const int gw = vcu * NWAVES + wave, NGW = G * NWAVES; const size_t NT = (size_t)G * NWAVES * 64;
#define WSP(T_, off_) ((T_*)(wsb() + (off_)))
#define INP(k_) inb(k_)
#define DOP(T_, off_) ((T_*)((unsigned char*)outb() + (off_)))
    auto wsb = [&]() __attribute__((always_inline)) { unsigned char* w_ = args.ws; asm volatile("" : "+s"(w_)); return w_; };
    auto inb = [&](int k_) __attribute__((always_inline)) { const float* p_ = args.in[k_]; asm volatile("" : "+s"(p_)); return p_; };
    auto outb = [&]() __attribute__((always_inline)) { float* p_ = args.out; asm volatile("" : "+s"(p_)); return p_; };

    XcdBarrier bar = xcd_barrier_post((unsigned*)((gu32*)(args.ws + WS_CTL) + CW_BAR), MISC + 8);
#if defined(DBG_CKPT)
#define CKPT(id_, lo_, hi_) do { if (DBG_CKPT == (id_)) { unsigned* cw_ = WSP(unsigned, WS_CTL) + 200100; const unsigned* p_ = (const unsigned*)(wsb() + (size_t)(lo_) * MiB); unsigned c_ = 0u; \
        for (size_t i = GT(); i < (size_t)((hi_) - (lo_)) * MiB / 4; i += NT) c_ += p_[i] * 2654435761u + (unsigned)i; \
        c_ += __shfl_xor(c_, 32); c_ += __shfl_xor(c_, 16); c_ += __shfl_xor(c_, 8); c_ += __shfl_xor(c_, 4); c_ += __shfl_xor(c_, 2); c_ += __shfl_xor(c_, 1); \
        if ((TID() & 63) == 0) atomicAdd(cw_, c_); xcd_barrier(bar); \
        const float X = (float)(__hip_atomic_load(cw_, RLX_AGENT) & 0xFFFFFFu) + 1.0f; float* o_ = outb(); \
        for (size_t i = GT(); i < (size_t)M * DM / 4; i += NT) *((GAS f32x4*)o_ + i) = (f32x4){X, X, X, X}; return; } } while (0)
#else
#define CKPT(id_, lo_, hi_) do { } while (0)
#endif
#if defined(DBG_SPIN)
#define STAMP(i_) do { if (threadIdx.x == 0) { const unsigned long long t_ = __builtin_amdgcn_s_memrealtime(); MISC[16 + 2 * (i_)] = (unsigned)t_; MISC[17 + 2 * (i_)] = (unsigned)(t_ >> 32); const unsigned long long c_ = __builtin_amdgcn_s_memtime(); MISC[100 + 2 * (i_)] = (unsigned)c_; MISC[101 + 2 * (i_)] = (unsigned)(c_ >> 32); } } while (0)
#else
#define STAMP(i_) do { } while (0)
#endif
#define SCR() ((LAS float*)(lds + RING_OFF + wave * TR_LDS))
#define SSQP() ((float*)(wsb() + WS_CTL + MiB))

#if defined(DBG_CHECK)
#define DBG_OA ((DBG_CHECK == 1 || DBG_CHECK == 4) ? WS_XB : WS_QA)
#define DBG_OB (DBG_CHECK == 2 ? WS_XB : WS_QN)
#define DBG_SEL ((DBG_CHECK == 1 || DBG_CHECK == 4) ? (unsigned short*)(wsb() + WS_END) : (unsigned short*)nullptr)
#else
#define DBG_OA WS_QA
#define DBG_OB WS_QN
#define DBG_SEL ((unsigned short*)nullptr)
#endif
#ifndef ONLY
#define ONLY -1
#endif
#ifndef SKIPMASK
#define SKIPMASK 0
#endif
#define PH(k) ((ONLY < 0 || ONLY == (k)) && !((SKIPMASK >> (k)) & 1))
    STAMP(0);
    if (PH(0)) {
    { const TrIn I{INP(2), INP(3), INP(4), INP(5), INP(6), INP(7), INP(8), INP(9), INP(10), INP(13), INP(16), INP(17), INP(19)}; tr_all(I, wsb(), SCR(), gw, NGW, LANE()); }
    cvt_flat_h(INP(0), WSP(bf16, WS_XB), WSP(unsigned char, WS_XF8), (size_t)M * DM / 8, GT(), NT);
    cvt_flat(INP(1), WSP(bf16, WS_PB), (size_t)M * PLE_DIM / 8, GT(), NT);
    { float* ROPE = WSP(float, WS_ROPE);
    for (size_t i = GT(); i < (size_t)SEQ * 32; i += NT) { const int pos = (int)(i >> 5), j = (int)(i & 31);
        const double f = exp2(-(double)j * (13.287712379549449 / 32.0)), turns = (double)pos * f * 0.15915494309189535, fr = turns - floor(turns);
        ROPE[i] = __builtin_amdgcn_cosf((float)fr); ROPE[(size_t)SEQ * 32 + i] = __builtin_amdgcn_sinf((float)fr); } }
    }
    xcd_barrier(bar);

    STAMP(1);
    if (PH(1)) { EpiU<1> E{WSP(bf16, WS_QA), DOP(bf16, DO_QI), DOP(bf16, DO_KA), DOP(bf16, DO_VA), DOP(bf16, DO_KI), DOP(bf16, DO_KR), DOP(bf16, DO_CQ), DOP(bf16, DO_CKV), DOP(float, DO_WI), SSQP(), WSP(float, WS_ROPE)};
        GEMM_PHASE_X(EpiU<1>, WSP(bf16, WS_XF8), WSP(bf16, WS_WIN8), NU8, 1024, E, 2, 127 - 6); }
    if (PH(1)) { EpiU<2> E{WSP(bf16, WS_QA), DOP(bf16, DO_QI), DOP(bf16, DO_KA), DOP(bf16, DO_VA), DOP(bf16, DO_KI), DOP(bf16, DO_KR), DOP(bf16, DO_CQ), DOP(bf16, DO_CKV), DOP(float, DO_WI), SSQP(), WSP(float, WS_ROPE)};
        GEMM_PHASE_LC(EpiU<2>, WSP(bf16, WS_XB), WSP(bf16, WS_WIN), NU16, 2048, E, 1, 127, 0, (bx + 64) % G); }
    xcd_barrier(bar);
    CKPT(1, 118, 260);

#if defined(DBG_CHECK) && DBG_CHECK == 3
    {   float* dbgw = (float*)(WSP(unsigned, WS_CTL) + 200000);
        LAS float* xr = (LAS float*)lds; LAS float* red = (LAS float*)(lds + 65536); LAS float* tru = (LAS float*)(lds + 69632);
        for (int smp = bx; smp < 256; smp += G) chk::p1(INP(0), INP(2), WSP(bf16, WS_QA), DOP(bf16, DO_QI), DOP(bf16, DO_KA), DOP(bf16, DO_VA), DOP(bf16, DO_KI), DOP(float, DO_WI), DOP(bf16, DO_CQ), DOP(bf16, DO_CKV), DOP(bf16, DO_KR), smp, xr, red, tru, dbgw, TID());
        xcd_barrier(bar);
        const float X = __hip_atomic_load(dbgw + DBG_WORD, RLX_AGENT) * 1e8f; float* o_ = outb();
        for (size_t i = GT(); i < (size_t)M * DM / 4; i += NT) *((GAS f32x4*)o_ + i) = (f32x4){X, X, X, X};
        return;
    }
#endif
#if defined(DBG_CHECK) && DBG_CHECK == 5
    {
        float* dbgw = (float*)(WSP(unsigned, WS_CTL) + 200000);
        for (int rep = 0; rep < 2; ++rep) {
            const dsa::Ptrs P{DOP(bf16, DO_QI), DOP(bf16, DO_KI), DOP(bf16, DO_KA), DOP(bf16, DO_VA), DOP(float, DO_WI), WSP(bf16, WS_QA), rep == 0 ? WSP(bf16, WS_XB) : WSP(bf16, WS_QN), (unsigned short*)(wsb() + WS_END + (size_t)rep * 8 * MiB)};
            LAS unsigned char* wl = lds + RING_OFF + wave * 16384; LAS dsa::u16* idl = (LAS dsa::u16*)(lds + IDL_OFF + wave * 2048);
            const int x_ = vcu >> 5, wv = (vcu & 31) * NWAVES + wave, j_ = wv >> 6, i_ = wv & 63;
#pragma unroll 1
            for (int jb = 0; jb < 2; ++jb) dsa::job(P, jb, jb == 0 ? 256 * (x_ + 8 * j_) + 4 * i_ : 256 * ((7 - x_) + 8 * (3 - j_)) + 4 * (63 - i_), wl, idl, LANE());
            xcd_barrier(bar);
        }
        { const unsigned short* sa = (const unsigned short*)(wsb() + WS_END); const unsigned short* sb = sa + (size_t)4 * MiB; unsigned c = 0u;
          for (size_t i = GT(); i < (size_t)M * 256; i += NT) c += sa[i] != sb[i] ? 1u : 0u;
          if (c) atomicAdd((unsigned*)dbgw + 20, c);
          const unsigned* oa = (const unsigned*)WSP(bf16, WS_XB); const unsigned* ob = (const unsigned*)WSP(bf16, WS_QN); unsigned c2 = 0u;
          for (size_t i = GT(); i < (size_t)M * 1024; i += NT) c2 += oa[i] != ob[i] ? 1u : 0u;
          if (c2) atomicAdd((unsigned*)dbgw + 21, c2); }
        xcd_barrier(bar);
        const float X = ((float)__hip_atomic_load((unsigned*)dbgw + 20 + DBG_WORD, RLX_AGENT) + 1.0f) * 1e8f; float* o_ = outb();
        for (size_t i = GT(); i < (size_t)M * DM / 4; i += NT) *((GAS f32x4*)o_ + i) = (f32x4){X, X, X, X};
        return;
    }
#endif
    STAMP(2);
    if (PH(3)) { const dsa::Ptrs P{DOP(bf16, DO_QI), DOP(bf16, DO_KI), DOP(bf16, DO_KA), DOP(bf16, DO_VA), DOP(float, DO_WI), WSP(bf16, WS_QA), WSP(bf16, DBG_OA), DBG_SEL};
      LAS unsigned char* wl = lds + RING_OFF + wave * 16384; LAS dsa::u16* idl = (LAS dsa::u16*)(lds + IDL_OFF + wave * 2048);
      const int x_ = vcu >> 5, j_ = wave & 3, i_ = (vcu & 31) * 2 + (wave >> 2);
#pragma unroll 1
      for (int jb = 0; jb < 2; ++jb) dsa::job(P, jb, jb == 0 ? 256 * (x_ + 8 * j_) + 4 * i_ : 256 * ((7 - x_) + 8 * (3 - j_)) + 4 * (63 - i_), wl, idl, LANE(), wave == 0 ? MISC + 64 : nullptr); }
    __syncthreads();
    STAMP(3);
    if (PH(2)) { EpiQ E{WSP(bf16, WS_QN), DOP(bf16, DO_QR), SSQP(), WSP(float, WS_ROPE)}; GEMM_PHASE_X(EpiQ, DOP(bf16, DO_CQ), WSP(bf16, WS_WUQ), 3072, 256, E, 2, 127 - 5); }
    if (PH(2)) { EpiKV E{WSP(bf16, WS_KN), WSP(bf16, WS_VB), SSQP() + (size_t)M * 8}; GEMM_PHASE_X(EpiKV, DOP(bf16, DO_CKV), WSP(bf16, WS_WKV), 4096, 256, E, 2, 127 - 5); }
    xcd_barrier(bar);
    CKPT(2, 118, 182); CKPT(3, 260, 484);
#if defined(DBG_CHECK) && DBG_CHECK == 6
    {   float* dbgw = (float*)(WSP(unsigned, WS_CTL) + 200000);
        LAS float* cr = (LAS float*)lds; LAS float* red = (LAS float*)(lds + 65536); LAS float* tru = (LAS float*)(lds + 69632);
        for (int smp = bx; smp < 256; smp += G) chk::p2(DOP(bf16, DO_CQ), DOP(bf16, DO_CKV), INP(3), INP(4), INP(5), INP(6), INP(7), WSP(bf16, WS_QN), DOP(bf16, DO_QR), WSP(bf16, WS_KN), WSP(bf16, WS_VB), smp, cr, red, tru, dbgw, TID());
        xcd_barrier(bar);
        const float X = __hip_atomic_load(dbgw + DBG_WORD, RLX_AGENT) * 1e8f; float* o_ = outb();
        for (size_t i = GT(); i < (size_t)M * DM / 4; i += NT) *((GAS f32x4*)o_ + i) = (f32x4){X, X, X, X};
        return;
    }
#endif

    STAMP(4);
    if (PH(4)) { const mla::Tensors T{WSP(bf16, WS_QN), DOP(bf16, DO_QR), WSP(bf16, WS_KN), DOP(bf16, DO_KR), WSP(bf16, WS_VB), DOP(bf16, DO_AB8)};
#pragma unroll 1
      for (int r_ = 0; r_ < 2; ++r_) { const int x_ = vcu >> 5, q_ = (vcu & 31) * 2 + r_, j_ = q_ >> 4, h_ = q_ & 15;
#pragma unroll 1
          for (int ps = 0; ps < 2; ++ps) mla::unit(T, ps, h_, ps == 0 ? x_ + 8 * j_ : (7 - x_) + 8 * (3 - j_), lds + RING_OFF); } }
    xcd_barrier(bar);
    CKPT(4, 260, 324);

#if defined(DBG_CHECK) && (DBG_CHECK == 1 || DBG_CHECK == 2 || DBG_CHECK == 4)
    {
        float* dbgw = (float*)(WSP(unsigned, WS_CTL) + 200000);
        LAS float* lgs = (LAS float*)lds; LAS float* red = (LAS float*)(lds + 65536); LAS float* aux = (LAS float*)(lds + 69632);
        for (int smp = bx; smp < (DBG_CHECK == 4 ? 256 : 512); smp += G) {
#if DBG_CHECK == 2
            chk::mla(WSP(bf16, WS_QN), DOP(bf16, DO_QR), WSP(bf16, WS_KN), DOP(bf16, DO_KR), WSP(bf16, WS_VB), WSP(bf16, DBG_OB), smp, lgs, red, aux, dbgw, TID());
#else
            chk::dsa<(DBG_CHECK == 4)>(INP(0), INP(2), DOP(bf16, DO_QI), DOP(bf16, DO_KI), DOP(float, DO_WI), WSP(bf16, WS_QA), DOP(bf16, DO_KA), DOP(bf16, DO_VA), WSP(bf16, DBG_OA), DBG_SEL, smp, lgs, red, aux, dbgw, TID());
#endif
        }
        xcd_barrier(bar);
        const float X = __hip_atomic_load(dbgw + DBG_WORD, RLX_AGENT) * 1e8f; float* o_ = outb();
        for (size_t i = GT(); i < (size_t)M * DM / 4; i += NT) *((GAS f32x4*)o_ + i) = (f32x4){X, X, X, X};
        return;
    }
#endif
    STAMP(5);
    if (PH(5)) { EpiB<1> E{WSP(bf16, WS_G), 4096, nullptr, nullptr, nullptr}; GEMM_PHASE_X(EpiB<1>, WSP(bf16, WS_XF8), WSP(bf16, WS_WG), 4096, 1024, E, 2, 127 - 6); }
    xcd_barrier(bar);
    CKPT(5, 356, 484); CKPT(6, 182, 256); CKPT(7, 324, 348);
#if defined(DBG_CHECK) && DBG_CHECK == 10
    {
        unsigned* dw = WSP(unsigned, WS_CTL) + 200000; const bf16* Gp = WSP(bf16, WS_G);
        unsigned cntb = 0u, rmax = 0u, rmin = 255u, pnmax = 0u, pnmin = 15u, r16 = 0u, nnan = 0u, pmaxb = 0u, pminb = 63u; float vmax = 0.f;
        for (int s_ = 0; s_ < 8; ++s_) { const int pnl = own_panel(vcu >> 5, s_);
            for (int e = (vcu & 31) * 512 + (int)TID(); e < 256 * 4096 / 8; e += 32 * 512) { const int r = e / 512, c8 = e % 512; const v4u w = *(const GAS v4u*)(Gp + ((size_t)pnl * 256 + r) * 4096 + c8 * 8); f32x4 a, b; unpack8(w, a, b);
                bool bad = false;
#pragma unroll
                for (int j = 0; j < 4; ++j) { bad |= !(a[j] >= 0.f && a[j] <= 1.001f); bad |= !(b[j] >= 0.f && b[j] <= 1.001f); }
                if (bad) { for (int j = 0; j < 4; ++j) { if (a[j] == a[j] && fabsf(a[j]) < 1e30f) vmax = fmaxf(vmax, fabsf(a[j])); else ++nnan; if (b[j] == b[j] && fabsf(b[j]) < 1e30f) vmax = fmaxf(vmax, fabsf(b[j])); else ++nnan; } pmaxb = max(pmaxb, (unsigned)pnl); pminb = min(pminb, (unsigned)pnl);
                    ++cntb; rmax = max(rmax, (unsigned)r); rmin = min(rmin, (unsigned)r); pnmax = max(pnmax, (unsigned)(c8 / 32)); pnmin = min(pnmin, (unsigned)(c8 / 32)); r16 |= 1u << (r & 15); } } }
        if (cntb) { atomicAdd(dw + 0, cntb); atomicMax(dw + 1, rmax + 1u); atomicMax(dw + 2, 256u - rmin); atomicMax(dw + 3, pnmax + 1u); atomicMax(dw + 4, 16u - pnmin); atomicOr(dw + 5, r16); atomicMax(dw + 6, (unsigned)vmax); atomicAdd(dw + 7, nnan); atomicMax(dw + 8, pmaxb + 1u); atomicMax(dw + 9, 64u - pminb); }
        xcd_barrier(bar);
        const float X = (float)__hip_atomic_load(dw + DBG_WORD, RLX_AGENT) * 1e8f; float* o_ = outb();
        for (size_t i = GT(); i < (size_t)M * DM / 4; i += NT) *((GAS f32x4*)o_ + i) = (f32x4){X, X, X, X};
        return;
    }
#endif
#if defined(DBG_CHECK) && DBG_CHECK == 9
    {   float* dbgw = (float*)(WSP(unsigned, WS_CTL) + 200000);
        LAS float* xr = (LAS float*)lds; LAS float* red = (LAS float*)(lds + 65536);
        { const size_t row_ = (size_t)256 * own_panel(vcu >> 5, vcu & 7) + (((unsigned)vcu * 2654435761u) >> 9) % 256;
          chk::gchk(INP(0), INP(2), WSP(bf16, WS_G), WSP(bf16, WS_XB), row_, xr, red, dbgw, TID()); }
        xcd_barrier(bar);
        const float X = __hip_atomic_load(dbgw + DBG_WORD, RLX_AGENT) * 1e8f; float* o_ = outb();
        for (size_t i = GT(); i < (size_t)M * DM / 4; i += NT) *((GAS f32x4*)o_ + i) = (f32x4){X, X, X, X};
        return;
    }
#endif

    STAMP(6);
    if (PH(7)) { EpiB<2> E{WSP(bf16, WS_MT), 2048, WSP(bf16, WS_G), nullptr, nullptr}; GEMM_PHASE_L(EpiB<2>, WSP(bf16, WS_QA), WSP(bf16, WS_WA), 2048, 1024, E, 2, 127 - 6, 2048); }
    if (PH(7)) { EpiB<5> E{WSP(bf16, WS_MT), 2048, (const bf16*)(WSP(unsigned char, WS_G) + 2048), nullptr, WSP(unsigned char, WS_MG8)}; GEMM_PHASE_X(EpiB<5>, DOP(bf16, DO_AB8), WSP(bf16, WS_WB), 2048, 1024, E, 2, 127 - 6); }
    xcd_barrier(bar);
    CKPT(8, 54, 118);

    STAMP(7);
    if (PH(8)) { EpiF<0> E{WSP(bf16, WS_X1B), INP(0), nullptr}; GEMM_PHASE_X(EpiF<0>, WSP(bf16, WS_MG8), WSP(bf16, WS_WO), 2048, 1024, E, 2, 127 - 6); }
    xcd_barrier(bar);
#if defined(DBG_CHECK) && DBG_CHECK == 7
    {   float* dbgw = (float*)(WSP(unsigned, WS_CTL) + 200000);
        LAS float* va = (LAS float*)lds; LAS float* red = (LAS float*)(lds + 65536); LAS float* mg = (LAS float*)(lds + 69632);
        { const size_t row_ = (size_t)256 * own_panel(vcu >> 5, vcu & 7) + (((unsigned)vcu * 2654435761u) >> 9) % 256;
          chk::mid(INP(0), INP(2), INP(8), INP(9), INP(10), WSP(bf16, WS_QA), WSP(bf16, WS_QN), WSP(bf16, WS_G), WSP(bf16, WS_MT), outb(), row_, vcu, va, red, mg, dbgw, TID()); }
        xcd_barrier(bar);
        const float X = __hip_atomic_load(dbgw + DBG_WORD, RLX_AGENT) * 1e8f; float* o_ = outb();
        for (size_t i = GT(); i < (size_t)M * DM / 4; i += NT) *((GAS f32x4*)o_ + i) = (f32x4){X, X, X, X};
        return;
    }
#endif
    if (PH(9)) { bf16* z_ = WSP(bf16, WS_X1B); ln_pass(z_, nullptr, z_, WSP(unsigned char, WS_X1F8), INP(11), INP(12), vcu, wave, LANE()); }
    xcd_barrier(bar);
    CKPT(9, 118, 182);

    STAMP(8);
    if (PH(10)) { EpiUp E{WSP(unsigned char, WS_ACT), WSP(float, WS_HEAD), WSP(float, WS_TAIL), INP(14), INP(15)}; GEMM_PHASE_X(EpiUp, WSP(bf16, WS_X1F8), WSP(bf16, WS_WUP), NUP, 1024, E, 2, 127 - 6); }
    xcd_barrier(bar);
    CKPT(10, 260, 484);

    STAMP(9);
    if (PH(11)) conv_fixup(WSP(unsigned char, WS_ACT), WSP(float, WS_HEAD), WSP(float, WS_TAIL), INP(14), INP(15), vcu, TID());
    if (PH(12)) { EpiB<0> E{WSP(bf16, WS_PEO), 2048, nullptr, nullptr, nullptr}; GEMM_PHASE(EpiB<0>, WSP(bf16, WS_PB), WSP(bf16, WS_WPE), 2048, 256, E); }
    if (PH(15)) { EpiB<4> E{WSP(bf16, WS_PEO), 2048, nullptr, INP(18), nullptr}; GEMM_PHASE_X(EpiB<4>, WSP(bf16, WS_X1F8), WSP(bf16, WS_WPG), 2048, 1024, E, 2, 127 - 6); }
    xcd_barrier(bar);
    CKPT(11, 54, 118); CKPT(12, 308, 484);

    STAMP(10);
    if (PH(13)) { EpiF<1> E{WSP(bf16, WS_X1B), nullptr, WSP(bf16, WS_PEO)}; GEMM_PHASE_X(EpiF<1>, WSP(bf16, WS_ACT), WSP(bf16, WS_WDN), 2048, DFF / 2, E, 2, 127 - 7); }
    xcd_barrier(bar);
    if (PH(14)) { ln_pass(WSP(bf16, WS_X1B), outb(), nullptr, nullptr, INP(20), INP(21), vcu, wave, LANE()); }
#if defined(DBG_SPIN)
    STAMP(11);
    if (threadIdx.x == 0 && vcu == DBG_VCU) { const unsigned long long a_ = ((unsigned long long)MISC[17 + 2 * (DBG_SPIN % 100)] << 32) | MISC[16 + 2 * (DBG_SPIN % 100)], b_ = ((unsigned long long)MISC[17 + 2 * (DBG_SPIN % 100 + DBG_SPAN)] << 32) | MISC[16 + 2 * (DBG_SPIN % 100 + DBG_SPAN)];
        const unsigned long long ca_ = ((unsigned long long)MISC[101 + 2 * (DBG_SPIN % 100)] << 32) | MISC[100 + 2 * (DBG_SPIN % 100)], cb_ = ((unsigned long long)MISC[101 + 2 * (DBG_SPIN % 100 + DBG_SPAN)] << 32) | MISC[100 + 2 * (DBG_SPIN % 100 + DBG_SPAN)];
        const unsigned long long t0_ = __builtin_amdgcn_s_memrealtime(), w_ = DBG_SPIN >= 200 ? (cb_ - ca_) / 20ull : DBG_SPIN >= 100 ? 4ull * MISC[64 + (DBG_SPIN - 100)] : 4ull * (b_ - a_); while (__builtin_amdgcn_s_memrealtime() - t0_ < w_) __builtin_amdgcn_s_sleep(8); }
#endif
#if defined(DBG_CHECK) && DBG_CHECK == 8
    {   xcd_barrier(bar);
        float* dbgw = (float*)(WSP(unsigned, WS_CTL) + 200000);
        LAS float* xs = (LAS float*)lds; LAS float* red = (LAS float*)(lds + 65536); LAS float* act = (LAS float*)(lds + 69632);
        for (int smp = bx; smp < 256; smp += G) chk::endp(WSP(bf16, WS_X1B), nullptr, INP(1), INP(13), INP(14), INP(15), INP(16), INP(17), INP(18), INP(19), INP(20), INP(21), outb(), smp, xs, red, act, dbgw, TID());
        xcd_barrier(bar);
        const float X = __hip_atomic_load(dbgw + DBG_WORD, RLX_AGENT) * 1e8f; float* o_ = outb();
        for (size_t i = GT(); i < (size_t)M * DM / 4; i += NT) *((GAS f32x4*)o_ + i) = (f32x4){X, X, X, X};
    }
#endif
}

extern "C" void kernel_launch(void* const* d_in, const int* in_sizes, int n_in, void* d_out, int out_size, void* d_ws, size_t ws_size, hipStream_t stream) {
    static int grid = 0;
    if (grid == 0) {
        if (n_in != 22 || in_sizes[0] != M * DM || out_size != M * DM || ws_size < WS_END) { fprintf(stderr, "kernel_launch: unexpected shapes (n_in %d, in0 %d, out %d, ws %zu); nothing launched\n", n_in, n_in > 0 ? in_sizes[0] : -1, out_size, ws_size); grid = -1; return; }
        int dev = 0, cus = 0, per_cu = 0;
        if (hipGetDevice(&dev) != hipSuccess || hipDeviceGetAttribute(&cus, hipDeviceAttributeMultiprocessorCount, dev) != hipSuccess) { grid = -1; return; }
        if (hipFuncSetAttribute((const void*)fwd_kernel, hipFuncAttributeMaxDynamicSharedMemorySize, LDS_BYTES) != hipSuccess) { fprintf(stderr, "kernel_launch: hipFuncSetAttribute failed\n"); grid = -1; return; }
        if (hipOccupancyMaxActiveBlocksPerMultiprocessor(&per_cu, (const void*)fwd_kernel, NWAVES * 64, LDS_BYTES) != hipSuccess || per_cu < 1) { fprintf(stderr, "kernel_launch: occupancy query reports %d workgroups per CU\n", per_cu); }
        (void)hipGetLastError();
        grid = cus;
    }
    if (grid < 0) return;
    if (hipMemsetAsync((char*)d_ws + WS_CTL, 0, CTL_ZERO_BYTES, stream) != hipSuccess) return;
    Args a{};
    for (int i = 0; i < 22; ++i) a.in[i] = (const float*)d_in[i];
    a.out = (float*)d_out; a.ws = (unsigned char*)d_ws;
    hipLaunchKernelGGL(fwd_kernel, dim3(grid), dim3(NWAVES * 64), LDS_BYTES, stream, a);
}
```

```cpp
#include <hip/hip_runtime.h>
#include <cstdio>
#include <cstdint>
namespace pg8 {
#define PG8_LAS __attribute__((address_space(3)))
typedef unsigned short bf16_t;
typedef short bf16x8 __attribute__((ext_vector_type(8)));
typedef float f32x4 __attribute__((ext_vector_type(4)));
typedef unsigned u32x4 __attribute__((ext_vector_type(4)));
constexpr int BM = 256, BK = 64, HALF = 128, HTB = HALF * BK * 2  , STAGE_BYTES = 8 * HTB, NXCD = 8, WGM = 8;

__host__ __device__ __forceinline__ int lds_byte(int r, int c) { const int st = (r >> 4) * 2 + (c >> 5), rr = r & 15, cc = c & 31, ob = rr * 64 + cc * 2; return st * 1024 + (ob ^ (((ob >> 9) & 1) << 5)); }
__host__ __device__ __forceinline__ void stage_rc(int b, int& R, int& C) { const int st = b / 1024, sb = b % 1024, swz = sb ^ (((sb >> 9) & 1) << 5); R = (st >> 1) * 16 + swz / 64; C = (st & 1) * 32 + (swz % 64) / 2; }
__host__ __device__ __forceinline__ int perm32(int rho) { const int n = rho >> 4, i = rho & 15; return 8 * (i >> 2) + 4 * n + (i & 3); }

struct Unit { int pm, pn; };
struct Gemm { const bf16_t* A; const bf16_t* Bt; int M, N, K; int wscale; int lda; };
typedef int i32x4 __attribute__((ext_vector_type(4))); typedef int i32x8 __attribute__((ext_vector_type(8)));
typedef _Float16 f16x8 __attribute__((ext_vector_type(8)));

struct StaticOrder {
    int nM, nN, nwg, G, c;
    __host__ __device__ void init(int M, int N, int G_, int c_) { nM = M / BM; nN = N / BM; nwg = nM * nN; G = G_; c = c_; }
    __host__ __device__ bool next(int i, Unit& u) const {
        const long L = (long)i * G + c; if (L >= nwg) return false;
        int wgid = (int)L; { const int q = nwg / NXCD, r = nwg % NXCD, xcd = wgid % NXCD, off = wgid / NXCD; wgid = (xcd < r ? xcd * (q + 1) : r * (q + 1) + (xcd - r) * q) + off; }
        const int nig = WGM * nN, gid = wgid / nig, fm = gid * WGM, gsz = (nM - fm) < WGM ? (nM - fm) : WGM;
        u.pm = fm + ((wgid % nig) % gsz); u.pn = (wgid % nig) / gsz;
        { const int x = u.pm >> 3, s = u.pm & 7; u.pm = s < 4 ? x + 8 * s : 32 + (7 - x) + 8 * (s - 4); }
        return true;
    }
    __device__ __forceinline__ void a_ready(const Unit&) const {}
    __device__ __forceinline__ void done(const Unit&) const {}
};

typedef float f32x2c_t __attribute__((ext_vector_type(2))); typedef __bf16 bf16x2c_t __attribute__((ext_vector_type(2)));
__device__ __forceinline__ unsigned cvt_pk_bf16(float lo, float hi) { const f32x2c_t v = {lo, hi}; const bf16x2c_t b = __builtin_convertvector(v, bf16x2c_t); return __builtin_bit_cast(unsigned, b); }
typedef float f32x2 __attribute__((ext_vector_type(2)));
template <class Epi, class Sched, bool ALIGN_EPI = false, bool SP2 = false, int DT = 0  >
__device__ __forceinline__ void gemm_phase(PG8_LAS unsigned char* lds, const Gemm g, const Sched& S, const Epi& E) {
    int tid_o_ = threadIdx.x; asm volatile("" : "+v"(tid_o_));
    const int tid = tid_o_, wid = __builtin_amdgcn_readfirstlane(tid >> 6), lane = tid & 63, wr = wid >> 2, wc = wid & 3, fr = lane & 15, fq = lane >> 4;
    const int K = g.K, nt = K / BK, lda = g.lda ? g.lda : g.K;
    unsigned voffA[2], voffB[2];
#pragma unroll
    for (int i = 0; i < 2; ++i) { int R, C; stage_rc(tid * 16 + i * 8192, R, C); const int Rb = Epi::PERM ? ((R & ~31) + perm32(R & 31)) : R;
        voffA[i] = (unsigned)(R * lda + C) * 2u; voffB[i] = (unsigned)(Rb * K + C) * 2u; }
    const size_t kstep = (size_t)(BK * 2);
    const size_t hstep = (size_t)HALF * K * 2;
    const size_t tstep = 2 * hstep;
    const size_t hstepA = (size_t)HALF * lda * 2, tstepA = 2 * hstepA;
    const unsigned ldsw = (unsigned)wid * 1024u;
    const int aoff = lds_byte(wr * 64 + fr, fq * 8), boff = lds_byte(wc * 32 + fr, fq * 8);
#define PG8_SA(b, h) (((b) * 2 + (h)) * HTB)
#define PG8_SB(b, h) ((4 + (b) * 2 + (h)) * HTB)
#define PG8_STAGE(bufoff, gbase, voff) do { _Pragma("unroll") for (int _i = 0; _i < 2; ++_i) \
        __builtin_amdgcn_global_load_lds((const unsigned*)((const char*)(gbase) + (voff)[_i]), (PG8_LAS unsigned*)(lds + (bufoff) + ldsw + _i * 8192), 16, 0, 0); } while (0)
#define PG8_LD16A(off_) (*(const PG8_LAS i32x4*)(abase8 + (off_)))
#define PG8_LD16B(off_) (*(const PG8_LAS i32x4*)(bbase8 + ((off_) - 65536)))
#define PG8_LDA(dst, b, h) do { if constexpr (DT == 2) { _Pragma("unroll") for (int m = 0; m < 4; ++m) dst##8[m] = __builtin_shufflevector(PG8_LD16A(PG8_SA(b, h) + m * 2048), PG8_LD16A(PG8_SA(b, h) + m * 2048 + 1024), 0, 1, 2, 3, 4, 5, 6, 7); } \
        else { _Pragma("unroll") for (int m = 0; m < 4; ++m) _Pragma("unroll") for (int k = 0; k < 2; ++k) dst[m][k] = *(const PG8_LAS bf16x8*)(lds + PG8_SA(b, h) + aoff + m * 2048 + k * 1024); } } while (0)
#define PG8_LDB(dst, b, h) do { if constexpr (DT == 2) { _Pragma("unroll") for (int n = 0; n < 2; ++n) dst##8[n] = __builtin_shufflevector(PG8_LD16B(PG8_SB(b, h) + n * 2048), PG8_LD16B(PG8_SB(b, h) + n * 2048 + 1024), 0, 1, 2, 3, 4, 5, 6, 7); } \
        else { _Pragma("unroll") for (int n = 0; n < 2; ++n) _Pragma("unroll") for (int k = 0; k < 2; ++k) dst[n][k] = *(const PG8_LAS bf16x8*)(lds + PG8_SB(b, h) + boff + n * 2048 + k * 1024); } } while (0)
#define PG8_MMA(ai, bj, At, Bt) do { __builtin_amdgcn_s_setprio(1); _Pragma("unroll") for (int m = 0; m < 4; ++m) _Pragma("unroll") for (int n = 0; n < 2; ++n) { \
        if constexpr (DT == 2) asm volatile("v_mfma_scale_f32_16x16x128_f8f6f4 %0, %1, %2, %0, %3, %4 op_sel_hi:[0,0,0]" : "+v"(acc[ai][bj][m][n]) : "v"(Bt##8[n]), "v"(At##8[m]), "v"(sclw), "v"(scla));   \
        else { _Pragma("unroll") for (int k = 0; k < 2; ++k) { \
        if constexpr (DT == 1) acc[ai][bj][m][n] = __builtin_amdgcn_mfma_f32_16x16x32_f16(__builtin_bit_cast(f16x8, Bt[n][k]), __builtin_bit_cast(f16x8, At[m][k]), acc[ai][bj][m][n], 0, 0, 0); \
        else acc[ai][bj][m][n] = __builtin_amdgcn_mfma_f32_16x16x32_bf16(Bt[n][k], At[m][k], acc[ai][bj][m][n], 0, 0, 0); } } } __builtin_amdgcn_s_setprio(0); } while (0)
#define PG8_WAIT_V(n) asm volatile("s_waitcnt vmcnt(" #n ")" ::: "memory")
#define PG8_WAIT_L(n) asm volatile("s_waitcnt lgkmcnt(" #n ")" ::: "memory")
#define PG8_BAR __builtin_amdgcn_s_barrier()
#define PG8_SCHED __builtin_amdgcn_sched_barrier(0)
    Unit cur, nxt; int ui = 0;
    if (!S.next(0, cur)) return;
    f32x4 acc[2][2][4][2];
#pragma unroll
    for (int a = 0; a < 2; ++a)
#pragma unroll
        for (int b = 0; b < 2; ++b)
#pragma unroll
            for (int m = 0; m < 4; ++m)
#pragma unroll
                for (int n = 0; n < 2; ++n) acc[a][b][m][n] = (f32x4){0.f, 0.f, 0.f, 0.f};
    const int sclw = g.wscale, scla = 127;
    unsigned abi_ = (unsigned)(uintptr_t)lds + (unsigned)aoff, bbi_ = (unsigned)(uintptr_t)lds + 65536u + (unsigned)boff; asm volatile("" : "+v"(abi_), "+v"(bbi_));
    const PG8_LAS unsigned char* abase8 = (const PG8_LAS unsigned char*)(uintptr_t)abi_; const PG8_LAS unsigned char* bbase8 = (const PG8_LAS unsigned char*)(uintptr_t)bbi_;
    bf16x8 At[4][2], B0[2][2], B1[2][2]; i32x8 At8[4], B08[2], B18[2];
    const char* cA = (const char*)g.A + (size_t)cur.pm * tstepA; const char* cB = (const char*)g.Bt + (size_t)cur.pn * tstep;
    S.a_ready(cur);
    if constexpr (SP2) {
        PG8_STAGE(PG8_SB(0, 0), cB, voffB); PG8_STAGE(PG8_SB(0, 1), cB + hstep, voffB); PG8_STAGE(PG8_SA(0, 0), cA, voffA); PG8_STAGE(PG8_SA(0, 1), cA + hstepA, voffA);
        if (wr == 1) PG8_BAR;
        PG8_WAIT_V(2); PG8_BAR;
        PG8_STAGE(PG8_SB(1, 0), cB + kstep, voffB); PG8_STAGE(PG8_SA(1, 0), cA + kstep, voffA); PG8_STAGE(PG8_SB(1, 1), cB + hstep + kstep, voffB);
        PG8_WAIT_V(6); PG8_BAR;
    } else {
        PG8_STAGE(PG8_SB(0, 0), cB, voffB); PG8_STAGE(PG8_SA(0, 0), cA, voffA); PG8_STAGE(PG8_SB(0, 1), cB + hstep, voffB); PG8_STAGE(PG8_SA(0, 1), cA + hstepA, voffA);
        if (wr == 1) PG8_BAR;
        PG8_WAIT_V(4); PG8_BAR;
        PG8_STAGE(PG8_SB(1, 0), cB + kstep, voffB); PG8_STAGE(PG8_SA(1, 0), cA + kstep, voffA); PG8_STAGE(PG8_SB(1, 1), cB + hstep + kstep, voffB);
        PG8_WAIT_V(6); PG8_BAR;
    }
    for (;;) {
        const bool has_next = S.next(ui + 1, nxt);
        const char* nA = has_next ? (const char*)g.A + (size_t)nxt.pm * tstepA : cA; const char* nB = has_next ? (const char*)g.Bt + (size_t)nxt.pn * tstep : cB;
        for (int t = 0; t < nt; t += 2) {
            const bool last = (t == nt - 2);
            const char* a1 = cA + (size_t)(t + 1) * kstep;
            const char* a2 = last ? nA : cA + (size_t)(t + 2) * kstep; const char* b2 = last ? nB : cB + (size_t)(t + 2) * kstep;
            const char* a3 = a2 + kstep; const char* b3 = b2 + kstep;
            if (last && has_next) S.a_ready(nxt);
            if constexpr (SP2) {
            PG8_LDB(B0, 0, 0); PG8_LDB(B1, 0, 1); PG8_SCHED; PG8_LDA(At, 0, 0); PG8_STAGE(PG8_SA(1, 1), a1 + hstepA, voffA);
            PG8_WAIT_V(8); PG8_WAIT_L(0); PG8_BAR; PG8_MMA(0, 0, At, B0); PG8_MMA(0, 1, At, B1); PG8_BAR; PG8_SCHED;
            PG8_LDA(At, 0, 1); PG8_STAGE(PG8_SB(0, 0), b2, voffB); PG8_STAGE(PG8_SB(0, 1), b2 + hstep, voffB); PG8_STAGE(PG8_SA(0, 0), a2, voffA);
            PG8_WAIT_V(8); PG8_WAIT_L(0); PG8_BAR; PG8_MMA(1, 0, At, B0); PG8_MMA(1, 1, At, B1); PG8_BAR; PG8_SCHED;
            PG8_LDB(B0, 1, 0); PG8_LDB(B1, 1, 1); PG8_SCHED; PG8_LDA(At, 1, 0); PG8_STAGE(PG8_SA(0, 1), a2 + hstepA, voffA);
            PG8_WAIT_V(8); PG8_WAIT_L(0); PG8_BAR; PG8_MMA(0, 0, At, B0); PG8_MMA(0, 1, At, B1); PG8_BAR; PG8_SCHED;
            PG8_LDA(At, 1, 1); PG8_STAGE(PG8_SB(1, 0), b3, voffB); PG8_STAGE(PG8_SB(1, 1), b3 + hstep, voffB); PG8_STAGE(PG8_SA(1, 0), a3, voffA);
            PG8_WAIT_V(8); PG8_WAIT_L(0); PG8_BAR; PG8_MMA(1, 0, At, B0); PG8_MMA(1, 1, At, B1); PG8_BAR; PG8_SCHED;
            } else {
            PG8_LDB(B0, 0, 0); PG8_SCHED; PG8_LDA(At, 0, 0); PG8_STAGE(PG8_SA(1, 1), a1 + hstepA, voffA);
            PG8_WAIT_L(8); PG8_BAR; PG8_WAIT_L(0); PG8_MMA(0, 0, At, B0); PG8_BAR; PG8_SCHED;
            PG8_LDB(B1, 0, 1); PG8_STAGE(PG8_SB(0, 0), b2, voffB);
            PG8_BAR; PG8_WAIT_L(0); PG8_MMA(0, 1, At, B1); PG8_BAR;
            PG8_LDA(At, 0, 1); PG8_STAGE(PG8_SA(0, 0), a2, voffA);
            PG8_BAR; PG8_WAIT_L(0); PG8_MMA(1, 0, At, B0); PG8_BAR; PG8_SCHED;
            PG8_STAGE(PG8_SB(0, 1), b2 + hstep, voffB);
            PG8_WAIT_V(6); PG8_BAR; PG8_MMA(1, 1, At, B1); PG8_BAR;
            PG8_LDB(B0, 1, 0); PG8_SCHED; PG8_LDA(At, 1, 0); PG8_STAGE(PG8_SA(0, 1), a2 + hstepA, voffA);
            PG8_WAIT_L(8); PG8_BAR; PG8_WAIT_L(0); PG8_MMA(0, 0, At, B0); PG8_BAR; PG8_SCHED;
            PG8_LDB(B1, 1, 1); PG8_STAGE(PG8_SB(1, 0), b3, voffB);
            PG8_BAR; PG8_WAIT_L(0); PG8_MMA(0, 1, At, B1); PG8_BAR;
            PG8_LDA(At, 1, 1); PG8_STAGE(PG8_SA(1, 0), a3, voffA);
            PG8_BAR; PG8_WAIT_L(0); PG8_MMA(1, 0, At, B0); PG8_BAR; PG8_SCHED;
            PG8_STAGE(PG8_SB(1, 1), b3 + hstep, voffB);
            PG8_WAIT_V(6); PG8_BAR; PG8_MMA(1, 1, At, B1); PG8_BAR;
            }
        }
        if constexpr (ALIGN_EPI) { if (wr == 0) PG8_BAR; }
        if constexpr (!Epi::AFTER_DRAIN) { E(acc, cur, wr, wc, fr, fq); S.done(cur); }
        if (!has_next) break;
#pragma unroll
        for (int a = 0; a < 2; ++a)
#pragma unroll
            for (int b = 0; b < 2; ++b)
#pragma unroll
                for (int m = 0; m < 4; ++m)
#pragma unroll
                    for (int n = 0; n < 2; ++n) acc[a][b][m][n] = (f32x4){0.f, 0.f, 0.f, 0.f};
        cur = nxt; cA = nA; cB = nB; ++ui;
        if constexpr (ALIGN_EPI) { if (wr == 1) PG8_BAR; }
    }
    PG8_WAIT_V(0);
    if constexpr (!ALIGN_EPI) { if (wr == 0) PG8_BAR; }
    PG8_BAR;
    if constexpr (Epi::AFTER_DRAIN) { E.fused(acc, cur, wr, wc, fr, fq, lds, wid, lane); S.done(cur); }
#undef PG8_SA
#undef PG8_SB
#undef PG8_STAGE
#undef PG8_LDA
#undef PG8_LD16A
#undef PG8_LD16B
#undef PG8_LDB
#undef PG8_MMA
#undef PG8_WAIT_V
#undef PG8_WAIT_L
#undef PG8_BAR
#undef PG8_SCHED
}
}

constexpr int NWAVES = 8;
constexpr int BATCH = 2, SEQ = 8192, DM = 2048, M = BATCH * SEQ;
constexpr int DIN = 8592, NU = 8704, NU1 = 4608;
constexpr int DFF = 5632, NUP = 2 * DFF, PLE_DIM = 256;
constexpr float LN_EPS = 1e-5f, RMS_EPS = 1e-6f;
constexpr float ALPHA = 1.189207115002721f;
constexpr float LOG2E = 1.4426950408889634f;
constexpr float QA_SCALE = 0.08838834764831845f * LOG2E;
constexpr float QB_SCALE = 0.07216878364870323f * LOG2E;
constexpr int U_QA = 0, U_KA = 2048, U_VA = 2176, U_QI = 2304, U_KI = 3328, U_WI = 3392, U_CQ = 3408, U_CKV = 3920, U_KPE = 4432, U_G = 4496;

constexpr size_t MiB = 1u << 20;
constexpr size_t WS_CTL = 0, CTL_ZERO_BYTES = 1 * MiB;
constexpr size_t WS_ROPE = 2 * MiB;
constexpr size_t WS_WIN = 4 * MiB;
constexpr size_t WS_WIN8 = 12 * MiB;
constexpr int NU16 = 1280, NU8 = 3328;
constexpr size_t WS_WUQ = 38 * MiB;
constexpr size_t WS_WKV = 41 * MiB;
constexpr size_t WS_WPE = 45 * MiB;
constexpr size_t WS_PB = 46 * MiB;
constexpr size_t WS_XB = 54 * MiB;
constexpr size_t WS_QA = 118 * MiB;
constexpr size_t WS_WUP = 182 * MiB, WS_WDN = 204 * MiB, WS_WPG = 215 * MiB;
constexpr size_t WS_WA = 223 * MiB, WS_WB = 227 * MiB, WS_WO = 231 * MiB, WS_WG = 235 * MiB;
constexpr size_t WS_QN = 260 * MiB;
constexpr size_t WS_XF8 = 324 * MiB;
constexpr size_t WS_MG8 = 292 * MiB;
constexpr size_t WS_KN = 356 * MiB, WS_VB = 420 * MiB;
constexpr size_t WS_G = 356 * MiB;
constexpr size_t WS_MT = WS_XB, WS_X1B = WS_QA, WS_PEO = WS_XB;
constexpr size_t WS_ACT = 320 * MiB;
constexpr size_t WS_X1F8 = 260 * MiB;
constexpr size_t WS_HEAD = 292 * MiB, WS_TAIL = 484 * MiB;
constexpr size_t DO_AB8 = 0 * MiB;
constexpr size_t DO_QI = 0 * MiB, DO_CQ = 32 * MiB, DO_CKV = 48 * MiB, DO_KA = 64 * MiB, DO_VA = 68 * MiB, DO_KI = 72 * MiB, DO_WI = 74 * MiB, DO_KR = 75 * MiB, DO_QR = 80 * MiB;
constexpr size_t WS_END = 506 * MiB;
constexpr int CW_TMO = 0, CW_CODE = 1, CW_BAR = 4096, CW_RANK = 32768, CW_JOB = 49152;
constexpr int CW_SSQ = 65536;

constexpr int RING_OFF = 0, RING_BYTES = 131072;
constexpr int IDL_OFF = 131072;
constexpr int LDSCTL_OFF = 147456, MISC_OFF = LDSCTL_OFF + 320;
constexpr int LDS_BYTES = 148480;
static_assert(MISC_OFF + 128 <= LDS_BYTES, "LDS map");
#define GAS __attribute__((address_space(1)))
#define LAS __attribute__((address_space(3)))
typedef unsigned short bf16;
typedef unsigned v4u __attribute__((ext_vector_type(4)));
typedef float f32x4 __attribute__((ext_vector_type(4)));
typedef short bf16x8 __attribute__((ext_vector_type(8)));
typedef GAS unsigned gu32;
typedef GAS unsigned long long gu64;
#define RLX_AGENT __ATOMIC_RELAXED, __HIP_MEMORY_SCOPE_AGENT
#define LDS_WAIT() asm volatile("s_waitcnt lgkmcnt(0)" ::: "memory")
#define VM_WAIT() asm volatile("s_waitcnt vmcnt(0)" ::: "memory")
__device__ __forceinline__ unsigned long long rt() { return __builtin_amdgcn_s_memrealtime(); }
__device__ __forceinline__ unsigned f2bf(float f) { unsigned u = __builtin_bit_cast(unsigned, f); return (u + 0x7fffu + ((u >> 16) & 1u)) >> 16; }
__device__ __forceinline__ unsigned pk2(float lo, float hi) { return f2bf(lo) | (f2bf(hi) << 16); }

#define XB_TMO      128
#define XB_XCNT(j)  (256  + 64 * (j))
#define XB_XSUB(j)  (1280 + 64 * (j))
#define XB_XGEN(j)  (2304 + 64 * (j))
#define XB_TOP      3328
#define XB_TOPGEN   3392
#define XCD_BAR_WORDS 3456
#define XB_SPIN_CAP (1u << 18)

__device__ __forceinline__ unsigned xb_ld(unsigned* p)              { return __hip_atomic_load(p, __ATOMIC_RELAXED, __HIP_MEMORY_SCOPE_AGENT); }
__device__ __forceinline__ unsigned xb_add(unsigned* p, unsigned v) { return __hip_atomic_fetch_add(p, v, __ATOMIC_RELAXED, __HIP_MEMORY_SCOPE_AGENT); }
__device__ __forceinline__ unsigned xb_xcc_id() { return (unsigned)__builtin_amdgcn_s_getreg((3 << 11) | 20) & 0xFu; }
#define XB_SPIN(cond, bar) do { unsigned _sp = 0; while (cond) { __builtin_amdgcn_s_sleep(1); \
    if ((++_sp & 255u) == 0u) { if (xb_ld(&(bar)[XB_TMO])) break; if (_sp > XB_SPIN_CAP) { atomicAdd(&(bar)[XB_TMO], 1u); break; } } } } while (0)

struct XcdBarrier {
    unsigned* bar; unsigned x;
    volatile LAS unsigned* st;
};

__device__ __forceinline__ XcdBarrier xcd_barrier_post(unsigned* bar, volatile LAS unsigned* st) {
    XcdBarrier b; b.bar = bar; b.x = xb_xcc_id(); b.st = st;
    if (threadIdx.x == 0) (void)xb_add(&bar[XB_XCNT(b.x)], 1u);
    return b;
}
__device__ __forceinline__ void xcd_barrier_complete(unsigned* bar, unsigned x, unsigned& nloc, unsigned& nx) {
    const unsigned G = gridDim.x * gridDim.y * gridDim.z;
    unsigned sum, cnt, mine, sp = 0u;
    for (;;) {
        sum = 0u; cnt = 0u; mine = 0u;
#pragma unroll
        for (unsigned j = 0; j < 16; ++j) { const unsigned c = xb_ld(&bar[XB_XCNT(j)]); sum += c; cnt += (c > 0u) ? 1u : 0u; mine = (j == x) ? c : mine; }
        if (sum == G) break;
        __builtin_amdgcn_s_sleep(1);
        if ((++sp & 255u) == 0u) { if (xb_ld(&bar[XB_TMO])) break; if (sp > XB_SPIN_CAP) { atomicAdd(&bar[XB_TMO], 1u); break; } }
    }
    nloc = mine > 0u ? mine : 1u; nx = cnt > 0u ? cnt : 1u;
}

__device__ __forceinline__ void xcd_barrier(const XcdBarrier& b) {
    asm volatile("s_waitcnt vmcnt(0)" ::: "memory");
    __syncthreads();
    if (threadIdx.x == 0) {
        unsigned* bar = b.bar;
        __builtin_amdgcn_s_waitcnt(0);
        unsigned nloc = b.st[0], nx = b.st[1];
        if (nloc == 0u) { xcd_barrier_complete(bar, b.x, nloc, nx); b.st[0] = nloc; b.st[1] = nx; }
        const unsigned old = xb_add(&bar[XB_XSUB(b.x)], 1u);
        const unsigned gen = old / nloc;
        if (old + 1u == (gen + 1u) * nloc) {
            __builtin_amdgcn_fence(__ATOMIC_RELEASE, "agent");
            asm volatile("s_waitcnt vmcnt(0)" ::: "memory");
            const unsigned og = xb_add(&bar[XB_TOP], 1u);
            const unsigned tg = og / nx;
            if (og + 1u == (tg + 1u) * nx) xb_add(&bar[XB_TOPGEN], 1u);
            else XB_SPIN(xb_ld(&bar[XB_TOPGEN]) == tg, bar);
            __builtin_amdgcn_fence(__ATOMIC_ACQUIRE, "agent");
            xb_add(&bar[XB_XGEN(b.x)], 1u);
            asm volatile("s_waitcnt vmcnt(0)" ::: "memory");
        } else {
            XB_SPIN(xb_ld(&bar[XB_XGEN(b.x)]) == gen, bar);
            __builtin_amdgcn_fence(__ATOMIC_ACQUIRE, "agent");
            asm volatile("s_waitcnt vmcnt(0)" ::: "memory");
        }
    }
    __syncthreads();
}

typedef unsigned u32x2 __attribute__((ext_vector_type(2)));
typedef float f32x16 __attribute__((ext_vector_type(16)));
typedef short s16x4 __attribute__((ext_vector_type(4)));
using pg8::cvt_pk_bf16;
__device__ __forceinline__ v4u pack8(f32x4 a, f32x4 b) { v4u w; w.x = cvt_pk_bf16(a[0], a[1]); w.y = cvt_pk_bf16(a[2], a[3]); w.z = cvt_pk_bf16(b[0], b[1]); w.w = cvt_pk_bf16(b[2], b[3]); return w; }
__device__ __forceinline__ u32x2 pack4(f32x4 a) { u32x2 w; w.x = cvt_pk_bf16(a[0], a[1]); w.y = cvt_pk_bf16(a[2], a[3]); return w; }
__device__ __forceinline__ float bflo(unsigned u) { return __uint_as_float(u << 16); }
__device__ __forceinline__ float bfhi(unsigned u) { return __uint_as_float(u & 0xffff0000u); }
__device__ __forceinline__ void unpack8(v4u w, f32x4& a, f32x4& b) { a = (f32x4){bflo(w.x), bfhi(w.x), bflo(w.y), bfhi(w.y)}; b = (f32x4){bflo(w.z), bfhi(w.z), bflo(w.w), bfhi(w.w)}; }
typedef _Float16 f16x2 __attribute__((ext_vector_type(2)));
using pg8::f16x8;
__device__ __forceinline__ unsigned pkh(float a, float b) { const f16x2 v = {(_Float16)a, (_Float16)b}; return __builtin_bit_cast(unsigned, v); }
__device__ __forceinline__ v4u pack8h(f32x4 a, f32x4 b) { v4u w; w.x = pkh(a[0], a[1]); w.y = pkh(a[2], a[3]); w.z = pkh(b[0], b[1]); w.w = pkh(b[2], b[3]); return w; }
__device__ __forceinline__ void unpack8h(v4u w, f32x4& a, f32x4& b) { const f16x8 h = __builtin_bit_cast(f16x8, w); a = (f32x4){(float)h[0], (float)h[1], (float)h[2], (float)h[3]}; b = (f32x4){(float)h[4], (float)h[5], (float)h[6], (float)h[7]}; }
__device__ __forceinline__ unsigned pkf8(float a, float b, float c, float d) { int w = 0; w = __builtin_amdgcn_cvt_pk_fp8_f32(a, b, w, false); w = __builtin_amdgcn_cvt_pk_fp8_f32(c, d, w, true); return (unsigned)w; }
__device__ __forceinline__ float sigmoidf_(float x) { return __builtin_amdgcn_rcpf(1.0f + __builtin_amdgcn_exp2f(-LOG2E * x)); }
__device__ __forceinline__ f32x4 sigmoid4(f32x4 x) { return (f32x4){sigmoidf_(x[0]), sigmoidf_(x[1]), sigmoidf_(x[2]), sigmoidf_(x[3])}; }
__device__ __forceinline__ float sum_x16(float v) { auto r = __builtin_amdgcn_permlane16_swap(__float_as_uint(v), __float_as_uint(v), false, false); return __uint_as_float(r[0]) + __uint_as_float(r[1]); }
__device__ __forceinline__ float sum_x32(float v) { auto r = __builtin_amdgcn_permlane32_swap(__float_as_uint(v), __float_as_uint(v), false, false); return __uint_as_float(r[0]) + __uint_as_float(r[1]); }
__device__ __forceinline__ float max_x16(float v) { auto r = __builtin_amdgcn_permlane16_swap(__float_as_uint(v), __float_as_uint(v), false, false); return fmaxf(__uint_as_float(r[0]), __uint_as_float(r[1])); }
__device__ __forceinline__ float max_x32(float v) { auto r = __builtin_amdgcn_permlane32_swap(__float_as_uint(v), __float_as_uint(v), false, false); return fmaxf(__uint_as_float(r[0]), __uint_as_float(r[1])); }
template <int CTRL> __device__ __forceinline__ float dppf(float v) { return __int_as_float(__builtin_amdgcn_update_dpp(0, __float_as_int(v), CTRL, 0xf, 0xf, false)); }
__device__ __forceinline__ float wave_sum(float v) {
    v += dppf<0xB1>(v); v += dppf<0x4E>(v); v += dppf<0x141>(v); v += dppf<0x140>(v);
    return sum_x32(sum_x16(v));
}
__device__ __forceinline__ int rope_perm(int pc) { const int g = pc >> 3, e = pc & 7; return e < 4 ? 4 * g + e : 32 + 4 * g + (e - 4); }
template <int MAP> __device__ __forceinline__ int srcmap(int n) {
    if (MAP == 0) return n;
    if (MAP == 1) {
        if (n < 2048) return U_QA + n;
        if (n < 3072) return U_QI + (n - 2048);
        if (n < 3200) return U_KA + (n - 3072);
        if (n < 3328) return U_VA + (n - 3200);
        if (n < 3584) { const int o = n - 3328; if (o < 64) return U_KI + o; if (o < 128) return U_KPE + rope_perm(o - 64); if (o < 144) return U_WI + (o - 128); return -1; }
        if (n < 4096) return U_CQ + (n - 3584);
        if (n < 4608) return U_CKV + (n - 4096);
        return U_G + (n - 4608);
    }
    if (MAP == 2) {
        if (n < 2048) return (n >> 7) * 192 + (n & 127);
        const int o = n - 2048; return (o >> 6) * 192 + 128 + rope_perm(o & 63);
    }
    { const int pn = n >> 8, o = n & 255; return o < 128 ? pn * 128 + o : DFF + pn * 128 + (o - 128); }
}
constexpr int TR_LDS = 64 * 68 * 4;
__device__ __forceinline__ void tr_item(const float* W, int ldw, const float* gk, bf16* WT, int K, int k0, int drow0, int srccol4, LAS float* scr, int lane, bool h16) {
    const int c4 = (lane & 15) * 4;
#pragma unroll 8
    for (int i = 0; i < 16; ++i) { const int kk = 4 * i + (lane >> 4); f32x4 v = (f32x4){0.f, 0.f, 0.f, 0.f};
        if (srccol4 >= 0) { v = *(const GAS f32x4*)(W + (size_t)(k0 + kk) * ldw + srccol4); if (gk) v = v * gk[k0 + kk]; }
        *(LAS f32x4*)(scr + kk * 68 + c4) = v; }
    LDS_WAIT(); asm volatile("" ::: "memory");
    bf16* orow = WT + (size_t)(drow0 + lane) * K + k0;
#pragma unroll
    for (int k8 = 0; k8 < 8; ++k8) { const LAS float* s = scr + (8 * k8) * 68 + lane;
        v4u o; if (h16) { o.x = pkh(s[0 * 68], s[1 * 68]); o.y = pkh(s[2 * 68], s[3 * 68]); o.z = pkh(s[4 * 68], s[5 * 68]); o.w = pkh(s[6 * 68], s[7 * 68]); }
        else { o.x = pk2(s[0 * 68], s[1 * 68]); o.y = pk2(s[2 * 68], s[3 * 68]); o.z = pk2(s[4 * 68], s[5 * 68]); o.w = pk2(s[6 * 68], s[7 * 68]); }
        *(GAS v4u*)(orow + 8 * k8) = o; }
    LDS_WAIT(); asm volatile("" ::: "memory");
}
struct TrIn { const float *w_in, *gq, *gkv, *w_uq, *w_uk, *w_uv, *w_a, *w_b, *w_o, *w_up, *w_dn, *w_pg, *w_pe; };
struct TrItem { const float* W; const float* gk; bf16* WT; int ldw, K, k0, drow0, srccol4, mode; float wmul; };
constexpr int TR_E0 = 32 * 72, TR_E1 = TR_E0 + 8 * 48, TR_E2 = TR_E1 + 8 * 32, TR_E3 = TR_E2 + 8 * 32, TR_E4 = TR_E3 + 4 * 32, TR_E5 = TR_E4 + 1024, TR_E6 = TR_E5 + 1024, TR_E7 = TR_E6 + 1024, TR_E8 = TR_E7 + 1024,
              TR_E9 = TR_E8 + 32 * 176, TR_E10 = TR_E9 + 88 * 32, TR_E11 = TR_E10 + 32 * 64;
__device__ __forceinline__ TrItem tr_decode(const TrIn& I, unsigned char* ws, int it, int lane) {
    TrItem t; int r, nblk, map = 0; t.gk = nullptr; t.mode = 0; t.wmul = 1.f; int rowoff = 0;
    if (it < 32 * 20) { r = it; nblk = 20; t.W = I.w_in; t.ldw = DIN; t.WT = (bf16*)(ws + WS_WIN); t.K = 2048; map = 5; t.mode = 1; }
    else if (it < TR_E0) { r = it - 32 * 20; nblk = 52; t.W = I.w_in; t.ldw = DIN; t.WT = (bf16*)(ws + WS_WIN8); t.K = 2048; map = 6; t.mode = 2; t.wmul = 64.f; }
    else if (it < TR_E1) { r = it - TR_E0; nblk = 48; t.W = I.w_uq; t.ldw = 3072; t.WT = (bf16*)(ws + WS_WUQ); t.K = 512; map = 2; t.gk = I.gq; t.mode = 2; t.wmul = 32.f; }
    else if (it < TR_E2) { r = it - TR_E1; nblk = 32; t.W = I.w_uk; t.ldw = 2048; t.WT = (bf16*)(ws + WS_WKV); t.K = 512; t.gk = I.gkv; t.mode = 2; t.wmul = 32.f; }
    else if (it < TR_E3) { r = it - TR_E2; nblk = 32; t.W = I.w_uv; t.ldw = 2048; t.WT = (bf16*)(ws + WS_WKV); t.K = 512; t.gk = I.gkv; rowoff = 2048; t.mode = 2; t.wmul = 32.f; }
    else if (it < TR_E4) { r = it - TR_E3; nblk = 32; t.W = I.w_pe; t.ldw = 2048; t.WT = (bf16*)(ws + WS_WPE); t.K = 256; }
    else if (it < TR_E5) { r = it - TR_E4; nblk = 32; t.W = I.w_a; t.ldw = 2048; t.WT = (bf16*)(ws + WS_WA); t.K = 2048; t.mode = 2; t.wmul = 64.f; }
    else if (it < TR_E6) { r = it - TR_E5; nblk = 32; t.W = I.w_b; t.ldw = 2048; t.WT = (bf16*)(ws + WS_WB); t.K = 2048; t.mode = 2; t.wmul = 64.f; }
    else if (it < TR_E7) { r = it - TR_E6; nblk = 32; t.W = I.w_o; t.ldw = 2048; t.WT = (bf16*)(ws + WS_WO); t.K = 2048; t.mode = 2; t.wmul = 64.f; }
    else if (it < TR_E8) { r = it - TR_E7; nblk = 32; t.W = I.w_pg; t.ldw = 2048; t.WT = (bf16*)(ws + WS_WPG); t.K = 2048; t.mode = 2; t.wmul = 64.f; }
    else if (it < TR_E9) { r = it - TR_E8; nblk = 176; t.W = I.w_up; t.ldw = NUP; t.WT = (bf16*)(ws + WS_WUP); t.K = 2048; map = 3; t.mode = 2; t.wmul = 64.f; }
    else if (it < TR_E10) { r = it - TR_E9; nblk = 32; t.W = I.w_dn; t.ldw = 2048; t.WT = (bf16*)(ws + WS_WDN); t.K = DFF; t.mode = 2; t.wmul = 128.f; }
    else { r = it - TR_E10; nblk = 64; t.W = I.w_in; t.ldw = DIN; t.WT = (bf16*)(ws + WS_WG); t.K = 2048; map = 4; t.mode = 2; t.wmul = 64.f; }
    const int kb = r / nblk, nb = r - kb * nblk, n0 = nb * 64, nl = n0 + 4 * (lane & 15);
    t.k0 = kb * 64; t.drow0 = rowoff + n0; t.srccol4 = map == 0 ? nl : map == 5 ? srcmap<1>(nl < 1024 ? 2048 + nl : 2304 + nl) : map == 6 ? srcmap<1>(nl < 2048 ? nl : nl < 2304 ? 1024 + nl : 1280 + nl) : map == 2 ? srcmap<2>(nl) : map == 3 ? srcmap<3>(nl) : U_G + nl;
    return t;
}
__device__ __forceinline__ void tr_load(const TrItem& t, f32x4 (&v)[16], int lane) {
#pragma unroll
    for (int i = 0; i < 16; ++i) { const int kk = 4 * i + (lane >> 4); v[i] = (f32x4){0.f, 0.f, 0.f, 0.f};
        if (t.srccol4 >= 0) { v[i] = *(const GAS f32x4*)(t.W + (size_t)(t.k0 + kk) * t.ldw + t.srccol4); if (t.gk) v[i] = v[i] * t.gk[t.k0 + kk]; } }
}
__device__ __forceinline__ void tr_all(const TrIn& I, unsigned char* ws, LAS float* scr, int gw, int NGW, int lane) {
    int it = gw; if (it >= TR_E11) return;
    TrItem cur = tr_decode(I, ws, it, lane); f32x4 v[16]; tr_load(cur, v, lane);
    for (;;) {
        const int c4 = (lane & 15) * 4;
#pragma unroll
        for (int i = 0; i < 16; ++i) *(LAS f32x4*)(scr + (4 * i + (lane >> 4)) * 68 + c4) = v[i];
        LDS_WAIT(); asm volatile("" ::: "memory");
        const int itn = it + NGW; const bool more = itn < TR_E11; TrItem nxt = cur;
        if (more) { nxt = tr_decode(I, ws, itn, lane); tr_load(nxt, v, lane); }
        if (cur.mode == 2) { unsigned char* orow = (unsigned char*)cur.WT + (size_t)(cur.drow0 + lane) * cur.K + cur.k0; const float wm = cur.wmul;
#pragma unroll
            for (int k16 = 0; k16 < 4; ++k16) { const LAS float* s = scr + (16 * k16) * 68 + lane; v4u o;
                o.x = pkf8(s[0 * 68] * wm, s[1 * 68] * wm, s[2 * 68] * wm, s[3 * 68] * wm); o.y = pkf8(s[4 * 68] * wm, s[5 * 68] * wm, s[6 * 68] * wm, s[7 * 68] * wm);
                o.z = pkf8(s[8 * 68] * wm, s[9 * 68] * wm, s[10 * 68] * wm, s[11 * 68] * wm); o.w = pkf8(s[12 * 68] * wm, s[13 * 68] * wm, s[14 * 68] * wm, s[15 * 68] * wm);
                *(GAS v4u*)(orow + 16 * k16) = o; } }
        else { bf16* orow = cur.WT + (size_t)(cur.drow0 + lane) * cur.K + cur.k0;
#pragma unroll
        for (int k8 = 0; k8 < 8; ++k8) { const LAS float* s = scr + (8 * k8) * 68 + lane;
            v4u o; if (cur.mode == 1) { o.x = pkh(s[0 * 68], s[1 * 68]); o.y = pkh(s[2 * 68], s[3 * 68]); o.z = pkh(s[4 * 68], s[5 * 68]); o.w = pkh(s[6 * 68], s[7 * 68]); }
            else { o.x = pk2(s[0 * 68], s[1 * 68]); o.y = pk2(s[2 * 68], s[3 * 68]); o.z = pk2(s[4 * 68], s[5 * 68]); o.w = pk2(s[6 * 68], s[7 * 68]); }
            *(GAS v4u*)(orow + 8 * k8) = o; } }
        LDS_WAIT(); asm volatile("" ::: "memory");
        if (!more) break;
        cur = nxt; it = itn;
    }
}
__device__ __forceinline__ void cvt_flat_h(const float* src, bf16* dst, unsigned char* dst8, size_t n8, size_t gt, size_t NT) {
    for (size_t i = gt; i < n8; i += 4 * NT) { f32x4 a[4], b[4];
#pragma unroll
        for (int u = 0; u < 4; ++u) { a[u] = *(const GAS f32x4*)(src + (i + u * NT) * 8); b[u] = *(const GAS f32x4*)(src + (i + u * NT) * 8 + 4); }
#pragma unroll
        for (int u = 0; u < 4; ++u) { *(GAS v4u*)(dst + (i + u * NT) * 8) = pack8h(a[u], b[u]);
            u32x2 w; w.x = pkf8(a[u][0], a[u][1], a[u][2], a[u][3]); w.y = pkf8(b[u][0], b[u][1], b[u][2], b[u][3]); *(GAS u32x2*)(dst8 + (i + u * NT) * 8) = w; } }
}
__device__ __forceinline__ void cvt_flat(const float* src, bf16* dst, size_t n8, size_t gt, size_t NT) {
    for (size_t i = gt; i < n8; i += 4 * NT) { f32x4 a[4], b[4];
#pragma unroll
        for (int u = 0; u < 4; ++u) { a[u] = *(const GAS f32x4*)(src + (i + u * NT) * 8); b[u] = *(const GAS f32x4*)(src + (i + u * NT) * 8 + 4); }
#pragma unroll
        for (int u = 0; u < 4; ++u) *(GAS v4u*)(dst + (i + u * NT) * 8) = pack8(a[u], b[u]); }
}

typedef const pg8::f32x4 (&AccRef)[2][2][4][2];
using pg8::f32x2;
using pg8::Unit;
#define EPI_ROWS(ai, m) for (int ai = 0; ai < 2; ++ai) _Pragma("unroll") for (int m = 0; m < 4; ++m)

template <int PM> struct EpiU {
    static constexpr bool PERM = true, AFTER_DRAIN = false;
    bf16 *QA, *QI, *KA, *VA, *KI, *KR, *CQ, *CKV; float* WI; float* SSQ; const float* ROPE;
    __device__ __forceinline__ void operator()(AccRef acc, const Unit& u, int wr, int wc, int fr, int fq) const {
        { int t_ = threadIdx.x; asm volatile("" : "+v"(t_)); fr = t_ & 15; fq = (t_ >> 4) & 3; }
        const int pn = PM == 1 ? (u.pn < 8 ? u.pn : u.pn == 8 ? 12 : u.pn + 5) : (u.pn < 4 ? 8 + u.pn : 13), rowb = u.pm * 256 + wr * 64 + fr, cw = wc * 32 + 8 * fq;
        if (pn < 12) {
            bf16* base = pn < 8 ? QA : QI; const int ldc = pn < 8 ? 2048 : 1024, colt = (pn < 8 ? pn : pn - 8) * 256; const float sc = pn < 8 ? QA_SCALE : 1.f;
#pragma unroll
            EPI_ROWS(ai, m) { bf16* rp = base + (size_t)(rowb + ai * 128 + m * 16) * ldc + colt + cw;
#pragma unroll
                for (int bj = 0; bj < 2; ++bj) *(GAS v4u*)(rp + bj * 128) = pn < 8 ? pack8(acc[ai][bj][m][0] * sc, acc[ai][bj][m][1] * sc) : pack8h(acc[ai][bj][m][0], acc[ai][bj][m][1]); }
        } else if (pn == 12) {
#pragma unroll
            EPI_ROWS(ai, m) { const size_t row = rowb + ai * 128 + m * 16;
                *(GAS v4u*)(KA + row * 128 + cw) = pack8(acc[ai][0][m][0], acc[ai][0][m][1]);
                *(GAS v4u*)(VA + row * 128 + cw) = pack8(acc[ai][1][m][0], acc[ai][1][m][1]); }
        } else if (pn == 13) {
#pragma unroll
            EPI_ROWS(ai, m) { const size_t row = rowb + ai * 128 + m * 16; const int pos = (int)(row & (SEQ - 1));
                const f32x4 v0 = acc[ai][0][m][0], v1 = acc[ai][0][m][1];
                if (wc < 2) { *(GAS v4u*)(KI + (row & ~(size_t)31) * 64 + (2 * wc + (fq >> 1)) * 512 + ((fq & 1) * 32 + (int)(row & 31)) * 8) = pack8h(v0, v1); }
                else { const int g = 4 * (wc - 2) + fq; const f32x4 c4 = *(const GAS f32x4*)(ROPE + pos * 32 + 4 * g), s4 = *(const GAS f32x4*)(ROPE + SEQ * 32 + pos * 32 + 4 * g);
                    const f32x4 y1 = v0 * c4 - v1 * s4, y2 = v0 * s4 + v1 * c4; GAS unsigned char* kr8 = (GAS unsigned char*)KR + row * 64 + 4 * g;
                    *(GAS unsigned*)kr8 = pkf8(y1[0], y1[1], y1[2], y1[3]); *(GAS unsigned*)(kr8 + 32) = pkf8(y2[0], y2[1], y2[2], y2[3]); }
                if (wc == 0 && fq < 2) { *(GAS f32x4*)(WI + row * 16 + 8 * fq) = acc[ai][1][m][0]; *(GAS f32x4*)(WI + row * 16 + 8 * fq + 4) = acc[ai][1][m][1]; } }
        } else {
            const int t = pn - 14; bf16* base = t < 2 ? CQ : CKV; float* ssq = SSQ + (t < 2 ? (size_t)0 : (size_t)M * 8); const int colt = (t & 1) * 256;
#pragma unroll
            EPI_ROWS(ai, m) { const size_t row = rowb + ai * 128 + m * 16; float s = 0.f;
#pragma unroll
                for (int bj = 0; bj < 2; ++bj) { const f32x4 v0 = acc[ai][bj][m][0], v1 = acc[ai][bj][m][1];
                    { u32x2 w8; w8.x = pkf8(v0[0], v0[1], v0[2], v0[3]); w8.y = pkf8(v1[0], v1[1], v1[2], v1[3]); *(GAS u32x2*)((GAS unsigned char*)base + row * 512 + colt + bj * 128 + cw) = w8; }
                    s += (v0[0] * v0[0] + v0[1] * v0[1]) + (v0[2] * v0[2] + v0[3] * v0[3]) + (v1[0] * v1[0] + v1[1] * v1[1]) + (v1[2] * v1[2] + v1[3] * v1[3]); }
                s = sum_x32(sum_x16(s));
                if (fq == 0) ssq[row * 8 + (t & 1) * 4 + wc] = s; }
        }
    }
};
struct EpiQ {
    static constexpr bool PERM = true, AFTER_DRAIN = false;
    bf16 *QN, *QR; const float* SSQ; const float* ROPE;
    __device__ __forceinline__ void operator()(AccRef acc, const Unit& u, int wr, int wc, int fr, int fq) const {
        { int t_ = threadIdx.x; asm volatile("" : "+v"(t_)); fr = t_ & 15; fq = (t_ >> 4) & 3; }
        const int pn = u.pn, rowb = u.pm * 256 + wr * 64 + fr, cw = wc * 32 + 8 * fq;
#pragma unroll
        EPI_ROWS(ai, m) { const size_t row = rowb + ai * 128 + m * 16;
            const f32x4 sa = *(const GAS f32x4*)(SSQ + row * 8), sb = *(const GAS f32x4*)(SSQ + row * 8 + 4); const float r = (8.f * QB_SCALE) / sqrtf((((sa[0] + sa[1]) + (sa[2] + sa[3])) + ((sb[0] + sb[1]) + (sb[2] + sb[3]))) * (1.f / 512.f) + RMS_EPS);
            if (pn < 8) {
#pragma unroll
                for (int bj = 0; bj < 2; ++bj) { const f32x4 v0 = acc[ai][bj][m][0] * r, v1 = acc[ai][bj][m][1] * r; u32x2 w; w.x = pkf8(v0[0], v0[1], v0[2], v0[3]); w.y = pkf8(v1[0], v1[1], v1[2], v1[3]);
                    *(GAS u32x2*)((GAS unsigned char*)QN + row * 2048 + pn * 256 + bj * 128 + cw) = w; }
            } else { const int pos = (int)(row & (SEQ - 1)), g = 4 * (wc & 1) + fq;
                const f32x4 c4 = *(const GAS f32x4*)(ROPE + pos * 32 + 4 * g) * r, s4 = *(const GAS f32x4*)(ROPE + SEQ * 32 + pos * 32 + 4 * g) * r;
#pragma unroll
                for (int bj = 0; bj < 2; ++bj) { const int head = (pn - 8) * 4 + bj * 2 + (wc >> 1); const f32x4 v0 = acc[ai][bj][m][0], v1 = acc[ai][bj][m][1];
                    const f32x4 y1 = v0 * c4 - v1 * s4, y2 = v0 * s4 + v1 * c4; GAS unsigned char* q8 = (GAS unsigned char*)QR + row * 1024 + head * 64 + 4 * g;
                    *(GAS unsigned*)q8 = pkf8(y1[0], y1[1], y1[2], y1[3]); *(GAS unsigned*)(q8 + 32) = pkf8(y2[0], y2[1], y2[2], y2[3]); } } }
    }
};
struct EpiKV {
    static constexpr bool PERM = true, AFTER_DRAIN = false;
    bf16 *KN, *VB; const float* SSQ;
    __device__ __forceinline__ void operator()(AccRef acc, const Unit& u, int wr, int wc, int fr, int fq) const {
        { int t_ = threadIdx.x; asm volatile("" : "+v"(t_)); fr = t_ & 15; fq = (t_ >> 4) & 3; }
        const int pn = u.pn, rowb = u.pm * 256 + wr * 64 + fr, cw = wc * 32 + 8 * fq; bf16* base = pn < 8 ? KN : VB; const int colt = (pn & 7) * 256;
#pragma unroll
        EPI_ROWS(ai, m) { const size_t row = rowb + ai * 128 + m * 16; const f32x4 sa = *(const GAS f32x4*)(SSQ + row * 8), sb = *(const GAS f32x4*)(SSQ + row * 8 + 4); const float r = 1.0f / sqrtf((((sa[0] + sa[1]) + (sa[2] + sa[3])) + ((sb[0] + sb[1]) + (sb[2] + sb[3]))) * (1.f / 512.f) + RMS_EPS);
#pragma unroll
            for (int bj = 0; bj < 2; ++bj) { const f32x4 v0 = acc[ai][bj][m][0] * r, v1 = acc[ai][bj][m][1] * r;
                if (pn < 8) { u32x2 w; w.x = pkf8(v0[0], v0[1], v0[2], v0[3]); w.y = pkf8(v1[0], v1[1], v1[2], v1[3]); *(GAS u32x2*)((GAS unsigned char*)KN + row * 2048 + colt + bj * 128 + cw) = w; }
                else *(GAS v4u*)(VB + row * 2048 + colt + bj * 128 + cw) = pack8(v0, v1); } }
    }
};
__device__ __forceinline__ void unpack8f8(const u32x2 w, f32x4& a, f32x4& b) {
    const f32x2 a0 = __builtin_amdgcn_cvt_pk_f32_fp8((int)w.x, false), a1 = __builtin_amdgcn_cvt_pk_f32_fp8((int)w.x, true), b0 = __builtin_amdgcn_cvt_pk_f32_fp8((int)w.y, false), b1 = __builtin_amdgcn_cvt_pk_f32_fp8((int)w.y, true);
    a = (f32x4){a0[0], a0[1], a1[0], a1[1]}; b = (f32x4){b0[0], b0[1], b1[0], b1[1]};
}
__device__ __forceinline__ u32x2 pack8f8(const f32x4 a, const f32x4 b) { u32x2 w; w.x = pkf8(a[0], a[1], a[2], a[3]); w.y = pkf8(b[0], b[1], b[2], b[3]); return w; }
template <int MODE> struct EpiB {
    static constexpr bool PERM = true, AFTER_DRAIN = false;
    bf16* O; int ldc; const bf16* gp; const float* bias; unsigned char* O8;
    __device__ __forceinline__ void operator()(AccRef acc, const Unit& u, int wr, int wc, int fr, int fq) const {
        { int t_ = threadIdx.x; asm volatile("" : "+v"(t_)); fr = t_ & 15; fq = (t_ >> 4) & 3; }
        const int rowb = u.pm * 256 + wr * 64 + fr, colb = u.pn * 256 + wc * 32 + 8 * fq;
#pragma unroll
        EPI_ROWS(ai, m) { const size_t row = rowb + ai * 128 + m * 16;
#pragma unroll
            for (int bj = 0; bj < 2; ++bj) { const int col = colb + bj * 128; f32x4 v0 = acc[ai][bj][m][0], v1 = acc[ai][bj][m][1]; GAS unsigned char* op = (GAS unsigned char*)O + row * ldc + col;
                if (MODE == 1) { v0 = sigmoid4(v0); v1 = sigmoid4(v1); }
                if (MODE == 2 || MODE == 5) { f32x4 g0, g1; unpack8f8(*(const GAS u32x2*)((const GAS unsigned char*)gp + row * 4096 + col), g0, g1); v0 = v0 * g0; v1 = v1 * g1; }
                if (MODE == 5) { f32x4 o0, o1; unpack8f8(*(const GAS u32x2*)op, o0, o1); v0 = v0 + o0; v1 = v1 + o1; }
                if (MODE == 4) { f32x4 o0, o1; unpack8f8(*(const GAS u32x2*)op, o0, o1); const f32x4 b0 = *(const GAS f32x4*)(bias + col), b1 = *(const GAS f32x4*)(bias + col + 4);
                    v0 = sigmoid4(v0 + b0) * o0; v1 = sigmoid4(v1 + b1) * o1; }
                if (MODE == 5) *(GAS u32x2*)(O8 + row * ldc + col) = pack8f8(v0, v1);
                else *(GAS u32x2*)op = pack8f8(v0, v1); }
            if (MODE >= 2) asm volatile("" ::: "memory"); }
    }
};
template <int MODE> struct EpiF {
    static constexpr bool PERM = true, AFTER_DRAIN = false;
    bf16* zb; const float* xin; const bf16* ple;
    __device__ __forceinline__ void operator()(AccRef acc, const Unit& u, int wr, int wc, int fr, int fq) const {
        { int t_ = threadIdx.x; asm volatile("" : "+v"(t_)); fr = t_ & 15; fq = (t_ >> 4) & 3; }
        const int rowb = u.pm * 256 + wr * 64 + fr, colb = u.pn * 256 + wc * 32 + 8 * fq;
#pragma unroll
        EPI_ROWS(ai, m) { const size_t row = rowb + ai * 128 + m * 16;
#pragma unroll
            for (int bj = 0; bj < 2; ++bj) { const size_t off = row * 2048 + colb + bj * 128; f32x4 v0 = acc[ai][bj][m][0], v1 = acc[ai][bj][m][1]; f32x4 x0, x1;
                if (MODE == 0) { x0 = *(const GAS f32x4*)(xin + off); x1 = *(const GAS f32x4*)(xin + off + 4); } else unpack8(*(const GAS v4u*)(zb + off), x0, x1);
                v0 = v0 + x0 * ALPHA; v1 = v1 + x1 * ALPHA;
                if (MODE == 1) { f32x4 p0, p1; unpack8f8(*(const GAS u32x2*)((const GAS unsigned char*)ple + off), p0, p1); v0 = v0 + p0; v1 = v1 + p1; }
                *(GAS v4u*)(zb + off) = pack8(v0, v1); }
            asm volatile("" ::: "memory"); }
    }
};
template <int CTRL> __device__ __forceinline__ f32x4 dpp4(f32x4 v) { return (f32x4){dppf<CTRL>(v[0]), dppf<CTRL>(v[1]), dppf<CTRL>(v[2]), dppf<CTRL>(v[3])}; }
__device__ __forceinline__ f32x4 sel4(bool c, f32x4 a, f32x4 b) { return (f32x4){c ? a[0] : b[0], c ? a[1] : b[1], c ? a[2] : b[2], c ? a[3] : b[3]}; }
struct EpiUp {
    static constexpr bool PERM = true, AFTER_DRAIN = false;
    unsigned char* ACT; float* HEADB; float* TAILB; const float* cw; const float* cb;
    __device__ __forceinline__ void operator()(AccRef acc, const Unit& u, int wr, int wc, int fr, int fq) const {
        { int t_ = threadIdx.x; asm volatile("" : "+v"(t_)); fr = t_ & 15; fq = (t_ >> 4) & 3; }
        const unsigned ch0 = (unsigned)(u.pn * 128 + wc * 32 + 8 * fq), cp0 = (unsigned)(u.pn * 256 + wc * 32 + 8 * fq);
        const GAS unsigned char* cwb = (const GAS unsigned char*)cw; const GAS unsigned char* cbb = (const GAS unsigned char*)cb; GAS unsigned char* actb = (GAS unsigned char*)ACT;
#pragma unroll
        for (int ai = 0; ai < 2; ++ai) {
            const unsigned g = (unsigned)(u.pm * 4 + ai * 2 + wr), row0 = g * 64u + (unsigned)fr;
            if (fr < 2) { GAS unsigned char* hp = (GAS unsigned char*)HEADB + ((g * 2u + (unsigned)fr) * (unsigned)NUP + cp0) * 4u;
#pragma unroll
                for (int bj = 0; bj < 2; ++bj)
#pragma unroll
                    for (int n = 0; n < 2; ++n) *(GAS f32x4*)(hp + (bj * 128 + 4 * n) * 4) = acc[ai][bj][0][n]; }
            if (fr >= 14) { GAS unsigned char* hp = (GAS unsigned char*)TAILB + ((g * 2u + (unsigned)(fr - 14)) * (unsigned)NUP + cp0) * 4u;
#pragma unroll
                for (int bj = 0; bj < 2; ++bj)
#pragma unroll
                    for (int n = 0; n < 2; ++n) *(GAS f32x4*)(hp + (bj * 128 + 4 * n) * 4) = acc[ai][bj][3][n]; }
            asm volatile("" ::: "memory"); __builtin_amdgcn_sched_barrier(0);
#pragma unroll
            for (int n = 0; n < 2; ++n) {
                unsigned pk[4];
#pragma unroll
                for (int hf = 0; hf < 2; ++hf) {
                    asm volatile("" ::: "memory"); __builtin_amdgcn_sched_barrier(0);
                    f32x2 yg[4];
#pragma unroll
                    for (int bj = 0; bj < 2; ++bj) { const unsigned cB = (ch0 + (unsigned)(4 * n + 2 * hf + bj * DFF)) * 4u;
                        const f32x2 w0 = *(const GAS f32x2*)(cwb + cB), w1 = *(const GAS f32x2*)(cwb + (cB + (unsigned)NUP * 4u)), w2 = *(const GAS f32x2*)(cwb + (cB + (unsigned)NUP * 8u)), bb = *(const GAS f32x2*)(cbb + cB);
                        f32x2 pr1 = (f32x2){0.f, 0.f}, pr2 = pr1;
#pragma unroll
                        for (int m = 0; m < 4; ++m) { const f32x4 v4 = acc[ai][bj][m][n]; const f32x2 v = hf ? (f32x2){v4[2], v4[3]} : (f32x2){v4[0], v4[1]};
                            const f32x2 r1 = (f32x2){dppf<0x121>(v[0]), dppf<0x121>(v[1])}, r2 = (f32x2){dppf<0x122>(v[0]), dppf<0x122>(v[1])};
                            const f32x2 p1 = fr >= 1 ? r1 : pr1, p2 = fr >= 2 ? r2 : pr2;
                            const f32x2 y = bb + w2 * v + w1 * p1 + w0 * p2; pr1 = r1; pr2 = r2;
                            if (bj == 0) yg[m] = y;
                            else { const f32x2 sg = (f32x2){sigmoidf_(yg[m][0]), sigmoidf_(yg[m][1])}; const f32x2 a = yg[m] * sg * y;
                                if (hf == 0) pk[m] = (unsigned)__builtin_amdgcn_cvt_pk_fp8_f32(a[0], a[1], 0, false);
                                else { const unsigned w = (unsigned)__builtin_amdgcn_cvt_pk_fp8_f32(a[0], a[1], (int)pk[m], true); if (!(m == 0 && fr < 2)) *(GAS unsigned*)(actb + ((row0 + (unsigned)(m * 16)) * (unsigned)DFF + ch0 + (unsigned)(4 * n))) = w; } } }
                        asm volatile("" ::: "memory"); __builtin_amdgcn_sched_barrier(0); }
                }
            }
        }
    }
};

namespace dsa {
constexpr int CAP = 512, TOPK = 256;
typedef unsigned long long u64;
typedef unsigned short u16;
__device__ __forceinline__ unsigned fkey(float f) { const unsigned u = __float_as_uint(f); return u ^ ((unsigned)((int)u >> 31) | 0x80000000u); }
__device__ __forceinline__ float keyf(unsigned k) { const unsigned u = (k & 0x80000000u) ? (k ^ 0x80000000u) : ~k; return __uint_as_float(u); }
__device__ __forceinline__ int mbcnt64(u64 m) { return (int)__builtin_amdgcn_mbcnt_hi((unsigned)(m >> 32), __builtin_amdgcn_mbcnt_lo((unsigned)m, 0u)); }

__device__ __forceinline__ unsigned wave_umax(unsigned v) {
#define DSA_UDPP(c_) (unsigned)__builtin_amdgcn_update_dpp(0, (int)v, c_, 0xf, 0xf, false)
    v = max(v, DSA_UDPP(0xB1)); v = max(v, DSA_UDPP(0x4E)); v = max(v, DSA_UDPP(0x141)); v = max(v, DSA_UDPP(0x140));
#undef DSA_UDPP
    { auto r = __builtin_amdgcn_permlane16_swap(v, v, false, false); v = max(r[0], r[1]); }
    { auto r = __builtin_amdgcn_permlane32_swap(v, v, false, false); v = max(r[0], r[1]); }
    return v;
}
__device__ __forceinline__ unsigned compact(LAS u64* buf, int n, int lane, unsigned lowk, bool exact, int& nout) {
    unsigned key[8], idx[8];
#pragma unroll
    for (int e = 0; e < 8; ++e) { const int i = lane + 64 * e; u64 v = 0ull; if (i < n) v = buf[i]; key[e] = (unsigned)(v >> 32); idx[e] = (unsigned)v; }
    unsigned mx = key[0];
#pragma unroll
    for (int e = 1; e < 8; ++e) mx = max(mx, key[e]);
    mx = (unsigned)__builtin_amdgcn_readfirstlane((int)wave_umax(mx));
    const unsigned diff = lowk ^ mx; unsigned P = lowk;
    if (diff) { const int hb = 31 - __builtin_clz(diff); P = hb == 31 ? 0u : (lowk >> (hb + 1)) << (hb + 1); const int lob = exact ? 0 : (hb > 15 ? hb - 15 : 0);
#pragma unroll 1
        for (int b = hb; b >= lob; --b) { const unsigned cand = P | (1u << b); int c = 0;
#pragma unroll
            for (int e = 0; e < 8; ++e) c += __builtin_popcountll(__ballot(key[e] >= cand));
            if (c >= TOPK) { P = cand; if (c == TOPK || (!exact && c <= TOPK + 48)) break; } } }
    int cgt = 0;
#pragma unroll
    for (int e = 0; e < 8; ++e) cgt += __builtin_popcountll(__ballot(key[e] > P));
    const int need = exact ? TOPK - cgt : CAP; int base = 0, eqbase = 0;
#pragma unroll
    for (int e = 0; e < 8; ++e) { const bool gt = key[e] > P, eq = key[e] == P && key[e] != 0u; const u64 beq = __ballot(eq); const bool sel = gt || (eq && (eqbase + mbcnt64(beq)) < need);
        const u64 bs = __ballot(sel); const int pos = base + mbcnt64(bs);
        if (sel) buf[pos] = ((u64)key[e] << 32) | idx[e];
        base += __builtin_popcountll(bs); eqbase += __builtin_popcountll(beq); }
    asm volatile("s_waitcnt lgkmcnt(0)" ::: "memory");
    nout = base;
    return P;
}

struct Ptrs { const bf16 *QI, *KI, *KA, *VA; const float* WI; const bf16* QA; bf16* O; unsigned short* SEL; };

__device__ __forceinline__ void attend(const Ptrs& P, int b, int t, const LAS u16* idl, LAS unsigned char* vbuf, int lane) {
    const int head = lane & 15, g = lane >> 4; const size_t m = (size_t)b * SEQ + t;
    bf16x8 Bq[4];
#pragma unroll
    for (int ks = 0; ks < 4; ++ks) Bq[ks] = *(const GAS bf16x8*)(P.QA + m * 2048 + head * 128 + 32 * ks + 8 * g);
    const float slope2 = __builtin_amdgcn_exp2f(-0.5f * (float)(head + 1)) * LOG2E;
    const bf16* vab = P.VA + (size_t)b * SEQ * 128;
    v4u st[8];
#define DSA_VLOAD(kk) do { _Pragma("unroll") for (int u_ = 0; u_ < 8; ++u_) { const int row_ = 4 * u_ + g; unsigned s_ = idl[32 * (kk) + row_]; s_ = s_ == 0xFFFFu ? 0u : s_; \
        const int cl_ = (lane & 15) ^ ((row_ & 7) << 1); st[u_] = *(const GAS v4u*)(vab + (size_t)s_ * 128 + cl_ * 8); } } while (0)
#define DSA_VWRITE(kk) do { _Pragma("unroll") for (int u_ = 0; u_ < 8; ++u_) *(LAS v4u*)(vbuf + ((kk) & 1) * 8192 + u_ * 1024 + lane * 16) = st[u_]; } while (0)
    DSA_VLOAD(0);
    const bf16* kab = P.KA + (size_t)b * SEQ * 128 + 8 * g;
    f32x4 L[16];
    bf16x8 Af[16][4];
#define DSA_KLD(i_) do { unsigned s_ = idl[16 * (i_) + head]; s_ = s_ == 0xFFFFu ? 0u : s_; const bf16* kp_ = kab + (size_t)s_ * 128; \
        _Pragma("unroll") for (int ks = 0; ks < 4; ++ks) Af[i_][ks] = *(const GAS bf16x8*)(kp_ + 32 * ks); } while (0)
    DSA_KLD(0); __builtin_amdgcn_sched_barrier(0); DSA_KLD(1); __builtin_amdgcn_sched_barrier(0); DSA_KLD(2); __builtin_amdgcn_sched_barrier(0);
#pragma unroll
    for (int i = 0; i < 16; ++i) {
        if (i + 3 < 16) { DSA_KLD(i + 3 < 16 ? i + 3 : 15); } __builtin_amdgcn_sched_barrier(0);
        f32x4 C = (f32x4){0.f, 0.f, 0.f, 0.f};
#pragma unroll
        for (int ks = 0; ks < 4; ++ks) C = __builtin_amdgcn_mfma_f32_16x16x32_bf16(Af[i][ks], Bq[ks], C, 0, 0, 0);
        const u32x2 idw = *(const LAS u32x2*)(idl + 16 * i + 4 * g);
        const unsigned i0 = idw.x & 0xffffu, i1 = idw.x >> 16, i2 = idw.y & 0xffffu, i3 = idw.y >> 16;
        L[i][0] = i0 == 0xFFFFu ? -__builtin_inff() : C[0] - slope2 * (float)(t - (int)i0);
        L[i][1] = i1 == 0xFFFFu ? -__builtin_inff() : C[1] - slope2 * (float)(t - (int)i1);
        L[i][2] = i2 == 0xFFFFu ? -__builtin_inff() : C[2] - slope2 * (float)(t - (int)i2);
        L[i][3] = i3 == 0xFFFFu ? -__builtin_inff() : C[3] - slope2 * (float)(t - (int)i3);
        __builtin_amdgcn_sched_barrier(0);
    }
#undef DSA_KLD
    float mx = -__builtin_inff();
#pragma unroll
    for (int i = 0; i < 16; ++i) mx = fmaxf(fmaxf(mx, fmaxf(L[i][0], L[i][1])), fmaxf(L[i][2], L[i][3]));
    mx = max_x32(max_x16(mx));
    float sum = 0.f;
#pragma unroll
    for (int i = 0; i < 16; ++i) {
#pragma unroll
        for (int r = 0; r < 4; ++r) { const float p = __builtin_amdgcn_exp2f(L[i][r] - mx); L[i][r] = p; sum += p; } }
    sum = sum_x32(sum_x16(sum));
    f32x4 O[8];
#pragma unroll
    for (int dt = 0; dt < 8; ++dt) O[dt] = (f32x4){0.f, 0.f, 0.f, 0.f};
    DSA_VWRITE(0); DSA_VLOAD(1);
    const int q4 = (lane >> 2) & 3, p4 = lane & 3, row1 = 4 * g + q4;
#pragma unroll
    for (int kk = 0; kk < 8; ++kk) {
        const v4u pw = pack8(L[2 * kk], L[2 * kk + 1]); const bf16x8 Pf = __builtin_bit_cast(bf16x8, pw);
        const LAS unsigned char* vb = vbuf + (kk & 1) * 8192 + row1 * 256 + 8 * p4;
        s16x4 lo[8], hi2[8];
#pragma unroll
        for (int dt = 0; dt < 8; ++dt) { const LAS unsigned char* a1 = vb + ((dt ^ (row1 & 7)) << 5);
            lo[dt] = __builtin_bit_cast(s16x4, __builtin_amdgcn_ds_read_tr16_b64_v4i16((LAS s16x4*)a1));
            hi2[dt] = __builtin_bit_cast(s16x4, __builtin_amdgcn_ds_read_tr16_b64_v4i16((LAS s16x4*)(a1 + 4096))); }
#pragma unroll
        for (int dt = 0; dt < 8; ++dt) {
            const bf16x8 Av = (bf16x8){lo[dt][0], lo[dt][1], lo[dt][2], lo[dt][3], hi2[dt][0], hi2[dt][1], hi2[dt][2], hi2[dt][3]};
            O[dt] = __builtin_amdgcn_mfma_f32_16x16x32_bf16(Av, Pf, O[dt], 0, 0, 0); }
        if (kk + 1 < 8) { DSA_VWRITE(kk + 1); if (kk + 2 < 8) DSA_VLOAD(kk + 2); }
    }
#undef DSA_VLOAD
#undef DSA_VWRITE
    const float inv = 1.0f / sum;
    unsigned char* op = (unsigned char*)P.O + m * 4096 + head * 128 + 4 * g;
#pragma unroll
    for (int dt = 0; dt < 8; ++dt) { const f32x4 o = O[dt] * inv; *(GAS unsigned*)(op + 16 * dt) = pkf8(o[0], o[1], o[2], o[3]); }
}

__device__ __forceinline__ void job(const Ptrs& P, int b, int t0, LAS unsigned char* wl, LAS u16* idl, int lane, volatile LAS unsigned* dbgp = nullptr) {
#if defined(DBG_SPIN)
    unsigned long long tcomp = 0ull, tatt = 0ull; const unsigned long long tj0 = __builtin_amdgcn_s_memrealtime();
#endif
    const int r32 = lane & 31, hi = lane >> 5;
    const int qsel = (r32 >> 2) & 1, headA = (r32 & 3) + 4 * (r32 >> 3);
    bf16x8 A[2][4]; float sg[2][16];
#pragma unroll
    for (int a = 0; a < 2; ++a) {
        const size_t mA = (size_t)b * SEQ + t0 + 2 * a + qsel; const float aw = P.WI[mA * 16 + headA];
#pragma unroll
        for (int d0 = 0; d0 < 4; ++d0) { f32x4 x0, x1; unpack8h(*(const GAS v4u*)(P.QI + mA * 1024 + headA * 64 + 16 * d0 + 8 * hi), x0, x1); A[a][d0] = __builtin_bit_cast(bf16x8, pack8h(x0 * aw, x1 * aw)); }
        const size_t mC = (size_t)b * SEQ + t0 + 2 * a + hi;
#pragma unroll
        for (int r4 = 0; r4 < 4; ++r4) { const f32x4 w4 = *(const GAS f32x4*)(P.WI + mC * 16 + 4 * r4);
#pragma unroll
            for (int j = 0; j < 4; ++j) sg[a][4 * r4 + j] = w4[j] < 0.f ? -__builtin_inff() : __builtin_inff(); }
    }
    LAS u64* cand = (LAS u64*)wl;
    int c0 = 0, c1 = 0, c2 = 0, c3 = 0; unsigned l0 = 0u, l1 = 0u, l2 = 0u, l3 = 0u; float tau0 = -__builtin_inff(), tau1 = -__builtin_inff();
    const int ntile = (t0 + 3) / 32 + 1;
    const bf16* kib = P.KI + (size_t)b * SEQ * 64 + 8 * lane;
    bf16x8 B0[4], B1[4], B2[4], B3[4];
#define DSA_LDK(B_, JN_) do { const int jn_ = (JN_) < ntile ? (JN_) : ntile - 1; _Pragma("unroll") for (int d0 = 0; d0 < 4; ++d0) B_[d0] = *(const GAS bf16x8*)(kib + (size_t)jn_ * 2048 + 512 * d0); } while (0)
    DSA_LDK(B0, 0); asm volatile("" ::: "memory"); DSA_LDK(B1, 1); asm volatile("" ::: "memory"); DSA_LDK(B2, 2); asm volatile("" ::: "memory"); DSA_LDK(B3, 3); asm volatile("" ::: "memory");
#if defined(DBG_SPIN)
#define DSA_TC0 const unsigned long long tc0 = __builtin_amdgcn_s_memrealtime();
#define DSA_TC1 tcomp += __builtin_amdgcn_s_memrealtime() - tc0;
#else
#define DSA_TC0
#define DSA_TC1
#endif
#define DSA_TILE(JT_, Bf) do { const int jt = (JT_); const int s = jt * 32 + r32; \
        f32x16 C0 = {}, C1 = {}; \
        _Pragma("unroll") for (int d0 = 0; d0 < 4; ++d0) C0 = __builtin_amdgcn_mfma_f32_32x32x16_f16(__builtin_bit_cast(f16x8, A[0][d0]), __builtin_bit_cast(f16x8, Bf[d0]), C0, 0, 0, 0); \
        _Pragma("unroll") for (int d0 = 0; d0 < 4; ++d0) C1 = __builtin_amdgcn_mfma_f32_32x32x16_f16(__builtin_bit_cast(f16x8, A[1][d0]), __builtin_bit_cast(f16x8, Bf[d0]), C1, 0, 0, 0); \
        DSA_LDK(Bf, jt + 4); \
        float scv[2]; \
        _Pragma("unroll") for (int a = 0; a < 2; ++a) { float s_ = 0.f;                                                    \
            _Pragma("unroll") for (int r = 0; r < 16; ++r) { s_ += __builtin_amdgcn_fmed3f(a == 0 ? C0[r] : C1[r], 0.f, sg[a][r]); if ((r & 3) == 3) asm volatile("" : "+v"(s_)); } \
            scv[a] = s_; } \
        _Pragma("unroll") for (int a = 0; a < 2; ++a) { \
            const float sc = scv[a]; \
            const int tq = t0 + 2 * a + hi; const float tau = a == 0 ? tau0 : tau1; \
            const bool pass = (s <= tq) && (sc > tau); \
            const u64 bal = __ballot(pass); \
            if (bal) { const unsigned blo = (unsigned)bal, bhi = (unsigned)(bal >> 32); \
                const int pre = hi ? (int)__builtin_amdgcn_mbcnt_hi(bhi, 0u) : (int)__builtin_amdgcn_mbcnt_lo(blo, 0u); \
                const int cq = a == 0 ? (hi ? c1 : c0) : (hi ? c3 : c2); \
                if (pass) cand[(2 * a + hi) * CAP + cq + pre] = ((u64)fkey(sc) << 32) | (unsigned)s; \
                if (a == 0) { c0 += __builtin_popcount(blo); c1 += __builtin_popcount(bhi); } else { c2 += __builtin_popcount(blo); c3 += __builtin_popcount(bhi); } } \
        } \
        const int lim = (jt == ntile - 1) ? TOPK : CAP - 32; \
        _Pragma("unroll 1") for (;;) { \
            const int q = c0 > lim ? 0 : c1 > lim ? 1 : c2 > lim ? 2 : c3 > lim ? 3 : -1; \
            if (q < 0) break; \
            int n = q == 0 ? c0 : q == 1 ? c1 : q == 2 ? c2 : c3; unsigned lowk = q == 0 ? l0 : q == 1 ? l1 : q == 2 ? l2 : l3; \
            asm volatile("s_waitcnt lgkmcnt(0)" ::: "memory"); \
            DSA_TC0 \
            bool ex = jt == ntile - 1; int nout; unsigned T; \
            _Pragma("unroll 1") for (;;) { T = compact(cand + q * CAP, n, lane, lowk, ex, nout); if (ex || nout <= lim) break; ex = true; n = nout; lowk = T; } \
            const float tf = keyf(T); \
            DSA_TC1 \
            if (q == 0) { c0 = nout; l0 = T; } else if (q == 1) { c1 = nout; l1 = T; } else if (q == 2) { c2 = nout; l2 = T; } else { c3 = nout; l3 = T; } \
            if ((q >> 1) == 0) { if (hi == (q & 1)) tau0 = tf; } else { if (hi == (q & 1)) tau1 = tf; } \
        } } while (0)
#pragma unroll 1
    for (int jt0 = 0; jt0 < ntile; jt0 += 4) { DSA_TILE(jt0, B0); DSA_TILE(jt0 + 1, B1); DSA_TILE(jt0 + 2, B2); DSA_TILE(jt0 + 3, B3); }
#undef DSA_TILE
#undef DSA_LDK
#undef DSA_TC0
#undef DSA_TC1
    asm volatile("s_waitcnt lgkmcnt(0)" ::: "memory");
#pragma unroll
    for (int q = 0; q < 4; ++q) { const int n = q == 0 ? c0 : q == 1 ? c1 : q == 2 ? c2 : c3;
#pragma unroll
        for (int e = 0; e < 4; ++e) { const int i = lane + 64 * e; unsigned v = 0xFFFFu; if (i < n) v = (unsigned)cand[q * CAP + i] & 0xFFFFu;
#if defined(DBG_FIXED_SEL)
            v = (t0 + q - i) >= 0 ? (unsigned)(t0 + q - i) : 0xFFFFu;
#endif
            idl[q * TOPK + i] = (u16)v; if (P.SEL) P.SEL[((size_t)b * SEQ + t0 + q) * TOPK + i] = (u16)v; } }
    asm volatile("s_waitcnt lgkmcnt(0)" ::: "memory");
#if defined(DBG_SPIN)
    const unsigned long long ta0 = __builtin_amdgcn_s_memrealtime();
#endif
#pragma unroll 1
    for (int q = 0; q < 4; ++q) attend(P, b, t0 + q, idl + q * TOPK, wl, lane);
#if defined(DBG_SPIN)
    tatt = __builtin_amdgcn_s_memrealtime() - ta0;
    if (dbgp && lane == 0) { dbgp[0] += (unsigned)tcomp; dbgp[1] += (unsigned)tatt; dbgp[2] += (unsigned)(__builtin_amdgcn_s_memrealtime() - tj0); }
#endif
}
}

namespace mla {
constexpr int NW = 8, QBLK = 32, KVBLK = 64, QB = 256;
constexpr int SHM_V = 16384, SHM_K = 8192, SHM_R = 4096;
constexpr int OFF_V = 0, OFF_K = 3 * SHM_V, OFF_R = OFF_K + 4 * SHM_K, OFF_WS = OFF_R + 4 * SHM_R, LDS_NEED = OFF_WS + NW * 64 * 4;
constexpr float THR = 8.f;
#define MLA_KSWZ(row, colB) ((row) * 256 + ((colB) ^ (((row) & 7) << 4)))
#define MLA_RSWZ(row, colB) ((row) * 128 + ((colB) ^ ((((row) >> 1) & 7) << 4)))
#define MLA_SBAR() __builtin_amdgcn_sched_barrier(0)
__device__ __forceinline__ int v_st(int k, int c) { const int kk = (k & ~0xC) | ((k & 4) << 1) | ((k & 8) >> 1); return ((kk >> 3) * 4 + (c >> 5)) * 512 + ((kk & 7) * 32 + (c & 31)) * 2; }
__device__ __forceinline__ int v_rd_base(int lane) { return ((lane & 3) << 3) | (((lane >> 2) & 3) << 6) | (((lane >> 4) & 1) << 5) | (((lane >> 5) & 1) << 8); }
constexpr int v_rd_off(int d0, int ks, int half) { return d0 * 512 + ks * 4096 + half * 2048; }
__device__ __forceinline__ int crow(int r, int hi) { return (r & 3) + 8 * (r >> 2) + 4 * hi; }
__device__ __forceinline__ unsigned cvtpk(float lo, float hi) { return pg8::cvt_pk_bf16(lo, hi); }

__device__ __forceinline__ void mask_tile(f32x16& p0, f32x16& p1, int dq) {
    const float NEG = -__builtin_inff();
#pragma unroll
    for (int r = 0; r < 16; ++r) { const int c = (r & 3) + 8 * (r >> 2);
        if (dq - c < 0) p0[r] = NEG;
        if (dq - c - 32 < 0) p1[r] = NEG; }
}
__device__ __forceinline__ void softmax_tile(f32x16& p0, f32x16& p1, float& m_reg, float& l_reg, float& alpha, bf16x8& pa0, bf16x8& pa1, bf16x8& pa2, bf16x8& pa3) {
    float pmax = p0[0];
#pragma unroll
    for (int r = 1; r < 16; ++r) pmax = fmaxf(pmax, p0[r]);
#pragma unroll
    for (int r = 0; r < 16; ++r) pmax = fmaxf(pmax, p1[r]);
    { auto rr = __builtin_amdgcn_permlane32_swap(__float_as_uint(pmax), __float_as_uint(pmax), false, false); pmax = fmaxf(__uint_as_float(rr[0]), __uint_as_float(rr[1])); }
    float mn;
    if (__builtin_expect(__all((pmax - m_reg) <= THR), 1)) { mn = m_reg; alpha = 1.f; }
    else { mn = fmaxf(m_reg, pmax); alpha = __builtin_amdgcn_exp2f(m_reg - mn); m_reg = mn; }
#pragma unroll
    for (int r = 0; r < 16; ++r) { p0[r] = __builtin_amdgcn_exp2f(p0[r] - mn); p1[r] = __builtin_amdgcn_exp2f(p1[r] - mn); }
    float ps = 0.f;
#pragma unroll
    for (int r = 0; r < 16; ++r) ps += p0[r];
#pragma unroll
    for (int r = 0; r < 16; ++r) ps += p1[r];
    { auto rr = __builtin_amdgcn_permlane32_swap(__float_as_uint(ps), __float_as_uint(ps), false, false); ps = __uint_as_float(rr[0]) + __uint_as_float(rr[1]); }
    l_reg = l_reg * alpha + ps;
#define MLA_PK4(P, B_, OUT) do { unsigned a0 = cvtpk(P[B_ + 0], P[B_ + 1]), a1 = cvtpk(P[B_ + 2], P[B_ + 3]); unsigned b0 = cvtpk(P[B_ + 4], P[B_ + 5]), b1 = cvtpk(P[B_ + 6], P[B_ + 7]); \
        auto r0 = __builtin_amdgcn_permlane32_swap(a0, b0, false, false); auto r1 = __builtin_amdgcn_permlane32_swap(a1, b1, false, false); \
        v4u w = {r0[0], r1[0], r0[1], r1[1]}; OUT = __builtin_bit_cast(bf16x8, w); } while (0)
    MLA_PK4(p0, 0, pa0); MLA_PK4(p0, 8, pa1); MLA_PK4(p1, 0, pa2); MLA_PK4(p1, 8, pa3);
#undef MLA_PK4
}
typedef int i32x8q __attribute__((ext_vector_type(8))); typedef int i32x4q __attribute__((ext_vector_type(4)));
template <int KB>
__device__ __forceinline__ void qkt(f32x16& p0, f32x16& p1, const LAS unsigned char* lds, int r32, int hi, const i32x8q* q8) {
    p0 = f32x16{}; p1 = f32x16{};
    const LAS unsigned char* kr = lds + OFF_K + KB * SHM_K + r32 * 128; const int kx = (r32 >> 1) & 7;
    const LAS unsigned char* rr = lds + OFF_R + KB * SHM_R + r32 * 64; const int rx = (r32 >> 2) & 3;
#define MLA_LD32(base_, c_, x_, step_) __builtin_shufflevector(*(const LAS i32x4q*)((base_) + ((((c_)) ^ (x_)) << 4) + (step_)), *(const LAS i32x4q*)((base_) + ((((c_) + 1) ^ (x_)) << 4) + (step_)), 0, 1, 2, 3, 4, 5, 6, 7)
#pragma unroll
    for (int j = 0; j < 2; ++j) { const int c = 4 * j + 2 * hi;
        const i32x8q a0 = MLA_LD32(kr, c, kx, 0), a1 = MLA_LD32(kr, c, kx, 32 * 128);
        p0 = __builtin_amdgcn_mfma_scale_f32_32x32x64_f8f6f4(a0, q8[j], p0, 0, 0, 0, 127, 0, 127 - 3);
        p1 = __builtin_amdgcn_mfma_scale_f32_32x32x64_f8f6f4(a1, q8[j], p1, 0, 0, 0, 127, 0, 127 - 3); }
    { const int c = 2 * hi;
        const i32x8q a0 = MLA_LD32(rr, c, rx, 0), a1 = MLA_LD32(rr, c, rx, 32 * 64);
        p0 = __builtin_amdgcn_mfma_scale_f32_32x32x64_f8f6f4(a0, q8[2], p0, 0, 0, 0, 127, 0, 127 - 3);
        p1 = __builtin_amdgcn_mfma_scale_f32_32x32x64_f8f6f4(a1, q8[2], p1, 0, 0, 0, 127, 0, 127 - 3); }
#undef MLA_LD32
}
template <int VB>
__device__ __forceinline__ void pv_tile(f32x16* o, int vb0, bf16x8 pa0, bf16x8 pa1, bf16x8 pa2, bf16x8 pa3) {
#define MLA_TRRD(dst, off) asm volatile("ds_read_b64_tr_b16 %0, %1 offset:%2" : "=&v"(dst) : "v"(vb0), "i"(off) : "memory")
#define MLA_PV_D0(d0) do { s16x4 l0, l1, l2, l3, h0, h1, h2, h3; constexpr int b_ = OFF_V + VB * SHM_V + v_rd_off(d0, 0, 0); \
        MLA_TRRD(l0, b_); MLA_TRRD(h0, b_ + 2048); MLA_TRRD(l1, b_ + 4096); MLA_TRRD(h1, b_ + 6144); MLA_TRRD(l2, b_ + 8192); MLA_TRRD(h2, b_ + 10240); MLA_TRRD(l3, b_ + 12288); MLA_TRRD(h3, b_ + 14336); \
        asm volatile("s_waitcnt lgkmcnt(0)" ::: "memory"); MLA_SBAR(); \
        o[d0] = __builtin_amdgcn_mfma_f32_32x32x16_bf16(pa0, (bf16x8){l0[0], l0[1], l0[2], l0[3], h0[0], h0[1], h0[2], h0[3]}, o[d0], 0, 0, 0); \
        o[d0] = __builtin_amdgcn_mfma_f32_32x32x16_bf16(pa1, (bf16x8){l1[0], l1[1], l1[2], l1[3], h1[0], h1[1], h1[2], h1[3]}, o[d0], 0, 0, 0); \
        o[d0] = __builtin_amdgcn_mfma_f32_32x32x16_bf16(pa2, (bf16x8){l2[0], l2[1], l2[2], l2[3], h2[0], h2[1], h2[2], h2[3]}, o[d0], 0, 0, 0); \
        o[d0] = __builtin_amdgcn_mfma_f32_32x32x16_bf16(pa3, (bf16x8){l3[0], l3[1], l3[2], l3[3], h3[0], h3[1], h3[2], h3[3]}, o[d0], 0, 0, 0); } while (0)
    MLA_PV_D0(0); MLA_PV_D0(1); MLA_PV_D0(2); MLA_PV_D0(3);
#undef MLA_PV_D0
#undef MLA_TRRD
}
struct Tensors { const bf16* QN; const bf16* QR; const bf16* KN; const bf16* KR; const bf16* VB; bf16* O; };

__device__ __forceinline__ s16x4 vtr(const LAS unsigned char* p) { return __builtin_bit_cast(s16x4, __builtin_amdgcn_ds_read_tr16_b64_v4i16((LAS s16x4*)p)); }
template <int N> __device__ __forceinline__ i32x8q kfrag(const LAS unsigned char* kr, const LAS unsigned char* rr, int hi, int kx, int rx) {
    if (N < 4) { const int c = 4 * (N >> 1) + 2 * hi; const LAS unsigned char* b_ = kr + (N & 1) * 32 * 128;
        return __builtin_shufflevector(*(const LAS i32x4q*)(b_ + ((c ^ kx) << 4)), *(const LAS i32x4q*)(b_ + (((c + 1) ^ kx) << 4)), 0, 1, 2, 3, 4, 5, 6, 7); }
    const int c = 2 * hi; const LAS unsigned char* b_ = rr + (N & 1) * 32 * 64;
    return __builtin_shufflevector(*(const LAS i32x4q*)(b_ + ((c ^ rx) << 4)), *(const LAS i32x4q*)(b_ + (((c + 1) ^ rx) << 4)), 0, 1, 2, 3, 4, 5, 6, 7);
}
__device__ __forceinline__ float rowmax(const f32x16& p0, const f32x16& p1) {
    float pmax = p0[0];
#pragma unroll
    for (int r = 1; r < 16; ++r) pmax = fmaxf(pmax, p0[r]);
#pragma unroll
    for (int r = 0; r < 16; ++r) pmax = fmaxf(pmax, p1[r]);
    auto rr = __builtin_amdgcn_permlane32_swap(__float_as_uint(pmax), __float_as_uint(pmax), false, false); return fmaxf(__uint_as_float(rr[0]), __uint_as_float(rr[1]));
}

__device__ __forceinline__ void unit(const Tensors& T, int b, int h, int qb, LAS unsigned char* lds) {
    const int tid = threadIdx.x, wid = __builtin_amdgcn_readfirstlane(tid >> 6), lane = tid & 63, r32 = lane & 31, hi = lane >> 5;
    const size_t rowq = (size_t)b * SEQ + qb * QB + wid * QBLK + r32;
    i32x8q qr[3];
    { const GAS unsigned char* qn8 = (const GAS unsigned char*)T.QN + rowq * 2048 + h * 128 + 32 * hi; const GAS unsigned char* qr8 = (const GAS unsigned char*)T.QR + rowq * 1024 + h * 64 + 32 * hi;
#pragma unroll
      for (int j = 0; j < 2; ++j) qr[j] = __builtin_shufflevector(*(const GAS i32x4q*)(qn8 + 64 * j), *(const GAS i32x4q*)(qn8 + 64 * j + 16), 0, 1, 2, 3, 4, 5, 6, 7);
      qr[2] = __builtin_shufflevector(*(const GAS i32x4q*)qr8, *(const GAS i32x4q*)(qr8 + 16), 0, 1, 2, 3, 4, 5, 6, 7); }
    const int NT = 4 * (qb + 1);
    const int qlo = qb * QB + wid * QBLK, qm = qlo + r32 - 4 * hi;
    LAS float* ws = (LAS float*)(lds + OFF_WS) + wid * 64; LAS float* li_l = ws; LAS float* al_l = ws + 32;
    float mhat = 0.f, l_reg = 0.f; f32x16 o[4] = {}; bool resc = false;
    const LAS unsigned char* vp0 = lds + OFF_V + v_rd_base(lane);
    const LAS unsigned char* kr0 = lds + OFF_K + r32 * 128; const LAS unsigned char* rr0 = lds + OFF_R + r32 * 64; const int kx = (r32 >> 1) & 7, rx = (r32 >> 2) & 3;
    int voff[2], koff, roff;
#pragma unroll
    for (int i = 0; i < 2; ++i) { const int G_ = (wid + 8 * i) * 64 + lane;
        { const int st = G_ >> 5, w_ = G_ & 31, kk = (st >> 2) * 8 + (w_ >> 2), c = (st & 3) * 32 + (w_ & 3) * 8, k = (kk & ~0xC) | ((kk & 4) << 1) | ((kk & 8) >> 1); voff[i] = (k * 2048 + c) * 2; } }
    { const int G_ = wid * 64 + lane, row = G_ >> 3, slot = G_ & 7; koff = row * 2048 + 16 * (slot ^ ((row >> 1) & 7)); }
    { const int G_ = (wid & 3) * 64 + lane, row = G_ >> 2, slot = G_ & 3; roff = row * 64 + 16 * (slot ^ ((row >> 2) & 3)); }
    const unsigned char* Kh = (const unsigned char*)T.KN + (size_t)b * SEQ * 2048 + h * 128; const bf16* Vh = T.VB + (size_t)b * SEQ * 2048 + h * 128; const unsigned char* Rh = (const unsigned char*)T.KR + (size_t)b * SEQ * 64;
#define MLA_GLDS(base_, off_, dst_) do { unsigned sv_; const void* g_ = (const void*)(base_); const unsigned o_ = (unsigned)(off_); const unsigned d_ = (unsigned)__builtin_amdgcn_readfirstlane((int)(unsigned)(uintptr_t)(dst_)); \
        asm volatile("s_mov_b32 %0, m0\n\ts_mov_b32 m0, %3\n\ts_nop 0\n\tglobal_load_lds_dwordx4 %1, %2\n\ts_mov_b32 m0, %0" : "=&s"(sv_) : "v"(o_), "s"(g_), "s"(d_) : "memory"); } while (0)
#define MLA_DMA_V(k0, bf) do { _Pragma("unroll") for (int i_ = 0; i_ < 2; ++i_) MLA_GLDS((const unsigned char*)Vh + (size_t)(k0) * 4096, voff[i_], lds + OFF_V + (bf) * SHM_V + (wid + 8 * i_) * 1024); } while (0)
#define MLA_DMA_K(k0, bf) do { MLA_GLDS(Kh + (size_t)(k0) * 2048, koff, lds + OFF_K + (bf) * SHM_K + wid * 1024); \
        if (wid < 4) MLA_GLDS(Rh + (size_t)(k0) * 64, roff, lds + OFF_R + (bf) * SHM_R + wid * 1024); } while (0)
#define MLA_WAITBAR() do { asm volatile("s_waitcnt vmcnt(0)" ::: "memory"); __syncthreads(); } while (0)
#define MLA_WAITBAR_C() do { if (wid < 4) asm volatile("s_waitcnt vmcnt(4)" ::: "memory"); else asm volatile("s_waitcnt vmcnt(3)" ::: "memory"); __syncthreads(); } while (0)
#define MLA_PIN(x) asm volatile("" : "+v"(x))
#define MLA_RESC() do { if (resc) { _Pragma("unroll") for (int d_ = 0; d_ < 4; ++d_) _Pragma("unroll") for (int r = 0; r < 16; ++r) o[d_][r] *= al_l[crow(r, hi)]; } } while (0)
#define MLA_QMF(C_, a_, j_, I_) C_ = __builtin_amdgcn_mfma_scale_f32_32x32x64_f8f6f4(a_, qr[j_], I_, 0, 0, 0, 127, 0, 127 - 3)
#define MLA_KF(N_) kfrag<N_>(kr_, rr_, hi, kx, rx)
#define MLA_PK4(P, B_, OUT) do { unsigned a0 = cvtpk(P[B_ + 0], P[B_ + 1]), a1 = cvtpk(P[B_ + 2], P[B_ + 3]); unsigned b0 = cvtpk(P[B_ + 4], P[B_ + 5]), b1 = cvtpk(P[B_ + 6], P[B_ + 7]); \
        auto r0 = __builtin_amdgcn_permlane32_swap(a0, b0, false, false); auto r1 = __builtin_amdgcn_permlane32_swap(a1, b1, false, false); \
        OUT = (v4u){r0[0], r1[0], r0[1], r1[1]}; } while (0)
#define MLA_S2(P, i) do { sa0 += P[i]; sa1 += P[(i) + 1]; } while (0)
#define MLA_EX2(X, i) do { const f32x2 d_ = (f32x2){X[i], X[i + 1]} - (f32x2){mhat, mhat}; X[i] = __builtin_amdgcn_exp2f(d_[0]); X[(i) + 1] = __builtin_amdgcn_exp2f(d_[1]); } while (0)
#define MLA_VRD(n) do { vlo[n] = vtr(vp_ + (((n) & 3) * 512 + ((n) >> 2) * 4096)); vhi[n] = vtr(vp_ + (((n) & 3) * 512 + ((n) >> 2) * 4096 + 2048)); } while (0)
#define MLA_VFR(n) (bf16x8){vlo[n][0], vlo[n][1], vlo[n][2], vlo[n][3], vhi[n][0], vhi[n][1], vhi[n][2], vhi[n][3]}
#define MLA_PAF(k) __builtin_bit_cast(bf16x8, pw##k)
#define MLA_GAPB(n, k, X, i) do { o[(n) & 3] = __builtin_amdgcn_mfma_f32_32x32x16_bf16(MLA_PAF(k), MLA_VFR(n), o[(n) & 3], 0, 0, 0); if ((n) + 2 < 16) MLA_VRD((n) + 2 < 16 ? (n) + 2 : 15); \
        MLA_EX2(X, i); MLA_PIN(X); MLA_SBAR(); } while (0)
    f32x16 pA0, pA1, pB0, pB1; v4u pw0, pw1, pw2, pw3; s16x4 vlo[16], vhi[16]; i32x8q kf0, kf1;
    int ks_cur = 0, ks_nxt = 1, ks_n2 = 2, ks_n3 = 3, vs_rd = 2, vs_mid = 0, vs_wr = 1;
#define MLA_ROT() do { const int o_ = ks_cur; ks_cur = ks_nxt; ks_nxt = ks_n2; ks_n2 = ks_n3; ks_n3 = o_; const int p_ = vs_rd; vs_rd = vs_mid; vs_mid = vs_wr; vs_wr = p_; } while (0)
    MLA_DMA_K(0, 0); MLA_DMA_K(KVBLK, 1); MLA_DMA_K(2 * KVBLK, 2); MLA_DMA_V(0, 0); MLA_WAITBAR();
    MLA_DMA_K(3 * KVBLK, 3); MLA_DMA_V(KVBLK, 1);
    qkt<0>(pA0, pA1, lds, r32, hi, qr);
    if (NT == 4) mask_tile(pA0, pA1, qm);
    mhat = rowmax(pA0, pA1);
#pragma unroll
    for (int r = 0; r < 16; r += 2) { MLA_EX2(pA0, r); MLA_EX2(pA1, r); }
    MLA_ROT();
    { const LAS unsigned char* kr_ = kr0 + ks_cur * SHM_K; const LAS unsigned char* rr_ = rr0 + ks_cur * SHM_R; kf0 = MLA_KF(0); kf1 = MLA_KF(1); }
    MLA_WAITBAR_C();
#define MLA_MX(X, i) fmaxf(fmaxf(X[i], X[(i) + 1]), fmaxf(X[(i) + 2], X[(i) + 3]))
#define MLA_PV(n, k) o[(n) & 3] = __builtin_amdgcn_mfma_f32_32x32x16_bf16(MLA_PAF(k), MLA_VFR(n), o[(n) & 3], 0, 0, 0)
#define MLA_VN(n) do { if ((n) + 4 < 16) MLA_VRD((n) + 4 < 16 ? (n) + 4 : 15); } while (0)
#define MLA_STEP(C0, C1, P0, P1, t, MASK, GK, GN) do { MLA_SBAR(); \
    const LAS unsigned char* kr_ = kr0 + ks_cur * SHM_K; const LAS unsigned char* rr_ = rr0 + ks_cur * SHM_R; const LAS unsigned char* vp_ = vp0 + vs_rd * SHM_V; \
    i32x8q kf2, kf3, kf4, kf5; \
    float sa0 = P0[0], sa1 = P0[1]; \
    MLA_QMF(C0, kf0, 0, (f32x16{})); kf2 = MLA_KF(2); MLA_S2(P0, 2); MLA_S2(P0, 4); MLA_S2(P0, 6); MLA_PK4(P0, 0, pw0); MLA_PIN(pw0); MLA_PIN(sa0); MLA_PIN(sa1); MLA_SBAR(); \
    MLA_QMF(C1, kf1, 0, (f32x16{})); kf3 = MLA_KF(3); MLA_S2(P0, 8); MLA_S2(P0, 10); MLA_S2(P0, 12); MLA_S2(P0, 14); MLA_PK4(P0, 8, pw1); MLA_PIN(pw1); MLA_PIN(sa0); MLA_PIN(sa1); MLA_SBAR(); \
    if (GK) MLA_DMA_K(((t) + 3) * KVBLK, ks_n3); if (GN) MLA_DMA_V(((t) + 1) * KVBLK, vs_wr); MLA_SBAR();                          \
    MLA_QMF(C0, kf2, 1, C0); kf4 = MLA_KF(4); MLA_S2(P1, 0); MLA_S2(P1, 2); MLA_S2(P1, 4); MLA_S2(P1, 6); MLA_PK4(P1, 0, pw2); MLA_PIN(pw2); MLA_PIN(sa0); MLA_PIN(sa1); MLA_SBAR(); \
    MLA_QMF(C1, kf3, 1, C1); kf5 = MLA_KF(5); MLA_VRD(0); MLA_S2(P1, 8); MLA_S2(P1, 10); MLA_S2(P1, 12); MLA_S2(P1, 14); MLA_PK4(P1, 8, pw3); MLA_PIN(pw3); MLA_PIN(sa0); MLA_PIN(sa1); MLA_SBAR(); \
    MLA_QMF(C0, kf4, 2, C0); MLA_VRD(1); MLA_VRD(2); MLA_SBAR(); \
    MLA_QMF(C1, kf5, 2, C1); MLA_VRD(3); l_reg += sa0 + sa1; MLA_SBAR(); \
      \
    MLA_PV(0, 0); MLA_VN(0); MLA_SBAR(); \
    MLA_PV(1, 0); MLA_VN(1); if (MASK) mask_tile(C0, C1, qm - (t) * KVBLK); \
    float mx0 = C0[0]; _Pragma("unroll") for (int r_ = 1; r_ < 8; ++r_) mx0 = fmaxf(mx0, C0[r_]); MLA_SBAR(); \
    MLA_PV(2, 0); MLA_VN(2); _Pragma("unroll") for (int r_ = 8; r_ < 16; ++r_) mx0 = fmaxf(mx0, C0[r_]); MLA_SBAR(); \
    MLA_PV(3, 0); MLA_VN(3); _Pragma("unroll") for (int r_ = 0; r_ < 8; ++r_) mx0 = fmaxf(mx0, C1[r_]); MLA_SBAR(); \
    MLA_PV(4, 1); MLA_VN(4); _Pragma("unroll") for (int r_ = 8; r_ < 16; ++r_) mx0 = fmaxf(mx0, C1[r_]); \
    { auto rr_x = __builtin_amdgcn_permlane32_swap(__float_as_uint(mx0), __float_as_uint(mx0), false, false); mx0 = fmaxf(__uint_as_float(rr_x[0]), __uint_as_float(rr_x[1])); } \
    { const float rm = mx0 - mhat; resc = false;                                                                         \
      if (__builtin_expect(__any(rm > THR), 0)) { const float dl = fmaxf(rm, 0.f); mhat += dl;                           \
          const float f = __builtin_amdgcn_exp2f(-dl); l_reg *= f; if (hi == 0) al_l[r32] = f; resc = true; } }            \
    MLA_SBAR(); \
    MLA_PV(5, 1);  MLA_VN(5);  MLA_EX2(C0, 0);  MLA_EX2(C0, 2);  MLA_PIN(C0); MLA_SBAR(); \
    MLA_PV(6, 1);  MLA_VN(6);  MLA_EX2(C0, 4);  MLA_EX2(C0, 6);  MLA_PIN(C0); MLA_SBAR(); \
    MLA_PV(7, 1);  MLA_VN(7);  MLA_EX2(C0, 8);  MLA_EX2(C0, 10); MLA_PIN(C0); MLA_SBAR(); \
    MLA_PV(8, 2);  MLA_VN(8);  MLA_EX2(C0, 12); MLA_EX2(C0, 14); MLA_PIN(C0); MLA_SBAR(); \
    MLA_PV(9, 2);  MLA_VN(9);  MLA_EX2(C1, 0);  MLA_EX2(C1, 2);  MLA_PIN(C1); MLA_SBAR(); \
    MLA_PV(10, 2); MLA_VN(10); MLA_EX2(C1, 4);  MLA_PIN(C1); MLA_SBAR(); \
    MLA_PV(11, 2); MLA_VN(11); MLA_EX2(C1, 6);  MLA_PIN(C1); MLA_SBAR(); \
    MLA_ROT(); \
    MLA_PV(12, 3); MLA_EX2(C1, 8);  MLA_PIN(C1); if (GN) { const LAS unsigned char* kr_ = kr0 + ks_cur * SHM_K; const LAS unsigned char* rr_ = rr0 + ks_cur * SHM_R; kf0 = MLA_KF(0); } MLA_SBAR(); \
    MLA_PV(13, 3); MLA_EX2(C1, 10); MLA_PIN(C1); if (GN) { const LAS unsigned char* kr_ = kr0 + ks_cur * SHM_K; const LAS unsigned char* rr_ = rr0 + ks_cur * SHM_R; kf1 = MLA_KF(1); } MLA_SBAR(); \
    MLA_PV(14, 3); MLA_EX2(C1, 12); MLA_PIN(C1); MLA_SBAR(); \
    MLA_PV(15, 3); MLA_EX2(C1, 14); MLA_PIN(C1); MLA_SBAR(); \
    } while (0)
    int t = 1;
#pragma unroll 1
    for (; t + 5 < NT; t += 2) {
        MLA_STEP(pB0, pB1, pA0, pA1, t, false, true, true);     MLA_WAITBAR_C(); MLA_RESC();
        MLA_STEP(pA0, pA1, pB0, pB1, t + 1, false, true, true); MLA_WAITBAR_C(); MLA_RESC(); }
#pragma unroll 1
    for (; t + 1 < NT; t += 2) {
        MLA_STEP(pB0, pB1, pA0, pA1, t, true, (t + 3 < NT), true);     MLA_WAITBAR(); MLA_RESC();
        MLA_STEP(pA0, pA1, pB0, pB1, t + 1, true, (t + 4 < NT), true); MLA_WAITBAR(); MLA_RESC(); }
    MLA_STEP(pB0, pB1, pA0, pA1, NT - 1, true, false, false); MLA_WAITBAR(); MLA_RESC();
    { float sa0 = pB0[0], sa1 = pB0[1];
#pragma unroll
      for (int r = 2; r < 16; r += 2) MLA_S2(pB0, r);
#pragma unroll
      for (int r = 0; r < 16; r += 2) MLA_S2(pB1, r);
      l_reg += sa0 + sa1;
      MLA_PK4(pB0, 0, pw0); MLA_PK4(pB0, 8, pw1); MLA_PK4(pB1, 0, pw2); MLA_PK4(pB1, 8, pw3);
      const LAS unsigned char* vp_ = vp0 + vs_rd * SHM_V;
#pragma unroll
      for (int k = 0; k < 4; ++k) {
#pragma unroll
          for (int d0 = 0; d0 < 4; ++d0) { const s16x4 lo = vtr(vp_ + (d0 * 512 + k * 4096)), hh = vtr(vp_ + (d0 * 512 + k * 4096 + 2048));
              const bf16x8 vf = (bf16x8){lo[0], lo[1], lo[2], lo[3], hh[0], hh[1], hh[2], hh[3]};
              o[d0] = __builtin_amdgcn_mfma_f32_32x32x16_bf16(k == 0 ? MLA_PAF(0) : k == 1 ? MLA_PAF(1) : k == 2 ? MLA_PAF(2) : MLA_PAF(3), vf, o[d0], 0, 0, 0); } } }
    { auto rr = __builtin_amdgcn_permlane32_swap(__float_as_uint(l_reg), __float_as_uint(l_reg), false, false); l_reg = __uint_as_float(rr[0]) + __uint_as_float(rr[1]); }
    if (hi == 0) li_l[r32] = l_reg; asm volatile("s_waitcnt lgkmcnt(0)" ::: "memory");
    unsigned char* Ow = (unsigned char*)T.O + ((size_t)b * SEQ + qb * QB + wid * QBLK) * 2048 + h * 128;
    int hi_e = hi; asm volatile("" : "+v"(hi_e));
#pragma unroll
    for (int r = 0; r < 16; ++r) { const int orow = crow(r, hi_e); const float rl = __builtin_amdgcn_rcpf(li_l[orow]);
#pragma unroll
        for (int d0 = 0; d0 < 4; ++d0) { const float v = o[d0][r] * rl; const float v1 = dppf<0xB1>(v), v2 = dppf<0x4E>(v), v3 = dppf<0x1B>(v);
            if ((r32 & 3) == 0) *(GAS unsigned*)(Ow + (size_t)orow * 2048 + d0 * 32 + r32) = pkf8(v, v1, v2, v3); } }
    __syncthreads();
#undef MLA_DMA_V
#undef MLA_GLDS
#undef MLA_DMA_K
#undef MLA_WAITBAR
#undef MLA_WAITBAR_C
#undef MLA_PIN
#undef MLA_RESC
#undef MLA_QMF
#undef MLA_KF
#undef MLA_PK4
#undef MLA_S2
#undef MLA_EX2
#undef MLA_VRD
#undef MLA_VFR
#undef MLA_PAF
#undef MLA_GAPB
#undef MLA_STEP
#undef MLA_ROT
#undef MLA_MX
#undef MLA_PV
#undef MLA_VN
}
}

#if defined(DBG_CHECK)
#ifndef DBG_WORD
#define DBG_WORD 0
#endif
namespace chk {
__device__ __forceinline__ float bsum(float v, LAS float* red, int tid) { red[tid] = v; __syncthreads(); for (int o = 256; o > 0; o >>= 1) { if (tid < o) red[tid] += red[tid + o]; __syncthreads(); } const float r = red[0]; __syncthreads(); return r; }
__device__ __forceinline__ float bmax(float v, LAS float* red, int tid) { red[tid] = v; __syncthreads(); for (int o = 256; o > 0; o >>= 1) { if (tid < o) red[tid] = fmaxf(red[tid], red[tid + o]); __syncthreads(); } const float r = red[0]; __syncthreads(); return r; }
__device__ __forceinline__ float bf(const bf16* p) { return __uint_as_float((unsigned)(*p) << 16); }
__device__ __forceinline__ float hf(const bf16* p) { return (float)__builtin_bit_cast(_Float16, *p); }
__device__ __forceinline__ int sample_t(int smp) { const int k = smp >> 5; const int edge[16] = {0, 1, 31, 32, 63, 64, 255, 256, 257, 511, 512, 4095, 4096, 8190, 8191, 300}; return k < 1 ? edge[smp & 15] : (int)(((unsigned)smp * 2654435761u) >> 13) & 8191; }
__device__ __forceinline__ void amax(float* w, float v) { if (v == v) atomicMax((int*)w, __float_as_int(v)); else atomicMax((int*)w, 0x7f000000); }
__device__ __forceinline__ void mla(const bf16* QN, const bf16* QR, const bf16* KN, const bf16* KR, const bf16* VB, const bf16* O, int smp, LAS float* lg, LAS float* red, LAS float* q, float* dbg, int tid) {
    const int b = smp & 1, h = (smp >> 1) & 15, t = sample_t(smp); const size_t row = (size_t)b * SEQ + t;
    if (tid < 128) q[tid] = bf(QN + row * 2048 + h * 128 + tid); else if (tid < 192) q[tid] = bf(QR + row * 1024 + h * 64 + (tid - 128));
    __syncthreads();
    float mx = -1e30f;
    for (int s = tid; s <= t; s += 512) { const bf16* kn = KN + ((size_t)b * SEQ + s) * 2048 + h * 128; const bf16* kr = KR + ((size_t)b * SEQ + s) * 64; float d = 0.f;
        for (int i = 0; i < 128; ++i) d += q[i] * bf(kn + i); for (int i = 0; i < 64; ++i) d += q[128 + i] * bf(kr + i); lg[s] = d; mx = fmaxf(mx, d); }
    mx = bmax(mx, red, tid); float sm = 0.f;
    for (int s = tid; s <= t; s += 512) { const float p = exp2f(lg[s] - mx); lg[s] = p; sm += p; }
    sm = bsum(sm, red, tid);
    float o = 0.f;
    if (tid < 128) { for (int s = 0; s <= t; ++s) o += lg[s] * bf(VB + ((size_t)b * SEQ + s) * 2048 + h * 128 + tid); o /= sm; }
    const float rms = sqrtf(bsum(tid < 128 ? o * o : 0.f, red, tid) / 128.f) + 1e-20f;
    const float e = tid < 128 ? fabsf(o - bf(O + row * 2048 + h * 128 + tid)) / rms : 0.f;
    const float em = bmax(e, red, tid);
    if (tid == 0) amax(dbg + 0, em);
    __syncthreads();
}
template <bool TRUE_SC> __device__ __forceinline__ void dsa(const float* x, const float* w_in, const bf16* QI, const bf16* KI, const float* WI, const bf16* QA, const bf16* KA, const bf16* VA, const bf16* O, const unsigned short* SEL, int smp, LAS float* sc, LAS float* red, LAS float* aux, float* dbg, int tid) {
    const int b = smp & 1, t = sample_t(smp >> 1 << 1 | 0) ; const size_t row = (size_t)b * SEQ + t;
    LAS float* qi = aux;
    LAS unsigned* sel = (LAS unsigned*)(aux + 1024);
    LAS float* pr = aux + 2048;
    LAS unsigned* cnt = (LAS unsigned*)(aux + 2048 + 4096);
    LAS float* wt = aux + 2048 + 4096 + 64;
    if (TRUE_SC) {
        for (int i = tid; i < 1024 + 16; i += 512) { const int c = i < 1024 ? U_QI + i : U_WI + (i - 1024); float d = 0.f; for (int k = 0; k < 2048; ++k) d += x[row * 2048 + k] * w_in[(size_t)k * DIN + c]; if (i < 1024) qi[i] = d; else wt[i - 1024] = d; }
        __syncthreads();
        for (int s = tid; s <= t; s += 512) { float kk[64];
#pragma unroll
            for (int c = 0; c < 64; ++c) kk[c] = 0.f;
            const float* xs = x + ((size_t)b * SEQ + s) * 2048;
            for (int k = 0; k < 2048; ++k) { const float xv = xs[k]; const float* wr = w_in + (size_t)k * DIN + U_KI;
#pragma unroll
                for (int c = 0; c < 64; ++c) kk[c] += xv * wr[c]; }
            float tot = 0.f;
#pragma unroll
            for (int hh = 0; hh < 16; ++hh) { float d = 0.f;
#pragma unroll
                for (int i = 0; i < 64; ++i) d += qi[hh * 64 + i] * kk[i];
                tot += wt[hh] * fmaxf(d, 0.f); }
            sc[s] = tot; }
    } else {
    for (int i = tid; i < 1024; i += 512) qi[i] = hf(QI + row * 1024 + i);
    __syncthreads();
    for (int s = tid; s <= t; s += 512) { const bf16* k = KI + ((size_t)b * SEQ + s) * 64; float tot = 0.f;
        for (int hh = 0; hh < 16; ++hh) { float d = 0.f; for (int i = 0; i < 64; ++i) d += qi[hh * 64 + i] * hf(k + i); tot += WI[row * 16 + hh] * fmaxf(d, 0.f); }
        sc[s] = tot; }
    }
    __syncthreads();
    const int n = t + 1, want = n < 256 ? n : 256;
    unsigned T = 0u;
    for (int bit = 31; bit >= 0; --bit) { const unsigned cand = T | (1u << bit); if (tid == 0) cnt[0] = 0u; __syncthreads(); unsigned c = 0u;
        for (int s = tid; s <= t; s += 512) c += (dsa::fkey(sc[s]) >= cand) ? 1u : 0u;
        if (c) atomicAdd((unsigned*)cnt, c); __syncthreads(); if (cnt[0] >= (unsigned)want) T = cand; __syncthreads(); }
    if (tid == 0) { cnt[0] = 0u; cnt[1] = 0u; } __syncthreads();
    { unsigned c = 0u; for (int s = tid; s <= t; s += 512) c += (dsa::fkey(sc[s]) > T) ? 1u : 0u; if (c) atomicAdd((unsigned*)cnt + 1, c); }
    __syncthreads();
    const unsigned cgt = cnt[1]; __syncthreads(); if (tid == 0) cnt[1] = 0u;
    for (int s = tid; s <= t; s += 512) { const unsigned ky = dsa::fkey(sc[s]); bool take = ky > T;
        if (ky == T) { unsigned rk = 0u; for (int s2 = 0; s2 < s; ++s2) rk += (dsa::fkey(sc[s2]) == T) ? 1u : 0u; take = cgt + rk < (unsigned)want; }
        if (take) { const unsigned p = atomicAdd((unsigned*)cnt, 1u); if (p < 256u) sel[p] = (unsigned)s; } }
    __syncthreads();
    const int nref = (int)(cnt[0] < 256u ? cnt[0] : 256u);
    if (tid < 256) sel[256 + tid] = SEL[row * 256 + tid];
    __syncthreads();
    { float miss = 0.f; if (tid < 256) { const unsigned s = sel[256 + tid]; if (s != 0xFFFFu) { bool found = false; for (int j = 0; j < nref; ++j) found |= (sel[j] == s); miss = found ? 0.f : 1.f; } }
      const float tm = bsum(miss, red, tid); if (tid == 0) { amax(dbg + 1, tm / (float)want); atomicAdd(dbg + 13, tm); } }
    for (int pass = 0; pass < 2; ++pass) {
        const int ns = pass == 0 ? nref : 256; LAS unsigned* sl = sel + pass * 256;
        for (int e = tid; e < 16 * 256; e += 512) { const int hh = e >> 8, j = e & 255; float v = -1e30f;
            if (j < ns && sl[j] != 0xFFFFu) { const unsigned s = sl[j]; const bf16* k = KA + ((size_t)b * SEQ + s) * 128; float d = 0.f; for (int i = 0; i < 128; ++i) d += bf(QA + row * 2048 + hh * 128 + i) * bf(k + i);
                v = d - exp2f(-0.5f * (float)(hh + 1)) * LOG2E * (float)(t - (int)s); }
            pr[e] = v; }
        __syncthreads();
        if (tid < 16) { float mx = -1e30f; for (int j = 0; j < 256; ++j) mx = fmaxf(mx, pr[tid * 256 + j]); float sm = 0.f; for (int j = 0; j < 256; ++j) { const float p = pr[tid * 256 + j] <= -1e29f ? 0.f : exp2f(pr[tid * 256 + j] - mx); pr[tid * 256 + j] = p; sm += p; }
            for (int j = 0; j < 256; ++j) pr[tid * 256 + j] /= sm; }
        __syncthreads();
        float e4 = 0.f, q4 = 0.f, s4 = 0.f;
        for (int e = tid; e < 2048; e += 512) { const int hh = e >> 7, d = e & 127; float o = 0.f;
            for (int j = 0; j < ns; ++j) { const unsigned s = sl[j]; if (s != 0xFFFFu) o += pr[hh * 256 + j] * bf(VA + ((size_t)b * SEQ + s) * 128 + d); }
            q4 += o * o; const float df = o - bf(O + row * 2048 + e); e4 = fmaxf(e4, fabsf(df)); s4 += df * df; }
        const float rms = sqrtf(bsum(q4, red, tid) / 2048.f) + 1e-20f; const float em = bmax(e4, red, tid); const float esq = bsum(s4, red, tid);
        if (tid == 0) { amax(dbg + (pass == 0 ? 0 : 2), em / rms); if (pass == 0) atomicAdd(dbg + 14, esq / (rms * rms * 2048.f)); }
        __syncthreads();
    }
}
__device__ __forceinline__ void p1(const float* x, const float* w_in, const bf16* QA, const bf16* QI, const bf16* KA, const bf16* VA, const bf16* KI, const float* WI, const bf16* CQ, const bf16* CKV, const bf16* KR, int smp, LAS float* xr, LAS float* red, LAS float* tru, float* dbg, int tid) {
    const size_t row = (size_t)(((unsigned)smp * 2654435761u) >> 9) % M; const int pos = (int)(row & (SEQ - 1));
    for (int i = tid; i < 2048; i += 512) xr[i] = x[row * 2048 + i];
    __syncthreads();
    for (int c = tid; c < U_G; c += 512) { float d = 0.f; for (int k = 0; k < 2048; ++k) d += xr[k] * w_in[(size_t)k * DIN + c]; tru[c] = d; }
    __syncthreads();
    for (int ty = 0; ty < 9; ++ty) {
        const int c0 = ty == 0 ? U_QA : ty == 1 ? U_QI : ty == 2 ? U_KA : ty == 3 ? U_VA : ty == 4 ? U_KI : ty == 5 ? U_WI : ty == 6 ? U_CQ : ty == 7 ? U_CKV : U_KPE;
        const int nc = ty == 0 ? 2048 : ty == 1 ? 1024 : ty == 2 ? 128 : ty == 3 ? 128 : ty == 4 ? 64 : ty == 5 ? 16 : ty == 6 ? 512 : ty == 7 ? 512 : 64;
        float q = 0.f, e = 0.f;
        for (int c = tid; c < nc; c += 512) { float tv = tru[c0 + c], sv;
            if (ty == 0) { tv *= QA_SCALE; sv = bf(QA + row * 2048 + c); } else if (ty == 1) sv = hf(QI + row * 1024 + c); else if (ty == 2) sv = bf(KA + row * 128 + c); else if (ty == 3) sv = bf(VA + row * 128 + c);
            else if (ty == 4) sv = hf(KI + row * 64 + c); else if (ty == 5) sv = WI[row * 16 + c]; else if (ty == 6) sv = bf(CQ + row * 512 + c); else if (ty == 7) sv = bf(CKV + row * 512 + c);
            else { const int i = c & 31; const float ang = (float)pos * exp2f(-(float)i * (13.287712379549449f / 32.f)), cs = cosf(ang), sn = sinf(ang); const float x1 = tru[c0 + i], x2 = tru[c0 + 32 + i]; tv = c < 32 ? x1 * cs - x2 * sn : x1 * sn + x2 * cs; sv = bf(KR + row * 64 + c); }
            q += tv * tv; e = fmaxf(e, fabsf(tv - sv)); }
        const float rms = sqrtf(bsum(q, red, tid) / (float)nc) + 1e-20f; const float em = bmax(e, red, tid) / rms;
        if (tid == 0) { amax(dbg + 3 + ty, em); amax(dbg + 12, em); }
        __syncthreads();
    }
}
__device__ __forceinline__ void p2(const bf16* CQ, const bf16* CKV, const float* gq, const float* gkv, const float* w_uq, const float* w_uk, const float* w_uv, const bf16* QN, const bf16* QR, const bf16* KN, const bf16* VB,
                                   int smp, LAS float* cr, LAS float* red, LAS float* tru, float* dbg, int tid) {
    const size_t row = (size_t)(((unsigned)smp * 2654435761u) >> 9) % M; const int pos = (int)(row & (SEQ - 1));
    for (int i = tid; i < 1024; i += 512) cr[i] = i < 512 ? bf(CQ + row * 512 + i) : bf(CKV + row * 512 + (i - 512));
    __syncthreads();
    const float ssq = bsum(cr[tid] * cr[tid], red, tid), ssk = bsum(cr[512 + tid] * cr[512 + tid], red, tid);
    const float rq = 1.f / sqrtf(ssq / 512.f + RMS_EPS), rk = 1.f / sqrtf(ssk / 512.f + RMS_EPS);
    for (int n = tid; n < 3072 + 4096; n += 512) { float d = 0.f;
        if (n < 3072) { for (int k = 0; k < 512; ++k) d += cr[k] * gq[k] * w_uq[(size_t)k * 3072 + n]; d *= rq * QB_SCALE; }
        else if (n < 3072 + 2048) { for (int k = 0; k < 512; ++k) d += cr[512 + k] * gkv[k] * w_uk[(size_t)k * 2048 + (n - 3072)]; d *= rk; }
        else { for (int k = 0; k < 512; ++k) d += cr[512 + k] * gkv[k] * w_uv[(size_t)k * 2048 + (n - 5120)]; d *= rk; }
        tru[n] = d; }
    __syncthreads();
    float q = 0.f, e = 0.f;
    for (int n = tid; n < 2048; n += 512) { const int h = n >> 7, d = n & 127; const float tv = tru[h * 192 + d]; q += tv * tv; e = fmaxf(e, fabsf(tv - bf(QN + row * 2048 + n))); }
    { const float rms = sqrtf(bsum(q, red, tid) / 2048.f) + 1e-20f; const float em = bmax(e, red, tid) / rms; if (tid == 0) { amax(dbg + 0, em); amax(dbg + 1, em); } }
    q = 0.f; e = 0.f;
    for (int n = tid; n < 1024; n += 512) { const int h = n >> 6, c = n & 63, i = c & 31; const float ang = (float)pos * exp2f(-(float)i * (13.287712379549449f / 32.f)), cs = cosf(ang), sn = sinf(ang);
        const float x1 = tru[h * 192 + 128 + i], x2 = tru[h * 192 + 160 + i], tv = c < 32 ? x1 * cs - x2 * sn : x1 * sn + x2 * cs; q += tv * tv; e = fmaxf(e, fabsf(tv - bf(QR + row * 1024 + n))); }
    { const float rms = sqrtf(bsum(q, red, tid) / 1024.f) + 1e-20f; const float em = bmax(e, red, tid) / rms; if (tid == 0) { amax(dbg + 0, em); amax(dbg + 2, em); } }
    q = 0.f; e = 0.f;
    for (int n = tid; n < 2048; n += 512) { const float tv = tru[3072 + n]; q += tv * tv; e = fmaxf(e, fabsf(tv - bf(KN + row * 2048 + n))); }
    { const float rms = sqrtf(bsum(q, red, tid) / 2048.f) + 1e-20f; const float em = bmax(e, red, tid) / rms; if (tid == 0) { amax(dbg + 0, em); amax(dbg + 3, em); } }
    q = 0.f; e = 0.f;
    for (int n = tid; n < 2048; n += 512) { const float tv = tru[5120 + n]; q += tv * tv; e = fmaxf(e, fabsf(tv - bf(VB + row * 2048 + n))); }
    { const float rms = sqrtf(bsum(q, red, tid) / 2048.f) + 1e-20f; const float em = bmax(e, red, tid) / rms; if (tid == 0) { amax(dbg + 0, em); amax(dbg + 4, em); } }
    __syncthreads();
}
__device__ __forceinline__ void gchk(const float* x, const float* w_in, const bf16* GS, const bf16* XHS, size_t row, LAS float* xr, LAS float* red, float* dbg, int tid) {
    for (int i = tid; i < 2048; i += 512) xr[i] = x[row * 2048 + i];
    __syncthreads();
    float eg = 0.f;
    for (int c = tid; c < 4096; c += 512) { float l0 = 0.f; for (int k = 0; k < 2048; ++k) l0 += xr[k] * w_in[(size_t)k * DIN + U_G + c]; eg = fmaxf(eg, fabsf(1.f / (1.f + expf(-l0)) - bf(GS + row * 4096 + c))); }
    const float egm = bmax(eg, red, tid);
    float ex = 0.f; for (int i = tid; i < 2048; i += 512) ex = fmaxf(ex, fabsf(xr[i] - hf(XHS + row * 2048 + i))); const float exm = bmax(ex, red, tid);
    int nb = 0; for (int c = tid; c < 4096; c += 512) { float l0 = 0.f; for (int k = 0; k < 2048; ++k) l0 += xr[k] * w_in[(size_t)k * DIN + U_G + c]; nb += fabsf(1.f / (1.f + expf(-l0)) - bf(GS + row * 4096 + c)) > 0.05f ? 1 : 0; }
    const float nbt = bsum((float)nb, red, tid);
    if (tid == 0) { amax(dbg + 0, egm); if (egm > 0.05f) { atomicAdd(dbg + 1, 1.0f); amax(dbg + 3, nbt); amax(dbg + 4, 4097.f - nbt); } amax(dbg + 2, exm); }
    __syncthreads();
}
__device__ __forceinline__ void mid(const float* x, const float* w_in, const float* wa, const float* wb, const float* wo, const bf16* AA, const bf16* AB, const bf16* GS, const bf16* MTS, const float* Z, size_t row, int vtag, LAS float* va, LAS float* red, LAS float* mg, float* dbg, int tid) {
    LAS float* vb = va + 2048; LAS float* xr = va + 4096;
    for (int i = tid; i < 2048; i += 512) { va[i] = bf(AA + row * 2048 + i); vb[i] = bf(AB + row * 2048 + i); xr[i] = x[row * 2048 + i]; }
    __syncthreads();
    float eg = 0.f, qm = 0.f, emt = 0.f; int cmx = -1, cmn = 1 << 20;
    for (int c = tid; c < 2048; c += 512) { float l0 = 0.f, l1 = 0.f, ma = 0.f, mb = 0.f;
        for (int k = 0; k < 2048; ++k) { const float xv = xr[k]; l0 += xv * w_in[(size_t)k * DIN + U_G + c]; l1 += xv * w_in[(size_t)k * DIN + U_G + 2048 + c]; ma += va[k] * wa[(size_t)k * 2048 + c]; mb += vb[k] * wb[(size_t)k * 2048 + c]; }
        const float g0 = 1.f / (1.f + expf(-l0)), g1 = 1.f / (1.f + expf(-l1)); mg[c] = ma * g0 + mb * g1;
        { const float e0 = fabsf(g0 - bf(GS + row * 4096 + c)), e1 = fabsf(g1 - bf(GS + row * 4096 + 2048 + c)); eg = fmaxf(eg, fmaxf(e0, e1)); if (e0 > 0.05f) { cmx = max(cmx, c); cmn = min(cmn, c); } if (e1 > 0.05f) { cmx = max(cmx, 2048 + c); cmn = min(cmn, 2048 + c); } } qm += mg[c] * mg[c]; emt = fmaxf(emt, fabsf(mg[c] - bf(MTS + row * 2048 + c))); }
    { const float egm = bmax(eg, red, tid); const float rm = sqrtf(bsum(qm, red, tid) / 2048.f) + 1e-20f; const float emm = bmax(emt, red, tid) / rm; if (tid == 0) { amax(dbg + 17, egm); amax(dbg + 18, emm); if (egm > 0.05f) { amax(dbg + 19, (float)(row & 255) + 1.0f); amax(dbg + 20, (float)(255 - (row & 255)) + 1.0f); atomicAdd(dbg + 21, 1.0f); amax(dbg + 22, (float)vtag + 1.0f); amax(dbg + 23, (float)(255 - vtag) + 1.0f); } }
      const float fx = bmax((float)cmx, red, tid), fn = bmax((float)(4096 - cmn), red, tid); if (tid == 0 && fx >= 0.f) { amax(dbg + 24, fx + 1.0f); amax(dbg + 25, fn + 1.0f); } }
    __syncthreads();
    float q = 0.f, e = 0.f;
    for (int c = tid; c < 2048; c += 512) { float d = 0.f; for (int k = 0; k < 2048; ++k) d += mg[k] * wo[(size_t)k * 2048 + c]; q += d * d; e = fmaxf(e, fabsf(ALPHA * xr[c] + d - Z[row * 2048 + c])); }
    const float rms = sqrtf(bsum(q, red, tid) / 2048.f) + 1e-20f; const float em = bmax(e, red, tid) / rms;
    if (tid == 0) { amax(dbg + 0, em); if (em > 0.25f) { atomicAdd(dbg + 13, 1.0f); amax(dbg + 15, (float)(row & 255) + 1.0f); amax(dbg + 16, (float)(row >> 8) + 1.0f); } }
    __syncthreads();
}
__device__ __forceinline__ void endp(const bf16* X1B, const float* x1f_unused, const float* p, const float* w_up, const float* cw, const float* cb, const float* w_down, const float* w_pg, const float* b_pg, const float* w_pe, const float* g2, const float* b2,
                                     const float* OUT, int smp, LAS float* xs, LAS float* red, LAS float* act, float* dbg, int tid) {
    const int k6 = smp & 7; const size_t rbase = (size_t)(((unsigned)smp * 2654435761u) >> 9) % M; const size_t row = k6 == 0 ? (rbase & ~(size_t)63) : k6 == 1 ? (rbase & ~(size_t)63) + 1 : k6 == 2 ? (rbase & ~(size_t)8191) : rbase; const int t = (int)(row & (SEQ - 1));
    LAS float* z = act + 5632; LAS float* pr = act + 5632 + 2048;
    for (int i = tid; i < 3 * 2048; i += 512) { const int j = i >> 11, c = i & 2047; const int tt = t - 2 + j; xs[i] = tt >= 0 ? bf(X1B + (row - 2 + j) * 2048 + c) : 0.f; }
    for (int i = tid; i < 256; i += 512) pr[i] = p[row * 256 + i];
    __syncthreads();
    for (int ch = tid; ch < DFF; ch += 512) { float hg[3] = {0.f, 0.f, 0.f}, hv[3] = {0.f, 0.f, 0.f};
        for (int k = 0; k < 2048; ++k) { const float wg = w_up[(size_t)k * NUP + ch], wv = w_up[(size_t)k * NUP + DFF + ch];
#pragma unroll
            for (int j = 0; j < 3; ++j) { hg[j] += xs[j * 2048 + k] * wg; hv[j] += xs[j * 2048 + k] * wv; } }
        float yg = cb[ch], yv = cb[DFF + ch];
#pragma unroll
        for (int j = 0; j < 3; ++j) { yg += cw[(size_t)j * NUP + ch] * hg[j]; yv += cw[(size_t)j * NUP + DFF + ch] * hv[j]; }
        act[ch] = yg / (1.f + expf(-yg)) * yv; }
    __syncthreads();
    for (int c = tid; c < 2048; c += 512) { float f = 0.f, lg = b_pg[c], pe = 0.f;
        for (int k = 0; k < DFF; ++k) f += act[k] * w_down[(size_t)k * 2048 + c];
        for (int k = 0; k < 2048; ++k) lg += xs[2 * 2048 + k] * w_pg[(size_t)k * 2048 + c];
        for (int k = 0; k < 256; ++k) pe += pr[k] * w_pe[(size_t)k * 2048 + c];
        z[c] = ALPHA * xs[2 * 2048 + c] + f + pe / (1.f + expf(-lg)); }
    __syncthreads();
    float s = 0.f; for (int c = tid; c < 2048; c += 512) s += z[c];
    const float mean = bsum(s, red, tid) / 2048.f; float s2 = 0.f; for (int c = tid; c < 2048; c += 512) s2 += (z[c] - mean) * (z[c] - mean);
    const float rstd = 1.f / sqrtf(bsum(s2, red, tid) / 2048.f + LN_EPS); float e = 0.f;
    for (int c = tid; c < 2048; c += 512) e = fmaxf(e, fabsf((z[c] - mean) * rstd * g2[c] + b2[c] - OUT[row * 2048 + c]));
    const float em = bmax(e, red, tid);
    if (tid == 0) { amax(dbg + 0, em); amax(dbg + 1 + (k6 < 3 ? k6 : 3), em); }
    __syncthreads();
}
}
#endif

__device__ __forceinline__ int own_panel(int x, int s) { return s < 4 ? x + 8 * s : 32 + (7 - x) + 8 * (s - 4); }
__device__ __forceinline__ void ln_pass(const bf16* zin, float* fout, bf16* bout, unsigned char* xf8, const float* g, const float* b, int vcu, int wave, int lane) {
#pragma unroll 1
    for (int s_ = 0; s_ < 8; ++s_) { const int m = 256 * own_panel(vcu >> 5, s_) + 8 * (vcu & 31) + wave;
        const GAS v4u* zr = (const GAS v4u*)(zin + (size_t)m * DM) + lane;
        f32x4 v[8]; float s = 0.f;
#pragma unroll
        for (int j = 0; j < 4; ++j) { unpack8(zr[64 * j], v[2 * j], v[2 * j + 1]); s += ((v[2 * j][0] + v[2 * j][1]) + (v[2 * j][2] + v[2 * j][3])) + ((v[2 * j + 1][0] + v[2 * j + 1][1]) + (v[2 * j + 1][2] + v[2 * j + 1][3])); }
        const float mean = wave_sum(s) * (1.f / DM); float s2 = 0.f;
#pragma unroll
        for (int j = 0; j < 8; ++j) { v[j] = v[j] - mean; s2 += (v[j][0] * v[j][0] + v[j][1] * v[j][1]) + (v[j][2] * v[j][2] + v[j][3] * v[j][3]); }
        const float rstd = 1.f / sqrtf(wave_sum(s2) * (1.f / DM) + LN_EPS);
#pragma unroll
        for (int j = 0; j < 4; ++j) { const int e0 = 8 * (lane + 64 * j);
            const f32x4 g0 = *(const GAS f32x4*)(g + e0), g1 = *(const GAS f32x4*)(g + e0 + 4), b0 = *(const GAS f32x4*)(b + e0), b1 = *(const GAS f32x4*)(b + e0 + 4);
            const f32x4 y0 = v[2 * j] * rstd * g0 + b0, y1 = v[2 * j + 1] * rstd * g1 + b1;
            if (fout) { *(GAS f32x4*)(fout + (size_t)m * DM + e0) = y0; *(GAS f32x4*)(fout + (size_t)m * DM + e0 + 4) = y1; }
            if (bout) *(GAS v4u*)(bout + (size_t)m * DM + e0) = pack8(y0, y1);
            if (xf8) { u32x2 w; w.x = pkf8(y0[0], y0[1], y0[2], y0[3]); w.y = pkf8(y1[0], y1[1], y1[2], y1[3]); *(GAS u32x2*)(xf8 + (size_t)m * DM + e0) = w; } }
    }
}
__device__ __forceinline__ void conv_fixup(unsigned char* ACT, const float* HEADB, const float* TAILB, const float* cw, const float* cb, int vcu, int tid) {
    constexpr int CH8 = DFF / 8;
    for (int it = (vcu & 31) * 512 + tid; it < 8 * 4 * 2 * CH8; it += 32 * 512) {
        const int c8 = it % CH8, rr = (it / CH8) & 1, g4 = (it / (2 * CH8)) & 3, s_ = it / (8 * CH8); const int g = own_panel(vcu >> 5, s_) * 4 + g4;
        const int ch = 8 * c8, pg = 256 * (ch >> 7) + (ch & 127); const bool first = (g & 127) == 0;
        f32x4 res[2][2];
#pragma unroll
        for (int bj = 0; bj < 2; ++bj) { const int pc = pg + bj * 128, c = ch + bj * DFF;
#pragma unroll
            for (int n = 0; n < 2; ++n) { const f32x4 z = (f32x4){0.f, 0.f, 0.f, 0.f};
                const f32x4 u0 = *(const GAS f32x4*)(HEADB + ((size_t)g * 2 + rr) * NUP + pc + 4 * n);
                const f32x4 t1 = first ? z : *(const GAS f32x4*)(TAILB + ((size_t)(g - 1) * 2 + 1) * NUP + pc + 4 * n);
                const f32x4 t0 = first ? z : *(const GAS f32x4*)(TAILB + ((size_t)(g - 1) * 2 + 0) * NUP + pc + 4 * n);
                const f32x4 h0 = *(const GAS f32x4*)(HEADB + ((size_t)g * 2 + 0) * NUP + pc + 4 * n);
                const f32x4 u1 = rr ? h0 : t1, u2 = rr ? t1 : t0;
                const f32x4 w0 = *(const GAS f32x4*)(cw + c + 4 * n), w1 = *(const GAS f32x4*)(cw + NUP + c + 4 * n), w2 = *(const GAS f32x4*)(cw + 2 * NUP + c + 4 * n), bb = *(const GAS f32x4*)(cb + c + 4 * n);
                res[bj][n] = bb + w2 * u0 + w1 * u1 + w0 * u2; } }
        const f32x4 a0 = res[0][0] * sigmoid4(res[0][0]) * res[1][0], a1 = res[0][1] * sigmoid4(res[0][1]) * res[1][1];
        { u32x2 w; w.x = pkf8(a0[0], a0[1], a0[2], a0[3]); w.y = pkf8(a1[0], a1[1], a1[2], a1[3]); *(GAS u32x2*)(ACT + ((size_t)g * 64 + rr) * DFF + ch) = w; }
    }
}

struct Args { const float* in[22]; float* out; unsigned char* ws; };
#define GEMM_PHASE_LC(EPI, A_, B_, N_, K_, E_, DT_, WS_, LDA_, C_) do { int kk_ = (K_); asm volatile("" : "+s"(kk_)); pg8::Gemm g_{(const pg8::bf16_t*)(A_), (const pg8::bf16_t*)(B_), M, (N_), kk_, (WS_), (LDA_)}; pg8::StaticOrder S_; S_.init(M, (N_), G, (C_)); \
        pg8::gemm_phase<EPI, pg8::StaticOrder, true, true, DT_>(lds, g_, S_, (E_)); } while (0)
#define GEMM_PHASE_L(EPI, A_, B_, N_, K_, E_, DT_, WS_, LDA_) do { int kk_ = (K_); asm volatile("" : "+s"(kk_)); pg8::Gemm g_{(const pg8::bf16_t*)(A_), (const pg8::bf16_t*)(B_), M, (N_), kk_, (WS_), (LDA_)}; pg8::StaticOrder S_; S_.init(M, (N_), G, bx); \
        pg8::gemm_phase<EPI, pg8::StaticOrder, true, true, DT_>(lds, g_, S_, (E_)); } while (0)
#define GEMM_PHASE_X(EPI, A_, B_, N_, K_, E_, DT_, WS_) GEMM_PHASE_L(EPI, A_, B_, N_, K_, E_, DT_, WS_, 0)
#define GEMM_PHASE_T(EPI, A_, B_, N_, K_, E_, F16_) GEMM_PHASE_X(EPI, A_, B_, N_, K_, E_, ((F16_) ? 1 : 0), 127)
#define GEMM_PHASE(EPI, A_, B_, N_, K_, E_) GEMM_PHASE_X(EPI, A_, B_, N_, K_, E_, 0, 127)

__global__ void __launch_bounds__(NWAVES * 64, 2) fwd_kernel(Args args) {
    extern __shared__ __attribute__((aligned(16))) unsigned char lds_raw[];
    LAS unsigned char* lds = (LAS unsigned char*)lds_raw;
    volatile LAS unsigned* MISC = (volatile LAS unsigned*)(lds + MISC_OFF);
    const int tid0 = threadIdx.x, wave = __builtin_amdgcn_readfirstlane(tid0 >> 6);
#define TID() ({ int t_ = threadIdx.x; asm volatile("" : "+v"(t_)); t_; })
#define LANE() (TID() & 63)
#define GT() ((size_t)bx * (NWAVES * 64) + TID())
    for (int u = threadIdx.x; u < (LDS_BYTES - LDSCTL_OFF) / 4; u += NWAVES * 64) ((LAS unsigned*)(lds + LDSCTL_OFF))[u] = 0u;
    __syncthreads();
    if (threadIdx.x == 0) { const unsigned xcc = xb_xcc_id() & 7u; const unsigned rk = __hip_atomic_fetch_add((gu32*)(args.ws + WS_CTL) + CW_RANK + 64 * xcc, 1u, RLX_AGENT); MISC[12] = (rk & 31u) * 8u + xcc; }
    __syncthreads();
    const int G = gridDim.x, bx = __builtin_amdgcn_readfirstlane((int)MISC[12]), vcu = (bx % 8) * (G / 8) + bx / 8;
    const int gw = vcu * NWAVES + wave, NGW = G * NWAVES; const size_t NT = (size_t)G * NWAVES * 64;
#define WSP(T_, off_) ((T_*)(wsb() + (off_)))
#define INP(k_) inb(k_)
#define DOP(T_, off_) ((T_*)((unsigned char*)outb() + (off_)))
    auto wsb = [&]() __attribute__((always_inline)) { unsigned char* w_ = args.ws; asm volatile("" : "+s"(w_)); return w_; };
    auto inb = [&](int k_) __attribute__((always_inline)) { const float* p_ = args.in[k_]; asm volatile("" : "+s"(p_)); return p_; };
    auto outb = [&]() __attribute__((always_inline)) { float* p_ = args.out; asm volatile("" : "+s"(p_)); return p_; };

    XcdBarrier bar = xcd_barrier_post((unsigned*)((gu32*)(args.ws + WS_CTL) + CW_BAR), MISC + 8);
#if defined(DBG_CKPT)
#define CKPT(id_, lo_, hi_) do { if (DBG_CKPT == (id_)) { unsigned* cw_ = WSP(unsigned, WS_CTL) + 200100; const unsigned* p_ = (const unsigned*)(wsb() + (size_t)(lo_) * MiB); unsigned c_ = 0u; \
        for (size_t i = GT(); i < (size_t)((hi_) - (lo_)) * MiB / 4; i += NT) c_ += p_[i] * 2654435761u + (unsigned)i; \
        c_ += __shfl_xor(c_, 32); c_ += __shfl_xor(c_, 16); c_ += __shfl_xor(c_, 8); c_ += __shfl_xor(c_, 4); c_ += __shfl_xor(c_, 2); c_ += __shfl_xor(c_, 1); \
        if ((TID() & 63) == 0) atomicAdd(cw_, c_); xcd_barrier(bar); \
        const float X = (float)(__hip_atomic_load(cw_, RLX_AGENT) & 0xFFFFFFu) + 1.0f; float* o_ = outb(); \
        for (size_t i = GT(); i < (size_t)M * DM / 4; i += NT) *((GAS f32x4*)o_ + i) = (f32x4){X, X, X, X}; return; } } while (0)
#else
#define CKPT(id_, lo_, hi_) do { } while (0)
#endif
#if defined(DBG_SPIN)
#define STAMP(i_) do { if (threadIdx.x == 0) { const unsigned long long t_ = __builtin_amdgcn_s_memrealtime(); MISC[16 + 2 * (i_)] = (unsigned)t_; MISC[17 + 2 * (i_)] = (unsigned)(t_ >> 32); const unsigned long long c_ = __builtin_amdgcn_s_memtime(); MISC[100 + 2 * (i_)] = (unsigned)c_; MISC[101 + 2 * (i_)] = (unsigned)(c_ >> 32); } } while (0)
#else
#define STAMP(i_) do { } while (0)
#endif
#define SCR() ((LAS float*)(lds + RING_OFF + wave * TR_LDS))
#define SSQP() ((float*)(wsb() + WS_CTL + MiB))

#if defined(DBG_CHECK)
#define DBG_OA ((DBG_CHECK == 1 || DBG_CHECK == 4) ? WS_XB : WS_QA)
#define DBG_OB (DBG_CHECK == 2 ? WS_XB : WS_QN)
#define DBG_SEL ((DBG_CHECK == 1 || DBG_CHECK == 4) ? (unsigned short*)(wsb() + WS_END) : (unsigned short*)nullptr)
#else
#define DBG_OA WS_QA
#define DBG_OB WS_QN
#define DBG_SEL ((unsigned short*)nullptr)
#endif
#ifndef ONLY
#define ONLY -1
#endif
#ifndef SKIPMASK
#define SKIPMASK 0
#endif
#define PH(k) ((ONLY < 0 || ONLY == (k)) && !((SKIPMASK >> (k)) & 1))
    STAMP(0);
    if (PH(0)) {
    { const TrIn I{INP(2), INP(3), INP(4), INP(5), INP(6), INP(7), INP(8), INP(9), INP(10), INP(13), INP(16), INP(17), INP(19)}; tr_all(I, wsb(), SCR(), gw, NGW, LANE()); }
    cvt_flat_h(INP(0), WSP(bf16, WS_XB), WSP(unsigned char, WS_XF8), (size_t)M * DM / 8, GT(), NT);
    cvt_flat(INP(1), WSP(bf16, WS_PB), (size_t)M * PLE_DIM / 8, GT(), NT);
    { float* ROPE = WSP(float, WS_ROPE);
    for (size_t i = GT(); i < (size_t)SEQ * 32; i += NT) { const int pos = (int)(i >> 5), j = (int)(i & 31);
        const double f = exp2(-(double)j * (13.287712379549449 / 32.0)), turns = (double)pos * f * 0.15915494309189535, fr = turns - floor(turns);
        ROPE[i] = __builtin_amdgcn_cosf((float)fr); ROPE[(size_t)SEQ * 32 + i] = __builtin_amdgcn_sinf((float)fr); } }
    }
    xcd_barrier(bar);

    STAMP(1);
    if (PH(1)) { EpiU<1> E{WSP(bf16, WS_QA), DOP(bf16, DO_QI), DOP(bf16, DO_KA), DOP(bf16, DO_VA), DOP(bf16, DO_KI), DOP(bf16, DO_KR), DOP(bf16, DO_CQ), DOP(bf16, DO_CKV), DOP(float, DO_WI), SSQP(), WSP(float, WS_ROPE)};
        GEMM_PHASE_X(EpiU<1>, WSP(bf16, WS_XF8), WSP(bf16, WS_WIN8), NU8, 1024, E, 2, 127 - 6); }
    if (PH(1)) { EpiU<2> E{WSP(bf16, WS_QA), DOP(bf16, DO_QI), DOP(bf16, DO_KA), DOP(bf16, DO_VA), DOP(bf16, DO_KI), DOP(bf16, DO_KR), DOP(bf16, DO_CQ), DOP(bf16, DO_CKV), DOP(float, DO_WI), SSQP(), WSP(float, WS_ROPE)};
        GEMM_PHASE_LC(EpiU<2>, WSP(bf16, WS_XB), WSP(bf16, WS_WIN), NU16, 2048, E, 1, 127, 0, (bx + 64) % G); }
    xcd_barrier(bar);
    CKPT(1, 118, 260);

#if defined(DBG_CHECK) && DBG_CHECK == 3
    {   float* dbgw = (float*)(WSP(unsigned, WS_CTL) + 200000);
        LAS float* xr = (LAS float*)lds; LAS float* red = (LAS float*)(lds + 65536); LAS float* tru = (LAS float*)(lds + 69632);
        for (int smp = bx; smp < 256; smp += G) chk::p1(INP(0), INP(2), WSP(bf16, WS_QA), DOP(bf16, DO_QI), DOP(bf16, DO_KA), DOP(bf16, DO_VA), DOP(bf16, DO_KI), DOP(float, DO_WI), DOP(bf16, DO_CQ), DOP(bf16, DO_CKV), DOP(bf16, DO_KR), smp, xr, red, tru, dbgw, TID());
        xcd_barrier(bar);
        const float X = __hip_atomic_load(dbgw + DBG_WORD, RLX_AGENT) * 1e8f; float* o_ = outb();
        for (size_t i = GT(); i < (size_t)M * DM / 4; i += NT) *((GAS f32x4*)o_ + i) = (f32x4){X, X, X, X};
        return;
    }
#endif
#if defined(DBG_CHECK) && DBG_CHECK == 5
    {
        float* dbgw = (float*)(WSP(unsigned, WS_CTL) + 200000);
        for (int rep = 0; rep < 2; ++rep) {
            const dsa::Ptrs P{DOP(bf16, DO_QI), DOP(bf16, DO_KI), DOP(bf16, DO_KA), DOP(bf16, DO_VA), DOP(float, DO_WI), WSP(bf16, WS_QA), rep == 0 ? WSP(bf16, WS_XB) : WSP(bf16, WS_QN), (unsigned short*)(wsb() + WS_END + (size_t)rep * 8 * MiB)};
            LAS unsigned char* wl = lds + RING_OFF + wave * 16384; LAS dsa::u16* idl = (LAS dsa::u16*)(lds + IDL_OFF + wave * 2048);
            const int x_ = vcu >> 5, wv = (vcu & 31) * NWAVES + wave, j_ = wv >> 6, i_ = wv & 63;
#pragma unroll 1
            for (int jb = 0; jb < 2; ++jb) dsa::job(P, jb, jb == 0 ? 256 * (x_ + 8 * j_) + 4 * i_ : 256 * ((7 - x_) + 8 * (3 - j_)) + 4 * (63 - i_), wl, idl, LANE());
            xcd_barrier(bar);
        }
        { const unsigned short* sa = (const unsigned short*)(wsb() + WS_END); const unsigned short* sb = sa + (size_t)4 * MiB; unsigned c = 0u;
          for (size_t i = GT(); i < (size_t)M * 256; i += NT) c += sa[i] != sb[i] ? 1u : 0u;
          if (c) atomicAdd((unsigned*)dbgw + 20, c);
          const unsigned* oa = (const unsigned*)WSP(bf16, WS_XB); const unsigned* ob = (const unsigned*)WSP(bf16, WS_QN); unsigned c2 = 0u;
          for (size_t i = GT(); i < (size_t)M * 1024; i += NT) c2 += oa[i] != ob[i] ? 1u : 0u;
          if (c2) atomicAdd((unsigned*)dbgw + 21, c2); }
        xcd_barrier(bar);
        const float X = ((float)__hip_atomic_load((unsigned*)dbgw + 20 + DBG_WORD, RLX_AGENT) + 1.0f) * 1e8f; float* o_ = outb();
        for (size_t i = GT(); i < (size_t)M * DM / 4; i += NT) *((GAS f32x4*)o_ + i) = (f32x4){X, X, X, X};
        return;
    }
#endif
    STAMP(2);
    if (PH(3)) { const dsa::Ptrs P{DOP(bf16, DO_QI), DOP(bf16, DO_KI), DOP(bf16, DO_KA), DOP(bf16, DO_VA), DOP(float, DO_WI), WSP(bf16, WS_QA), WSP(bf16, DBG_OA), DBG_SEL};
      LAS unsigned char* wl = lds + RING_OFF + wave * 16384; LAS dsa::u16* idl = (LAS dsa::u16*)(lds + IDL_OFF + wave * 2048);
      const int x_ = vcu >> 5, j_ = wave & 3, i_ = (vcu & 31) * 2 + (wave >> 2);
#pragma unroll 1
      for (int jb = 0; jb < 2; ++jb) dsa::job(P, jb, jb == 0 ? 256 * (x_ + 8 * j_) + 4 * i_ : 256 * ((7 - x_) + 8 * (3 - j_)) + 4 * (63 - i_), wl, idl, LANE(), wave == 0 ? MISC + 64 : nullptr); }
    __syncthreads();
    STAMP(3);
    if (PH(2)) { EpiQ E{WSP(bf16, WS_QN), DOP(bf16, DO_QR), SSQP(), WSP(float, WS_ROPE)}; GEMM_PHASE_X(EpiQ, DOP(bf16, DO_CQ), WSP(bf16, WS_WUQ), 3072, 256, E, 2, 127 - 5); }
    if (PH(2)) { EpiKV E{WSP(bf16, WS_KN), WSP(bf16, WS_VB), SSQP() + (size_t)M * 8}; GEMM_PHASE_X(EpiKV, DOP(bf16, DO_CKV), WSP(bf16, WS_WKV), 4096, 256, E, 2, 127 - 5); }
    xcd_barrier(bar);
    CKPT(2, 118, 182); CKPT(3, 260, 484);
#if defined(DBG_CHECK) && DBG_CHECK == 6
    {   float* dbgw = (float*)(WSP(unsigned, WS_CTL) + 200000);
        LAS float* cr = (LAS float*)lds; LAS float* red = (LAS float*)(lds + 65536); LAS float* tru = (LAS float*)(lds + 69632);
        for (int smp = bx; smp < 256; smp += G) chk::p2(DOP(bf16, DO_CQ), DOP(bf16, DO_CKV), INP(3), INP(4), INP(5), INP(6), INP(7), WSP(bf16, WS_QN), DOP(bf16, DO_QR), WSP(bf16, WS_KN), WSP(bf16, WS_VB), smp, cr, red, tru, dbgw, TID());
        xcd_barrier(bar);
        const float X = __hip_atomic_load(dbgw + DBG_WORD, RLX_AGENT) * 1e8f; float* o_ = outb();
        for (size_t i = GT(); i < (size_t)M * DM / 4; i += NT) *((GAS f32x4*)o_ + i) = (f32x4){X, X, X, X};
        return;
    }
#endif

    STAMP(4);
    if (PH(4)) { const mla::Tensors T{WSP(bf16, WS_QN), DOP(bf16, DO_QR), WSP(bf16, WS_KN), DOP(bf16, DO_KR), WSP(bf16, WS_VB), DOP(bf16, DO_AB8)};
#pragma unroll 1
      for (int r_ = 0; r_ < 2; ++r_) { const int x_ = vcu >> 5, q_ = (vcu & 31) * 2 + r_, j_ = q_ >> 4, h_ = q_ & 15;
#pragma unroll 1
          for (int ps = 0; ps < 2; ++ps) mla::unit(T, ps, h_, ps == 0 ? x_ + 8 * j_ : (7 - x_) + 8 * (3 - j_), lds + RING_OFF); } }
    xcd_barrier(bar);
    CKPT(4, 260, 324);

#if defined(DBG_CHECK) && (DBG_CHECK == 1 || DBG_CHECK == 2 || DBG_CHECK == 4)
    {
        float* dbgw = (float*)(WSP(unsigned, WS_CTL) + 200000);
        LAS float* lgs = (LAS float*)lds; LAS float* red = (LAS float*)(lds + 65536); LAS float* aux = (LAS float*)(lds + 69632);
        for (int smp = bx; smp < (DBG_CHECK == 4 ? 256 : 512); smp += G) {
#if DBG_CHECK == 2
            chk::mla(WSP(bf16, WS_QN), DOP(bf16, DO_QR), WSP(bf16, WS_KN), DOP(bf16, DO_KR), WSP(bf16, WS_VB), WSP(bf16, DBG_OB), smp, lgs, red, aux, dbgw, TID());
#else
            chk::dsa<(DBG_CHECK == 4)>(INP(0), INP(2), DOP(bf16, DO_QI), DOP(bf16, DO_KI), DOP(float, DO_WI), WSP(bf16, WS_QA), DOP(bf16, DO_KA), DOP(bf16, DO_VA), WSP(bf16, DBG_OA), DBG_SEL, smp, lgs, red, aux, dbgw, TID());
#endif
        }
        xcd_barrier(bar);
        const float X = __hip_atomic_load(dbgw + DBG_WORD, RLX_AGENT) * 1e8f; float* o_ = outb();
        for (size_t i = GT(); i < (size_t)M * DM / 4; i += NT) *((GAS f32x4*)o_ + i) = (f32x4){X, X, X, X};
        return;
    }
#endif
    STAMP(5);
    if (PH(5)) { EpiB<1> E{WSP(bf16, WS_G), 4096, nullptr, nullptr, nullptr}; GEMM_PHASE_X(EpiB<1>, WSP(bf16, WS_XF8), WSP(bf16, WS_WG), 4096, 1024, E, 2, 127 - 6); }
    xcd_barrier(bar);
    CKPT(5, 356, 484); CKPT(6, 182, 256); CKPT(7, 324, 348);
#if defined(DBG_CHECK) && DBG_CHECK == 10
    {
        unsigned* dw = WSP(unsigned, WS_CTL) + 200000; const bf16* Gp = WSP(bf16, WS_G);
        unsigned cntb = 0u, rmax = 0u, rmin = 255u, pnmax = 0u, pnmin = 15u, r16 = 0u, nnan = 0u, pmaxb = 0u, pminb = 63u; float vmax = 0.f;
        for (int s_ = 0; s_ < 8; ++s_) { const int pnl = own_panel(vcu >> 5, s_);
            for (int e = (vcu & 31) * 512 + (int)TID(); e < 256 * 4096 / 8; e += 32 * 512) { const int r = e / 512, c8 = e % 512; const v4u w = *(const GAS v4u*)(Gp + ((size_t)pnl * 256 + r) * 4096 + c8 * 8); f32x4 a, b; unpack8(w, a, b);
                bool bad = false;
#pragma unroll
                for (int j = 0; j < 4; ++j) { bad |= !(a[j] >= 0.f && a[j] <= 1.001f); bad |= !(b[j] >= 0.f && b[j] <= 1.001f); }
                if (bad) { for (int j = 0; j < 4; ++j) { if (a[j] == a[j] && fabsf(a[j]) < 1e30f) vmax = fmaxf(vmax, fabsf(a[j])); else ++nnan; if (b[j] == b[j] && fabsf(b[j]) < 1e30f) vmax = fmaxf(vmax, fabsf(b[j])); else ++nnan; } pmaxb = max(pmaxb, (unsigned)pnl); pminb = min(pminb, (unsigned)pnl);
                    ++cntb; rmax = max(rmax, (unsigned)r); rmin = min(rmin, (unsigned)r); pnmax = max(pnmax, (unsigned)(c8 / 32)); pnmin = min(pnmin, (unsigned)(c8 / 32)); r16 |= 1u << (r & 15); } } }
        if (cntb) { atomicAdd(dw + 0, cntb); atomicMax(dw + 1, rmax + 1u); atomicMax(dw + 2, 256u - rmin); atomicMax(dw + 3, pnmax + 1u); atomicMax(dw + 4, 16u - pnmin); atomicOr(dw + 5, r16); atomicMax(dw + 6, (unsigned)vmax); atomicAdd(dw + 7, nnan); atomicMax(dw + 8, pmaxb + 1u); atomicMax(dw + 9, 64u - pminb); }
        xcd_barrier(bar);
        const float X = (float)__hip_atomic_load(dw + DBG_WORD, RLX_AGENT) * 1e8f; float* o_ = outb();
        for (size_t i = GT(); i < (size_t)M * DM / 4; i += NT) *((GAS f32x4*)o_ + i) = (f32x4){X, X, X, X};
        return;
    }
#endif
#if defined(DBG_CHECK) && DBG_CHECK == 9
    {   float* dbgw = (float*)(WSP(unsigned, WS_CTL) + 200000);
        LAS float* xr = (LAS float*)lds; LAS float* red = (LAS float*)(lds + 65536);
        { const size_t row_ = (size_t)256 * own_panel(vcu >> 5, vcu & 7) + (((unsigned)vcu * 2654435761u) >> 9) % 256;
          chk::gchk(INP(0), INP(2), WSP(bf16, WS_G), WSP(bf16, WS_XB), row_, xr, red, dbgw, TID()); }
        xcd_barrier(bar);
        const float X = __hip_atomic_load(dbgw + DBG_WORD, RLX_AGENT) * 1e8f; float* o_ = outb();
        for (size_t i = GT(); i < (size_t)M * DM / 4; i += NT) *((GAS f32x4*)o_ + i) = (f32x4){X, X, X, X};
        return;
    }
#endif

    STAMP(6);
    if (PH(7)) { EpiB<2> E{WSP(bf16, WS_MT), 2048, WSP(bf16, WS_G), nullptr, nullptr}; GEMM_PHASE_L(EpiB<2>, WSP(bf16, WS_QA), WSP(bf16, WS_WA), 2048, 1024, E, 2, 127 - 6, 2048); }
    if (PH(7)) { EpiB<5> E{WSP(bf16, WS_MT), 2048, (const bf16*)(WSP(unsigned char, WS_G) + 2048), nullptr, WSP(unsigned char, WS_MG8)}; GEMM_PHASE_X(EpiB<5>, DOP(bf16, DO_AB8), WSP(bf16, WS_WB), 2048, 1024, E, 2, 127 - 6); }
    xcd_barrier(bar);
    CKPT(8, 54, 118);

    STAMP(7);
    if (PH(8)) { EpiF<0> E{WSP(bf16, WS_X1B), INP(0), nullptr}; GEMM_PHASE_X(EpiF<0>, WSP(bf16, WS_MG8), WSP(bf16, WS_WO), 2048, 1024, E, 2, 127 - 6); }
    xcd_barrier(bar);
#if defined(DBG_CHECK) && DBG_CHECK == 7
    {   float* dbgw = (float*)(WSP(unsigned, WS_CTL) + 200000);
        LAS float* va = (LAS float*)lds; LAS float* red = (LAS float*)(lds + 65536); LAS float* mg = (LAS float*)(lds + 69632);
        { const size_t row_ = (size_t)256 * own_panel(vcu >> 5, vcu & 7) + (((unsigned)vcu * 2654435761u) >> 9) % 256;
          chk::mid(INP(0), INP(2), INP(8), INP(9), INP(10), WSP(bf16, WS_QA), WSP(bf16, WS_QN), WSP(bf16, WS_G), WSP(bf16, WS_MT), outb(), row_, vcu, va, red, mg, dbgw, TID()); }
        xcd_barrier(bar);
        const float X = __hip_atomic_load(dbgw + DBG_WORD, RLX_AGENT) * 1e8f; float* o_ = outb();
        for (size_t i = GT(); i < (size_t)M * DM / 4; i += NT) *((GAS f32x4*)o_ + i) = (f32x4){X, X, X, X};
        return;
    }
#endif
    if (PH(9)) { bf16* z_ = WSP(bf16, WS_X1B); ln_pass(z_, nullptr, z_, WSP(unsigned char, WS_X1F8), INP(11), INP(12), vcu, wave, LANE()); }
    xcd_barrier(bar);
    CKPT(9, 118, 182);

    STAMP(8);
    if (PH(10)) { EpiUp E{WSP(unsigned char, WS_ACT), WSP(float, WS_HEAD), WSP(float, WS_TAIL), INP(14), INP(15)}; GEMM_PHASE_X(EpiUp, WSP(bf16, WS_X1F8), WSP(bf16, WS_WUP), NUP, 1024, E, 2, 127 - 6); }
    xcd_barrier(bar);
    CKPT(10, 260, 484);

    STAMP(9);
    if (PH(11)) conv_fixup(WSP(unsigned char, WS_ACT), WSP(float, WS_HEAD), WSP(float, WS_TAIL), INP(14), INP(15), vcu, TID());
    if (PH(12)) { EpiB<0> E{WSP(bf16, WS_PEO), 2048, nullptr, nullptr, nullptr}; GEMM_PHASE(EpiB<0>, WSP(bf16, WS_PB), WSP(bf16, WS_WPE), 2048, 256, E); }
    if (PH(15)) { EpiB<4> E{WSP(bf16, WS_PEO), 2048, nullptr, INP(18), nullptr}; GEMM_PHASE_X(EpiB<4>, WSP(bf16, WS_X1F8), WSP(bf16, WS_WPG), 2048, 1024, E, 2, 127 - 6); }
    xcd_barrier(bar);
    CKPT(11, 54, 118); CKPT(12, 308, 484);

    STAMP(10);
    if (PH(13)) { EpiF<1> E{WSP(bf16, WS_X1B), nullptr, WSP(bf16, WS_PEO)}; GEMM_PHASE_X(EpiF<1>, WSP(bf16, WS_ACT), WSP(bf16, WS_WDN), 2048, DFF / 2, E, 2, 127 - 7); }
    xcd_barrier(bar);
    if (PH(14)) { ln_pass(WSP(bf16, WS_X1B), outb(), nullptr, nullptr, INP(20), INP(21), vcu, wave, LANE()); }
#if defined(DBG_SPIN)
    STAMP(11);
    if (threadIdx.x == 0 && vcu == DBG_VCU) { const unsigned long long a_ = ((unsigned long long)MISC[17 + 2 * (DBG_SPIN % 100)] << 32) | MISC[16 + 2 * (DBG_SPIN % 100)], b_ = ((unsigned long long)MISC[17 + 2 * (DBG_SPIN % 100 + DBG_SPAN)] << 32) | MISC[16 + 2 * (DBG_SPIN % 100 + DBG_SPAN)];
        const unsigned long long ca_ = ((unsigned long long)MISC[101 + 2 * (DBG_SPIN % 100)] << 32) | MISC[100 + 2 * (DBG_SPIN % 100)], cb_ = ((unsigned long long)MISC[101 + 2 * (DBG_SPIN % 100 + DBG_SPAN)] << 32) | MISC[100 + 2 * (DBG_SPIN % 100 + DBG_SPAN)];
        const unsigned long long t0_ = __builtin_amdgcn_s_memrealtime(), w_ = DBG_SPIN >= 200 ? (cb_ - ca_) / 20ull : DBG_SPIN >= 100 ? 4ull * MISC[64 + (DBG_SPIN - 100)] : 4ull * (b_ - a_); while (__builtin_amdgcn_s_memrealtime() - t0_ < w_) __builtin_amdgcn_s_sleep(8); }
#endif
#if defined(DBG_CHECK) && DBG_CHECK == 8
    {   xcd_barrier(bar);
        float* dbgw = (float*)(WSP(unsigned, WS_CTL) + 200000);
        LAS float* xs = (LAS float*)lds; LAS float* red = (LAS float*)(lds + 65536); LAS float* act = (LAS float*)(lds + 69632);
        for (int smp = bx; smp < 256; smp += G) chk::endp(WSP(bf16, WS_X1B), nullptr, INP(1), INP(13), INP(14), INP(15), INP(16), INP(17), INP(18), INP(19), INP(20), INP(21), outb(), smp, xs, red, act, dbgw, TID());
        xcd_barrier(bar);
        const float X = __hip_atomic_load(dbgw + DBG_WORD, RLX_AGENT) * 1e8f; float* o_ = outb();
        for (size_t i = GT(); i < (size_t)M * DM / 4; i += NT) *((GAS f32x4*)o_ + i) = (f32x4){X, X, X, X};
    }
#endif
}

extern "C" void kernel_launch(void* const* d_in, const int* in_sizes, int n_in, void* d_out, int out_size, void* d_ws, size_t ws_size, hipStream_t stream) {
    static int grid = 0;
    if (grid == 0) {
        if (n_in != 22 || in_sizes[0] != M * DM || out_size != M * DM || ws_size < WS_END) { fprintf(stderr, "kernel_launch: unexpected shapes (n_in %d, in0 %d, out %d, ws %zu); nothing launched\n", n_in, n_in > 0 ? in_sizes[0] : -1, out_size, ws_size); grid = -1; return; }
        int dev = 0, cus = 0, per_cu = 0;
        if (hipGetDevice(&dev) != hipSuccess || hipDeviceGetAttribute(&cus, hipDeviceAttributeMultiprocessorCount, dev) != hipSuccess) { grid = -1; return; }
        if (hipFuncSetAttribute((const void*)fwd_kernel, hipFuncAttributeMaxDynamicSharedMemorySize, LDS_BYTES) != hipSuccess) { fprintf(stderr, "kernel_launch: hipFuncSetAttribute failed\n"); grid = -1; return; }
        if (hipOccupancyMaxActiveBlocksPerMultiprocessor(&per_cu, (const void*)fwd_kernel, NWAVES * 64, LDS_BYTES) != hipSuccess || per_cu < 1) { fprintf(stderr, "kernel_launch: occupancy query reports %d workgroups per CU\n", per_cu); }
        (void)hipGetLastError();
        grid = cus;
    }
    if (grid < 0) return;
    if (hipMemsetAsync((char*)d_ws + WS_CTL, 0, CTL_ZERO_BYTES, stream) != hipSuccess) return;
    Args a{};
    for (int i = 0; i < 22; ++i) a.in[i] = (const float*)d_in[i];
    a.out = (float*)d_out; a.ws = (unsigned char*)d_ws;
    hipLaunchKernelGGL(fwd_kernel, dim3(grid), dim3(NWAVES * 64), LDS_BYTES, stream, a);
}
```

```cpp
#include <hip/hip_runtime.h>
#include <cstdio>
#include <cstdint>
namespace pg8 {
#define PG8_LAS __attribute__((address_space(3)))
typedef unsigned short bf16_t;
typedef short bf16x8 __attribute__((ext_vector_type(8)));
typedef float f32x4 __attribute__((ext_vector_type(4)));
typedef unsigned u32x4 __attribute__((ext_vector_type(4)));
constexpr int BM = 256, BK = 64, HALF = 128, HTB = HALF * BK * 2  , STAGE_BYTES = 8 * HTB, NXCD = 8, WGM = 8;

__host__ __device__ __forceinline__ int lds_byte(int r, int c) { const int st = (r >> 4) * 2 + (c >> 5), rr = r & 15, cc = c & 31, ob = rr * 64 + cc * 2; return st * 1024 + (ob ^ (((ob >> 9) & 1) << 5)); }
__host__ __device__ __forceinline__ void stage_rc(int b, int& R, int& C) { const int st = b / 1024, sb = b % 1024, swz = sb ^ (((sb >> 9) & 1) << 5); R = (st >> 1) * 16 + swz / 64; C = (st & 1) * 32 + (swz % 64) / 2; }
__host__ __device__ __forceinline__ int perm32(int rho) { const int n = rho >> 4, i = rho & 15; return 8 * (i >> 2) + 4 * n + (i & 3); }

struct Unit { int pm, pn; };
struct Gemm { const bf16_t* A; const bf16_t* Bt; int M, N, K; int wscale; int lda; };
typedef int i32x4 __attribute__((ext_vector_type(4))); typedef int i32x8 __attribute__((ext_vector_type(8)));
typedef _Float16 f16x8 __attribute__((ext_vector_type(8)));

struct StaticOrder {
    int nM, nN, nwg, G, c;
    __host__ __device__ void init(int M, int N, int G_, int c_) { nM = M / BM; nN = N / BM; nwg = nM * nN; G = G_; c = c_; }
    __host__ __device__ bool next(int i, Unit& u) const {
        const long L = (long)i * G + c; if (L >= nwg) return false;
        int wgid = (int)L; { const int q = nwg / NXCD, r = nwg % NXCD, xcd = wgid % NXCD, off = wgid / NXCD; wgid = (xcd < r ? xcd * (q + 1) : r * (q + 1) + (xcd - r) * q) + off; }
        const int nig = WGM * nN, gid = wgid / nig, fm = gid * WGM, gsz = (nM - fm) < WGM ? (nM - fm) : WGM;
        u.pm = fm + ((wgid % nig) % gsz); u.pn = (wgid % nig) / gsz;
        { const int x = u.pm >> 3, s = u.pm & 7; u.pm = s < 4 ? x + 8 * s : 32 + (7 - x) + 8 * (s - 4); }
        return true;
    }
    __device__ __forceinline__ void a_ready(const Unit&) const {}
    __device__ __forceinline__ void done(const Unit&) const {}
};

typedef float f32x2c_t __attribute__((ext_vector_type(2))); typedef __bf16 bf16x2c_t __attribute__((ext_vector_type(2)));
__device__ __forceinline__ unsigned cvt_pk_bf16(float lo, float hi) { const f32x2c_t v = {lo, hi}; const bf16x2c_t b = __builtin_convertvector(v, bf16x2c_t); return __builtin_bit_cast(unsigned, b); }
typedef float f32x2 __attribute__((ext_vector_type(2)));
template <class Epi, class Sched, bool ALIGN_EPI = false, bool SP2 = false, int DT = 0  >
__device__ __forceinline__ void gemm_phase(PG8_LAS unsigned char* lds, const Gemm g, const Sched& S, const Epi& E) {
    int tid_o_ = threadIdx.x; asm volatile("" : "+v"(tid_o_));
    const int tid = tid_o_, wid = __builtin_amdgcn_readfirstlane(tid >> 6), lane = tid & 63, wr = wid >> 2, wc = wid & 3, fr = lane & 15, fq = lane >> 4;
    const int K = g.K, nt = K / BK, lda = g.lda ? g.lda : g.K;
    unsigned voffA[2], voffB[2];
#pragma unroll
    for (int i = 0; i < 2; ++i) { int R, C; stage_rc(tid * 16 + i * 8192, R, C); const int Rb = Epi::PERM ? ((R & ~31) + perm32(R & 31)) : R;
        voffA[i] = (unsigned)(R * lda + C) * 2u; voffB[i] = (unsigned)(Rb * K + C) * 2u; }
    const size_t kstep = (size_t)(BK * 2);
    const size_t hstep = (size_t)HALF * K * 2;
    const size_t tstep = 2 * hstep;
    const size_t hstepA = (size_t)HALF * lda * 2, tstepA = 2 * hstepA;
    const unsigned ldsw = (unsigned)wid * 1024u;
    const int aoff = lds_byte(wr * 64 + fr, fq * 8), boff = lds_byte(wc * 32 + fr, fq * 8);
#define PG8_SA(b, h) (((b) * 2 + (h)) * HTB)
#define PG8_SB(b, h) ((4 + (b) * 2 + (h)) * HTB)
#define PG8_STAGE(bufoff, gbase, voff) do { _Pragma("unroll") for (int _i = 0; _i < 2; ++_i) \
        __builtin_amdgcn_global_load_lds((const unsigned*)((const char*)(gbase) + (voff)[_i]), (PG8_LAS unsigned*)(lds + (bufoff) + ldsw + _i * 8192), 16, 0, 0); } while (0)
#define PG8_LD16A(off_) (*(const PG8_LAS i32x4*)(abase8 + (off_)))
#define PG8_LD16B(off_) (*(const PG8_LAS i32x4*)(bbase8 + ((off_) - 65536)))
#define PG8_LDA(dst, b, h) do { if constexpr (DT == 2) { _Pragma("unroll") for (int m = 0; m < 4; ++m) dst##8[m] = __builtin_shufflevector(PG8_LD16A(PG8_SA(b, h) + m * 2048), PG8_LD16A(PG8_SA(b, h) + m * 2048 + 1024), 0, 1, 2, 3, 4, 5, 6, 7); } \
        else { _Pragma("unroll") for (int m = 0; m < 4; ++m) _Pragma("unroll") for (int k = 0; k < 2; ++k) dst[m][k] = *(const PG8_LAS bf16x8*)(lds + PG8_SA(b, h) + aoff + m * 2048 + k * 1024); } } while (0)
#define PG8_LDB(dst, b, h) do { if constexpr (DT == 2) { _Pragma("unroll") for (int n = 0; n < 2; ++n) dst##8[n] = __builtin_shufflevector(PG8_LD16B(PG8_SB(b, h) + n * 2048), PG8_LD16B(PG8_SB(b, h) + n * 2048 + 1024), 0, 1, 2, 3, 4, 5, 6, 7); } \
        else { _Pragma("unroll") for (int n = 0; n < 2; ++n) _Pragma("unroll") for (int k = 0; k < 2; ++k) dst[n][k] = *(const PG8_LAS bf16x8*)(lds + PG8_SB(b, h) + boff + n * 2048 + k * 1024); } } while (0)
#define PG8_MMA(ai, bj, At, Bt) do { __builtin_amdgcn_s_setprio(1); _Pragma("unroll") for (int m = 0; m < 4; ++m) _Pragma("unroll") for (int n = 0; n < 2; ++n) { \
        if constexpr (DT == 2) asm volatile("v_mfma_scale_f32_16x16x128_f8f6f4 %0, %1, %2, %0, %3, %4 op_sel_hi:[0,0,0]" : "+v"(acc[ai][bj][m][n]) : "v"(Bt##8[n]), "v"(At##8[m]), "v"(sclw), "v"(scla));   \
        else { _Pragma("unroll") for (int k = 0; k < 2; ++k) { \
        if constexpr (DT == 1) acc[ai][bj][m][n] = __builtin_amdgcn_mfma_f32_16x16x32_f16(__builtin_bit_cast(f16x8, Bt[n][k]), __builtin_bit_cast(f16x8, At[m][k]), acc[ai][bj][m][n], 0, 0, 0); \
        else acc[ai][bj][m][n] = __builtin_amdgcn_mfma_f32_16x16x32_bf16(Bt[n][k], At[m][k], acc[ai][bj][m][n], 0, 0, 0); } } } __builtin_amdgcn_s_setprio(0); } while (0)
#define PG8_WAIT_V(n) asm volatile("s_waitcnt vmcnt(" #n ")" ::: "memory")
#define PG8_WAIT_L(n) asm volatile("s_waitcnt lgkmcnt(" #n ")" ::: "memory")
#define PG8_BAR __builtin_amdgcn_s_barrier()
#define PG8_SCHED __builtin_amdgcn_sched_barrier(0)
    Unit cur, nxt; int ui = 0;
    if (!S.next(0, cur)) return;
    f32x4 acc[2][2][4][2];
#pragma unroll
    for (int a = 0; a < 2; ++a)
#pragma unroll
        for (int b = 0; b < 2; ++b)
#pragma unroll
            for (int m = 0; m < 4; ++m)
#pragma unroll
                for (int n = 0; n < 2; ++n) acc[a][b][m][n] = (f32x4){0.f, 0.f, 0.f, 0.f};
    const int sclw = g.wscale, scla = 127;
    unsigned abi_ = (unsigned)(uintptr_t)lds + (unsigned)aoff, bbi_ = (unsigned)(uintptr_t)lds + 65536u + (unsigned)boff; asm volatile("" : "+v"(abi_), "+v"(bbi_));
    const PG8_LAS unsigned char* abase8 = (const PG8_LAS unsigned char*)(uintptr_t)abi_; const PG8_LAS unsigned char* bbase8 = (const PG8_LAS unsigned char*)(uintptr_t)bbi_;
    bf16x8 At[4][2], B0[2][2], B1[2][2]; i32x8 At8[4], B08[2], B18[2];
    const char* cA = (const char*)g.A + (size_t)cur.pm * tstepA; const char* cB = (const char*)g.Bt + (size_t)cur.pn * tstep;
    S.a_ready(cur);
    if constexpr (SP2) {
        PG8_STAGE(PG8_SB(0, 0), cB, voffB); PG8_STAGE(PG8_SB(0, 1), cB + hstep, voffB); PG8_STAGE(PG8_SA(0, 0), cA, voffA); PG8_STAGE(PG8_SA(0, 1), cA + hstepA, voffA);
        if (wr == 1) PG8_BAR;
        PG8_WAIT_V(2); PG8_BAR;
        PG8_STAGE(PG8_SB(1, 0), cB + kstep, voffB); PG8_STAGE(PG8_SA(1, 0), cA + kstep, voffA); PG8_STAGE(PG8_SB(1, 1), cB + hstep + kstep, voffB);
        PG8_WAIT_V(6); PG8_BAR;
    } else {
        PG8_STAGE(PG8_SB(0, 0), cB, voffB); PG8_STAGE(PG8_SA(0, 0), cA, voffA); PG8_STAGE(PG8_SB(0, 1), cB + hstep, voffB); PG8_STAGE(PG8_SA(0, 1), cA + hstepA, voffA);
        if (wr == 1) PG8_BAR;
        PG8_WAIT_V(4); PG8_BAR;
        PG8_STAGE(PG8_SB(1, 0), cB + kstep, voffB); PG8_STAGE(PG8_SA(1, 0), cA + kstep, voffA); PG8_STAGE(PG8_SB(1, 1), cB + hstep + kstep, voffB);
        PG8_WAIT_V(6); PG8_BAR;
    }
    for (;;) {
        const bool has_next = S.next(ui + 1, nxt);
        const char* nA = has_next ? (const char*)g.A + (size_t)nxt.pm * tstepA : cA; const char* nB = has_next ? (const char*)g.Bt + (size_t)nxt.pn * tstep : cB;
        for (int t = 0; t < nt; t += 2) {
            const bool last = (t == nt - 2);
            const char* a1 = cA + (size_t)(t + 1) * kstep;
            const char* a2 = last ? nA : cA + (size_t)(t + 2) * kstep; const char* b2 = last ? nB : cB + (size_t)(t + 2) * kstep;
            const char* a3 = a2 + kstep; const char* b3 = b2 + kstep;
            if (last && has_next) S.a_ready(nxt);
            if constexpr (SP2) {
            PG8_LDB(B0, 0, 0); PG8_LDB(B1, 0, 1); PG8_SCHED; PG8_LDA(At, 0, 0); PG8_STAGE(PG8_SA(1, 1), a1 + hstepA, voffA);
            PG8_WAIT_V(8); PG8_WAIT_L(0); PG8_BAR; PG8_MMA(0, 0, At, B0); PG8_MMA(0, 1, At, B1); PG8_BAR; PG8_SCHED;
            PG8_LDA(At, 0, 1); PG8_STAGE(PG8_SB(0, 0), b2, voffB); PG8_STAGE(PG8_SB(0, 1), b2 + hstep, voffB); PG8_STAGE(PG8_SA(0, 0), a2, voffA);
            PG8_WAIT_V(8); PG8_WAIT_L(0); PG8_BAR; PG8_MMA(1, 0, At, B0); PG8_MMA(1, 1, At, B1); PG8_BAR; PG8_SCHED;
            PG8_LDB(B0, 1, 0); PG8_LDB(B1, 1, 1); PG8_SCHED; PG8_LDA(At, 1, 0); PG8_STAGE(PG8_SA(0, 1), a2 + hstepA, voffA);
            PG8_WAIT_V(8); PG8_WAIT_L(0); PG8_BAR; PG8_MMA(0, 0, At, B0); PG8_MMA(0, 1, At, B1); PG8_BAR; PG8_SCHED;
            PG8_LDA(At, 1, 1); PG8_STAGE(PG8_SB(1, 0), b3, voffB); PG8_STAGE(PG8_SB(1, 1), b3 + hstep, voffB); PG8_STAGE(PG8_SA(1, 0), a3, voffA);
            PG8_WAIT_V(8); PG8_WAIT_L(0); PG8_BAR; PG8_MMA(1, 0, At, B0); PG8_MMA(1, 1, At, B1); PG8_BAR; PG8_SCHED;
            } else {
            PG8_LDB(B0, 0, 0); PG8_SCHED; PG8_LDA(At, 0, 0); PG8_STAGE(PG8_SA(1, 1), a1 + hstepA, voffA);
            PG8_WAIT_L(8); PG8_BAR; PG8_WAIT_L(0); PG8_MMA(0, 0, At, B0); PG8_BAR; PG8_SCHED;
            PG8_LDB(B1, 0, 1); PG8_STAGE(PG8_SB(0, 0), b2, voffB);
            PG8_BAR; PG8_WAIT_L(0); PG8_MMA(0, 1, At, B1); PG8_BAR;
            PG8_LDA(At, 0, 1); PG8_STAGE(PG8_SA(0, 0), a2, voffA);
            PG8_BAR; PG8_WAIT_L(0); PG8_MMA(1, 0, At, B0); PG8_BAR; PG8_SCHED;
            PG8_STAGE(PG8_SB(0, 1), b2 + hstep, voffB);
            PG8_WAIT_V(6); PG8_BAR; PG8_MMA(1, 1, At, B1); PG8_BAR;
            PG8_LDB(B0, 1, 0); PG8_SCHED; PG8_LDA(At, 1, 0); PG8_STAGE(PG8_SA(0, 1), a2 + hstepA, voffA);
            PG8_WAIT_L(8); PG8_BAR; PG8_WAIT_L(0); PG8_MMA(0, 0, At, B0); PG8_BAR; PG8_SCHED;
            PG8_LDB(B1, 1, 1); PG8_STAGE(PG8_SB(1, 0), b3, voffB);
            PG8_BAR; PG8_WAIT_L(0); PG8_MMA(0, 1, At, B1); PG8_BAR;
            PG8_LDA(At, 1, 1); PG8_STAGE(PG8_SA(1, 0), a3, voffA);
            PG8_BAR; PG8_WAIT_L(0); PG8_MMA(1, 0, At, B0); PG8_BAR; PG8_SCHED;
            PG8_STAGE(PG8_SB(1, 1), b3 + hstep, voffB);
            PG8_WAIT_V(6); PG8_BAR; PG8_MMA(1, 1, At, B1); PG8_BAR;
            }
        }
        if constexpr (ALIGN_EPI) { if (wr == 0) PG8_BAR; }
        if constexpr (!Epi::AFTER_DRAIN) { E(acc, cur, wr, wc, fr, fq); S.done(cur); }
        if (!has_next) break;
#pragma unroll
        for (int a = 0; a < 2; ++a)
#pragma unroll
            for (int b = 0; b < 2; ++b)
#pragma unroll
                for (int m = 0; m < 4; ++m)
#pragma unroll
                    for (int n = 0; n < 2; ++n) acc[a][b][m][n] = (f32x4){0.f, 0.f, 0.f, 0.f};
        cur = nxt; cA = nA; cB = nB; ++ui;
        if constexpr (ALIGN_EPI) { if (wr == 1) PG8_BAR; }
    }
    PG8_WAIT_V(0);
    if constexpr (!ALIGN_EPI) { if (wr == 0) PG8_BAR; }
    PG8_BAR;
    if constexpr (Epi::AFTER_DRAIN) { E.fused(acc, cur, wr, wc, fr, fq, lds, wid, lane); S.done(cur); }
#undef PG8_SA
#undef PG8_SB
#undef PG8_STAGE
#undef PG8_LDA
#undef PG8_LD16A
#undef PG8_LD16B
#undef PG8_LDB
#undef PG8_MMA
#undef PG8_WAIT_V
#undef PG8_WAIT_L
#undef PG8_BAR
#undef PG8_SCHED
}
}

constexpr int NWAVES = 8;
constexpr int BATCH = 2, SEQ = 8192, DM = 2048, M = BATCH * SEQ;
constexpr int DIN = 8592, NU = 8704, NU1 = 4608;
constexpr int DFF = 5632, NUP = 2 * DFF, PLE_DIM = 256;
constexpr float LN_EPS = 1e-5f, RMS_EPS = 1e-6f;
constexpr float ALPHA = 1.189207115002721f;
constexpr float LOG2E = 1.4426950408889634f;
constexpr float QA_SCALE = 0.08838834764831845f * LOG2E;
constexpr float QB_SCALE = 0.07216878364870323f * LOG2E;
constexpr int U_QA = 0, U_KA = 2048, U_VA = 2176, U_QI = 2304, U_KI = 3328, U_WI = 3392, U_CQ = 3408, U_CKV = 3920, U_KPE = 4432, U_G = 4496;

constexpr size_t MiB = 1u << 20;
constexpr size_t WS_CTL = 0, CTL_ZERO_BYTES = 1 * MiB;
constexpr size_t WS_ROPE = 2 * MiB;
constexpr size_t WS_WIN = 4 * MiB;
constexpr size_t WS_WIN8 = 12 * MiB;
constexpr int NU16 = 1280, NU8 = 3328;
constexpr size_t WS_WUQ = 38 * MiB;
constexpr size_t WS_WKV = 41 * MiB;
constexpr size_t WS_WPE = 45 * MiB;
constexpr size_t WS_PB = 46 * MiB;
constexpr size_t WS_XB = 54 * MiB;
constexpr size_t WS_QA = 118 * MiB;
constexpr size_t WS_WUP = 182 * MiB, WS_WDN = 204 * MiB, WS_WPG = 215 * MiB;
constexpr size_t WS_WA = 223 * MiB, WS_WB = 227 * MiB, WS_WO = 231 * MiB, WS_WG = 235 * MiB;
constexpr size_t WS_QN = 260 * MiB;
constexpr size_t WS_XF8 = 324 * MiB;
constexpr size_t WS_MG8 = 292 * MiB;
constexpr size_t WS_KN = 356 * MiB, WS_VB = 420 * MiB;
constexpr size_t WS_G = 356 * MiB;
constexpr size_t WS_MT = WS_XB, WS_X1B = WS_QA, WS_PEO = WS_XB;
constexpr size_t WS_ACT = 320 * MiB;
constexpr size_t WS_X1F8 = 260 * MiB;
constexpr size_t WS_HEAD = 292 * MiB, WS_TAIL = 484 * MiB;
constexpr size_t DO_AB8 = 0 * MiB;
constexpr size_t DO_QI = 0 * MiB, DO_CQ = 32 * MiB, DO_CKV = 48 * MiB, DO_KA = 64 * MiB, DO_VA = 68 * MiB, DO_KI = 72 * MiB, DO_WI = 74 * MiB, DO_KR = 75 * MiB, DO_QR = 80 * MiB;
constexpr size_t WS_END = 506 * MiB;
constexpr int CW_TMO = 0, CW_CODE = 1, CW_BAR = 4096, CW_RANK = 32768, CW_JOB = 49152;
constexpr int CW_SSQ = 65536;

constexpr int RING_OFF = 0, RING_BYTES = 131072;
constexpr int IDL_OFF = 131072;
constexpr int LDSCTL_OFF = 147456, MISC_OFF = LDSCTL_OFF + 320;
constexpr int LDS_BYTES = 148480;
static_assert(MISC_OFF + 128 <= LDS_BYTES, "LDS map");
#define GAS __attribute__((address_space(1)))
#define LAS __attribute__((address_space(3)))
typedef unsigned short bf16;
typedef unsigned v4u __attribute__((ext_vector_type(4)));
typedef float f32x4 __attribute__((ext_vector_type(4)));
typedef short bf16x8 __attribute__((ext_vector_type(8)));
typedef GAS unsigned gu32;
typedef GAS unsigned long long gu64;
#define RLX_AGENT __ATOMIC_RELAXED, __HIP_MEMORY_SCOPE_AGENT
#define LDS_WAIT() asm volatile("s_waitcnt lgkmcnt(0)" ::: "memory")
#define VM_WAIT() asm volatile("s_waitcnt vmcnt(0)" ::: "memory")
__device__ __forceinline__ unsigned long long rt() { return __builtin_amdgcn_s_memrealtime(); }
__device__ __forceinline__ unsigned f2bf(float f) { unsigned u = __builtin_bit_cast(unsigned, f); return (u + 0x7fffu + ((u >> 16) & 1u)) >> 16; }
__device__ __forceinline__ unsigned pk2(float lo, float hi) { return f2bf(lo) | (f2bf(hi) << 16); }

#define XB_TMO      128
#define XB_XCNT(j)  (256  + 64 * (j))
#define XB_XSUB(j)  (1280 + 64 * (j))
#define XB_XGEN(j)  (2304 + 64 * (j))
#define XB_TOP      3328
#define XB_TOPGEN   3392
#define XCD_BAR_WORDS 3456
#define XB_SPIN_CAP (1u << 18)

__device__ __forceinline__ unsigned xb_ld(unsigned* p)              { return __hip_atomic_load(p, __ATOMIC_RELAXED, __HIP_MEMORY_SCOPE_AGENT); }
__device__ __forceinline__ unsigned xb_add(unsigned* p, unsigned v) { return __hip_atomic_fetch_add(p, v, __ATOMIC_RELAXED, __HIP_MEMORY_SCOPE_AGENT); }
__device__ __forceinline__ unsigned xb_xcc_id() { return (unsigned)__builtin_amdgcn_s_getreg((3 << 11) | 20) & 0xFu; }
#define XB_SPIN(cond, bar) do { unsigned _sp = 0; while (cond) { __builtin_amdgcn_s_sleep(1); \
    if ((++_sp & 255u) == 0u) { if (xb_ld(&(bar)[XB_TMO])) break; if (_sp > XB_SPIN_CAP) { atomicAdd(&(bar)[XB_TMO], 1u); break; } } } } while (0)

struct XcdBarrier {
    unsigned* bar; unsigned x;
    volatile LAS unsigned* st;
};

__device__ __forceinline__ XcdBarrier xcd_barrier_post(unsigned* bar, volatile LAS unsigned* st) {
    XcdBarrier b; b.bar = bar; b.x = xb_xcc_id(); b.st = st;
    if (threadIdx.x == 0) (void)xb_add(&bar[XB_XCNT(b.x)], 1u);
    return b;
}
__device__ __forceinline__ void xcd_barrier_complete(unsigned* bar, unsigned x, unsigned& nloc, unsigned& nx) {
    const unsigned G = gridDim.x * gridDim.y * gridDim.z;
    unsigned sum, cnt, mine, sp = 0u;
    for (;;) {
        sum = 0u; cnt = 0u; mine = 0u;
#pragma unroll
        for (unsigned j = 0; j < 16; ++j) { const unsigned c = xb_ld(&bar[XB_XCNT(j)]); sum += c; cnt += (c > 0u) ? 1u : 0u; mine = (j == x) ? c : mine; }
        if (sum == G) break;
        __builtin_amdgcn_s_sleep(1);
        if ((++sp & 255u) == 0u) { if (xb_ld(&bar[XB_TMO])) break; if (sp > XB_SPIN_CAP) { atomicAdd(&bar[XB_TMO], 1u); break; } }
    }
    nloc = mine > 0u ? mine : 1u; nx = cnt > 0u ? cnt : 1u;
}

__device__ __forceinline__ void xcd_barrier(const XcdBarrier& b) {
    asm volatile("s_waitcnt vmcnt(0)" ::: "memory");
    __syncthreads();
    if (threadIdx.x == 0) {
        unsigned* bar = b.bar;
        __builtin_amdgcn_s_waitcnt(0);
        unsigned nloc = b.st[0], nx = b.st[1];
        if (nloc == 0u) { xcd_barrier_complete(bar, b.x, nloc, nx); b.st[0] = nloc; b.st[1] = nx; }
        const unsigned old = xb_add(&bar[XB_XSUB(b.x)], 1u);
        const unsigned gen = old / nloc;
        if (old + 1u == (gen + 1u) * nloc) {
            __builtin_amdgcn_fence(__ATOMIC_RELEASE, "agent");
            asm volatile("s_waitcnt vmcnt(0)" ::: "memory");
            const unsigned og = xb_add(&bar[XB_TOP], 1u);
            const unsigned tg = og / nx;
            if (og + 1u == (tg + 1u) * nx) xb_add(&bar[XB_TOPGEN], 1u);
            else XB_SPIN(xb_ld(&bar[XB_TOPGEN]) == tg, bar);
            __builtin_amdgcn_fence(__ATOMIC_ACQUIRE, "agent");
            xb_add(&bar[XB_XGEN(b.x)], 1u);
            asm volatile("s_waitcnt vmcnt(0)" ::: "memory");
        } else {
            XB_SPIN(xb_ld(&bar[XB_XGEN(b.x)]) == gen, bar);
            __builtin_amdgcn_fence(__ATOMIC_ACQUIRE, "agent");
            asm volatile("s_waitcnt vmcnt(0)" ::: "memory");
        }
    }
    __syncthreads();
}

typedef unsigned u32x2 __attribute__((ext_vector_type(2)));
typedef float f32x16 __attribute__((ext_vector_type(16)));
typedef short s16x4 __attribute__((ext_vector_type(4)));
using pg8::cvt_pk_bf16;
__device__ __forceinline__ v4u pack8(f32x4 a, f32x4 b) { v4u w; w.x = cvt_pk_bf16(a[0], a[1]); w.y = cvt_pk_bf16(a[2], a[3]); w.z = cvt_pk_bf16(b[0], b[1]); w.w = cvt_pk_bf16(b[2], b[3]); return w; }
__device__ __forceinline__ u32x2 pack4(f32x4 a) { u32x2 w; w.x = cvt_pk_bf16(a[0], a[1]); w.y = cvt_pk_bf16(a[2], a[3]); return w; }
__device__ __forceinline__ float bflo(unsigned u) { return __uint_as_float(u << 16); }
__device__ __forceinline__ float bfhi(unsigned u) { return __uint_as_float(u & 0xffff0000u); }
__device__ __forceinline__ void unpack8(v4u w, f32x4& a, f32x4& b) { a = (f32x4){bflo(w.x), bfhi(w.x), bflo(w.y), bfhi(w.y)}; b = (f32x4){bflo(w.z), bfhi(w.z), bflo(w.w), bfhi(w.w)}; }
typedef _Float16 f16x2 __attribute__((ext_vector_type(2)));
using pg8::f16x8;
__device__ __forceinline__ unsigned pkh(float a, float b) { const f16x2 v = {(_Float16)a, (_Float16)b}; return __builtin_bit_cast(unsigned, v); }
__device__ __forceinline__ v4u pack8h(f32x4 a, f32x4 b) { v4u w; w.x = pkh(a[0], a[1]); w.y = pkh(a[2], a[3]); w.z = pkh(b[0], b[1]); w.w = pkh(b[2], b[3]); return w; }
__device__ __forceinline__ void unpack8h(v4u w, f32x4& a, f32x4& b) { const f16x8 h = __builtin_bit_cast(f16x8, w); a = (f32x4){(float)h[0], (float)h[1], (float)h[2], (float)h[3]}; b = (f32x4){(float)h[4], (float)h[5], (float)h[6], (float)h[7]}; }
__device__ __forceinline__ unsigned pkf8(float a, float b, float c, float d) { int w = 0; w = __builtin_amdgcn_cvt_pk_fp8_f32(a, b, w, false); w = __builtin_amdgcn_cvt_pk_fp8_f32(c, d, w, true); return (unsigned)w; }
__device__ __forceinline__ float sigmoidf_(float x) { return __builtin_amdgcn_rcpf(1.0f + __builtin_amdgcn_exp2f(-LOG2E * x)); }
__device__ __forceinline__ f32x4 sigmoid4(f32x4 x) { return (f32x4){sigmoidf_(x[0]), sigmoidf_(x[1]), sigmoidf_(x[2]), sigmoidf_(x[3])}; }
__device__ __forceinline__ float sum_x16(float v) { auto r = __builtin_amdgcn_permlane16_swap(__float_as_uint(v), __float_as_uint(v), false, false); return __uint_as_float(r[0]) + __uint_as_float(r[1]); }
__device__ __forceinline__ float sum_x32(float v) { auto r = __builtin_amdgcn_permlane32_swap(__float_as_uint(v), __float_as_uint(v), false, false); return __uint_as_float(r[0]) + __uint_as_float(r[1]); }
__device__ __forceinline__ float max_x16(float v) { auto r = __builtin_amdgcn_permlane16_swap(__float_as_uint(v), __float_as_uint(v), false, false); return fmaxf(__uint_as_float(r[0]), __uint_as_float(r[1])); }
__device__ __forceinline__ float max_x32(float v) { auto r = __builtin_amdgcn_permlane32_swap(__float_as_uint(v), __float_as_uint(v), false, false); return fmaxf(__uint_as_float(r[0]), __uint_as_float(r[1])); }
template <int CTRL> __device__ __forceinline__ float dppf(float v) { return __int_as_float(__builtin_amdgcn_update_dpp(0, __float_as_int(v), CTRL, 0xf, 0xf, false)); }
__device__ __forceinline__ float wave_sum(float v) {
    v += dppf<0xB1>(v); v += dppf<0x4E>(v); v += dppf<0x141>(v); v += dppf<0x140>(v);
    return sum_x32(sum_x16(v));
}
__device__ __forceinline__ int rope_perm(int pc) { const int g = pc >> 3, e = pc & 7; return e < 4 ? 4 * g + e : 32 + 4 * g + (e - 4); }
template <int MAP> __device__ __forceinline__ int srcmap(int n) {
    if (MAP == 0) return n;
    if (MAP == 1) {
        if (n < 2048) return U_QA + n;
        if (n < 3072) return U_QI + (n - 2048);
        if (n < 3200) return U_KA + (n - 3072);
        if (n < 3328) return U_VA + (n - 3200);
        if (n < 3584) { const int o = n - 3328; if (o < 64) return U_KI + o; if (o < 128) return U_KPE + rope_perm(o - 64); if (o < 144) return U_WI + (o - 128); return -1; }
        if (n < 4096) return U_CQ + (n - 3584);
        if (n < 4608) return U_CKV + (n - 4096);
        return U_G + (n - 4608);
    }
    if (MAP == 2) {
        if (n < 2048) return (n >> 7) * 192 + (n & 127);
        const int o = n - 2048; return (o >> 6) * 192 + 128 + rope_perm(o & 63);
    }
    { const int pn = n >> 8, o = n & 255; return o < 128 ? pn * 128 + o : DFF + pn * 128 + (o - 128); }
}
constexpr int TR_LDS = 64 * 68 * 4;
__device__ __forceinline__ void tr_item(const float* W, int ldw, const float* gk, bf16* WT, int K, int k0, int drow0, int srccol4, LAS float* scr, int lane, bool h16) {
    const int c4 = (lane & 15) * 4;
#pragma unroll 8
    for (int i = 0; i < 16; ++i) { const int kk = 4 * i + (lane >> 4); f32x4 v = (f32x4){0.f, 0.f, 0.f, 0.f};
        if (srccol4 >= 0) { v = *(const GAS f32x4*)(W + (size_t)(k0 + kk) * ldw + srccol4); if (gk) v = v * gk[k0 + kk]; }
        *(LAS f32x4*)(scr + kk * 68 + c4) = v; }
    LDS_WAIT(); asm volatile("" ::: "memory");
    bf16* orow = WT + (size_t)(drow0 + lane) * K + k0;
#pragma unroll
    for (int k8 = 0; k8 < 8; ++k8) { const LAS float* s = scr + (8 * k8) * 68 + lane;
        v4u o; if (h16) { o.x = pkh(s[0 * 68], s[1 * 68]); o.y = pkh(s[2 * 68], s[3 * 68]); o.z = pkh(s[4 * 68], s[5 * 68]); o.w = pkh(s[6 * 68], s[7 * 68]); }
        else { o.x = pk2(s[0 * 68], s[1 * 68]); o.y = pk2(s[2 * 68], s[3 * 68]); o.z = pk2(s[4 * 68], s[5 * 68]); o.w = pk2(s[6 * 68], s[7 * 68]); }
        *(GAS v4u*)(orow + 8 * k8) = o; }
    LDS_WAIT(); asm volatile("" ::: "memory");
}
struct TrIn { const float *w_in, *gq, *gkv, *w_uq, *w_uk, *w_uv, *w_a, *w_b, *w_o, *w_up, *w_dn, *w_pg, *w_pe; };
struct TrItem { const float* W; const float* gk; bf16* WT; int ldw, K, k0, drow0, srccol4, mode; float wmul; };
constexpr int TR_E0 = 32 * 72, TR_E1 = TR_E0 + 8 * 48, TR_E2 = TR_E1 + 8 * 32, TR_E3 = TR_E2 + 8 * 32, TR_E4 = TR_E3 + 4 * 32, TR_E5 = TR_E4 + 1024, TR_E6 = TR_E5 + 1024, TR_E7 = TR_E6 + 1024, TR_E8 = TR_E7 + 1024,
              TR_E9 = TR_E8 + 32 * 176, TR_E10 = TR_E9 + 88 * 32, TR_E11 = TR_E10 + 32 * 64;
__device__ __forceinline__ TrItem tr_decode(const TrIn& I, unsigned char* ws, int it, int lane) {
    TrItem t; int r, nblk, map = 0; t.gk = nullptr; t.mode = 0; t.wmul = 1.f; int rowoff = 0;
    if (it < 32 * 20) { r = it; nblk = 20; t.W = I.w_in; t.ldw = DIN; t.WT = (bf16*)(ws + WS_WIN); t.K = 2048; map = 5; t.mode = 1; }
    else if (it < TR_E0) { r = it - 32 * 20; nblk = 52; t.W = I.w_in; t.ldw = DIN; t.WT = (bf16*)(ws + WS_WIN8); t.K = 2048; map = 6; t.mode = 2; t.wmul = 64.f; }
    else if (it < TR_E1) { r = it - TR_E0; nblk = 48; t.W = I.w_uq; t.ldw = 3072; t.WT = (bf16*)(ws + WS_WUQ); t.K = 512; map = 2; t.gk = I.gq; t.mode = 2; t.wmul = 32.f; }
    else if (it < TR_E2) { r = it - TR_E1; nblk = 32; t.W = I.w_uk; t.ldw = 2048; t.WT = (bf16*)(ws + WS_WKV); t.K = 512; t.gk = I.gkv; t.mode = 2; t.wmul = 32.f; }
    else if (it < TR_E3) { r = it - TR_E2; nblk = 32; t.W = I.w_uv; t.ldw = 2048; t.WT = (bf16*)(ws + WS_WKV); t.K = 512; t.gk = I.gkv; rowoff = 2048; t.mode = 2; t.wmul = 32.f; }
    else if (it < TR_E4) { r = it - TR_E3; nblk = 32; t.W = I.w_pe; t.ldw = 2048; t.WT = (bf16*)(ws + WS_WPE); t.K = 256; }
    else if (it < TR_E5) { r = it - TR_E4; nblk = 32; t.W = I.w_a; t.ldw = 2048; t.WT = (bf16*)(ws + WS_WA); t.K = 2048; t.mode = 2; t.wmul = 64.f; }
    else if (it < TR_E6) { r = it - TR_E5; nblk = 32; t.W = I.w_b; t.ldw = 2048; t.WT = (bf16*)(ws + WS_WB); t.K = 2048; t.mode = 2; t.wmul = 64.f; }
    else if (it < TR_E7) { r = it - TR_E6; nblk = 32; t.W = I.w_o; t.ldw = 2048; t.WT = (bf16*)(ws + WS_WO); t.K = 2048; t.mode = 2; t.wmul = 64.f; }
    else if (it < TR_E8) { r = it - TR_E7; nblk = 32; t.W = I.w_pg; t.ldw = 2048; t.WT = (bf16*)(ws + WS_WPG); t.K = 2048; t.mode = 2; t.wmul = 64.f; }
    else if (it < TR_E9) { r = it - TR_E8; nblk = 176; t.W = I.w_up; t.ldw = NUP; t.WT = (bf16*)(ws + WS_WUP); t.K = 2048; map = 3; t.mode = 2; t.wmul = 64.f; }
    else if (it < TR_E10) { r = it - TR_E9; nblk = 32; t.W = I.w_dn; t.ldw = 2048; t.WT = (bf16*)(ws + WS_WDN); t.K = DFF; t.mode = 2; t.wmul = 128.f; }
    else { r = it - TR_E10; nblk = 64; t.W = I.w_in; t.ldw = DIN; t.WT = (bf16*)(ws + WS_WG); t.K = 2048; map = 4; t.mode = 2; t.wmul = 64.f; }
    const int kb = r / nblk, nb = r - kb * nblk, n0 = nb * 64, nl = n0 + 4 * (lane & 15);
    t.k0 = kb * 64; t.drow0 = rowoff + n0; t.srccol4 = map == 0 ? nl : map == 5 ? srcmap<1>(nl < 1024 ? 2048 + nl : 2304 + nl) : map == 6 ? srcmap<1>(nl < 2048 ? nl : nl < 2304 ? 1024 + nl : 1280 + nl) : map == 2 ? srcmap<2>(nl) : map == 3 ? srcmap<3>(nl) : U_G + nl;
    return t;
}
__device__ __forceinline__ void tr_load(const TrItem& t, f32x4 (&v)[16], int lane) {
#pragma unroll
    for (int i = 0; i < 16; ++i) { const int kk = 4 * i + (lane >> 4); v[i] = (f32x4){0.f, 0.f, 0.f, 0.f};
        if (t.srccol4 >= 0) { v[i] = *(const GAS f32x4*)(t.W + (size_t)(t.k0 + kk) * t.ldw + t.srccol4); if (t.gk) v[i] = v[i] * t.gk[t.k0 + kk]; } }
}
__device__ __forceinline__ void tr_all(const TrIn& I, unsigned char* ws, LAS float* scr, int gw, int NGW, int lane) {
    int it = gw; if (it >= TR_E11) return;
    TrItem cur = tr_decode(I, ws, it, lane); f32x4 v[16]; tr_load(cur, v, lane);
    for (;;) {
        const int c4 = (lane & 15) * 4;
#pragma unroll
        for (int i = 0; i < 16; ++i) *(LAS f32x4*)(scr + (4 * i + (lane >> 4)) * 68 + c4) = v[i];
        LDS_WAIT(); asm volatile("" ::: "memory");
        const int itn = it + NGW; const bool more = itn < TR_E11; TrItem nxt = cur;
        if (more) { nxt = tr_decode(I, ws, itn, lane); tr_load(nxt, v, lane); }
        if (cur.mode == 2) { unsigned char* orow = (unsigned char*)cur.WT + (size_t)(cur.drow0 + lane) * cur.K + cur.k0; const float wm = cur.wmul;
#pragma unroll
            for (int k16 = 0; k16 < 4; ++k16) { const LAS float* s = scr + (16 * k16) * 68 + lane; v4u o;
                o.x = pkf8(s[0 * 68] * wm, s[1 * 68] * wm, s[2 * 68] * wm, s[3 * 68] * wm); o.y = pkf8(s[4 * 68] * wm, s[5 * 68] * wm, s[6 * 68] * wm, s[7 * 68] * wm);
                o.z = pkf8(s[8 * 68] * wm, s[9 * 68] * wm, s[10 * 68] * wm, s[11 * 68] * wm); o.w = pkf8(s[12 * 68] * wm, s[13 * 68] * wm, s[14 * 68] * wm, s[15 * 68] * wm);
                *(GAS v4u*)(orow + 16 * k16) = o; } }
        else { bf16* orow = cur.WT + (size_t)(cur.drow0 + lane) * cur.K + cur.k0;
#pragma unroll
        for (int k8 = 0; k8 < 8; ++k8) { const LAS float* s = scr + (8 * k8) * 68 + lane;
            v4u o; if (cur.mode == 1) { o.x = pkh(s[0 * 68], s[1 * 68]); o.y = pkh(s[2 * 68], s[3 * 68]); o.z = pkh(s[4 * 68], s[5 * 68]); o.w = pkh(s[6 * 68], s[7 * 68]); }
            else { o.x = pk2(s[0 * 68], s[1 * 68]); o.y = pk2(s[2 * 68], s[3 * 68]); o.z = pk2(s[4 * 68], s[5 * 68]); o.w = pk2(s[6 * 68], s[7 * 68]); }
            *(GAS v4u*)(orow + 8 * k8) = o; } }
        LDS_WAIT(); asm volatile("" ::: "memory");
        if (!more) break;
        cur = nxt; it = itn;
    }
}
__device__ __forceinline__ void cvt_flat_h(const float* src, bf16* dst, unsigned char* dst8, size_t n8, size_t gt, size_t NT) {
    for (size_t i = gt; i < n8; i += 4 * NT) { f32x4 a[4], b[4];
#pragma unroll
        for (int u = 0; u < 4; ++u) { a[u] = *(const GAS f32x4*)(src + (i + u * NT) * 8); b[u] = *(const GAS f32x4*)(src + (i + u * NT) * 8 + 4); }
#pragma unroll
        for (int u = 0; u < 4; ++u) { *(GAS v4u*)(dst + (i + u * NT) * 8) = pack8h(a[u], b[u]);
            u32x2 w; w.x = pkf8(a[u][0], a[u][1], a[u][2], a[u][3]); w.y = pkf8(b[u][0], b[u][1], b[u][2], b[u][3]); *(GAS u32x2*)(dst8 + (i + u * NT) * 8) = w; } }
}
__device__ __forceinline__ void cvt_flat(const float* src, bf16* dst, size_t n8, size_t gt, size_t NT) {
    for (size_t i = gt; i < n8; i += 4 * NT) { f32x4 a[4], b[4];
#pragma unroll
        for (int u = 0; u < 4; ++u) { a[u] = *(const GAS f32x4*)(src + (i + u * NT) * 8); b[u] = *(const GAS f32x4*)(src + (i + u * NT) * 8 + 4); }
#pragma unroll
        for (int u = 0; u < 4; ++u) *(GAS v4u*)(dst + (i + u * NT) * 8) = pack8(a[u], b[u]); }
}

typedef const pg8::f32x4 (&AccRef)[2][2][4][2];
using pg8::f32x2;
using pg8::Unit;
#define EPI_ROWS(ai, m) for (int ai = 0; ai < 2; ++ai) _Pragma("unroll") for (int m = 0; m < 4; ++m)

template <int PM> struct EpiU {
    static constexpr bool PERM = true, AFTER_DRAIN = false;
    bf16 *QA, *QI, *KA, *VA, *KI, *KR, *CQ, *CKV; float* WI; float* SSQ; const float* ROPE;
    __device__ __forceinline__ void operator()(AccRef acc, const Unit& u, int wr, int wc, int fr, int fq) const {
        { int t_ = threadIdx.x; asm volatile("" : "+v"(t_)); fr = t_ & 15; fq = (t_ >> 4) & 3; }
        const int pn = PM == 1 ? (u.pn < 8 ? u.pn : u.pn == 8 ? 12 : u.pn + 5) : (u.pn < 4 ? 8 + u.pn : 13), rowb = u.pm * 256 + wr * 64 + fr, cw = wc * 32 + 8 * fq;
        if (pn < 12) {
            bf16* base = pn < 8 ? QA : QI; const int ldc = pn < 8 ? 2048 : 1024, colt = (pn < 8 ? pn : pn - 8) * 256; const float sc = pn < 8 ? QA_SCALE : 1.f;
#pragma unroll
            EPI_ROWS(ai, m) { bf16* rp = base + (size_t)(rowb + ai * 128 + m * 16) * ldc + colt + cw;
#pragma unroll
                for (int bj = 0; bj < 2; ++bj) *(GAS v4u*)(rp + bj * 128) = pn < 8 ? pack8(acc[ai][bj][m][0] * sc, acc[ai][bj][m][1] * sc) : pack8h(acc[ai][bj][m][0], acc[ai][bj][m][1]); }
        } else if (pn == 12) {
#pragma unroll
            EPI_ROWS(ai, m) { const size_t row = rowb + ai * 128 + m * 16;
                *(GAS v4u*)(KA + row * 128 + cw) = pack8(acc[ai][0][m][0], acc[ai][0][m][1]);
                *(GAS v4u*)(VA + row * 128 + cw) = pack8(acc[ai][1][m][0], acc[ai][1][m][1]); }
        } else if (pn == 13) {
#pragma unroll
            EPI_ROWS(ai, m) { const size_t row = rowb + ai * 128 + m * 16; const int pos = (int)(row & (SEQ - 1));
                const f32x4 v0 = acc[ai][0][m][0], v1 = acc[ai][0][m][1];
                if (wc < 2) { *(GAS v4u*)(KI + (row & ~(size_t)31) * 64 + (2 * wc + (fq >> 1)) * 512 + ((fq & 1) * 32 + (int)(row & 31)) * 8) = pack8h(v0, v1); }
                else { const int g = 4 * (wc - 2) + fq; const f32x4 c4 = *(const GAS f32x4*)(ROPE + pos * 32 + 4 * g), s4 = *(const GAS f32x4*)(ROPE + SEQ * 32 + pos * 32 + 4 * g);
                    const f32x4 y1 = v0 * c4 - v1 * s4, y2 = v0 * s4 + v1 * c4; GAS unsigned char* kr8 = (GAS unsigned char*)KR + row * 64 + 4 * g;
                    *(GAS unsigned*)kr8 = pkf8(y1[0], y1[1], y1[2], y1[3]); *(GAS unsigned*)(kr8 + 32) = pkf8(y2[0], y2[1], y2[2], y2[3]); }
                if (wc == 0 && fq < 2) { *(GAS f32x4*)(WI + row * 16 + 8 * fq) = acc[ai][1][m][0]; *(GAS f32x4*)(WI + row * 16 + 8 * fq + 4) = acc[ai][1][m][1]; } }
        } else {
            const int t = pn - 14; bf16* base = t < 2 ? CQ : CKV; float* ssq = SSQ + (t < 2 ? (size_t)0 : (size_t)M * 8); const int colt = (t & 1) * 256;
#pragma unroll
            EPI_ROWS(ai, m) { const size_t row = rowb + ai * 128 + m * 16; float s = 0.f;
#pragma unroll
                for (int bj = 0; bj < 2; ++bj) { const f32x4 v0 = acc[ai][bj][m][0], v1 = acc[ai][bj][m][1];
                    { u32x2 w8; w8.x = pkf8(v0[0], v0[1], v0[2], v0[3]); w8.y = pkf8(v1[0], v1[1], v1[2], v1[3]); *(GAS u32x2*)((GAS unsigned char*)base + row * 512 + colt + bj * 128 + cw) = w8; }
                    s += (v0[0] * v0[0] + v0[1] * v0[1]) + (v0[2] * v0[2] + v0[3] * v0[3]) + (v1[0] * v1[0] + v1[1] * v1[1]) + (v1[2] * v1[2] + v1[3] * v1[3]); }
                s = sum_x32(sum_x16(s));
                if (fq == 0) ssq[row * 8 + (t & 1) * 4 + wc] = s; }
        }
    }
};
struct EpiQ {
    static constexpr bool PERM = true, AFTER_DRAIN = false;
    bf16 *QN, *QR; const float* SSQ; const float* ROPE;
    __device__ __forceinline__ void operator()(AccRef acc, const Unit& u, int wr, int wc, int fr, int fq) const {
        { int t_ = threadIdx.x; asm volatile("" : "+v"(t_)); fr = t_ & 15; fq = (t_ >> 4) & 3; }
        const int pn = u.pn, rowb = u.pm * 256 + wr * 64 + fr, cw = wc * 32 + 8 * fq;
#pragma unroll
        EPI_ROWS(ai, m) { const size_t row = rowb + ai * 128 + m * 16;
            const f32x4 sa = *(const GAS f32x4*)(SSQ + row * 8), sb = *(const GAS f32x4*)(SSQ + row * 8 + 4); const float r = (8.f * QB_SCALE) / sqrtf((((sa[0] + sa[1]) + (sa[2] + sa[3])) + ((sb[0] + sb[1]) + (sb[2] + sb[3]))) * (1.f / 512.f) + RMS_EPS);
            if (pn < 8) {
#pragma unroll
                for (int bj = 0; bj < 2; ++bj) { const f32x4 v0 = acc[ai][bj][m][0] * r, v1 = acc[ai][bj][m][1] * r; u32x2 w; w.x = pkf8(v0[0], v0[1], v0[2], v0[3]); w.y = pkf8(v1[0], v1[1], v1[2], v1[3]);
                    *(GAS u32x2*)((GAS unsigned char*)QN + row * 2048 + pn * 256 + bj * 128 + cw) = w; }
            } else { const int pos = (int)(row & (SEQ - 1)), g = 4 * (wc & 1) + fq;
                const f32x4 c4 = *(const GAS f32x4*)(ROPE + pos * 32 + 4 * g) * r, s4 = *(const GAS f32x4*)(ROPE + SEQ * 32 + pos * 32 + 4 * g) * r;
#pragma unroll
                for (int bj = 0; bj < 2; ++bj) { const int head = (pn - 8) * 4 + bj * 2 + (wc >> 1); const f32x4 v0 = acc[ai][bj][m][0], v1 = acc[ai][bj][m][1];
                    const f32x4 y1 = v0 * c4 - v1 * s4, y2 = v0 * s4 + v1 * c4; GAS unsigned char* q8 = (GAS unsigned char*)QR + row * 1024 + head * 64 + 4 * g;
                    *(GAS unsigned*)q8 = pkf8(y1[0], y1[1], y1[2], y1[3]); *(GAS unsigned*)(q8 + 32) = pkf8(y2[0], y2[1], y2[2], y2[3]); } } }
    }
};
struct EpiKV {
    static constexpr bool PERM = true, AFTER_DRAIN = false;
    bf16 *KN, *VB; const float* SSQ;
    __device__ __forceinline__ void operator()(AccRef acc, const Unit& u, int wr, int wc, int fr, int fq) const {
        { int t_ = threadIdx.x; asm volatile("" : "+v"(t_)); fr = t_ & 15; fq = (t_ >> 4) & 3; }
        const int pn = u.pn, rowb = u.pm * 256 + wr * 64 + fr, cw = wc * 32 + 8 * fq; bf16* base = pn < 8 ? KN : VB; const int colt = (pn & 7) * 256;
#pragma unroll
        EPI_ROWS(ai, m) { const size_t row = rowb + ai * 128 + m * 16; const f32x4 sa = *(const GAS f32x4*)(SSQ + row * 8), sb = *(const GAS f32x4*)(SSQ + row * 8 + 4); const float r = 1.0f / sqrtf((((sa[0] + sa[1]) + (sa[2] + sa[3])) + ((sb[0] + sb[1]) + (sb[2] + sb[3]))) * (1.f / 512.f) + RMS_EPS);
#pragma unroll
            for (int bj = 0; bj < 2; ++bj) { const f32x4 v0 = acc[ai][bj][m][0] * r, v1 = acc[ai][bj][m][1] * r;
                if (pn < 8) { u32x2 w; w.x = pkf8(v0[0], v0[1], v0[2], v0[3]); w.y = pkf8(v1[0], v1[1], v1[2], v1[3]); *(GAS u32x2*)((GAS unsigned char*)KN + row * 2048 + colt + bj * 128 + cw) = w; }
                else *(GAS v4u*)(VB + row * 2048 + colt + bj * 128 + cw) = pack8(v0, v1); } }
    }
};
__device__ __forceinline__ void unpack8f8(const u32x2 w, f32x4& a, f32x4& b) {
    const f32x2 a0 = __builtin_amdgcn_cvt_pk_f32_fp8((int)w.x, false), a1 = __builtin_amdgcn_cvt_pk_f32_fp8((int)w.x, true), b0 = __builtin_amdgcn_cvt_pk_f32_fp8((int)w.y, false), b1 = __builtin_amdgcn_cvt_pk_f32_fp8((int)w.y, true);
    a = (f32x4){a0[0], a0[1], a1[0], a1[1]}; b = (f32x4){b0[0], b0[1], b1[0], b1[1]};
}
__device__ __forceinline__ u32x2 pack8f8(const f32x4 a, const f32x4 b) { u32x2 w; w.x = pkf8(a[0], a[1], a[2], a[3]); w.y = pkf8(b[0], b[1], b[2], b[3]); return w; }
template <int MODE> struct EpiB {
    static constexpr bool PERM = true, AFTER_DRAIN = false;
    bf16* O; int ldc; const bf16* gp; const float* bias; unsigned char* O8;
    __device__ __forceinline__ void operator()(AccRef acc, const Unit& u, int wr, int wc, int fr, int fq) const {
        { int t_ = threadIdx.x; asm volatile("" : "+v"(t_)); fr = t_ & 15; fq = (t_ >> 4) & 3; }
        const int rowb = u.pm * 256 + wr * 64 + fr, colb = u.pn * 256 + wc * 32 + 8 * fq;
#pragma unroll
        EPI_ROWS(ai, m) { const size_t row = rowb + ai * 128 + m * 16;
#pragma unroll
            for (int bj = 0; bj < 2; ++bj) { const int col = colb + bj * 128; f32x4 v0 = acc[ai][bj][m][0], v1 = acc[ai][bj][m][1]; GAS unsigned char* op = (GAS unsigned char*)O + row * ldc + col;
                if (MODE == 1) { v0 = sigmoid4(v0); v1 = sigmoid4(v1); }
                if (MODE == 2 || MODE == 5) { f32x4 g0, g1; unpack8f8(*(const GAS u32x2*)((const GAS unsigned char*)gp + row * 4096 + col), g0, g1); v0 = v0 * g0; v1 = v1 * g1; }
                if (MODE == 5) { f32x4 o0, o1; unpack8f8(*(const GAS u32x2*)op, o0, o1); v0 = v0 + o0; v1 = v1 + o1; }
                if (MODE == 4) { f32x4 o0, o1; unpack8f8(*(const GAS u32x2*)op, o0, o1); const f32x4 b0 = *(const GAS f32x4*)(bias + col), b1 = *(const GAS f32x4*)(bias + col + 4);
                    v0 = sigmoid4(v0 + b0) * o0; v1 = sigmoid4(v1 + b1) * o1; }
                if (MODE == 5) *(GAS u32x2*)(O8 + row * ldc + col) = pack8f8(v0, v1);
                else *(GAS u32x2*)op = pack8f8(v0, v1); }
            if (MODE >= 2) asm volatile("" ::: "memory"); }
    }
};
template <int MODE> struct EpiF {
    static constexpr bool PERM = true, AFTER_DRAIN = false;
    bf16* zb; const float* xin; const bf16* ple;
    __device__ __forceinline__ void operator()(AccRef acc, const Unit& u, int wr, int wc, int fr, int fq) const {
        { int t_ = threadIdx.x; asm volatile("" : "+v"(t_)); fr = t_ & 15; fq = (t_ >> 4) & 3; }
        const int rowb = u.pm * 256 + wr * 64 + fr, colb = u.pn * 256 + wc * 32 + 8 * fq;
#pragma unroll
        EPI_ROWS(ai, m) { const size_t row = rowb + ai * 128 + m * 16;
#pragma unroll
            for (int bj = 0; bj < 2; ++bj) { const size_t off = row * 2048 + colb + bj * 128; f32x4 v0 = acc[ai][bj][m][0], v1 = acc[ai][bj][m][1]; f32x4 x0, x1;
                if (MODE == 0) { x0 = *(const GAS f32x4*)(xin + off); x1 = *(const GAS f32x4*)(xin + off + 4); } else unpack8(*(const GAS v4u*)(zb + off), x0, x1);
                v0 = v0 + x0 * ALPHA; v1 = v1 + x1 * ALPHA;
                if (MODE == 1) { f32x4 p0, p1; unpack8f8(*(const GAS u32x2*)((const GAS unsigned char*)ple + off), p0, p1); v0 = v0 + p0; v1 = v1 + p1; }
                *(GAS v4u*)(zb + off) = pack8(v0, v1); }
            asm volatile("" ::: "memory"); }
    }
};
template <int CTRL> __device__ __forceinline__ f32x4 dpp4(f32x4 v) { return (f32x4){dppf<CTRL>(v[0]), dppf<CTRL>(v[1]), dppf<CTRL>(v[2]), dppf<CTRL>(v[3])}; }
__device__ __forceinline__ f32x4 sel4(bool c, f32x4 a, f32x4 b) { return (f32x4){c ? a[0] : b[0], c ? a[1] : b[1], c ? a[2] : b[2], c ? a[3] : b[3]}; }
struct EpiUp {
    static constexpr bool PERM = true, AFTER_DRAIN = false;
    unsigned char* ACT; float* HEADB; float* TAILB; const float* cw; const float* cb;
    __device__ __forceinline__ void operator()(AccRef acc, const Unit& u, int wr, int wc, int fr, int fq) const {
        { int t_ = threadIdx.x; asm volatile("" : "+v"(t_)); fr = t_ & 15; fq = (t_ >> 4) & 3; }
        const unsigned ch0 = (unsigned)(u.pn * 128 + wc * 32 + 8 * fq), cp0 = (unsigned)(u.pn * 256 + wc * 32 + 8 * fq);
        const GAS unsigned char* cwb = (const GAS unsigned char*)cw; const GAS unsigned char* cbb = (const GAS unsigned char*)cb; GAS unsigned char* actb = (GAS unsigned char*)ACT;
#pragma unroll
        for (int ai = 0; ai < 2; ++ai) {
            const unsigned g = (unsigned)(u.pm * 4 + ai * 2 + wr), row0 = g * 64u + (unsigned)fr;
            if (fr < 2) { GAS unsigned char* hp = (GAS unsigned char*)HEADB + ((g * 2u + (unsigned)fr) * (unsigned)NUP + cp0) * 4u;
#pragma unroll
                for (int bj = 0; bj < 2; ++bj)
#pragma unroll
                    for (int n = 0; n < 2; ++n) *(GAS f32x4*)(hp + (bj * 128 + 4 * n) * 4) = acc[ai][bj][0][n]; }
            if (fr >= 14) { GAS unsigned char* hp = (GAS unsigned char*)TAILB + ((g * 2u + (unsigned)(fr - 14)) * (unsigned)NUP + cp0) * 4u;
#pragma unroll
                for (int bj = 0; bj < 2; ++bj)
#pragma unroll
                    for (int n = 0; n < 2; ++n) *(GAS f32x4*)(hp + (bj * 128 + 4 * n) * 4) = acc[ai][bj][3][n]; }
            asm volatile("" ::: "memory"); __builtin_amdgcn_sched_barrier(0);
#pragma unroll
            for (int n = 0; n < 2; ++n) {
                unsigned pk[4];
#pragma unroll
                for (int hf = 0; hf < 2; ++hf) {
                    asm volatile("" ::: "memory"); __builtin_amdgcn_sched_barrier(0);
                    f32x2 yg[4];
#pragma unroll
                    for (int bj = 0; bj < 2; ++bj) { const unsigned cB = (ch0 + (unsigned)(4 * n + 2 * hf + bj * DFF)) * 4u;
                        const f32x2 w0 = *(const GAS f32x2*)(cwb + cB), w1 = *(const GAS f32x2*)(cwb + (cB + (unsigned)NUP * 4u)), w2 = *(const GAS f32x2*)(cwb + (cB + (unsigned)NUP * 8u)), bb = *(const GAS f32x2*)(cbb + cB);
                        f32x2 pr1 = (f32x2){0.f, 0.f}, pr2 = pr1;
#pragma unroll
                        for (int m = 0; m < 4; ++m) { const f32x4 v4 = acc[ai][bj][m][n]; const f32x2 v = hf ? (f32x2){v4[2], v4[3]} : (f32x2){v4[0], v4[1]};
                            const f32x2 r1 = (f32x2){dppf<0x121>(v[0]), dppf<0x121>(v[1])}, r2 = (f32x2){dppf<0x122>(v[0]), dppf<0x122>(v[1])};
                            const f32x2 p1 = fr >= 1 ? r1 : pr1, p2 = fr >= 2 ? r2 : pr2;
                            const f32x2 y = bb + w2 * v + w1 * p1 + w0 * p2; pr1 = r1; pr2 = r2;
                            if (bj == 0) yg[m] = y;
                            else { const f32x2 sg = (f32x2){sigmoidf_(yg[m][0]), sigmoidf_(yg[m][1])}; const f32x2 a = yg[m] * sg * y;
                                if (hf == 0) pk[m] = (unsigned)__builtin_amdgcn_cvt_pk_fp8_f32(a[0], a[1], 0, false);
                                else { const unsigned w = (unsigned)__builtin_amdgcn_cvt_pk_fp8_f32(a[0], a[1], (int)pk[m], true); if (!(m == 0 && fr < 2)) *(GAS unsigned*)(actb + ((row0 + (unsigned)(m * 16)) * (unsigned)DFF + ch0 + (unsigned)(4 * n))) = w; } } }
                        asm volatile("" ::: "memory"); __builtin_amdgcn_sched_barrier(0); }
                }
            }
        }
    }
};

namespace dsa {
constexpr int CAP = 512, TOPK = 256;
typedef unsigned long long u64;
typedef unsigned short u16;
__device__ __forceinline__ unsigned fkey(float f) { const unsigned u = __float_as_uint(f); return u ^ ((unsigned)((int)u >> 31) | 0x80000000u); }
__device__ __forceinline__ float keyf(unsigned k) { const unsigned u = (k & 0x80000000u) ? (k ^ 0x80000000u) : ~k; return __uint_as_float(u); }
__device__ __forceinline__ int mbcnt64(u64 m) { return (int)__builtin_amdgcn_mbcnt_hi((unsigned)(m >> 32), __builtin_amdgcn_mbcnt_lo((unsigned)m, 0u)); }

__device__ __forceinline__ unsigned wave_umax(unsigned v) {
#define DSA_UDPP(c_) (unsigned)__builtin_amdgcn_update_dpp(0, (int)v, c_, 0xf, 0xf, false)
    v = max(v, DSA_UDPP(0xB1)); v = max(v, DSA_UDPP(0x4E)); v = max(v, DSA_UDPP(0x141)); v = max(v, DSA_UDPP(0x140));
#undef DSA_UDPP
    { auto r = __builtin_amdgcn_permlane16_swap(v, v, false, false); v = max(r[0], r[1]); }
    { auto r = __builtin_amdgcn_permlane32_swap(v, v, false, false); v = max(r[0], r[1]); }
    return v;
}
__device__ __forceinline__ unsigned compact(LAS u64* buf, int n, int lane, unsigned lowk, bool exact, int& nout) {
    unsigned key[8], idx[8];
#pragma unroll
    for (int e = 0; e < 8; ++e) { const int i = lane + 64 * e; u64 v = 0ull; if (i < n) v = buf[i]; key[e] = (unsigned)(v >> 32); idx[e] = (unsigned)v; }
    unsigned mx = key[0];
#pragma unroll
    for (int e = 1; e < 8; ++e) mx = max(mx, key[e]);
    mx = (unsigned)__builtin_amdgcn_readfirstlane((int)wave_umax(mx));
    const unsigned diff = lowk ^ mx; unsigned P = lowk;
    if (diff) { const int hb = 31 - __builtin_clz(diff); P = hb == 31 ? 0u : (lowk >> (hb + 1)) << (hb + 1); const int lob = exact ? 0 : (hb > 15 ? hb - 15 : 0);
#pragma unroll 1
        for (int b = hb; b >= lob; --b) { const unsigned cand = P | (1u << b); int c = 0;
#pragma unroll
            for (int e = 0; e < 8; ++e) c += __builtin_popcountll(__ballot(key[e] >= cand));
            if (c >= TOPK) { P = cand; if (c == TOPK || (!exact && c <= TOPK + 48)) break; } } }
    int cgt = 0;
#pragma unroll
    for (int e = 0; e < 8; ++e) cgt += __builtin_popcountll(__ballot(key[e] > P));
    const int need = exact ? TOPK - cgt : CAP; int base = 0, eqbase = 0;
#pragma unroll
    for (int e = 0; e < 8; ++e) { const bool gt = key[e] > P, eq = key[e] == P && key[e] != 0u; const u64 beq = __ballot(eq); const bool sel = gt || (eq && (eqbase + mbcnt64(beq)) < need);
        const u64 bs = __ballot(sel); const int pos = base + mbcnt64(bs);
        if (sel) buf[pos] = ((u64)key[e] << 32) | idx[e];
        base += __builtin_popcountll(bs); eqbase += __builtin_popcountll(beq); }
    asm volatile("s_waitcnt lgkmcnt(0)" ::: "memory");
    nout = base;
    return P;
}

struct Ptrs { const bf16 *QI, *KI, *KA, *VA; const float* WI; const bf16* QA; bf16* O; unsigned short* SEL; };

__device__ __forceinline__ void attend(const Ptrs& P, int b, int t, const LAS u16* idl, LAS unsigned char* vbuf, int lane) {
    const int head = lane & 15, g = lane >> 4; const size_t m = (size_t)b * SEQ + t;
    bf16x8 Bq[4];
#pragma unroll
    for (int ks = 0; ks < 4; ++ks) Bq[ks] = *(const GAS bf16x8*)(P.QA + m * 2048 + head * 128 + 32 * ks + 8 * g);
    const float slope2 = __builtin_amdgcn_exp2f(-0.5f * (float)(head + 1)) * LOG2E;
    const bf16* vab = P.VA + (size_t)b * SEQ * 128;
    v4u st[8];
#define DSA_VLOAD(kk) do { _Pragma("unroll") for (int u_ = 0; u_ < 8; ++u_) { const int row_ = 4 * u_ + g; unsigned s_ = idl[32 * (kk) + row_]; s_ = s_ == 0xFFFFu ? 0u : s_; \
        const int cl_ = (lane & 15) ^ ((row_ & 7) << 1); st[u_] = *(const GAS v4u*)(vab + (size_t)s_ * 128 + cl_ * 8); } } while (0)
#define DSA_VWRITE(kk) do { _Pragma("unroll") for (int u_ = 0; u_ < 8; ++u_) *(LAS v4u*)(vbuf + ((kk) & 1) * 8192 + u_ * 1024 + lane * 16) = st[u_]; } while (0)
    DSA_VLOAD(0);
    const bf16* kab = P.KA + (size_t)b * SEQ * 128 + 8 * g;
    f32x4 L[16];
    bf16x8 Af[16][4];
#define DSA_KLD(i_) do { unsigned s_ = idl[16 * (i_) + head]; s_ = s_ == 0xFFFFu ? 0u : s_; const bf16* kp_ = kab + (size_t)s_ * 128; \
        _Pragma("unroll") for (int ks = 0; ks < 4; ++ks) Af[i_][ks] = *(const GAS bf16x8*)(kp_ + 32 * ks); } while (0)
    DSA_KLD(0); __builtin_amdgcn_sched_barrier(0); DSA_KLD(1); __builtin_amdgcn_sched_barrier(0); DSA_KLD(2); __builtin_amdgcn_sched_barrier(0);
#pragma unroll
    for (int i = 0; i < 16; ++i) {
        if (i + 3 < 16) { DSA_KLD(i + 3 < 16 ? i + 3 : 15); } __builtin_amdgcn_sched_barrier(0);
        f32x4 C = (f32x4){0.f, 0.f, 0.f, 0.f};
#pragma unroll
        for (int ks = 0; ks < 4; ++ks) C = __builtin_amdgcn_mfma_f32_16x16x32_bf16(Af[i][ks], Bq[ks], C, 0, 0, 0);
        const u32x2 idw = *(const LAS u32x2*)(idl + 16 * i + 4 * g);
        const unsigned i0 = idw.x & 0xffffu, i1 = idw.x >> 16, i2 = idw.y & 0xffffu, i3 = idw.y >> 16;
        L[i][0] = i0 == 0xFFFFu ? -__builtin_inff() : C[0] - slope2 * (float)(t - (int)i0);
        L[i][1] = i1 == 0xFFFFu ? -__builtin_inff() : C[1] - slope2 * (float)(t - (int)i1);
        L[i][2] = i2 == 0xFFFFu ? -__builtin_inff() : C[2] - slope2 * (float)(t - (int)i2);
        L[i][3] = i3 == 0xFFFFu ? -__builtin_inff() : C[3] - slope2 * (float)(t - (int)i3);
        __builtin_amdgcn_sched_barrier(0);
    }
#undef DSA_KLD
    float mx = -__builtin_inff();
#pragma unroll
    for (int i = 0; i < 16; ++i) mx = fmaxf(fmaxf(mx, fmaxf(L[i][0], L[i][1])), fmaxf(L[i][2], L[i][3]));
    mx = max_x32(max_x16(mx));
    float sum = 0.f;
#pragma unroll
    for (int i = 0; i < 16; ++i) {
#pragma unroll
        for (int r = 0; r < 4; ++r) { const float p = __builtin_amdgcn_exp2f(L[i][r] - mx); L[i][r] = p; sum += p; } }
    sum = sum_x32(sum_x16(sum));
    f32x4 O[8];
#pragma unroll
    for (int dt = 0; dt < 8; ++dt) O[dt] = (f32x4){0.f, 0.f, 0.f, 0.f};
    DSA_VWRITE(0); DSA_VLOAD(1);
    const int q4 = (lane >> 2) & 3, p4 = lane & 3, row1 = 4 * g + q4;
#pragma unroll
    for (int kk = 0; kk < 8; ++kk) {
        const v4u pw = pack8(L[2 * kk], L[2 * kk + 1]); const bf16x8 Pf = __builtin_bit_cast(bf16x8, pw);
        const LAS unsigned char* vb = vbuf + (kk & 1) * 8192 + row1 * 256 + 8 * p4;
        s16x4 lo[8], hi2[8];
#pragma unroll
        for (int dt = 0; dt < 8; ++dt) { const LAS unsigned char* a1 = vb + ((dt ^ (row1 & 7)) << 5);
            lo[dt] = __builtin_bit_cast(s16x4, __builtin_amdgcn_ds_read_tr16_b64_v4i16((LAS s16x4*)a1));
            hi2[dt] = __builtin_bit_cast(s16x4, __builtin_amdgcn_ds_read_tr16_b64_v4i16((LAS s16x4*)(a1 + 4096))); }
#pragma unroll
        for (int dt = 0; dt < 8; ++dt) {
            const bf16x8 Av = (bf16x8){lo[dt][0], lo[dt][1], lo[dt][2], lo[dt][3], hi2[dt][0], hi2[dt][1], hi2[dt][2], hi2[dt][3]};
            O[dt] = __builtin_amdgcn_mfma_f32_16x16x32_bf16(Av, Pf, O[dt], 0, 0, 0); }
        if (kk + 1 < 8) { DSA_VWRITE(kk + 1); if (kk + 2 < 8) DSA_VLOAD(kk + 2); }
    }
#undef DSA_VLOAD
#undef DSA_VWRITE
    const float inv = 1.0f / sum;
    unsigned char* op = (unsigned char*)P.O + m * 4096 + head * 128 + 4 * g;
#pragma unroll
    for (int dt = 0; dt < 8; ++dt) { const f32x4 o = O[dt] * inv; *(GAS unsigned*)(op + 16 * dt) = pkf8(o[0], o[1], o[2], o[3]); }
}

__device__ __forceinline__ void job(const Ptrs& P, int b, int t0, LAS unsigned char* wl, LAS u16* idl, int lane, volatile LAS unsigned* dbgp = nullptr) {
#if defined(DBG_SPIN)
    unsigned long long tcomp = 0ull, tatt = 0ull; const unsigned long long tj0 = __builtin_amdgcn_s_memrealtime();
#endif
    const int r32 = lane & 31, hi = lane >> 5;
    const int qsel = (r32 >> 2) & 1, headA = (r32 & 3) + 4 * (r32 >> 3);
    bf16x8 A[2][4]; float sg[2][16];
#pragma unroll
    for (int a = 0; a < 2; ++a) {
        const size_t mA = (size_t)b * SEQ + t0 + 2 * a + qsel; const float aw = P.WI[mA * 16 + headA];
#pragma unroll
        for (int d0 = 0; d0 < 4; ++d0) { f32x4 x0, x1; unpack8h(*(const GAS v4u*)(P.QI + mA * 1024 + headA * 64 + 16 * d0 + 8 * hi), x0, x1); A[a][d0] = __builtin_bit_cast(bf16x8, pack8h(x0 * aw, x1 * aw)); }
        const size_t mC = (size_t)b * SEQ + t0 + 2 * a + hi;
#pragma unroll
        for (int r4 = 0; r4 < 4; ++r4) { const f32x4 w4 = *(const GAS f32x4*)(P.WI + mC * 16 + 4 * r4);
#pragma unroll
            for (int j = 0; j < 4; ++j) sg[a][4 * r4 + j] = w4[j] < 0.f ? -__builtin_inff() : __builtin_inff(); }
    }
    LAS u64* cand = (LAS u64*)wl;
    int c0 = 0, c1 = 0, c2 = 0, c3 = 0; unsigned l0 = 0u, l1 = 0u, l2 = 0u, l3 = 0u; float tau0 = -__builtin_inff(), tau1 = -__builtin_inff();
    const int ntile = (t0 + 3) / 32 + 1;
    const bf16* kib = P.KI + (size_t)b * SEQ * 64 + 8 * lane;
    bf16x8 B0[4], B1[4], B2[4], B3[4];
#define DSA_LDK(B_, JN_) do { const int jn_ = (JN_) < ntile ? (JN_) : ntile - 1; _Pragma("unroll") for (int d0 = 0; d0 < 4; ++d0) B_[d0] = *(const GAS bf16x8*)(kib + (size_t)jn_ * 2048 + 512 * d0); } while (0)
    DSA_LDK(B0, 0); asm volatile("" ::: "memory"); DSA_LDK(B1, 1); asm volatile("" ::: "memory"); DSA_LDK(B2, 2); asm volatile("" ::: "memory"); DSA_LDK(B3, 3); asm volatile("" ::: "memory");
#if defined(DBG_SPIN)
#define DSA_TC0 const unsigned long long tc0 = __builtin_amdgcn_s_memrealtime();
#define DSA_TC1 tcomp += __builtin_amdgcn_s_memrealtime() - tc0;
#else
#define DSA_TC0
#define DSA_TC1
#endif
#define DSA_TILE(JT_, Bf) do { const int jt = (JT_); const int s = jt * 32 + r32; \
        f32x16 C0 = {}, C1 = {}; \
        _Pragma("unroll") for (int d0 = 0; d0 < 4; ++d0) C0 = __builtin_amdgcn_mfma_f32_32x32x16_f16(__builtin_bit_cast(f16x8, A[0][d0]), __builtin_bit_cast(f16x8, Bf[d0]), C0, 0, 0, 0); \
        _Pragma("unroll") for (int d0 = 0; d0 < 4; ++d0) C1 = __builtin_amdgcn_mfma_f32_32x32x16_f16(__builtin_bit_cast(f16x8, A[1][d0]), __builtin_bit_cast(f16x8, Bf[d0]), C1, 0, 0, 0); \
        DSA_LDK(Bf, jt + 4); \
        float scv[2]; \
        _Pragma("unroll") for (int a = 0; a < 2; ++a) { float s_ = 0.f;                                                    \
            _Pragma("unroll") for (int r = 0; r < 16; ++r) { s_ += __builtin_amdgcn_fmed3f(a == 0 ? C0[r] : C1[r], 0.f, sg[a][r]); if ((r & 3) == 3) asm volatile("" : "+v"(s_)); } \
            scv[a] = s_; } \
        _Pragma("unroll") for (int a = 0; a < 2; ++a) { \
            const float sc = scv[a]; \
            const int tq = t0 + 2 * a + hi; const float tau = a == 0 ? tau0 : tau1; \
            const bool pass = (s <= tq) && (sc > tau); \
            const u64 bal = __ballot(pass); \
            if (bal) { const unsigned blo = (unsigned)bal, bhi = (unsigned)(bal >> 32); \
                const int pre = hi ? (int)__builtin_amdgcn_mbcnt_hi(bhi, 0u) : (int)__builtin_amdgcn_mbcnt_lo(blo, 0u); \
                const int cq = a == 0 ? (hi ? c1 : c0) : (hi ? c3 : c2); \
                if (pass) cand[(2 * a + hi) * CAP + cq + pre] = ((u64)fkey(sc) << 32) | (unsigned)s; \
                if (a == 0) { c0 += __builtin_popcount(blo); c1 += __builtin_popcount(bhi); } else { c2 += __builtin_popcount(blo); c3 += __builtin_popcount(bhi); } } \
        } \
        const int lim = (jt == ntile - 1) ? TOPK : CAP - 32; \
        _Pragma("unroll 1") for (;;) { \
            const int q = c0 > lim ? 0 : c1 > lim ? 1 : c2 > lim ? 2 : c3 > lim ? 3 : -1; \
            if (q < 0) break; \
            int n = q == 0 ? c0 : q == 1 ? c1 : q == 2 ? c2 : c3; unsigned lowk = q == 0 ? l0 : q == 1 ? l1 : q == 2 ? l2 : l3; \
            asm volatile("s_waitcnt lgkmcnt(0)" ::: "memory"); \
            DSA_TC0 \
            bool ex = jt == ntile - 1; int nout; unsigned T; \
            _Pragma("unroll 1") for (;;) { T = compact(cand + q * CAP, n, lane, lowk, ex, nout); if (ex || nout <= lim) break; ex = true; n = nout; lowk = T; } \
            const float tf = keyf(T); \
            DSA_TC1 \
            if (q == 0) { c0 = nout; l0 = T; } else if (q == 1) { c1 = nout; l1 = T; } else if (q == 2) { c2 = nout; l2 = T; } else { c3 = nout; l3 = T; } \
            if ((q >> 1) == 0) { if (hi == (q & 1)) tau0 = tf; } else { if (hi == (q & 1)) tau1 = tf; } \
        } } while (0)
#pragma unroll 1
    for (int jt0 = 0; jt0 < ntile; jt0 += 4) { DSA_TILE(jt0, B0); DSA_TILE(jt0 + 1, B1); DSA_TILE(jt0 + 2, B2); DSA_TILE(jt0 + 3, B3); }
#undef DSA_TILE
#undef DSA_LDK
#undef DSA_TC0
#undef DSA_TC1
    asm volatile("s_waitcnt lgkmcnt(0)" ::: "memory");
#pragma unroll
    for (int q = 0; q < 4; ++q) { const int n = q == 0 ? c0 : q == 1 ? c1 : q == 2 ? c2 : c3;
#pragma unroll
        for (int e = 0; e < 4; ++e) { const int i = lane + 64 * e; unsigned v = 0xFFFFu; if (i < n) v = (unsigned)cand[q * CAP + i] & 0xFFFFu;
#if defined(DBG_FIXED_SEL)
            v = (t0 + q - i) >= 0 ? (unsigned)(t0 + q - i) : 0xFFFFu;
#endif
            idl[q * TOPK + i] = (u16)v; if (P.SEL) P.SEL[((size_t)b * SEQ + t0 + q) * TOPK + i] = (u16)v; } }
    asm volatile("s_waitcnt lgkmcnt(0)" ::: "memory");
#if defined(DBG_SPIN)
    const unsigned long long ta0 = __builtin_amdgcn_s_memrealtime();
#endif
#pragma unroll 1
    for (int q = 0; q < 4; ++q) attend(P, b, t0 + q, idl + q * TOPK, wl, lane);
#if defined(DBG_SPIN)
    tatt = __builtin_amdgcn_s_memrealtime() - ta0;
    if (dbgp && lane == 0) { dbgp[0] += (unsigned)tcomp; dbgp[1] += (unsigned)tatt; dbgp[2] += (unsigned)(__builtin_amdgcn_s_memrealtime() - tj0); }
#endif
}
}

namespace mla {
constexpr int NW = 8, QBLK = 32, KVBLK = 64, QB = 256;
constexpr int SHM_V = 16384, SHM_K = 8192, SHM_R = 4096;
constexpr int OFF_V = 0, OFF_K = 3 * SHM_V, OFF_R = OFF_K + 4 * SHM_K, OFF_WS = OFF_R + 4 * SHM_R, LDS_NEED = OFF_WS + NW * 64 * 4;
constexpr float THR = 8.f;
#define MLA_KSWZ(row, colB) ((row) * 256 + ((colB) ^ (((row) & 7) << 4)))
#define MLA_RSWZ(row, colB) ((row) * 128 + ((colB) ^ ((((row) >> 1) & 7) << 4)))
#define MLA_SBAR() __builtin_amdgcn_sched_barrier(0)
__device__ __forceinline__ int v_st(int k, int c) { const int kk = (k & ~0xC) | ((k & 4) << 1) | ((k & 8) >> 1); return ((kk >> 3) * 4 + (c >> 5)) * 512 + ((kk & 7) * 32 + (c & 31)) * 2; }
__device__ __forceinline__ int v_rd_base(int lane) { return ((lane & 3) << 3) | (((lane >> 2) & 3) << 6) | (((lane >> 4) & 1) << 5) | (((lane >> 5) & 1) << 8); }
constexpr int v_rd_off(int d0, int ks, int half) { return d0 * 512 + ks * 4096 + half * 2048; }
__device__ __forceinline__ int crow(int r, int hi) { return (r & 3) + 8 * (r >> 2) + 4 * hi; }
__device__ __forceinline__ unsigned cvtpk(float lo, float hi) { return pg8::cvt_pk_bf16(lo, hi); }

__device__ __forceinline__ void mask_tile(f32x16& p0, f32x16& p1, int dq) {
    const float NEG = -__builtin_inff();
#pragma unroll
    for (int r = 0; r < 16; ++r) { const int c = (r & 3) + 8 * (r >> 2);
        if (dq - c < 0) p0[r] = NEG;
        if (dq - c - 32 < 0) p1[r] = NEG; }
}
__device__ __forceinline__ void softmax_tile(f32x16& p0, f32x16& p1, float& m_reg, float& l_reg, float& alpha, bf16x8& pa0, bf16x8& pa1, bf16x8& pa2, bf16x8& pa3) {
    float pmax = p0[0];
#pragma unroll
    for (int r = 1; r < 16; ++r) pmax = fmaxf(pmax, p0[r]);
#pragma unroll
    for (int r = 0; r < 16; ++r) pmax = fmaxf(pmax, p1[r]);
    { auto rr = __builtin_amdgcn_permlane32_swap(__float_as_uint(pmax), __float_as_uint(pmax), false, false); pmax = fmaxf(__uint_as_float(rr[0]), __uint_as_float(rr[1])); }
    float mn;
    if (__builtin_expect(__all((pmax - m_reg) <= THR), 1)) { mn = m_reg; alpha = 1.f; }
    else { mn = fmaxf(m_reg, pmax); alpha = __builtin_amdgcn_exp2f(m_reg - mn); m_reg = mn; }
#pragma unroll
    for (int r = 0; r < 16; ++r) { p0[r] = __builtin_amdgcn_exp2f(p0[r] - mn); p1[r] = __builtin_amdgcn_exp2f(p1[r] - mn); }
    float ps = 0.f;
#pragma unroll
    for (int r = 0; r < 16; ++r) ps += p0[r];
#pragma unroll
    for (int r = 0; r < 16; ++r) ps += p1[r];
    { auto rr = __builtin_amdgcn_permlane32_swap(__float_as_uint(ps), __float_as_uint(ps), false, false); ps = __uint_as_float(rr[0]) + __uint_as_float(rr[1]); }
    l_reg = l_reg * alpha + ps;
#define MLA_PK4(P, B_, OUT) do { unsigned a0 = cvtpk(P[B_ + 0], P[B_ + 1]), a1 = cvtpk(P[B_ + 2], P[B_ + 3]); unsigned b0 = cvtpk(P[B_ + 4], P[B_ + 5]), b1 = cvtpk(P[B_ + 6], P[B_ + 7]); \
        auto r0 = __builtin_amdgcn_permlane32_swap(a0, b0, false, false); auto r1 = __builtin_amdgcn_permlane32_swap(a1, b1, false, false); \
        v4u w = {r0[0], r1[0], r0[1], r1[1]}; OUT = __builtin_bit_cast(bf16x8, w); } while (0)
    MLA_PK4(p0, 0, pa0); MLA_PK4(p0, 8, pa1); MLA_PK4(p1, 0, pa2); MLA_PK4(p1, 8, pa3);
#undef MLA_PK4
}
typedef int i32x8q __attribute__((ext_vector_type(8))); typedef int i32x4q __attribute__((ext_vector_type(4)));
template <int KB>
__device__ __forceinline__ void qkt(f32x16& p0, f32x16& p1, const LAS unsigned char* lds, int r32, int hi, const i32x8q* q8) {
    p0 = f32x16{}; p1 = f32x16{};
    const LAS unsigned char* kr = lds + OFF_K + KB * SHM_K + r32 * 128; const int kx = (r32 >> 1) & 7;
    const LAS unsigned char* rr = lds + OFF_R + KB * SHM_R + r32 * 64; const int rx = (r32 >> 2) & 3;
#define MLA_LD32(base_, c_, x_, step_) __builtin_shufflevector(*(const LAS i32x4q*)((base_) + ((((c_)) ^ (x_)) << 4) + (step_)), *(const LAS i32x4q*)((base_) + ((((c_) + 1) ^ (x_)) << 4) + (step_)), 0, 1, 2, 3, 4, 5, 6, 7)
#pragma unroll
    for (int j = 0; j < 2; ++j) { const int c = 4 * j + 2 * hi;
        const i32x8q a0 = MLA_LD32(kr, c, kx, 0), a1 = MLA_LD32(kr, c, kx, 32 * 128);
        p0 = __builtin_amdgcn_mfma_scale_f32_32x32x64_f8f6f4(a0, q8[j], p0, 0, 0, 0, 127, 0, 127 - 3);
        p1 = __builtin_amdgcn_mfma_scale_f32_32x32x64_f8f6f4(a1, q8[j], p1, 0, 0, 0, 127, 0, 127 - 3); }
    { const int c = 2 * hi;
        const i32x8q a0 = MLA_LD32(rr, c, rx, 0), a1 = MLA_LD32(rr, c, rx, 32 * 64);
        p0 = __builtin_amdgcn_mfma_scale_f32_32x32x64_f8f6f4(a0, q8[2], p0, 0, 0, 0, 127, 0, 127 - 3);
        p1 = __builtin_amdgcn_mfma_scale_f32_32x32x64_f8f6f4(a1, q8[2], p1, 0, 0, 0, 127, 0, 127 - 3); }
#undef MLA_LD32
}
template <int VB>
__device__ __forceinline__ void pv_tile(f32x16* o, int vb0, bf16x8 pa0, bf16x8 pa1, bf16x8 pa2, bf16x8 pa3) {
#define MLA_TRRD(dst, off) asm volatile("ds_read_b64_tr_b16 %0, %1 offset:%2" : "=&v"(dst) : "v"(vb0), "i"(off) : "memory")
#define MLA_PV_D0(d0) do { s16x4 l0, l1, l2, l3, h0, h1, h2, h3; constexpr int b_ = OFF_V + VB * SHM_V + v_rd_off(d0, 0, 0); \
        MLA_TRRD(l0, b_); MLA_TRRD(h0, b_ + 2048); MLA_TRRD(l1, b_ + 4096); MLA_TRRD(h1, b_ + 6144); MLA_TRRD(l2, b_ + 8192); MLA_TRRD(h2, b_ + 10240); MLA_TRRD(l3, b_ + 12288); MLA_TRRD(h3, b_ + 14336); \
        asm volatile("s_waitcnt lgkmcnt(0)" ::: "memory"); MLA_SBAR(); \
        o[d0] = __builtin_amdgcn_mfma_f32_32x32x16_bf16(pa0, (bf16x8){l0[0], l0[1], l0[2], l0[3], h0[0], h0[1], h0[2], h0[3]}, o[d0], 0, 0, 0); \
        o[d0] = __builtin_amdgcn_mfma_f32_32x32x16_bf16(pa1, (bf16x8){l1[0], l1[1], l1[2], l1[3], h1[0], h1[1], h1[2], h1[3]}, o[d0], 0, 0, 0); \
        o[d0] = __builtin_amdgcn_mfma_f32_32x32x16_bf16(pa2, (bf16x8){l2[0], l2[1], l2[2], l2[3], h2[0], h2[1], h2[2], h2[3]}, o[d0], 0, 0, 0); \
        o[d0] = __builtin_amdgcn_mfma_f32_32x32x16_bf16(pa3, (bf16x8){l3[0], l3[1], l3[2], l3[3], h3[0], h3[1], h3[2], h3[3]}, o[d0], 0, 0, 0); } while (0)
    MLA_PV_D0(0); MLA_PV_D0(1); MLA_PV_D0(2); MLA_PV_D0(3);
#undef MLA_PV_D0
#undef MLA_TRRD
}
struct Tensors { const bf16* QN; const bf16* QR; const bf16* KN; const bf16* KR; const bf16* VB; bf16* O; };

__device__ __forceinline__ s16x4 vtr(const LAS unsigned char* p) { return __builtin_bit_cast(s16x4, __builtin_amdgcn_ds_read_tr16_b64_v4i16((LAS s16x4*)p)); }
template <int N> __device__ __forceinline__ i32x8q kfrag(const LAS unsigned char* kr, const LAS unsigned char* rr, int hi, int kx, int rx) {
    if (N < 4) { const int c = 4 * (N >> 1) + 2 * hi; const LAS unsigned char* b_ = kr + (N & 1) * 32 * 128;
        return __builtin_shufflevector(*(const LAS i32x4q*)(b_ + ((c ^ kx) << 4)), *(const LAS i32x4q*)(b_ + (((c + 1) ^ kx) << 4)), 0, 1, 2, 3, 4, 5, 6, 7); }
    const int c = 2 * hi; const LAS unsigned char* b_ = rr + (N & 1) * 32 * 64;
    return __builtin_shufflevector(*(const LAS i32x4q*)(b_ + ((c ^ rx) << 4)), *(const LAS i32x4q*)(b_ + (((c + 1) ^ rx) << 4)), 0, 1, 2, 3, 4, 5, 6, 7);
}
__device__ __forceinline__ float rowmax(const f32x16& p0, const f32x16& p1) {
    float pmax = p0[0];
#pragma unroll
    for (int r = 1; r < 16; ++r) pmax = fmaxf(pmax, p0[r]);
#pragma unroll
    for (int r = 0; r < 16; ++r) pmax = fmaxf(pmax, p1[r]);
    auto rr = __builtin_amdgcn_permlane32_swap(__float_as_uint(pmax), __float_as_uint(pmax), false, false); return fmaxf(__uint_as_float(rr[0]), __uint_as_float(rr[1]));
}

__device__ __forceinline__ void unit(const Tensors& T, int b, int h, int qb, LAS unsigned char* lds) {
    const int tid = threadIdx.x, wid = __builtin_amdgcn_readfirstlane(tid >> 6), lane = tid & 63, r32 = lane & 31, hi = lane >> 5;
    const size_t rowq = (size_t)b * SEQ + qb * QB + wid * QBLK + r32;
    i32x8q qr[3];
    { const GAS unsigned char* qn8 = (const GAS unsigned char*)T.QN + rowq * 2048 + h * 128 + 32 * hi; const GAS unsigned char* qr8 = (const GAS unsigned char*)T.QR + rowq * 1024 + h * 64 + 32 * hi;
#pragma unroll
      for (int j = 0; j < 2; ++j) qr[j] = __builtin_shufflevector(*(const GAS i32x4q*)(qn8 + 64 * j), *(const GAS i32x4q*)(qn8 + 64 * j + 16), 0, 1, 2, 3, 4, 5, 6, 7);
      qr[2] = __builtin_shufflevector(*(const GAS i32x4q*)qr8, *(const GAS i32x4q*)(qr8 + 16), 0, 1, 2, 3, 4, 5, 6, 7); }
    const int NT = 4 * (qb + 1);
    const int qlo = qb * QB + wid * QBLK, qm = qlo + r32 - 4 * hi;
    LAS float* ws = (LAS float*)(lds + OFF_WS) + wid * 64; LAS float* li_l = ws; LAS float* al_l = ws + 32;
    float mhat = 0.f, l_reg = 0.f; f32x16 o[4] = {}; bool resc = false;
    const LAS unsigned char* vp0 = lds + OFF_V + v_rd_base(lane);
    const LAS unsigned char* kr0 = lds + OFF_K + r32 * 128; const LAS unsigned char* rr0 = lds + OFF_R + r32 * 64; const int kx = (r32 >> 1) & 7, rx = (r32 >> 2) & 3;
    int voff[2], koff, roff;
#pragma unroll
    for (int i = 0; i < 2; ++i) { const int G_ = (wid + 8 * i) * 64 + lane;
        { const int st = G_ >> 5, w_ = G_ & 31, kk = (st >> 2) * 8 + (w_ >> 2), c = (st & 3) * 32 + (w_ & 3) * 8, k = (kk & ~0xC) | ((kk & 4) << 1) | ((kk & 8) >> 1); voff[i] = (k * 2048 + c) * 2; } }
    { const int G_ = wid * 64 + lane, row = G_ >> 3, slot = G_ & 7; koff = row * 2048 + 16 * (slot ^ ((row >> 1) & 7)); }
    { const int G_ = (wid & 3) * 64 + lane, row = G_ >> 2, slot = G_ & 3; roff = row * 64 + 16 * (slot ^ ((row >> 2) & 3)); }
    const unsigned char* Kh = (const unsigned char*)T.KN + (size_t)b * SEQ * 2048 + h * 128; const bf16* Vh = T.VB + (size_t)b * SEQ * 2048 + h * 128; const unsigned char* Rh = (const unsigned char*)T.KR + (size_t)b * SEQ * 64;
#define MLA_GLDS(base_, off_, dst_) do { unsigned sv_; const void* g_ = (const void*)(base_); const unsigned o_ = (unsigned)(off_); const unsigned d_ = (unsigned)__builtin_amdgcn_readfirstlane((int)(unsigned)(uintptr_t)(dst_)); \
        asm volatile("s_mov_b32 %0, m0\n\ts_mov_b32 m0, %3\n\ts_nop 0\n\tglobal_load_lds_dwordx4 %1, %2\n\ts_mov_b32 m0, %0" : "=&s"(sv_) : "v"(o_), "s"(g_), "s"(d_) : "memory"); } while (0)
#define MLA_DMA_V(k0, bf) do { _Pragma("unroll") for (int i_ = 0; i_ < 2; ++i_) MLA_GLDS((const unsigned char*)Vh + (size_t)(k0) * 4096, voff[i_], lds + OFF_V + (bf) * SHM_V + (wid + 8 * i_) * 1024); } while (0)
#define MLA_DMA_K(k0, bf) do { MLA_GLDS(Kh + (size_t)(k0) * 2048, koff, lds + OFF_K + (bf) * SHM_K + wid * 1024); \
        if (wid < 4) MLA_GLDS(Rh + (size_t)(k0) * 64, roff, lds + OFF_R + (bf) * SHM_R + wid * 1024); } while (0)
#define MLA_WAITBAR() do { asm volatile("s_waitcnt vmcnt(0)" ::: "memory"); __syncthreads(); } while (0)
#define MLA_WAITBAR_C() do { if (wid < 4) asm volatile("s_waitcnt vmcnt(4)" ::: "memory"); else asm volatile("s_waitcnt vmcnt(3)" ::: "memory"); __syncthreads(); } while (0)
#define MLA_PIN(x) asm volatile("" : "+v"(x))
#define MLA_RESC() do { if (resc) { _Pragma("unroll") for (int d_ = 0; d_ < 4; ++d_) _Pragma("unroll") for (int r = 0; r < 16; ++r) o[d_][r] *= al_l[crow(r, hi)]; } } while (0)
#define MLA_QMF(C_, a_, j_, I_) C_ = __builtin_amdgcn_mfma_scale_f32_32x32x64_f8f6f4(a_, qr[j_], I_, 0, 0, 0, 127, 0, 127 - 3)
#define MLA_KF(N_) kfrag<N_>(kr_, rr_, hi, kx, rx)
#define MLA_PK4(P, B_, OUT) do { unsigned a0 = cvtpk(P[B_ + 0], P[B_ + 1]), a1 = cvtpk(P[B_ + 2], P[B_ + 3]); unsigned b0 = cvtpk(P[B_ + 4], P[B_ + 5]), b1 = cvtpk(P[B_ + 6], P[B_ + 7]); \
        auto r0 = __builtin_amdgcn_permlane32_swap(a0, b0, false, false); auto r1 = __builtin_amdgcn_permlane32_swap(a1, b1, false, false); \
        OUT = (v4u){r0[0], r1[0], r0[1], r1[1]}; } while (0)
#define MLA_S2(P, i) do { sa0 += P[i]; sa1 += P[(i) + 1]; } while (0)
#define MLA_EX2S(X, i) do { X[i] = __builtin_amdgcn_exp2f(X[i] - mhat); X[(i) + 1] = __builtin_amdgcn_exp2f(X[(i) + 1] - mhat); } while (0)
#define MLA_EX2(X, i) do { X[i] = __builtin_amdgcn_exp2f(X[i]); X[(i) + 1] = __builtin_amdgcn_exp2f(X[(i) + 1]); } while (0)
#define MLA_VRD(n) do { vlo[n] = vtr(vp_ + (((n) & 3) * 512 + ((n) >> 2) * 4096)); vhi[n] = vtr(vp_ + (((n) & 3) * 512 + ((n) >> 2) * 4096 + 2048)); } while (0)
#define MLA_VFR(n) (bf16x8){vlo[n][0], vlo[n][1], vlo[n][2], vlo[n][3], vhi[n][0], vhi[n][1], vhi[n][2], vhi[n][3]}
#define MLA_PAF(k) __builtin_bit_cast(bf16x8, pw##k)
#define MLA_GAPB(n, k, X, i) do { o[(n) & 3] = __builtin_amdgcn_mfma_f32_32x32x16_bf16(MLA_PAF(k), MLA_VFR(n), o[(n) & 3], 0, 0, 0); if ((n) + 2 < 16) MLA_VRD((n) + 2 < 16 ? (n) + 2 : 15); \
        MLA_EX2(X, i); MLA_PIN(X); MLA_SBAR(); } while (0)
    f32x16 pA0, pA1, pB0, pB1; v4u pw0, pw1, pw2, pw3; s16x4 vlo[16], vhi[16]; i32x8q kf0, kf1;
    int ks_cur = 0, ks_nxt = 1, ks_n2 = 2, ks_n3 = 3, vs_rd = 2, vs_mid = 0, vs_wr = 1;
#define MLA_ROT() do { const int o_ = ks_cur; ks_cur = ks_nxt; ks_nxt = ks_n2; ks_n2 = ks_n3; ks_n3 = o_; const int p_ = vs_rd; vs_rd = vs_mid; vs_mid = vs_wr; vs_wr = p_; } while (0)
    MLA_DMA_K(0, 0); MLA_DMA_K(KVBLK, 1); MLA_DMA_K(2 * KVBLK, 2); MLA_DMA_V(0, 0); MLA_WAITBAR();
    MLA_DMA_K(3 * KVBLK, 3); MLA_DMA_V(KVBLK, 1);
    qkt<0>(pA0, pA1, lds, r32, hi, qr);
    if (NT == 4) mask_tile(pA0, pA1, qm);
    mhat = rowmax(pA0, pA1);
#pragma unroll
    for (int r = 0; r < 16; r += 2) { MLA_EX2S(pA0, r); MLA_EX2S(pA1, r); }
#define MLA_SEED(X) do { const float nm_ = -mhat; _Pragma("unroll") for (int r_ = 0; r_ < 16; ++r_) X[r_] = nm_; MLA_PIN(X); } while (0)
    MLA_SEED(pB0); MLA_SEED(pB1);
    MLA_ROT();
    { const LAS unsigned char* kr_ = kr0 + ks_cur * SHM_K; const LAS unsigned char* rr_ = rr0 + ks_cur * SHM_R; kf0 = MLA_KF(0); kf1 = MLA_KF(1); }
    MLA_WAITBAR_C();
#define MLA_MX(X, i) fmaxf(fmaxf(X[i], X[(i) + 1]), fmaxf(X[(i) + 2], X[(i) + 3]))
#define MLA_PV(n, k) o[(n) & 3] = __builtin_amdgcn_mfma_f32_32x32x16_bf16(MLA_PAF(k), MLA_VFR(n), o[(n) & 3], 0, 0, 0)
#define MLA_VN(n) do { if ((n) + 4 < 16) MLA_VRD((n) + 4 < 16 ? (n) + 4 : 15); } while (0)
#define MLA_STEP(C0, C1, P0, P1, t, MASK, GK, GN) do { MLA_SBAR(); \
    const LAS unsigned char* kr_ = kr0 + ks_cur * SHM_K; const LAS unsigned char* rr_ = rr0 + ks_cur * SHM_R; const LAS unsigned char* vp_ = vp0 + vs_rd * SHM_V; \
    i32x8q kf2, kf3, kf4, kf5; \
    float sa0 = P0[0], sa1 = P0[1]; \
    MLA_QMF(C0, kf0, 0, C0); kf2 = MLA_KF(2); MLA_S2(P0, 2); MLA_S2(P0, 4); MLA_S2(P0, 6); MLA_PK4(P0, 0, pw0); MLA_PIN(pw0); MLA_PIN(sa0); MLA_PIN(sa1); MLA_SBAR(); \
    MLA_QMF(C1, kf1, 0, C1); kf3 = MLA_KF(3); MLA_S2(P0, 8); MLA_S2(P0, 10); MLA_S2(P0, 12); MLA_S2(P0, 14); MLA_PK4(P0, 8, pw1); MLA_PIN(pw1); MLA_PIN(sa0); MLA_PIN(sa1); MLA_SBAR(); \
    if (GK) MLA_DMA_K(((t) + 3) * KVBLK, ks_n3); if (GN) MLA_DMA_V(((t) + 1) * KVBLK, vs_wr); MLA_SBAR();                          \
    MLA_QMF(C0, kf2, 1, C0); kf4 = MLA_KF(4); MLA_S2(P1, 0); MLA_S2(P1, 2); MLA_S2(P1, 4); MLA_S2(P1, 6); MLA_PK4(P1, 0, pw2); MLA_PIN(pw2); MLA_PIN(sa0); MLA_PIN(sa1); MLA_SBAR(); \
    MLA_QMF(C1, kf3, 1, C1); kf5 = MLA_KF(5); MLA_VRD(0); MLA_S2(P1, 8); MLA_S2(P1, 10); MLA_S2(P1, 12); MLA_S2(P1, 14); MLA_PK4(P1, 8, pw3); MLA_PIN(pw3); MLA_PIN(sa0); MLA_PIN(sa1); MLA_SBAR(); \
    MLA_QMF(C0, kf4, 2, C0); MLA_VRD(1); MLA_VRD(2); MLA_SBAR(); \
    MLA_QMF(C1, kf5, 2, C1); MLA_VRD(3); l_reg += sa0 + sa1; MLA_SBAR(); \
      \
    MLA_PV(0, 0); MLA_VN(0); MLA_SBAR(); \
    MLA_PV(1, 0); MLA_VN(1); if (MASK) mask_tile(C0, C1, qm - (t) * KVBLK); \
    float mx0 = C0[0]; _Pragma("unroll") for (int r_ = 1; r_ < 8; ++r_) mx0 = fmaxf(mx0, C0[r_]); MLA_SBAR(); \
    MLA_PV(2, 0); MLA_VN(2); _Pragma("unroll") for (int r_ = 8; r_ < 16; ++r_) mx0 = fmaxf(mx0, C0[r_]); MLA_SBAR(); \
    MLA_PV(3, 0); MLA_VN(3); _Pragma("unroll") for (int r_ = 0; r_ < 8; ++r_) mx0 = fmaxf(mx0, C1[r_]); MLA_SBAR(); \
    MLA_PV(4, 1); MLA_VN(4); _Pragma("unroll") for (int r_ = 8; r_ < 16; ++r_) mx0 = fmaxf(mx0, C1[r_]); \
    { auto rr_x = __builtin_amdgcn_permlane32_swap(__float_as_uint(mx0), __float_as_uint(mx0), false, false); mx0 = fmaxf(__uint_as_float(rr_x[0]), __uint_as_float(rr_x[1])); } \
    { resc = false;                                                                                                      \
      if (__builtin_expect(__any(mx0 > THR), 0)) { const float dl = fmaxf(mx0, 0.f); mhat += dl;                          \
          const float f = __builtin_amdgcn_exp2f(-dl); l_reg *= f; if (hi == 0) al_l[r32] = f; resc = true;                \
          _Pragma("unroll") for (int r_ = 0; r_ < 16; ++r_) { C0[r_] -= dl; C1[r_] -= dl; } } }                          \
    MLA_SBAR(); \
    MLA_PV(5, 1);  MLA_VN(5);  MLA_EX2(C0, 0);  MLA_EX2(C0, 2);  MLA_PIN(C0); MLA_SBAR(); \
    MLA_PV(6, 1);  MLA_VN(6);  MLA_EX2(C0, 4);  MLA_EX2(C0, 6);  MLA_PIN(C0); MLA_SBAR(); \
    MLA_PV(7, 1);  MLA_VN(7);  MLA_EX2(C0, 8);  MLA_EX2(C0, 10); MLA_PIN(C0); MLA_SBAR(); \
    MLA_PV(8, 2);  MLA_VN(8);  MLA_EX2(C0, 12); MLA_EX2(C0, 14); MLA_PIN(C0); MLA_SBAR(); \
    MLA_PV(9, 2);  MLA_VN(9);  MLA_EX2(C1, 0);  MLA_EX2(C1, 2);  MLA_PIN(C1); MLA_SBAR(); \
    MLA_PV(10, 2); MLA_VN(10); MLA_EX2(C1, 4);  MLA_PIN(C1); MLA_SBAR(); \
    MLA_PV(11, 2); MLA_VN(11); MLA_EX2(C1, 6);  MLA_PIN(C1); MLA_SBAR(); \
    MLA_ROT(); \
    MLA_PV(12, 3); MLA_EX2(C1, 8);  MLA_PIN(C1); if (GN) { const LAS unsigned char* kr_ = kr0 + ks_cur * SHM_K; const LAS unsigned char* rr_ = rr0 + ks_cur * SHM_R; kf0 = MLA_KF(0); } MLA_SBAR(); \
    MLA_PV(13, 3); MLA_EX2(C1, 10); MLA_PIN(C1); if (GN) { const LAS unsigned char* kr_ = kr0 + ks_cur * SHM_K; const LAS unsigned char* rr_ = rr0 + ks_cur * SHM_R; kf1 = MLA_KF(1); } MLA_SBAR(); \
    MLA_PV(14, 3); MLA_EX2(C1, 12); MLA_PIN(C1); MLA_SEED(P0); MLA_SBAR(); \
    MLA_PV(15, 3); MLA_EX2(C1, 14); MLA_PIN(C1); MLA_SEED(P1); MLA_SBAR();                            \
    } while (0)
    int t = 1;
#pragma unroll 1
    for (; t + 5 < NT; t += 2) {
        MLA_STEP(pB0, pB1, pA0, pA1, t, false, true, true);     MLA_WAITBAR_C(); MLA_RESC();
        MLA_STEP(pA0, pA1, pB0, pB1, t + 1, false, true, true); MLA_WAITBAR_C(); MLA_RESC(); }
#pragma unroll 1
    for (; t + 1 < NT; t += 2) {
        MLA_STEP(pB0, pB1, pA0, pA1, t, true, (t + 3 < NT), true);     MLA_WAITBAR(); MLA_RESC();
        MLA_STEP(pA0, pA1, pB0, pB1, t + 1, true, (t + 4 < NT), true); MLA_WAITBAR(); MLA_RESC(); }
    MLA_STEP(pB0, pB1, pA0, pA1, NT - 1, true, false, false); MLA_WAITBAR(); MLA_RESC();
    { float sa0 = pB0[0], sa1 = pB0[1];
#pragma unroll
      for (int r = 2; r < 16; r += 2) MLA_S2(pB0, r);
#pragma unroll
      for (int r = 0; r < 16; r += 2) MLA_S2(pB1, r);
      l_reg += sa0 + sa1;
      MLA_PK4(pB0, 0, pw0); MLA_PK4(pB0, 8, pw1); MLA_PK4(pB1, 0, pw2); MLA_PK4(pB1, 8, pw3);
      const LAS unsigned char* vp_ = vp0 + vs_rd * SHM_V;
#pragma unroll
      for (int k = 0; k < 4; ++k) {
#pragma unroll
          for (int d0 = 0; d0 < 4; ++d0) { const s16x4 lo = vtr(vp_ + (d0 * 512 + k * 4096)), hh = vtr(vp_ + (d0 * 512 + k * 4096 + 2048));
              const bf16x8 vf = (bf16x8){lo[0], lo[1], lo[2], lo[3], hh[0], hh[1], hh[2], hh[3]};
              o[d0] = __builtin_amdgcn_mfma_f32_32x32x16_bf16(k == 0 ? MLA_PAF(0) : k == 1 ? MLA_PAF(1) : k == 2 ? MLA_PAF(2) : MLA_PAF(3), vf, o[d0], 0, 0, 0); } } }
    { auto rr = __builtin_amdgcn_permlane32_swap(__float_as_uint(l_reg), __float_as_uint(l_reg), false, false); l_reg = __uint_as_float(rr[0]) + __uint_as_float(rr[1]); }
    if (hi == 0) li_l[r32] = l_reg; asm volatile("s_waitcnt lgkmcnt(0)" ::: "memory");
    unsigned char* Ow = (unsigned char*)T.O + ((size_t)b * SEQ + qb * QB + wid * QBLK) * 2048 + h * 128;
    int hi_e = hi; asm volatile("" : "+v"(hi_e));
#pragma unroll
    for (int r = 0; r < 16; ++r) { const int orow = crow(r, hi_e); const float rl = __builtin_amdgcn_rcpf(li_l[orow]);
#pragma unroll
        for (int d0 = 0; d0 < 4; ++d0) { const float v = o[d0][r] * rl; const float v1 = dppf<0xB1>(v), v2 = dppf<0x4E>(v), v3 = dppf<0x1B>(v);
            if ((r32 & 3) == 0) *(GAS unsigned*)(Ow + (size_t)orow * 2048 + d0 * 32 + r32) = pkf8(v, v1, v2, v3); } }
    __syncthreads();
#undef MLA_DMA_V
#undef MLA_GLDS
#undef MLA_DMA_K
#undef MLA_WAITBAR
#undef MLA_WAITBAR_C
#undef MLA_PIN
#undef MLA_RESC
#undef MLA_QMF
#undef MLA_KF
#undef MLA_PK4
#undef MLA_S2
#undef MLA_EX2
#undef MLA_EX2S
#undef MLA_SEED
#undef MLA_VRD
#undef MLA_VFR
#undef MLA_PAF
#undef MLA_GAPB
#undef MLA_STEP
#undef MLA_ROT
#undef MLA_MX
#undef MLA_PV
#undef MLA_VN
}
}

#if defined(DBG_CHECK)
#ifndef DBG_WORD
#define DBG_WORD 0
#endif
namespace chk {
__device__ __forceinline__ float bsum(float v, LAS float* red, int tid) { red[tid] = v; __syncthreads(); for (int o = 256; o > 0; o >>= 1) { if (tid < o) red[tid] += red[tid + o]; __syncthreads(); } const float r = red[0]; __syncthreads(); return r; }
__device__ __forceinline__ float bmax(float v, LAS float* red, int tid) { red[tid] = v; __syncthreads(); for (int o = 256; o > 0; o >>= 1) { if (tid < o) red[tid] = fmaxf(red[tid], red[tid + o]); __syncthreads(); } const float r = red[0]; __syncthreads(); return r; }
__device__ __forceinline__ float bf(const bf16* p) { return __uint_as_float((unsigned)(*p) << 16); }
__device__ __forceinline__ float hf(const bf16* p) { return (float)__builtin_bit_cast(_Float16, *p); }
__device__ __forceinline__ int sample_t(int smp) { const int k = smp >> 5; const int edge[16] = {0, 1, 31, 32, 63, 64, 255, 256, 257, 511, 512, 4095, 4096, 8190, 8191, 300}; return k < 1 ? edge[smp & 15] : (int)(((unsigned)smp * 2654435761u) >> 13) & 8191; }
__device__ __forceinline__ void amax(float* w, float v) { if (v == v) atomicMax((int*)w, __float_as_int(v)); else atomicMax((int*)w, 0x7f000000); }
__device__ __forceinline__ void mla(const bf16* QN, const bf16* QR, const bf16* KN, const bf16* KR, const bf16* VB, const bf16* O, int smp, LAS float* lg, LAS float* red, LAS float* q, float* dbg, int tid) {
    const int b = smp & 1, h = (smp >> 1) & 15, t = sample_t(smp); const size_t row = (size_t)b * SEQ + t;
    if (tid < 128) q[tid] = bf(QN + row * 2048 + h * 128 + tid); else if (tid < 192) q[tid] = bf(QR + row * 1024 + h * 64 + (tid - 128));
    __syncthreads();
    float mx = -1e30f;
    for (int s = tid; s <= t; s += 512) { const bf16* kn = KN + ((size_t)b * SEQ + s) * 2048 + h * 128; const bf16* kr = KR + ((size_t)b * SEQ + s) * 64; float d = 0.f;
        for (int i = 0; i < 128; ++i) d += q[i] * bf(kn + i); for (int i = 0; i < 64; ++i) d += q[128 + i] * bf(kr + i); lg[s] = d; mx = fmaxf(mx, d); }
    mx = bmax(mx, red, tid); float sm = 0.f;
    for (int s = tid; s <= t; s += 512) { const float p = exp2f(lg[s] - mx); lg[s] = p; sm += p; }
    sm = bsum(sm, red, tid);
    float o = 0.f;
    if (tid < 128) { for (int s = 0; s <= t; ++s) o += lg[s] * bf(VB + ((size_t)b * SEQ + s) * 2048 + h * 128 + tid); o /= sm; }
    const float rms = sqrtf(bsum(tid < 128 ? o * o : 0.f, red, tid) / 128.f) + 1e-20f;
    const float e = tid < 128 ? fabsf(o - bf(O + row * 2048 + h * 128 + tid)) / rms : 0.f;
    const float em = bmax(e, red, tid);
    if (tid == 0) amax(dbg + 0, em);
    __syncthreads();
}
template <bool TRUE_SC> __device__ __forceinline__ void dsa(const float* x, const float* w_in, const bf16* QI, const bf16* KI, const float* WI, const bf16* QA, const bf16* KA, const bf16* VA, const bf16* O, const unsigned short* SEL, int smp, LAS float* sc, LAS float* red, LAS float* aux, float* dbg, int tid) {
    const int b = smp & 1, t = sample_t(smp >> 1 << 1 | 0) ; const size_t row = (size_t)b * SEQ + t;
    LAS float* qi = aux;
    LAS unsigned* sel = (LAS unsigned*)(aux + 1024);
    LAS float* pr = aux + 2048;
    LAS unsigned* cnt = (LAS unsigned*)(aux + 2048 + 4096);
    LAS float* wt = aux + 2048 + 4096 + 64;
    if (TRUE_SC) {
        for (int i = tid; i < 1024 + 16; i += 512) { const int c = i < 1024 ? U_QI + i : U_WI + (i - 1024); float d = 0.f; for (int k = 0; k < 2048; ++k) d += x[row * 2048 + k] * w_in[(size_t)k * DIN + c]; if (i < 1024) qi[i] = d; else wt[i - 1024] = d; }
        __syncthreads();
        for (int s = tid; s <= t; s += 512) { float kk[64];
#pragma unroll
            for (int c = 0; c < 64; ++c) kk[c] = 0.f;
            const float* xs = x + ((size_t)b * SEQ + s) * 2048;
            for (int k = 0; k < 2048; ++k) { const float xv = xs[k]; const float* wr = w_in + (size_t)k * DIN + U_KI;
#pragma unroll
                for (int c = 0; c < 64; ++c) kk[c] += xv * wr[c]; }
            float tot = 0.f;
#pragma unroll
            for (int hh = 0; hh < 16; ++hh) { float d = 0.f;
#pragma unroll
                for (int i = 0; i < 64; ++i) d += qi[hh * 64 + i] * kk[i];
                tot += wt[hh] * fmaxf(d, 0.f); }
            sc[s] = tot; }
    } else {
    for (int i = tid; i < 1024; i += 512) qi[i] = hf(QI + row * 1024 + i);
    __syncthreads();
    for (int s = tid; s <= t; s += 512) { const bf16* k = KI + ((size_t)b * SEQ + s) * 64; float tot = 0.f;
        for (int hh = 0; hh < 16; ++hh) { float d = 0.f; for (int i = 0; i < 64; ++i) d += qi[hh * 64 + i] * hf(k + i); tot += WI[row * 16 + hh] * fmaxf(d, 0.f); }
        sc[s] = tot; }
    }
    __syncthreads();
    const int n = t + 1, want = n < 256 ? n : 256;
    unsigned T = 0u;
    for (int bit = 31; bit >= 0; --bit) { const unsigned cand = T | (1u << bit); if (tid == 0) cnt[0] = 0u; __syncthreads(); unsigned c = 0u;
        for (int s = tid; s <= t; s += 512) c += (dsa::fkey(sc[s]) >= cand) ? 1u : 0u;
        if (c) atomicAdd((unsigned*)cnt, c); __syncthreads(); if (cnt[0] >= (unsigned)want) T = cand; __syncthreads(); }
    if (tid == 0) { cnt[0] = 0u; cnt[1] = 0u; } __syncthreads();
    { unsigned c = 0u; for (int s = tid; s <= t; s += 512) c += (dsa::fkey(sc[s]) > T) ? 1u : 0u; if (c) atomicAdd((unsigned*)cnt + 1, c); }
    __syncthreads();
    const unsigned cgt = cnt[1]; __syncthreads(); if (tid == 0) cnt[1] = 0u;
    for (int s = tid; s <= t; s += 512) { const unsigned ky = dsa::fkey(sc[s]); bool take = ky > T;
        if (ky == T) { unsigned rk = 0u; for (int s2 = 0; s2 < s; ++s2) rk += (dsa::fkey(sc[s2]) == T) ? 1u : 0u; take = cgt + rk < (unsigned)want; }
        if (take) { const unsigned p = atomicAdd((unsigned*)cnt, 1u); if (p < 256u) sel[p] = (unsigned)s; } }
    __syncthreads();
    const int nref = (int)(cnt[0] < 256u ? cnt[0] : 256u);
    if (tid < 256) sel[256 + tid] = SEL[row * 256 + tid];
    __syncthreads();
    { float miss = 0.f; if (tid < 256) { const unsigned s = sel[256 + tid]; if (s != 0xFFFFu) { bool found = false; for (int j = 0; j < nref; ++j) found |= (sel[j] == s); miss = found ? 0.f : 1.f; } }
      const float tm = bsum(miss, red, tid); if (tid == 0) { amax(dbg + 1, tm / (float)want); atomicAdd(dbg + 13, tm); } }
    for (int pass = 0; pass < 2; ++pass) {
        const int ns = pass == 0 ? nref : 256; LAS unsigned* sl = sel + pass * 256;
        for (int e = tid; e < 16 * 256; e += 512) { const int hh = e >> 8, j = e & 255; float v = -1e30f;
            if (j < ns && sl[j] != 0xFFFFu) { const unsigned s = sl[j]; const bf16* k = KA + ((size_t)b * SEQ + s) * 128; float d = 0.f; for (int i = 0; i < 128; ++i) d += bf(QA + row * 2048 + hh * 128 + i) * bf(k + i);
                v = d - exp2f(-0.5f * (float)(hh + 1)) * LOG2E * (float)(t - (int)s); }
            pr[e] = v; }
        __syncthreads();
        if (tid < 16) { float mx = -1e30f; for (int j = 0; j < 256; ++j) mx = fmaxf(mx, pr[tid * 256 + j]); float sm = 0.f; for (int j = 0; j < 256; ++j) { const float p = pr[tid * 256 + j] <= -1e29f ? 0.f : exp2f(pr[tid * 256 + j] - mx); pr[tid * 256 + j] = p; sm += p; }
            for (int j = 0; j < 256; ++j) pr[tid * 256 + j] /= sm; }
        __syncthreads();
        float e4 = 0.f, q4 = 0.f, s4 = 0.f;
        for (int e = tid; e < 2048; e += 512) { const int hh = e >> 7, d = e & 127; float o = 0.f;
            for (int j = 0; j < ns; ++j) { const unsigned s = sl[j]; if (s != 0xFFFFu) o += pr[hh * 256 + j] * bf(VA + ((size_t)b * SEQ + s) * 128 + d); }
            q4 += o * o; const float df = o - bf(O + row * 2048 + e); e4 = fmaxf(e4, fabsf(df)); s4 += df * df; }
        const float rms = sqrtf(bsum(q4, red, tid) / 2048.f) + 1e-20f; const float em = bmax(e4, red, tid); const float esq = bsum(s4, red, tid);
        if (tid == 0) { amax(dbg + (pass == 0 ? 0 : 2), em / rms); if (pass == 0) atomicAdd(dbg + 14, esq / (rms * rms * 2048.f)); }
        __syncthreads();
    }
}
__device__ __forceinline__ void p1(const float* x, const float* w_in, const bf16* QA, const bf16* QI, const bf16* KA, const bf16* VA, const bf16* KI, const float* WI, const bf16* CQ, const bf16* CKV, const bf16* KR, int smp, LAS float* xr, LAS float* red, LAS float* tru, float* dbg, int tid) {
    const size_t row = (size_t)(((unsigned)smp * 2654435761u) >> 9) % M; const int pos = (int)(row & (SEQ - 1));
    for (int i = tid; i < 2048; i += 512) xr[i] = x[row * 2048 + i];
    __syncthreads();
    for (int c = tid; c < U_G; c += 512) { float d = 0.f; for (int k = 0; k < 2048; ++k) d += xr[k] * w_in[(size_t)k * DIN + c]; tru[c] = d; }
    __syncthreads();
    for (int ty = 0; ty < 9; ++ty) {
        const int c0 = ty == 0 ? U_QA : ty == 1 ? U_QI : ty == 2 ? U_KA : ty == 3 ? U_VA : ty == 4 ? U_KI : ty == 5 ? U_WI : ty == 6 ? U_CQ : ty == 7 ? U_CKV : U_KPE;
        const int nc = ty == 0 ? 2048 : ty == 1 ? 1024 : ty == 2 ? 128 : ty == 3 ? 128 : ty == 4 ? 64 : ty == 5 ? 16 : ty == 6 ? 512 : ty == 7 ? 512 : 64;
        float q = 0.f, e = 0.f;
        for (int c = tid; c < nc; c += 512) { float tv = tru[c0 + c], sv;
            if (ty == 0) { tv *= QA_SCALE; sv = bf(QA + row * 2048 + c); } else if (ty == 1) sv = hf(QI + row * 1024 + c); else if (ty == 2) sv = bf(KA + row * 128 + c); else if (ty == 3) sv = bf(VA + row * 128 + c);
            else if (ty == 4) sv = hf(KI + row * 64 + c); else if (ty == 5) sv = WI[row * 16 + c]; else if (ty == 6) sv = bf(CQ + row * 512 + c); else if (ty == 7) sv = bf(CKV + row * 512 + c);
            else { const int i = c & 31; const float ang = (float)pos * exp2f(-(float)i * (13.287712379549449f / 32.f)), cs = cosf(ang), sn = sinf(ang); const float x1 = tru[c0 + i], x2 = tru[c0 + 32 + i]; tv = c < 32 ? x1 * cs - x2 * sn : x1 * sn + x2 * cs; sv = bf(KR + row * 64 + c); }
            q += tv * tv; e = fmaxf(e, fabsf(tv - sv)); }
        const float rms = sqrtf(bsum(q, red, tid) / (float)nc) + 1e-20f; const float em = bmax(e, red, tid) / rms;
        if (tid == 0) { amax(dbg + 3 + ty, em); amax(dbg + 12, em); }
        __syncthreads();
    }
}
__device__ __forceinline__ void p2(const bf16* CQ, const bf16* CKV, const float* gq, const float* gkv, const float* w_uq, const float* w_uk, const float* w_uv, const bf16* QN, const bf16* QR, const bf16* KN, const bf16* VB,
                                   int smp, LAS float* cr, LAS float* red, LAS float* tru, float* dbg, int tid) {
    const size_t row = (size_t)(((unsigned)smp * 2654435761u) >> 9) % M; const int pos = (int)(row & (SEQ - 1));
    for (int i = tid; i < 1024; i += 512) cr[i] = i < 512 ? bf(CQ + row * 512 + i) : bf(CKV + row * 512 + (i - 512));
    __syncthreads();
    const float ssq = bsum(cr[tid] * cr[tid], red, tid), ssk = bsum(cr[512 + tid] * cr[512 + tid], red, tid);
    const float rq = 1.f / sqrtf(ssq / 512.f + RMS_EPS), rk = 1.f / sqrtf(ssk / 512.f + RMS_EPS);
    for (int n = tid; n < 3072 + 4096; n += 512) { float d = 0.f;
        if (n < 3072) { for (int k = 0; k < 512; ++k) d += cr[k] * gq[k] * w_uq[(size_t)k * 3072 + n]; d *= rq * QB_SCALE; }
        else if (n < 3072 + 2048) { for (int k = 0; k < 512; ++k) d += cr[512 + k] * gkv[k] * w_uk[(size_t)k * 2048 + (n - 3072)]; d *= rk; }
        else { for (int k = 0; k < 512; ++k) d += cr[512 + k] * gkv[k] * w_uv[(size_t)k * 2048 + (n - 5120)]; d *= rk; }
        tru[n] = d; }
    __syncthreads();
    float q = 0.f, e = 0.f;
    for (int n = tid; n < 2048; n += 512) { const int h = n >> 7, d = n & 127; const float tv = tru[h * 192 + d]; q += tv * tv; e = fmaxf(e, fabsf(tv - bf(QN + row * 2048 + n))); }
    { const float rms = sqrtf(bsum(q, red, tid) / 2048.f) + 1e-20f; const float em = bmax(e, red, tid) / rms; if (tid == 0) { amax(dbg + 0, em); amax(dbg + 1, em); } }
    q = 0.f; e = 0.f;
    for (int n = tid; n < 1024; n += 512) { const int h = n >> 6, c = n & 63, i = c & 31; const float ang = (float)pos * exp2f(-(float)i * (13.287712379549449f / 32.f)), cs = cosf(ang), sn = sinf(ang);
        const float x1 = tru[h * 192 + 128 + i], x2 = tru[h * 192 + 160 + i], tv = c < 32 ? x1 * cs - x2 * sn : x1 * sn + x2 * cs; q += tv * tv; e = fmaxf(e, fabsf(tv - bf(QR + row * 1024 + n))); }
    { const float rms = sqrtf(bsum(q, red, tid) / 1024.f) + 1e-20f; const float em = bmax(e, red, tid) / rms; if (tid == 0) { amax(dbg + 0, em); amax(dbg + 2, em); } }
    q = 0.f; e = 0.f;
    for (int n = tid; n < 2048; n += 512) { const float tv = tru[3072 + n]; q += tv * tv; e = fmaxf(e, fabsf(tv - bf(KN + row * 2048 + n))); }
    { const float rms = sqrtf(bsum(q, red, tid) / 2048.f) + 1e-20f; const float em = bmax(e, red, tid) / rms; if (tid == 0) { amax(dbg + 0, em); amax(dbg + 3, em); } }
    q = 0.f; e = 0.f;
    for (int n = tid; n < 2048; n += 512) { const float tv = tru[5120 + n]; q += tv * tv; e = fmaxf(e, fabsf(tv - bf(VB + row * 2048 + n))); }
    { const float rms = sqrtf(bsum(q, red, tid) / 2048.f) + 1e-20f; const float em = bmax(e, red, tid) / rms; if (tid == 0) { amax(dbg + 0, em); amax(dbg + 4, em); } }
    __syncthreads();
}
__device__ __forceinline__ void gchk(const float* x, const float* w_in, const bf16* GS, const bf16* XHS, size_t row, LAS float* xr, LAS float* red, float* dbg, int tid) {
    for (int i = tid; i < 2048; i += 512) xr[i] = x[row * 2048 + i];
    __syncthreads();
    float eg = 0.f;
    for (int c = tid; c < 4096; c += 512) { float l0 = 0.f; for (int k = 0; k < 2048; ++k) l0 += xr[k] * w_in[(size_t)k * DIN + U_G + c]; eg = fmaxf(eg, fabsf(1.f / (1.f + expf(-l0)) - bf(GS + row * 4096 + c))); }
    const float egm = bmax(eg, red, tid);
    float ex = 0.f; for (int i = tid; i < 2048; i += 512) ex = fmaxf(ex, fabsf(xr[i] - hf(XHS + row * 2048 + i))); const float exm = bmax(ex, red, tid);
    int nb = 0; for (int c = tid; c < 4096; c += 512) { float l0 = 0.f; for (int k = 0; k < 2048; ++k) l0 += xr[k] * w_in[(size_t)k * DIN + U_G + c]; nb += fabsf(1.f / (1.f + expf(-l0)) - bf(GS + row * 4096 + c)) > 0.05f ? 1 : 0; }
    const float nbt = bsum((float)nb, red, tid);
    if (tid == 0) { amax(dbg + 0, egm); if (egm > 0.05f) { atomicAdd(dbg + 1, 1.0f); amax(dbg + 3, nbt); amax(dbg + 4, 4097.f - nbt); } amax(dbg + 2, exm); }
    __syncthreads();
}
__device__ __forceinline__ void mid(const float* x, const float* w_in, const float* wa, const float* wb, const float* wo, const bf16* AA, const bf16* AB, const bf16* GS, const bf16* MTS, const float* Z, size_t row, int vtag, LAS float* va, LAS float* red, LAS float* mg, float* dbg, int tid) {
    LAS float* vb = va + 2048; LAS float* xr = va + 4096;
    for (int i = tid; i < 2048; i += 512) { va[i] = bf(AA + row * 2048 + i); vb[i] = bf(AB + row * 2048 + i); xr[i] = x[row * 2048 + i]; }
    __syncthreads();
    float eg = 0.f, qm = 0.f, emt = 0.f; int cmx = -1, cmn = 1 << 20;
    for (int c = tid; c < 2048; c += 512) { float l0 = 0.f, l1 = 0.f, ma = 0.f, mb = 0.f;
        for (int k = 0; k < 2048; ++k) { const float xv = xr[k]; l0 += xv * w_in[(size_t)k * DIN + U_G + c]; l1 += xv * w_in[(size_t)k * DIN + U_G + 2048 + c]; ma += va[k] * wa[(size_t)k * 2048 + c]; mb += vb[k] * wb[(size_t)k * 2048 + c]; }
        const float g0 = 1.f / (1.f + expf(-l0)), g1 = 1.f / (1.f + expf(-l1)); mg[c] = ma * g0 + mb * g1;
        { const float e0 = fabsf(g0 - bf(GS + row * 4096 + c)), e1 = fabsf(g1 - bf(GS + row * 4096 + 2048 + c)); eg = fmaxf(eg, fmaxf(e0, e1)); if (e0 > 0.05f) { cmx = max(cmx, c); cmn = min(cmn, c); } if (e1 > 0.05f) { cmx = max(cmx, 2048 + c); cmn = min(cmn, 2048 + c); } } qm += mg[c] * mg[c]; emt = fmaxf(emt, fabsf(mg[c] - bf(MTS + row * 2048 + c))); }
    { const float egm = bmax(eg, red, tid); const float rm = sqrtf(bsum(qm, red, tid) / 2048.f) + 1e-20f; const float emm = bmax(emt, red, tid) / rm; if (tid == 0) { amax(dbg + 17, egm); amax(dbg + 18, emm); if (egm > 0.05f) { amax(dbg + 19, (float)(row & 255) + 1.0f); amax(dbg + 20, (float)(255 - (row & 255)) + 1.0f); atomicAdd(dbg + 21, 1.0f); amax(dbg + 22, (float)vtag + 1.0f); amax(dbg + 23, (float)(255 - vtag) + 1.0f); } }
      const float fx = bmax((float)cmx, red, tid), fn = bmax((float)(4096 - cmn), red, tid); if (tid == 0 && fx >= 0.f) { amax(dbg + 24, fx + 1.0f); amax(dbg + 25, fn + 1.0f); } }
    __syncthreads();
    float q = 0.f, e = 0.f;
    for (int c = tid; c < 2048; c += 512) { float d = 0.f; for (int k = 0; k < 2048; ++k) d += mg[k] * wo[(size_t)k * 2048 + c]; q += d * d; e = fmaxf(e, fabsf(ALPHA * xr[c] + d - Z[row * 2048 + c])); }
    const float rms = sqrtf(bsum(q, red, tid) / 2048.f) + 1e-20f; const float em = bmax(e, red, tid) / rms;
    if (tid == 0) { amax(dbg + 0, em); if (em > 0.25f) { atomicAdd(dbg + 13, 1.0f); amax(dbg + 15, (float)(row & 255) + 1.0f); amax(dbg + 16, (float)(row >> 8) + 1.0f); } }
    __syncthreads();
}
__device__ __forceinline__ void endp(const bf16* X1B, const float* x1f_unused, const float* p, const float* w_up, const float* cw, const float* cb, const float* w_down, const float* w_pg, const float* b_pg, const float* w_pe, const float* g2, const float* b2,
                                     const float* OUT, int smp, LAS float* xs, LAS float* red, LAS float* act, float* dbg, int tid) {
    const int k6 = smp & 7; const size_t rbase = (size_t)(((unsigned)smp * 2654435761u) >> 9) % M; const size_t row = k6 == 0 ? (rbase & ~(size_t)63) : k6 == 1 ? (rbase & ~(size_t)63) + 1 : k6 == 2 ? (rbase & ~(size_t)8191) : rbase; const int t = (int)(row & (SEQ - 1));
    LAS float* z = act + 5632; LAS float* pr = act + 5632 + 2048;
    for (int i = tid; i < 3 * 2048; i += 512) { const int j = i >> 11, c = i & 2047; const int tt = t - 2 + j; xs[i] = tt >= 0 ? bf(X1B + (row - 2 + j) * 2048 + c) : 0.f; }
    for (int i = tid; i < 256; i += 512) pr[i] = p[row * 256 + i];
    __syncthreads();
    for (int ch = tid; ch < DFF; ch += 512) { float hg[3] = {0.f, 0.f, 0.f}, hv[3] = {0.f, 0.f, 0.f};
        for (int k = 0; k < 2048; ++k) { const float wg = w_up[(size_t)k * NUP + ch], wv = w_up[(size_t)k * NUP + DFF + ch];
#pragma unroll
            for (int j = 0; j < 3; ++j) { hg[j] += xs[j * 2048 + k] * wg; hv[j] += xs[j * 2048 + k] * wv; } }
        float yg = cb[ch], yv = cb[DFF + ch];
#pragma unroll
        for (int j = 0; j < 3; ++j) { yg += cw[(size_t)j * NUP + ch] * hg[j]; yv += cw[(size_t)j * NUP + DFF + ch] * hv[j]; }
        act[ch] = yg / (1.f + expf(-yg)) * yv; }
    __syncthreads();
    for (int c = tid; c < 2048; c += 512) { float f = 0.f, lg = b_pg[c], pe = 0.f;
        for (int k = 0; k < DFF; ++k) f += act[k] * w_down[(size_t)k * 2048 + c];
        for (int k = 0; k < 2048; ++k) lg += xs[2 * 2048 + k] * w_pg[(size_t)k * 2048 + c];
        for (int k = 0; k < 256; ++k) pe += pr[k] * w_pe[(size_t)k * 2048 + c];
        z[c] = ALPHA * xs[2 * 2048 + c] + f + pe / (1.f + expf(-lg)); }
    __syncthreads();
    float s = 0.f; for (int c = tid; c < 2048; c += 512) s += z[c];
    const float mean = bsum(s, red, tid) / 2048.f; float s2 = 0.f; for (int c = tid; c < 2048; c += 512) s2 += (z[c] - mean) * (z[c] - mean);
    const float rstd = 1.f / sqrtf(bsum(s2, red, tid) / 2048.f + LN_EPS); float e = 0.f;
    for (int c = tid; c < 2048; c += 512) e = fmaxf(e, fabsf((z[c] - mean) * rstd * g2[c] + b2[c] - OUT[row * 2048 + c]));
    const float em = bmax(e, red, tid);
    if (tid == 0) { amax(dbg + 0, em); amax(dbg + 1 + (k6 < 3 ? k6 : 3), em); }
    __syncthreads();
}
}
#endif

__device__ __forceinline__ int own_panel(int x, int s) { return s < 4 ? x + 8 * s : 32 + (7 - x) + 8 * (s - 4); }
__device__ __forceinline__ void ln_pass(const bf16* zin, float* fout, bf16* bout, unsigned char* xf8, const float* g, const float* b, int vcu, int wave, int lane) {
#pragma unroll 1
    for (int s_ = 0; s_ < 8; ++s_) { const int m = 256 * own_panel(vcu >> 5, s_) + 8 * (vcu & 31) + wave;
        const GAS v4u* zr = (const GAS v4u*)(zin + (size_t)m * DM) + lane;
        f32x4 v[8]; float s = 0.f;
#pragma unroll
        for (int j = 0; j < 4; ++j) { unpack8(zr[64 * j], v[2 * j], v[2 * j + 1]); s += ((v[2 * j][0] + v[2 * j][1]) + (v[2 * j][2] + v[2 * j][3])) + ((v[2 * j + 1][0] + v[2 * j + 1][1]) + (v[2 * j + 1][2] + v[2 * j + 1][3])); }
        const float mean = wave_sum(s) * (1.f / DM); float s2 = 0.f;
#pragma unroll
        for (int j = 0; j < 8; ++j) { v[j] = v[j] - mean; s2 += (v[j][0] * v[j][0] + v[j][1] * v[j][1]) + (v[j][2] * v[j][2] + v[j][3] * v[j][3]); }
        const float rstd = 1.f / sqrtf(wave_sum(s2) * (1.f / DM) + LN_EPS);
#pragma unroll
        for (int j = 0; j < 4; ++j) { const int e0 = 8 * (lane + 64 * j);
            const f32x4 g0 = *(const GAS f32x4*)(g + e0), g1 = *(const GAS f32x4*)(g + e0 + 4), b0 = *(const GAS f32x4*)(b + e0), b1 = *(const GAS f32x4*)(b + e0 + 4);
            const f32x4 y0 = v[2 * j] * rstd * g0 + b0, y1 = v[2 * j + 1] * rstd * g1 + b1;
            if (fout) { *(GAS f32x4*)(fout + (size_t)m * DM + e0) = y0; *(GAS f32x4*)(fout + (size_t)m * DM + e0 + 4) = y1; }
            if (bout) *(GAS v4u*)(bout + (size_t)m * DM + e0) = pack8(y0, y1);
            if (xf8) { u32x2 w; w.x = pkf8(y0[0], y0[1], y0[2], y0[3]); w.y = pkf8(y1[0], y1[1], y1[2], y1[3]); *(GAS u32x2*)(xf8 + (size_t)m * DM + e0) = w; } }
    }
}
__device__ __forceinline__ void conv_fixup(unsigned char* ACT, const float* HEADB, const float* TAILB, const float* cw, const float* cb, int vcu, int tid) {
    constexpr int CH8 = DFF / 8;
    for (int it = (vcu & 31) * 512 + tid; it < 8 * 4 * 2 * CH8; it += 32 * 512) {
        const int c8 = it % CH8, rr = (it / CH8) & 1, g4 = (it / (2 * CH8)) & 3, s_ = it / (8 * CH8); const int g = own_panel(vcu >> 5, s_) * 4 + g4;
        const int ch = 8 * c8, pg = 256 * (ch >> 7) + (ch & 127); const bool first = (g & 127) == 0;
        f32x4 res[2][2];
#pragma unroll
        for (int bj = 0; bj < 2; ++bj) { const int pc = pg + bj * 128, c = ch + bj * DFF;
#pragma unroll
            for (int n = 0; n < 2; ++n) { const f32x4 z = (f32x4){0.f, 0.f, 0.f, 0.f};
                const f32x4 u0 = *(const GAS f32x4*)(HEADB + ((size_t)g * 2 + rr) * NUP + pc + 4 * n);
                const f32x4 t1 = first ? z : *(const GAS f32x4*)(TAILB + ((size_t)(g - 1) * 2 + 1) * NUP + pc + 4 * n);
                const f32x4 t0 = first ? z : *(const GAS f32x4*)(TAILB + ((size_t)(g - 1) * 2 + 0) * NUP + pc + 4 * n);
                const f32x4 h0 = *(const GAS f32x4*)(HEADB + ((size_t)g * 2 + 0) * NUP + pc + 4 * n);
                const f32x4 u1 = rr ? h0 : t1, u2 = rr ? t1 : t0;
                const f32x4 w0 = *(const GAS f32x4*)(cw + c + 4 * n), w1 = *(const GAS f32x4*)(cw + NUP + c + 4 * n), w2 = *(const GAS f32x4*)(cw + 2 * NUP + c + 4 * n), bb = *(const GAS f32x4*)(cb + c + 4 * n);
                res[bj][n] = bb + w2 * u0 + w1 * u1 + w0 * u2; } }
        const f32x4 a0 = res[0][0] * sigmoid4(res[0][0]) * res[1][0], a1 = res[0][1] * sigmoid4(res[0][1]) * res[1][1];
        { u32x2 w; w.x = pkf8(a0[0], a0[1], a0[2], a0[3]); w.y = pkf8(a1[0], a1[1], a1[2], a1[3]); *(GAS u32x2*)(ACT + ((size_t)g * 64 + rr) * DFF + ch) = w; }
    }
}

struct Args { const float* in[22]; float* out; unsigned char* ws; };
#define GEMM_PHASE_LC(EPI, A_, B_, N_, K_, E_, DT_, WS_, LDA_, C_) do { int kk_ = (K_); asm volatile("" : "+s"(kk_)); pg8::Gemm g_{(const pg8::bf16_t*)(A_), (const pg8::bf16_t*)(B_), M, (N_), kk_, (WS_), (LDA_)}; pg8::StaticOrder S_; S_.init(M, (N_), G, (C_)); \
        pg8::gemm_phase<EPI, pg8::StaticOrder, true, true, DT_>(lds, g_, S_, (E_)); } while (0)
#define GEMM_PHASE_L(EPI, A_, B_, N_, K_, E_, DT_, WS_, LDA_) do { int kk_ = (K_); asm volatile("" : "+s"(kk_)); pg8::Gemm g_{(const pg8::bf16_t*)(A_), (const pg8::bf16_t*)(B_), M, (N_), kk_, (WS_), (LDA_)}; pg8::StaticOrder S_; S_.init(M, (N_), G, bx); \
        pg8::gemm_phase<EPI, pg8::StaticOrder, true, true, DT_>(lds, g_, S_, (E_)); } while (0)
#define GEMM_PHASE_X(EPI, A_, B_, N_, K_, E_, DT_, WS_) GEMM_PHASE_L(EPI, A_, B_, N_, K_, E_, DT_, WS_, 0)
#define GEMM_PHASE_T(EPI, A_, B_, N_, K_, E_, F16_) GEMM_PHASE_X(EPI, A_, B_, N_, K_, E_, ((F16_) ? 1 : 0), 127)
#define GEMM_PHASE(EPI, A_, B_, N_, K_, E_) GEMM_PHASE_X(EPI, A_, B_, N_, K_, E_, 0, 127)

__global__ void __launch_bounds__(NWAVES * 64, 2) fwd_kernel(Args args) {
    extern __shared__ __attribute__((aligned(16))) unsigned char lds_raw[];
    LAS unsigned char* lds = (LAS unsigned char*)lds_raw;
    volatile LAS unsigned* MISC = (volatile LAS unsigned*)(lds + MISC_OFF);
    const int tid0 = threadIdx.x, wave = __builtin_amdgcn_readfirstlane(tid0 >> 6);
#define TID() ({ int t_ = threadIdx.x; asm volatile("" : "+v"(t_)); t_; })
#define LANE() (TID() & 63)
#define GT() ((size_t)bx * (NWAVES * 64) + TID())
    for (int u = threadIdx.x; u < (LDS_BYTES - LDSCTL_OFF) / 4; u += NWAVES * 64) ((LAS unsigned*)(lds + LDSCTL_OFF))[u] = 0u;
    __syncthreads();
    if (threadIdx.x == 0) { const unsigned xcc = xb_xcc_id() & 7u; const unsigned rk = __hip_atomic_fetch_add((gu32*)(args.ws + WS_CTL) + CW_RANK + 64 * xcc, 1u, RLX_AGENT); MISC[12] = (rk & 31u) * 8u + xcc; }
    __syncthreads();
    const int G = gridDim.x, bx = __builtin_amdgcn_readfirstlane((int)MISC[12]), vcu = (bx % 8) * (G / 8) + bx / 8;
    const int gw = vcu * NWAVES + wave, NGW = G * NWAVES; const size_t NT = (size_t)G * NWAVES * 64;
#define WSP(T_, off_) ((T_*)(wsb() + (off_)))
#define INP(k_) inb(k_)
#define DOP(T_, off_) ((T_*)((unsigned char*)outb() + (off_)))
    auto wsb = [&]() __attribute__((always_inline)) { unsigned char* w_ = args.ws; asm volatile("" : "+s"(w_)); return w_; };
    auto inb = [&](int k_) __attribute__((always_inline)) { const float* p_ = args.in[k_]; asm volatile("" : "+s"(p_)); return p_; };
    auto outb = [&]() __attribute__((always_inline)) { float* p_ = args.out; asm volatile("" : "+s"(p_)); return p_; };

    XcdBarrier bar = xcd_barrier_post((unsigned*)((gu32*)(args.ws + WS_CTL) + CW_BAR), MISC + 8);
#if defined(DBG_CKPT)
#define CKPT(id_, lo_, hi_) do { if (DBG_CKPT == (id_)) { unsigned* cw_ = WSP(unsigned, WS_CTL) + 200100; const unsigned* p_ = (const unsigned*)(wsb() + (size_t)(lo_) * MiB); unsigned c_ = 0u; \
        for (size_t i = GT(); i < (size_t)((hi_) - (lo_)) * MiB / 4; i += NT) c_ += p_[i] * 2654435761u + (unsigned)i; \
        c_ += __shfl_xor(c_, 32); c_ += __shfl_xor(c_, 16); c_ += __shfl_xor(c_, 8); c_ += __shfl_xor(c_, 4); c_ += __shfl_xor(c_, 2); c_ += __shfl_xor(c_, 1); \
        if ((TID() & 63) == 0) atomicAdd(cw_, c_); xcd_barrier(bar); \
        const float X = (float)(__hip_atomic_load(cw_, RLX_AGENT) & 0xFFFFFFu) + 1.0f; float* o_ = outb(); \
        for (size_t i = GT(); i < (size_t)M * DM / 4; i += NT) *((GAS f32x4*)o_ + i) = (f32x4){X, X, X, X}; return; } } while (0)
#else
#define CKPT(id_, lo_, hi_) do { } while (0)
#endif
#if defined(DBG_SPIN)
#define STAMP(i_) do { if (threadIdx.x == 0) { const unsigned long long t_ = __builtin_amdgcn_s_memrealtime(); MISC[16 + 2 * (i_)] = (unsigned)t_; MISC[17 + 2 * (i_)] = (unsigned)(t_ >> 32); const unsigned long long c_ = __builtin_amdgcn_s_memtime(); MISC[100 + 2 * (i_)] = (unsigned)c_; MISC[101 + 2 * (i_)] = (unsigned)(c_ >> 32); } } while (0)
#else
#define STAMP(i_) do { } while (0)
#endif
#define SCR() ((LAS float*)(lds + RING_OFF + wave * TR_LDS))
#define SSQP() ((float*)(wsb() + WS_CTL + MiB))

#if defined(DBG_CHECK)
#define DBG_OA ((DBG_CHECK == 1 || DBG_CHECK == 4) ? WS_XB : WS_QA)
#define DBG_OB (DBG_CHECK == 2 ? WS_XB : WS_QN)
#define DBG_SEL ((DBG_CHECK == 1 || DBG_CHECK == 4) ? (unsigned short*)(wsb() + WS_END) : (unsigned short*)nullptr)
#else
#define DBG_OA WS_QA
#define DBG_OB WS_QN
#define DBG_SEL ((unsigned short*)nullptr)
#endif
#ifndef ONLY
#define ONLY -1
#endif
#ifndef SKIPMASK
#define SKIPMASK 0
#endif
#define PH(k) ((ONLY < 0 || ONLY == (k)) && !((SKIPMASK >> (k)) & 1))
    STAMP(0);
    if (PH(0)) {
    { const TrIn I{INP(2), INP(3), INP(4), INP(5), INP(6), INP(7), INP(8), INP(9), INP(10), INP(13), INP(16), INP(17), INP(19)}; tr_all(I, wsb(), SCR(), gw, NGW, LANE()); }
    cvt_flat_h(INP(0), WSP(bf16, WS_XB), WSP(unsigned char, WS_XF8), (size_t)M * DM / 8, GT(), NT);
    cvt_flat(INP(1), WSP(bf16, WS_PB), (size_t)M * PLE_DIM / 8, GT(), NT);
    { float* ROPE = WSP(float, WS_ROPE);
    for (size_t i = GT(); i < (size_t)SEQ * 32; i += NT) { const int pos = (int)(i >> 5), j = (int)(i & 31);
        const double f = exp2(-(double)j * (13.287712379549449 / 32.0)), turns = (double)pos * f * 0.15915494309189535, fr = turns - floor(turns);
        ROPE[i] = __builtin_amdgcn_cosf((float)fr); ROPE[(size_t)SEQ * 32 + i] = __builtin_amdgcn_sinf((float)fr); } }
    }
    xcd_barrier(bar);

    STAMP(1);
    if (PH(1)) { EpiU<1> E{WSP(bf16, WS_QA), DOP(bf16, DO_QI), DOP(bf16, DO_KA), DOP(bf16, DO_VA), DOP(bf16, DO_KI), DOP(bf16, DO_KR), DOP(bf16, DO_CQ), DOP(bf16, DO_CKV), DOP(float, DO_WI), SSQP(), WSP(float, WS_ROPE)};
        GEMM_PHASE_X(EpiU<1>, WSP(bf16, WS_XF8), WSP(bf16, WS_WIN8), NU8, 1024, E, 2, 127 - 6); }
    if (PH(1)) { EpiU<2> E{WSP(bf16, WS_QA), DOP(bf16, DO_QI), DOP(bf16, DO_KA), DOP(bf16, DO_VA), DOP(bf16, DO_KI), DOP(bf16, DO_KR), DOP(bf16, DO_CQ), DOP(bf16, DO_CKV), DOP(float, DO_WI), SSQP(), WSP(float, WS_ROPE)};
        GEMM_PHASE_LC(EpiU<2>, WSP(bf16, WS_XB), WSP(bf16, WS_WIN), NU16, 2048, E, 1, 127, 0, (bx + 64) % G); }
    xcd_barrier(bar);
    CKPT(1, 118, 260);

#if defined(DBG_CHECK) && DBG_CHECK == 3
    {   float* dbgw = (float*)(WSP(unsigned, WS_CTL) + 200000);
        LAS float* xr = (LAS float*)lds; LAS float* red = (LAS float*)(lds + 65536); LAS float* tru = (LAS float*)(lds + 69632);
        for (int smp = bx; smp < 256; smp += G) chk::p1(INP(0), INP(2), WSP(bf16, WS_QA), DOP(bf16, DO_QI), DOP(bf16, DO_KA), DOP(bf16, DO_VA), DOP(bf16, DO_KI), DOP(float, DO_WI), DOP(bf16, DO_CQ), DOP(bf16, DO_CKV), DOP(bf16, DO_KR), smp, xr, red, tru, dbgw, TID());
        xcd_barrier(bar);
        const float X = __hip_atomic_load(dbgw + DBG_WORD, RLX_AGENT) * 1e8f; float* o_ = outb();
        for (size_t i = GT(); i < (size_t)M * DM / 4; i += NT) *((GAS f32x4*)o_ + i) = (f32x4){X, X, X, X};
        return;
    }
#endif
#if defined(DBG_CHECK) && DBG_CHECK == 5
    {
        float* dbgw = (float*)(WSP(unsigned, WS_CTL) + 200000);
        for (int rep = 0; rep < 2; ++rep) {
            const dsa::Ptrs P{DOP(bf16, DO_QI), DOP(bf16, DO_KI), DOP(bf16, DO_KA), DOP(bf16, DO_VA), DOP(float, DO_WI), WSP(bf16, WS_QA), rep == 0 ? WSP(bf16, WS_XB) : WSP(bf16, WS_QN), (unsigned short*)(wsb() + WS_END + (size_t)rep * 8 * MiB)};
            LAS unsigned char* wl = lds + RING_OFF + wave * 16384; LAS dsa::u16* idl = (LAS dsa::u16*)(lds + IDL_OFF + wave * 2048);
            const int x_ = vcu >> 5, wv = (vcu & 31) * NWAVES + wave, j_ = wv >> 6, i_ = wv & 63;
#pragma unroll 1
            for (int jb = 0; jb < 2; ++jb) dsa::job(P, jb, jb == 0 ? 256 * (x_ + 8 * j_) + 4 * i_ : 256 * ((7 - x_) + 8 * (3 - j_)) + 4 * (63 - i_), wl, idl, LANE());
            xcd_barrier(bar);
        }
        { const unsigned short* sa = (const unsigned short*)(wsb() + WS_END); const unsigned short* sb = sa + (size_t)4 * MiB; unsigned c = 0u;
          for (size_t i = GT(); i < (size_t)M * 256; i += NT) c += sa[i] != sb[i] ? 1u : 0u;
          if (c) atomicAdd((unsigned*)dbgw + 20, c);
          const unsigned* oa = (const unsigned*)WSP(bf16, WS_XB); const unsigned* ob = (const unsigned*)WSP(bf16, WS_QN); unsigned c2 = 0u;
          for (size_t i = GT(); i < (size_t)M * 1024; i += NT) c2 += oa[i] != ob[i] ? 1u : 0u;
          if (c2) atomicAdd((unsigned*)dbgw + 21, c2); }
        xcd_barrier(bar);
        const float X = ((float)__hip_atomic_load((unsigned*)dbgw + 20 + DBG_WORD, RLX_AGENT) + 1.0f) * 1e8f; float* o_ = outb();
        for (size_t i = GT(); i < (size_t)M * DM / 4; i += NT) *((GAS f32x4*)o_ + i) = (f32x4){X, X, X, X};
        return;
    }
#endif
    STAMP(2);
    if (PH(3)) { const dsa::Ptrs P{DOP(bf16, DO_QI), DOP(bf16, DO_KI), DOP(bf16, DO_KA), DOP(bf16, DO_VA), DOP(float, DO_WI), WSP(bf16, WS_QA), WSP(bf16, DBG_OA), DBG_SEL};
      LAS unsigned char* wl = lds + RING_OFF + wave * 16384; LAS dsa::u16* idl = (LAS dsa::u16*)(lds + IDL_OFF + wave * 2048);
      const int x_ = vcu >> 5, j_ = wave & 3, i_ = (vcu & 31) * 2 + (wave >> 2);
#pragma unroll 1
      for (int jb = 0; jb < 2; ++jb) dsa::job(P, jb, jb == 0 ? 256 * (x_ + 8 * j_) + 4 * i_ : 256 * ((7 - x_) + 8 * (3 - j_)) + 4 * (63 - i_), wl, idl, LANE(), wave == 0 ? MISC + 64 : nullptr); }
    __syncthreads();
    STAMP(3);
    if (PH(2)) { EpiQ E{WSP(bf16, WS_QN), DOP(bf16, DO_QR), SSQP(), WSP(float, WS_ROPE)}; GEMM_PHASE_X(EpiQ, DOP(bf16, DO_CQ), WSP(bf16, WS_WUQ), 3072, 256, E, 2, 127 - 5); }
    if (PH(2)) { EpiKV E{WSP(bf16, WS_KN), WSP(bf16, WS_VB), SSQP() + (size_t)M * 8}; GEMM_PHASE_X(EpiKV, DOP(bf16, DO_CKV), WSP(bf16, WS_WKV), 4096, 256, E, 2, 127 - 5); }
    xcd_barrier(bar);
    CKPT(2, 118, 182); CKPT(3, 260, 484);
#if defined(DBG_CHECK) && DBG_CHECK == 6
    {   float* dbgw = (float*)(WSP(unsigned, WS_CTL) + 200000);
        LAS float* cr = (LAS float*)lds; LAS float* red = (LAS float*)(lds + 65536); LAS float* tru = (LAS float*)(lds + 69632);
        for (int smp = bx; smp < 256; smp += G) chk::p2(DOP(bf16, DO_CQ), DOP(bf16, DO_CKV), INP(3), INP(4), INP(5), INP(6), INP(7), WSP(bf16, WS_QN), DOP(bf16, DO_QR), WSP(bf16, WS_KN), WSP(bf16, WS_VB), smp, cr, red, tru, dbgw, TID());
        xcd_barrier(bar);
        const float X = __hip_atomic_load(dbgw + DBG_WORD, RLX_AGENT) * 1e8f; float* o_ = outb();
        for (size_t i = GT(); i < (size_t)M * DM / 4; i += NT) *((GAS f32x4*)o_ + i) = (f32x4){X, X, X, X};
        return;
    }
#endif

    STAMP(4);
    if (PH(4)) { const mla::Tensors T{WSP(bf16, WS_QN), DOP(bf16, DO_QR), WSP(bf16, WS_KN), DOP(bf16, DO_KR), WSP(bf16, WS_VB), DOP(bf16, DO_AB8)};
#pragma unroll 1
      for (int r_ = 0; r_ < 2; ++r_) { const int x_ = vcu >> 5, q_ = (vcu & 31) * 2 + r_, j_ = q_ >> 4, h_ = q_ & 15;
#pragma unroll 1
          for (int ps = 0; ps < 2; ++ps) mla::unit(T, ps, h_, ps == 0 ? x_ + 8 * j_ : (7 - x_) + 8 * (3 - j_), lds + RING_OFF); } }
    xcd_barrier(bar);
    CKPT(4, 260, 324);

#if defined(DBG_CHECK) && (DBG_CHECK == 1 || DBG_CHECK == 2 || DBG_CHECK == 4)
    {
        float* dbgw = (float*)(WSP(unsigned, WS_CTL) + 200000);
        LAS float* lgs = (LAS float*)lds; LAS float* red = (LAS float*)(lds + 65536); LAS float* aux = (LAS float*)(lds + 69632);
        for (int smp = bx; smp < (DBG_CHECK == 4 ? 256 : 512); smp += G) {
#if DBG_CHECK == 2
            chk::mla(WSP(bf16, WS_QN), DOP(bf16, DO_QR), WSP(bf16, WS_KN), DOP(bf16, DO_KR), WSP(bf16, WS_VB), WSP(bf16, DBG_OB), smp, lgs, red, aux, dbgw, TID());
#else
            chk::dsa<(DBG_CHECK == 4)>(INP(0), INP(2), DOP(bf16, DO_QI), DOP(bf16, DO_KI), DOP(float, DO_WI), WSP(bf16, WS_QA), DOP(bf16, DO_KA), DOP(bf16, DO_VA), WSP(bf16, DBG_OA), DBG_SEL, smp, lgs, red, aux, dbgw, TID());
#endif
        }
        xcd_barrier(bar);
        const float X = __hip_atomic_load(dbgw + DBG_WORD, RLX_AGENT) * 1e8f; float* o_ = outb();
        for (size_t i = GT(); i < (size_t)M * DM / 4; i += NT) *((GAS f32x4*)o_ + i) = (f32x4){X, X, X, X};
        return;
    }
#endif
    STAMP(5);
    if (PH(5)) { EpiB<1> E{WSP(bf16, WS_G), 4096, nullptr, nullptr, nullptr}; GEMM_PHASE_X(EpiB<1>, WSP(bf16, WS_XF8), WSP(bf16, WS_WG), 4096, 1024, E, 2, 127 - 6); }
    xcd_barrier(bar);
    CKPT(5, 356, 484); CKPT(6, 182, 256); CKPT(7, 324, 348);
#if defined(DBG_CHECK) && DBG_CHECK == 10
    {
        unsigned* dw = WSP(unsigned, WS_CTL) + 200000; const bf16* Gp = WSP(bf16, WS_G);
        unsigned cntb = 0u, rmax = 0u, rmin = 255u, pnmax = 0u, pnmin = 15u, r16 = 0u, nnan = 0u, pmaxb = 0u, pminb = 63u; float vmax = 0.f;
        for (int s_ = 0; s_ < 8; ++s_) { const int pnl = own_panel(vcu >> 5, s_);
            for (int e = (vcu & 31) * 512 + (int)TID(); e < 256 * 4096 / 8; e += 32 * 512) { const int r = e / 512, c8 = e % 512; const v4u w = *(const GAS v4u*)(Gp + ((size_t)pnl * 256 + r) * 4096 + c8 * 8); f32x4 a, b; unpack8(w, a, b);
                bool bad = false;
#pragma unroll
                for (int j = 0; j < 4; ++j) { bad |= !(a[j] >= 0.f && a[j] <= 1.001f); bad |= !(b[j] >= 0.f && b[j] <= 1.001f); }
                if (bad) { for (int j = 0; j < 4; ++j) { if (a[j] == a[j] && fabsf(a[j]) < 1e30f) vmax = fmaxf(vmax, fabsf(a[j])); else ++nnan; if (b[j] == b[j] && fabsf(b[j]) < 1e30f) vmax = fmaxf(vmax, fabsf(b[j])); else ++nnan; } pmaxb = max(pmaxb, (unsigned)pnl); pminb = min(pminb, (unsigned)pnl);
                    ++cntb; rmax = max(rmax, (unsigned)r); rmin = min(rmin, (unsigned)r); pnmax = max(pnmax, (unsigned)(c8 / 32)); pnmin = min(pnmin, (unsigned)(c8 / 32)); r16 |= 1u << (r & 15); } } }
        if (cntb) { atomicAdd(dw + 0, cntb); atomicMax(dw + 1, rmax + 1u); atomicMax(dw + 2, 256u - rmin); atomicMax(dw + 3, pnmax + 1u); atomicMax(dw + 4, 16u - pnmin); atomicOr(dw + 5, r16); atomicMax(dw + 6, (unsigned)vmax); atomicAdd(dw + 7, nnan); atomicMax(dw + 8, pmaxb + 1u); atomicMax(dw + 9, 64u - pminb); }
        xcd_barrier(bar);
        const float X = (float)__hip_atomic_load(dw + DBG_WORD, RLX_AGENT) * 1e8f; float* o_ = outb();
        for (size_t i = GT(); i < (size_t)M * DM / 4; i += NT) *((GAS f32x4*)o_ + i) = (f32x4){X, X, X, X};
        return;
    }
#endif
#if defined(DBG_CHECK) && DBG_CHECK == 9
    {   float* dbgw = (float*)(WSP(unsigned, WS_CTL) + 200000);
        LAS float* xr = (LAS float*)lds; LAS float* red = (LAS float*)(lds + 65536);
        { const size_t row_ = (size_t)256 * own_panel(vcu >> 5, vcu & 7) + (((unsigned)vcu * 2654435761u) >> 9) % 256;
          chk::gchk(INP(0), INP(2), WSP(bf16, WS_G), WSP(bf16, WS_XB), row_, xr, red, dbgw, TID()); }
        xcd_barrier(bar);
        const float X = __hip_atomic_load(dbgw + DBG_WORD, RLX_AGENT) * 1e8f; float* o_ = outb();
        for (size_t i = GT(); i < (size_t)M * DM / 4; i += NT) *((GAS f32x4*)o_ + i) = (f32x4){X, X, X, X};
        return;
    }
#endif

    STAMP(6);
    if (PH(7)) { EpiB<2> E{WSP(bf16, WS_MT), 2048, WSP(bf16, WS_G), nullptr, nullptr}; GEMM_PHASE_L(EpiB<2>, WSP(bf16, WS_QA), WSP(bf16, WS_WA), 2048, 1024, E, 2, 127 - 6, 2048); }
    if (PH(7)) { EpiB<5> E{WSP(bf16, WS_MT), 2048, (const bf16*)(WSP(unsigned char, WS_G) + 2048), nullptr, WSP(unsigned char, WS_MG8)}; GEMM_PHASE_X(EpiB<5>, DOP(bf16, DO_AB8), WSP(bf16, WS_WB), 2048, 1024, E, 2, 127 - 6); }
    xcd_barrier(bar);
    CKPT(8, 54, 118);

    STAMP(7);
    if (PH(8)) { EpiF<0> E{WSP(bf16, WS_X1B), INP(0), nullptr}; GEMM_PHASE_X(EpiF<0>, WSP(bf16, WS_MG8), WSP(bf16, WS_WO), 2048, 1024, E, 2, 127 - 6); }
    xcd_barrier(bar);
#if defined(DBG_CHECK) && DBG_CHECK == 7
    {   float* dbgw = (float*)(WSP(unsigned, WS_CTL) + 200000);
        LAS float* va = (LAS float*)lds; LAS float* red = (LAS float*)(lds + 65536); LAS float* mg = (LAS float*)(lds + 69632);
        { const size_t row_ = (size_t)256 * own_panel(vcu >> 5, vcu & 7) + (((unsigned)vcu * 2654435761u) >> 9) % 256;
          chk::mid(INP(0), INP(2), INP(8), INP(9), INP(10), WSP(bf16, WS_QA), WSP(bf16, WS_QN), WSP(bf16, WS_G), WSP(bf16, WS_MT), outb(), row_, vcu, va, red, mg, dbgw, TID()); }
        xcd_barrier(bar);
        const float X = __hip_atomic_load(dbgw + DBG_WORD, RLX_AGENT) * 1e8f; float* o_ = outb();
        for (size_t i = GT(); i < (size_t)M * DM / 4; i += NT) *((GAS f32x4*)o_ + i) = (f32x4){X, X, X, X};
        return;
    }
#endif
    if (PH(9)) { bf16* z_ = WSP(bf16, WS_X1B); ln_pass(z_, nullptr, z_, WSP(unsigned char, WS_X1F8), INP(11), INP(12), vcu, wave, LANE()); }
    xcd_barrier(bar);
    CKPT(9, 118, 182);

    STAMP(8);
    if (PH(10)) { EpiUp E{WSP(unsigned char, WS_ACT), WSP(float, WS_HEAD), WSP(float, WS_TAIL), INP(14), INP(15)}; GEMM_PHASE_X(EpiUp, WSP(bf16, WS_X1F8), WSP(bf16, WS_WUP), NUP, 1024, E, 2, 127 - 6); }
    xcd_barrier(bar);
    CKPT(10, 260, 484);

    STAMP(9);
    if (PH(11)) conv_fixup(WSP(unsigned char, WS_ACT), WSP(float, WS_HEAD), WSP(float, WS_TAIL), INP(14), INP(15), vcu, TID());
    if (PH(12)) { EpiB<0> E{WSP(bf16, WS_PEO), 2048, nullptr, nullptr, nullptr}; GEMM_PHASE(EpiB<0>, WSP(bf16, WS_PB), WSP(bf16, WS_WPE), 2048, 256, E); }
    if (PH(15)) { EpiB<4> E{WSP(bf16, WS_PEO), 2048, nullptr, INP(18), nullptr}; GEMM_PHASE_X(EpiB<4>, WSP(bf16, WS_X1F8), WSP(bf16, WS_WPG), 2048, 1024, E, 2, 127 - 6); }
    xcd_barrier(bar);
    CKPT(11, 54, 118); CKPT(12, 308, 484);

    STAMP(10);
    if (PH(13)) { EpiF<1> E{WSP(bf16, WS_X1B), nullptr, WSP(bf16, WS_PEO)}; GEMM_PHASE_X(EpiF<1>, WSP(bf16, WS_ACT), WSP(bf16, WS_WDN), 2048, DFF / 2, E, 2, 127 - 7); }
    xcd_barrier(bar);
    if (PH(14)) { ln_pass(WSP(bf16, WS_X1B), outb(), nullptr, nullptr, INP(20), INP(21), vcu, wave, LANE()); }
#if defined(DBG_SPIN)
    STAMP(11);
    if (threadIdx.x == 0 && vcu == DBG_VCU) { const unsigned long long a_ = ((unsigned long long)MISC[17 + 2 * (DBG_SPIN % 100)] << 32) | MISC[16 + 2 * (DBG_SPIN % 100)], b_ = ((unsigned long long)MISC[17 + 2 * (DBG_SPIN % 100 + DBG_SPAN)] << 32) | MISC[16 + 2 * (DBG_SPIN % 100 + DBG_SPAN)];
        const unsigned long long ca_ = ((unsigned long long)MISC[101 + 2 * (DBG_SPIN % 100)] << 32) | MISC[100 + 2 * (DBG_SPIN % 100)], cb_ = ((unsigned long long)MISC[101 + 2 * (DBG_SPIN % 100 + DBG_SPAN)] << 32) | MISC[100 + 2 * (DBG_SPIN % 100 + DBG_SPAN)];
        const unsigned long long t0_ = __builtin_amdgcn_s_memrealtime(), w_ = DBG_SPIN >= 200 ? (cb_ - ca_) / 20ull : DBG_SPIN >= 100 ? 4ull * MISC[64 + (DBG_SPIN - 100)] : 4ull * (b_ - a_); while (__builtin_amdgcn_s_memrealtime() - t0_ < w_) __builtin_amdgcn_s_sleep(8); }
#endif
#if defined(DBG_CHECK) && DBG_CHECK == 8
    {   xcd_barrier(bar);
        float* dbgw = (float*)(WSP(unsigned, WS_CTL) + 200000);
        LAS float* xs = (LAS float*)lds; LAS float* red = (LAS float*)(lds + 65536); LAS float* act = (LAS float*)(lds + 69632);
        for (int smp = bx; smp < 256; smp += G) chk::endp(WSP(bf16, WS_X1B), nullptr, INP(1), INP(13), INP(14), INP(15), INP(16), INP(17), INP(18), INP(19), INP(20), INP(21), outb(), smp, xs, red, act, dbgw, TID());
        xcd_barrier(bar);
        const float X = __hip_atomic_load(dbgw + DBG_WORD, RLX_AGENT) * 1e8f; float* o_ = outb();
        for (size_t i = GT(); i < (size_t)M * DM / 4; i += NT) *((GAS f32x4*)o_ + i) = (f32x4){X, X, X, X};
    }
#endif
}

extern "C" void kernel_launch(void* const* d_in, const int* in_sizes, int n_in, void* d_out, int out_size, void* d_ws, size_t ws_size, hipStream_t stream) {
    static int grid = 0;
    if (grid == 0) {
        if (n_in != 22 || in_sizes[0] != M * DM || out_size != M * DM || ws_size < WS_END) { fprintf(stderr, "kernel_launch: unexpected shapes (n_in %d, in0 %d, out %d, ws %zu); nothing launched\n", n_in, n_in > 0 ? in_sizes[0] : -1, out_size, ws_size); grid = -1; return; }
        int dev = 0, cus = 0, per_cu = 0;
        if (hipGetDevice(&dev) != hipSuccess || hipDeviceGetAttribute(&cus, hipDeviceAttributeMultiprocessorCount, dev) != hipSuccess) { grid = -1; return; }
        if (hipFuncSetAttribute((const void*)fwd_kernel, hipFuncAttributeMaxDynamicSharedMemorySize, LDS_BYTES) != hipSuccess) { fprintf(stderr, "kernel_launch: hipFuncSetAttribute failed\n"); grid = -1; return; }
        if (hipOccupancyMaxActiveBlocksPerMultiprocessor(&per_cu, (const void*)fwd_kernel, NWAVES * 64, LDS_BYTES) != hipSuccess || per_cu < 1) { fprintf(stderr, "kernel_launch: occupancy query reports %d workgroups per CU\n", per_cu); }
        (void)hipGetLastError();
        grid = cus;
    }
    if (grid < 0) return;
    if (hipMemsetAsync((char*)d_ws + WS_CTL, 0, CTL_ZERO_BYTES, stream) != hipSuccess) return;
    Args a{};
    for (int i = 0; i < 22; ++i) a.in[i] = (const float*)d_in[i];
    a.out = (float*)d_out; a.ws = (unsigned char*)d_ws;
    hipLaunchKernelGGL(fwd_kernel, dim3(grid), dim3(NWAVES * 64), LDS_BYTES, stream, a);
}
```

```cpp
#include <hip/hip_runtime.h>
#include <cstdio>
#include <cstdint>
namespace pg8 {
#define PG8_LAS __attribute__((address_space(3)))
typedef unsigned short bf16_t;
typedef short bf16x8 __attribute__((ext_vector_type(8)));
typedef float f32x4 __attribute__((ext_vector_type(4)));
typedef unsigned u32x4 __attribute__((ext_vector_type(4)));
constexpr int BM = 256, BK = 64, HALF = 128, HTB = HALF * BK * 2  , STAGE_BYTES = 8 * HTB, NXCD = 8, WGM = 8;

__host__ __device__ __forceinline__ int lds_byte(int r, int c) { const int st = (r >> 4) * 2 + (c >> 5), rr = r & 15, cc = c & 31, ob = rr * 64 + cc * 2; return st * 1024 + (ob ^ (((ob >> 9) & 1) << 5)); }
__host__ __device__ __forceinline__ void stage_rc(int b, int& R, int& C) { const int st = b / 1024, sb = b % 1024, swz = sb ^ (((sb >> 9) & 1) << 5); R = (st >> 1) * 16 + swz / 64; C = (st & 1) * 32 + (swz % 64) / 2; }
__host__ __device__ __forceinline__ int perm32(int rho) { const int n = rho >> 4, i = rho & 15; return 8 * (i >> 2) + 4 * n + (i & 3); }

struct Unit { int pm, pn; };
struct Gemm { const bf16_t* A; const bf16_t* Bt; int M, N, K; int wscale; int lda; };
typedef int i32x4 __attribute__((ext_vector_type(4))); typedef int i32x8 __attribute__((ext_vector_type(8)));
typedef _Float16 f16x8 __attribute__((ext_vector_type(8)));

struct StaticOrder {
    int nM, nN, nwg, G, c;
    __host__ __device__ void init(int M, int N, int G_, int c_) { nM = M / BM; nN = N / BM; nwg = nM * nN; G = G_; c = c_; }
    __host__ __device__ bool next(int i, Unit& u) const {
        const long L = (long)i * G + c; if (L >= nwg) return false;
        int wgid = (int)L; { const int q = nwg / NXCD, r = nwg % NXCD, xcd = wgid % NXCD, off = wgid / NXCD; wgid = (xcd < r ? xcd * (q + 1) : r * (q + 1) + (xcd - r) * q) + off; }
        const int nig = WGM * nN, gid = wgid / nig, fm = gid * WGM, gsz = (nM - fm) < WGM ? (nM - fm) : WGM;
        u.pm = fm + ((wgid % nig) % gsz); u.pn = (wgid % nig) / gsz;
        { const int x = u.pm >> 3, s = u.pm & 7; u.pm = s < 4 ? x + 8 * s : 32 + (7 - x) + 8 * (s - 4); }
        return true;
    }
    __device__ __forceinline__ void a_ready(const Unit&) const {}
    __device__ __forceinline__ void done(const Unit&) const {}
};

typedef float f32x2c_t __attribute__((ext_vector_type(2))); typedef __bf16 bf16x2c_t __attribute__((ext_vector_type(2)));
__device__ __forceinline__ unsigned cvt_pk_bf16(float lo, float hi) { const f32x2c_t v = {lo, hi}; const bf16x2c_t b = __builtin_convertvector(v, bf16x2c_t); return __builtin_bit_cast(unsigned, b); }
typedef float f32x2 __attribute__((ext_vector_type(2)));
template <class Epi, class Sched, bool ALIGN_EPI = false, bool SP2 = false, int DT = 0  >
__device__ __forceinline__ void gemm_phase(PG8_LAS unsigned char* lds, const Gemm g, const Sched& S, const Epi& E) {
    int tid_o_ = threadIdx.x; asm volatile("" : "+v"(tid_o_));
    const int tid = tid_o_, wid = __builtin_amdgcn_readfirstlane(tid >> 6), lane = tid & 63, wr = wid >> 2, wc = wid & 3, fr = lane & 15, fq = lane >> 4;
    const int K = g.K, nt = K / BK, lda = g.lda ? g.lda : g.K;
    unsigned voffA[2], voffB[2];
#pragma unroll
    for (int i = 0; i < 2; ++i) { int R, C; stage_rc(tid * 16 + i * 8192, R, C); const int Rb = Epi::PERM ? ((R & ~31) + perm32(R & 31)) : R;
        voffA[i] = (unsigned)(R * lda + C) * 2u; voffB[i] = (unsigned)(Rb * K + C) * 2u; }
    const size_t kstep = (size_t)(BK * 2);
    const size_t hstep = (size_t)HALF * K * 2;
    const size_t tstep = 2 * hstep;
    const size_t hstepA = (size_t)HALF * lda * 2, tstepA = 2 * hstepA;
    const unsigned ldsw = (unsigned)wid * 1024u;
    const int aoff = lds_byte(wr * 64 + fr, fq * 8), boff = lds_byte(wc * 32 + fr, fq * 8);
#define PG8_SA(b, h) (((b) * 2 + (h)) * HTB)
#define PG8_SB(b, h) ((4 + (b) * 2 + (h)) * HTB)
#define PG8_STAGE(bufoff, gbase, voff) do { _Pragma("unroll") for (int _i = 0; _i < 2; ++_i) \
        __builtin_amdgcn_global_load_lds((const unsigned*)((const char*)(gbase) + (voff)[_i]), (PG8_LAS unsigned*)(lds + (bufoff) + ldsw + _i * 8192), 16, 0, 0); } while (0)
#define PG8_LD16A(off_) (*(const PG8_LAS i32x4*)(abase8 + (off_)))
#define PG8_LD16B(off_) (*(const PG8_LAS i32x4*)(bbase8 + ((off_) - 65536)))
#define PG8_LDA(dst, b, h) do { if constexpr (DT == 2) { _Pragma("unroll") for (int m = 0; m < 4; ++m) dst##8[m] = __builtin_shufflevector(PG8_LD16A(PG8_SA(b, h) + m * 2048), PG8_LD16A(PG8_SA(b, h) + m * 2048 + 1024), 0, 1, 2, 3, 4, 5, 6, 7); } \
        else { _Pragma("unroll") for (int m = 0; m < 4; ++m) _Pragma("unroll") for (int k = 0; k < 2; ++k) dst[m][k] = *(const PG8_LAS bf16x8*)(lds + PG8_SA(b, h) + aoff + m * 2048 + k * 1024); } } while (0)
#define PG8_LDB(dst, b, h) do { if constexpr (DT == 2) { _Pragma("unroll") for (int n = 0; n < 2; ++n) dst##8[n] = __builtin_shufflevector(PG8_LD16B(PG8_SB(b, h) + n * 2048), PG8_LD16B(PG8_SB(b, h) + n * 2048 + 1024), 0, 1, 2, 3, 4, 5, 6, 7); } \
        else { _Pragma("unroll") for (int n = 0; n < 2; ++n) _Pragma("unroll") for (int k = 0; k < 2; ++k) dst[n][k] = *(const PG8_LAS bf16x8*)(lds + PG8_SB(b, h) + boff + n * 2048 + k * 1024); } } while (0)
#define PG8_MMA(ai, bj, At, Bt) do { __builtin_amdgcn_s_setprio(1); _Pragma("unroll") for (int m = 0; m < 4; ++m) _Pragma("unroll") for (int n = 0; n < 2; ++n) { \
        if constexpr (DT == 2) asm volatile("v_mfma_scale_f32_16x16x128_f8f6f4 %0, %1, %2, %0, %3, %4 op_sel_hi:[0,0,0]" : "+v"(acc[ai][bj][m][n]) : "v"(Bt##8[n]), "v"(At##8[m]), "v"(sclw), "v"(scla));   \
        else { _Pragma("unroll") for (int k = 0; k < 2; ++k) { \
        if constexpr (DT == 1) acc[ai][bj][m][n] = __builtin_amdgcn_mfma_f32_16x16x32_f16(__builtin_bit_cast(f16x8, Bt[n][k]), __builtin_bit_cast(f16x8, At[m][k]), acc[ai][bj][m][n], 0, 0, 0); \
        else acc[ai][bj][m][n] = __builtin_amdgcn_mfma_f32_16x16x32_bf16(Bt[n][k], At[m][k], acc[ai][bj][m][n], 0, 0, 0); } } } __builtin_amdgcn_s_setprio(0); } while (0)
#define PG8_WAIT_V(n) asm volatile("s_waitcnt vmcnt(" #n ")" ::: "memory")
#define PG8_WAIT_L(n) asm volatile("s_waitcnt lgkmcnt(" #n ")" ::: "memory")
#define PG8_BAR __builtin_amdgcn_s_barrier()
#define PG8_SCHED __builtin_amdgcn_sched_barrier(0)
    Unit cur, nxt; int ui = 0;
    if (!S.next(0, cur)) return;
    f32x4 acc[2][2][4][2];
#pragma unroll
    for (int a = 0; a < 2; ++a)
#pragma unroll
        for (int b = 0; b < 2; ++b)
#pragma unroll
            for (int m = 0; m < 4; ++m)
#pragma unroll
                for (int n = 0; n < 2; ++n) acc[a][b][m][n] = (f32x4){0.f, 0.f, 0.f, 0.f};
    const int sclw = g.wscale, scla = 127;
    unsigned abi_ = (unsigned)(uintptr_t)lds + (unsigned)aoff, bbi_ = (unsigned)(uintptr_t)lds + 65536u + (unsigned)boff; asm volatile("" : "+v"(abi_), "+v"(bbi_));
    const PG8_LAS unsigned char* abase8 = (const PG8_LAS unsigned char*)(uintptr_t)abi_; const PG8_LAS unsigned char* bbase8 = (const PG8_LAS unsigned char*)(uintptr_t)bbi_;
    bf16x8 At[4][2], B0[2][2], B1[2][2]; i32x8 At8[4], B08[2], B18[2];
    const char* cA = (const char*)g.A + (size_t)cur.pm * tstepA; const char* cB = (const char*)g.Bt + (size_t)cur.pn * tstep;
    S.a_ready(cur);
    if constexpr (SP2) {
        PG8_STAGE(PG8_SB(0, 0), cB, voffB); PG8_STAGE(PG8_SB(0, 1), cB + hstep, voffB); PG8_STAGE(PG8_SA(0, 0), cA, voffA); PG8_STAGE(PG8_SA(0, 1), cA + hstepA, voffA);
        if (wr == 1) PG8_BAR;
        PG8_WAIT_V(2); PG8_BAR;
        PG8_STAGE(PG8_SB(1, 0), cB + kstep, voffB); PG8_STAGE(PG8_SA(1, 0), cA + kstep, voffA); PG8_STAGE(PG8_SB(1, 1), cB + hstep + kstep, voffB);
        PG8_WAIT_V(6); PG8_BAR;
    } else {
        PG8_STAGE(PG8_SB(0, 0), cB, voffB); PG8_STAGE(PG8_SA(0, 0), cA, voffA); PG8_STAGE(PG8_SB(0, 1), cB + hstep, voffB); PG8_STAGE(PG8_SA(0, 1), cA + hstepA, voffA);
        if (wr == 1) PG8_BAR;
        PG8_WAIT_V(4); PG8_BAR;
        PG8_STAGE(PG8_SB(1, 0), cB + kstep, voffB); PG8_STAGE(PG8_SA(1, 0), cA + kstep, voffA); PG8_STAGE(PG8_SB(1, 1), cB + hstep + kstep, voffB);
        PG8_WAIT_V(6); PG8_BAR;
    }
    for (;;) {
        const bool has_next = S.next(ui + 1, nxt);
        const char* nA = has_next ? (const char*)g.A + (size_t)nxt.pm * tstepA : cA; const char* nB = has_next ? (const char*)g.Bt + (size_t)nxt.pn * tstep : cB;
        for (int t = 0; t < nt; t += 2) {
            const bool last = (t == nt - 2);
            const char* a1 = cA + (size_t)(t + 1) * kstep;
            const char* a2 = last ? nA : cA + (size_t)(t + 2) * kstep; const char* b2 = last ? nB : cB + (size_t)(t + 2) * kstep;
            const char* a3 = a2 + kstep; const char* b3 = b2 + kstep;
            if (last && has_next) S.a_ready(nxt);
            if constexpr (SP2) {
            PG8_LDB(B0, 0, 0); PG8_LDB(B1, 0, 1); PG8_SCHED; PG8_LDA(At, 0, 0); PG8_STAGE(PG8_SA(1, 1), a1 + hstepA, voffA);
            PG8_WAIT_V(8); PG8_WAIT_L(0); PG8_BAR; PG8_MMA(0, 0, At, B0); PG8_MMA(0, 1, At, B1); PG8_BAR; PG8_SCHED;
            PG8_LDA(At, 0, 1); PG8_STAGE(PG8_SB(0, 0), b2, voffB); PG8_STAGE(PG8_SB(0, 1), b2 + hstep, voffB); PG8_STAGE(PG8_SA(0, 0), a2, voffA);
            PG8_WAIT_V(8); PG8_WAIT_L(0); PG8_BAR; PG8_MMA(1, 0, At, B0); PG8_MMA(1, 1, At, B1); PG8_BAR; PG8_SCHED;
            PG8_LDB(B0, 1, 0); PG8_LDB(B1, 1, 1); PG8_SCHED; PG8_LDA(At, 1, 0); PG8_STAGE(PG8_SA(0, 1), a2 + hstepA, voffA);
            PG8_WAIT_V(8); PG8_WAIT_L(0); PG8_BAR; PG8_MMA(0, 0, At, B0); PG8_MMA(0, 1, At, B1); PG8_BAR; PG8_SCHED;
            PG8_LDA(At, 1, 1); PG8_STAGE(PG8_SB(1, 0), b3, voffB); PG8_STAGE(PG8_SB(1, 1), b3 + hstep, voffB); PG8_STAGE(PG8_SA(1, 0), a3, voffA);
            PG8_WAIT_V(8); PG8_WAIT_L(0); PG8_BAR; PG8_MMA(1, 0, At, B0); PG8_MMA(1, 1, At, B1); PG8_BAR; PG8_SCHED;
            } else {
            PG8_LDB(B0, 0, 0); PG8_SCHED; PG8_LDA(At, 0, 0); PG8_STAGE(PG8_SA(1, 1), a1 + hstepA, voffA);
            PG8_WAIT_L(8); PG8_BAR; PG8_WAIT_L(0); PG8_MMA(0, 0, At, B0); PG8_BAR; PG8_SCHED;
            PG8_LDB(B1, 0, 1); PG8_STAGE(PG8_SB(0, 0), b2, voffB);
            PG8_BAR; PG8_WAIT_L(0); PG8_MMA(0, 1, At, B1); PG8_BAR;
            PG8_LDA(At, 0, 1); PG8_STAGE(PG8_SA(0, 0), a2, voffA);
            PG8_BAR; PG8_WAIT_L(0); PG8_MMA(1, 0, At, B0); PG8_BAR; PG8_SCHED;
            PG8_STAGE(PG8_SB(0, 1), b2 + hstep, voffB);
            PG8_WAIT_V(6); PG8_BAR; PG8_MMA(1, 1, At, B1); PG8_BAR;
            PG8_LDB(B0, 1, 0); PG8_SCHED; PG8_LDA(At, 1, 0); PG8_STAGE(PG8_SA(0, 1), a2 + hstepA, voffA);
            PG8_WAIT_L(8); PG8_BAR; PG8_WAIT_L(0); PG8_MMA(0, 0, At, B0); PG8_BAR; PG8_SCHED;
            PG8_LDB(B1, 1, 1); PG8_STAGE(PG8_SB(1, 0), b3, voffB);
            PG8_BAR; PG8_WAIT_L(0); PG8_MMA(0, 1, At, B1); PG8_BAR;
            PG8_LDA(At, 1, 1); PG8_STAGE(PG8_SA(1, 0), a3, voffA);
            PG8_BAR; PG8_WAIT_L(0); PG8_MMA(1, 0, At, B0); PG8_BAR; PG8_SCHED;
            PG8_STAGE(PG8_SB(1, 1), b3 + hstep, voffB);
            PG8_WAIT_V(6); PG8_BAR; PG8_MMA(1, 1, At, B1); PG8_BAR;
            }
        }
        if constexpr (ALIGN_EPI) { if (wr == 0) PG8_BAR; }
        if constexpr (!Epi::AFTER_DRAIN) { E(acc, cur, wr, wc, fr, fq); S.done(cur); }
        if (!has_next) break;
#pragma unroll
        for (int a = 0; a < 2; ++a)
#pragma unroll
            for (int b = 0; b < 2; ++b)
#pragma unroll
                for (int m = 0; m < 4; ++m)
#pragma unroll
                    for (int n = 0; n < 2; ++n) acc[a][b][m][n] = (f32x4){0.f, 0.f, 0.f, 0.f};
        cur = nxt; cA = nA; cB = nB; ++ui;
        if constexpr (ALIGN_EPI) { if (wr == 1) PG8_BAR; }
    }
    PG8_WAIT_V(0);
    if constexpr (!ALIGN_EPI) { if (wr == 0) PG8_BAR; }
    PG8_BAR;
    if constexpr (Epi::AFTER_DRAIN) { E.fused(acc, cur, wr, wc, fr, fq, lds, wid, lane); S.done(cur); }
#undef PG8_SA
#undef PG8_SB
#undef PG8_STAGE
#undef PG8_LDA
#undef PG8_LD16A
#undef PG8_LD16B
#undef PG8_LDB
#undef PG8_MMA
#undef PG8_WAIT_V
#undef PG8_WAIT_L
#undef PG8_BAR
#undef PG8_SCHED
}
}

constexpr int NWAVES = 8;
constexpr int BATCH = 2, SEQ = 8192, DM = 2048, M = BATCH * SEQ;
constexpr int DIN = 8592, NU = 8704, NU1 = 4608;
constexpr int DFF = 5632, NUP = 2 * DFF, PLE_DIM = 256;
constexpr float LN_EPS = 1e-5f, RMS_EPS = 1e-6f;
constexpr float ALPHA = 1.189207115002721f;
constexpr float LOG2E = 1.4426950408889634f;
constexpr float QA_SCALE = 0.08838834764831845f * LOG2E;
constexpr float QB_SCALE = 0.07216878364870323f * LOG2E;
constexpr int U_QA = 0, U_KA = 2048, U_VA = 2176, U_QI = 2304, U_KI = 3328, U_WI = 3392, U_CQ = 3408, U_CKV = 3920, U_KPE = 4432, U_G = 4496;

constexpr size_t MiB = 1u << 20;
constexpr size_t WS_CTL = 0, CTL_ZERO_BYTES = 1 * MiB;
constexpr size_t WS_ROPE = 2 * MiB;
constexpr size_t WS_WIN = 4 * MiB;
constexpr size_t WS_WIN8 = 12 * MiB;
constexpr int NU16 = 1280, NU8 = 3328;
constexpr size_t WS_WUQ = 38 * MiB;
constexpr size_t WS_WKV = 41 * MiB;
constexpr size_t WS_WPE = 45 * MiB;
constexpr size_t WS_PB = 46 * MiB;
constexpr size_t WS_XB = 54 * MiB;
constexpr size_t WS_QA = 118 * MiB;
constexpr size_t WS_WUP = 182 * MiB, WS_WDN = 204 * MiB, WS_WPG = 215 * MiB;
constexpr size_t WS_WA = 223 * MiB, WS_WB = 227 * MiB, WS_WO = 231 * MiB, WS_WG = 235 * MiB;
constexpr size_t WS_QN = 260 * MiB;
constexpr size_t WS_XF8 = 324 * MiB;
constexpr size_t WS_MG8 = 292 * MiB;
constexpr size_t WS_KN = 356 * MiB, WS_VB = 420 * MiB;
constexpr size_t WS_G = WS_XB;
constexpr size_t WS_MT = WS_QN, WS_X1B = WS_QA, WS_PEO = WS_XB;
constexpr size_t WS_ACT = 320 * MiB;
constexpr size_t WS_X1F8 = 260 * MiB;
constexpr size_t WS_HEAD = 292 * MiB, WS_TAIL = 484 * MiB;
constexpr size_t DO_AB8 = 0 * MiB;
constexpr size_t DO_QI = 0 * MiB, DO_CQ = 32 * MiB, DO_CKV = 48 * MiB, DO_KA = 64 * MiB, DO_VA = 68 * MiB, DO_KI = 72 * MiB, DO_WI = 74 * MiB, DO_KR = 75 * MiB, DO_QR = 80 * MiB;
constexpr size_t WS_END = 506 * MiB;
constexpr int CW_TMO = 0, CW_CODE = 1, CW_BAR = 4096, CW_RANK = 32768, CW_JOB = 49152;
constexpr int CW_SSQ = 65536;

constexpr int RING_OFF = 0, RING_BYTES = 131072;
constexpr int IDL_OFF = 131072;
constexpr int LDSCTL_OFF = 147456, MISC_OFF = LDSCTL_OFF + 320;
constexpr int LDS_BYTES = 148480;
static_assert(MISC_OFF + 128 <= LDS_BYTES, "LDS map");
#define GAS __attribute__((address_space(1)))
#define LAS __attribute__((address_space(3)))
typedef unsigned short bf16;
typedef unsigned v4u __attribute__((ext_vector_type(4)));
typedef float f32x4 __attribute__((ext_vector_type(4)));
typedef short bf16x8 __attribute__((ext_vector_type(8)));
typedef GAS unsigned gu32;
typedef GAS unsigned long long gu64;
#define RLX_AGENT __ATOMIC_RELAXED, __HIP_MEMORY_SCOPE_AGENT
#define LDS_WAIT() asm volatile("s_waitcnt lgkmcnt(0)" ::: "memory")
#define VM_WAIT() asm volatile("s_waitcnt vmcnt(0)" ::: "memory")
__device__ __forceinline__ unsigned long long rt() { return __builtin_amdgcn_s_memrealtime(); }
__device__ __forceinline__ unsigned f2bf(float f) { unsigned u = __builtin_bit_cast(unsigned, f); return (u + 0x7fffu + ((u >> 16) & 1u)) >> 16; }
__device__ __forceinline__ unsigned pk2(float lo, float hi) { return f2bf(lo) | (f2bf(hi) << 16); }

#define XB_TMO      128
#define XB_XCNT(j)  (256  + 64 * (j))
#define XB_XSUB(j)  (1280 + 64 * (j))
#define XB_XGEN(j)  (2304 + 64 * (j))
#define XB_TOP      3328
#define XB_TOPGEN   3392
#define XCD_BAR_WORDS 3456
#define XB_SPIN_CAP (1u << 18)

__device__ __forceinline__ unsigned xb_ld(unsigned* p)              { return __hip_atomic_load(p, __ATOMIC_RELAXED, __HIP_MEMORY_SCOPE_AGENT); }
__device__ __forceinline__ unsigned xb_add(unsigned* p, unsigned v) { return __hip_atomic_fetch_add(p, v, __ATOMIC_RELAXED, __HIP_MEMORY_SCOPE_AGENT); }
__device__ __forceinline__ unsigned xb_xcc_id() { return (unsigned)__builtin_amdgcn_s_getreg((3 << 11) | 20) & 0xFu; }
#define XB_SPIN(cond, bar) do { unsigned _sp = 0; while (cond) { __builtin_amdgcn_s_sleep(1); \
    if ((++_sp & 255u) == 0u) { if (xb_ld(&(bar)[XB_TMO])) break; if (_sp > XB_SPIN_CAP) { atomicAdd(&(bar)[XB_TMO], 1u); break; } } } } while (0)

struct XcdBarrier {
    unsigned* bar; unsigned x;
    volatile LAS unsigned* st;
};

__device__ __forceinline__ XcdBarrier xcd_barrier_post(unsigned* bar, volatile LAS unsigned* st) {
    XcdBarrier b; b.bar = bar; b.x = xb_xcc_id(); b.st = st;
    if (threadIdx.x == 0) (void)xb_add(&bar[XB_XCNT(b.x)], 1u);
    return b;
}
__device__ __forceinline__ void xcd_barrier_complete(unsigned* bar, unsigned x, unsigned& nloc, unsigned& nx) {
    const unsigned G = gridDim.x * gridDim.y * gridDim.z;
    unsigned sum, cnt, mine, sp = 0u;
    for (;;) {
        sum = 0u; cnt = 0u; mine = 0u;
#pragma unroll
        for (unsigned j = 0; j < 16; ++j) { const unsigned c = xb_ld(&bar[XB_XCNT(j)]); sum += c; cnt += (c > 0u) ? 1u : 0u; mine = (j == x) ? c : mine; }
        if (sum == G) break;
        __builtin_amdgcn_s_sleep(1);
        if ((++sp & 255u) == 0u) { if (xb_ld(&bar[XB_TMO])) break; if (sp > XB_SPIN_CAP) { atomicAdd(&bar[XB_TMO], 1u); break; } }
    }
    nloc = mine > 0u ? mine : 1u; nx = cnt > 0u ? cnt : 1u;
}

__device__ __forceinline__ void xcd_barrier(const XcdBarrier& b) {
    asm volatile("s_waitcnt vmcnt(0)" ::: "memory");
    __syncthreads();
    if (threadIdx.x == 0) {
        unsigned* bar = b.bar;
        __builtin_amdgcn_s_waitcnt(0);
        unsigned nloc = b.st[0], nx = b.st[1];
        if (nloc == 0u) { xcd_barrier_complete(bar, b.x, nloc, nx); b.st[0] = nloc; b.st[1] = nx; }
        const unsigned old = xb_add(&bar[XB_XSUB(b.x)], 1u);
        const unsigned gen = old / nloc;
        if (old + 1u == (gen + 1u) * nloc) {
            __builtin_amdgcn_fence(__ATOMIC_RELEASE, "agent");
            asm volatile("s_waitcnt vmcnt(0)" ::: "memory");
            const unsigned og = xb_add(&bar[XB_TOP], 1u);
            const unsigned tg = og / nx;
            if (og + 1u == (tg + 1u) * nx) xb_add(&bar[XB_TOPGEN], 1u);
            else XB_SPIN(xb_ld(&bar[XB_TOPGEN]) == tg, bar);
            __builtin_amdgcn_fence(__ATOMIC_ACQUIRE, "agent");
            xb_add(&bar[XB_XGEN(b.x)], 1u);
            asm volatile("s_waitcnt vmcnt(0)" ::: "memory");
        } else {
            XB_SPIN(xb_ld(&bar[XB_XGEN(b.x)]) == gen, bar);
            __builtin_amdgcn_fence(__ATOMIC_ACQUIRE, "agent");
            asm volatile("s_waitcnt vmcnt(0)" ::: "memory");
        }
    }
    __syncthreads();
}

typedef unsigned u32x2 __attribute__((ext_vector_type(2)));
typedef float f32x16 __attribute__((ext_vector_type(16)));
typedef short s16x4 __attribute__((ext_vector_type(4)));
using pg8::cvt_pk_bf16;
__device__ __forceinline__ v4u pack8(f32x4 a, f32x4 b) { v4u w; w.x = cvt_pk_bf16(a[0], a[1]); w.y = cvt_pk_bf16(a[2], a[3]); w.z = cvt_pk_bf16(b[0], b[1]); w.w = cvt_pk_bf16(b[2], b[3]); return w; }
__device__ __forceinline__ u32x2 pack4(f32x4 a) { u32x2 w; w.x = cvt_pk_bf16(a[0], a[1]); w.y = cvt_pk_bf16(a[2], a[3]); return w; }
__device__ __forceinline__ float bflo(unsigned u) { return __uint_as_float(u << 16); }
__device__ __forceinline__ float bfhi(unsigned u) { return __uint_as_float(u & 0xffff0000u); }
__device__ __forceinline__ void unpack8(v4u w, f32x4& a, f32x4& b) { a = (f32x4){bflo(w.x), bfhi(w.x), bflo(w.y), bfhi(w.y)}; b = (f32x4){bflo(w.z), bfhi(w.z), bflo(w.w), bfhi(w.w)}; }
typedef _Float16 f16x2 __attribute__((ext_vector_type(2)));
using pg8::f16x8;
__device__ __forceinline__ unsigned pkh(float a, float b) { const f16x2 v = {(_Float16)a, (_Float16)b}; return __builtin_bit_cast(unsigned, v); }
__device__ __forceinline__ v4u pack8h(f32x4 a, f32x4 b) { v4u w; w.x = pkh(a[0], a[1]); w.y = pkh(a[2], a[3]); w.z = pkh(b[0], b[1]); w.w = pkh(b[2], b[3]); return w; }
__device__ __forceinline__ void unpack8h(v4u w, f32x4& a, f32x4& b) { const f16x8 h = __builtin_bit_cast(f16x8, w); a = (f32x4){(float)h[0], (float)h[1], (float)h[2], (float)h[3]}; b = (f32x4){(float)h[4], (float)h[5], (float)h[6], (float)h[7]}; }
__device__ __forceinline__ unsigned pkf8(float a, float b, float c, float d) { int w = 0; w = __builtin_amdgcn_cvt_pk_fp8_f32(a, b, w, false); w = __builtin_amdgcn_cvt_pk_fp8_f32(c, d, w, true); return (unsigned)w; }
__device__ __forceinline__ float sigmoidf_(float x) { return __builtin_amdgcn_rcpf(1.0f + __builtin_amdgcn_exp2f(-LOG2E * x)); }
__device__ __forceinline__ f32x4 sigmoid4(f32x4 x) { return (f32x4){sigmoidf_(x[0]), sigmoidf_(x[1]), sigmoidf_(x[2]), sigmoidf_(x[3])}; }
__device__ __forceinline__ float sum_x16(float v) { auto r = __builtin_amdgcn_permlane16_swap(__float_as_uint(v), __float_as_uint(v), false, false); return __uint_as_float(r[0]) + __uint_as_float(r[1]); }
__device__ __forceinline__ float sum_x32(float v) { auto r = __builtin_amdgcn_permlane32_swap(__float_as_uint(v), __float_as_uint(v), false, false); return __uint_as_float(r[0]) + __uint_as_float(r[1]); }
__device__ __forceinline__ float max_x16(float v) { auto r = __builtin_amdgcn_permlane16_swap(__float_as_uint(v), __float_as_uint(v), false, false); return fmaxf(__uint_as_float(r[0]), __uint_as_float(r[1])); }
__device__ __forceinline__ float max_x32(float v) { auto r = __builtin_amdgcn_permlane32_swap(__float_as_uint(v), __float_as_uint(v), false, false); return fmaxf(__uint_as_float(r[0]), __uint_as_float(r[1])); }
template <int CTRL> __device__ __forceinline__ float dppf(float v) { return __int_as_float(__builtin_amdgcn_update_dpp(0, __float_as_int(v), CTRL, 0xf, 0xf, false)); }
__device__ __forceinline__ float wave_sum(float v) {
    v += dppf<0xB1>(v); v += dppf<0x4E>(v); v += dppf<0x141>(v); v += dppf<0x140>(v);
    return sum_x32(sum_x16(v));
}
__device__ __forceinline__ int rope_perm(int pc) { const int g = pc >> 3, e = pc & 7; return e < 4 ? 4 * g + e : 32 + 4 * g + (e - 4); }
template <int MAP> __device__ __forceinline__ int srcmap(int n) {
    if (MAP == 0) return n;
    if (MAP == 1) {
        if (n < 2048) return U_QA + n;
        if (n < 3072) return U_QI + (n - 2048);
        if (n < 3200) return U_KA + (n - 3072);
        if (n < 3328) return U_VA + (n - 3200);
        if (n < 3584) { const int o = n - 3328; if (o < 64) return U_KI + o; if (o < 128) return U_KPE + rope_perm(o - 64); if (o < 144) return U_WI + (o - 128); return -1; }
        if (n < 4096) return U_CQ + (n - 3584);
        if (n < 4608) return U_CKV + (n - 4096);
        return U_G + (n - 4608);
    }
    if (MAP == 2) {
        if (n < 2048) return (n >> 7) * 192 + (n & 127);
        const int o = n - 2048; return (o >> 6) * 192 + 128 + rope_perm(o & 63);
    }
    { const int pn = n >> 8, o = n & 255; return o < 128 ? pn * 128 + o : DFF + pn * 128 + (o - 128); }
}
constexpr int TR_LDS = 64 * 68 * 4;
__device__ __forceinline__ void tr_item(const float* W, int ldw, const float* gk, bf16* WT, int K, int k0, int drow0, int srccol4, LAS float* scr, int lane, bool h16) {
    const int c4 = (lane & 15) * 4;
#pragma unroll 8
    for (int i = 0; i < 16; ++i) { const int kk = 4 * i + (lane >> 4); f32x4 v = (f32x4){0.f, 0.f, 0.f, 0.f};
        if (srccol4 >= 0) { v = *(const GAS f32x4*)(W + (size_t)(k0 + kk) * ldw + srccol4); if (gk) v = v * gk[k0 + kk]; }
        *(LAS f32x4*)(scr + kk * 68 + c4) = v; }
    LDS_WAIT(); asm volatile("" ::: "memory");
    bf16* orow = WT + (size_t)(drow0 + lane) * K + k0;
#pragma unroll
    for (int k8 = 0; k8 < 8; ++k8) { const LAS float* s = scr + (8 * k8) * 68 + lane;
        v4u o; if (h16) { o.x = pkh(s[0 * 68], s[1 * 68]); o.y = pkh(s[2 * 68], s[3 * 68]); o.z = pkh(s[4 * 68], s[5 * 68]); o.w = pkh(s[6 * 68], s[7 * 68]); }
        else { o.x = pk2(s[0 * 68], s[1 * 68]); o.y = pk2(s[2 * 68], s[3 * 68]); o.z = pk2(s[4 * 68], s[5 * 68]); o.w = pk2(s[6 * 68], s[7 * 68]); }
        *(GAS v4u*)(orow + 8 * k8) = o; }
    LDS_WAIT(); asm volatile("" ::: "memory");
}
struct TrIn { const float *w_in, *gq, *gkv, *w_uq, *w_uk, *w_uv, *w_a, *w_b, *w_o, *w_up, *w_dn, *w_pg, *w_pe; };
struct TrItem { const float* W; const float* gk; bf16* WT; int ldw, K, k0, drow0, srccol4, mode; float wmul; };
constexpr int TR_E0 = 32 * 72, TR_E1 = TR_E0 + 8 * 48, TR_E2 = TR_E1 + 8 * 32, TR_E3 = TR_E2 + 8 * 32, TR_E4 = TR_E3 + 4 * 32, TR_E5 = TR_E4 + 1024, TR_E6 = TR_E5 + 1024, TR_E7 = TR_E6 + 1024, TR_E8 = TR_E7 + 1024,
              TR_E9 = TR_E8 + 32 * 176, TR_E10 = TR_E9 + 88 * 32, TR_E11 = TR_E10 + 32 * 64;
__device__ __forceinline__ TrItem tr_decode(const TrIn& I, unsigned char* ws, int it, int lane) {
    TrItem t; int r, nblk, map = 0; t.gk = nullptr; t.mode = 0; t.wmul = 1.f; int rowoff = 0;
    if (it < 32 * 20) { r = it; nblk = 20; t.W = I.w_in; t.ldw = DIN; t.WT = (bf16*)(ws + WS_WIN); t.K = 2048; map = 5; t.mode = 1; }
    else if (it < TR_E0) { r = it - 32 * 20; nblk = 52; t.W = I.w_in; t.ldw = DIN; t.WT = (bf16*)(ws + WS_WIN8); t.K = 2048; map = 6; t.mode = 2; t.wmul = 64.f; }
    else if (it < TR_E1) { r = it - TR_E0; nblk = 48; t.W = I.w_uq; t.ldw = 3072; t.WT = (bf16*)(ws + WS_WUQ); t.K = 512; map = 2; t.gk = I.gq; t.mode = 2; t.wmul = 32.f; }
    else if (it < TR_E2) { r = it - TR_E1; nblk = 32; t.W = I.w_uk; t.ldw = 2048; t.WT = (bf16*)(ws + WS_WKV); t.K = 512; t.gk = I.gkv; t.mode = 2; t.wmul = 32.f; }
    else if (it < TR_E3) { r = it - TR_E2; nblk = 32; t.W = I.w_uv; t.ldw = 2048; t.WT = (bf16*)(ws + WS_WKV); t.K = 512; t.gk = I.gkv; rowoff = 2048; t.mode = 2; t.wmul = 32.f; }
    else if (it < TR_E4) { r = it - TR_E3; nblk = 32; t.W = I.w_pe; t.ldw = 2048; t.WT = (bf16*)(ws + WS_WPE); t.K = 256; }
    else if (it < TR_E5) { r = it - TR_E4; nblk = 32; t.W = I.w_a; t.ldw = 2048; t.WT = (bf16*)(ws + WS_WA); t.K = 2048; t.mode = 2; t.wmul = 64.f; }
    else if (it < TR_E6) { r = it - TR_E5; nblk = 32; t.W = I.w_b; t.ldw = 2048; t.WT = (bf16*)(ws + WS_WB); t.K = 2048; t.mode = 2; t.wmul = 64.f; }
    else if (it < TR_E7) { r = it - TR_E6; nblk = 32; t.W = I.w_o; t.ldw = 2048; t.WT = (bf16*)(ws + WS_WO); t.K = 2048; t.mode = 2; t.wmul = 64.f; }
    else if (it < TR_E8) { r = it - TR_E7; nblk = 32; t.W = I.w_pg; t.ldw = 2048; t.WT = (bf16*)(ws + WS_WPG); t.K = 2048; t.mode = 2; t.wmul = 64.f; }
    else if (it < TR_E9) { r = it - TR_E8; nblk = 176; t.W = I.w_up; t.ldw = NUP; t.WT = (bf16*)(ws + WS_WUP); t.K = 2048; map = 3; t.mode = 2; t.wmul = 64.f; }
    else if (it < TR_E10) { r = it - TR_E9; nblk = 32; t.W = I.w_dn; t.ldw = 2048; t.WT = (bf16*)(ws + WS_WDN); t.K = DFF; t.mode = 2; t.wmul = 128.f; }
    else { r = it - TR_E10; nblk = 64; t.W = I.w_in; t.ldw = DIN; t.WT = (bf16*)(ws + WS_WG); t.K = 2048; map = 4; t.mode = 2; t.wmul = 64.f; }
    const int kb = r / nblk, nb = r - kb * nblk, n0 = nb * 64, nl = n0 + 4 * (lane & 15);
    t.k0 = kb * 64; t.drow0 = rowoff + n0; t.srccol4 = map == 0 ? nl : map == 5 ? srcmap<1>(nl < 1024 ? 2048 + nl : 2304 + nl) : map == 6 ? srcmap<1>(nl < 2048 ? nl : nl < 2304 ? 1024 + nl : 1280 + nl) : map == 2 ? srcmap<2>(nl) : map == 3 ? srcmap<3>(nl) : U_G + nl;
    return t;
}
__device__ __forceinline__ void tr_load(const TrItem& t, f32x4 (&v)[16], int lane) {
#pragma unroll
    for (int i = 0; i < 16; ++i) { const int kk = 4 * i + (lane >> 4); v[i] = (f32x4){0.f, 0.f, 0.f, 0.f};
        if (t.srccol4 >= 0) { v[i] = *(const GAS f32x4*)(t.W + (size_t)(t.k0 + kk) * t.ldw + t.srccol4); if (t.gk) v[i] = v[i] * t.gk[t.k0 + kk]; } }
}
__device__ __forceinline__ void tr_all(const TrIn& I, unsigned char* ws, LAS float* scr, int gw, int NGW, int lane) {
    int it = gw; if (it >= TR_E11) return;
    TrItem cur = tr_decode(I, ws, it, lane); f32x4 v[16]; tr_load(cur, v, lane);
    for (;;) {
        const int c4 = (lane & 15) * 4;
#pragma unroll
        for (int i = 0; i < 16; ++i) *(LAS f32x4*)(scr + (4 * i + (lane >> 4)) * 68 + c4) = v[i];
        LDS_WAIT(); asm volatile("" ::: "memory");
        const int itn = it + NGW; const bool more = itn < TR_E11; TrItem nxt = cur;
        if (more) { nxt = tr_decode(I, ws, itn, lane); tr_load(nxt, v, lane); }
        if (cur.mode == 2) { unsigned char* orow = (unsigned char*)cur.WT + (size_t)(cur.drow0 + lane) * cur.K + cur.k0; const float wm = cur.wmul;
#pragma unroll
            for (int k16 = 0; k16 < 4; ++k16) { const LAS float* s = scr + (16 * k16) * 68 + lane; v4u o;
                o.x = pkf8(s[0 * 68] * wm, s[1 * 68] * wm, s[2 * 68] * wm, s[3 * 68] * wm); o.y = pkf8(s[4 * 68] * wm, s[5 * 68] * wm, s[6 * 68] * wm, s[7 * 68] * wm);
                o.z = pkf8(s[8 * 68] * wm, s[9 * 68] * wm, s[10 * 68] * wm, s[11 * 68] * wm); o.w = pkf8(s[12 * 68] * wm, s[13 * 68] * wm, s[14 * 68] * wm, s[15 * 68] * wm);
                *(GAS v4u*)(orow + 16 * k16) = o; } }
        else { bf16* orow = cur.WT + (size_t)(cur.drow0 + lane) * cur.K + cur.k0;
#pragma unroll
        for (int k8 = 0; k8 < 8; ++k8) { const LAS float* s = scr + (8 * k8) * 68 + lane;
            v4u o; if (cur.mode == 1) { o.x = pkh(s[0 * 68], s[1 * 68]); o.y = pkh(s[2 * 68], s[3 * 68]); o.z = pkh(s[4 * 68], s[5 * 68]); o.w = pkh(s[6 * 68], s[7 * 68]); }
            else { o.x = pk2(s[0 * 68], s[1 * 68]); o.y = pk2(s[2 * 68], s[3 * 68]); o.z = pk2(s[4 * 68], s[5 * 68]); o.w = pk2(s[6 * 68], s[7 * 68]); }
            *(GAS v4u*)(orow + 8 * k8) = o; } }
        LDS_WAIT(); asm volatile("" ::: "memory");
        if (!more) break;
        cur = nxt; it = itn;
    }
}
__device__ __forceinline__ void cvt_flat_h(const float* src, bf16* dst, unsigned char* dst8, size_t n8, size_t gt, size_t NT) {
    for (size_t i = gt; i < n8; i += 4 * NT) { f32x4 a[4], b[4];
#pragma unroll
        for (int u = 0; u < 4; ++u) { a[u] = *(const GAS f32x4*)(src + (i + u * NT) * 8); b[u] = *(const GAS f32x4*)(src + (i + u * NT) * 8 + 4); }
#pragma unroll
        for (int u = 0; u < 4; ++u) { *(GAS v4u*)(dst + (i + u * NT) * 8) = pack8h(a[u], b[u]);
            u32x2 w; w.x = pkf8(a[u][0], a[u][1], a[u][2], a[u][3]); w.y = pkf8(b[u][0], b[u][1], b[u][2], b[u][3]); *(GAS u32x2*)(dst8 + (i + u * NT) * 8) = w; } }
}
__device__ __forceinline__ void cvt_flat(const float* src, bf16* dst, size_t n8, size_t gt, size_t NT) {
    for (size_t i = gt; i < n8; i += 4 * NT) { f32x4 a[4], b[4];
#pragma unroll
        for (int u = 0; u < 4; ++u) { a[u] = *(const GAS f32x4*)(src + (i + u * NT) * 8); b[u] = *(const GAS f32x4*)(src + (i + u * NT) * 8 + 4); }
#pragma unroll
        for (int u = 0; u < 4; ++u) *(GAS v4u*)(dst + (i + u * NT) * 8) = pack8(a[u], b[u]); }
}

typedef const pg8::f32x4 (&AccRef)[2][2][4][2];
using pg8::f32x2;
using pg8::Unit;
#define EPI_ROWS(ai, m) for (int ai = 0; ai < 2; ++ai) _Pragma("unroll") for (int m = 0; m < 4; ++m)

template <int PM> struct EpiU {
    static constexpr bool PERM = true, AFTER_DRAIN = false;
    bf16 *QA, *QI, *KA, *VA, *KI, *KR, *CQ, *CKV; float* WI; float* SSQ; const float* ROPE;
    __device__ __forceinline__ void operator()(AccRef acc, const Unit& u, int wr, int wc, int fr, int fq) const {
        { int t_ = threadIdx.x; asm volatile("" : "+v"(t_)); fr = t_ & 15; fq = (t_ >> 4) & 3; }
        const int pn = PM == 1 ? (u.pn < 8 ? u.pn : u.pn == 8 ? 12 : u.pn + 5) : (u.pn < 4 ? 8 + u.pn : 13), rowb = u.pm * 256 + wr * 64 + fr, cw = wc * 32 + 8 * fq;
        if (pn < 12) {
            bf16* base = pn < 8 ? QA : QI; const int ldc = pn < 8 ? 2048 : 1024, colt = (pn < 8 ? pn : pn - 8) * 256; const float sc = pn < 8 ? QA_SCALE : 1.f;
#pragma unroll
            EPI_ROWS(ai, m) { bf16* rp = base + (size_t)(rowb + ai * 128 + m * 16) * ldc + colt + cw;
#pragma unroll
                for (int bj = 0; bj < 2; ++bj) *(GAS v4u*)(rp + bj * 128) = pn < 8 ? pack8(acc[ai][bj][m][0] * sc, acc[ai][bj][m][1] * sc) : pack8h(acc[ai][bj][m][0], acc[ai][bj][m][1]); }
        } else if (pn == 12) {
#pragma unroll
            EPI_ROWS(ai, m) { const size_t row = rowb + ai * 128 + m * 16;
                *(GAS v4u*)(KA + row * 128 + cw) = pack8(acc[ai][0][m][0], acc[ai][0][m][1]);
                *(GAS v4u*)(VA + row * 128 + cw) = pack8(acc[ai][1][m][0], acc[ai][1][m][1]); }
        } else if (pn == 13) {
#pragma unroll
            EPI_ROWS(ai, m) { const size_t row = rowb + ai * 128 + m * 16; const int pos = (int)(row & (SEQ - 1));
                const f32x4 v0 = acc[ai][0][m][0], v1 = acc[ai][0][m][1];
                if (wc < 2) { *(GAS v4u*)(KI + (row & ~(size_t)31) * 64 + (2 * wc + (fq >> 1)) * 512 + ((fq & 1) * 32 + (int)(row & 31)) * 8) = pack8h(v0, v1); }
                else { const int g = 4 * (wc - 2) + fq; const f32x4 c4 = *(const GAS f32x4*)(ROPE + pos * 32 + 4 * g), s4 = *(const GAS f32x4*)(ROPE + SEQ * 32 + pos * 32 + 4 * g);
                    const f32x4 y1 = v0 * c4 - v1 * s4, y2 = v0 * s4 + v1 * c4; GAS unsigned char* kr8 = (GAS unsigned char*)KR + row * 64 + 4 * g;
                    *(GAS unsigned*)kr8 = pkf8(y1[0], y1[1], y1[2], y1[3]); *(GAS unsigned*)(kr8 + 32) = pkf8(y2[0], y2[1], y2[2], y2[3]); }
                if (wc == 0 && fq < 2) { *(GAS f32x4*)(WI + row * 16 + 8 * fq) = acc[ai][1][m][0]; *(GAS f32x4*)(WI + row * 16 + 8 * fq + 4) = acc[ai][1][m][1]; } }
        } else {
            const int t = pn - 14; bf16* base = t < 2 ? CQ : CKV; float* ssq = SSQ + (t < 2 ? (size_t)0 : (size_t)M * 8); const int colt = (t & 1) * 256;
#pragma unroll
            EPI_ROWS(ai, m) { const size_t row = rowb + ai * 128 + m * 16; float s = 0.f;
#pragma unroll
                for (int bj = 0; bj < 2; ++bj) { const f32x4 v0 = acc[ai][bj][m][0], v1 = acc[ai][bj][m][1];
                    { u32x2 w8; w8.x = pkf8(v0[0], v0[1], v0[2], v0[3]); w8.y = pkf8(v1[0], v1[1], v1[2], v1[3]); *(GAS u32x2*)((GAS unsigned char*)base + row * 512 + colt + bj * 128 + cw) = w8; }
                    s += (v0[0] * v0[0] + v0[1] * v0[1]) + (v0[2] * v0[2] + v0[3] * v0[3]) + (v1[0] * v1[0] + v1[1] * v1[1]) + (v1[2] * v1[2] + v1[3] * v1[3]); }
                s = sum_x32(sum_x16(s));
                if (fq == 0) ssq[row * 8 + (t & 1) * 4 + wc] = s; }
        }
    }
};
struct EpiQ {
    static constexpr bool PERM = true, AFTER_DRAIN = false;
    bf16 *QN, *QR; const float* SSQ; const float* ROPE;
    __device__ __forceinline__ void operator()(AccRef acc, const Unit& u, int wr, int wc, int fr, int fq) const {
        { int t_ = threadIdx.x; asm volatile("" : "+v"(t_)); fr = t_ & 15; fq = (t_ >> 4) & 3; }
        const int pn = u.pn, rowb = u.pm * 256 + wr * 64 + fr, cw = wc * 32 + 8 * fq;
#pragma unroll
        EPI_ROWS(ai, m) { const size_t row = rowb + ai * 128 + m * 16;
            const f32x4 sa = *(const GAS f32x4*)(SSQ + row * 8), sb = *(const GAS f32x4*)(SSQ + row * 8 + 4); const float r = (8.f * QB_SCALE) / sqrtf((((sa[0] + sa[1]) + (sa[2] + sa[3])) + ((sb[0] + sb[1]) + (sb[2] + sb[3]))) * (1.f / 512.f) + RMS_EPS);
            if (pn < 8) {
#pragma unroll
                for (int bj = 0; bj < 2; ++bj) { const f32x4 v0 = acc[ai][bj][m][0] * r, v1 = acc[ai][bj][m][1] * r; u32x2 w; w.x = pkf8(v0[0], v0[1], v0[2], v0[3]); w.y = pkf8(v1[0], v1[1], v1[2], v1[3]);
                    *(GAS u32x2*)((GAS unsigned char*)QN + row * 2048 + pn * 256 + bj * 128 + cw) = w; }
            } else { const int pos = (int)(row & (SEQ - 1)), g = 4 * (wc & 1) + fq;
                const f32x4 c4 = *(const GAS f32x4*)(ROPE + pos * 32 + 4 * g) * r, s4 = *(const GAS f32x4*)(ROPE + SEQ * 32 + pos * 32 + 4 * g) * r;
#pragma unroll
                for (int bj = 0; bj < 2; ++bj) { const int head = (pn - 8) * 4 + bj * 2 + (wc >> 1); const f32x4 v0 = acc[ai][bj][m][0], v1 = acc[ai][bj][m][1];
                    const f32x4 y1 = v0 * c4 - v1 * s4, y2 = v0 * s4 + v1 * c4; GAS unsigned char* q8 = (GAS unsigned char*)QR + row * 1024 + head * 64 + 4 * g;
                    *(GAS unsigned*)q8 = pkf8(y1[0], y1[1], y1[2], y1[3]); *(GAS unsigned*)(q8 + 32) = pkf8(y2[0], y2[1], y2[2], y2[3]); } } }
    }
};
struct EpiKV {
    static constexpr bool PERM = true, AFTER_DRAIN = false;
    bf16 *KN, *VB; const float* SSQ;
    __device__ __forceinline__ void operator()(AccRef acc, const Unit& u, int wr, int wc, int fr, int fq) const {
        { int t_ = threadIdx.x; asm volatile("" : "+v"(t_)); fr = t_ & 15; fq = (t_ >> 4) & 3; }
        const int pn = u.pn, rowb = u.pm * 256 + wr * 64 + fr, cw = wc * 32 + 8 * fq; bf16* base = pn < 8 ? KN : VB; const int colt = (pn & 7) * 256;
#pragma unroll
        EPI_ROWS(ai, m) { const size_t row = rowb + ai * 128 + m * 16; const f32x4 sa = *(const GAS f32x4*)(SSQ + row * 8), sb = *(const GAS f32x4*)(SSQ + row * 8 + 4); const float r = 1.0f / sqrtf((((sa[0] + sa[1]) + (sa[2] + sa[3])) + ((sb[0] + sb[1]) + (sb[2] + sb[3]))) * (1.f / 512.f) + RMS_EPS);
#pragma unroll
            for (int bj = 0; bj < 2; ++bj) { const f32x4 v0 = acc[ai][bj][m][0] * r, v1 = acc[ai][bj][m][1] * r;
                if (pn < 8) { u32x2 w; w.x = pkf8(v0[0], v0[1], v0[2], v0[3]); w.y = pkf8(v1[0], v1[1], v1[2], v1[3]); *(GAS u32x2*)((GAS unsigned char*)KN + row * 2048 + colt + bj * 128 + cw) = w; }
                else *(GAS v4u*)(VB + row * 2048 + colt + bj * 128 + cw) = pack8(v0, v1); } }
    }
};
__device__ __forceinline__ void unpack8f8(const u32x2 w, f32x4& a, f32x4& b) {
    const f32x2 a0 = __builtin_amdgcn_cvt_pk_f32_fp8((int)w.x, false), a1 = __builtin_amdgcn_cvt_pk_f32_fp8((int)w.x, true), b0 = __builtin_amdgcn_cvt_pk_f32_fp8((int)w.y, false), b1 = __builtin_amdgcn_cvt_pk_f32_fp8((int)w.y, true);
    a = (f32x4){a0[0], a0[1], a1[0], a1[1]}; b = (f32x4){b0[0], b0[1], b1[0], b1[1]};
}
__device__ __forceinline__ u32x2 pack8f8(const f32x4 a, const f32x4 b) { u32x2 w; w.x = pkf8(a[0], a[1], a[2], a[3]); w.y = pkf8(b[0], b[1], b[2], b[3]); return w; }
template <int MODE> struct EpiB {
    static constexpr bool PERM = true, AFTER_DRAIN = false;
    bf16* O; int ldc; const bf16* gp; const float* bias; unsigned char* O8;
    __device__ __forceinline__ void operator()(AccRef acc, const Unit& u, int wr, int wc, int fr, int fq) const {
        { int t_ = threadIdx.x; asm volatile("" : "+v"(t_)); fr = t_ & 15; fq = (t_ >> 4) & 3; }
        const int rowb = u.pm * 256 + wr * 64 + fr, colb = u.pn * 256 + wc * 32 + 8 * fq;
#pragma unroll
        EPI_ROWS(ai, m) { const size_t row = rowb + ai * 128 + m * 16;
#pragma unroll
            for (int bj = 0; bj < 2; ++bj) { const int col = colb + bj * 128; f32x4 v0 = acc[ai][bj][m][0], v1 = acc[ai][bj][m][1]; GAS unsigned char* op = (GAS unsigned char*)O + row * ldc + col;
                if (MODE == 1) { v0 = sigmoid4(v0); v1 = sigmoid4(v1); }
                if (MODE == 2 || MODE == 5) { f32x4 g0, g1; unpack8f8(*(const GAS u32x2*)((const GAS unsigned char*)gp + row * 4096 + col), g0, g1); v0 = v0 * g0; v1 = v1 * g1; }
                if (MODE == 5) { f32x4 o0, o1; unpack8f8(*(const GAS u32x2*)op, o0, o1); v0 = v0 + o0; v1 = v1 + o1; }
                if (MODE == 4) { f32x4 o0, o1; unpack8f8(*(const GAS u32x2*)op, o0, o1); const f32x4 b0 = *(const GAS f32x4*)(bias + col), b1 = *(const GAS f32x4*)(bias + col + 4);
                    v0 = sigmoid4(v0 + b0) * o0; v1 = sigmoid4(v1 + b1) * o1; }
                if (MODE == 5) *(GAS u32x2*)(O8 + row * ldc + col) = pack8f8(v0, v1);
                else *(GAS u32x2*)op = pack8f8(v0, v1); }
            if (MODE >= 2) asm volatile("" ::: "memory"); }
    }
};
template <int MODE> struct EpiF {
    static constexpr bool PERM = true, AFTER_DRAIN = false;
    bf16* zb; const float* xin; const bf16* ple;
    __device__ __forceinline__ void operator()(AccRef acc, const Unit& u, int wr, int wc, int fr, int fq) const {
        { int t_ = threadIdx.x; asm volatile("" : "+v"(t_)); fr = t_ & 15; fq = (t_ >> 4) & 3; }
        const int rowb = u.pm * 256 + wr * 64 + fr, colb = u.pn * 256 + wc * 32 + 8 * fq;
#pragma unroll
        EPI_ROWS(ai, m) { const size_t row = rowb + ai * 128 + m * 16;
#pragma unroll
            for (int bj = 0; bj < 2; ++bj) { const size_t off = row * 2048 + colb + bj * 128; f32x4 v0 = acc[ai][bj][m][0], v1 = acc[ai][bj][m][1]; f32x4 x0, x1;
                if (MODE == 0) { x0 = *(const GAS f32x4*)(xin + off); x1 = *(const GAS f32x4*)(xin + off + 4); } else unpack8(*(const GAS v4u*)(zb + off), x0, x1);
                v0 = v0 + x0 * ALPHA; v1 = v1 + x1 * ALPHA;
                if (MODE == 1) { f32x4 p0, p1; unpack8f8(*(const GAS u32x2*)((const GAS unsigned char*)ple + off), p0, p1); v0 = v0 + p0; v1 = v1 + p1; }
                *(GAS v4u*)(zb + off) = pack8(v0, v1); }
            asm volatile("" ::: "memory"); }
    }
};
template <int CTRL> __device__ __forceinline__ f32x4 dpp4(f32x4 v) { return (f32x4){dppf<CTRL>(v[0]), dppf<CTRL>(v[1]), dppf<CTRL>(v[2]), dppf<CTRL>(v[3])}; }
__device__ __forceinline__ f32x4 sel4(bool c, f32x4 a, f32x4 b) { return (f32x4){c ? a[0] : b[0], c ? a[1] : b[1], c ? a[2] : b[2], c ? a[3] : b[3]}; }
struct EpiUp {
    static constexpr bool PERM = true, AFTER_DRAIN = false;
    unsigned char* ACT; float* HEADB; float* TAILB; const float* cw; const float* cb;
    __device__ __forceinline__ void operator()(AccRef acc, const Unit& u, int wr, int wc, int fr, int fq) const {
        { int t_ = threadIdx.x; asm volatile("" : "+v"(t_)); fr = t_ & 15; fq = (t_ >> 4) & 3; }
        const unsigned ch0 = (unsigned)(u.pn * 128 + wc * 32 + 8 * fq), cp0 = (unsigned)(u.pn * 256 + wc * 32 + 8 * fq);
        const GAS unsigned char* cwb = (const GAS unsigned char*)cw; const GAS unsigned char* cbb = (const GAS unsigned char*)cb; GAS unsigned char* actb = (GAS unsigned char*)ACT;
#pragma unroll
        for (int ai = 0; ai < 2; ++ai) {
            const unsigned g = (unsigned)(u.pm * 4 + ai * 2 + wr), row0 = g * 64u + (unsigned)fr;
            if (fr < 2) { GAS unsigned char* hp = (GAS unsigned char*)HEADB + ((g * 2u + (unsigned)fr) * (unsigned)NUP + cp0) * 4u;
#pragma unroll
                for (int bj = 0; bj < 2; ++bj)
#pragma unroll
                    for (int n = 0; n < 2; ++n) *(GAS f32x4*)(hp + (bj * 128 + 4 * n) * 4) = acc[ai][bj][0][n]; }
            if (fr >= 14) { GAS unsigned char* hp = (GAS unsigned char*)TAILB + ((g * 2u + (unsigned)(fr - 14)) * (unsigned)NUP + cp0) * 4u;
#pragma unroll
                for (int bj = 0; bj < 2; ++bj)
#pragma unroll
                    for (int n = 0; n < 2; ++n) *(GAS f32x4*)(hp + (bj * 128 + 4 * n) * 4) = acc[ai][bj][3][n]; }
            asm volatile("" ::: "memory"); __builtin_amdgcn_sched_barrier(0);
#pragma unroll
            for (int n = 0; n < 2; ++n) {
                unsigned pk[4];
#pragma unroll
                for (int hf = 0; hf < 2; ++hf) {
                    asm volatile("" ::: "memory"); __builtin_amdgcn_sched_barrier(0);
                    f32x2 yg[4];
#pragma unroll
                    for (int bj = 0; bj < 2; ++bj) { const unsigned cB = (ch0 + (unsigned)(4 * n + 2 * hf + bj * DFF)) * 4u;
                        const f32x2 w0 = *(const GAS f32x2*)(cwb + cB), w1 = *(const GAS f32x2*)(cwb + (cB + (unsigned)NUP * 4u)), w2 = *(const GAS f32x2*)(cwb + (cB + (unsigned)NUP * 8u)), bb = *(const GAS f32x2*)(cbb + cB);
                        f32x2 pr1 = (f32x2){0.f, 0.f}, pr2 = pr1;
#pragma unroll
                        for (int m = 0; m < 4; ++m) { const f32x4 v4 = acc[ai][bj][m][n]; const f32x2 v = hf ? (f32x2){v4[2], v4[3]} : (f32x2){v4[0], v4[1]};
                            const f32x2 r1 = (f32x2){dppf<0x121>(v[0]), dppf<0x121>(v[1])}, r2 = (f32x2){dppf<0x122>(v[0]), dppf<0x122>(v[1])};
                            const f32x2 p1 = fr >= 1 ? r1 : pr1, p2 = fr >= 2 ? r2 : pr2;
                            const f32x2 y = bb + w2 * v + w1 * p1 + w0 * p2; pr1 = r1; pr2 = r2;
                            if (bj == 0) yg[m] = y;
                            else { const f32x2 sg = (f32x2){sigmoidf_(yg[m][0]), sigmoidf_(yg[m][1])}; const f32x2 a = yg[m] * sg * y;
                                if (hf == 0) pk[m] = (unsigned)__builtin_amdgcn_cvt_pk_fp8_f32(a[0], a[1], 0, false);
                                else { const unsigned w = (unsigned)__builtin_amdgcn_cvt_pk_fp8_f32(a[0], a[1], (int)pk[m], true); if (!(m == 0 && fr < 2)) *(GAS unsigned*)(actb + ((row0 + (unsigned)(m * 16)) * (unsigned)DFF + ch0 + (unsigned)(4 * n))) = w; } } }
                        asm volatile("" ::: "memory"); __builtin_amdgcn_sched_barrier(0); }
                }
            }
        }
    }
};

namespace dsa {
constexpr int CAP = 512, TOPK = 256;
typedef unsigned long long u64;
typedef unsigned short u16;
__device__ __forceinline__ unsigned fkey(float f) { const unsigned u = __float_as_uint(f); return u ^ ((unsigned)((int)u >> 31) | 0x80000000u); }
__device__ __forceinline__ float keyf(unsigned k) { const unsigned u = (k & 0x80000000u) ? (k ^ 0x80000000u) : ~k; return __uint_as_float(u); }
__device__ __forceinline__ int mbcnt64(u64 m) { return (int)__builtin_amdgcn_mbcnt_hi((unsigned)(m >> 32), __builtin_amdgcn_mbcnt_lo((unsigned)m, 0u)); }

__device__ __forceinline__ unsigned wave_umax(unsigned v) {
#define DSA_UDPP(c_) (unsigned)__builtin_amdgcn_update_dpp(0, (int)v, c_, 0xf, 0xf, false)
    v = max(v, DSA_UDPP(0xB1)); v = max(v, DSA_UDPP(0x4E)); v = max(v, DSA_UDPP(0x141)); v = max(v, DSA_UDPP(0x140));
#undef DSA_UDPP
    { auto r = __builtin_amdgcn_permlane16_swap(v, v, false, false); v = max(r[0], r[1]); }
    { auto r = __builtin_amdgcn_permlane32_swap(v, v, false, false); v = max(r[0], r[1]); }
    return v;
}
__device__ __forceinline__ unsigned compact(LAS u64* buf, int n, int lane, unsigned lowk, bool exact, int& nout) {
    unsigned key[8], idx[8];
#pragma unroll
    for (int e = 0; e < 8; ++e) { const int i = lane + 64 * e; u64 v = 0ull; if (i < n) v = buf[i]; key[e] = (unsigned)(v >> 32); idx[e] = (unsigned)v; }
    unsigned mx = key[0];
#pragma unroll
    for (int e = 1; e < 8; ++e) mx = max(mx, key[e]);
    mx = (unsigned)__builtin_amdgcn_readfirstlane((int)wave_umax(mx));
    const unsigned diff = lowk ^ mx; unsigned P = lowk;
    if (diff) { const int hb = 31 - __builtin_clz(diff); P = hb == 31 ? 0u : (lowk >> (hb + 1)) << (hb + 1); const int lob = exact ? 0 : (hb > 15 ? hb - 15 : 0);
#pragma unroll 1
        for (int b = hb; b >= lob; --b) { const unsigned cand = P | (1u << b); int c = 0;
#pragma unroll
            for (int e = 0; e < 8; ++e) c += __builtin_popcountll(__ballot(key[e] >= cand));
            if (c >= TOPK) { P = cand; if (c == TOPK || (!exact && c <= TOPK + 48)) break; } } }
    int cgt = 0;
#pragma unroll
    for (int e = 0; e < 8; ++e) cgt += __builtin_popcountll(__ballot(key[e] > P));
    const int need = exact ? TOPK - cgt : CAP; int base = 0, eqbase = 0;
#pragma unroll
    for (int e = 0; e < 8; ++e) { const bool gt = key[e] > P, eq = key[e] == P && key[e] != 0u; const u64 beq = __ballot(eq); const bool sel = gt || (eq && (eqbase + mbcnt64(beq)) < need);
        const u64 bs = __ballot(sel); const int pos = base + mbcnt64(bs);
        if (sel) buf[pos] = ((u64)key[e] << 32) | idx[e];
        base += __builtin_popcountll(bs); eqbase += __builtin_popcountll(beq); }
    asm volatile("s_waitcnt lgkmcnt(0)" ::: "memory");
    nout = base;
    return P;
}

struct Ptrs { const bf16 *QI, *KI, *KA, *VA; const float* WI; const bf16* QA; bf16* O; unsigned short* SEL; };

__device__ __forceinline__ void attend(const Ptrs& P, int b, int t, const LAS u16* idl, LAS unsigned char* vbuf, int lane) {
    const int head = lane & 15, g = lane >> 4; const size_t m = (size_t)b * SEQ + t;
    bf16x8 Bq[4];
#pragma unroll
    for (int ks = 0; ks < 4; ++ks) Bq[ks] = *(const GAS bf16x8*)(P.QA + m * 2048 + head * 128 + 32 * ks + 8 * g);
    const float slope2 = __builtin_amdgcn_exp2f(-0.5f * (float)(head + 1)) * LOG2E;
    const bf16* vab = P.VA + (size_t)b * SEQ * 128;
    v4u st[8];
#define DSA_VLOAD(kk) do { _Pragma("unroll") for (int u_ = 0; u_ < 8; ++u_) { const int row_ = 4 * u_ + g; unsigned s_ = idl[32 * (kk) + row_]; s_ = s_ == 0xFFFFu ? 0u : s_; \
        const int cl_ = (lane & 15) ^ ((row_ & 7) << 1); st[u_] = *(const GAS v4u*)(vab + (size_t)s_ * 128 + cl_ * 8); } } while (0)
#define DSA_VWRITE(kk) do { _Pragma("unroll") for (int u_ = 0; u_ < 8; ++u_) *(LAS v4u*)(vbuf + ((kk) & 1) * 8192 + u_ * 1024 + lane * 16) = st[u_]; } while (0)
    DSA_VLOAD(0);
    const bf16* kab = P.KA + (size_t)b * SEQ * 128 + 8 * g;
    f32x4 L[16];
    bf16x8 Af[16][4];
#define DSA_KLD(i_) do { unsigned s_ = idl[16 * (i_) + head]; s_ = s_ == 0xFFFFu ? 0u : s_; const bf16* kp_ = kab + (size_t)s_ * 128; \
        _Pragma("unroll") for (int ks = 0; ks < 4; ++ks) Af[i_][ks] = *(const GAS bf16x8*)(kp_ + 32 * ks); } while (0)
    DSA_KLD(0); __builtin_amdgcn_sched_barrier(0); DSA_KLD(1); __builtin_amdgcn_sched_barrier(0); DSA_KLD(2); __builtin_amdgcn_sched_barrier(0);
#pragma unroll
    for (int i = 0; i < 16; ++i) {
        if (i + 3 < 16) { DSA_KLD(i + 3 < 16 ? i + 3 : 15); } __builtin_amdgcn_sched_barrier(0);
        f32x4 C = (f32x4){0.f, 0.f, 0.f, 0.f};
#pragma unroll
        for (int ks = 0; ks < 4; ++ks) C = __builtin_amdgcn_mfma_f32_16x16x32_bf16(Af[i][ks], Bq[ks], C, 0, 0, 0);
        const u32x2 idw = *(const LAS u32x2*)(idl + 16 * i + 4 * g);
        const unsigned i0 = idw.x & 0xffffu, i1 = idw.x >> 16, i2 = idw.y & 0xffffu, i3 = idw.y >> 16;
        L[i][0] = i0 == 0xFFFFu ? -__builtin_inff() : C[0] - slope2 * (float)(t - (int)i0);
        L[i][1] = i1 == 0xFFFFu ? -__builtin_inff() : C[1] - slope2 * (float)(t - (int)i1);
        L[i][2] = i2 == 0xFFFFu ? -__builtin_inff() : C[2] - slope2 * (float)(t - (int)i2);
        L[i][3] = i3 == 0xFFFFu ? -__builtin_inff() : C[3] - slope2 * (float)(t - (int)i3);
        __builtin_amdgcn_sched_barrier(0);
    }
#undef DSA_KLD
    float mx = -__builtin_inff();
#pragma unroll
    for (int i = 0; i < 16; ++i) mx = fmaxf(fmaxf(mx, fmaxf(L[i][0], L[i][1])), fmaxf(L[i][2], L[i][3]));
    mx = max_x32(max_x16(mx));
    float sum = 0.f;
#pragma unroll
    for (int i = 0; i < 16; ++i) {
#pragma unroll
        for (int r = 0; r < 4; ++r) { const float p = __builtin_amdgcn_exp2f(L[i][r] - mx); L[i][r] = p; sum += p; } }
    sum = sum_x32(sum_x16(sum));
    f32x4 O[8];
#pragma unroll
    for (int dt = 0; dt < 8; ++dt) O[dt] = (f32x4){0.f, 0.f, 0.f, 0.f};
    DSA_VWRITE(0); DSA_VLOAD(1);
    const int q4 = (lane >> 2) & 3, p4 = lane & 3, row1 = 4 * g + q4;
#pragma unroll
    for (int kk = 0; kk < 8; ++kk) {
        const v4u pw = pack8(L[2 * kk], L[2 * kk + 1]); const bf16x8 Pf = __builtin_bit_cast(bf16x8, pw);
        const LAS unsigned char* vb = vbuf + (kk & 1) * 8192 + row1 * 256 + 8 * p4;
        s16x4 lo[8], hi2[8];
#pragma unroll
        for (int dt = 0; dt < 8; ++dt) { const LAS unsigned char* a1 = vb + ((dt ^ (row1 & 7)) << 5);
            lo[dt] = __builtin_bit_cast(s16x4, __builtin_amdgcn_ds_read_tr16_b64_v4i16((LAS s16x4*)a1));
            hi2[dt] = __builtin_bit_cast(s16x4, __builtin_amdgcn_ds_read_tr16_b64_v4i16((LAS s16x4*)(a1 + 4096))); }
#pragma unroll
        for (int dt = 0; dt < 8; ++dt) {
            const bf16x8 Av = (bf16x8){lo[dt][0], lo[dt][1], lo[dt][2], lo[dt][3], hi2[dt][0], hi2[dt][1], hi2[dt][2], hi2[dt][3]};
            O[dt] = __builtin_amdgcn_mfma_f32_16x16x32_bf16(Av, Pf, O[dt], 0, 0, 0); }
        if (kk + 1 < 8) { DSA_VWRITE(kk + 1); if (kk + 2 < 8) DSA_VLOAD(kk + 2); }
    }
#undef DSA_VLOAD
#undef DSA_VWRITE
    const float inv = 1.0f / sum;
    unsigned char* op = (unsigned char*)P.O + m * 4096 + head * 128 + 4 * g;
#pragma unroll
    for (int dt = 0; dt < 8; ++dt) { const f32x4 o = O[dt] * inv; *(GAS unsigned*)(op + 16 * dt) = pkf8(o[0], o[1], o[2], o[3]); }
}

__device__ __forceinline__ void job(const Ptrs& P, int b, int t0, LAS unsigned char* wl, LAS u16* idl, int lane, volatile LAS unsigned* dbgp = nullptr) {
#if defined(DBG_SPIN)
    unsigned long long tcomp = 0ull, tatt = 0ull; const unsigned long long tj0 = __builtin_amdgcn_s_memrealtime();
#endif
    const int r32 = lane & 31, hi = lane >> 5;
    const int qsel = (r32 >> 2) & 1, headA = (r32 & 3) + 4 * (r32 >> 3);
    bf16x8 A[2][4]; float sg[2][16];
#pragma unroll
    for (int a = 0; a < 2; ++a) {
        const size_t mA = (size_t)b * SEQ + t0 + 2 * a + qsel; const float aw = P.WI[mA * 16 + headA];
#pragma unroll
        for (int d0 = 0; d0 < 4; ++d0) { f32x4 x0, x1; unpack8h(*(const GAS v4u*)(P.QI + mA * 1024 + headA * 64 + 16 * d0 + 8 * hi), x0, x1); A[a][d0] = __builtin_bit_cast(bf16x8, pack8h(x0 * aw, x1 * aw)); }
        const size_t mC = (size_t)b * SEQ + t0 + 2 * a + hi;
#pragma unroll
        for (int r4 = 0; r4 < 4; ++r4) { const f32x4 w4 = *(const GAS f32x4*)(P.WI + mC * 16 + 4 * r4);
#pragma unroll
            for (int j = 0; j < 4; ++j) sg[a][4 * r4 + j] = w4[j] < 0.f ? -__builtin_inff() : __builtin_inff(); }
    }
    LAS u64* cand = (LAS u64*)wl;
    int c0 = 0, c1 = 0, c2 = 0, c3 = 0; unsigned l0 = 0u, l1 = 0u, l2 = 0u, l3 = 0u; float tau0 = -__builtin_inff(), tau1 = -__builtin_inff();
    const int ntile = (t0 + 3) / 32 + 1;
    const bf16* kib = P.KI + (size_t)b * SEQ * 64 + 8 * lane;
    bf16x8 B0[4], B1[4], B2[4], B3[4];
#define DSA_LDK(B_, JN_) do { const int jn_ = (JN_) < ntile ? (JN_) : ntile - 1; _Pragma("unroll") for (int d0 = 0; d0 < 4; ++d0) B_[d0] = *(const GAS bf16x8*)(kib + (size_t)jn_ * 2048 + 512 * d0); } while (0)
    DSA_LDK(B0, 0); asm volatile("" ::: "memory"); DSA_LDK(B1, 1); asm volatile("" ::: "memory"); DSA_LDK(B2, 2); asm volatile("" ::: "memory"); DSA_LDK(B3, 3); asm volatile("" ::: "memory");
#if defined(DBG_SPIN)
#define DSA_TC0 const unsigned long long tc0 = __builtin_amdgcn_s_memrealtime();
#define DSA_TC1 tcomp += __builtin_amdgcn_s_memrealtime() - tc0;
#else
#define DSA_TC0
#define DSA_TC1
#endif
#define DSA_TILE(JT_, Bf) do { const int jt = (JT_); const int s = jt * 32 + r32; \
        f32x16 C0 = {}, C1 = {}; \
        _Pragma("unroll") for (int d0 = 0; d0 < 4; ++d0) C0 = __builtin_amdgcn_mfma_f32_32x32x16_f16(__builtin_bit_cast(f16x8, A[0][d0]), __builtin_bit_cast(f16x8, Bf[d0]), C0, 0, 0, 0); \
        _Pragma("unroll") for (int d0 = 0; d0 < 4; ++d0) C1 = __builtin_amdgcn_mfma_f32_32x32x16_f16(__builtin_bit_cast(f16x8, A[1][d0]), __builtin_bit_cast(f16x8, Bf[d0]), C1, 0, 0, 0); \
        DSA_LDK(Bf, jt + 4); \
        float scv[2]; \
        _Pragma("unroll") for (int a = 0; a < 2; ++a) { float s_ = 0.f;                                                    \
            _Pragma("unroll") for (int r = 0; r < 16; ++r) { s_ += __builtin_amdgcn_fmed3f(a == 0 ? C0[r] : C1[r], 0.f, sg[a][r]); if ((r & 3) == 3) asm volatile("" : "+v"(s_)); } \
            scv[a] = s_; } \
        _Pragma("unroll") for (int a = 0; a < 2; ++a) { \
            const float sc = scv[a]; \
            const int tq = t0 + 2 * a + hi; const float tau = a == 0 ? tau0 : tau1; \
            const bool pass = (s <= tq) && (sc > tau); \
            const u64 bal = __ballot(pass); \
            if (bal) { const unsigned blo = (unsigned)bal, bhi = (unsigned)(bal >> 32); \
                const int pre = hi ? (int)__builtin_amdgcn_mbcnt_hi(bhi, 0u) : (int)__builtin_amdgcn_mbcnt_lo(blo, 0u); \
                const int cq = a == 0 ? (hi ? c1 : c0) : (hi ? c3 : c2); \
                if (pass) cand[(2 * a + hi) * CAP + cq + pre] = ((u64)fkey(sc) << 32) | (unsigned)s; \
                if (a == 0) { c0 += __builtin_popcount(blo); c1 += __builtin_popcount(bhi); } else { c2 += __builtin_popcount(blo); c3 += __builtin_popcount(bhi); } } \
        } \
        const int lim = (jt == ntile - 1) ? TOPK : CAP - 32; \
        _Pragma("unroll 1") for (;;) { \
            const int q = c0 > lim ? 0 : c1 > lim ? 1 : c2 > lim ? 2 : c3 > lim ? 3 : -1; \
            if (q < 0) break; \
            int n = q == 0 ? c0 : q == 1 ? c1 : q == 2 ? c2 : c3; unsigned lowk = q == 0 ? l0 : q == 1 ? l1 : q == 2 ? l2 : l3; \
            asm volatile("s_waitcnt lgkmcnt(0)" ::: "memory"); \
            DSA_TC0 \
            bool ex = jt == ntile - 1; int nout; unsigned T; \
            _Pragma("unroll 1") for (;;) { T = compact(cand + q * CAP, n, lane, lowk, ex, nout); if (ex || nout <= lim) break; ex = true; n = nout; lowk = T; } \
            const float tf = keyf(T); \
            DSA_TC1 \
            if (q == 0) { c0 = nout; l0 = T; } else if (q == 1) { c1 = nout; l1 = T; } else if (q == 2) { c2 = nout; l2 = T; } else { c3 = nout; l3 = T; } \
            if ((q >> 1) == 0) { if (hi == (q & 1)) tau0 = tf; } else { if (hi == (q & 1)) tau1 = tf; } \
        } } while (0)
#pragma unroll 1
    for (int jt0 = 0; jt0 < ntile; jt0 += 4) { DSA_TILE(jt0, B0); DSA_TILE(jt0 + 1, B1); DSA_TILE(jt0 + 2, B2); DSA_TILE(jt0 + 3, B3); }
#undef DSA_TILE
#undef DSA_LDK
#undef DSA_TC0
#undef DSA_TC1
    asm volatile("s_waitcnt lgkmcnt(0)" ::: "memory");
#pragma unroll
    for (int q = 0; q < 4; ++q) { const int n = q == 0 ? c0 : q == 1 ? c1 : q == 2 ? c2 : c3;
#pragma unroll
        for (int e = 0; e < 4; ++e) { const int i = lane + 64 * e; unsigned v = 0xFFFFu; if (i < n) v = (unsigned)cand[q * CAP + i] & 0xFFFFu;
#if defined(DBG_FIXED_SEL)
            v = (t0 + q - i) >= 0 ? (unsigned)(t0 + q - i) : 0xFFFFu;
#endif
            idl[q * TOPK + i] = (u16)v; if (P.SEL) P.SEL[((size_t)b * SEQ + t0 + q) * TOPK + i] = (u16)v; } }
    asm volatile("s_waitcnt lgkmcnt(0)" ::: "memory");
#if defined(DBG_SPIN)
    const unsigned long long ta0 = __builtin_amdgcn_s_memrealtime();
#endif
#pragma unroll 1
    for (int q = 0; q < 4; ++q) attend(P, b, t0 + q, idl + q * TOPK, wl, lane);
#if defined(DBG_SPIN)
    tatt = __builtin_amdgcn_s_memrealtime() - ta0;
    if (dbgp && lane == 0) { dbgp[0] += (unsigned)tcomp; dbgp[1] += (unsigned)tatt; dbgp[2] += (unsigned)(__builtin_amdgcn_s_memrealtime() - tj0); }
#endif
}
}

namespace mla {
constexpr int NW = 8, QBLK = 32, KVBLK = 64, QB = 256;
constexpr int SHM_V = 16384, SHM_K = 8192, SHM_R = 4096;
constexpr int OFF_V = 0, OFF_K = 3 * SHM_V, OFF_R = OFF_K + 4 * SHM_K, OFF_WS = OFF_R + 4 * SHM_R, LDS_NEED = OFF_WS + NW * 64 * 4;
constexpr float THR = 8.f;
#define MLA_KSWZ(row, colB) ((row) * 256 + ((colB) ^ (((row) & 7) << 4)))
#define MLA_RSWZ(row, colB) ((row) * 128 + ((colB) ^ ((((row) >> 1) & 7) << 4)))
#define MLA_SBAR() __builtin_amdgcn_sched_barrier(0)
__device__ __forceinline__ int v_st(int k, int c) { const int kk = (k & ~0xC) | ((k & 4) << 1) | ((k & 8) >> 1); return ((kk >> 3) * 4 + (c >> 5)) * 512 + ((kk & 7) * 32 + (c & 31)) * 2; }
__device__ __forceinline__ int v_rd_base(int lane) { return ((lane & 3) << 3) | (((lane >> 2) & 3) << 6) | (((lane >> 4) & 1) << 5) | (((lane >> 5) & 1) << 8); }
constexpr int v_rd_off(int d0, int ks, int half) { return d0 * 512 + ks * 4096 + half * 2048; }
__device__ __forceinline__ int crow(int r, int hi) { return (r & 3) + 8 * (r >> 2) + 4 * hi; }
__device__ __forceinline__ unsigned cvtpk(float lo, float hi) { return pg8::cvt_pk_bf16(lo, hi); }

__device__ __forceinline__ void mask_tile(f32x16& p0, f32x16& p1, int dq) {
    const float NEG = -__builtin_inff();
#pragma unroll
    for (int r = 0; r < 16; ++r) { const int c = (r & 3) + 8 * (r >> 2);
        if (dq - c < 0) p0[r] = NEG;
        if (dq - c - 32 < 0) p1[r] = NEG; }
}
__device__ __forceinline__ void softmax_tile(f32x16& p0, f32x16& p1, float& m_reg, float& l_reg, float& alpha, bf16x8& pa0, bf16x8& pa1, bf16x8& pa2, bf16x8& pa3) {
    float pmax = p0[0];
#pragma unroll
    for (int r = 1; r < 16; ++r) pmax = fmaxf(pmax, p0[r]);
#pragma unroll
    for (int r = 0; r < 16; ++r) pmax = fmaxf(pmax, p1[r]);
    { auto rr = __builtin_amdgcn_permlane32_swap(__float_as_uint(pmax), __float_as_uint(pmax), false, false); pmax = fmaxf(__uint_as_float(rr[0]), __uint_as_float(rr[1])); }
    float mn;
    if (__builtin_expect(__all((pmax - m_reg) <= THR), 1)) { mn = m_reg; alpha = 1.f; }
    else { mn = fmaxf(m_reg, pmax); alpha = __builtin_amdgcn_exp2f(m_reg - mn); m_reg = mn; }
#pragma unroll
    for (int r = 0; r < 16; ++r) { p0[r] = __builtin_amdgcn_exp2f(p0[r] - mn); p1[r] = __builtin_amdgcn_exp2f(p1[r] - mn); }
    float ps = 0.f;
#pragma unroll
    for (int r = 0; r < 16; ++r) ps += p0[r];
#pragma unroll
    for (int r = 0; r < 16; ++r) ps += p1[r];
    { auto rr = __builtin_amdgcn_permlane32_swap(__float_as_uint(ps), __float_as_uint(ps), false, false); ps = __uint_as_float(rr[0]) + __uint_as_float(rr[1]); }
    l_reg = l_reg * alpha + ps;
#define MLA_PK4(P, B_, OUT) do { unsigned a0 = cvtpk(P[B_ + 0], P[B_ + 1]), a1 = cvtpk(P[B_ + 2], P[B_ + 3]); unsigned b0 = cvtpk(P[B_ + 4], P[B_ + 5]), b1 = cvtpk(P[B_ + 6], P[B_ + 7]); \
        auto r0 = __builtin_amdgcn_permlane32_swap(a0, b0, false, false); auto r1 = __builtin_amdgcn_permlane32_swap(a1, b1, false, false); \
        v4u w = {r0[0], r1[0], r0[1], r1[1]}; OUT = __builtin_bit_cast(bf16x8, w); } while (0)
    MLA_PK4(p0, 0, pa0); MLA_PK4(p0, 8, pa1); MLA_PK4(p1, 0, pa2); MLA_PK4(p1, 8, pa3);
#undef MLA_PK4
}
typedef int i32x8q __attribute__((ext_vector_type(8))); typedef int i32x4q __attribute__((ext_vector_type(4)));
template <int KB>
__device__ __forceinline__ void qkt(f32x16& p0, f32x16& p1, const LAS unsigned char* lds, int r32, int hi, const i32x8q* q8) {
    p0 = f32x16{}; p1 = f32x16{};
    const LAS unsigned char* kr = lds + OFF_K + KB * SHM_K + r32 * 128; const int kx = (r32 >> 1) & 7;
    const LAS unsigned char* rr = lds + OFF_R + KB * SHM_R + r32 * 64; const int rx = (r32 >> 2) & 3;
#define MLA_LD32(base_, c_, x_, step_) __builtin_shufflevector(*(const LAS i32x4q*)((base_) + ((((c_)) ^ (x_)) << 4) + (step_)), *(const LAS i32x4q*)((base_) + ((((c_) + 1) ^ (x_)) << 4) + (step_)), 0, 1, 2, 3, 4, 5, 6, 7)
#pragma unroll
    for (int j = 0; j < 2; ++j) { const int c = 4 * j + 2 * hi;
        const i32x8q a0 = MLA_LD32(kr, c, kx, 0), a1 = MLA_LD32(kr, c, kx, 32 * 128);
        p0 = __builtin_amdgcn_mfma_scale_f32_32x32x64_f8f6f4(a0, q8[j], p0, 0, 0, 0, 127, 0, 127 - 3);
        p1 = __builtin_amdgcn_mfma_scale_f32_32x32x64_f8f6f4(a1, q8[j], p1, 0, 0, 0, 127, 0, 127 - 3); }
    { const int c = 2 * hi;
        const i32x8q a0 = MLA_LD32(rr, c, rx, 0), a1 = MLA_LD32(rr, c, rx, 32 * 64);
        p0 = __builtin_amdgcn_mfma_scale_f32_32x32x64_f8f6f4(a0, q8[2], p0, 0, 0, 0, 127, 0, 127 - 3);
        p1 = __builtin_amdgcn_mfma_scale_f32_32x32x64_f8f6f4(a1, q8[2], p1, 0, 0, 0, 127, 0, 127 - 3); }
#undef MLA_LD32
}
template <int VB>
__device__ __forceinline__ void pv_tile(f32x16* o, int vb0, bf16x8 pa0, bf16x8 pa1, bf16x8 pa2, bf16x8 pa3) {
#define MLA_TRRD(dst, off) asm volatile("ds_read_b64_tr_b16 %0, %1 offset:%2" : "=&v"(dst) : "v"(vb0), "i"(off) : "memory")
#define MLA_PV_D0(d0) do { s16x4 l0, l1, l2, l3, h0, h1, h2, h3; constexpr int b_ = OFF_V + VB * SHM_V + v_rd_off(d0, 0, 0); \
        MLA_TRRD(l0, b_); MLA_TRRD(h0, b_ + 2048); MLA_TRRD(l1, b_ + 4096); MLA_TRRD(h1, b_ + 6144); MLA_TRRD(l2, b_ + 8192); MLA_TRRD(h2, b_ + 10240); MLA_TRRD(l3, b_ + 12288); MLA_TRRD(h3, b_ + 14336); \
        asm volatile("s_waitcnt lgkmcnt(0)" ::: "memory"); MLA_SBAR(); \
        o[d0] = __builtin_amdgcn_mfma_f32_32x32x16_bf16(pa0, (bf16x8){l0[0], l0[1], l0[2], l0[3], h0[0], h0[1], h0[2], h0[3]}, o[d0], 0, 0, 0); \
        o[d0] = __builtin_amdgcn_mfma_f32_32x32x16_bf16(pa1, (bf16x8){l1[0], l1[1], l1[2], l1[3], h1[0], h1[1], h1[2], h1[3]}, o[d0], 0, 0, 0); \
        o[d0] = __builtin_amdgcn_mfma_f32_32x32x16_bf16(pa2, (bf16x8){l2[0], l2[1], l2[2], l2[3], h2[0], h2[1], h2[2], h2[3]}, o[d0], 0, 0, 0); \
        o[d0] = __builtin_amdgcn_mfma_f32_32x32x16_bf16(pa3, (bf16x8){l3[0], l3[1], l3[2], l3[3], h3[0], h3[1], h3[2], h3[3]}, o[d0], 0, 0, 0); } while (0)
    MLA_PV_D0(0); MLA_PV_D0(1); MLA_PV_D0(2); MLA_PV_D0(3);
#undef MLA_PV_D0
#undef MLA_TRRD
}
struct Tensors { const bf16* QN; const bf16* QR; const bf16* KN; const bf16* KR; const bf16* VB; bf16* O; };

__device__ __forceinline__ s16x4 vtr(const LAS unsigned char* p) { return __builtin_bit_cast(s16x4, __builtin_amdgcn_ds_read_tr16_b64_v4i16((LAS s16x4*)p)); }
template <int N> __device__ __forceinline__ i32x8q kfrag(const LAS unsigned char* kr, const LAS unsigned char* rr, int hi, int kx, int rx) {
    if (N < 4) { const int c = 4 * (N >> 1) + 2 * hi; const LAS unsigned char* b_ = kr + (N & 1) * 32 * 128;
        return __builtin_shufflevector(*(const LAS i32x4q*)(b_ + ((c ^ kx) << 4)), *(const LAS i32x4q*)(b_ + (((c + 1) ^ kx) << 4)), 0, 1, 2, 3, 4, 5, 6, 7); }
    const int c = 2 * hi; const LAS unsigned char* b_ = rr + (N & 1) * 32 * 64;
    return __builtin_shufflevector(*(const LAS i32x4q*)(b_ + ((c ^ rx) << 4)), *(const LAS i32x4q*)(b_ + (((c + 1) ^ rx) << 4)), 0, 1, 2, 3, 4, 5, 6, 7);
}
__device__ __forceinline__ float rowmax(const f32x16& p0, const f32x16& p1) {
    float pmax = p0[0];
#pragma unroll
    for (int r = 1; r < 16; ++r) pmax = fmaxf(pmax, p0[r]);
#pragma unroll
    for (int r = 0; r < 16; ++r) pmax = fmaxf(pmax, p1[r]);
    auto rr = __builtin_amdgcn_permlane32_swap(__float_as_uint(pmax), __float_as_uint(pmax), false, false); return fmaxf(__uint_as_float(rr[0]), __uint_as_float(rr[1]));
}

__device__ __forceinline__ void unit(const Tensors& T, int b, int h, int qb, LAS unsigned char* lds) {
    const int tid = threadIdx.x, wid = __builtin_amdgcn_readfirstlane(tid >> 6), lane = tid & 63, r32 = lane & 31, hi = lane >> 5;
    const size_t rowq = (size_t)b * SEQ + qb * QB + wid * QBLK + r32;
    i32x8q qr[3];
    { const GAS unsigned char* qn8 = (const GAS unsigned char*)T.QN + rowq * 2048 + h * 128 + 32 * hi; const GAS unsigned char* qr8 = (const GAS unsigned char*)T.QR + rowq * 1024 + h * 64 + 32 * hi;
#pragma unroll
      for (int j = 0; j < 2; ++j) qr[j] = __builtin_shufflevector(*(const GAS i32x4q*)(qn8 + 64 * j), *(const GAS i32x4q*)(qn8 + 64 * j + 16), 0, 1, 2, 3, 4, 5, 6, 7);
      qr[2] = __builtin_shufflevector(*(const GAS i32x4q*)qr8, *(const GAS i32x4q*)(qr8 + 16), 0, 1, 2, 3, 4, 5, 6, 7); }
    const int NT = 4 * (qb + 1);
    const int qlo = qb * QB + wid * QBLK, qm = qlo + r32 - 4 * hi;
    LAS float* ws = (LAS float*)(lds + OFF_WS) + wid * 64; LAS float* li_l = ws; LAS float* al_l = ws + 32;
    float mhat = 0.f, l_reg = 0.f; f32x16 o[4] = {}; bool resc = false;
    const LAS unsigned char* vp0 = lds + OFF_V + v_rd_base(lane);
    const LAS unsigned char* kr0 = lds + OFF_K + r32 * 128; const LAS unsigned char* rr0 = lds + OFF_R + r32 * 64; const int kx = (r32 >> 1) & 7, rx = (r32 >> 2) & 3;
    int voff[2], koff, roff;
#pragma unroll
    for (int i = 0; i < 2; ++i) { const int G_ = (wid + 8 * i) * 64 + lane;
        { const int st = G_ >> 5, w_ = G_ & 31, kk = (st >> 2) * 8 + (w_ >> 2), c = (st & 3) * 32 + (w_ & 3) * 8, k = (kk & ~0xC) | ((kk & 4) << 1) | ((kk & 8) >> 1); voff[i] = (k * 2048 + c) * 2; } }
    { const int G_ = wid * 64 + lane, row = G_ >> 3, slot = G_ & 7; koff = row * 2048 + 16 * (slot ^ ((row >> 1) & 7)); }
    { const int G_ = (wid & 3) * 64 + lane, row = G_ >> 2, slot = G_ & 3; roff = row * 64 + 16 * (slot ^ ((row >> 2) & 3)); }
    const unsigned char* Kh = (const unsigned char*)T.KN + (size_t)b * SEQ * 2048 + h * 128; const bf16* Vh = T.VB + (size_t)b * SEQ * 2048 + h * 128; const unsigned char* Rh = (const unsigned char*)T.KR + (size_t)b * SEQ * 64;
#define MLA_GLDS(base_, off_, dst_) do { unsigned sv_; const void* g_ = (const void*)(base_); const unsigned o_ = (unsigned)(off_); const unsigned d_ = (unsigned)__builtin_amdgcn_readfirstlane((int)(unsigned)(uintptr_t)(dst_)); \
        asm volatile("s_mov_b32 %0, m0\n\ts_mov_b32 m0, %3\n\ts_nop 0\n\tglobal_load_lds_dwordx4 %1, %2\n\ts_mov_b32 m0, %0" : "=&s"(sv_) : "v"(o_), "s"(g_), "s"(d_) : "memory"); } while (0)
#define MLA_DMA_V(k0, bf) do { _Pragma("unroll") for (int i_ = 0; i_ < 2; ++i_) MLA_GLDS((const unsigned char*)Vh + (size_t)(k0) * 4096, voff[i_], lds + OFF_V + (bf) * SHM_V + (wid + 8 * i_) * 1024); } while (0)
#define MLA_DMA_K(k0, bf) do { MLA_GLDS(Kh + (size_t)(k0) * 2048, koff, lds + OFF_K + (bf) * SHM_K + wid * 1024); \
        if (wid < 4) MLA_GLDS(Rh + (size_t)(k0) * 64, roff, lds + OFF_R + (bf) * SHM_R + wid * 1024); } while (0)
#define MLA_WAITBAR() do { asm volatile("s_waitcnt vmcnt(0)" ::: "memory"); __syncthreads(); } while (0)
#define MLA_WAITBAR_C() do { if (wid < 4) asm volatile("s_waitcnt vmcnt(4)" ::: "memory"); else asm volatile("s_waitcnt vmcnt(3)" ::: "memory"); __syncthreads(); } while (0)
#define MLA_PIN(x) asm volatile("" : "+v"(x))
#define MLA_RESC() do { if (resc) { _Pragma("unroll") for (int d_ = 0; d_ < 4; ++d_) _Pragma("unroll") for (int r = 0; r < 16; ++r) o[d_][r] *= al_l[crow(r, hi)]; } } while (0)
#define MLA_QMF(C_, a_, j_, I_) C_ = __builtin_amdgcn_mfma_scale_f32_32x32x64_f8f6f4(a_, qr[j_], I_, 0, 0, 0, 127, 0, 127 - 3)
#define MLA_KF(N_) kfrag<N_>(kr_, rr_, hi, kx, rx)
#define MLA_PK4(P, B_, OUT) do { unsigned a0 = cvtpk(P[B_ + 0], P[B_ + 1]), a1 = cvtpk(P[B_ + 2], P[B_ + 3]); unsigned b0 = cvtpk(P[B_ + 4], P[B_ + 5]), b1 = cvtpk(P[B_ + 6], P[B_ + 7]); \
        auto r0 = __builtin_amdgcn_permlane32_swap(a0, b0, false, false); auto r1 = __builtin_amdgcn_permlane32_swap(a1, b1, false, false); \
        OUT = (v4u){r0[0], r1[0], r0[1], r1[1]}; } while (0)
#define MLA_S2(P, i) do { sa0 += P[i]; sa1 += P[(i) + 1]; } while (0)
#define MLA_EX2S(X, i) do { X[i] = __builtin_amdgcn_exp2f(X[i] - mhat); X[(i) + 1] = __builtin_amdgcn_exp2f(X[(i) + 1] - mhat); } while (0)
#define MLA_EX2(X, i) do { X[i] = __builtin_amdgcn_exp2f(X[i]); X[(i) + 1] = __builtin_amdgcn_exp2f(X[(i) + 1]); } while (0)
#define MLA_VRD(n) do { vlo[n] = vtr(vp_ + (((n) & 3) * 512 + ((n) >> 2) * 4096)); vhi[n] = vtr(vp_ + (((n) & 3) * 512 + ((n) >> 2) * 4096 + 2048)); } while (0)
#define MLA_VFR(n) (bf16x8){vlo[n][0], vlo[n][1], vlo[n][2], vlo[n][3], vhi[n][0], vhi[n][1], vhi[n][2], vhi[n][3]}
#define MLA_PAF(k) __builtin_bit_cast(bf16x8, pw##k)
#define MLA_GAPB(n, k, X, i) do { o[(n) & 3] = __builtin_amdgcn_mfma_f32_32x32x16_bf16(MLA_PAF(k), MLA_VFR(n), o[(n) & 3], 0, 0, 0); if ((n) + 2 < 16) MLA_VRD((n) + 2 < 16 ? (n) + 2 : 15); \
        MLA_EX2(X, i); MLA_PIN(X); MLA_SBAR(); } while (0)
    f32x16 pA0, pA1, pB0, pB1; v4u pw0, pw1, pw2, pw3; s16x4 vlo[16], vhi[16]; i32x8q kf0, kf1;
    int ks_cur = 0, ks_nxt = 1, ks_n2 = 2, ks_n3 = 3, vs_rd = 2, vs_mid = 0, vs_wr = 1;
#define MLA_ROT() do { const int o_ = ks_cur; ks_cur = ks_nxt; ks_nxt = ks_n2; ks_n2 = ks_n3; ks_n3 = o_; const int p_ = vs_rd; vs_rd = vs_mid; vs_mid = vs_wr; vs_wr = p_; } while (0)
    MLA_DMA_K(0, 0); MLA_DMA_K(KVBLK, 1); MLA_DMA_K(2 * KVBLK, 2); MLA_DMA_V(0, 0); MLA_WAITBAR();
    MLA_DMA_K(3 * KVBLK, 3); MLA_DMA_V(KVBLK, 1);
    qkt<0>(pA0, pA1, lds, r32, hi, qr);
    if (NT == 4) mask_tile(pA0, pA1, qm);
    mhat = rowmax(pA0, pA1);
#pragma unroll
    for (int r = 0; r < 16; r += 2) { MLA_EX2S(pA0, r); MLA_EX2S(pA1, r); }
#define MLA_SEED(X) do { const float nm_ = -mhat; _Pragma("unroll") for (int r_ = 0; r_ < 16; ++r_) X[r_] = nm_; MLA_PIN(X); } while (0)
    MLA_SEED(pB0); MLA_SEED(pB1);
    MLA_ROT();
    { const LAS unsigned char* kr_ = kr0 + ks_cur * SHM_K; const LAS unsigned char* rr_ = rr0 + ks_cur * SHM_R; kf0 = MLA_KF(0); kf1 = MLA_KF(1); }
    MLA_WAITBAR_C();
#define MLA_MX(X, i) fmaxf(fmaxf(X[i], X[(i) + 1]), fmaxf(X[(i) + 2], X[(i) + 3]))
#define MLA_PV(n, k) o[(n) & 3] = __builtin_amdgcn_mfma_f32_32x32x16_bf16(MLA_PAF(k), MLA_VFR(n), o[(n) & 3], 0, 0, 0)
#define MLA_VN(n) do { if ((n) + 4 < 16) MLA_VRD((n) + 4 < 16 ? (n) + 4 : 15); } while (0)
#define MLA_STEP(C0, C1, P0, P1, t, MASK, GK, GN) do { MLA_SBAR(); \
    const LAS unsigned char* kr_ = kr0 + ks_cur * SHM_K; const LAS unsigned char* rr_ = rr0 + ks_cur * SHM_R; const LAS unsigned char* vp_ = vp0 + vs_rd * SHM_V; \
    i32x8q kf2, kf3, kf4, kf5; \
    float sa0 = P0[0], sa1 = P0[1]; \
    MLA_QMF(C0, kf0, 0, C0); kf2 = MLA_KF(2); MLA_S2(P0, 2); MLA_S2(P0, 4); MLA_S2(P0, 6); MLA_PK4(P0, 0, pw0); MLA_PIN(pw0); MLA_PIN(sa0); MLA_PIN(sa1); MLA_SBAR(); \
    MLA_QMF(C1, kf1, 0, C1); kf3 = MLA_KF(3); MLA_S2(P0, 8); MLA_S2(P0, 10); MLA_S2(P0, 12); MLA_S2(P0, 14); MLA_PK4(P0, 8, pw1); MLA_PIN(pw1); MLA_PIN(sa0); MLA_PIN(sa1); MLA_SBAR(); \
    if (GK) MLA_DMA_K(((t) + 3) * KVBLK, ks_n3); if (GN) MLA_DMA_V(((t) + 1) * KVBLK, vs_wr); MLA_SBAR();                          \
    MLA_QMF(C0, kf2, 1, C0); kf4 = MLA_KF(4); MLA_S2(P1, 0); MLA_S2(P1, 2); MLA_S2(P1, 4); MLA_S2(P1, 6); MLA_PK4(P1, 0, pw2); MLA_PIN(pw2); MLA_PIN(sa0); MLA_PIN(sa1); MLA_SBAR(); \
    MLA_QMF(C1, kf3, 1, C1); kf5 = MLA_KF(5); MLA_VRD(0); MLA_S2(P1, 8); MLA_S2(P1, 10); MLA_S2(P1, 12); MLA_S2(P1, 14); MLA_PK4(P1, 8, pw3); MLA_PIN(pw3); MLA_PIN(sa0); MLA_PIN(sa1); MLA_SBAR(); \
    MLA_QMF(C0, kf4, 2, C0); MLA_VRD(1); MLA_VRD(2); MLA_SBAR(); \
    MLA_QMF(C1, kf5, 2, C1); MLA_VRD(3); l_reg += sa0 + sa1; MLA_SBAR(); \
      \
    MLA_PV(0, 0); MLA_VN(0); MLA_SBAR(); \
    MLA_PV(1, 0); MLA_VN(1); if (MASK) mask_tile(C0, C1, qm - (t) * KVBLK); \
    float mx0 = C0[0]; _Pragma("unroll") for (int r_ = 1; r_ < 8; ++r_) mx0 = fmaxf(mx0, C0[r_]); MLA_SBAR(); \
    MLA_PV(2, 0); MLA_VN(2); _Pragma("unroll") for (int r_ = 8; r_ < 16; ++r_) mx0 = fmaxf(mx0, C0[r_]); MLA_SBAR(); \
    MLA_PV(3, 0); MLA_VN(3); _Pragma("unroll") for (int r_ = 0; r_ < 8; ++r_) mx0 = fmaxf(mx0, C1[r_]); MLA_SBAR(); \
    MLA_PV(4, 1); MLA_VN(4); _Pragma("unroll") for (int r_ = 8; r_ < 16; ++r_) mx0 = fmaxf(mx0, C1[r_]); \
    { auto rr_x = __builtin_amdgcn_permlane32_swap(__float_as_uint(mx0), __float_as_uint(mx0), false, false); mx0 = fmaxf(__uint_as_float(rr_x[0]), __uint_as_float(rr_x[1])); } \
    { resc = false;                                                                                                      \
      if (__builtin_expect(__any(mx0 > THR), 0)) { const float dl = fmaxf(mx0, 0.f); mhat += dl;                          \
          const float f = __builtin_amdgcn_exp2f(-dl); l_reg *= f; if (hi == 0) al_l[r32] = f; resc = true;                \
          _Pragma("unroll") for (int r_ = 0; r_ < 16; ++r_) { C0[r_] -= dl; C1[r_] -= dl; } } }                          \
    MLA_SBAR(); \
    MLA_PV(5, 1);  MLA_VN(5);  MLA_EX2(C0, 0);  MLA_EX2(C0, 2);  MLA_PIN(C0); MLA_SBAR(); \
    MLA_PV(6, 1);  MLA_VN(6);  MLA_EX2(C0, 4);  MLA_EX2(C0, 6);  MLA_PIN(C0); MLA_SBAR(); \
    MLA_PV(7, 1);  MLA_VN(7);  MLA_EX2(C0, 8);  MLA_EX2(C0, 10); MLA_PIN(C0); MLA_SBAR(); \
    MLA_PV(8, 2);  MLA_VN(8);  MLA_EX2(C0, 12); MLA_EX2(C0, 14); MLA_PIN(C0); MLA_SBAR(); \
    MLA_PV(9, 2);  MLA_VN(9);  MLA_EX2(C1, 0);  MLA_EX2(C1, 2);  MLA_PIN(C1); MLA_SBAR(); \
    MLA_PV(10, 2); MLA_VN(10); MLA_EX2(C1, 4);  MLA_PIN(C1); MLA_SBAR(); \
    MLA_PV(11, 2); MLA_VN(11); MLA_EX2(C1, 6);  MLA_PIN(C1); MLA_SBAR(); \
    MLA_ROT(); \
    MLA_PV(12, 3); MLA_EX2(C1, 8);  MLA_PIN(C1); if (GN) { const LAS unsigned char* kr_ = kr0 + ks_cur * SHM_K; const LAS unsigned char* rr_ = rr0 + ks_cur * SHM_R; kf0 = MLA_KF(0); } MLA_SBAR(); \
    MLA_PV(13, 3); MLA_EX2(C1, 10); MLA_PIN(C1); if (GN) { const LAS unsigned char* kr_ = kr0 + ks_cur * SHM_K; const LAS unsigned char* rr_ = rr0 + ks_cur * SHM_R; kf1 = MLA_KF(1); } MLA_SBAR(); \
    MLA_PV(14, 3); MLA_EX2(C1, 12); MLA_PIN(C1); MLA_SEED(P0); MLA_SBAR(); \
    MLA_PV(15, 3); MLA_EX2(C1, 14); MLA_PIN(C1); MLA_SEED(P1); MLA_SBAR();                            \
    } while (0)
    int t = 1;
#pragma unroll 1
    for (; t + 5 < NT; t += 2) {
        MLA_STEP(pB0, pB1, pA0, pA1, t, false, true, true);     MLA_WAITBAR_C(); MLA_RESC();
        MLA_STEP(pA0, pA1, pB0, pB1, t + 1, false, true, true); MLA_WAITBAR_C(); MLA_RESC(); }
#pragma unroll 1
    for (; t + 1 < NT; t += 2) {
        MLA_STEP(pB0, pB1, pA0, pA1, t, true, (t + 3 < NT), true);     MLA_WAITBAR(); MLA_RESC();
        MLA_STEP(pA0, pA1, pB0, pB1, t + 1, true, (t + 4 < NT), true); MLA_WAITBAR(); MLA_RESC(); }
    MLA_STEP(pB0, pB1, pA0, pA1, NT - 1, true, false, false); MLA_WAITBAR(); MLA_RESC();
    { float sa0 = pB0[0], sa1 = pB0[1];
#pragma unroll
      for (int r = 2; r < 16; r += 2) MLA_S2(pB0, r);
#pragma unroll
      for (int r = 0; r < 16; r += 2) MLA_S2(pB1, r);
      l_reg += sa0 + sa1;
      MLA_PK4(pB0, 0, pw0); MLA_PK4(pB0, 8, pw1); MLA_PK4(pB1, 0, pw2); MLA_PK4(pB1, 8, pw3);
      const LAS unsigned char* vp_ = vp0 + vs_rd * SHM_V;
#pragma unroll
      for (int k = 0; k < 4; ++k) {
#pragma unroll
          for (int d0 = 0; d0 < 4; ++d0) { const s16x4 lo = vtr(vp_ + (d0 * 512 + k * 4096)), hh = vtr(vp_ + (d0 * 512 + k * 4096 + 2048));
              const bf16x8 vf = (bf16x8){lo[0], lo[1], lo[2], lo[3], hh[0], hh[1], hh[2], hh[3]};
              o[d0] = __builtin_amdgcn_mfma_f32_32x32x16_bf16(k == 0 ? MLA_PAF(0) : k == 1 ? MLA_PAF(1) : k == 2 ? MLA_PAF(2) : MLA_PAF(3), vf, o[d0], 0, 0, 0); } } }
    { auto rr = __builtin_amdgcn_permlane32_swap(__float_as_uint(l_reg), __float_as_uint(l_reg), false, false); l_reg = __uint_as_float(rr[0]) + __uint_as_float(rr[1]); }
    if (hi == 0) li_l[r32] = l_reg; asm volatile("s_waitcnt lgkmcnt(0)" ::: "memory");
    unsigned char* Ow = (unsigned char*)T.O + ((size_t)b * SEQ + qb * QB + wid * QBLK) * 2048 + h * 128;
    int hi_e = hi; asm volatile("" : "+v"(hi_e));
#pragma unroll
    for (int r = 0; r < 16; ++r) { const int orow = crow(r, hi_e); const float rl = __builtin_amdgcn_rcpf(li_l[orow]);
#pragma unroll
        for (int d0 = 0; d0 < 4; ++d0) { const float v = o[d0][r] * rl; const float v1 = dppf<0xB1>(v), v2 = dppf<0x4E>(v), v3 = dppf<0x1B>(v);
            if ((r32 & 3) == 0) *(GAS unsigned*)(Ow + (size_t)orow * 2048 + d0 * 32 + r32) = pkf8(v, v1, v2, v3); } }
    __syncthreads();
#undef MLA_DMA_V
#undef MLA_GLDS
#undef MLA_DMA_K
#undef MLA_WAITBAR
#undef MLA_WAITBAR_C
#undef MLA_PIN
#undef MLA_RESC
#undef MLA_QMF
#undef MLA_KF
#undef MLA_PK4
#undef MLA_S2
#undef MLA_EX2
#undef MLA_EX2S
#undef MLA_SEED
#undef MLA_VRD
#undef MLA_VFR
#undef MLA_PAF
#undef MLA_GAPB
#undef MLA_STEP
#undef MLA_ROT
#undef MLA_MX
#undef MLA_PV
#undef MLA_VN
}
}

#if defined(DBG_CHECK)
#ifndef DBG_WORD
#define DBG_WORD 0
#endif
namespace chk {
__device__ __forceinline__ float bsum(float v, LAS float* red, int tid) { red[tid] = v; __syncthreads(); for (int o = 256; o > 0; o >>= 1) { if (tid < o) red[tid] += red[tid + o]; __syncthreads(); } const float r = red[0]; __syncthreads(); return r; }
__device__ __forceinline__ float bmax(float v, LAS float* red, int tid) { red[tid] = v; __syncthreads(); for (int o = 256; o > 0; o >>= 1) { if (tid < o) red[tid] = fmaxf(red[tid], red[tid + o]); __syncthreads(); } const float r = red[0]; __syncthreads(); return r; }
__device__ __forceinline__ float bf(const bf16* p) { return __uint_as_float((unsigned)(*p) << 16); }
__device__ __forceinline__ float hf(const bf16* p) { return (float)__builtin_bit_cast(_Float16, *p); }
__device__ __forceinline__ int sample_t(int smp) { const int k = smp >> 5; const int edge[16] = {0, 1, 31, 32, 63, 64, 255, 256, 257, 511, 512, 4095, 4096, 8190, 8191, 300}; return k < 1 ? edge[smp & 15] : (int)(((unsigned)smp * 2654435761u) >> 13) & 8191; }
__device__ __forceinline__ void amax(float* w, float v) { if (v == v) atomicMax((int*)w, __float_as_int(v)); else atomicMax((int*)w, 0x7f000000); }
__device__ __forceinline__ void mla(const bf16* QN, const bf16* QR, const bf16* KN, const bf16* KR, const bf16* VB, const bf16* O, int smp, LAS float* lg, LAS float* red, LAS float* q, float* dbg, int tid) {
    const int b = smp & 1, h = (smp >> 1) & 15, t = sample_t(smp); const size_t row = (size_t)b * SEQ + t;
    if (tid < 128) q[tid] = bf(QN + row * 2048 + h * 128 + tid); else if (tid < 192) q[tid] = bf(QR + row * 1024 + h * 64 + (tid - 128));
    __syncthreads();
    float mx = -1e30f;
    for (int s = tid; s <= t; s += 512) { const bf16* kn = KN + ((size_t)b * SEQ + s) * 2048 + h * 128; const bf16* kr = KR + ((size_t)b * SEQ + s) * 64; float d = 0.f;
        for (int i = 0; i < 128; ++i) d += q[i] * bf(kn + i); for (int i = 0; i < 64; ++i) d += q[128 + i] * bf(kr + i); lg[s] = d; mx = fmaxf(mx, d); }
    mx = bmax(mx, red, tid); float sm = 0.f;
    for (int s = tid; s <= t; s += 512) { const float p = exp2f(lg[s] - mx); lg[s] = p; sm += p; }
    sm = bsum(sm, red, tid);
    float o = 0.f;
    if (tid < 128) { for (int s = 0; s <= t; ++s) o += lg[s] * bf(VB + ((size_t)b * SEQ + s) * 2048 + h * 128 + tid); o /= sm; }
    const float rms = sqrtf(bsum(tid < 128 ? o * o : 0.f, red, tid) / 128.f) + 1e-20f;
    const float e = tid < 128 ? fabsf(o - bf(O + row * 2048 + h * 128 + tid)) / rms : 0.f;
    const float em = bmax(e, red, tid);
    if (tid == 0) amax(dbg + 0, em);
    __syncthreads();
}
template <bool TRUE_SC> __device__ __forceinline__ void dsa(const float* x, const float* w_in, const bf16* QI, const bf16* KI, const float* WI, const bf16* QA, const bf16* KA, const bf16* VA, const bf16* O, const unsigned short* SEL, int smp, LAS float* sc, LAS float* red, LAS float* aux, float* dbg, int tid) {
    const int b = smp & 1, t = sample_t(smp >> 1 << 1 | 0) ; const size_t row = (size_t)b * SEQ + t;
    LAS float* qi = aux;
    LAS unsigned* sel = (LAS unsigned*)(aux + 1024);
    LAS float* pr = aux + 2048;
    LAS unsigned* cnt = (LAS unsigned*)(aux + 2048 + 4096);
    LAS float* wt = aux + 2048 + 4096 + 64;
    if (TRUE_SC) {
        for (int i = tid; i < 1024 + 16; i += 512) { const int c = i < 1024 ? U_QI + i : U_WI + (i - 1024); float d = 0.f; for (int k = 0; k < 2048; ++k) d += x[row * 2048 + k] * w_in[(size_t)k * DIN + c]; if (i < 1024) qi[i] = d; else wt[i - 1024] = d; }
        __syncthreads();
        for (int s = tid; s <= t; s += 512) { float kk[64];
#pragma unroll
            for (int c = 0; c < 64; ++c) kk[c] = 0.f;
            const float* xs = x + ((size_t)b * SEQ + s) * 2048;
            for (int k = 0; k < 2048; ++k) { const float xv = xs[k]; const float* wr = w_in + (size_t)k * DIN + U_KI;
#pragma unroll
                for (int c = 0; c < 64; ++c) kk[c] += xv * wr[c]; }
            float tot = 0.f;
#pragma unroll
            for (int hh = 0; hh < 16; ++hh) { float d = 0.f;
#pragma unroll
                for (int i = 0; i < 64; ++i) d += qi[hh * 64 + i] * kk[i];
                tot += wt[hh] * fmaxf(d, 0.f); }
            sc[s] = tot; }
    } else {
    for (int i = tid; i < 1024; i += 512) qi[i] = hf(QI + row * 1024 + i);
    __syncthreads();
    for (int s = tid; s <= t; s += 512) { const bf16* k = KI + ((size_t)b * SEQ + s) * 64; float tot = 0.f;
        for (int hh = 0; hh < 16; ++hh) { float d = 0.f; for (int i = 0; i < 64; ++i) d += qi[hh * 64 + i] * hf(k + i); tot += WI[row * 16 + hh] * fmaxf(d, 0.f); }
        sc[s] = tot; }
    }
    __syncthreads();
    const int n = t + 1, want = n < 256 ? n : 256;
    unsigned T = 0u;
    for (int bit = 31; bit >= 0; --bit) { const unsigned cand = T | (1u << bit); if (tid == 0) cnt[0] = 0u; __syncthreads(); unsigned c = 0u;
        for (int s = tid; s <= t; s += 512) c += (dsa::fkey(sc[s]) >= cand) ? 1u : 0u;
        if (c) atomicAdd((unsigned*)cnt, c); __syncthreads(); if (cnt[0] >= (unsigned)want) T = cand; __syncthreads(); }
    if (tid == 0) { cnt[0] = 0u; cnt[1] = 0u; } __syncthreads();
    { unsigned c = 0u; for (int s = tid; s <= t; s += 512) c += (dsa::fkey(sc[s]) > T) ? 1u : 0u; if (c) atomicAdd((unsigned*)cnt + 1, c); }
    __syncthreads();
    const unsigned cgt = cnt[1]; __syncthreads(); if (tid == 0) cnt[1] = 0u;
    for (int s = tid; s <= t; s += 512) { const unsigned ky = dsa::fkey(sc[s]); bool take = ky > T;
        if (ky == T) { unsigned rk = 0u; for (int s2 = 0; s2 < s; ++s2) rk += (dsa::fkey(sc[s2]) == T) ? 1u : 0u; take = cgt + rk < (unsigned)want; }
        if (take) { const unsigned p = atomicAdd((unsigned*)cnt, 1u); if (p < 256u) sel[p] = (unsigned)s; } }
    __syncthreads();
    const int nref = (int)(cnt[0] < 256u ? cnt[0] : 256u);
    if (tid < 256) sel[256 + tid] = SEL[row * 256 + tid];
    __syncthreads();
    { float miss = 0.f; if (tid < 256) { const unsigned s = sel[256 + tid]; if (s != 0xFFFFu) { bool found = false; for (int j = 0; j < nref; ++j) found |= (sel[j] == s); miss = found ? 0.f : 1.f; } }
      const float tm = bsum(miss, red, tid); if (tid == 0) { amax(dbg + 1, tm / (float)want); atomicAdd(dbg + 13, tm); } }
    for (int pass = 0; pass < 2; ++pass) {
        const int ns = pass == 0 ? nref : 256; LAS unsigned* sl = sel + pass * 256;
        for (int e = tid; e < 16 * 256; e += 512) { const int hh = e >> 8, j = e & 255; float v = -1e30f;
            if (j < ns && sl[j] != 0xFFFFu) { const unsigned s = sl[j]; const bf16* k = KA + ((size_t)b * SEQ + s) * 128; float d = 0.f; for (int i = 0; i < 128; ++i) d += bf(QA + row * 2048 + hh * 128 + i) * bf(k + i);
                v = d - exp2f(-0.5f * (float)(hh + 1)) * LOG2E * (float)(t - (int)s); }
            pr[e] = v; }
        __syncthreads();
        if (tid < 16) { float mx = -1e30f; for (int j = 0; j < 256; ++j) mx = fmaxf(mx, pr[tid * 256 + j]); float sm = 0.f; for (int j = 0; j < 256; ++j) { const float p = pr[tid * 256 + j] <= -1e29f ? 0.f : exp2f(pr[tid * 256 + j] - mx); pr[tid * 256 + j] = p; sm += p; }
            for (int j = 0; j < 256; ++j) pr[tid * 256 + j] /= sm; }
        __syncthreads();
        float e4 = 0.f, q4 = 0.f, s4 = 0.f;
        for (int e = tid; e < 2048; e += 512) { const int hh = e >> 7, d = e & 127; float o = 0.f;
            for (int j = 0; j < ns; ++j) { const unsigned s = sl[j]; if (s != 0xFFFFu) o += pr[hh * 256 + j] * bf(VA + ((size_t)b * SEQ + s) * 128 + d); }
            q4 += o * o; const float df = o - bf(O + row * 2048 + e); e4 = fmaxf(e4, fabsf(df)); s4 += df * df; }
        const float rms = sqrtf(bsum(q4, red, tid) / 2048.f) + 1e-20f; const float em = bmax(e4, red, tid); const float esq = bsum(s4, red, tid);
        if (tid == 0) { amax(dbg + (pass == 0 ? 0 : 2), em / rms); if (pass == 0) atomicAdd(dbg + 14, esq / (rms * rms * 2048.f)); }
        __syncthreads();
    }
}
__device__ __forceinline__ void p1(const float* x, const float* w_in, const bf16* QA, const bf16* QI, const bf16* KA, const bf16* VA, const bf16* KI, const float* WI, const bf16* CQ, const bf16* CKV, const bf16* KR, int smp, LAS float* xr, LAS float* red, LAS float* tru, float* dbg, int tid) {
    const size_t row = (size_t)(((unsigned)smp * 2654435761u) >> 9) % M; const int pos = (int)(row & (SEQ - 1));
    for (int i = tid; i < 2048; i += 512) xr[i] = x[row * 2048 + i];
    __syncthreads();
    for (int c = tid; c < U_G; c += 512) { float d = 0.f; for (int k = 0; k < 2048; ++k) d += xr[k] * w_in[(size_t)k * DIN + c]; tru[c] = d; }
    __syncthreads();
    for (int ty = 0; ty < 9; ++ty) {
        const int c0 = ty == 0 ? U_QA : ty == 1 ? U_QI : ty == 2 ? U_KA : ty == 3 ? U_VA : ty == 4 ? U_KI : ty == 5 ? U_WI : ty == 6 ? U_CQ : ty == 7 ? U_CKV : U_KPE;
        const int nc = ty == 0 ? 2048 : ty == 1 ? 1024 : ty == 2 ? 128 : ty == 3 ? 128 : ty == 4 ? 64 : ty == 5 ? 16 : ty == 6 ? 512 : ty == 7 ? 512 : 64;
        float q = 0.f, e = 0.f;
        for (int c = tid; c < nc; c += 512) { float tv = tru[c0 + c], sv;
            if (ty == 0) { tv *= QA_SCALE; sv = bf(QA + row * 2048 + c); } else if (ty == 1) sv = hf(QI + row * 1024 + c); else if (ty == 2) sv = bf(KA + row * 128 + c); else if (ty == 3) sv = bf(VA + row * 128 + c);
            else if (ty == 4) sv = hf(KI + row * 64 + c); else if (ty == 5) sv = WI[row * 16 + c]; else if (ty == 6) sv = bf(CQ + row * 512 + c); else if (ty == 7) sv = bf(CKV + row * 512 + c);
            else { const int i = c & 31; const float ang = (float)pos * exp2f(-(float)i * (13.287712379549449f / 32.f)), cs = cosf(ang), sn = sinf(ang); const float x1 = tru[c0 + i], x2 = tru[c0 + 32 + i]; tv = c < 32 ? x1 * cs - x2 * sn : x1 * sn + x2 * cs; sv = bf(KR + row * 64 + c); }
            q += tv * tv; e = fmaxf(e, fabsf(tv - sv)); }
        const float rms = sqrtf(bsum(q, red, tid) / (float)nc) + 1e-20f; const float em = bmax(e, red, tid) / rms;
        if (tid == 0) { amax(dbg + 3 + ty, em); amax(dbg + 12, em); }
        __syncthreads();
    }
}
__device__ __forceinline__ void p2(const bf16* CQ, const bf16* CKV, const float* gq, const float* gkv, const float* w_uq, const float* w_uk, const float* w_uv, const bf16* QN, const bf16* QR, const bf16* KN, const bf16* VB,
                                   int smp, LAS float* cr, LAS float* red, LAS float* tru, float* dbg, int tid) {
    const size_t row = (size_t)(((unsigned)smp * 2654435761u) >> 9) % M; const int pos = (int)(row & (SEQ - 1));
    for (int i = tid; i < 1024; i += 512) cr[i] = i < 512 ? bf(CQ + row * 512 + i) : bf(CKV + row * 512 + (i - 512));
    __syncthreads();
    const float ssq = bsum(cr[tid] * cr[tid], red, tid), ssk = bsum(cr[512 + tid] * cr[512 + tid], red, tid);
    const float rq = 1.f / sqrtf(ssq / 512.f + RMS_EPS), rk = 1.f / sqrtf(ssk / 512.f + RMS_EPS);
    for (int n = tid; n < 3072 + 4096; n += 512) { float d = 0.f;
        if (n < 3072) { for (int k = 0; k < 512; ++k) d += cr[k] * gq[k] * w_uq[(size_t)k * 3072 + n]; d *= rq * QB_SCALE; }
        else if (n < 3072 + 2048) { for (int k = 0; k < 512; ++k) d += cr[512 + k] * gkv[k] * w_uk[(size_t)k * 2048 + (n - 3072)]; d *= rk; }
        else { for (int k = 0; k < 512; ++k) d += cr[512 + k] * gkv[k] * w_uv[(size_t)k * 2048 + (n - 5120)]; d *= rk; }
        tru[n] = d; }
    __syncthreads();
    float q = 0.f, e = 0.f;
    for (int n = tid; n < 2048; n += 512) { const int h = n >> 7, d = n & 127; const float tv = tru[h * 192 + d]; q += tv * tv; e = fmaxf(e, fabsf(tv - bf(QN + row * 2048 + n))); }
    { const float rms = sqrtf(bsum(q, red, tid) / 2048.f) + 1e-20f; const float em = bmax(e, red, tid) / rms; if (tid == 0) { amax(dbg + 0, em); amax(dbg + 1, em); } }
    q = 0.f; e = 0.f;
    for (int n = tid; n < 1024; n += 512) { const int h = n >> 6, c = n & 63, i = c & 31; const float ang = (float)pos * exp2f(-(float)i * (13.287712379549449f / 32.f)), cs = cosf(ang), sn = sinf(ang);
        const float x1 = tru[h * 192 + 128 + i], x2 = tru[h * 192 + 160 + i], tv = c < 32 ? x1 * cs - x2 * sn : x1 * sn + x2 * cs; q += tv * tv; e = fmaxf(e, fabsf(tv - bf(QR + row * 1024 + n))); }
    { const float rms = sqrtf(bsum(q, red, tid) / 1024.f) + 1e-20f; const float em = bmax(e, red, tid) / rms; if (tid == 0) { amax(dbg + 0, em); amax(dbg + 2, em); } }
    q = 0.f; e = 0.f;
    for (int n = tid; n < 2048; n += 512) { const float tv = tru[3072 + n]; q += tv * tv; e = fmaxf(e, fabsf(tv - bf(KN + row * 2048 + n))); }
    { const float rms = sqrtf(bsum(q, red, tid) / 2048.f) + 1e-20f; const float em = bmax(e, red, tid) / rms; if (tid == 0) { amax(dbg + 0, em); amax(dbg + 3, em); } }
    q = 0.f; e = 0.f;
    for (int n = tid; n < 2048; n += 512) { const float tv = tru[5120 + n]; q += tv * tv; e = fmaxf(e, fabsf(tv - bf(VB + row * 2048 + n))); }
    { const float rms = sqrtf(bsum(q, red, tid) / 2048.f) + 1e-20f; const float em = bmax(e, red, tid) / rms; if (tid == 0) { amax(dbg + 0, em); amax(dbg + 4, em); } }
    __syncthreads();
}
__device__ __forceinline__ void gchk(const float* x, const float* w_in, const bf16* GS, const bf16* XHS, size_t row, LAS float* xr, LAS float* red, float* dbg, int tid) {
    for (int i = tid; i < 2048; i += 512) xr[i] = x[row * 2048 + i];
    __syncthreads();
    float eg = 0.f;
    for (int c = tid; c < 4096; c += 512) { float l0 = 0.f; for (int k = 0; k < 2048; ++k) l0 += xr[k] * w_in[(size_t)k * DIN + U_G + c]; eg = fmaxf(eg, fabsf(1.f / (1.f + expf(-l0)) - bf(GS + row * 4096 + c))); }
    const float egm = bmax(eg, red, tid);
    float ex = 0.f; for (int i = tid; i < 2048; i += 512) ex = fmaxf(ex, fabsf(xr[i] - hf(XHS + row * 2048 + i))); const float exm = bmax(ex, red, tid);
    int nb = 0; for (int c = tid; c < 4096; c += 512) { float l0 = 0.f; for (int k = 0; k < 2048; ++k) l0 += xr[k] * w_in[(size_t)k * DIN + U_G + c]; nb += fabsf(1.f / (1.f + expf(-l0)) - bf(GS + row * 4096 + c)) > 0.05f ? 1 : 0; }
    const float nbt = bsum((float)nb, red, tid);
    if (tid == 0) { amax(dbg + 0, egm); if (egm > 0.05f) { atomicAdd(dbg + 1, 1.0f); amax(dbg + 3, nbt); amax(dbg + 4, 4097.f - nbt); } amax(dbg + 2, exm); }
    __syncthreads();
}
__device__ __forceinline__ void mid(const float* x, const float* w_in, const float* wa, const float* wb, const float* wo, const bf16* AA, const bf16* AB, const bf16* GS, const bf16* MTS, const float* Z, size_t row, int vtag, LAS float* va, LAS float* red, LAS float* mg, float* dbg, int tid) {
    LAS float* vb = va + 2048; LAS float* xr = va + 4096;
    for (int i = tid; i < 2048; i += 512) { va[i] = bf(AA + row * 2048 + i); vb[i] = bf(AB + row * 2048 + i); xr[i] = x[row * 2048 + i]; }
    __syncthreads();
    float eg = 0.f, qm = 0.f, emt = 0.f; int cmx = -1, cmn = 1 << 20;
    for (int c = tid; c < 2048; c += 512) { float l0 = 0.f, l1 = 0.f, ma = 0.f, mb = 0.f;
        for (int k = 0; k < 2048; ++k) { const float xv = xr[k]; l0 += xv * w_in[(size_t)k * DIN + U_G + c]; l1 += xv * w_in[(size_t)k * DIN + U_G + 2048 + c]; ma += va[k] * wa[(size_t)k * 2048 + c]; mb += vb[k] * wb[(size_t)k * 2048 + c]; }
        const float g0 = 1.f / (1.f + expf(-l0)), g1 = 1.f / (1.f + expf(-l1)); mg[c] = ma * g0 + mb * g1;
        { const float e0 = fabsf(g0 - bf(GS + row * 4096 + c)), e1 = fabsf(g1 - bf(GS + row * 4096 + 2048 + c)); eg = fmaxf(eg, fmaxf(e0, e1)); if (e0 > 0.05f) { cmx = max(cmx, c); cmn = min(cmn, c); } if (e1 > 0.05f) { cmx = max(cmx, 2048 + c); cmn = min(cmn, 2048 + c); } } qm += mg[c] * mg[c]; emt = fmaxf(emt, fabsf(mg[c] - bf(MTS + row * 2048 + c))); }
    { const float egm = bmax(eg, red, tid); const float rm = sqrtf(bsum(qm, red, tid) / 2048.f) + 1e-20f; const float emm = bmax(emt, red, tid) / rm; if (tid == 0) { amax(dbg + 17, egm); amax(dbg + 18, emm); if (egm > 0.05f) { amax(dbg + 19, (float)(row & 255) + 1.0f); amax(dbg + 20, (float)(255 - (row & 255)) + 1.0f); atomicAdd(dbg + 21, 1.0f); amax(dbg + 22, (float)vtag + 1.0f); amax(dbg + 23, (float)(255 - vtag) + 1.0f); } }
      const float fx = bmax((float)cmx, red, tid), fn = bmax((float)(4096 - cmn), red, tid); if (tid == 0 && fx >= 0.f) { amax(dbg + 24, fx + 1.0f); amax(dbg + 25, fn + 1.0f); } }
    __syncthreads();
    float q = 0.f, e = 0.f;
    for (int c = tid; c < 2048; c += 512) { float d = 0.f; for (int k = 0; k < 2048; ++k) d += mg[k] * wo[(size_t)k * 2048 + c]; q += d * d; e = fmaxf(e, fabsf(ALPHA * xr[c] + d - Z[row * 2048 + c])); }
    const float rms = sqrtf(bsum(q, red, tid) / 2048.f) + 1e-20f; const float em = bmax(e, red, tid) / rms;
    if (tid == 0) { amax(dbg + 0, em); if (em > 0.25f) { atomicAdd(dbg + 13, 1.0f); amax(dbg + 15, (float)(row & 255) + 1.0f); amax(dbg + 16, (float)(row >> 8) + 1.0f); } }
    __syncthreads();
}
__device__ __forceinline__ void endp(const bf16* X1B, const float* x1f_unused, const float* p, const float* w_up, const float* cw, const float* cb, const float* w_down, const float* w_pg, const float* b_pg, const float* w_pe, const float* g2, const float* b2,
                                     const float* OUT, int smp, LAS float* xs, LAS float* red, LAS float* act, float* dbg, int tid) {
    const int k6 = smp & 7; const size_t rbase = (size_t)(((unsigned)smp * 2654435761u) >> 9) % M; const size_t row = k6 == 0 ? (rbase & ~(size_t)63) : k6 == 1 ? (rbase & ~(size_t)63) + 1 : k6 == 2 ? (rbase & ~(size_t)8191) : rbase; const int t = (int)(row & (SEQ - 1));
    LAS float* z = act + 5632; LAS float* pr = act + 5632 + 2048;
    for (int i = tid; i < 3 * 2048; i += 512) { const int j = i >> 11, c = i & 2047; const int tt = t - 2 + j; xs[i] = tt >= 0 ? bf(X1B + (row - 2 + j) * 2048 + c) : 0.f; }
    for (int i = tid; i < 256; i += 512) pr[i] = p[row * 256 + i];
    __syncthreads();
    for (int ch = tid; ch < DFF; ch += 512) { float hg[3] = {0.f, 0.f, 0.f}, hv[3] = {0.f, 0.f, 0.f};
        for (int k = 0; k < 2048; ++k) { const float wg = w_up[(size_t)k * NUP + ch], wv = w_up[(size_t)k * NUP + DFF + ch];
#pragma unroll
            for (int j = 0; j < 3; ++j) { hg[j] += xs[j * 2048 + k] * wg; hv[j] += xs[j * 2048 + k] * wv; } }
        float yg = cb[ch], yv = cb[DFF + ch];
#pragma unroll
        for (int j = 0; j < 3; ++j) { yg += cw[(size_t)j * NUP + ch] * hg[j]; yv += cw[(size_t)j * NUP + DFF + ch] * hv[j]; }
        act[ch] = yg / (1.f + expf(-yg)) * yv; }
    __syncthreads();
    for (int c = tid; c < 2048; c += 512) { float f = 0.f, lg = b_pg[c], pe = 0.f;
        for (int k = 0; k < DFF; ++k) f += act[k] * w_down[(size_t)k * 2048 + c];
        for (int k = 0; k < 2048; ++k) lg += xs[2 * 2048 + k] * w_pg[(size_t)k * 2048 + c];
        for (int k = 0; k < 256; ++k) pe += pr[k] * w_pe[(size_t)k * 2048 + c];
        z[c] = ALPHA * xs[2 * 2048 + c] + f + pe / (1.f + expf(-lg)); }
    __syncthreads();
    float s = 0.f; for (int c = tid; c < 2048; c += 512) s += z[c];
    const float mean = bsum(s, red, tid) / 2048.f; float s2 = 0.f; for (int c = tid; c < 2048; c += 512) s2 += (z[c] - mean) * (z[c] - mean);
    const float rstd = 1.f / sqrtf(bsum(s2, red, tid) / 2048.f + LN_EPS); float e = 0.f;
    for (int c = tid; c < 2048; c += 512) e = fmaxf(e, fabsf((z[c] - mean) * rstd * g2[c] + b2[c] - OUT[row * 2048 + c]));
    const float em = bmax(e, red, tid);
    if (tid == 0) { amax(dbg + 0, em); amax(dbg + 1 + (k6 < 3 ? k6 : 3), em); }
    __syncthreads();
}
}
#endif

__device__ __forceinline__ int own_panel(int x, int s) { return s < 4 ? x + 8 * s : 32 + (7 - x) + 8 * (s - 4); }
__device__ __forceinline__ void ln_pass(const bf16* zin, float* fout, bf16* bout, unsigned char* xf8, const float* g, const float* b, int vcu, int wave, int lane) {
#pragma unroll 1
    for (int s_ = 0; s_ < 8; ++s_) { const int m = 256 * own_panel(vcu >> 5, s_) + 8 * (vcu & 31) + wave;
        const GAS v4u* zr = (const GAS v4u*)(zin + (size_t)m * DM) + lane;
        f32x4 v[8]; float s = 0.f;
#pragma unroll
        for (int j = 0; j < 4; ++j) { unpack8(zr[64 * j], v[2 * j], v[2 * j + 1]); s += ((v[2 * j][0] + v[2 * j][1]) + (v[2 * j][2] + v[2 * j][3])) + ((v[2 * j + 1][0] + v[2 * j + 1][1]) + (v[2 * j + 1][2] + v[2 * j + 1][3])); }
        const float mean = wave_sum(s) * (1.f / DM); float s2 = 0.f;
#pragma unroll
        for (int j = 0; j < 8; ++j) { v[j] = v[j] - mean; s2 += (v[j][0] * v[j][0] + v[j][1] * v[j][1]) + (v[j][2] * v[j][2] + v[j][3] * v[j][3]); }
        const float rstd = 1.f / sqrtf(wave_sum(s2) * (1.f / DM) + LN_EPS);
#pragma unroll
        for (int j = 0; j < 4; ++j) { const int e0 = 8 * (lane + 64 * j);
            const f32x4 g0 = *(const GAS f32x4*)(g + e0), g1 = *(const GAS f32x4*)(g + e0 + 4), b0 = *(const GAS f32x4*)(b + e0), b1 = *(const GAS f32x4*)(b + e0 + 4);
            const f32x4 y0 = v[2 * j] * rstd * g0 + b0, y1 = v[2 * j + 1] * rstd * g1 + b1;
            if (fout) { *(GAS f32x4*)(fout + (size_t)m * DM + e0) = y0; *(GAS f32x4*)(fout + (size_t)m * DM + e0 + 4) = y1; }
            if (bout) *(GAS v4u*)(bout + (size_t)m * DM + e0) = pack8(y0, y1);
            if (xf8) { u32x2 w; w.x = pkf8(y0[0], y0[1], y0[2], y0[3]); w.y = pkf8(y1[0], y1[1], y1[2], y1[3]); *(GAS u32x2*)(xf8 + (size_t)m * DM + e0) = w; } }
    }
}
__device__ __forceinline__ void conv_fixup(unsigned char* ACT, const float* HEADB, const float* TAILB, const float* cw, const float* cb, int vcu, int tid) {
    constexpr int CH8 = DFF / 8;
    for (int it = (vcu & 31) * 512 + tid; it < 8 * 4 * 2 * CH8; it += 32 * 512) {
        const int c8 = it % CH8, rr = (it / CH8) & 1, g4 = (it / (2 * CH8)) & 3, s_ = it / (8 * CH8); const int g = own_panel(vcu >> 5, s_) * 4 + g4;
        const int ch = 8 * c8, pg = 256 * (ch >> 7) + (ch & 127); const bool first = (g & 127) == 0;
        f32x4 res[2][2];
#pragma unroll
        for (int bj = 0; bj < 2; ++bj) { const int pc = pg + bj * 128, c = ch + bj * DFF;
#pragma unroll
            for (int n = 0; n < 2; ++n) { const f32x4 z = (f32x4){0.f, 0.f, 0.f, 0.f};
                const f32x4 u0 = *(const GAS f32x4*)(HEADB + ((size_t)g * 2 + rr) * NUP + pc + 4 * n);
                const f32x4 t1 = first ? z : *(const GAS f32x4*)(TAILB + ((size_t)(g - 1) * 2 + 1) * NUP + pc + 4 * n);
                const f32x4 t0 = first ? z : *(const GAS f32x4*)(TAILB + ((size_t)(g - 1) * 2 + 0) * NUP + pc + 4 * n);
                const f32x4 h0 = *(const GAS f32x4*)(HEADB + ((size_t)g * 2 + 0) * NUP + pc + 4 * n);
                const f32x4 u1 = rr ? h0 : t1, u2 = rr ? t1 : t0;
                const f32x4 w0 = *(const GAS f32x4*)(cw + c + 4 * n), w1 = *(const GAS f32x4*)(cw + NUP + c + 4 * n), w2 = *(const GAS f32x4*)(cw + 2 * NUP + c + 4 * n), bb = *(const GAS f32x4*)(cb + c + 4 * n);
                res[bj][n] = bb + w2 * u0 + w1 * u1 + w0 * u2; } }
        const f32x4 a0 = res[0][0] * sigmoid4(res[0][0]) * res[1][0], a1 = res[0][1] * sigmoid4(res[0][1]) * res[1][1];
        { u32x2 w; w.x = pkf8(a0[0], a0[1], a0[2], a0[3]); w.y = pkf8(a1[0], a1[1], a1[2], a1[3]); *(GAS u32x2*)(ACT + ((size_t)g * 64 + rr) * DFF + ch) = w; }
    }
}

struct Args { const float* in[22]; float* out; unsigned char* ws; };
#define GEMM_PHASE_LC(EPI, A_, B_, N_, K_, E_, DT_, WS_, LDA_, C_) do { int kk_ = (K_); asm volatile("" : "+s"(kk_)); pg8::Gemm g_{(const pg8::bf16_t*)(A_), (const pg8::bf16_t*)(B_), M, (N_), kk_, (WS_), (LDA_)}; pg8::StaticOrder S_; S_.init(M, (N_), G, (C_)); \
        pg8::gemm_phase<EPI, pg8::StaticOrder, true, true, DT_>(lds, g_, S_, (E_)); } while (0)
#define GEMM_PHASE_L(EPI, A_, B_, N_, K_, E_, DT_, WS_, LDA_) do { int kk_ = (K_); asm volatile("" : "+s"(kk_)); pg8::Gemm g_{(const pg8::bf16_t*)(A_), (const pg8::bf16_t*)(B_), M, (N_), kk_, (WS_), (LDA_)}; pg8::StaticOrder S_; S_.init(M, (N_), G, bx); \
        pg8::gemm_phase<EPI, pg8::StaticOrder, true, true, DT_>(lds, g_, S_, (E_)); } while (0)
#define GEMM_PHASE_X(EPI, A_, B_, N_, K_, E_, DT_, WS_) GEMM_PHASE_L(EPI, A_, B_, N_, K_, E_, DT_, WS_, 0)
#define GEMM_PHASE_T(EPI, A_, B_, N_, K_, E_, F16_) GEMM_PHASE_X(EPI, A_, B_, N_, K_, E_, ((F16_) ? 1 : 0), 127)
#define GEMM_PHASE(EPI, A_, B_, N_, K_, E_) GEMM_PHASE_X(EPI, A_, B_, N_, K_, E_, 0, 127)

__global__ void __launch_bounds__(NWAVES * 64, 2) fwd_kernel(Args args) {
    extern __shared__ __attribute__((aligned(16))) unsigned char lds_raw[];
    LAS unsigned char* lds = (LAS unsigned char*)lds_raw;
    volatile LAS unsigned* MISC = (volatile LAS unsigned*)(lds + MISC_OFF);
    const int tid0 = threadIdx.x, wave = __builtin_amdgcn_readfirstlane(tid0 >> 6);
#define TID() ({ int t_ = threadIdx.x; asm volatile("" : "+v"(t_)); t_; })
#define LANE() (TID() & 63)
#define GT() ((size_t)bx * (NWAVES * 64) + TID())
    for (int u = threadIdx.x; u < (LDS_BYTES - LDSCTL_OFF) / 4; u += NWAVES * 64) ((LAS unsigned*)(lds + LDSCTL_OFF))[u] = 0u;
    __syncthreads();
    if (threadIdx.x == 0) { const unsigned xcc = xb_xcc_id() & 7u; const unsigned rk = __hip_atomic_fetch_add((gu32*)(args.ws + WS_CTL) + CW_RANK + 64 * xcc, 1u, RLX_AGENT); MISC[12] = (rk & 31u) * 8u + xcc; }
    __syncthreads();
    const int G = gridDim.x, bx = __builtin_amdgcn_readfirstlane((int)MISC[12]), vcu = (bx % 8) * (G / 8) + bx / 8;
    const int gw = vcu * NWAVES + wave, NGW = G * NWAVES; const size_t NT = (size_t)G * NWAVES * 64;
#define WSP(T_, off_) ((T_*)(wsb() + (off_)))
#define INP(k_) inb(k_)
#define DOP(T_, off_) ((T_*)((unsigned char*)outb() + (off_)))
    auto wsb = [&]() __attribute__((always_inline)) { unsigned char* w_ = args.ws; asm volatile("" : "+s"(w_)); return w_; };
    auto inb = [&](int k_) __attribute__((always_inline)) { const float* p_ = args.in[k_]; asm volatile("" : "+s"(p_)); return p_; };
    auto outb = [&]() __attribute__((always_inline)) { float* p_ = args.out; asm volatile("" : "+s"(p_)); return p_; };

    XcdBarrier bar = xcd_barrier_post((unsigned*)((gu32*)(args.ws + WS_CTL) + CW_BAR), MISC + 8);
#if defined(DBG_CKPT)
#define CKPT(id_, lo_, hi_) do { if (DBG_CKPT == (id_)) { unsigned* cw_ = WSP(unsigned, WS_CTL) + 200100; const unsigned* p_ = (const unsigned*)(wsb() + (size_t)(lo_) * MiB); unsigned c_ = 0u; \
        for (size_t i = GT(); i < (size_t)((hi_) - (lo_)) * MiB / 4; i += NT) c_ += p_[i] * 2654435761u + (unsigned)i; \
        c_ += __shfl_xor(c_, 32); c_ += __shfl_xor(c_, 16); c_ += __shfl_xor(c_, 8); c_ += __shfl_xor(c_, 4); c_ += __shfl_xor(c_, 2); c_ += __shfl_xor(c_, 1); \
        if ((TID() & 63) == 0) atomicAdd(cw_, c_); xcd_barrier(bar); \
        const float X = (float)(__hip_atomic_load(cw_, RLX_AGENT) & 0xFFFFFFu) + 1.0f; float* o_ = outb(); \
        for (size_t i = GT(); i < (size_t)M * DM / 4; i += NT) *((GAS f32x4*)o_ + i) = (f32x4){X, X, X, X}; return; } } while (0)
#else
#define CKPT(id_, lo_, hi_) do { } while (0)
#endif
#if defined(DBG_SPIN)
#define STAMP(i_) do { if (threadIdx.x == 0) { const unsigned long long t_ = __builtin_amdgcn_s_memrealtime(); MISC[16 + 2 * (i_)] = (unsigned)t_; MISC[17 + 2 * (i_)] = (unsigned)(t_ >> 32); const unsigned long long c_ = __builtin_amdgcn_s_memtime(); MISC[100 + 2 * (i_)] = (unsigned)c_; MISC[101 + 2 * (i_)] = (unsigned)(c_ >> 32); } } while (0)
#else
#define STAMP(i_) do { } while (0)
#endif
#define SCR() ((LAS float*)(lds + RING_OFF + wave * TR_LDS))
#define SSQP() ((float*)(wsb() + WS_CTL + MiB))

#if defined(DBG_CHECK)
#define DBG_OA ((DBG_CHECK == 1 || DBG_CHECK == 4) ? WS_XB : WS_QA)
#define DBG_OB (DBG_CHECK == 2 ? WS_XB : WS_QN)
#define DBG_SEL ((DBG_CHECK == 1 || DBG_CHECK == 4) ? (unsigned short*)(wsb() + WS_END) : (unsigned short*)nullptr)
#else
#define DBG_OA WS_QA
#define DBG_OB WS_QN
#define DBG_SEL ((unsigned short*)nullptr)
#endif
#ifndef ONLY
#define ONLY -1
#endif
#ifndef SKIPMASK
#define SKIPMASK 0
#endif
#define PH(k) ((ONLY < 0 || ONLY == (k)) && !((SKIPMASK >> (k)) & 1))
    STAMP(0);
    if (PH(0)) {
    { const TrIn I{INP(2), INP(3), INP(4), INP(5), INP(6), INP(7), INP(8), INP(9), INP(10), INP(13), INP(16), INP(17), INP(19)}; tr_all(I, wsb(), SCR(), gw, NGW, LANE()); }
    cvt_flat_h(INP(0), WSP(bf16, WS_XB), WSP(unsigned char, WS_XF8), (size_t)M * DM / 8, GT(), NT);
    cvt_flat(INP(1), WSP(bf16, WS_PB), (size_t)M * PLE_DIM / 8, GT(), NT);
    { float* ROPE = WSP(float, WS_ROPE);
    for (size_t i = GT(); i < (size_t)SEQ * 32; i += NT) { const int pos = (int)(i >> 5), j = (int)(i & 31);
        const double f = exp2(-(double)j * (13.287712379549449 / 32.0)), turns = (double)pos * f * 0.15915494309189535, fr = turns - floor(turns);
        ROPE[i] = __builtin_amdgcn_cosf((float)fr); ROPE[(size_t)SEQ * 32 + i] = __builtin_amdgcn_sinf((float)fr); } }
    }
    xcd_barrier(bar);

    STAMP(1);
    if (PH(1)) { EpiU<1> E{WSP(bf16, WS_QA), DOP(bf16, DO_QI), DOP(bf16, DO_KA), DOP(bf16, DO_VA), DOP(bf16, DO_KI), DOP(bf16, DO_KR), DOP(bf16, DO_CQ), DOP(bf16, DO_CKV), DOP(float, DO_WI), SSQP(), WSP(float, WS_ROPE)};
        GEMM_PHASE_X(EpiU<1>, WSP(bf16, WS_XF8), WSP(bf16, WS_WIN8), NU8, 1024, E, 2, 127 - 6); }
    if (PH(1)) { EpiU<2> E{WSP(bf16, WS_QA), DOP(bf16, DO_QI), DOP(bf16, DO_KA), DOP(bf16, DO_VA), DOP(bf16, DO_KI), DOP(bf16, DO_KR), DOP(bf16, DO_CQ), DOP(bf16, DO_CKV), DOP(float, DO_WI), SSQP(), WSP(float, WS_ROPE)};
        GEMM_PHASE_LC(EpiU<2>, WSP(bf16, WS_XB), WSP(bf16, WS_WIN), NU16, 2048, E, 1, 127, 0, (bx + 64) % G); }
    xcd_barrier(bar);
    CKPT(1, 118, 260);

#if defined(DBG_CHECK) && DBG_CHECK == 3
    {   float* dbgw = (float*)(WSP(unsigned, WS_CTL) + 200000);
        LAS float* xr = (LAS float*)lds; LAS float* red = (LAS float*)(lds + 65536); LAS float* tru = (LAS float*)(lds + 69632);
        for (int smp = bx; smp < 256; smp += G) chk::p1(INP(0), INP(2), WSP(bf16, WS_QA), DOP(bf16, DO_QI), DOP(bf16, DO_KA), DOP(bf16, DO_VA), DOP(bf16, DO_KI), DOP(float, DO_WI), DOP(bf16, DO_CQ), DOP(bf16, DO_CKV), DOP(bf16, DO_KR), smp, xr, red, tru, dbgw, TID());
        xcd_barrier(bar);
        const float X = __hip_atomic_load(dbgw + DBG_WORD, RLX_AGENT) * 1e8f; float* o_ = outb();
        for (size_t i = GT(); i < (size_t)M * DM / 4; i += NT) *((GAS f32x4*)o_ + i) = (f32x4){X, X, X, X};
        return;
    }
#endif
#if defined(DBG_CHECK) && DBG_CHECK == 5
    {
        float* dbgw = (float*)(WSP(unsigned, WS_CTL) + 200000);
        for (int rep = 0; rep < 2; ++rep) {
            const dsa::Ptrs P{DOP(bf16, DO_QI), DOP(bf16, DO_KI), DOP(bf16, DO_KA), DOP(bf16, DO_VA), DOP(float, DO_WI), WSP(bf16, WS_QA), rep == 0 ? WSP(bf16, WS_XB) : WSP(bf16, WS_QN), (unsigned short*)(wsb() + WS_END + (size_t)rep * 8 * MiB)};
            LAS unsigned char* wl = lds + RING_OFF + wave * 16384; LAS dsa::u16* idl = (LAS dsa::u16*)(lds + IDL_OFF + wave * 2048);
            const int x_ = vcu >> 5, wv = (vcu & 31) * NWAVES + wave, j_ = wv >> 6, i_ = wv & 63;
#pragma unroll 1
            for (int jb = 0; jb < 2; ++jb) dsa::job(P, jb, jb == 0 ? 256 * (x_ + 8 * j_) + 4 * i_ : 256 * ((7 - x_) + 8 * (3 - j_)) + 4 * (63 - i_), wl, idl, LANE());
            xcd_barrier(bar);
        }
        { const unsigned short* sa = (const unsigned short*)(wsb() + WS_END); const unsigned short* sb = sa + (size_t)4 * MiB; unsigned c = 0u;
          for (size_t i = GT(); i < (size_t)M * 256; i += NT) c += sa[i] != sb[i] ? 1u : 0u;
          if (c) atomicAdd((unsigned*)dbgw + 20, c);
          const unsigned* oa = (const unsigned*)WSP(bf16, WS_XB); const unsigned* ob = (const unsigned*)WSP(bf16, WS_QN); unsigned c2 = 0u;
          for (size_t i = GT(); i < (size_t)M * 1024; i += NT) c2 += oa[i] != ob[i] ? 1u : 0u;
          if (c2) atomicAdd((unsigned*)dbgw + 21, c2); }
        xcd_barrier(bar);
        const float X = ((float)__hip_atomic_load((unsigned*)dbgw + 20 + DBG_WORD, RLX_AGENT) + 1.0f) * 1e8f; float* o_ = outb();
        for (size_t i = GT(); i < (size_t)M * DM / 4; i += NT) *((GAS f32x4*)o_ + i) = (f32x4){X, X, X, X};
        return;
    }
#endif
    STAMP(2);
    if (PH(3)) { const dsa::Ptrs P{DOP(bf16, DO_QI), DOP(bf16, DO_KI), DOP(bf16, DO_KA), DOP(bf16, DO_VA), DOP(float, DO_WI), WSP(bf16, WS_QA), WSP(bf16, DBG_OA), DBG_SEL};
      LAS unsigned char* wl = lds + RING_OFF + wave * 16384; LAS dsa::u16* idl = (LAS dsa::u16*)(lds + IDL_OFF + wave * 2048);
      const int x_ = vcu >> 5, j_ = wave & 3, i_ = (vcu & 31) * 2 + (wave >> 2);
#pragma unroll 1
      for (int jb = 0; jb < 2; ++jb) dsa::job(P, jb, jb == 0 ? 256 * (x_ + 8 * j_) + 4 * i_ : 256 * ((7 - x_) + 8 * (3 - j_)) + 4 * (63 - i_), wl, idl, LANE(), wave == 0 ? MISC + 64 : nullptr); }
    __syncthreads();
    STAMP(3);
    if (PH(2)) { EpiQ E{WSP(bf16, WS_QN), DOP(bf16, DO_QR), SSQP(), WSP(float, WS_ROPE)}; GEMM_PHASE_X(EpiQ, DOP(bf16, DO_CQ), WSP(bf16, WS_WUQ), 3072, 256, E, 2, 127 - 5); }
    if (PH(2)) { EpiKV E{WSP(bf16, WS_KN), WSP(bf16, WS_VB), SSQP() + (size_t)M * 8}; GEMM_PHASE_X(EpiKV, DOP(bf16, DO_CKV), WSP(bf16, WS_WKV), 4096, 256, E, 2, 127 - 5); }
    xcd_barrier(bar);
    CKPT(2, 118, 182); CKPT(3, 260, 484);
#if defined(DBG_CHECK) && DBG_CHECK == 6
    {   float* dbgw = (float*)(WSP(unsigned, WS_CTL) + 200000);
        LAS float* cr = (LAS float*)lds; LAS float* red = (LAS float*)(lds + 65536); LAS float* tru = (LAS float*)(lds + 69632);
        for (int smp = bx; smp < 256; smp += G) chk::p2(DOP(bf16, DO_CQ), DOP(bf16, DO_CKV), INP(3), INP(4), INP(5), INP(6), INP(7), WSP(bf16, WS_QN), DOP(bf16, DO_QR), WSP(bf16, WS_KN), WSP(bf16, WS_VB), smp, cr, red, tru, dbgw, TID());
        xcd_barrier(bar);
        const float X = __hip_atomic_load(dbgw + DBG_WORD, RLX_AGENT) * 1e8f; float* o_ = outb();
        for (size_t i = GT(); i < (size_t)M * DM / 4; i += NT) *((GAS f32x4*)o_ + i) = (f32x4){X, X, X, X};
        return;
    }
#endif

    STAMP(4);
    if (PH(4)) { const mla::Tensors T{WSP(bf16, WS_QN), DOP(bf16, DO_QR), WSP(bf16, WS_KN), DOP(bf16, DO_KR), WSP(bf16, WS_VB), DOP(bf16, DO_AB8)};
#pragma unroll 1
      for (int r_ = 0; r_ < 2; ++r_) { const int x_ = vcu >> 5, q_ = (vcu & 31) * 2 + r_, j_ = q_ >> 4, h_ = q_ & 15;
#pragma unroll 1
          for (int ps = 0; ps < 2; ++ps) mla::unit(T, ps, h_, ps == 0 ? x_ + 8 * j_ : (7 - x_) + 8 * (3 - j_), lds + RING_OFF); } }
    CKPT(4, 260, 324);

#if defined(DBG_CHECK) && (DBG_CHECK == 1 || DBG_CHECK == 2 || DBG_CHECK == 4)
    {
        float* dbgw = (float*)(WSP(unsigned, WS_CTL) + 200000);
        LAS float* lgs = (LAS float*)lds; LAS float* red = (LAS float*)(lds + 65536); LAS float* aux = (LAS float*)(lds + 69632);
        for (int smp = bx; smp < (DBG_CHECK == 4 ? 256 : 512); smp += G) {
#if DBG_CHECK == 2
            chk::mla(WSP(bf16, WS_QN), DOP(bf16, DO_QR), WSP(bf16, WS_KN), DOP(bf16, DO_KR), WSP(bf16, WS_VB), WSP(bf16, DBG_OB), smp, lgs, red, aux, dbgw, TID());
#else
            chk::dsa<(DBG_CHECK == 4)>(INP(0), INP(2), DOP(bf16, DO_QI), DOP(bf16, DO_KI), DOP(float, DO_WI), WSP(bf16, WS_QA), DOP(bf16, DO_KA), DOP(bf16, DO_VA), WSP(bf16, DBG_OA), DBG_SEL, smp, lgs, red, aux, dbgw, TID());
#endif
        }
        xcd_barrier(bar);
        const float X = __hip_atomic_load(dbgw + DBG_WORD, RLX_AGENT) * 1e8f; float* o_ = outb();
        for (size_t i = GT(); i < (size_t)M * DM / 4; i += NT) *((GAS f32x4*)o_ + i) = (f32x4){X, X, X, X};
        return;
    }
#endif
    STAMP(5);
    if (PH(5)) { EpiB<1> E{WSP(bf16, WS_G), 4096, nullptr, nullptr, nullptr}; GEMM_PHASE_X(EpiB<1>, WSP(bf16, WS_XF8), WSP(bf16, WS_WG), 4096, 1024, E, 2, 127 - 6); }
    xcd_barrier(bar);
    CKPT(5, 356, 484); CKPT(6, 182, 256); CKPT(7, 324, 348);
#if defined(DBG_CHECK) && DBG_CHECK == 10
    {
        unsigned* dw = WSP(unsigned, WS_CTL) + 200000; const bf16* Gp = WSP(bf16, WS_G);
        unsigned cntb = 0u, rmax = 0u, rmin = 255u, pnmax = 0u, pnmin = 15u, r16 = 0u, nnan = 0u, pmaxb = 0u, pminb = 63u; float vmax = 0.f;
        for (int s_ = 0; s_ < 8; ++s_) { const int pnl = own_panel(vcu >> 5, s_);
            for (int e = (vcu & 31) * 512 + (int)TID(); e < 256 * 4096 / 8; e += 32 * 512) { const int r = e / 512, c8 = e % 512; const v4u w = *(const GAS v4u*)(Gp + ((size_t)pnl * 256 + r) * 4096 + c8 * 8); f32x4 a, b; unpack8(w, a, b);
                bool bad = false;
#pragma unroll
                for (int j = 0; j < 4; ++j) { bad |= !(a[j] >= 0.f && a[j] <= 1.001f); bad |= !(b[j] >= 0.f && b[j] <= 1.001f); }
                if (bad) { for (int j = 0; j < 4; ++j) { if (a[j] == a[j] && fabsf(a[j]) < 1e30f) vmax = fmaxf(vmax, fabsf(a[j])); else ++nnan; if (b[j] == b[j] && fabsf(b[j]) < 1e30f) vmax = fmaxf(vmax, fabsf(b[j])); else ++nnan; } pmaxb = max(pmaxb, (unsigned)pnl); pminb = min(pminb, (unsigned)pnl);
                    ++cntb; rmax = max(rmax, (unsigned)r); rmin = min(rmin, (unsigned)r); pnmax = max(pnmax, (unsigned)(c8 / 32)); pnmin = min(pnmin, (unsigned)(c8 / 32)); r16 |= 1u << (r & 15); } } }
        if (cntb) { atomicAdd(dw + 0, cntb); atomicMax(dw + 1, rmax + 1u); atomicMax(dw + 2, 256u - rmin); atomicMax(dw + 3, pnmax + 1u); atomicMax(dw + 4, 16u - pnmin); atomicOr(dw + 5, r16); atomicMax(dw + 6, (unsigned)vmax); atomicAdd(dw + 7, nnan); atomicMax(dw + 8, pmaxb + 1u); atomicMax(dw + 9, 64u - pminb); }
        xcd_barrier(bar);
        const float X = (float)__hip_atomic_load(dw + DBG_WORD, RLX_AGENT) * 1e8f; float* o_ = outb();
        for (size_t i = GT(); i < (size_t)M * DM / 4; i += NT) *((GAS f32x4*)o_ + i) = (f32x4){X, X, X, X};
        return;
    }
#endif
#if defined(DBG_CHECK) && DBG_CHECK == 9
    {   float* dbgw = (float*)(WSP(unsigned, WS_CTL) + 200000);
        LAS float* xr = (LAS float*)lds; LAS float* red = (LAS float*)(lds + 65536);
        { const size_t row_ = (size_t)256 * own_panel(vcu >> 5, vcu & 7) + (((unsigned)vcu * 2654435761u) >> 9) % 256;
          chk::gchk(INP(0), INP(2), WSP(bf16, WS_G), WSP(bf16, WS_XB), row_, xr, red, dbgw, TID()); }
        xcd_barrier(bar);
        const float X = __hip_atomic_load(dbgw + DBG_WORD, RLX_AGENT) * 1e8f; float* o_ = outb();
        for (size_t i = GT(); i < (size_t)M * DM / 4; i += NT) *((GAS f32x4*)o_ + i) = (f32x4){X, X, X, X};
        return;
    }
#endif

    STAMP(6);
    if (PH(7)) { EpiB<2> E{WSP(bf16, WS_MT), 2048, WSP(bf16, WS_G), nullptr, nullptr}; GEMM_PHASE_L(EpiB<2>, WSP(bf16, WS_QA), WSP(bf16, WS_WA), 2048, 1024, E, 2, 127 - 6, 2048); }
    if (PH(7)) { EpiB<5> E{WSP(bf16, WS_MT), 2048, (const bf16*)(WSP(unsigned char, WS_G) + 2048), nullptr, WSP(unsigned char, WS_MG8)}; GEMM_PHASE_X(EpiB<5>, DOP(bf16, DO_AB8), WSP(bf16, WS_WB), 2048, 1024, E, 2, 127 - 6); }
    xcd_barrier(bar);
    CKPT(8, 54, 118);

    STAMP(7);
    if (PH(8)) { EpiF<0> E{WSP(bf16, WS_X1B), INP(0), nullptr}; GEMM_PHASE_X(EpiF<0>, WSP(bf16, WS_MG8), WSP(bf16, WS_WO), 2048, 1024, E, 2, 127 - 6); }
    xcd_barrier(bar);
#if defined(DBG_CHECK) && DBG_CHECK == 7
    {   float* dbgw = (float*)(WSP(unsigned, WS_CTL) + 200000);
        LAS float* va = (LAS float*)lds; LAS float* red = (LAS float*)(lds + 65536); LAS float* mg = (LAS float*)(lds + 69632);
        { const size_t row_ = (size_t)256 * own_panel(vcu >> 5, vcu & 7) + (((unsigned)vcu * 2654435761u) >> 9) % 256;
          chk::mid(INP(0), INP(2), INP(8), INP(9), INP(10), WSP(bf16, WS_QA), WSP(bf16, WS_QN), WSP(bf16, WS_G), WSP(bf16, WS_MT), outb(), row_, vcu, va, red, mg, dbgw, TID()); }
        xcd_barrier(bar);
        const float X = __hip_atomic_load(dbgw + DBG_WORD, RLX_AGENT) * 1e8f; float* o_ = outb();
        for (size_t i = GT(); i < (size_t)M * DM / 4; i += NT) *((GAS f32x4*)o_ + i) = (f32x4){X, X, X, X};
        return;
    }
#endif
    if (PH(9)) { bf16* z_ = WSP(bf16, WS_X1B); ln_pass(z_, nullptr, z_, WSP(unsigned char, WS_X1F8), INP(11), INP(12), vcu, wave, LANE()); }
    xcd_barrier(bar);
    CKPT(9, 118, 182);

    STAMP(8);
    if (PH(10)) { EpiUp E{WSP(unsigned char, WS_ACT), WSP(float, WS_HEAD), WSP(float, WS_TAIL), INP(14), INP(15)}; GEMM_PHASE_X(EpiUp, WSP(bf16, WS_X1F8), WSP(bf16, WS_WUP), NUP, 1024, E, 2, 127 - 6); }
    xcd_barrier(bar);
    CKPT(10, 260, 484);

    STAMP(9);
    if (PH(11)) conv_fixup(WSP(unsigned char, WS_ACT), WSP(float, WS_HEAD), WSP(float, WS_TAIL), INP(14), INP(15), vcu, TID());
    if (PH(12)) { EpiB<0> E{WSP(bf16, WS_PEO), 2048, nullptr, nullptr, nullptr}; GEMM_PHASE(EpiB<0>, WSP(bf16, WS_PB), WSP(bf16, WS_WPE), 2048, 256, E); }
    if (PH(15)) { EpiB<4> E{WSP(bf16, WS_PEO), 2048, nullptr, INP(18), nullptr}; GEMM_PHASE_X(EpiB<4>, WSP(bf16, WS_X1F8), WSP(bf16, WS_WPG), 2048, 1024, E, 2, 127 - 6); }
    xcd_barrier(bar);
    CKPT(11, 54, 118); CKPT(12, 308, 484);

    STAMP(10);
    if (PH(13)) { EpiF<1> E{WSP(bf16, WS_X1B), nullptr, WSP(bf16, WS_PEO)}; GEMM_PHASE_X(EpiF<1>, WSP(bf16, WS_ACT), WSP(bf16, WS_WDN), 2048, DFF / 2, E, 2, 127 - 7); }
    xcd_barrier(bar);
    if (PH(14)) { ln_pass(WSP(bf16, WS_X1B), outb(), nullptr, nullptr, INP(20), INP(21), vcu, wave, LANE()); }
#if defined(DBG_SPIN)
    STAMP(11);
    if (threadIdx.x == 0 && vcu == DBG_VCU) { const unsigned long long a_ = ((unsigned long long)MISC[17 + 2 * (DBG_SPIN % 100)] << 32) | MISC[16 + 2 * (DBG_SPIN % 100)], b_ = ((unsigned long long)MISC[17 + 2 * (DBG_SPIN % 100 + DBG_SPAN)] << 32) | MISC[16 + 2 * (DBG_SPIN % 100 + DBG_SPAN)];
        const unsigned long long ca_ = ((unsigned long long)MISC[101 + 2 * (DBG_SPIN % 100)] << 32) | MISC[100 + 2 * (DBG_SPIN % 100)], cb_ = ((unsigned long long)MISC[101 + 2 * (DBG_SPIN % 100 + DBG_SPAN)] << 32) | MISC[100 + 2 * (DBG_SPIN % 100 + DBG_SPAN)];
        const unsigned long long t0_ = __builtin_amdgcn_s_memrealtime(), w_ = DBG_SPIN >= 200 ? (cb_ - ca_) / 20ull : DBG_SPIN >= 100 ? 4ull * MISC[64 + (DBG_SPIN - 100)] : 4ull * (b_ - a_); while (__builtin_amdgcn_s_memrealtime() - t0_ < w_) __builtin_amdgcn_s_sleep(8); }
#endif
#if defined(DBG_CHECK) && DBG_CHECK == 8
    {   xcd_barrier(bar);
        float* dbgw = (float*)(WSP(unsigned, WS_CTL) + 200000);
        LAS float* xs = (LAS float*)lds; LAS float* red = (LAS float*)(lds + 65536); LAS float* act = (LAS float*)(lds + 69632);
        for (int smp = bx; smp < 256; smp += G) chk::endp(WSP(bf16, WS_X1B), nullptr, INP(1), INP(13), INP(14), INP(15), INP(16), INP(17), INP(18), INP(19), INP(20), INP(21), outb(), smp, xs, red, act, dbgw, TID());
        xcd_barrier(bar);
        const float X = __hip_atomic_load(dbgw + DBG_WORD, RLX_AGENT) * 1e8f; float* o_ = outb();
        for (size_t i = GT(); i < (size_t)M * DM / 4; i += NT) *((GAS f32x4*)o_ + i) = (f32x4){X, X, X, X};
    }
#endif
}

extern "C" void kernel_launch(void* const* d_in, const int* in_sizes, int n_in, void* d_out, int out_size, void* d_ws, size_t ws_size, hipStream_t stream) {
    static int grid = 0;
    if (grid == 0) {
        if (n_in != 22 || in_sizes[0] != M * DM || out_size != M * DM || ws_size < WS_END) { fprintf(stderr, "kernel_launch: unexpected shapes (n_in %d, in0 %d, out %d, ws %zu); nothing launched\n", n_in, n_in > 0 ? in_sizes[0] : -1, out_size, ws_size); grid = -1; return; }
        int dev = 0, cus = 0, per_cu = 0;
        if (hipGetDevice(&dev) != hipSuccess || hipDeviceGetAttribute(&cus, hipDeviceAttributeMultiprocessorCount, dev) != hipSuccess) { grid = -1; return; }
        if (hipFuncSetAttribute((const void*)fwd_kernel, hipFuncAttributeMaxDynamicSharedMemorySize, LDS_BYTES) != hipSuccess) { fprintf(stderr, "kernel_launch: hipFuncSetAttribute failed\n"); grid = -1; return; }
        if (hipOccupancyMaxActiveBlocksPerMultiprocessor(&per_cu, (const void*)fwd_kernel, NWAVES * 64, LDS_BYTES) != hipSuccess || per_cu < 1) { fprintf(stderr, "kernel_launch: occupancy query reports %d workgroups per CU\n", per_cu); }
        (void)hipGetLastError();
        grid = cus;
    }
    if (grid < 0) return;
    if (hipMemsetAsync((char*)d_ws + WS_CTL, 0, CTL_ZERO_BYTES, stream) != hipSuccess) return;
    Args a{};
    for (int i = 0; i < 22; ++i) a.in[i] = (const float*)d_in[i];
    a.out = (float*)d_out; a.ws = (unsigned char*)d_ws;
    hipLaunchKernelGGL(fwd_kernel, dim3(grid), dim3(NWAVES * 64), LDS_BYTES, stream, a);
}
```

```cpp
#include <hip/hip_runtime.h>
#include <cstdio>
#include <cstdint>
namespace pg8 {
#define PG8_LAS __attribute__((address_space(3)))
typedef unsigned short bf16_t;
typedef short bf16x8 __attribute__((ext_vector_type(8)));
typedef float f32x4 __attribute__((ext_vector_type(4)));
typedef unsigned u32x4 __attribute__((ext_vector_type(4)));
constexpr int BM = 256, BK = 64, HALF = 128, HTB = HALF * BK * 2  , STAGE_BYTES = 8 * HTB, NXCD = 8, WGM = 8;

__host__ __device__ __forceinline__ int lds_byte(int r, int c) { const int st = (r >> 4) * 2 + (c >> 5), rr = r & 15, cc = c & 31, ob = rr * 64 + cc * 2; return st * 1024 + (ob ^ (((ob >> 9) & 1) << 5)); }
__host__ __device__ __forceinline__ void stage_rc(int b, int& R, int& C) { const int st = b / 1024, sb = b % 1024, swz = sb ^ (((sb >> 9) & 1) << 5); R = (st >> 1) * 16 + swz / 64; C = (st & 1) * 32 + (swz % 64) / 2; }
__host__ __device__ __forceinline__ int perm32(int rho) { const int n = rho >> 4, i = rho & 15; return 8 * (i >> 2) + 4 * n + (i & 3); }

struct Unit { int pm, pn; };
struct Gemm { const bf16_t* A; const bf16_t* Bt; int M, N, K; int wscale; int lda; };
typedef int i32x4 __attribute__((ext_vector_type(4))); typedef int i32x8 __attribute__((ext_vector_type(8)));
typedef _Float16 f16x8 __attribute__((ext_vector_type(8)));

struct StaticOrder {
    int nM, nN, nwg, G, c;
    __host__ __device__ void init(int M, int N, int G_, int c_) { nM = M / BM; nN = N / BM; nwg = nM * nN; G = G_; c = c_; }
    __host__ __device__ bool next(int i, Unit& u) const {
        const long L = (long)i * G + c; if (L >= nwg) return false;
        int wgid = (int)L; { const int q = nwg / NXCD, r = nwg % NXCD, xcd = wgid % NXCD, off = wgid / NXCD; wgid = (xcd < r ? xcd * (q + 1) : r * (q + 1) + (xcd - r) * q) + off; }
        const int nig = WGM * nN, gid = wgid / nig, fm = gid * WGM, gsz = (nM - fm) < WGM ? (nM - fm) : WGM;
        u.pm = fm + ((wgid % nig) % gsz); u.pn = (wgid % nig) / gsz;
        { const int x = u.pm >> 3, s = u.pm & 7; u.pm = s < 4 ? x + 8 * s : 32 + (7 - x) + 8 * (s - 4); }
        return true;
    }
    __device__ __forceinline__ void a_ready(const Unit&) const {}
    __device__ __forceinline__ void done(const Unit&) const {}
};
struct PEOrder {
    int c;
    __host__ __device__ void init(int c_) { c = c_; }
    __host__ __device__ bool next(int i, Unit& u) const {
        const int x = c & 7, r = c >> 3; if (r < 8 || r >= 24 || i >= 4) return false;
        const int w = 4 * (r - 8) + i, s = w & 7; u.pm = s < 4 ? x + 8 * s : 32 + (7 - x) + 8 * (s - 4); u.pn = w >> 3;
        return true;
    }
    __device__ __forceinline__ void a_ready(const Unit&) const {}
    __device__ __forceinline__ void done(const Unit&) const {}
};

typedef float f32x2c_t __attribute__((ext_vector_type(2))); typedef __bf16 bf16x2c_t __attribute__((ext_vector_type(2)));
__device__ __forceinline__ unsigned cvt_pk_bf16(float lo, float hi) { const f32x2c_t v = {lo, hi}; const bf16x2c_t b = __builtin_convertvector(v, bf16x2c_t); return __builtin_bit_cast(unsigned, b); }
typedef float f32x2 __attribute__((ext_vector_type(2)));
template <class Epi, class Sched, bool ALIGN_EPI = false, bool SP2 = false, int DT = 0  >
__device__ __forceinline__ void gemm_phase(PG8_LAS unsigned char* lds, const Gemm g, const Sched& S, const Epi& E) {
    int tid_o_ = threadIdx.x; asm volatile("" : "+v"(tid_o_));
    const int tid = tid_o_, wid = __builtin_amdgcn_readfirstlane(tid >> 6), lane = tid & 63, wr = wid >> 2, wc = wid & 3, fr = lane & 15, fq = lane >> 4;
    const int K = g.K, nt = K / BK, lda = g.lda ? g.lda : g.K;
    unsigned voffA[2], voffB[2];
#pragma unroll
    for (int i = 0; i < 2; ++i) { int R, C; stage_rc(tid * 16 + i * 8192, R, C); const int Rb = Epi::PERM ? ((R & ~31) + perm32(R & 31)) : R;
        voffA[i] = (unsigned)(R * lda + C) * 2u; voffB[i] = (unsigned)(Rb * K + C) * 2u; }
    const size_t kstep = (size_t)(BK * 2);
    const size_t hstep = (size_t)HALF * K * 2;
    const size_t tstep = 2 * hstep;
    const size_t hstepA = (size_t)HALF * lda * 2, tstepA = 2 * hstepA;
    const unsigned ldsw = (unsigned)wid * 1024u;
    const int aoff = lds_byte(wr * 64 + fr, fq * 8), boff = lds_byte(wc * 32 + fr, fq * 8);
#define PG8_SA(b, h) (((b) * 2 + (h)) * HTB)
#define PG8_SB(b, h) ((4 + (b) * 2 + (h)) * HTB)
#define PG8_STAGE(bufoff, gbase, voff) do { _Pragma("unroll") for (int _i = 0; _i < 2; ++_i) \
        __builtin_amdgcn_global_load_lds((const unsigned*)((const char*)(gbase) + (voff)[_i]), (PG8_LAS unsigned*)(lds + (bufoff) + ldsw + _i * 8192), 16, 0, 0); } while (0)
#define PG8_LD16A(off_) (*(const PG8_LAS i32x4*)(abase8 + (off_)))
#define PG8_LD16B(off_) (*(const PG8_LAS i32x4*)(bbase8 + ((off_) - 65536)))
#define PG8_LDA(dst, b, h) do { if constexpr (DT == 2) { _Pragma("unroll") for (int m = 0; m < 4; ++m) dst##8[m] = __builtin_shufflevector(PG8_LD16A(PG8_SA(b, h) + m * 2048), PG8_LD16A(PG8_SA(b, h) + m * 2048 + 1024), 0, 1, 2, 3, 4, 5, 6, 7); } \
        else { _Pragma("unroll") for (int m = 0; m < 4; ++m) _Pragma("unroll") for (int k = 0; k < 2; ++k) dst[m][k] = *(const PG8_LAS bf16x8*)(lds + PG8_SA(b, h) + aoff + m * 2048 + k * 1024); } } while (0)
#define PG8_LDB(dst, b, h) do { if constexpr (DT == 2) { _Pragma("unroll") for (int n = 0; n < 2; ++n) dst##8[n] = __builtin_shufflevector(PG8_LD16B(PG8_SB(b, h) + n * 2048), PG8_LD16B(PG8_SB(b, h) + n * 2048 + 1024), 0, 1, 2, 3, 4, 5, 6, 7); } \
        else { _Pragma("unroll") for (int n = 0; n < 2; ++n) _Pragma("unroll") for (int k = 0; k < 2; ++k) dst[n][k] = *(const PG8_LAS bf16x8*)(lds + PG8_SB(b, h) + boff + n * 2048 + k * 1024); } } while (0)
#define PG8_MMA(ai, bj, At, Bt) do { __builtin_amdgcn_s_setprio(1); _Pragma("unroll") for (int m = 0; m < 4; ++m) _Pragma("unroll") for (int n = 0; n < 2; ++n) { \
        if constexpr (DT == 2) asm volatile("v_mfma_scale_f32_16x16x128_f8f6f4 %0, %1, %2, %0, %3, %4 op_sel_hi:[0,0,0]" : "+v"(acc[ai][bj][m][n]) : "v"(Bt##8[n]), "v"(At##8[m]), "v"(sclw), "v"(scla));   \
        else { _Pragma("unroll") for (int k = 0; k < 2; ++k) { \
        if constexpr (DT == 1) acc[ai][bj][m][n] = __builtin_amdgcn_mfma_f32_16x16x32_f16(__builtin_bit_cast(f16x8, Bt[n][k]), __builtin_bit_cast(f16x8, At[m][k]), acc[ai][bj][m][n], 0, 0, 0); \
        else acc[ai][bj][m][n] = __builtin_amdgcn_mfma_f32_16x16x32_bf16(Bt[n][k], At[m][k], acc[ai][bj][m][n], 0, 0, 0); } } } __builtin_amdgcn_s_setprio(0); } while (0)
#define PG8_WAIT_V(n) asm volatile("s_waitcnt vmcnt(" #n ")" ::: "memory")
#define PG8_WAIT_L(n) asm volatile("s_waitcnt lgkmcnt(" #n ")" ::: "memory")
#define PG8_BAR __builtin_amdgcn_s_barrier()
#define PG8_SCHED __builtin_amdgcn_sched_barrier(0)
    Unit cur, nxt; int ui = 0;
    if (!S.next(0, cur)) return;
    f32x4 acc[2][2][4][2];
#pragma unroll
    for (int a = 0; a < 2; ++a)
#pragma unroll
        for (int b = 0; b < 2; ++b)
#pragma unroll
            for (int m = 0; m < 4; ++m)
#pragma unroll
                for (int n = 0; n < 2; ++n) acc[a][b][m][n] = (f32x4){0.f, 0.f, 0.f, 0.f};
    const int sclw = g.wscale, scla = 127;
    unsigned abi_ = (unsigned)(uintptr_t)lds + (unsigned)aoff, bbi_ = (unsigned)(uintptr_t)lds + 65536u + (unsigned)boff; asm volatile("" : "+v"(abi_), "+v"(bbi_));
    const PG8_LAS unsigned char* abase8 = (const PG8_LAS unsigned char*)(uintptr_t)abi_; const PG8_LAS unsigned char* bbase8 = (const PG8_LAS unsigned char*)(uintptr_t)bbi_;
    bf16x8 At[4][2], B0[2][2], B1[2][2]; i32x8 At8[4], B08[2], B18[2];
    const char* cA = (const char*)g.A + (size_t)cur.pm * tstepA; const char* cB = (const char*)g.Bt + (size_t)cur.pn * tstep;
    S.a_ready(cur);
    if constexpr (SP2) {
        PG8_STAGE(PG8_SB(0, 0), cB, voffB); PG8_STAGE(PG8_SB(0, 1), cB + hstep, voffB); PG8_STAGE(PG8_SA(0, 0), cA, voffA); PG8_STAGE(PG8_SA(0, 1), cA + hstepA, voffA);
        if (wr == 1) PG8_BAR;
        PG8_WAIT_V(2); PG8_BAR;
        PG8_STAGE(PG8_SB(1, 0), cB + kstep, voffB); PG8_STAGE(PG8_SA(1, 0), cA + kstep, voffA); PG8_STAGE(PG8_SB(1, 1), cB + hstep + kstep, voffB);
        PG8_WAIT_V(6); PG8_BAR;
    } else {
        PG8_STAGE(PG8_SB(0, 0), cB, voffB); PG8_STAGE(PG8_SA(0, 0), cA, voffA); PG8_STAGE(PG8_SB(0, 1), cB + hstep, voffB); PG8_STAGE(PG8_SA(0, 1), cA + hstepA, voffA);
        if (wr == 1) PG8_BAR;
        PG8_WAIT_V(4); PG8_BAR;
        PG8_STAGE(PG8_SB(1, 0), cB + kstep, voffB); PG8_STAGE(PG8_SA(1, 0), cA + kstep, voffA); PG8_STAGE(PG8_SB(1, 1), cB + hstep + kstep, voffB);
        PG8_WAIT_V(6); PG8_BAR;
    }
    for (;;) {
        const bool has_next = S.next(ui + 1, nxt);
        const char* nA = has_next ? (const char*)g.A + (size_t)nxt.pm * tstepA : cA; const char* nB = has_next ? (const char*)g.Bt + (size_t)nxt.pn * tstep : cB;
        for (int t = 0; t < nt; t += 2) {
            const bool last = (t == nt - 2);
            const char* a1 = cA + (size_t)(t + 1) * kstep;
            const char* a2 = last ? nA : cA + (size_t)(t + 2) * kstep; const char* b2 = last ? nB : cB + (size_t)(t + 2) * kstep;
            const char* a3 = a2 + kstep; const char* b3 = b2 + kstep;
            if (last && has_next) S.a_ready(nxt);
            if constexpr (SP2) {
            PG8_LDB(B0, 0, 0); PG8_LDB(B1, 0, 1); PG8_SCHED; PG8_LDA(At, 0, 0); PG8_STAGE(PG8_SA(1, 1), a1 + hstepA, voffA);
            PG8_WAIT_V(8); PG8_WAIT_L(0); PG8_BAR; PG8_MMA(0, 0, At, B0); PG8_MMA(0, 1, At, B1); PG8_BAR; PG8_SCHED;
            PG8_LDA(At, 0, 1); PG8_STAGE(PG8_SB(0, 0), b2, voffB); PG8_STAGE(PG8_SB(0, 1), b2 + hstep, voffB); PG8_STAGE(PG8_SA(0, 0), a2, voffA);
            PG8_WAIT_V(8); PG8_WAIT_L(0); PG8_BAR; PG8_MMA(1, 0, At, B0); PG8_MMA(1, 1, At, B1); PG8_BAR; PG8_SCHED;
            PG8_LDB(B0, 1, 0); PG8_LDB(B1, 1, 1); PG8_SCHED; PG8_LDA(At, 1, 0); PG8_STAGE(PG8_SA(0, 1), a2 + hstepA, voffA);
            PG8_WAIT_V(8); PG8_WAIT_L(0); PG8_BAR; PG8_MMA(0, 0, At, B0); PG8_MMA(0, 1, At, B1); PG8_BAR; PG8_SCHED;
            PG8_LDA(At, 1, 1); PG8_STAGE(PG8_SB(1, 0), b3, voffB); PG8_STAGE(PG8_SB(1, 1), b3 + hstep, voffB); PG8_STAGE(PG8_SA(1, 0), a3, voffA);
            PG8_WAIT_V(8); PG8_WAIT_L(0); PG8_BAR; PG8_MMA(1, 0, At, B0); PG8_MMA(1, 1, At, B1); PG8_BAR; PG8_SCHED;
            } else {
            PG8_LDB(B0, 0, 0); PG8_SCHED; PG8_LDA(At, 0, 0); PG8_STAGE(PG8_SA(1, 1), a1 + hstepA, voffA);
            PG8_WAIT_L(8); PG8_BAR; PG8_WAIT_L(0); PG8_MMA(0, 0, At, B0); PG8_BAR; PG8_SCHED;
            PG8_LDB(B1, 0, 1); PG8_STAGE(PG8_SB(0, 0), b2, voffB);
            PG8_BAR; PG8_WAIT_L(0); PG8_MMA(0, 1, At, B1); PG8_BAR;
            PG8_LDA(At, 0, 1); PG8_STAGE(PG8_SA(0, 0), a2, voffA);
            PG8_BAR; PG8_WAIT_L(0); PG8_MMA(1, 0, At, B0); PG8_BAR; PG8_SCHED;
            PG8_STAGE(PG8_SB(0, 1), b2 + hstep, voffB);
            PG8_WAIT_V(6); PG8_BAR; PG8_MMA(1, 1, At, B1); PG8_BAR;
            PG8_LDB(B0, 1, 0); PG8_SCHED; PG8_LDA(At, 1, 0); PG8_STAGE(PG8_SA(0, 1), a2 + hstepA, voffA);
            PG8_WAIT_L(8); PG8_BAR; PG8_WAIT_L(0); PG8_MMA(0, 0, At, B0); PG8_BAR; PG8_SCHED;
            PG8_LDB(B1, 1, 1); PG8_STAGE(PG8_SB(1, 0), b3, voffB);
            PG8_BAR; PG8_WAIT_L(0); PG8_MMA(0, 1, At, B1); PG8_BAR;
            PG8_LDA(At, 1, 1); PG8_STAGE(PG8_SA(1, 0), a3, voffA);
            PG8_BAR; PG8_WAIT_L(0); PG8_MMA(1, 0, At, B0); PG8_BAR; PG8_SCHED;
            PG8_STAGE(PG8_SB(1, 1), b3 + hstep, voffB);
            PG8_WAIT_V(6); PG8_BAR; PG8_MMA(1, 1, At, B1); PG8_BAR;
            }
        }
        if constexpr (ALIGN_EPI) { if (wr == 0) PG8_BAR; }
        if constexpr (!Epi::AFTER_DRAIN) { E(acc, cur, wr, wc, fr, fq); S.done(cur); }
        if (!has_next) break;
#pragma unroll
        for (int a = 0; a < 2; ++a)
#pragma unroll
            for (int b = 0; b < 2; ++b)
#pragma unroll
                for (int m = 0; m < 4; ++m)
#pragma unroll
                    for (int n = 0; n < 2; ++n) acc[a][b][m][n] = (f32x4){0.f, 0.f, 0.f, 0.f};
        cur = nxt; cA = nA; cB = nB; ++ui;
        if constexpr (ALIGN_EPI) { if (wr == 1) PG8_BAR; }
    }
    PG8_WAIT_V(0);
    if constexpr (!ALIGN_EPI) { if (wr == 0) PG8_BAR; }
    PG8_BAR;
    if constexpr (Epi::AFTER_DRAIN) { E.fused(acc, cur, wr, wc, fr, fq, lds, wid, lane); S.done(cur); }
#undef PG8_SA
#undef PG8_SB
#undef PG8_STAGE
#undef PG8_LDA
#undef PG8_LD16A
#undef PG8_LD16B
#undef PG8_LDB
#undef PG8_MMA
#undef PG8_WAIT_V
#undef PG8_WAIT_L
#undef PG8_BAR
#undef PG8_SCHED
}
}

constexpr int NWAVES = 8;
constexpr int BATCH = 2, SEQ = 8192, DM = 2048, M = BATCH * SEQ;
constexpr int DIN = 8592, NU = 8704, NU1 = 4608;
constexpr int DFF = 5632, NUP = 2 * DFF, PLE_DIM = 256;
constexpr float LN_EPS = 1e-5f, RMS_EPS = 1e-6f;
constexpr float ALPHA = 1.189207115002721f;
constexpr float LOG2E = 1.4426950408889634f;
constexpr float QA_SCALE = 0.08838834764831845f * LOG2E;
constexpr float QB_SCALE = 0.07216878364870323f * LOG2E;
constexpr int U_QA = 0, U_KA = 2048, U_VA = 2176, U_QI = 2304, U_KI = 3328, U_WI = 3392, U_CQ = 3408, U_CKV = 3920, U_KPE = 4432, U_G = 4496;

constexpr size_t MiB = 1u << 20;
constexpr size_t WS_CTL = 0, CTL_ZERO_BYTES = 1 * MiB;
constexpr size_t WS_ROPE = 2 * MiB;
constexpr size_t WS_WIN = 4 * MiB;
constexpr size_t WS_WIN8 = 12 * MiB;
constexpr int NU16 = 1280, NU8 = 3328;
constexpr size_t WS_WUQ = 38 * MiB;
constexpr size_t WS_WKV = 41 * MiB;
constexpr size_t WS_WPE = 45 * MiB;
constexpr size_t WS_PB = 46 * MiB;
constexpr size_t WS_XB = 54 * MiB;
constexpr size_t WS_QA = 118 * MiB;
constexpr size_t WS_WUP = 182 * MiB, WS_WDN = 204 * MiB, WS_WPG = 215 * MiB;
constexpr size_t WS_WA = 223 * MiB, WS_WB = 227 * MiB, WS_WO = 231 * MiB, WS_WG = 235 * MiB;
constexpr size_t WS_QN = 260 * MiB;
constexpr size_t WS_XF8 = 324 * MiB;
constexpr size_t WS_MG8 = 292 * MiB;
constexpr size_t WS_KN = 356 * MiB, WS_VB = 420 * MiB;
constexpr size_t WS_G = WS_XB;
constexpr size_t WS_MT = WS_QN, WS_X1B = WS_QA, WS_PEO = WS_XB;
constexpr size_t WS_ACT = 320 * MiB;
constexpr size_t WS_X1F8 = 260 * MiB;
constexpr size_t WS_HEAD = 292 * MiB, WS_TAIL = 484 * MiB;
constexpr size_t DO_AB8 = 0 * MiB;
constexpr size_t DO_QI = 0 * MiB, DO_CQ = 32 * MiB, DO_CKV = 48 * MiB, DO_KA = 64 * MiB, DO_VA = 68 * MiB, DO_KI = 72 * MiB, DO_WI = 74 * MiB, DO_KR = 75 * MiB, DO_QR = 80 * MiB;
constexpr size_t DO_PEO = 96 * MiB;
constexpr size_t WS_END = 506 * MiB;
constexpr int CW_TMO = 0, CW_CODE = 1, CW_BAR = 4096, CW_RANK = 32768, CW_JOB = 49152;
constexpr int CW_SSQ = 65536;

constexpr int RING_OFF = 0, RING_BYTES = 131072;
constexpr int IDL_OFF = 131072;
constexpr int LDSCTL_OFF = 147456, MISC_OFF = LDSCTL_OFF + 320;
constexpr int LDS_BYTES = 148480;
static_assert(MISC_OFF + 128 <= LDS_BYTES, "LDS map");
#define GAS __attribute__((address_space(1)))
#define LAS __attribute__((address_space(3)))
typedef unsigned short bf16;
typedef unsigned v4u __attribute__((ext_vector_type(4)));
typedef float f32x4 __attribute__((ext_vector_type(4)));
typedef short bf16x8 __attribute__((ext_vector_type(8)));
typedef GAS unsigned gu32;
typedef GAS unsigned long long gu64;
#define RLX_AGENT __ATOMIC_RELAXED, __HIP_MEMORY_SCOPE_AGENT
#define LDS_WAIT() asm volatile("s_waitcnt lgkmcnt(0)" ::: "memory")
#define VM_WAIT() asm volatile("s_waitcnt vmcnt(0)" ::: "memory")
__device__ __forceinline__ unsigned long long rt() { return __builtin_amdgcn_s_memrealtime(); }
__device__ __forceinline__ unsigned f2bf(float f) { unsigned u = __builtin_bit_cast(unsigned, f); return (u + 0x7fffu + ((u >> 16) & 1u)) >> 16; }
__device__ __forceinline__ unsigned pk2(float lo, float hi) { return f2bf(lo) | (f2bf(hi) << 16); }

#define XB_TMO      128
#define XB_XCNT(j)  (256  + 64 * (j))
#define XB_XSUB(j)  (1280 + 64 * (j))
#define XB_XGEN(j)  (2304 + 64 * (j))
#define XB_TOP      3328
#define XB_TOPGEN   3392
#define XCD_BAR_WORDS 3456
#define XB_SPIN_CAP (1u << 18)

__device__ __forceinline__ unsigned xb_ld(unsigned* p)              { return __hip_atomic_load(p, __ATOMIC_RELAXED, __HIP_MEMORY_SCOPE_AGENT); }
__device__ __forceinline__ unsigned xb_add(unsigned* p, unsigned v) { return __hip_atomic_fetch_add(p, v, __ATOMIC_RELAXED, __HIP_MEMORY_SCOPE_AGENT); }
__device__ __forceinline__ unsigned xb_xcc_id() { return (unsigned)__builtin_amdgcn_s_getreg((3 << 11) | 20) & 0xFu; }
#define XB_SPIN(cond, bar) do { unsigned _sp = 0; while (cond) { __builtin_amdgcn_s_sleep(1); \
    if ((++_sp & 255u) == 0u) { if (xb_ld(&(bar)[XB_TMO])) break; if (_sp > XB_SPIN_CAP) { atomicAdd(&(bar)[XB_TMO], 1u); break; } } } } while (0)

struct XcdBarrier {
    unsigned* bar; unsigned x;
    volatile LAS unsigned* st;
};

__device__ __forceinline__ XcdBarrier xcd_barrier_post(unsigned* bar, volatile LAS unsigned* st) {
    XcdBarrier b; b.bar = bar; b.x = xb_xcc_id(); b.st = st;
    if (threadIdx.x == 0) (void)xb_add(&bar[XB_XCNT(b.x)], 1u);
    return b;
}
__device__ __forceinline__ void xcd_barrier_complete(unsigned* bar, unsigned x, unsigned& nloc, unsigned& nx) {
    const unsigned G = gridDim.x * gridDim.y * gridDim.z;
    unsigned sum, cnt, mine, sp = 0u;
    for (;;) {
        sum = 0u; cnt = 0u; mine = 0u;
#pragma unroll
        for (unsigned j = 0; j < 16; ++j) { const unsigned c = xb_ld(&bar[XB_XCNT(j)]); sum += c; cnt += (c > 0u) ? 1u : 0u; mine = (j == x) ? c : mine; }
        if (sum == G) break;
        __builtin_amdgcn_s_sleep(1);
        if ((++sp & 255u) == 0u) { if (xb_ld(&bar[XB_TMO])) break; if (sp > XB_SPIN_CAP) { atomicAdd(&bar[XB_TMO], 1u); break; } }
    }
    nloc = mine > 0u ? mine : 1u; nx = cnt > 0u ? cnt : 1u;
}

__device__ __forceinline__ void xcd_barrier(const XcdBarrier& b) {
    asm volatile("s_waitcnt vmcnt(0)" ::: "memory");
    __syncthreads();
    if (threadIdx.x == 0) {
        unsigned* bar = b.bar;
        __builtin_amdgcn_s_waitcnt(0);
        unsigned nloc = b.st[0], nx = b.st[1];
        if (nloc == 0u) { xcd_barrier_complete(bar, b.x, nloc, nx); b.st[0] = nloc; b.st[1] = nx; }
        const unsigned old = xb_add(&bar[XB_XSUB(b.x)], 1u);
        const unsigned gen = old / nloc;
        if (old + 1u == (gen + 1u) * nloc) {
            __builtin_amdgcn_fence(__ATOMIC_RELEASE, "agent");
            asm volatile("s_waitcnt vmcnt(0)" ::: "memory");
            const unsigned og = xb_add(&bar[XB_TOP], 1u);
            const unsigned tg = og / nx;
            if (og + 1u == (tg + 1u) * nx) xb_add(&bar[XB_TOPGEN], 1u);
            else XB_SPIN(xb_ld(&bar[XB_TOPGEN]) == tg, bar);
            __builtin_amdgcn_fence(__ATOMIC_ACQUIRE, "agent");
            xb_add(&bar[XB_XGEN(b.x)], 1u);
            asm volatile("s_waitcnt vmcnt(0)" ::: "memory");
        } else {
            XB_SPIN(xb_ld(&bar[XB_XGEN(b.x)]) == gen, bar);
            __builtin_amdgcn_fence(__ATOMIC_ACQUIRE, "agent");
            asm volatile("s_waitcnt vmcnt(0)" ::: "memory");
        }
    }
    __syncthreads();
}

typedef unsigned u32x2 __attribute__((ext_vector_type(2)));
typedef float f32x16 __attribute__((ext_vector_type(16)));
typedef short s16x4 __attribute__((ext_vector_type(4)));
using pg8::cvt_pk_bf16;
__device__ __forceinline__ v4u pack8(f32x4 a, f32x4 b) { v4u w; w.x = cvt_pk_bf16(a[0], a[1]); w.y = cvt_pk_bf16(a[2], a[3]); w.z = cvt_pk_bf16(b[0], b[1]); w.w = cvt_pk_bf16(b[2], b[3]); return w; }
__device__ __forceinline__ u32x2 pack4(f32x4 a) { u32x2 w; w.x = cvt_pk_bf16(a[0], a[1]); w.y = cvt_pk_bf16(a[2], a[3]); return w; }
__device__ __forceinline__ float bflo(unsigned u) { return __uint_as_float(u << 16); }
__device__ __forceinline__ float bfhi(unsigned u) { return __uint_as_float(u & 0xffff0000u); }
__device__ __forceinline__ void unpack8(v4u w, f32x4& a, f32x4& b) { a = (f32x4){bflo(w.x), bfhi(w.x), bflo(w.y), bfhi(w.y)}; b = (f32x4){bflo(w.z), bfhi(w.z), bflo(w.w), bfhi(w.w)}; }
typedef _Float16 f16x2 __attribute__((ext_vector_type(2)));
using pg8::f16x8;
__device__ __forceinline__ unsigned pkh(float a, float b) { const f16x2 v = {(_Float16)a, (_Float16)b}; return __builtin_bit_cast(unsigned, v); }
__device__ __forceinline__ v4u pack8h(f32x4 a, f32x4 b) { v4u w; w.x = pkh(a[0], a[1]); w.y = pkh(a[2], a[3]); w.z = pkh(b[0], b[1]); w.w = pkh(b[2], b[3]); return w; }
__device__ __forceinline__ void unpack8h(v4u w, f32x4& a, f32x4& b) { const f16x8 h = __builtin_bit_cast(f16x8, w); a = (f32x4){(float)h[0], (float)h[1], (float)h[2], (float)h[3]}; b = (f32x4){(float)h[4], (float)h[5], (float)h[6], (float)h[7]}; }
__device__ __forceinline__ unsigned pkf8(float a, float b, float c, float d) { int w = 0; w = __builtin_amdgcn_cvt_pk_fp8_f32(a, b, w, false); w = __builtin_amdgcn_cvt_pk_fp8_f32(c, d, w, true); return (unsigned)w; }
__device__ __forceinline__ float sigmoidf_(float x) { return __builtin_amdgcn_rcpf(1.0f + __builtin_amdgcn_exp2f(-LOG2E * x)); }
__device__ __forceinline__ f32x4 sigmoid4(f32x4 x) { return (f32x4){sigmoidf_(x[0]), sigmoidf_(x[1]), sigmoidf_(x[2]), sigmoidf_(x[3])}; }
__device__ __forceinline__ float sum_x16(float v) { auto r = __builtin_amdgcn_permlane16_swap(__float_as_uint(v), __float_as_uint(v), false, false); return __uint_as_float(r[0]) + __uint_as_float(r[1]); }
__device__ __forceinline__ float sum_x32(float v) { auto r = __builtin_amdgcn_permlane32_swap(__float_as_uint(v), __float_as_uint(v), false, false); return __uint_as_float(r[0]) + __uint_as_float(r[1]); }
__device__ __forceinline__ float max_x16(float v) { auto r = __builtin_amdgcn_permlane16_swap(__float_as_uint(v), __float_as_uint(v), false, false); return fmaxf(__uint_as_float(r[0]), __uint_as_float(r[1])); }
__device__ __forceinline__ float max_x32(float v) { auto r = __builtin_amdgcn_permlane32_swap(__float_as_uint(v), __float_as_uint(v), false, false); return fmaxf(__uint_as_float(r[0]), __uint_as_float(r[1])); }
template <int CTRL> __device__ __forceinline__ float dppf(float v) { return __int_as_float(__builtin_amdgcn_update_dpp(0, __float_as_int(v), CTRL, 0xf, 0xf, false)); }
__device__ __forceinline__ float wave_sum(float v) {
    v += dppf<0xB1>(v); v += dppf<0x4E>(v); v += dppf<0x141>(v); v += dppf<0x140>(v);
    return sum_x32(sum_x16(v));
}
__device__ __forceinline__ int rope_perm(int pc) { const int g = pc >> 3, e = pc & 7; return e < 4 ? 4 * g + e : 32 + 4 * g + (e - 4); }
template <int MAP> __device__ __forceinline__ int srcmap(int n) {
    if (MAP == 0) return n;
    if (MAP == 1) {
        if (n < 2048) return U_QA + n;
        if (n < 3072) return U_QI + (n - 2048);
        if (n < 3200) return U_KA + (n - 3072);
        if (n < 3328) return U_VA + (n - 3200);
        if (n < 3584) { const int o = n - 3328; if (o < 64) return U_KI + o; if (o < 128) return U_KPE + rope_perm(o - 64); if (o < 144) return U_WI + (o - 128); return -1; }
        if (n < 4096) return U_CQ + (n - 3584);
        if (n < 4608) return U_CKV + (n - 4096);
        return U_G + (n - 4608);
    }
    if (MAP == 2) {
        if (n < 2048) return (n >> 7) * 192 + (n & 127);
        const int o = n - 2048; return (o >> 6) * 192 + 128 + rope_perm(o & 63);
    }
    { const int pn = n >> 8, o = n & 255; return o < 128 ? pn * 128 + o : DFF + pn * 128 + (o - 128); }
}
constexpr int TR_LDS = 64 * 68 * 4;
__device__ __forceinline__ void tr_item(const float* W, int ldw, const float* gk, bf16* WT, int K, int k0, int drow0, int srccol4, LAS float* scr, int lane, bool h16) {
    const int c4 = (lane & 15) * 4;
#pragma unroll 8
    for (int i = 0; i < 16; ++i) { const int kk = 4 * i + (lane >> 4); f32x4 v = (f32x4){0.f, 0.f, 0.f, 0.f};
        if (srccol4 >= 0) { v = *(const GAS f32x4*)(W + (size_t)(k0 + kk) * ldw + srccol4); if (gk) v = v * gk[k0 + kk]; }
        *(LAS f32x4*)(scr + kk * 68 + c4) = v; }
    LDS_WAIT(); asm volatile("" ::: "memory");
    bf16* orow = WT + (size_t)(drow0 + lane) * K + k0;
#pragma unroll
    for (int k8 = 0; k8 < 8; ++k8) { const LAS float* s = scr + (8 * k8) * 68 + lane;
        v4u o; if (h16) { o.x = pkh(s[0 * 68], s[1 * 68]); o.y = pkh(s[2 * 68], s[3 * 68]); o.z = pkh(s[4 * 68], s[5 * 68]); o.w = pkh(s[6 * 68], s[7 * 68]); }
        else { o.x = pk2(s[0 * 68], s[1 * 68]); o.y = pk2(s[2 * 68], s[3 * 68]); o.z = pk2(s[4 * 68], s[5 * 68]); o.w = pk2(s[6 * 68], s[7 * 68]); }
        *(GAS v4u*)(orow + 8 * k8) = o; }
    LDS_WAIT(); asm volatile("" ::: "memory");
}
struct TrIn { const float *w_in, *gq, *gkv, *w_uq, *w_uk, *w_uv, *w_a, *w_b, *w_o, *w_up, *w_dn, *w_pg, *w_pe; };
struct TrItem { const float* W; const float* gk; bf16* WT; int ldw, K, k0, drow0, srccol4, mode; float wmul; };
constexpr int TR_E0 = 32 * 72, TR_E1 = TR_E0 + 8 * 48, TR_E2 = TR_E1 + 8 * 32, TR_E3 = TR_E2 + 8 * 32, TR_E4 = TR_E3 + 4 * 32, TR_E5 = TR_E4 + 1024, TR_E6 = TR_E5 + 1024, TR_E7 = TR_E6 + 1024, TR_E8 = TR_E7 + 1024,
              TR_E9 = TR_E8 + 32 * 176, TR_E10 = TR_E9 + 88 * 32, TR_E11 = TR_E10 + 32 * 64;
__device__ __forceinline__ TrItem tr_decode(const TrIn& I, unsigned char* ws, int it, int lane) {
    TrItem t; int r, nblk, map = 0; t.gk = nullptr; t.mode = 0; t.wmul = 1.f; int rowoff = 0;
    if (it < 32 * 20) { r = it; nblk = 20; t.W = I.w_in; t.ldw = DIN; t.WT = (bf16*)(ws + WS_WIN); t.K = 2048; map = 5; t.mode = 1; }
    else if (it < TR_E0) { r = it - 32 * 20; nblk = 52; t.W = I.w_in; t.ldw = DIN; t.WT = (bf16*)(ws + WS_WIN8); t.K = 2048; map = 6; t.mode = 2; t.wmul = 64.f; }
    else if (it < TR_E1) { r = it - TR_E0; nblk = 48; t.W = I.w_uq; t.ldw = 3072; t.WT = (bf16*)(ws + WS_WUQ); t.K = 512; map = 2; t.gk = I.gq; t.mode = 2; t.wmul = 32.f; }
    else if (it < TR_E2) { r = it - TR_E1; nblk = 32; t.W = I.w_uk; t.ldw = 2048; t.WT = (bf16*)(ws + WS_WKV); t.K = 512; t.gk = I.gkv; t.mode = 2; t.wmul = 32.f; }
    else if (it < TR_E3) { r = it - TR_E2; nblk = 32; t.W = I.w_uv; t.ldw = 2048; t.WT = (bf16*)(ws + WS_WKV); t.K = 512; t.gk = I.gkv; rowoff = 2048; t.mode = 2; t.wmul = 32.f; }
    else if (it < TR_E4) { r = it - TR_E3; nblk = 32; t.W = I.w_pe; t.ldw = 2048; t.WT = (bf16*)(ws + WS_WPE); t.K = 256; }
    else if (it < TR_E5) { r = it - TR_E4; nblk = 32; t.W = I.w_a; t.ldw = 2048; t.WT = (bf16*)(ws + WS_WA); t.K = 2048; t.mode = 2; t.wmul = 64.f; }
    else if (it < TR_E6) { r = it - TR_E5; nblk = 32; t.W = I.w_b; t.ldw = 2048; t.WT = (bf16*)(ws + WS_WB); t.K = 2048; t.mode = 2; t.wmul = 64.f; }
    else if (it < TR_E7) { r = it - TR_E6; nblk = 32; t.W = I.w_o; t.ldw = 2048; t.WT = (bf16*)(ws + WS_WO); t.K = 2048; t.mode = 2; t.wmul = 64.f; }
    else if (it < TR_E8) { r = it - TR_E7; nblk = 32; t.W = I.w_pg; t.ldw = 2048; t.WT = (bf16*)(ws + WS_WPG); t.K = 2048; t.mode = 2; t.wmul = 64.f; }
    else if (it < TR_E9) { r = it - TR_E8; nblk = 176; t.W = I.w_up; t.ldw = NUP; t.WT = (bf16*)(ws + WS_WUP); t.K = 2048; map = 3; t.mode = 2; t.wmul = 64.f; }
    else if (it < TR_E10) { r = it - TR_E9; nblk = 32; t.W = I.w_dn; t.ldw = 2048; t.WT = (bf16*)(ws + WS_WDN); t.K = DFF; t.mode = 2; t.wmul = 128.f; }
    else { r = it - TR_E10; nblk = 64; t.W = I.w_in; t.ldw = DIN; t.WT = (bf16*)(ws + WS_WG); t.K = 2048; map = 4; t.mode = 2; t.wmul = 64.f; }
    const int kb = r / nblk, nb = r - kb * nblk, n0 = nb * 64, nl = n0 + 4 * (lane & 15);
    t.k0 = kb * 64; t.drow0 = rowoff + n0; t.srccol4 = map == 0 ? nl : map == 5 ? srcmap<1>(nl < 1024 ? 2048 + nl : 2304 + nl) : map == 6 ? srcmap<1>(nl < 2048 ? nl : nl < 2304 ? 1024 + nl : 1280 + nl) : map == 2 ? srcmap<2>(nl) : map == 3 ? srcmap<3>(nl) : U_G + nl;
    return t;
}
__device__ __forceinline__ void tr_load(const TrItem& t, f32x4 (&v)[16], int lane) {
#pragma unroll
    for (int i = 0; i < 16; ++i) { const int kk = 4 * i + (lane >> 4); v[i] = (f32x4){0.f, 0.f, 0.f, 0.f};
        if (t.srccol4 >= 0) { v[i] = *(const GAS f32x4*)(t.W + (size_t)(t.k0 + kk) * t.ldw + t.srccol4); if (t.gk) v[i] = v[i] * t.gk[t.k0 + kk]; } }
}
__device__ __forceinline__ void tr_all(const TrIn& I, unsigned char* ws, LAS float* scr, int gw, int NGW, int lane) {
    int it = gw; if (it >= TR_E11) return;
    TrItem cur = tr_decode(I, ws, it, lane); f32x4 v[16]; tr_load(cur, v, lane);
    for (;;) {
        const int c4 = (lane & 15) * 4;
#pragma unroll
        for (int i = 0; i < 16; ++i) *(LAS f32x4*)(scr + (4 * i + (lane >> 4)) * 68 + c4) = v[i];
        LDS_WAIT(); asm volatile("" ::: "memory");
        const int itn = it + NGW; const bool more = itn < TR_E11; TrItem nxt = cur;
        if (more) { nxt = tr_decode(I, ws, itn, lane); tr_load(nxt, v, lane); }
        if (cur.mode == 2) { unsigned char* orow = (unsigned char*)cur.WT + (size_t)(cur.drow0 + lane) * cur.K + cur.k0; const float wm = cur.wmul;
#pragma unroll
            for (int k16 = 0; k16 < 4; ++k16) { const LAS float* s = scr + (16 * k16) * 68 + lane; v4u o;
                o.x = pkf8(s[0 * 68] * wm, s[1 * 68] * wm, s[2 * 68] * wm, s[3 * 68] * wm); o.y = pkf8(s[4 * 68] * wm, s[5 * 68] * wm, s[6 * 68] * wm, s[7 * 68] * wm);
                o.z = pkf8(s[8 * 68] * wm, s[9 * 68] * wm, s[10 * 68] * wm, s[11 * 68] * wm); o.w = pkf8(s[12 * 68] * wm, s[13 * 68] * wm, s[14 * 68] * wm, s[15 * 68] * wm);
                *(GAS v4u*)(orow + 16 * k16) = o; } }
        else { bf16* orow = cur.WT + (size_t)(cur.drow0 + lane) * cur.K + cur.k0;
#pragma unroll
        for (int k8 = 0; k8 < 8; ++k8) { const LAS float* s = scr + (8 * k8) * 68 + lane;
            v4u o; if (cur.mode == 1) { o.x = pkh(s[0 * 68], s[1 * 68]); o.y = pkh(s[2 * 68], s[3 * 68]); o.z = pkh(s[4 * 68], s[5 * 68]); o.w = pkh(s[6 * 68], s[7 * 68]); }
            else { o.x = pk2(s[0 * 68], s[1 * 68]); o.y = pk2(s[2 * 68], s[3 * 68]); o.z = pk2(s[4 * 68], s[5 * 68]); o.w = pk2(s[6 * 68], s[7 * 68]); }
            *(GAS v4u*)(orow + 8 * k8) = o; } }
        LDS_WAIT(); asm volatile("" ::: "memory");
        if (!more) break;
        cur = nxt; it = itn;
    }
}
__device__ __forceinline__ void cvt_flat_h(const float* src, bf16* dst, unsigned char* dst8, size_t n8, size_t gt, size_t NT) {
    for (size_t i = gt; i < n8; i += 4 * NT) { f32x4 a[4], b[4];
#pragma unroll
        for (int u = 0; u < 4; ++u) { a[u] = *(const GAS f32x4*)(src + (i + u * NT) * 8); b[u] = *(const GAS f32x4*)(src + (i + u * NT) * 8 + 4); }
#pragma unroll
        for (int u = 0; u < 4; ++u) { *(GAS v4u*)(dst + (i + u * NT) * 8) = pack8h(a[u], b[u]);
            u32x2 w; w.x = pkf8(a[u][0], a[u][1], a[u][2], a[u][3]); w.y = pkf8(b[u][0], b[u][1], b[u][2], b[u][3]); *(GAS u32x2*)(dst8 + (i + u * NT) * 8) = w; } }
}
__device__ __forceinline__ void cvt_flat(const float* src, bf16* dst, size_t n8, size_t gt, size_t NT) {
    for (size_t i = gt; i < n8; i += 4 * NT) { f32x4 a[4], b[4];
#pragma unroll
        for (int u = 0; u < 4; ++u) { a[u] = *(const GAS f32x4*)(src + (i + u * NT) * 8); b[u] = *(const GAS f32x4*)(src + (i + u * NT) * 8 + 4); }
#pragma unroll
        for (int u = 0; u < 4; ++u) *(GAS v4u*)(dst + (i + u * NT) * 8) = pack8(a[u], b[u]); }
}

typedef const pg8::f32x4 (&AccRef)[2][2][4][2];
using pg8::f32x2;
using pg8::Unit;
#define EPI_ROWS(ai, m) for (int ai = 0; ai < 2; ++ai) _Pragma("unroll") for (int m = 0; m < 4; ++m)

template <int PM> struct EpiU {
    static constexpr bool PERM = true, AFTER_DRAIN = false;
    bf16 *QA, *QI, *KA, *VA, *KI, *KR, *CQ, *CKV; float* WI; float* SSQ; const float* ROPE;
    __device__ __forceinline__ void operator()(AccRef acc, const Unit& u, int wr, int wc, int fr, int fq) const {
        { int t_ = threadIdx.x; asm volatile("" : "+v"(t_)); fr = t_ & 15; fq = (t_ >> 4) & 3; }
        const int pn = PM == 1 ? (u.pn < 8 ? u.pn : u.pn == 8 ? 12 : u.pn + 5) : (u.pn < 4 ? 8 + u.pn : 13), rowb = u.pm * 256 + wr * 64 + fr, cw = wc * 32 + 8 * fq;
        if (pn < 12) {
            bf16* base = pn < 8 ? QA : QI; const int ldc = pn < 8 ? 2048 : 1024, colt = (pn < 8 ? pn : pn - 8) * 256; const float sc = pn < 8 ? QA_SCALE : 1.f;
#pragma unroll
            EPI_ROWS(ai, m) { bf16* rp = base + (size_t)(rowb + ai * 128 + m * 16) * ldc + colt + cw;
#pragma unroll
                for (int bj = 0; bj < 2; ++bj) *(GAS v4u*)(rp + bj * 128) = pn < 8 ? pack8(acc[ai][bj][m][0] * sc, acc[ai][bj][m][1] * sc) : pack8h(acc[ai][bj][m][0], acc[ai][bj][m][1]); }
        } else if (pn == 12) {
#pragma unroll
            EPI_ROWS(ai, m) { const size_t row = rowb + ai * 128 + m * 16;
                *(GAS v4u*)(KA + row * 128 + cw) = pack8(acc[ai][0][m][0], acc[ai][0][m][1]);
                *(GAS v4u*)(VA + row * 128 + cw) = pack8(acc[ai][1][m][0], acc[ai][1][m][1]); }
        } else if (pn == 13) {
#pragma unroll
            EPI_ROWS(ai, m) { const size_t row = rowb + ai * 128 + m * 16; const int pos = (int)(row & (SEQ - 1));
                const f32x4 v0 = acc[ai][0][m][0], v1 = acc[ai][0][m][1];
                if (wc < 2) { *(GAS v4u*)(KI + (row & ~(size_t)31) * 64 + (2 * wc + (fq >> 1)) * 512 + ((fq & 1) * 32 + (int)(row & 31)) * 8) = pack8h(v0, v1); }
                else { const int g = 4 * (wc - 2) + fq; const f32x4 c4 = *(const GAS f32x4*)(ROPE + pos * 32 + 4 * g), s4 = *(const GAS f32x4*)(ROPE + SEQ * 32 + pos * 32 + 4 * g);
                    const f32x4 y1 = v0 * c4 - v1 * s4, y2 = v0 * s4 + v1 * c4; GAS unsigned char* kr8 = (GAS unsigned char*)KR + row * 64 + 4 * g;
                    *(GAS unsigned*)kr8 = pkf8(y1[0], y1[1], y1[2], y1[3]); *(GAS unsigned*)(kr8 + 32) = pkf8(y2[0], y2[1], y2[2], y2[3]); }
                if (wc == 0 && fq < 2) { *(GAS f32x4*)(WI + row * 16 + 8 * fq) = acc[ai][1][m][0]; *(GAS f32x4*)(WI + row * 16 + 8 * fq + 4) = acc[ai][1][m][1]; } }
        } else {
            const int t = pn - 14; bf16* base = t < 2 ? CQ : CKV; float* ssq = SSQ + (t < 2 ? (size_t)0 : (size_t)M * 8); const int colt = (t & 1) * 256;
#pragma unroll
            EPI_ROWS(ai, m) { const size_t row = rowb + ai * 128 + m * 16; float s = 0.f;
#pragma unroll
                for (int bj = 0; bj < 2; ++bj) { const f32x4 v0 = acc[ai][bj][m][0], v1 = acc[ai][bj][m][1];
                    { u32x2 w8; w8.x = pkf8(v0[0], v0[1], v0[2], v0[3]); w8.y = pkf8(v1[0], v1[1], v1[2], v1[3]); *(GAS u32x2*)((GAS unsigned char*)base + row * 512 + colt + bj * 128 + cw) = w8; }
                    s += (v0[0] * v0[0] + v0[1] * v0[1]) + (v0[2] * v0[2] + v0[3] * v0[3]) + (v1[0] * v1[0] + v1[1] * v1[1]) + (v1[2] * v1[2] + v1[3] * v1[3]); }
                s = sum_x32(sum_x16(s));
                if (fq == 0) ssq[row * 8 + (t & 1) * 4 + wc] = s; }
        }
    }
};
struct EpiQ {
    static constexpr bool PERM = true, AFTER_DRAIN = false;
    bf16 *QN, *QR; const float* SSQ; const float* ROPE;
    __device__ __forceinline__ void operator()(AccRef acc, const Unit& u, int wr, int wc, int fr, int fq) const {
        { int t_ = threadIdx.x; asm volatile("" : "+v"(t_)); fr = t_ & 15; fq = (t_ >> 4) & 3; }
        const int pn = u.pn, rowb = u.pm * 256 + wr * 64 + fr, cw = wc * 32 + 8 * fq;
#pragma unroll
        EPI_ROWS(ai, m) { const size_t row = rowb + ai * 128 + m * 16;
            const f32x4 sa = *(const GAS f32x4*)(SSQ + row * 8), sb = *(const GAS f32x4*)(SSQ + row * 8 + 4); const float r = (8.f * QB_SCALE) / sqrtf((((sa[0] + sa[1]) + (sa[2] + sa[3])) + ((sb[0] + sb[1]) + (sb[2] + sb[3]))) * (1.f / 512.f) + RMS_EPS);
            if (pn < 8) {
#pragma unroll
                for (int bj = 0; bj < 2; ++bj) { const f32x4 v0 = acc[ai][bj][m][0] * r, v1 = acc[ai][bj][m][1] * r; u32x2 w; w.x = pkf8(v0[0], v0[1], v0[2], v0[3]); w.y = pkf8(v1[0], v1[1], v1[2], v1[3]);
                    *(GAS u32x2*)((GAS unsigned char*)QN + row * 2048 + pn * 256 + bj * 128 + cw) = w; }
            } else { const int pos = (int)(row & (SEQ - 1)), g = 4 * (wc & 1) + fq;
                const f32x4 c4 = *(const GAS f32x4*)(ROPE + pos * 32 + 4 * g) * r, s4 = *(const GAS f32x4*)(ROPE + SEQ * 32 + pos * 32 + 4 * g) * r;
#pragma unroll
                for (int bj = 0; bj < 2; ++bj) { const int head = (pn - 8) * 4 + bj * 2 + (wc >> 1); const f32x4 v0 = acc[ai][bj][m][0], v1 = acc[ai][bj][m][1];
                    const f32x4 y1 = v0 * c4 - v1 * s4, y2 = v0 * s4 + v1 * c4; GAS unsigned char* q8 = (GAS unsigned char*)QR + row * 1024 + head * 64 + 4 * g;
                    *(GAS unsigned*)q8 = pkf8(y1[0], y1[1], y1[2], y1[3]); *(GAS unsigned*)(q8 + 32) = pkf8(y2[0], y2[1], y2[2], y2[3]); } } }
    }
};
struct EpiKV {
    static constexpr bool PERM = true, AFTER_DRAIN = false;
    bf16 *KN, *VB; const float* SSQ;
    __device__ __forceinline__ void operator()(AccRef acc, const Unit& u, int wr, int wc, int fr, int fq) const {
        { int t_ = threadIdx.x; asm volatile("" : "+v"(t_)); fr = t_ & 15; fq = (t_ >> 4) & 3; }
        const int pn = u.pn, rowb = u.pm * 256 + wr * 64 + fr, cw = wc * 32 + 8 * fq; bf16* base = pn < 8 ? KN : VB; const int colt = (pn & 7) * 256;
#pragma unroll
        EPI_ROWS(ai, m) { const size_t row = rowb + ai * 128 + m * 16; const f32x4 sa = *(const GAS f32x4*)(SSQ + row * 8), sb = *(const GAS f32x4*)(SSQ + row * 8 + 4); const float r = 1.0f / sqrtf((((sa[0] + sa[1]) + (sa[2] + sa[3])) + ((sb[0] + sb[1]) + (sb[2] + sb[3]))) * (1.f / 512.f) + RMS_EPS);
#pragma unroll
            for (int bj = 0; bj < 2; ++bj) { const f32x4 v0 = acc[ai][bj][m][0] * r, v1 = acc[ai][bj][m][1] * r;
                if (pn < 8) { u32x2 w; w.x = pkf8(v0[0], v0[1], v0[2], v0[3]); w.y = pkf8(v1[0], v1[1], v1[2], v1[3]); *(GAS u32x2*)((GAS unsigned char*)KN + row * 2048 + colt + bj * 128 + cw) = w; }
                else *(GAS v4u*)(VB + row * 2048 + colt + bj * 128 + cw) = pack8(v0, v1); } }
    }
};
__device__ __forceinline__ void unpack8f8(const u32x2 w, f32x4& a, f32x4& b) {
    const f32x2 a0 = __builtin_amdgcn_cvt_pk_f32_fp8((int)w.x, false), a1 = __builtin_amdgcn_cvt_pk_f32_fp8((int)w.x, true), b0 = __builtin_amdgcn_cvt_pk_f32_fp8((int)w.y, false), b1 = __builtin_amdgcn_cvt_pk_f32_fp8((int)w.y, true);
    a = (f32x4){a0[0], a0[1], a1[0], a1[1]}; b = (f32x4){b0[0], b0[1], b1[0], b1[1]};
}
__device__ __forceinline__ u32x2 pack8f8(const f32x4 a, const f32x4 b) { u32x2 w; w.x = pkf8(a[0], a[1], a[2], a[3]); w.y = pkf8(b[0], b[1], b[2], b[3]); return w; }
template <int MODE> struct EpiB {
    static constexpr bool PERM = true, AFTER_DRAIN = false;
    bf16* O; int ldc; const bf16* gp; const float* bias; unsigned char* O8;
    __device__ __forceinline__ void operator()(AccRef acc, const Unit& u, int wr, int wc, int fr, int fq) const {
        { int t_ = threadIdx.x; asm volatile("" : "+v"(t_)); fr = t_ & 15; fq = (t_ >> 4) & 3; }
        const int rowb = u.pm * 256 + wr * 64 + fr, colb = u.pn * 256 + wc * 32 + 8 * fq;
#pragma unroll
        EPI_ROWS(ai, m) { const size_t row = rowb + ai * 128 + m * 16;
#pragma unroll
            for (int bj = 0; bj < 2; ++bj) { const int col = colb + bj * 128; f32x4 v0 = acc[ai][bj][m][0], v1 = acc[ai][bj][m][1]; GAS unsigned char* op = (GAS unsigned char*)O + row * ldc + col;
                if (MODE == 1) { v0 = sigmoid4(v0); v1 = sigmoid4(v1); }
                if (MODE == 2 || MODE == 5) { f32x4 g0, g1; unpack8f8(*(const GAS u32x2*)((const GAS unsigned char*)gp + row * 4096 + col), g0, g1); v0 = v0 * g0; v1 = v1 * g1; }
                if (MODE == 5) { f32x4 o0, o1; unpack8f8(*(const GAS u32x2*)op, o0, o1); v0 = v0 + o0; v1 = v1 + o1; }
                if (MODE == 4) { f32x4 o0, o1; unpack8f8(*(const GAS u32x2*)op, o0, o1); const f32x4 b0 = *(const GAS f32x4*)(bias + col), b1 = *(const GAS f32x4*)(bias + col + 4);
                    v0 = sigmoid4(v0 + b0) * o0; v1 = sigmoid4(v1 + b1) * o1; }
                if (MODE == 5) *(GAS u32x2*)(O8 + row * ldc + col) = pack8f8(v0, v1);
                else *(GAS u32x2*)op = pack8f8(v0, v1); }
            if (MODE >= 2) asm volatile("" ::: "memory"); }
    }
};
template <int MODE> struct EpiF {
    static constexpr bool PERM = true, AFTER_DRAIN = false;
    bf16* zb; const float* xin; const bf16* ple;
    __device__ __forceinline__ void operator()(AccRef acc, const Unit& u, int wr, int wc, int fr, int fq) const {
        { int t_ = threadIdx.x; asm volatile("" : "+v"(t_)); fr = t_ & 15; fq = (t_ >> 4) & 3; }
        const int rowb = u.pm * 256 + wr * 64 + fr, colb = u.pn * 256 + wc * 32 + 8 * fq;
#pragma unroll
        EPI_ROWS(ai, m) { const size_t row = rowb + ai * 128 + m * 16;
#pragma unroll
            for (int bj = 0; bj < 2; ++bj) { const size_t off = row * 2048 + colb + bj * 128; f32x4 v0 = acc[ai][bj][m][0], v1 = acc[ai][bj][m][1]; f32x4 x0, x1;
                if (MODE == 0) { x0 = *(const GAS f32x4*)(xin + off); x1 = *(const GAS f32x4*)(xin + off + 4); } else unpack8(*(const GAS v4u*)(zb + off), x0, x1);
                v0 = v0 + x0 * ALPHA; v1 = v1 + x1 * ALPHA;
                if (MODE == 1) { f32x4 p0, p1; unpack8f8(*(const GAS u32x2*)((const GAS unsigned char*)ple + off), p0, p1); v0 = v0 + p0; v1 = v1 + p1; }
                *(GAS v4u*)(zb + off) = pack8(v0, v1); }
            asm volatile("" ::: "memory"); }
    }
};
template <int CTRL> __device__ __forceinline__ f32x4 dpp4(f32x4 v) { return (f32x4){dppf<CTRL>(v[0]), dppf<CTRL>(v[1]), dppf<CTRL>(v[2]), dppf<CTRL>(v[3])}; }
__device__ __forceinline__ f32x4 sel4(bool c, f32x4 a, f32x4 b) { return (f32x4){c ? a[0] : b[0], c ? a[1] : b[1], c ? a[2] : b[2], c ? a[3] : b[3]}; }
struct EpiUp {
    static constexpr bool PERM = true, AFTER_DRAIN = false;
    unsigned char* ACT; float* HEADB; float* TAILB; const float* cw; const float* cb;
    __device__ __forceinline__ void operator()(AccRef acc, const Unit& u, int wr, int wc, int fr, int fq) const {
        { int t_ = threadIdx.x; asm volatile("" : "+v"(t_)); fr = t_ & 15; fq = (t_ >> 4) & 3; }
        const unsigned ch0 = (unsigned)(u.pn * 128 + wc * 32 + 8 * fq), cp0 = (unsigned)(u.pn * 256 + wc * 32 + 8 * fq);
        const GAS unsigned char* cwb = (const GAS unsigned char*)cw; const GAS unsigned char* cbb = (const GAS unsigned char*)cb; GAS unsigned char* actb = (GAS unsigned char*)ACT;
#pragma unroll
        for (int ai = 0; ai < 2; ++ai) {
            const unsigned g = (unsigned)(u.pm * 4 + ai * 2 + wr), row0 = g * 64u + (unsigned)fr;
            if (fr < 2) { GAS unsigned char* hp = (GAS unsigned char*)HEADB + ((g * 2u + (unsigned)fr) * (unsigned)NUP + cp0) * 4u;
#pragma unroll
                for (int bj = 0; bj < 2; ++bj)
#pragma unroll
                    for (int n = 0; n < 2; ++n) *(GAS f32x4*)(hp + (bj * 128 + 4 * n) * 4) = acc[ai][bj][0][n]; }
            if (fr >= 14) { GAS unsigned char* hp = (GAS unsigned char*)TAILB + ((g * 2u + (unsigned)(fr - 14)) * (unsigned)NUP + cp0) * 4u;
#pragma unroll
                for (int bj = 0; bj < 2; ++bj)
#pragma unroll
                    for (int n = 0; n < 2; ++n) *(GAS f32x4*)(hp + (bj * 128 + 4 * n) * 4) = acc[ai][bj][3][n]; }
            asm volatile("" ::: "memory"); __builtin_amdgcn_sched_barrier(0);
#pragma unroll
            for (int n = 0; n < 2; ++n) {
                unsigned pk[4];
#pragma unroll
                for (int hf = 0; hf < 2; ++hf) {
                    asm volatile("" ::: "memory"); __builtin_amdgcn_sched_barrier(0);
                    f32x2 yg[4];
#pragma unroll
                    for (int bj = 0; bj < 2; ++bj) { const unsigned cB = (ch0 + (unsigned)(4 * n + 2 * hf + bj * DFF)) * 4u;
                        const f32x2 w0 = *(const GAS f32x2*)(cwb + cB), w1 = *(const GAS f32x2*)(cwb + (cB + (unsigned)NUP * 4u)), w2 = *(const GAS f32x2*)(cwb + (cB + (unsigned)NUP * 8u)), bb = *(const GAS f32x2*)(cbb + cB);
                        f32x2 pr1 = (f32x2){0.f, 0.f}, pr2 = pr1;
#pragma unroll
                        for (int m = 0; m < 4; ++m) { const f32x4 v4 = acc[ai][bj][m][n]; const f32x2 v = hf ? (f32x2){v4[2], v4[3]} : (f32x2){v4[0], v4[1]};
                            const f32x2 r1 = (f32x2){dppf<0x121>(v[0]), dppf<0x121>(v[1])}, r2 = (f32x2){dppf<0x122>(v[0]), dppf<0x122>(v[1])};
                            const f32x2 p1 = fr >= 1 ? r1 : pr1, p2 = fr >= 2 ? r2 : pr2;
                            const f32x2 y = bb + w2 * v + w1 * p1 + w0 * p2; pr1 = r1; pr2 = r2;
                            if (bj == 0) yg[m] = y;
                            else { const f32x2 sg = (f32x2){sigmoidf_(yg[m][0]), sigmoidf_(yg[m][1])}; const f32x2 a = yg[m] * sg * y;
                                if (hf == 0) pk[m] = (unsigned)__builtin_amdgcn_cvt_pk_fp8_f32(a[0], a[1], 0, false);
                                else { const unsigned w = (unsigned)__builtin_amdgcn_cvt_pk_fp8_f32(a[0], a[1], (int)pk[m], true); if (!(m == 0 && fr < 2)) *(GAS unsigned*)(actb + ((row0 + (unsigned)(m * 16)) * (unsigned)DFF + ch0 + (unsigned)(4 * n))) = w; } } }
                        asm volatile("" ::: "memory"); __builtin_amdgcn_sched_barrier(0); }
                }
            }
        }
    }
};

namespace dsa {
constexpr int CAP = 512, TOPK = 256;
typedef unsigned long long u64;
typedef unsigned short u16;
__device__ __forceinline__ unsigned fkey(float f) { const unsigned u = __float_as_uint(f); return u ^ ((unsigned)((int)u >> 31) | 0x80000000u); }
__device__ __forceinline__ float keyf(unsigned k) { const unsigned u = (k & 0x80000000u) ? (k ^ 0x80000000u) : ~k; return __uint_as_float(u); }
__device__ __forceinline__ int mbcnt64(u64 m) { return (int)__builtin_amdgcn_mbcnt_hi((unsigned)(m >> 32), __builtin_amdgcn_mbcnt_lo((unsigned)m, 0u)); }

__device__ __forceinline__ unsigned wave_umax(unsigned v) {
#define DSA_UDPP(c_) (unsigned)__builtin_amdgcn_update_dpp(0, (int)v, c_, 0xf, 0xf, false)
    v = max(v, DSA_UDPP(0xB1)); v = max(v, DSA_UDPP(0x4E)); v = max(v, DSA_UDPP(0x141)); v = max(v, DSA_UDPP(0x140));
#undef DSA_UDPP
    { auto r = __builtin_amdgcn_permlane16_swap(v, v, false, false); v = max(r[0], r[1]); }
    { auto r = __builtin_amdgcn_permlane32_swap(v, v, false, false); v = max(r[0], r[1]); }
    return v;
}
__device__ __forceinline__ unsigned compact(LAS u64* buf, int n, int lane, unsigned lowk, bool exact, int& nout) {
    unsigned key[8], idx[8];
#pragma unroll
    for (int e = 0; e < 8; ++e) { const int i = lane + 64 * e; u64 v = 0ull; if (i < n) v = buf[i]; key[e] = (unsigned)(v >> 32); idx[e] = (unsigned)v; }
    unsigned mx = key[0];
#pragma unroll
    for (int e = 1; e < 8; ++e) mx = max(mx, key[e]);
    mx = (unsigned)__builtin_amdgcn_readfirstlane((int)wave_umax(mx));
    const unsigned diff = lowk ^ mx; unsigned P = lowk;
    if (diff) { const int hb = 31 - __builtin_clz(diff); P = hb == 31 ? 0u : (lowk >> (hb + 1)) << (hb + 1); const int lob = exact ? 0 : (hb > 15 ? hb - 15 : 0);
#pragma unroll 1
        for (int b = hb; b >= lob; --b) { const unsigned cand = P | (1u << b); int c = 0;
#pragma unroll
            for (int e = 0; e < 8; ++e) c += __builtin_popcountll(__ballot(key[e] >= cand));
            if (c >= TOPK) { P = cand; if (c == TOPK || (!exact && c <= TOPK + 48)) break; } } }
    int cgt = 0;
#pragma unroll
    for (int e = 0; e < 8; ++e) cgt += __builtin_popcountll(__ballot(key[e] > P));
    const int need = exact ? TOPK - cgt : CAP; int base = 0, eqbase = 0;
#pragma unroll
    for (int e = 0; e < 8; ++e) { const bool gt = key[e] > P, eq = key[e] == P && key[e] != 0u; const u64 beq = __ballot(eq); const bool sel = gt || (eq && (eqbase + mbcnt64(beq)) < need);
        const u64 bs = __ballot(sel); const int pos = base + mbcnt64(bs);
        if (sel) buf[pos] = ((u64)key[e] << 32) | idx[e];
        base += __builtin_popcountll(bs); eqbase += __builtin_popcountll(beq); }
    asm volatile("s_waitcnt lgkmcnt(0)" ::: "memory");
    nout = base;
    return P;
}

struct Ptrs { const bf16 *QI, *KI, *KA, *VA; const float* WI; const bf16* QA; bf16* O; unsigned short* SEL; };

__device__ __forceinline__ void attend(const Ptrs& P, int b, int t, const LAS u16* idl, LAS unsigned char* vbuf, int lane) {
    const int head = lane & 15, g = lane >> 4; const size_t m = (size_t)b * SEQ + t;
    bf16x8 Bq[4];
#pragma unroll
    for (int ks = 0; ks < 4; ++ks) Bq[ks] = *(const GAS bf16x8*)(P.QA + m * 2048 + head * 128 + 32 * ks + 8 * g);
    const float slope2 = __builtin_amdgcn_exp2f(-0.5f * (float)(head + 1)) * LOG2E;
    const bf16* vab = P.VA + (size_t)b * SEQ * 128;
    v4u st[8];
#define DSA_VLOAD(kk) do { _Pragma("unroll") for (int u_ = 0; u_ < 8; ++u_) { const int row_ = 4 * u_ + g; unsigned s_ = idl[32 * (kk) + row_]; s_ = s_ == 0xFFFFu ? 0u : s_; \
        const int cl_ = (lane & 15) ^ ((row_ & 7) << 1); st[u_] = *(const GAS v4u*)(vab + (size_t)s_ * 128 + cl_ * 8); } } while (0)
#define DSA_VWRITE(kk) do { _Pragma("unroll") for (int u_ = 0; u_ < 8; ++u_) *(LAS v4u*)(vbuf + ((kk) & 1) * 8192 + u_ * 1024 + lane * 16) = st[u_]; } while (0)
    DSA_VLOAD(0);
    const bf16* kab = P.KA + (size_t)b * SEQ * 128 + 8 * g;
    f32x4 L[16];
    bf16x8 Af[16][4];
#define DSA_KLD(i_) do { unsigned s_ = idl[16 * (i_) + head]; s_ = s_ == 0xFFFFu ? 0u : s_; const bf16* kp_ = kab + (size_t)s_ * 128; \
        _Pragma("unroll") for (int ks = 0; ks < 4; ++ks) Af[i_][ks] = *(const GAS bf16x8*)(kp_ + 32 * ks); } while (0)
    DSA_KLD(0); __builtin_amdgcn_sched_barrier(0); DSA_KLD(1); __builtin_amdgcn_sched_barrier(0); DSA_KLD(2); __builtin_amdgcn_sched_barrier(0);
#pragma unroll
    for (int i = 0; i < 16; ++i) {
        if (i + 3 < 16) { DSA_KLD(i + 3 < 16 ? i + 3 : 15); } __builtin_amdgcn_sched_barrier(0);
        f32x4 C = (f32x4){0.f, 0.f, 0.f, 0.f};
#pragma unroll
        for (int ks = 0; ks < 4; ++ks) C = __builtin_amdgcn_mfma_f32_16x16x32_bf16(Af[i][ks], Bq[ks], C, 0, 0, 0);
        const u32x2 idw = *(const LAS u32x2*)(idl + 16 * i + 4 * g);
        const unsigned i0 = idw.x & 0xffffu, i1 = idw.x >> 16, i2 = idw.y & 0xffffu, i3 = idw.y >> 16;
        L[i][0] = i0 == 0xFFFFu ? -__builtin_inff() : C[0] - slope2 * (float)(t - (int)i0);
        L[i][1] = i1 == 0xFFFFu ? -__builtin_inff() : C[1] - slope2 * (float)(t - (int)i1);
        L[i][2] = i2 == 0xFFFFu ? -__builtin_inff() : C[2] - slope2 * (float)(t - (int)i2);
        L[i][3] = i3 == 0xFFFFu ? -__builtin_inff() : C[3] - slope2 * (float)(t - (int)i3);
        __builtin_amdgcn_sched_barrier(0);
    }
#undef DSA_KLD
    float mx = -__builtin_inff();
#pragma unroll
    for (int i = 0; i < 16; ++i) mx = fmaxf(fmaxf(mx, fmaxf(L[i][0], L[i][1])), fmaxf(L[i][2], L[i][3]));
    mx = max_x32(max_x16(mx));
    float sum = 0.f;
#pragma unroll
    for (int i = 0; i < 16; ++i) {
#pragma unroll
        for (int r = 0; r < 4; ++r) { const float p = __builtin_amdgcn_exp2f(L[i][r] - mx); L[i][r] = p; sum += p; } }
    sum = sum_x32(sum_x16(sum));
    f32x4 O[8];
#pragma unroll
    for (int dt = 0; dt < 8; ++dt) O[dt] = (f32x4){0.f, 0.f, 0.f, 0.f};
    DSA_VWRITE(0); DSA_VLOAD(1);
    const int q4 = (lane >> 2) & 3, p4 = lane & 3, row1 = 4 * g + q4;
#pragma unroll
    for (int kk = 0; kk < 8; ++kk) {
        const v4u pw = pack8(L[2 * kk], L[2 * kk + 1]); const bf16x8 Pf = __builtin_bit_cast(bf16x8, pw);
        const LAS unsigned char* vb = vbuf + (kk & 1) * 8192 + row1 * 256 + 8 * p4;
        s16x4 lo[8], hi2[8];
#pragma unroll
        for (int dt = 0; dt < 8; ++dt) { const LAS unsigned char* a1 = vb + ((dt ^ (row1 & 7)) << 5);
            lo[dt] = __builtin_bit_cast(s16x4, __builtin_amdgcn_ds_read_tr16_b64_v4i16((LAS s16x4*)a1));
            hi2[dt] = __builtin_bit_cast(s16x4, __builtin_amdgcn_ds_read_tr16_b64_v4i16((LAS s16x4*)(a1 + 4096))); }
#pragma unroll
        for (int dt = 0; dt < 8; ++dt) {
            const bf16x8 Av = (bf16x8){lo[dt][0], lo[dt][1], lo[dt][2], lo[dt][3], hi2[dt][0], hi2[dt][1], hi2[dt][2], hi2[dt][3]};
            O[dt] = __builtin_amdgcn_mfma_f32_16x16x32_bf16(Av, Pf, O[dt], 0, 0, 0); }
        if (kk + 1 < 8) { DSA_VWRITE(kk + 1); if (kk + 2 < 8) DSA_VLOAD(kk + 2); }
    }
#undef DSA_VLOAD
#undef DSA_VWRITE
    const float inv = 1.0f / sum;
    unsigned char* op = (unsigned char*)P.O + m * 4096 + head * 128 + 4 * g;
#pragma unroll
    for (int dt = 0; dt < 8; ++dt) { const f32x4 o = O[dt] * inv; *(GAS unsigned*)(op + 16 * dt) = pkf8(o[0], o[1], o[2], o[3]); }
}

__device__ __forceinline__ void job(const Ptrs& P, int b, int t0, LAS unsigned char* wl, LAS u16* idl, int lane, volatile LAS unsigned* dbgp = nullptr) {
#if defined(DBG_SPIN)
    unsigned long long tcomp = 0ull, tatt = 0ull; const unsigned long long tj0 = __builtin_amdgcn_s_memrealtime();
#endif
    const int r32 = lane & 31, hi = lane >> 5;
    const int qsel = (r32 >> 2) & 1, headA = (r32 & 3) + 4 * (r32 >> 3);
    bf16x8 A[2][4]; float sg[2][16];
#pragma unroll
    for (int a = 0; a < 2; ++a) {
        const size_t mA = (size_t)b * SEQ + t0 + 2 * a + qsel; const float aw = P.WI[mA * 16 + headA];
#pragma unroll
        for (int d0 = 0; d0 < 4; ++d0) { f32x4 x0, x1; unpack8h(*(const GAS v4u*)(P.QI + mA * 1024 + headA * 64 + 16 * d0 + 8 * hi), x0, x1); A[a][d0] = __builtin_bit_cast(bf16x8, pack8h(x0 * aw, x1 * aw)); }
        const size_t mC = (size_t)b * SEQ + t0 + 2 * a + hi;
#pragma unroll
        for (int r4 = 0; r4 < 4; ++r4) { const f32x4 w4 = *(const GAS f32x4*)(P.WI + mC * 16 + 4 * r4);
#pragma unroll
            for (int j = 0; j < 4; ++j) sg[a][4 * r4 + j] = w4[j] < 0.f ? -__builtin_inff() : __builtin_inff(); }
    }
    LAS u64* cand = (LAS u64*)wl;
    int c0 = 0, c1 = 0, c2 = 0, c3 = 0; unsigned l0 = 0u, l1 = 0u, l2 = 0u, l3 = 0u; float tau0 = -__builtin_inff(), tau1 = -__builtin_inff();
    const int ntile = (t0 + 3) / 32 + 1;
    const bf16* kib = P.KI + (size_t)b * SEQ * 64 + 8 * lane;
    bf16x8 B0[4], B1[4], B2[4], B3[4];
#define DSA_LDK(B_, JN_) do { const int jn_ = (JN_) < ntile ? (JN_) : ntile - 1; _Pragma("unroll") for (int d0 = 0; d0 < 4; ++d0) B_[d0] = *(const GAS bf16x8*)(kib + (size_t)jn_ * 2048 + 512 * d0); } while (0)
    DSA_LDK(B0, 0); asm volatile("" ::: "memory"); DSA_LDK(B1, 1); asm volatile("" ::: "memory"); DSA_LDK(B2, 2); asm volatile("" ::: "memory"); DSA_LDK(B3, 3); asm volatile("" ::: "memory");
#if defined(DBG_SPIN)
#define DSA_TC0 const unsigned long long tc0 = __builtin_amdgcn_s_memrealtime();
#define DSA_TC1 tcomp += __builtin_amdgcn_s_memrealtime() - tc0;
#else
#define DSA_TC0
#define DSA_TC1
#endif
#define DSA_TILE(JT_, Bf) do { const int jt = (JT_); const int s = jt * 32 + r32; \
        f32x16 C0 = {}, C1 = {}; \
        _Pragma("unroll") for (int d0 = 0; d0 < 4; ++d0) C0 = __builtin_amdgcn_mfma_f32_32x32x16_f16(__builtin_bit_cast(f16x8, A[0][d0]), __builtin_bit_cast(f16x8, Bf[d0]), C0, 0, 0, 0); \
        _Pragma("unroll") for (int d0 = 0; d0 < 4; ++d0) C1 = __builtin_amdgcn_mfma_f32_32x32x16_f16(__builtin_bit_cast(f16x8, A[1][d0]), __builtin_bit_cast(f16x8, Bf[d0]), C1, 0, 0, 0); \
        DSA_LDK(Bf, jt + 4); \
        float scv[2]; \
        _Pragma("unroll") for (int a = 0; a < 2; ++a) { float s_ = 0.f;                                                    \
            _Pragma("unroll") for (int r = 0; r < 16; ++r) { s_ += __builtin_amdgcn_fmed3f(a == 0 ? C0[r] : C1[r], 0.f, sg[a][r]); if ((r & 3) == 3) asm volatile("" : "+v"(s_)); } \
            scv[a] = s_; } \
        _Pragma("unroll") for (int a = 0; a < 2; ++a) { \
            const float sc = scv[a]; \
            const int tq = t0 + 2 * a + hi; const float tau = a == 0 ? tau0 : tau1; \
            const bool pass = (s <= tq) && (sc > tau); \
            const u64 bal = __ballot(pass); \
            if (bal) { const unsigned blo = (unsigned)bal, bhi = (unsigned)(bal >> 32); \
                const int pre = hi ? (int)__builtin_amdgcn_mbcnt_hi(bhi, 0u) : (int)__builtin_amdgcn_mbcnt_lo(blo, 0u); \
                const int cq = a == 0 ? (hi ? c1 : c0) : (hi ? c3 : c2); \
                if (pass) cand[(2 * a + hi) * CAP + cq + pre] = ((u64)fkey(sc) << 32) | (unsigned)s; \
                if (a == 0) { c0 += __builtin_popcount(blo); c1 += __builtin_popcount(bhi); } else { c2 += __builtin_popcount(blo); c3 += __builtin_popcount(bhi); } } \
        } \
        const int lim = (jt == ntile - 1) ? TOPK : CAP - 32; \
        _Pragma("unroll 1") for (;;) { \
            const int q = c0 > lim ? 0 : c1 > lim ? 1 : c2 > lim ? 2 : c3 > lim ? 3 : -1; \
            if (q < 0) break; \
            int n = q == 0 ? c0 : q == 1 ? c1 : q == 2 ? c2 : c3; unsigned lowk = q == 0 ? l0 : q == 1 ? l1 : q == 2 ? l2 : l3; \
            asm volatile("s_waitcnt lgkmcnt(0)" ::: "memory"); \
            DSA_TC0 \
            bool ex = jt == ntile - 1; int nout; unsigned T; \
            _Pragma("unroll 1") for (;;) { T = compact(cand + q * CAP, n, lane, lowk, ex, nout); if (ex || nout <= lim) break; ex = true; n = nout; lowk = T; } \
            const float tf = keyf(T); \
            DSA_TC1 \
            if (q == 0) { c0 = nout; l0 = T; } else if (q == 1) { c1 = nout; l1 = T; } else if (q == 2) { c2 = nout; l2 = T; } else { c3 = nout; l3 = T; } \
            if ((q >> 1) == 0) { if (hi == (q & 1)) tau0 = tf; } else { if (hi == (q & 1)) tau1 = tf; } \
        } } while (0)
#pragma unroll 1
    for (int jt0 = 0; jt0 < ntile; jt0 += 4) { DSA_TILE(jt0, B0); DSA_TILE(jt0 + 1, B1); DSA_TILE(jt0 + 2, B2); DSA_TILE(jt0 + 3, B3); }
#undef DSA_TILE
#undef DSA_LDK
#undef DSA_TC0
#undef DSA_TC1
    asm volatile("s_waitcnt lgkmcnt(0)" ::: "memory");
#pragma unroll
    for (int q = 0; q < 4; ++q) { const int n = q == 0 ? c0 : q == 1 ? c1 : q == 2 ? c2 : c3;
#pragma unroll
        for (int e = 0; e < 4; ++e) { const int i = lane + 64 * e; unsigned v = 0xFFFFu; if (i < n) v = (unsigned)cand[q * CAP + i] & 0xFFFFu;
#if defined(DBG_FIXED_SEL)
            v = (t0 + q - i) >= 0 ? (unsigned)(t0 + q - i) : 0xFFFFu;
#endif
            idl[q * TOPK + i] = (u16)v; if (P.SEL) P.SEL[((size_t)b * SEQ + t0 + q) * TOPK + i] = (u16)v; } }
    asm volatile("s_waitcnt lgkmcnt(0)" ::: "memory");
#if defined(DBG_SPIN)
    const unsigned long long ta0 = __builtin_amdgcn_s_memrealtime();
#endif
#pragma unroll 1
    for (int q = 0; q < 4; ++q) attend(P, b, t0 + q, idl + q * TOPK, wl, lane);
#if defined(DBG_SPIN)
    tatt = __builtin_amdgcn_s_memrealtime() - ta0;
    if (dbgp && lane == 0) { dbgp[0] += (unsigned)tcomp; dbgp[1] += (unsigned)tatt; dbgp[2] += (unsigned)(__builtin_amdgcn_s_memrealtime() - tj0); }
#endif
}
}

namespace mla {
constexpr int NW = 8, QBLK = 32, KVBLK = 64, QB = 256;
constexpr int SHM_V = 16384, SHM_K = 8192, SHM_R = 4096;
constexpr int OFF_V = 0, OFF_K = 3 * SHM_V, OFF_R = OFF_K + 4 * SHM_K, OFF_WS = OFF_R + 4 * SHM_R, LDS_NEED = OFF_WS + NW * 64 * 4;
constexpr float THR = 8.f;
#define MLA_KSWZ(row, colB) ((row) * 256 + ((colB) ^ (((row) & 7) << 4)))
#define MLA_RSWZ(row, colB) ((row) * 128 + ((colB) ^ ((((row) >> 1) & 7) << 4)))
#define MLA_SBAR() __builtin_amdgcn_sched_barrier(0)
__device__ __forceinline__ int v_st(int k, int c) { const int kk = (k & ~0xC) | ((k & 4) << 1) | ((k & 8) >> 1); return ((kk >> 3) * 4 + (c >> 5)) * 512 + ((kk & 7) * 32 + (c & 31)) * 2; }
__device__ __forceinline__ int v_rd_base(int lane) { return ((lane & 3) << 3) | (((lane >> 2) & 3) << 6) | (((lane >> 4) & 1) << 5) | (((lane >> 5) & 1) << 8); }
constexpr int v_rd_off(int d0, int ks, int half) { return d0 * 512 + ks * 4096 + half * 2048; }
__device__ __forceinline__ int crow(int r, int hi) { return (r & 3) + 8 * (r >> 2) + 4 * hi; }
__device__ __forceinline__ unsigned cvtpk(float lo, float hi) { return pg8::cvt_pk_bf16(lo, hi); }

__device__ __forceinline__ void mask_tile(f32x16& p0, f32x16& p1, int dq) {
    const float NEG = -__builtin_inff();
#pragma unroll
    for (int r = 0; r < 16; ++r) { const int c = (r & 3) + 8 * (r >> 2);
        if (dq - c < 0) p0[r] = NEG;
        if (dq - c - 32 < 0) p1[r] = NEG; }
}
__device__ __forceinline__ void softmax_tile(f32x16& p0, f32x16& p1, float& m_reg, float& l_reg, float& alpha, bf16x8& pa0, bf16x8& pa1, bf16x8& pa2, bf16x8& pa3) {
    float pmax = p0[0];
#pragma unroll
    for (int r = 1; r < 16; ++r) pmax = fmaxf(pmax, p0[r]);
#pragma unroll
    for (int r = 0; r < 16; ++r) pmax = fmaxf(pmax, p1[r]);
    { auto rr = __builtin_amdgcn_permlane32_swap(__float_as_uint(pmax), __float_as_uint(pmax), false, false); pmax = fmaxf(__uint_as_float(rr[0]), __uint_as_float(rr[1])); }
    float mn;
    if (__builtin_expect(__all((pmax - m_reg) <= THR), 1)) { mn = m_reg; alpha = 1.f; }
    else { mn = fmaxf(m_reg, pmax); alpha = __builtin_amdgcn_exp2f(m_reg - mn); m_reg = mn; }
#pragma unroll
    for (int r = 0; r < 16; ++r) { p0[r] = __builtin_amdgcn_exp2f(p0[r] - mn); p1[r] = __builtin_amdgcn_exp2f(p1[r] - mn); }
    float ps = 0.f;
#pragma unroll
    for (int r = 0; r < 16; ++r) ps += p0[r];
#pragma unroll
    for (int r = 0; r < 16; ++r) ps += p1[r];
    { auto rr = __builtin_amdgcn_permlane32_swap(__float_as_uint(ps), __float_as_uint(ps), false, false); ps = __uint_as_float(rr[0]) + __uint_as_float(rr[1]); }
    l_reg = l_reg * alpha + ps;
#define MLA_PK4(P, B_, OUT) do { unsigned a0 = cvtpk(P[B_ + 0], P[B_ + 1]), a1 = cvtpk(P[B_ + 2], P[B_ + 3]); unsigned b0 = cvtpk(P[B_ + 4], P[B_ + 5]), b1 = cvtpk(P[B_ + 6], P[B_ + 7]); \
        auto r0 = __builtin_amdgcn_permlane32_swap(a0, b0, false, false); auto r1 = __builtin_amdgcn_permlane32_swap(a1, b1, false, false); \
        v4u w = {r0[0], r1[0], r0[1], r1[1]}; OUT = __builtin_bit_cast(bf16x8, w); } while (0)
    MLA_PK4(p0, 0, pa0); MLA_PK4(p0, 8, pa1); MLA_PK4(p1, 0, pa2); MLA_PK4(p1, 8, pa3);
#undef MLA_PK4
}
typedef int i32x8q __attribute__((ext_vector_type(8))); typedef int i32x4q __attribute__((ext_vector_type(4)));
template <int KB>
__device__ __forceinline__ void qkt(f32x16& p0, f32x16& p1, const LAS unsigned char* lds, int r32, int hi, const i32x8q* q8) {
    p0 = f32x16{}; p1 = f32x16{};
    const LAS unsigned char* kr = lds + OFF_K + KB * SHM_K + r32 * 128; const int kx = (r32 >> 1) & 7;
    const LAS unsigned char* rr = lds + OFF_R + KB * SHM_R + r32 * 64; const int rx = (r32 >> 2) & 3;
#define MLA_LD32(base_, c_, x_, step_) __builtin_shufflevector(*(const LAS i32x4q*)((base_) + ((((c_)) ^ (x_)) << 4) + (step_)), *(const LAS i32x4q*)((base_) + ((((c_) + 1) ^ (x_)) << 4) + (step_)), 0, 1, 2, 3, 4, 5, 6, 7)
#pragma unroll
    for (int j = 0; j < 2; ++j) { const int c = 4 * j + 2 * hi;
        const i32x8q a0 = MLA_LD32(kr, c, kx, 0), a1 = MLA_LD32(kr, c, kx, 32 * 128);
        p0 = __builtin_amdgcn_mfma_scale_f32_32x32x64_f8f6f4(a0, q8[j], p0, 0, 0, 0, 127, 0, 127 - 3);
        p1 = __builtin_amdgcn_mfma_scale_f32_32x32x64_f8f6f4(a1, q8[j], p1, 0, 0, 0, 127, 0, 127 - 3); }
    { const int c = 2 * hi;
        const i32x8q a0 = MLA_LD32(rr, c, rx, 0), a1 = MLA_LD32(rr, c, rx, 32 * 64);
        p0 = __builtin_amdgcn_mfma_scale_f32_32x32x64_f8f6f4(a0, q8[2], p0, 0, 0, 0, 127, 0, 127 - 3);
        p1 = __builtin_amdgcn_mfma_scale_f32_32x32x64_f8f6f4(a1, q8[2], p1, 0, 0, 0, 127, 0, 127 - 3); }
#undef MLA_LD32
}
template <int VB>
__device__ __forceinline__ void pv_tile(f32x16* o, int vb0, bf16x8 pa0, bf16x8 pa1, bf16x8 pa2, bf16x8 pa3) {
#define MLA_TRRD(dst, off) asm volatile("ds_read_b64_tr_b16 %0, %1 offset:%2" : "=&v"(dst) : "v"(vb0), "i"(off) : "memory")
#define MLA_PV_D0(d0) do { s16x4 l0, l1, l2, l3, h0, h1, h2, h3; constexpr int b_ = OFF_V + VB * SHM_V + v_rd_off(d0, 0, 0); \
        MLA_TRRD(l0, b_); MLA_TRRD(h0, b_ + 2048); MLA_TRRD(l1, b_ + 4096); MLA_TRRD(h1, b_ + 6144); MLA_TRRD(l2, b_ + 8192); MLA_TRRD(h2, b_ + 10240); MLA_TRRD(l3, b_ + 12288); MLA_TRRD(h3, b_ + 14336); \
        asm volatile("s_waitcnt lgkmcnt(0)" ::: "memory"); MLA_SBAR(); \
        o[d0] = __builtin_amdgcn_mfma_f32_32x32x16_bf16(pa0, (bf16x8){l0[0], l0[1], l0[2], l0[3], h0[0], h0[1], h0[2], h0[3]}, o[d0], 0, 0, 0); \
        o[d0] = __builtin_amdgcn_mfma_f32_32x32x16_bf16(pa1, (bf16x8){l1[0], l1[1], l1[2], l1[3], h1[0], h1[1], h1[2], h1[3]}, o[d0], 0, 0, 0); \
        o[d0] = __builtin_amdgcn_mfma_f32_32x32x16_bf16(pa2, (bf16x8){l2[0], l2[1], l2[2], l2[3], h2[0], h2[1], h2[2], h2[3]}, o[d0], 0, 0, 0); \
        o[d0] = __builtin_amdgcn_mfma_f32_32x32x16_bf16(pa3, (bf16x8){l3[0], l3[1], l3[2], l3[3], h3[0], h3[1], h3[2], h3[3]}, o[d0], 0, 0, 0); } while (0)
    MLA_PV_D0(0); MLA_PV_D0(1); MLA_PV_D0(2); MLA_PV_D0(3);
#undef MLA_PV_D0
#undef MLA_TRRD
}
struct Tensors { const bf16* QN; const bf16* QR; const bf16* KN; const bf16* KR; const bf16* VB; bf16* O; };

__device__ __forceinline__ s16x4 vtr(const LAS unsigned char* p) { return __builtin_bit_cast(s16x4, __builtin_amdgcn_ds_read_tr16_b64_v4i16((LAS s16x4*)p)); }
template <int N> __device__ __forceinline__ i32x8q kfrag(const LAS unsigned char* kr, const LAS unsigned char* rr, int hi, int kx, int rx) {
    if (N < 4) { const int c = 4 * (N >> 1) + 2 * hi; const LAS unsigned char* b_ = kr + (N & 1) * 32 * 128;
        return __builtin_shufflevector(*(const LAS i32x4q*)(b_ + ((c ^ kx) << 4)), *(const LAS i32x4q*)(b_ + (((c + 1) ^ kx) << 4)), 0, 1, 2, 3, 4, 5, 6, 7); }
    const int c = 2 * hi; const LAS unsigned char* b_ = rr + (N & 1) * 32 * 64;
    return __builtin_shufflevector(*(const LAS i32x4q*)(b_ + ((c ^ rx) << 4)), *(const LAS i32x4q*)(b_ + (((c + 1) ^ rx) << 4)), 0, 1, 2, 3, 4, 5, 6, 7);
}
__device__ __forceinline__ float rowmax(const f32x16& p0, const f32x16& p1) {
    float pmax = p0[0];
#pragma unroll
    for (int r = 1; r < 16; ++r) pmax = fmaxf(pmax, p0[r]);
#pragma unroll
    for (int r = 0; r < 16; ++r) pmax = fmaxf(pmax, p1[r]);
    auto rr = __builtin_amdgcn_permlane32_swap(__float_as_uint(pmax), __float_as_uint(pmax), false, false); return fmaxf(__uint_as_float(rr[0]), __uint_as_float(rr[1]));
}

__device__ __forceinline__ void unit(const Tensors& T, int b, int h, int qb, LAS unsigned char* lds) {
    const int tid = threadIdx.x, wid = __builtin_amdgcn_readfirstlane(tid >> 6), lane = tid & 63, r32 = lane & 31, hi = lane >> 5;
    const size_t rowq = (size_t)b * SEQ + qb * QB + wid * QBLK + r32;
    i32x8q qr[3];
    { const GAS unsigned char* qn8 = (const GAS unsigned char*)T.QN + rowq * 2048 + h * 128 + 32 * hi; const GAS unsigned char* qr8 = (const GAS unsigned char*)T.QR + rowq * 1024 + h * 64 + 32 * hi;
#pragma unroll
      for (int j = 0; j < 2; ++j) qr[j] = __builtin_shufflevector(*(const GAS i32x4q*)(qn8 + 64 * j), *(const GAS i32x4q*)(qn8 + 64 * j + 16), 0, 1, 2, 3, 4, 5, 6, 7);
      qr[2] = __builtin_shufflevector(*(const GAS i32x4q*)qr8, *(const GAS i32x4q*)(qr8 + 16), 0, 1, 2, 3, 4, 5, 6, 7); }
    const int NT = 4 * (qb + 1);
    const int qlo = qb * QB + wid * QBLK, qm = qlo + r32 - 4 * hi;
    LAS float* ws = (LAS float*)(lds + OFF_WS) + wid * 64; LAS float* li_l = ws; LAS float* al_l = ws + 32;
    float mhat = 0.f, l_reg = 0.f; f32x16 o[4] = {}; bool resc = false;
    const LAS unsigned char* vp0 = lds + OFF_V + v_rd_base(lane);
    const LAS unsigned char* kr0 = lds + OFF_K + r32 * 128; const LAS unsigned char* rr0 = lds + OFF_R + r32 * 64; const int kx = (r32 >> 1) & 7, rx = (r32 >> 2) & 3;
    int voff[2], koff, roff;
#pragma unroll
    for (int i = 0; i < 2; ++i) { const int G_ = (wid + 8 * i) * 64 + lane;
        { const int st = G_ >> 5, w_ = G_ & 31, kk = (st >> 2) * 8 + (w_ >> 2), c = (st & 3) * 32 + (w_ & 3) * 8, k = (kk & ~0xC) | ((kk & 4) << 1) | ((kk & 8) >> 1); voff[i] = (k * 2048 + c) * 2; } }
    { const int G_ = wid * 64 + lane, row = G_ >> 3, slot = G_ & 7; koff = row * 2048 + 16 * (slot ^ ((row >> 1) & 7)); }
    { const int G_ = (wid & 3) * 64 + lane, row = G_ >> 2, slot = G_ & 3; roff = row * 64 + 16 * (slot ^ ((row >> 2) & 3)); }
    const unsigned char* Kh = (const unsigned char*)T.KN + (size_t)b * SEQ * 2048 + h * 128; const bf16* Vh = T.VB + (size_t)b * SEQ * 2048 + h * 128; const unsigned char* Rh = (const unsigned char*)T.KR + (size_t)b * SEQ * 64;
#define MLA_GLDS(base_, off_, dst_) do { unsigned sv_; const void* g_ = (const void*)(base_); const unsigned o_ = (unsigned)(off_); const unsigned d_ = (unsigned)__builtin_amdgcn_readfirstlane((int)(unsigned)(uintptr_t)(dst_)); \
        asm volatile("s_mov_b32 %0, m0\n\ts_mov_b32 m0, %3\n\ts_nop 0\n\tglobal_load_lds_dwordx4 %1, %2\n\ts_mov_b32 m0, %0" : "=&s"(sv_) : "v"(o_), "s"(g_), "s"(d_) : "memory"); } while (0)
#define MLA_DMA_V(k0, bf) do { _Pragma("unroll") for (int i_ = 0; i_ < 2; ++i_) MLA_GLDS((const unsigned char*)Vh + (size_t)(k0) * 4096, voff[i_], lds + OFF_V + (bf) * SHM_V + (wid + 8 * i_) * 1024); } while (0)
#define MLA_DMA_K(k0, bf) do { MLA_GLDS(Kh + (size_t)(k0) * 2048, koff, lds + OFF_K + (bf) * SHM_K + wid * 1024); \
        if (wid < 4) MLA_GLDS(Rh + (size_t)(k0) * 64, roff, lds + OFF_R + (bf) * SHM_R + wid * 1024); } while (0)
#define MLA_WAITBAR() do { asm volatile("s_waitcnt vmcnt(0)" ::: "memory"); __syncthreads(); } while (0)
#define MLA_WAITBAR_C() do { if (wid < 4) asm volatile("s_waitcnt vmcnt(4)" ::: "memory"); else asm volatile("s_waitcnt vmcnt(3)" ::: "memory"); __syncthreads(); } while (0)
#define MLA_PIN(x) asm volatile("" : "+v"(x))
#define MLA_RESC() do { if (resc) { _Pragma("unroll") for (int d_ = 0; d_ < 4; ++d_) _Pragma("unroll") for (int r = 0; r < 16; ++r) o[d_][r] *= al_l[crow(r, hi)]; } } while (0)
#define MLA_QMF(C_, a_, j_, I_) C_ = __builtin_amdgcn_mfma_scale_f32_32x32x64_f8f6f4(a_, qr[j_], I_, 0, 0, 0, 127, 0, 127 - 3)
#define MLA_KF(N_) kfrag<N_>(kr_, rr_, hi, kx, rx)
#define MLA_PK4(P, B_, OUT) do { unsigned a0 = cvtpk(P[B_ + 0], P[B_ + 1]), a1 = cvtpk(P[B_ + 2], P[B_ + 3]); unsigned b0 = cvtpk(P[B_ + 4], P[B_ + 5]), b1 = cvtpk(P[B_ + 6], P[B_ + 7]); \
        auto r0 = __builtin_amdgcn_permlane32_swap(a0, b0, false, false); auto r1 = __builtin_amdgcn_permlane32_swap(a1, b1, false, false); \
        OUT = (v4u){r0[0], r1[0], r0[1], r1[1]}; } while (0)
#define MLA_S2(P, i) do { sa0 += P[i]; sa1 += P[(i) + 1]; } while (0)
#define MLA_EX2S(X, i) do { X[i] = __builtin_amdgcn_exp2f(X[i] - mhat); X[(i) + 1] = __builtin_amdgcn_exp2f(X[(i) + 1] - mhat); } while (0)
#define MLA_EX2(X, i) do { X[i] = __builtin_amdgcn_exp2f(X[i]); X[(i) + 1] = __builtin_amdgcn_exp2f(X[(i) + 1]); } while (0)
#define MLA_VRD(n) do { vlo[n] = vtr(vp_ + (((n) & 3) * 512 + ((n) >> 2) * 4096)); vhi[n] = vtr(vp_ + (((n) & 3) * 512 + ((n) >> 2) * 4096 + 2048)); } while (0)
#define MLA_VFR(n) (bf16x8){vlo[n][0], vlo[n][1], vlo[n][2], vlo[n][3], vhi[n][0], vhi[n][1], vhi[n][2], vhi[n][3]}
#define MLA_PAF(k) __builtin_bit_cast(bf16x8, pw##k)
#define MLA_GAPB(n, k, X, i) do { o[(n) & 3] = __builtin_amdgcn_mfma_f32_32x32x16_bf16(MLA_PAF(k), MLA_VFR(n), o[(n) & 3], 0, 0, 0); if ((n) + 2 < 16) MLA_VRD((n) + 2 < 16 ? (n) + 2 : 15); \
        MLA_EX2(X, i); MLA_PIN(X); MLA_SBAR(); } while (0)
    f32x16 pA0, pA1, pB0, pB1; v4u pw0, pw1, pw2, pw3; s16x4 vlo[16], vhi[16]; i32x8q kf0, kf1;
    int ks_cur = 0, ks_nxt = 1, ks_n2 = 2, ks_n3 = 3, vs_rd = 2, vs_mid = 0, vs_wr = 1;
#define MLA_ROT() do { const int o_ = ks_cur; ks_cur = ks_nxt; ks_nxt = ks_n2; ks_n2 = ks_n3; ks_n3 = o_; const int p_ = vs_rd; vs_rd = vs_mid; vs_mid = vs_wr; vs_wr = p_; } while (0)
    MLA_DMA_K(0, 0); MLA_DMA_K(KVBLK, 1); MLA_DMA_K(2 * KVBLK, 2); MLA_DMA_V(0, 0); MLA_WAITBAR();
    MLA_DMA_K(3 * KVBLK, 3); MLA_DMA_V(KVBLK, 1);
    qkt<0>(pA0, pA1, lds, r32, hi, qr);
    if (NT == 4) mask_tile(pA0, pA1, qm);
    mhat = rowmax(pA0, pA1);
#pragma unroll
    for (int r = 0; r < 16; r += 2) { MLA_EX2S(pA0, r); MLA_EX2S(pA1, r); }
#define MLA_SEED(X) do { const float nm_ = -mhat; _Pragma("unroll") for (int r_ = 0; r_ < 16; ++r_) X[r_] = nm_; MLA_PIN(X); } while (0)
    MLA_SEED(pB0); MLA_SEED(pB1);
    MLA_ROT();
    { const LAS unsigned char* kr_ = kr0 + ks_cur * SHM_K; const LAS unsigned char* rr_ = rr0 + ks_cur * SHM_R; kf0 = MLA_KF(0); kf1 = MLA_KF(1); }
    MLA_WAITBAR_C();
#define MLA_MX(X, i) fmaxf(fmaxf(X[i], X[(i) + 1]), fmaxf(X[(i) + 2], X[(i) + 3]))
#define MLA_PV(n, k) o[(n) & 3] = __builtin_amdgcn_mfma_f32_32x32x16_bf16(MLA_PAF(k), MLA_VFR(n), o[(n) & 3], 0, 0, 0)
#define MLA_VN(n) do { if ((n) + 4 < 16) MLA_VRD((n) + 4 < 16 ? (n) + 4 : 15); } while (0)
#define MLA_STEP(C0, C1, P0, P1, t, MASK, GK, GN) do { MLA_SBAR(); \
    const LAS unsigned char* kr_ = kr0 + ks_cur * SHM_K; const LAS unsigned char* rr_ = rr0 + ks_cur * SHM_R; const LAS unsigned char* vp_ = vp0 + vs_rd * SHM_V; \
    i32x8q kf2, kf3, kf4, kf5; \
    float sa0 = P0[0], sa1 = P0[1]; \
    MLA_QMF(C0, kf0, 0, C0); kf2 = MLA_KF(2); MLA_S2(P0, 2); MLA_S2(P0, 4); MLA_S2(P0, 6); MLA_PK4(P0, 0, pw0); MLA_PIN(pw0); MLA_PIN(sa0); MLA_PIN(sa1); MLA_SBAR(); \
    MLA_QMF(C1, kf1, 0, C1); kf3 = MLA_KF(3); MLA_S2(P0, 8); MLA_S2(P0, 10); MLA_S2(P0, 12); MLA_S2(P0, 14); MLA_PK4(P0, 8, pw1); MLA_PIN(pw1); MLA_PIN(sa0); MLA_PIN(sa1); MLA_SBAR(); \
    if (GK) MLA_DMA_K(((t) + 3) * KVBLK, ks_n3); if (GN) MLA_DMA_V(((t) + 1) * KVBLK, vs_wr); MLA_SBAR();                          \
    MLA_QMF(C0, kf2, 1, C0); kf4 = MLA_KF(4); MLA_S2(P1, 0); MLA_S2(P1, 2); MLA_S2(P1, 4); MLA_S2(P1, 6); MLA_PK4(P1, 0, pw2); MLA_PIN(pw2); MLA_PIN(sa0); MLA_PIN(sa1); MLA_SBAR(); \
    MLA_QMF(C1, kf3, 1, C1); kf5 = MLA_KF(5); MLA_VRD(0); MLA_S2(P1, 8); MLA_S2(P1, 10); MLA_S2(P1, 12); MLA_S2(P1, 14); MLA_PK4(P1, 8, pw3); MLA_PIN(pw3); MLA_PIN(sa0); MLA_PIN(sa1); MLA_SBAR(); \
    MLA_QMF(C0, kf4, 2, C0); MLA_VRD(1); MLA_VRD(2); MLA_SBAR(); \
    MLA_QMF(C1, kf5, 2, C1); MLA_VRD(3); l_reg += sa0 + sa1; MLA_SBAR(); \
      \
    MLA_PV(0, 0); MLA_VN(0); MLA_SBAR(); \
    MLA_PV(1, 0); MLA_VN(1); if (MASK) mask_tile(C0, C1, qm - (t) * KVBLK); \
    float mx0 = C0[0]; _Pragma("unroll") for (int r_ = 1; r_ < 8; ++r_) mx0 = fmaxf(mx0, C0[r_]); MLA_SBAR(); \
    MLA_PV(2, 0); MLA_VN(2); _Pragma("unroll") for (int r_ = 8; r_ < 16; ++r_) mx0 = fmaxf(mx0, C0[r_]); MLA_SBAR(); \
    MLA_PV(3, 0); MLA_VN(3); _Pragma("unroll") for (int r_ = 0; r_ < 8; ++r_) mx0 = fmaxf(mx0, C1[r_]); MLA_SBAR(); \
    MLA_PV(4, 1); MLA_VN(4); _Pragma("unroll") for (int r_ = 8; r_ < 16; ++r_) mx0 = fmaxf(mx0, C1[r_]); \
    { auto rr_x = __builtin_amdgcn_permlane32_swap(__float_as_uint(mx0), __float_as_uint(mx0), false, false); mx0 = fmaxf(__uint_as_float(rr_x[0]), __uint_as_float(rr_x[1])); } \
    { resc = false;                                                                                                      \
      if (__builtin_expect(__any(mx0 > THR), 0)) { const float dl = fmaxf(mx0, 0.f); mhat += dl;                          \
          const float f = __builtin_amdgcn_exp2f(-dl); l_reg *= f; if (hi == 0) al_l[r32] = f; resc = true;                \
          _Pragma("unroll") for (int r_ = 0; r_ < 16; ++r_) { C0[r_] -= dl; C1[r_] -= dl; } } }                          \
    MLA_SBAR(); \
    MLA_PV(5, 1);  MLA_VN(5);  MLA_EX2(C0, 0);  MLA_EX2(C0, 2);  MLA_PIN(C0); MLA_SBAR(); \
    MLA_PV(6, 1);  MLA_VN(6);  MLA_EX2(C0, 4);  MLA_EX2(C0, 6);  MLA_PIN(C0); MLA_SBAR(); \
    MLA_PV(7, 1);  MLA_VN(7);  MLA_EX2(C0, 8);  MLA_EX2(C0, 10); MLA_PIN(C0); MLA_SBAR(); \
    MLA_PV(8, 2);  MLA_VN(8);  MLA_EX2(C0, 12); MLA_EX2(C0, 14); MLA_PIN(C0); MLA_SBAR(); \
    MLA_PV(9, 2);  MLA_VN(9);  MLA_EX2(C1, 0);  MLA_EX2(C1, 2);  MLA_PIN(C1); MLA_SBAR(); \
    MLA_PV(10, 2); MLA_VN(10); MLA_EX2(C1, 4);  MLA_PIN(C1); MLA_SBAR(); \
    MLA_PV(11, 2); MLA_VN(11); MLA_EX2(C1, 6);  MLA_PIN(C1); MLA_SBAR(); \
    MLA_ROT(); \
    MLA_PV(12, 3); MLA_EX2(C1, 8);  MLA_PIN(C1); if (GN) { const LAS unsigned char* kr_ = kr0 + ks_cur * SHM_K; const LAS unsigned char* rr_ = rr0 + ks_cur * SHM_R; kf0 = MLA_KF(0); } MLA_SBAR(); \
    MLA_PV(13, 3); MLA_EX2(C1, 10); MLA_PIN(C1); if (GN) { const LAS unsigned char* kr_ = kr0 + ks_cur * SHM_K; const LAS unsigned char* rr_ = rr0 + ks_cur * SHM_R; kf1 = MLA_KF(1); } MLA_SBAR(); \
    MLA_PV(14, 3); MLA_EX2(C1, 12); MLA_PIN(C1); MLA_SEED(P0); MLA_SBAR(); \
    MLA_PV(15, 3); MLA_EX2(C1, 14); MLA_PIN(C1); MLA_SEED(P1); MLA_SBAR();                            \
    } while (0)
    int t = 1;
#pragma unroll 1
    for (; t + 5 < NT; t += 2) {
        MLA_STEP(pB0, pB1, pA0, pA1, t, false, true, true);     MLA_WAITBAR_C(); MLA_RESC();
        MLA_STEP(pA0, pA1, pB0, pB1, t + 1, false, true, true); MLA_WAITBAR_C(); MLA_RESC(); }
#pragma unroll 1
    for (; t + 1 < NT; t += 2) {
        MLA_STEP(pB0, pB1, pA0, pA1, t, true, (t + 3 < NT), true);     MLA_WAITBAR(); MLA_RESC();
        MLA_STEP(pA0, pA1, pB0, pB1, t + 1, true, (t + 4 < NT), true); MLA_WAITBAR(); MLA_RESC(); }
    MLA_STEP(pB0, pB1, pA0, pA1, NT - 1, true, false, false); MLA_WAITBAR(); MLA_RESC();
    { float sa0 = pB0[0], sa1 = pB0[1];
#pragma unroll
      for (int r = 2; r < 16; r += 2) MLA_S2(pB0, r);
#pragma unroll
      for (int r = 0; r < 16; r += 2) MLA_S2(pB1, r);
      l_reg += sa0 + sa1;
      MLA_PK4(pB0, 0, pw0); MLA_PK4(pB0, 8, pw1); MLA_PK4(pB1, 0, pw2); MLA_PK4(pB1, 8, pw3);
      const LAS unsigned char* vp_ = vp0 + vs_rd * SHM_V;
#pragma unroll
      for (int k = 0; k < 4; ++k) {
#pragma unroll
          for (int d0 = 0; d0 < 4; ++d0) { const s16x4 lo = vtr(vp_ + (d0 * 512 + k * 4096)), hh = vtr(vp_ + (d0 * 512 + k * 4096 + 2048));
              const bf16x8 vf = (bf16x8){lo[0], lo[1], lo[2], lo[3], hh[0], hh[1], hh[2], hh[3]};
              o[d0] = __builtin_amdgcn_mfma_f32_32x32x16_bf16(k == 0 ? MLA_PAF(0) : k == 1 ? MLA_PAF(1) : k == 2 ? MLA_PAF(2) : MLA_PAF(3), vf, o[d0], 0, 0, 0); } } }
    { auto rr = __builtin_amdgcn_permlane32_swap(__float_as_uint(l_reg), __float_as_uint(l_reg), false, false); l_reg = __uint_as_float(rr[0]) + __uint_as_float(rr[1]); }
    if (hi == 0) li_l[r32] = l_reg; asm volatile("s_waitcnt lgkmcnt(0)" ::: "memory");
    unsigned char* Ow = (unsigned char*)T.O + ((size_t)b * SEQ + qb * QB + wid * QBLK) * 2048 + h * 128;
    int hi_e = hi; asm volatile("" : "+v"(hi_e));
#pragma unroll
    for (int r = 0; r < 16; ++r) { const int orow = crow(r, hi_e); const float rl = __builtin_amdgcn_rcpf(li_l[orow]);
#pragma unroll
        for (int d0 = 0; d0 < 4; ++d0) { const float v = o[d0][r] * rl; const float v1 = dppf<0xB1>(v), v2 = dppf<0x4E>(v), v3 = dppf<0x1B>(v);
            if ((r32 & 3) == 0) *(GAS unsigned*)(Ow + (size_t)orow * 2048 + d0 * 32 + r32) = pkf8(v, v1, v2, v3); } }
    __syncthreads();
#undef MLA_DMA_V
#undef MLA_GLDS
#undef MLA_DMA_K
#undef MLA_WAITBAR
#undef MLA_WAITBAR_C
#undef MLA_PIN
#undef MLA_RESC
#undef MLA_QMF
#undef MLA_KF
#undef MLA_PK4
#undef MLA_S2
#undef MLA_EX2
#undef MLA_EX2S
#undef MLA_SEED
#undef MLA_VRD
#undef MLA_VFR
#undef MLA_PAF
#undef MLA_GAPB
#undef MLA_STEP
#undef MLA_ROT
#undef MLA_MX
#undef MLA_PV
#undef MLA_VN
}
}

#if defined(DBG_CHECK)
#ifndef DBG_WORD
#define DBG_WORD 0
#endif
namespace chk {
__device__ __forceinline__ float bsum(float v, LAS float* red, int tid) { red[tid] = v; __syncthreads(); for (int o = 256; o > 0; o >>= 1) { if (tid < o) red[tid] += red[tid + o]; __syncthreads(); } const float r = red[0]; __syncthreads(); return r; }
__device__ __forceinline__ float bmax(float v, LAS float* red, int tid) { red[tid] = v; __syncthreads(); for (int o = 256; o > 0; o >>= 1) { if (tid < o) red[tid] = fmaxf(red[tid], red[tid + o]); __syncthreads(); } const float r = red[0]; __syncthreads(); return r; }
__device__ __forceinline__ float bf(const bf16* p) { return __uint_as_float((unsigned)(*p) << 16); }
__device__ __forceinline__ float hf(const bf16* p) { return (float)__builtin_bit_cast(_Float16, *p); }
__device__ __forceinline__ int sample_t(int smp) { const int k = smp >> 5; const int edge[16] = {0, 1, 31, 32, 63, 64, 255, 256, 257, 511, 512, 4095, 4096, 8190, 8191, 300}; return k < 1 ? edge[smp & 15] : (int)(((unsigned)smp * 2654435761u) >> 13) & 8191; }
__device__ __forceinline__ void amax(float* w, float v) { if (v == v) atomicMax((int*)w, __float_as_int(v)); else atomicMax((int*)w, 0x7f000000); }
__device__ __forceinline__ void mla(const bf16* QN, const bf16* QR, const bf16* KN, const bf16* KR, const bf16* VB, const bf16* O, int smp, LAS float* lg, LAS float* red, LAS float* q, float* dbg, int tid) {
    const int b = smp & 1, h = (smp >> 1) & 15, t = sample_t(smp); const size_t row = (size_t)b * SEQ + t;
    if (tid < 128) q[tid] = bf(QN + row * 2048 + h * 128 + tid); else if (tid < 192) q[tid] = bf(QR + row * 1024 + h * 64 + (tid - 128));
    __syncthreads();
    float mx = -1e30f;
    for (int s = tid; s <= t; s += 512) { const bf16* kn = KN + ((size_t)b * SEQ + s) * 2048 + h * 128; const bf16* kr = KR + ((size_t)b * SEQ + s) * 64; float d = 0.f;
        for (int i = 0; i < 128; ++i) d += q[i] * bf(kn + i); for (int i = 0; i < 64; ++i) d += q[128 + i] * bf(kr + i); lg[s] = d; mx = fmaxf(mx, d); }
    mx = bmax(mx, red, tid); float sm = 0.f;
    for (int s = tid; s <= t; s += 512) { const float p = exp2f(lg[s] - mx); lg[s] = p; sm += p; }
    sm = bsum(sm, red, tid);
    float o = 0.f;
    if (tid < 128) { for (int s = 0; s <= t; ++s) o += lg[s] * bf(VB + ((size_t)b * SEQ + s) * 2048 + h * 128 + tid); o /= sm; }
    const float rms = sqrtf(bsum(tid < 128 ? o * o : 0.f, red, tid) / 128.f) + 1e-20f;
    const float e = tid < 128 ? fabsf(o - bf(O + row * 2048 + h * 128 + tid)) / rms : 0.f;
    const float em = bmax(e, red, tid);
    if (tid == 0) amax(dbg + 0, em);
    __syncthreads();
}
template <bool TRUE_SC> __device__ __forceinline__ void dsa(const float* x, const float* w_in, const bf16* QI, const bf16* KI, const float* WI, const bf16* QA, const bf16* KA, const bf16* VA, const bf16* O, const unsigned short* SEL, int smp, LAS float* sc, LAS float* red, LAS float* aux, float* dbg, int tid) {
    const int b = smp & 1, t = sample_t(smp >> 1 << 1 | 0) ; const size_t row = (size_t)b * SEQ + t;
    LAS float* qi = aux;
    LAS unsigned* sel = (LAS unsigned*)(aux + 1024);
    LAS float* pr = aux + 2048;
    LAS unsigned* cnt = (LAS unsigned*)(aux + 2048 + 4096);
    LAS float* wt = aux + 2048 + 4096 + 64;
    if (TRUE_SC) {
        for (int i = tid; i < 1024 + 16; i += 512) { const int c = i < 1024 ? U_QI + i : U_WI + (i - 1024); float d = 0.f; for (int k = 0; k < 2048; ++k) d += x[row * 2048 + k] * w_in[(size_t)k * DIN + c]; if (i < 1024) qi[i] = d; else wt[i - 1024] = d; }
        __syncthreads();
        for (int s = tid; s <= t; s += 512) { float kk[64];
#pragma unroll
            for (int c = 0; c < 64; ++c) kk[c] = 0.f;
            const float* xs = x + ((size_t)b * SEQ + s) * 2048;
            for (int k = 0; k < 2048; ++k) { const float xv = xs[k]; const float* wr = w_in + (size_t)k * DIN + U_KI;
#pragma unroll
                for (int c = 0; c < 64; ++c) kk[c] += xv * wr[c]; }
            float tot = 0.f;
#pragma unroll
            for (int hh = 0; hh < 16; ++hh) { float d = 0.f;
#pragma unroll
                for (int i = 0; i < 64; ++i) d += qi[hh * 64 + i] * kk[i];
                tot += wt[hh] * fmaxf(d, 0.f); }
            sc[s] = tot; }
    } else {
    for (int i = tid; i < 1024; i += 512) qi[i] = hf(QI + row * 1024 + i);
    __syncthreads();
    for (int s = tid; s <= t; s += 512) { const bf16* k = KI + ((size_t)b * SEQ + s) * 64; float tot = 0.f;
        for (int hh = 0; hh < 16; ++hh) { float d = 0.f; for (int i = 0; i < 64; ++i) d += qi[hh * 64 + i] * hf(k + i); tot += WI[row * 16 + hh] * fmaxf(d, 0.f); }
        sc[s] = tot; }
    }
    __syncthreads();
    const int n = t + 1, want = n < 256 ? n : 256;
    unsigned T = 0u;
    for (int bit = 31; bit >= 0; --bit) { const unsigned cand = T | (1u << bit); if (tid == 0) cnt[0] = 0u; __syncthreads(); unsigned c = 0u;
        for (int s = tid; s <= t; s += 512) c += (dsa::fkey(sc[s]) >= cand) ? 1u : 0u;
        if (c) atomicAdd((unsigned*)cnt, c); __syncthreads(); if (cnt[0] >= (unsigned)want) T = cand; __syncthreads(); }
    if (tid == 0) { cnt[0] = 0u; cnt[1] = 0u; } __syncthreads();
    { unsigned c = 0u; for (int s = tid; s <= t; s += 512) c += (dsa::fkey(sc[s]) > T) ? 1u : 0u; if (c) atomicAdd((unsigned*)cnt + 1, c); }
    __syncthreads();
    const unsigned cgt = cnt[1]; __syncthreads(); if (tid == 0) cnt[1] = 0u;
    for (int s = tid; s <= t; s += 512) { const unsigned ky = dsa::fkey(sc[s]); bool take = ky > T;
        if (ky == T) { unsigned rk = 0u; for (int s2 = 0; s2 < s; ++s2) rk += (dsa::fkey(sc[s2]) == T) ? 1u : 0u; take = cgt + rk < (unsigned)want; }
        if (take) { const unsigned p = atomicAdd((unsigned*)cnt, 1u); if (p < 256u) sel[p] = (unsigned)s; } }
    __syncthreads();
    const int nref = (int)(cnt[0] < 256u ? cnt[0] : 256u);
    if (tid < 256) sel[256 + tid] = SEL[row * 256 + tid];
    __syncthreads();
    { float miss = 0.f; if (tid < 256) { const unsigned s = sel[256 + tid]; if (s != 0xFFFFu) { bool found = false; for (int j = 0; j < nref; ++j) found |= (sel[j] == s); miss = found ? 0.f : 1.f; } }
      const float tm = bsum(miss, red, tid); if (tid == 0) { amax(dbg + 1, tm / (float)want); atomicAdd(dbg + 13, tm); } }
    for (int pass = 0; pass < 2; ++pass) {
        const int ns = pass == 0 ? nref : 256; LAS unsigned* sl = sel + pass * 256;
        for (int e = tid; e < 16 * 256; e += 512) { const int hh = e >> 8, j = e & 255; float v = -1e30f;
            if (j < ns && sl[j] != 0xFFFFu) { const unsigned s = sl[j]; const bf16* k = KA + ((size_t)b * SEQ + s) * 128; float d = 0.f; for (int i = 0; i < 128; ++i) d += bf(QA + row * 2048 + hh * 128 + i) * bf(k + i);
                v = d - exp2f(-0.5f * (float)(hh + 1)) * LOG2E * (float)(t - (int)s); }
            pr[e] = v; }
        __syncthreads();
        if (tid < 16) { float mx = -1e30f; for (int j = 0; j < 256; ++j) mx = fmaxf(mx, pr[tid * 256 + j]); float sm = 0.f; for (int j = 0; j < 256; ++j) { const float p = pr[tid * 256 + j] <= -1e29f ? 0.f : exp2f(pr[tid * 256 + j] - mx); pr[tid * 256 + j] = p; sm += p; }
            for (int j = 0; j < 256; ++j) pr[tid * 256 + j] /= sm; }
        __syncthreads();
        float e4 = 0.f, q4 = 0.f, s4 = 0.f;
        for (int e = tid; e < 2048; e += 512) { const int hh = e >> 7, d = e & 127; float o = 0.f;
            for (int j = 0; j < ns; ++j) { const unsigned s = sl[j]; if (s != 0xFFFFu) o += pr[hh * 256 + j] * bf(VA + ((size_t)b * SEQ + s) * 128 + d); }
            q4 += o * o; const float df = o - bf(O + row * 2048 + e); e4 = fmaxf(e4, fabsf(df)); s4 += df * df; }
        const float rms = sqrtf(bsum(q4, red, tid) / 2048.f) + 1e-20f; const float em = bmax(e4, red, tid); const float esq = bsum(s4, red, tid);
        if (tid == 0) { amax(dbg + (pass == 0 ? 0 : 2), em / rms); if (pass == 0) atomicAdd(dbg + 14, esq / (rms * rms * 2048.f)); }
        __syncthreads();
    }
}
__device__ __forceinline__ void p1(const float* x, const float* w_in, const bf16* QA, const bf16* QI, const bf16* KA, const bf16* VA, const bf16* KI, const float* WI, const bf16* CQ, const bf16* CKV, const bf16* KR, int smp, LAS float* xr, LAS float* red, LAS float* tru, float* dbg, int tid) {
    const size_t row = (size_t)(((unsigned)smp * 2654435761u) >> 9) % M; const int pos = (int)(row & (SEQ - 1));
    for (int i = tid; i < 2048; i += 512) xr[i] = x[row * 2048 + i];
    __syncthreads();
    for (int c = tid; c < U_G; c += 512) { float d = 0.f; for (int k = 0; k < 2048; ++k) d += xr[k] * w_in[(size_t)k * DIN + c]; tru[c] = d; }
    __syncthreads();
    for (int ty = 0; ty < 9; ++ty) {
        const int c0 = ty == 0 ? U_QA : ty == 1 ? U_QI : ty == 2 ? U_KA : ty == 3 ? U_VA : ty == 4 ? U_KI : ty == 5 ? U_WI : ty == 6 ? U_CQ : ty == 7 ? U_CKV : U_KPE;
        const int nc = ty == 0 ? 2048 : ty == 1 ? 1024 : ty == 2 ? 128 : ty == 3 ? 128 : ty == 4 ? 64 : ty == 5 ? 16 : ty == 6 ? 512 : ty == 7 ? 512 : 64;
        float q = 0.f, e = 0.f;
        for (int c = tid; c < nc; c += 512) { float tv = tru[c0 + c], sv;
            if (ty == 0) { tv *= QA_SCALE; sv = bf(QA + row * 2048 + c); } else if (ty == 1) sv = hf(QI + row * 1024 + c); else if (ty == 2) sv = bf(KA + row * 128 + c); else if (ty == 3) sv = bf(VA + row * 128 + c);
            else if (ty == 4) sv = hf(KI + row * 64 + c); else if (ty == 5) sv = WI[row * 16 + c]; else if (ty == 6) sv = bf(CQ + row * 512 + c); else if (ty == 7) sv = bf(CKV + row * 512 + c);
            else { const int i = c & 31; const float ang = (float)pos * exp2f(-(float)i * (13.287712379549449f / 32.f)), cs = cosf(ang), sn = sinf(ang); const float x1 = tru[c0 + i], x2 = tru[c0 + 32 + i]; tv = c < 32 ? x1 * cs - x2 * sn : x1 * sn + x2 * cs; sv = bf(KR + row * 64 + c); }
            q += tv * tv; e = fmaxf(e, fabsf(tv - sv)); }
        const float rms = sqrtf(bsum(q, red, tid) / (float)nc) + 1e-20f; const float em = bmax(e, red, tid) / rms;
        if (tid == 0) { amax(dbg + 3 + ty, em); amax(dbg + 12, em); }
        __syncthreads();
    }
}
__device__ __forceinline__ void p2(const bf16* CQ, const bf16* CKV, const float* gq, const float* gkv, const float* w_uq, const float* w_uk, const float* w_uv, const bf16* QN, const bf16* QR, const bf16* KN, const bf16* VB,
                                   int smp, LAS float* cr, LAS float* red, LAS float* tru, float* dbg, int tid) {
    const size_t row = (size_t)(((unsigned)smp * 2654435761u) >> 9) % M; const int pos = (int)(row & (SEQ - 1));
    for (int i = tid; i < 1024; i += 512) cr[i] = i < 512 ? bf(CQ + row * 512 + i) : bf(CKV + row * 512 + (i - 512));
    __syncthreads();
    const float ssq = bsum(cr[tid] * cr[tid], red, tid), ssk = bsum(cr[512 + tid] * cr[512 + tid], red, tid);
    const float rq = 1.f / sqrtf(ssq / 512.f + RMS_EPS), rk = 1.f / sqrtf(ssk / 512.f + RMS_EPS);
    for (int n = tid; n < 3072 + 4096; n += 512) { float d = 0.f;
        if (n < 3072) { for (int k = 0; k < 512; ++k) d += cr[k] * gq[k] * w_uq[(size_t)k * 3072 + n]; d *= rq * QB_SCALE; }
        else if (n < 3072 + 2048) { for (int k = 0; k < 512; ++k) d += cr[512 + k] * gkv[k] * w_uk[(size_t)k * 2048 + (n - 3072)]; d *= rk; }
        else { for (int k = 0; k < 512; ++k) d += cr[512 + k] * gkv[k] * w_uv[(size_t)k * 2048 + (n - 5120)]; d *= rk; }
        tru[n] = d; }
    __syncthreads();
    float q = 0.f, e = 0.f;
    for (int n = tid; n < 2048; n += 512) { const int h = n >> 7, d = n & 127; const float tv = tru[h * 192 + d]; q += tv * tv; e = fmaxf(e, fabsf(tv - bf(QN + row * 2048 + n))); }
    { const float rms = sqrtf(bsum(q, red, tid) / 2048.f) + 1e-20f; const float em = bmax(e, red, tid) / rms; if (tid == 0) { amax(dbg + 0, em); amax(dbg + 1, em); } }
    q = 0.f; e = 0.f;
    for (int n = tid; n < 1024; n += 512) { const int h = n >> 6, c = n & 63, i = c & 31; const float ang = (float)pos * exp2f(-(float)i * (13.287712379549449f / 32.f)), cs = cosf(ang), sn = sinf(ang);
        const float x1 = tru[h * 192 + 128 + i], x2 = tru[h * 192 + 160 + i], tv = c < 32 ? x1 * cs - x2 * sn : x1 * sn + x2 * cs; q += tv * tv; e = fmaxf(e, fabsf(tv - bf(QR + row * 1024 + n))); }
    { const float rms = sqrtf(bsum(q, red, tid) / 1024.f) + 1e-20f; const float em = bmax(e, red, tid) / rms; if (tid == 0) { amax(dbg + 0, em); amax(dbg + 2, em); } }
    q = 0.f; e = 0.f;
    for (int n = tid; n < 2048; n += 512) { const float tv = tru[3072 + n]; q += tv * tv; e = fmaxf(e, fabsf(tv - bf(KN + row * 2048 + n))); }
    { const float rms = sqrtf(bsum(q, red, tid) / 2048.f) + 1e-20f; const float em = bmax(e, red, tid) / rms; if (tid == 0) { amax(dbg + 0, em); amax(dbg + 3, em); } }
    q = 0.f; e = 0.f;
    for (int n = tid; n < 2048; n += 512) { const float tv = tru[5120 + n]; q += tv * tv; e = fmaxf(e, fabsf(tv - bf(VB + row * 2048 + n))); }
    { const float rms = sqrtf(bsum(q, red, tid) / 2048.f) + 1e-20f; const float em = bmax(e, red, tid) / rms; if (tid == 0) { amax(dbg + 0, em); amax(dbg + 4, em); } }
    __syncthreads();
}
__device__ __forceinline__ void gchk(const float* x, const float* w_in, const bf16* GS, const bf16* XHS, size_t row, LAS float* xr, LAS float* red, float* dbg, int tid) {
    for (int i = tid; i < 2048; i += 512) xr[i] = x[row * 2048 + i];
    __syncthreads();
    float eg = 0.f;
    for (int c = tid; c < 4096; c += 512) { float l0 = 0.f; for (int k = 0; k < 2048; ++k) l0 += xr[k] * w_in[(size_t)k * DIN + U_G + c]; eg = fmaxf(eg, fabsf(1.f / (1.f + expf(-l0)) - bf(GS + row * 4096 + c))); }
    const float egm = bmax(eg, red, tid);
    float ex = 0.f; for (int i = tid; i < 2048; i += 512) ex = fmaxf(ex, fabsf(xr[i] - hf(XHS + row * 2048 + i))); const float exm = bmax(ex, red, tid);
    int nb = 0; for (int c = tid; c < 4096; c += 512) { float l0 = 0.f; for (int k = 0; k < 2048; ++k) l0 += xr[k] * w_in[(size_t)k * DIN + U_G + c]; nb += fabsf(1.f / (1.f + expf(-l0)) - bf(GS + row * 4096 + c)) > 0.05f ? 1 : 0; }
    const float nbt = bsum((float)nb, red, tid);
    if (tid == 0) { amax(dbg + 0, egm); if (egm > 0.05f) { atomicAdd(dbg + 1, 1.0f); amax(dbg + 3, nbt); amax(dbg + 4, 4097.f - nbt); } amax(dbg + 2, exm); }
    __syncthreads();
}
__device__ __forceinline__ void mid(const float* x, const float* w_in, const float* wa, const float* wb, const float* wo, const bf16* AA, const bf16* AB, const bf16* GS, const bf16* MTS, const float* Z, size_t row, int vtag, LAS float* va, LAS float* red, LAS float* mg, float* dbg, int tid) {
    LAS float* vb = va + 2048; LAS float* xr = va + 4096;
    for (int i = tid; i < 2048; i += 512) { va[i] = bf(AA + row * 2048 + i); vb[i] = bf(AB + row * 2048 + i); xr[i] = x[row * 2048 + i]; }
    __syncthreads();
    float eg = 0.f, qm = 0.f, emt = 0.f; int cmx = -1, cmn = 1 << 20;
    for (int c = tid; c < 2048; c += 512) { float l0 = 0.f, l1 = 0.f, ma = 0.f, mb = 0.f;
        for (int k = 0; k < 2048; ++k) { const float xv = xr[k]; l0 += xv * w_in[(size_t)k * DIN + U_G + c]; l1 += xv * w_in[(size_t)k * DIN + U_G + 2048 + c]; ma += va[k] * wa[(size_t)k * 2048 + c]; mb += vb[k] * wb[(size_t)k * 2048 + c]; }
        const float g0 = 1.f / (1.f + expf(-l0)), g1 = 1.f / (1.f + expf(-l1)); mg[c] = ma * g0 + mb * g1;
        { const float e0 = fabsf(g0 - bf(GS + row * 4096 + c)), e1 = fabsf(g1 - bf(GS + row * 4096 + 2048 + c)); eg = fmaxf(eg, fmaxf(e0, e1)); if (e0 > 0.05f) { cmx = max(cmx, c); cmn = min(cmn, c); } if (e1 > 0.05f) { cmx = max(cmx, 2048 + c); cmn = min(cmn, 2048 + c); } } qm += mg[c] * mg[c]; emt = fmaxf(emt, fabsf(mg[c] - bf(MTS + row * 2048 + c))); }
    { const float egm = bmax(eg, red, tid); const float rm = sqrtf(bsum(qm, red, tid) / 2048.f) + 1e-20f; const float emm = bmax(emt, red, tid) / rm; if (tid == 0) { amax(dbg + 17, egm); amax(dbg + 18, emm); if (egm > 0.05f) { amax(dbg + 19, (float)(row & 255) + 1.0f); amax(dbg + 20, (float)(255 - (row & 255)) + 1.0f); atomicAdd(dbg + 21, 1.0f); amax(dbg + 22, (float)vtag + 1.0f); amax(dbg + 23, (float)(255 - vtag) + 1.0f); } }
      const float fx = bmax((float)cmx, red, tid), fn = bmax((float)(4096 - cmn), red, tid); if (tid == 0 && fx >= 0.f) { amax(dbg + 24, fx + 1.0f); amax(dbg + 25, fn + 1.0f); } }
    __syncthreads();
    float q = 0.f, e = 0.f;
    for (int c = tid; c < 2048; c += 512) { float d = 0.f; for (int k = 0; k < 2048; ++k) d += mg[k] * wo[(size_t)k * 2048 + c]; q += d * d; e = fmaxf(e, fabsf(ALPHA * xr[c] + d - Z[row * 2048 + c])); }
    const float rms = sqrtf(bsum(q, red, tid) / 2048.f) + 1e-20f; const float em = bmax(e, red, tid) / rms;
    if (tid == 0) { amax(dbg + 0, em); if (em > 0.25f) { atomicAdd(dbg + 13, 1.0f); amax(dbg + 15, (float)(row & 255) + 1.0f); amax(dbg + 16, (float)(row >> 8) + 1.0f); } }
    __syncthreads();
}
__device__ __forceinline__ void endp(const bf16* X1B, const float* x1f_unused, const float* p, const float* w_up, const float* cw, const float* cb, const float* w_down, const float* w_pg, const float* b_pg, const float* w_pe, const float* g2, const float* b2,
                                     const float* OUT, int smp, LAS float* xs, LAS float* red, LAS float* act, float* dbg, int tid) {
    const int k6 = smp & 7; const size_t rbase = (size_t)(((unsigned)smp * 2654435761u) >> 9) % M; const size_t row = k6 == 0 ? (rbase & ~(size_t)63) : k6 == 1 ? (rbase & ~(size_t)63) + 1 : k6 == 2 ? (rbase & ~(size_t)8191) : rbase; const int t = (int)(row & (SEQ - 1));
    LAS float* z = act + 5632; LAS float* pr = act + 5632 + 2048;
    for (int i = tid; i < 3 * 2048; i += 512) { const int j = i >> 11, c = i & 2047; const int tt = t - 2 + j; xs[i] = tt >= 0 ? bf(X1B + (row - 2 + j) * 2048 + c) : 0.f; }
    for (int i = tid; i < 256; i += 512) pr[i] = p[row * 256 + i];
    __syncthreads();
    for (int ch = tid; ch < DFF; ch += 512) { float hg[3] = {0.f, 0.f, 0.f}, hv[3] = {0.f, 0.f, 0.f};
        for (int k = 0; k < 2048; ++k) { const float wg = w_up[(size_t)k * NUP + ch], wv = w_up[(size_t)k * NUP + DFF + ch];
#pragma unroll
            for (int j = 0; j < 3; ++j) { hg[j] += xs[j * 2048 + k] * wg; hv[j] += xs[j * 2048 + k] * wv; } }
        float yg = cb[ch], yv = cb[DFF + ch];
#pragma unroll
        for (int j = 0; j < 3; ++j) { yg += cw[(size_t)j * NUP + ch] * hg[j]; yv += cw[(size_t)j * NUP + DFF + ch] * hv[j]; }
        act[ch] = yg / (1.f + expf(-yg)) * yv; }
    __syncthreads();
    for (int c = tid; c < 2048; c += 512) { float f = 0.f, lg = b_pg[c], pe = 0.f;
        for (int k = 0; k < DFF; ++k) f += act[k] * w_down[(size_t)k * 2048 + c];
        for (int k = 0; k < 2048; ++k) lg += xs[2 * 2048 + k] * w_pg[(size_t)k * 2048 + c];
        for (int k = 0; k < 256; ++k) pe += pr[k] * w_pe[(size_t)k * 2048 + c];
        z[c] = ALPHA * xs[2 * 2048 + c] + f + pe / (1.f + expf(-lg)); }
    __syncthreads();
    float s = 0.f; for (int c = tid; c < 2048; c += 512) s += z[c];
    const float mean = bsum(s, red, tid) / 2048.f; float s2 = 0.f; for (int c = tid; c < 2048; c += 512) s2 += (z[c] - mean) * (z[c] - mean);
    const float rstd = 1.f / sqrtf(bsum(s2, red, tid) / 2048.f + LN_EPS); float e = 0.f;
    for (int c = tid; c < 2048; c += 512) e = fmaxf(e, fabsf((z[c] - mean) * rstd * g2[c] + b2[c] - OUT[row * 2048 + c]));
    const float em = bmax(e, red, tid);
    if (tid == 0) { amax(dbg + 0, em); amax(dbg + 1 + (k6 < 3 ? k6 : 3), em); }
    __syncthreads();
}
}
#endif

__device__ __forceinline__ int own_panel(int x, int s) { return s < 4 ? x + 8 * s : 32 + (7 - x) + 8 * (s - 4); }
__device__ __forceinline__ void ln_pass(const bf16* zin, float* fout, bf16* bout, unsigned char* xf8, const float* g, const float* b, int vcu, int wave, int lane) {
#pragma unroll 1
    for (int s_ = 0; s_ < 8; ++s_) { const int m = 256 * own_panel(vcu >> 5, s_) + 8 * (vcu & 31) + wave;
        const GAS v4u* zr = (const GAS v4u*)(zin + (size_t)m * DM) + lane;
        f32x4 v[8]; float s = 0.f;
#pragma unroll
        for (int j = 0; j < 4; ++j) { unpack8(zr[64 * j], v[2 * j], v[2 * j + 1]); s += ((v[2 * j][0] + v[2 * j][1]) + (v[2 * j][2] + v[2 * j][3])) + ((v[2 * j + 1][0] + v[2 * j + 1][1]) + (v[2 * j + 1][2] + v[2 * j + 1][3])); }
        const float mean = wave_sum(s) * (1.f / DM); float s2 = 0.f;
#pragma unroll
        for (int j = 0; j < 8; ++j) { v[j] = v[j] - mean; s2 += (v[j][0] * v[j][0] + v[j][1] * v[j][1]) + (v[j][2] * v[j][2] + v[j][3] * v[j][3]); }
        const float rstd = 1.f / sqrtf(wave_sum(s2) * (1.f / DM) + LN_EPS);
#pragma unroll
        for (int j = 0; j < 4; ++j) { const int e0 = 8 * (lane + 64 * j);
            const f32x4 g0 = *(const GAS f32x4*)(g + e0), g1 = *(const GAS f32x4*)(g + e0 + 4), b0 = *(const GAS f32x4*)(b + e0), b1 = *(const GAS f32x4*)(b + e0 + 4);
            const f32x4 y0 = v[2 * j] * rstd * g0 + b0, y1 = v[2 * j + 1] * rstd * g1 + b1;
            if (fout) { *(GAS f32x4*)(fout + (size_t)m * DM + e0) = y0; *(GAS f32x4*)(fout + (size_t)m * DM + e0 + 4) = y1; }
            if (bout) *(GAS v4u*)(bout + (size_t)m * DM + e0) = pack8(y0, y1);
            if (xf8) { u32x2 w; w.x = pkf8(y0[0], y0[1], y0[2], y0[3]); w.y = pkf8(y1[0], y1[1], y1[2], y1[3]); *(GAS u32x2*)(xf8 + (size_t)m * DM + e0) = w; } }
    }
}
__device__ __forceinline__ void conv_fixup(unsigned char* ACT, const float* HEADB, const float* TAILB, const float* cw, const float* cb, int vcu, int tid) {
    constexpr int CH8 = DFF / 8;
    for (int it = (vcu & 31) * 512 + tid; it < 8 * 4 * 2 * CH8; it += 32 * 512) {
        const int c8 = it % CH8, rr = (it / CH8) & 1, g4 = (it / (2 * CH8)) & 3, s_ = it / (8 * CH8); const int g = own_panel(vcu >> 5, s_) * 4 + g4;
        const int ch = 8 * c8, pg = 256 * (ch >> 7) + (ch & 127); const bool first = (g & 127) == 0;
        f32x4 res[2][2];
#pragma unroll
        for (int bj = 0; bj < 2; ++bj) { const int pc = pg + bj * 128, c = ch + bj * DFF;
#pragma unroll
            for (int n = 0; n < 2; ++n) { const f32x4 z = (f32x4){0.f, 0.f, 0.f, 0.f};
                const f32x4 u0 = *(const GAS f32x4*)(HEADB + ((size_t)g * 2 + rr) * NUP + pc + 4 * n);
                const f32x4 t1 = first ? z : *(const GAS f32x4*)(TAILB + ((size_t)(g - 1) * 2 + 1) * NUP + pc + 4 * n);
                const f32x4 t0 = first ? z : *(const GAS f32x4*)(TAILB + ((size_t)(g - 1) * 2 + 0) * NUP + pc + 4 * n);
                const f32x4 h0 = *(const GAS f32x4*)(HEADB + ((size_t)g * 2 + 0) * NUP + pc + 4 * n);
                const f32x4 u1 = rr ? h0 : t1, u2 = rr ? t1 : t0;
                const f32x4 w0 = *(const GAS f32x4*)(cw + c + 4 * n), w1 = *(const GAS f32x4*)(cw + NUP + c + 4 * n), w2 = *(const GAS f32x4*)(cw + 2 * NUP + c + 4 * n), bb = *(const GAS f32x4*)(cb + c + 4 * n);
                res[bj][n] = bb + w2 * u0 + w1 * u1 + w0 * u2; } }
        const f32x4 a0 = res[0][0] * sigmoid4(res[0][0]) * res[1][0], a1 = res[0][1] * sigmoid4(res[0][1]) * res[1][1];
        { u32x2 w; w.x = pkf8(a0[0], a0[1], a0[2], a0[3]); w.y = pkf8(a1[0], a1[1], a1[2], a1[3]); *(GAS u32x2*)(ACT + ((size_t)g * 64 + rr) * DFF + ch) = w; }
    }
}

struct Args { const float* in[22]; float* out; unsigned char* ws; };
#define GEMM_PHASE_LC(EPI, A_, B_, N_, K_, E_, DT_, WS_, LDA_, C_) do { int kk_ = (K_); asm volatile("" : "+s"(kk_)); pg8::Gemm g_{(const pg8::bf16_t*)(A_), (const pg8::bf16_t*)(B_), M, (N_), kk_, (WS_), (LDA_)}; pg8::StaticOrder S_; S_.init(M, (N_), G, (C_)); \
        pg8::gemm_phase<EPI, pg8::StaticOrder, true, true, DT_>(lds, g_, S_, (E_)); } while (0)
#define GEMM_PHASE_L(EPI, A_, B_, N_, K_, E_, DT_, WS_, LDA_) do { int kk_ = (K_); asm volatile("" : "+s"(kk_)); pg8::Gemm g_{(const pg8::bf16_t*)(A_), (const pg8::bf16_t*)(B_), M, (N_), kk_, (WS_), (LDA_)}; pg8::StaticOrder S_; S_.init(M, (N_), G, bx); \
        pg8::gemm_phase<EPI, pg8::StaticOrder, true, true, DT_>(lds, g_, S_, (E_)); } while (0)
#define GEMM_PHASE_X(EPI, A_, B_, N_, K_, E_, DT_, WS_) GEMM_PHASE_L(EPI, A_, B_, N_, K_, E_, DT_, WS_, 0)
#define GEMM_PHASE_T(EPI, A_, B_, N_, K_, E_, F16_) GEMM_PHASE_X(EPI, A_, B_, N_, K_, E_, ((F16_) ? 1 : 0), 127)
#define GEMM_PHASE(EPI, A_, B_, N_, K_, E_) GEMM_PHASE_X(EPI, A_, B_, N_, K_, E_, 0, 127)

__global__ void __launch_bounds__(NWAVES * 64, 2) fwd_kernel(Args args) {
    extern __shared__ __attribute__((aligned(16))) unsigned char lds_raw[];
    LAS unsigned char* lds = (LAS unsigned char*)lds_raw;
    volatile LAS unsigned* MISC = (volatile LAS unsigned*)(lds + MISC_OFF);
    const int tid0 = threadIdx.x, wave = __builtin_amdgcn_readfirstlane(tid0 >> 6);
#define TID() ({ int t_ = threadIdx.x; asm volatile("" : "+v"(t_)); t_; })
#define LANE() (TID() & 63)
#define GT() ((size_t)bx * (NWAVES * 64) + TID())
    for (int u = threadIdx.x; u < (LDS_BYTES - LDSCTL_OFF) / 4; u += NWAVES * 64) ((LAS unsigned*)(lds + LDSCTL_OFF))[u] = 0u;
    __syncthreads();
    if (threadIdx.x == 0) { const unsigned xcc = xb_xcc_id() & 7u; const unsigned rk = __hip_atomic_fetch_add((gu32*)(args.ws + WS_CTL) + CW_RANK + 64 * xcc, 1u, RLX_AGENT); MISC[12] = (rk & 31u) * 8u + xcc; }
    __syncthreads();
    const int G = gridDim.x, bx = __builtin_amdgcn_readfirstlane((int)MISC[12]), vcu = (bx % 8) * (G / 8) + bx / 8;
    const int gw = vcu * NWAVES + wave, NGW = G * NWAVES; const size_t NT = (size_t)G * NWAVES * 64;
#define WSP(T_, off_) ((T_*)(wsb() + (off_)))
#define INP(k_) inb(k_)
#define DOP(T_, off_) ((T_*)((unsigned char*)outb() + (off_)))
    auto wsb = [&]() __attribute__((always_inline)) { unsigned char* w_ = args.ws; asm volatile("" : "+s"(w_)); return w_; };
    auto inb = [&](int k_) __attribute__((always_inline)) { const float* p_ = args.in[k_]; asm volatile("" : "+s"(p_)); return p_; };
    auto outb = [&]() __attribute__((always_inline)) { float* p_ = args.out; asm volatile("" : "+s"(p_)); return p_; };

    XcdBarrier bar = xcd_barrier_post((unsigned*)((gu32*)(args.ws + WS_CTL) + CW_BAR), MISC + 8);
#if defined(DBG_CKPT)
#define CKPT(id_, lo_, hi_) do { if (DBG_CKPT == (id_)) { unsigned* cw_ = WSP(unsigned, WS_CTL) + 200100; const unsigned* p_ = (const unsigned*)(wsb() + (size_t)(lo_) * MiB); unsigned c_ = 0u; \
        for (size_t i = GT(); i < (size_t)((hi_) - (lo_)) * MiB / 4; i += NT) c_ += p_[i] * 2654435761u + (unsigned)i; \
        c_ += __shfl_xor(c_, 32); c_ += __shfl_xor(c_, 16); c_ += __shfl_xor(c_, 8); c_ += __shfl_xor(c_, 4); c_ += __shfl_xor(c_, 2); c_ += __shfl_xor(c_, 1); \
        if ((TID() & 63) == 0) atomicAdd(cw_, c_); xcd_barrier(bar); \
        const float X = (float)(__hip_atomic_load(cw_, RLX_AGENT) & 0xFFFFFFu) + 1.0f; float* o_ = outb(); \
        for (size_t i = GT(); i < (size_t)M * DM / 4; i += NT) *((GAS f32x4*)o_ + i) = (f32x4){X, X, X, X}; return; } } while (0)
#else
#define CKPT(id_, lo_, hi_) do { } while (0)
#endif
#if defined(DBG_SPIN)
#define STAMP(i_) do { if (threadIdx.x == 0) { const unsigned long long t_ = __builtin_amdgcn_s_memrealtime(); MISC[16 + 2 * (i_)] = (unsigned)t_; MISC[17 + 2 * (i_)] = (unsigned)(t_ >> 32); const unsigned long long c_ = __builtin_amdgcn_s_memtime(); MISC[100 + 2 * (i_)] = (unsigned)c_; MISC[101 + 2 * (i_)] = (unsigned)(c_ >> 32); } } while (0)
#else
#define STAMP(i_) do { } while (0)
#endif
#define SCR() ((LAS float*)(lds + RING_OFF + wave * TR_LDS))
#define SSQP() ((float*)(wsb() + WS_CTL + MiB))

#if defined(DBG_CHECK)
#define DBG_OA ((DBG_CHECK == 1 || DBG_CHECK == 4) ? WS_XB : WS_QA)
#define DBG_OB (DBG_CHECK == 2 ? WS_XB : WS_QN)
#define DBG_SEL ((DBG_CHECK == 1 || DBG_CHECK == 4) ? (unsigned short*)(wsb() + WS_END) : (unsigned short*)nullptr)
#else
#define DBG_OA WS_QA
#define DBG_OB WS_QN
#define DBG_SEL ((unsigned short*)nullptr)
#endif
#ifndef ONLY
#define ONLY -1
#endif
#ifndef SKIPMASK
#define SKIPMASK 0
#endif
#define PH(k) ((ONLY < 0 || ONLY == (k)) && !((SKIPMASK >> (k)) & 1))
    STAMP(0);
    if (PH(0)) {
    { const TrIn I{INP(2), INP(3), INP(4), INP(5), INP(6), INP(7), INP(8), INP(9), INP(10), INP(13), INP(16), INP(17), INP(19)}; tr_all(I, wsb(), SCR(), gw, NGW, LANE()); }
    cvt_flat_h(INP(0), WSP(bf16, WS_XB), WSP(unsigned char, WS_XF8), (size_t)M * DM / 8, GT(), NT);
    cvt_flat(INP(1), WSP(bf16, WS_PB), (size_t)M * PLE_DIM / 8, GT(), NT);
    { float* ROPE = WSP(float, WS_ROPE);
    for (size_t i = GT(); i < (size_t)SEQ * 32; i += NT) { const int pos = (int)(i >> 5), j = (int)(i & 31);
        const double f = exp2(-(double)j * (13.287712379549449 / 32.0)), turns = (double)pos * f * 0.15915494309189535, fr = turns - floor(turns);
        ROPE[i] = __builtin_amdgcn_cosf((float)fr); ROPE[(size_t)SEQ * 32 + i] = __builtin_amdgcn_sinf((float)fr); } }
    }
    xcd_barrier(bar);

    STAMP(1);
    if (PH(1)) { EpiU<1> E{WSP(bf16, WS_QA), DOP(bf16, DO_QI), DOP(bf16, DO_KA), DOP(bf16, DO_VA), DOP(bf16, DO_KI), DOP(bf16, DO_KR), DOP(bf16, DO_CQ), DOP(bf16, DO_CKV), DOP(float, DO_WI), SSQP(), WSP(float, WS_ROPE)};
        GEMM_PHASE_X(EpiU<1>, WSP(bf16, WS_XF8), WSP(bf16, WS_WIN8), NU8, 1024, E, 2, 127 - 6); }
    if (PH(1)) { EpiU<2> E{WSP(bf16, WS_QA), DOP(bf16, DO_QI), DOP(bf16, DO_KA), DOP(bf16, DO_VA), DOP(bf16, DO_KI), DOP(bf16, DO_KR), DOP(bf16, DO_CQ), DOP(bf16, DO_CKV), DOP(float, DO_WI), SSQP(), WSP(float, WS_ROPE)};
        GEMM_PHASE_LC(EpiU<2>, WSP(bf16, WS_XB), WSP(bf16, WS_WIN), NU16, 2048, E, 1, 127, 0, (bx + 64) % G); }
    if (PH(12)) { EpiB<0> E{DOP(bf16, DO_PEO), 2048, nullptr, nullptr, nullptr};
        { int kk_ = 256; asm volatile("" : "+s"(kk_)); pg8::Gemm g_{(const pg8::bf16_t*)WSP(bf16, WS_PB), (const pg8::bf16_t*)WSP(bf16, WS_WPE), M, 2048, kk_, 127, 0}; pg8::PEOrder S_; S_.init(bx);
          pg8::gemm_phase<EpiB<0>, pg8::PEOrder, true, true, 0>(lds, g_, S_, E); } }
    xcd_barrier(bar);
    CKPT(1, 118, 260);

#if defined(DBG_CHECK) && DBG_CHECK == 3
    {   float* dbgw = (float*)(WSP(unsigned, WS_CTL) + 200000);
        LAS float* xr = (LAS float*)lds; LAS float* red = (LAS float*)(lds + 65536); LAS float* tru = (LAS float*)(lds + 69632);
        for (int smp = bx; smp < 256; smp += G) chk::p1(INP(0), INP(2), WSP(bf16, WS_QA), DOP(bf16, DO_QI), DOP(bf16, DO_KA), DOP(bf16, DO_VA), DOP(bf16, DO_KI), DOP(float, DO_WI), DOP(bf16, DO_CQ), DOP(bf16, DO_CKV), DOP(bf16, DO_KR), smp, xr, red, tru, dbgw, TID());
        xcd_barrier(bar);
        const float X = __hip_atomic_load(dbgw + DBG_WORD, RLX_AGENT) * 1e8f; float* o_ = outb();
        for (size_t i = GT(); i < (size_t)M * DM / 4; i += NT) *((GAS f32x4*)o_ + i) = (f32x4){X, X, X, X};
        return;
    }
#endif
#if defined(DBG_CHECK) && DBG_CHECK == 5
    {
        float* dbgw = (float*)(WSP(unsigned, WS_CTL) + 200000);
        for (int rep = 0; rep < 2; ++rep) {
            const dsa::Ptrs P{DOP(bf16, DO_QI), DOP(bf16, DO_KI), DOP(bf16, DO_KA), DOP(bf16, DO_VA), DOP(float, DO_WI), WSP(bf16, WS_QA), rep == 0 ? WSP(bf16, WS_XB) : WSP(bf16, WS_QN), (unsigned short*)(wsb() + WS_END + (size_t)rep * 8 * MiB)};
            LAS unsigned char* wl = lds + RING_OFF + wave * 16384; LAS dsa::u16* idl = (LAS dsa::u16*)(lds + IDL_OFF + wave * 2048);
            const int x_ = vcu >> 5, wv = (vcu & 31) * NWAVES + wave, j_ = wv >> 6, i_ = wv & 63;
#pragma unroll 1
            for (int jb = 0; jb < 2; ++jb) dsa::job(P, jb, jb == 0 ? 256 * (x_ + 8 * j_) + 4 * i_ : 256 * ((7 - x_) + 8 * (3 - j_)) + 4 * (63 - i_), wl, idl, LANE());
            xcd_barrier(bar);
        }
        { const unsigned short* sa = (const unsigned short*)(wsb() + WS_END); const unsigned short* sb = sa + (size_t)4 * MiB; unsigned c = 0u;
          for (size_t i = GT(); i < (size_t)M * 256; i += NT) c += sa[i] != sb[i] ? 1u : 0u;
          if (c) atomicAdd((unsigned*)dbgw + 20, c);
          const unsigned* oa = (const unsigned*)WSP(bf16, WS_XB); const unsigned* ob = (const unsigned*)WSP(bf16, WS_QN); unsigned c2 = 0u;
          for (size_t i = GT(); i < (size_t)M * 1024; i += NT) c2 += oa[i] != ob[i] ? 1u : 0u;
          if (c2) atomicAdd((unsigned*)dbgw + 21, c2); }
        xcd_barrier(bar);
        const float X = ((float)__hip_atomic_load((unsigned*)dbgw + 20 + DBG_WORD, RLX_AGENT) + 1.0f) * 1e8f; float* o_ = outb();
        for (size_t i = GT(); i < (size_t)M * DM / 4; i += NT) *((GAS f32x4*)o_ + i) = (f32x4){X, X, X, X};
        return;
    }
#endif
    STAMP(2);
    if (PH(3)) { const dsa::Ptrs P{DOP(bf16, DO_QI), DOP(bf16, DO_KI), DOP(bf16, DO_KA), DOP(bf16, DO_VA), DOP(float, DO_WI), WSP(bf16, WS_QA), WSP(bf16, DBG_OA), DBG_SEL};
      LAS unsigned char* wl = lds + RING_OFF + wave * 16384; LAS dsa::u16* idl = (LAS dsa::u16*)(lds + IDL_OFF + wave * 2048);
      const int x_ = vcu >> 5, j_ = wave & 3, i_ = (vcu & 31) * 2 + (wave >> 2);
#pragma unroll 1
      for (int jb = 0; jb < 2; ++jb) dsa::job(P, jb, jb == 0 ? 256 * (x_ + 8 * j_) + 4 * i_ : 256 * ((7 - x_) + 8 * (3 - j_)) + 4 * (63 - i_), wl, idl, LANE(), wave == 0 ? MISC + 64 : nullptr); }
    __syncthreads();
    STAMP(3);
    if (PH(2)) { EpiQ E{WSP(bf16, WS_QN), DOP(bf16, DO_QR), SSQP(), WSP(float, WS_ROPE)}; GEMM_PHASE_X(EpiQ, DOP(bf16, DO_CQ), WSP(bf16, WS_WUQ), 3072, 256, E, 2, 127 - 5); }
    if (PH(2)) { EpiKV E{WSP(bf16, WS_KN), WSP(bf16, WS_VB), SSQP() + (size_t)M * 8}; GEMM_PHASE_X(EpiKV, DOP(bf16, DO_CKV), WSP(bf16, WS_WKV), 4096, 256, E, 2, 127 - 5); }
    xcd_barrier(bar);
    CKPT(2, 118, 182); CKPT(3, 260, 484);
#if defined(DBG_CHECK) && DBG_CHECK == 6
    {   float* dbgw = (float*)(WSP(unsigned, WS_CTL) + 200000);
        LAS float* cr = (LAS float*)lds; LAS float* red = (LAS float*)(lds + 65536); LAS float* tru = (LAS float*)(lds + 69632);
        for (int smp = bx; smp < 256; smp += G) chk::p2(DOP(bf16, DO_CQ), DOP(bf16, DO_CKV), INP(3), INP(4), INP(5), INP(6), INP(7), WSP(bf16, WS_QN), DOP(bf16, DO_QR), WSP(bf16, WS_KN), WSP(bf16, WS_VB), smp, cr, red, tru, dbgw, TID());
        xcd_barrier(bar);
        const float X = __hip_atomic_load(dbgw + DBG_WORD, RLX_AGENT) * 1e8f; float* o_ = outb();
        for (size_t i = GT(); i < (size_t)M * DM / 4; i += NT) *((GAS f32x4*)o_ + i) = (f32x4){X, X, X, X};
        return;
    }
#endif

    STAMP(4);
    if (PH(4)) { const mla::Tensors T{WSP(bf16, WS_QN), DOP(bf16, DO_QR), WSP(bf16, WS_KN), DOP(bf16, DO_KR), WSP(bf16, WS_VB), DOP(bf16, DO_AB8)};
#pragma unroll 1
      for (int r_ = 0; r_ < 2; ++r_) { const int x_ = vcu >> 5, q_ = (vcu & 31) * 2 + r_, j_ = q_ >> 4, h_ = q_ & 15;
#pragma unroll 1
          for (int ps = 0; ps < 2; ++ps) mla::unit(T, ps, h_, ps == 0 ? x_ + 8 * j_ : (7 - x_) + 8 * (3 - j_), lds + RING_OFF); } }
    CKPT(4, 260, 324);

#if defined(DBG_CHECK) && (DBG_CHECK == 1 || DBG_CHECK == 2 || DBG_CHECK == 4)
    {
        float* dbgw = (float*)(WSP(unsigned, WS_CTL) + 200000);
        LAS float* lgs = (LAS float*)lds; LAS float* red = (LAS float*)(lds + 65536); LAS float* aux = (LAS float*)(lds + 69632);
        for (int smp = bx; smp < (DBG_CHECK == 4 ? 256 : 512); smp += G) {
#if DBG_CHECK == 2
            chk::mla(WSP(bf16, WS_QN), DOP(bf16, DO_QR), WSP(bf16, WS_KN), DOP(bf16, DO_KR), WSP(bf16, WS_VB), WSP(bf16, DBG_OB), smp, lgs, red, aux, dbgw, TID());
#else
            chk::dsa<(DBG_CHECK == 4)>(INP(0), INP(2), DOP(bf16, DO_QI), DOP(bf16, DO_KI), DOP(float, DO_WI), WSP(bf16, WS_QA), DOP(bf16, DO_KA), DOP(bf16, DO_VA), WSP(bf16, DBG_OA), DBG_SEL, smp, lgs, red, aux, dbgw, TID());
#endif
        }
        xcd_barrier(bar);
        const float X = __hip_atomic_load(dbgw + DBG_WORD, RLX_AGENT) * 1e8f; float* o_ = outb();
        for (size_t i = GT(); i < (size_t)M * DM / 4; i += NT) *((GAS f32x4*)o_ + i) = (f32x4){X, X, X, X};
        return;
    }
#endif
    STAMP(5);
    if (PH(5)) { EpiB<1> E{WSP(bf16, WS_G), 4096, nullptr, nullptr, nullptr}; GEMM_PHASE_X(EpiB<1>, WSP(bf16, WS_XF8), WSP(bf16, WS_WG), 4096, 1024, E, 2, 127 - 6); }
    xcd_barrier(bar);
    CKPT(5, 356, 484); CKPT(6, 182, 256); CKPT(7, 324, 348);
#if defined(DBG_CHECK) && DBG_CHECK == 10
    {
        unsigned* dw = WSP(unsigned, WS_CTL) + 200000; const bf16* Gp = WSP(bf16, WS_G);
        unsigned cntb = 0u, rmax = 0u, rmin = 255u, pnmax = 0u, pnmin = 15u, r16 = 0u, nnan = 0u, pmaxb = 0u, pminb = 63u; float vmax = 0.f;
        for (int s_ = 0; s_ < 8; ++s_) { const int pnl = own_panel(vcu >> 5, s_);
            for (int e = (vcu & 31) * 512 + (int)TID(); e < 256 * 4096 / 8; e += 32 * 512) { const int r = e / 512, c8 = e % 512; const v4u w = *(const GAS v4u*)(Gp + ((size_t)pnl * 256 + r) * 4096 + c8 * 8); f32x4 a, b; unpack8(w, a, b);
                bool bad = false;
#pragma unroll
                for (int j = 0; j < 4; ++j) { bad |= !(a[j] >= 0.f && a[j] <= 1.001f); bad |= !(b[j] >= 0.f && b[j] <= 1.001f); }
                if (bad) { for (int j = 0; j < 4; ++j) { if (a[j] == a[j] && fabsf(a[j]) < 1e30f) vmax = fmaxf(vmax, fabsf(a[j])); else ++nnan; if (b[j] == b[j] && fabsf(b[j]) < 1e30f) vmax = fmaxf(vmax, fabsf(b[j])); else ++nnan; } pmaxb = max(pmaxb, (unsigned)pnl); pminb = min(pminb, (unsigned)pnl);
                    ++cntb; rmax = max(rmax, (unsigned)r); rmin = min(rmin, (unsigned)r); pnmax = max(pnmax, (unsigned)(c8 / 32)); pnmin = min(pnmin, (unsigned)(c8 / 32)); r16 |= 1u << (r & 15); } } }
        if (cntb) { atomicAdd(dw + 0, cntb); atomicMax(dw + 1, rmax + 1u); atomicMax(dw + 2, 256u - rmin); atomicMax(dw + 3, pnmax + 1u); atomicMax(dw + 4, 16u - pnmin); atomicOr(dw + 5, r16); atomicMax(dw + 6, (unsigned)vmax); atomicAdd(dw + 7, nnan); atomicMax(dw + 8, pmaxb + 1u); atomicMax(dw + 9, 64u - pminb); }
        xcd_barrier(bar);
        const float X = (float)__hip_atomic_load(dw + DBG_WORD, RLX_AGENT) * 1e8f; float* o_ = outb();
        for (size_t i = GT(); i < (size_t)M * DM / 4; i += NT) *((GAS f32x4*)o_ + i) = (f32x4){X, X, X, X};
        return;
    }
#endif
#if defined(DBG_CHECK) && DBG_CHECK == 9
    {   float* dbgw = (float*)(WSP(unsigned, WS_CTL) + 200000);
        LAS float* xr = (LAS float*)lds; LAS float* red = (LAS float*)(lds + 65536);
        { const size_t row_ = (size_t)256 * own_panel(vcu >> 5, vcu & 7) + (((unsigned)vcu * 2654435761u) >> 9) % 256;
          chk::gchk(INP(0), INP(2), WSP(bf16, WS_G), WSP(bf16, WS_XB), row_, xr, red, dbgw, TID()); }
        xcd_barrier(bar);
        const float X = __hip_atomic_load(dbgw + DBG_WORD, RLX_AGENT) * 1e8f; float* o_ = outb();
        for (size_t i = GT(); i < (size_t)M * DM / 4; i += NT) *((GAS f32x4*)o_ + i) = (f32x4){X, X, X, X};
        return;
    }
#endif

    STAMP(6);
    if (PH(7)) { EpiB<2> E{WSP(bf16, WS_MT), 2048, WSP(bf16, WS_G), nullptr, nullptr}; GEMM_PHASE_L(EpiB<2>, WSP(bf16, WS_QA), WSP(bf16, WS_WA), 2048, 1024, E, 2, 127 - 6, 2048); }
    if (PH(7)) { EpiB<5> E{WSP(bf16, WS_MT), 2048, (const bf16*)(WSP(unsigned char, WS_G) + 2048), nullptr, WSP(unsigned char, WS_MG8)}; GEMM_PHASE_X(EpiB<5>, DOP(bf16, DO_AB8), WSP(bf16, WS_WB), 2048, 1024, E, 2, 127 - 6); }
    xcd_barrier(bar);
    CKPT(8, 54, 118);

    STAMP(7);
    if (PH(8)) { EpiF<0> E{WSP(bf16, WS_X1B), INP(0), nullptr}; GEMM_PHASE_X(EpiF<0>, WSP(bf16, WS_MG8), WSP(bf16, WS_WO), 2048, 1024, E, 2, 127 - 6); }
    xcd_barrier(bar);
#if defined(DBG_CHECK) && DBG_CHECK == 7
    {   float* dbgw = (float*)(WSP(unsigned, WS_CTL) + 200000);
        LAS float* va = (LAS float*)lds; LAS float* red = (LAS float*)(lds + 65536); LAS float* mg = (LAS float*)(lds + 69632);
        { const size_t row_ = (size_t)256 * own_panel(vcu >> 5, vcu & 7) + (((unsigned)vcu * 2654435761u) >> 9) % 256;
          chk::mid(INP(0), INP(2), INP(8), INP(9), INP(10), WSP(bf16, WS_QA), WSP(bf16, WS_QN), WSP(bf16, WS_G), WSP(bf16, WS_MT), outb(), row_, vcu, va, red, mg, dbgw, TID()); }
        xcd_barrier(bar);
        const float X = __hip_atomic_load(dbgw + DBG_WORD, RLX_AGENT) * 1e8f; float* o_ = outb();
        for (size_t i = GT(); i < (size_t)M * DM / 4; i += NT) *((GAS f32x4*)o_ + i) = (f32x4){X, X, X, X};
        return;
    }
#endif
    if (PH(9)) { bf16* z_ = WSP(bf16, WS_X1B); ln_pass(z_, nullptr, z_, WSP(unsigned char, WS_X1F8), INP(11), INP(12), vcu, wave, LANE()); }
    xcd_barrier(bar);
    CKPT(9, 118, 182);

    STAMP(8);
    if (PH(10)) { EpiUp E{WSP(unsigned char, WS_ACT), WSP(float, WS_HEAD), WSP(float, WS_TAIL), INP(14), INP(15)}; GEMM_PHASE_X(EpiUp, WSP(bf16, WS_X1F8), WSP(bf16, WS_WUP), NUP, 1024, E, 2, 127 - 6); }
    xcd_barrier(bar);
    CKPT(10, 260, 484);

    STAMP(9);
    if (PH(11)) conv_fixup(WSP(unsigned char, WS_ACT), WSP(float, WS_HEAD), WSP(float, WS_TAIL), INP(14), INP(15), vcu, TID());
    if (PH(15)) { EpiB<4> E{DOP(bf16, DO_PEO), 2048, nullptr, INP(18), nullptr}; GEMM_PHASE_X(EpiB<4>, WSP(bf16, WS_X1F8), WSP(bf16, WS_WPG), 2048, 1024, E, 2, 127 - 6); }
    xcd_barrier(bar);
    CKPT(11, 54, 118); CKPT(12, 308, 484);

    STAMP(10);
    if (PH(13)) { EpiF<1> E{WSP(bf16, WS_X1B), nullptr, DOP(bf16, DO_PEO)}; GEMM_PHASE_X(EpiF<1>, WSP(bf16, WS_ACT), WSP(bf16, WS_WDN), 2048, DFF / 2, E, 2, 127 - 7); }
    xcd_barrier(bar);
    if (PH(14)) { ln_pass(WSP(bf16, WS_X1B), outb(), nullptr, nullptr, INP(20), INP(21), vcu, wave, LANE()); }
#if defined(DBG_SPIN)
    STAMP(11);
    if (threadIdx.x == 0 && vcu == DBG_VCU) { const unsigned long long a_ = ((unsigned long long)MISC[17 + 2 * (DBG_SPIN % 100)] << 32) | MISC[16 + 2 * (DBG_SPIN % 100)], b_ = ((unsigned long long)MISC[17 + 2 * (DBG_SPIN % 100 + DBG_SPAN)] << 32) | MISC[16 + 2 * (DBG_SPIN % 100 + DBG_SPAN)];
        const unsigned long long ca_ = ((unsigned long long)MISC[101 + 2 * (DBG_SPIN % 100)] << 32) | MISC[100 + 2 * (DBG_SPIN % 100)], cb_ = ((unsigned long long)MISC[101 + 2 * (DBG_SPIN % 100 + DBG_SPAN)] << 32) | MISC[100 + 2 * (DBG_SPIN % 100 + DBG_SPAN)];
        const unsigned long long t0_ = __builtin_amdgcn_s_memrealtime(), w_ = DBG_SPIN >= 200 ? (cb_ - ca_) / 20ull : DBG_SPIN >= 100 ? 4ull * MISC[64 + (DBG_SPIN - 100)] : 4ull * (b_ - a_); while (__builtin_amdgcn_s_memrealtime() - t0_ < w_) __builtin_amdgcn_s_sleep(8); }
#endif
#if defined(DBG_CHECK) && DBG_CHECK == 8
    {   xcd_barrier(bar);
        float* dbgw = (float*)(WSP(unsigned, WS_CTL) + 200000);
        LAS float* xs = (LAS float*)lds; LAS float* red = (LAS float*)(lds + 65536); LAS float* act = (LAS float*)(lds + 69632);
        for (int smp = bx; smp < 256; smp += G) chk::endp(WSP(bf16, WS_X1B), nullptr, INP(1), INP(13), INP(14), INP(15), INP(16), INP(17), INP(18), INP(19), INP(20), INP(21), outb(), smp, xs, red, act, dbgw, TID());
        xcd_barrier(bar);
        const float X = __hip_atomic_load(dbgw + DBG_WORD, RLX_AGENT) * 1e8f; float* o_ = outb();
        for (size_t i = GT(); i < (size_t)M * DM / 4; i += NT) *((GAS f32x4*)o_ + i) = (f32x4){X, X, X, X};
    }
#endif
}

extern "C" void kernel_launch(void* const* d_in, const int* in_sizes, int n_in, void* d_out, int out_size, void* d_ws, size_t ws_size, hipStream_t stream) {
    static int grid = 0;
    if (grid == 0) {
        if (n_in != 22 || in_sizes[0] != M * DM || out_size != M * DM || ws_size < WS_END) { fprintf(stderr, "kernel_launch: unexpected shapes (n_in %d, in0 %d, out %d, ws %zu); nothing launched\n", n_in, n_in > 0 ? in_sizes[0] : -1, out_size, ws_size); grid = -1; return; }
        int dev = 0, cus = 0, per_cu = 0;
        if (hipGetDevice(&dev) != hipSuccess || hipDeviceGetAttribute(&cus, hipDeviceAttributeMultiprocessorCount, dev) != hipSuccess) { grid = -1; return; }
        if (hipFuncSetAttribute((const void*)fwd_kernel, hipFuncAttributeMaxDynamicSharedMemorySize, LDS_BYTES) != hipSuccess) { fprintf(stderr, "kernel_launch: hipFuncSetAttribute failed\n"); grid = -1; return; }
        if (hipOccupancyMaxActiveBlocksPerMultiprocessor(&per_cu, (const void*)fwd_kernel, NWAVES * 64, LDS_BYTES) != hipSuccess || per_cu < 1) { fprintf(stderr, "kernel_launch: occupancy query reports %d workgroups per CU\n", per_cu); }
        (void)hipGetLastError();
        grid = cus;
    }
    if (grid < 0) return;
    if (hipMemsetAsync((char*)d_ws + WS_CTL, 0, CTL_ZERO_BYTES, stream) != hipSuccess) return;
    Args a{};
    for (int i = 0; i < 22; ++i) a.in[i] = (const float*)d_in[i];
    a.out = (float*)d_out; a.ws = (unsigned char*)d_ws;
    hipLaunchKernelGGL(fwd_kernel, dim3(grid), dim3(NWAVES * 64), LDS_BYTES, stream, a);
}
```

```cpp
#include <hip/hip_runtime.h>
#include <cstdio>
#include <cstdint>
namespace pg8 {
#define PG8_LAS __attribute__((address_space(3)))
typedef unsigned short bf16_t;
typedef short bf16x8 __attribute__((ext_vector_type(8)));
typedef float f32x4 __attribute__((ext_vector_type(4)));
typedef unsigned u32x4 __attribute__((ext_vector_type(4)));
constexpr int BM = 256, BK = 64, HALF = 128, HTB = HALF * BK * 2  , STAGE_BYTES = 8 * HTB, NXCD = 8, WGM = 8;

__host__ __device__ __forceinline__ int lds_byte(int r, int c) { const int st = (r >> 4) * 2 + (c >> 5), rr = r & 15, cc = c & 31, ob = rr * 64 + cc * 2; return st * 1024 + (ob ^ (((ob >> 9) & 1) << 5)); }
__host__ __device__ __forceinline__ void stage_rc(int b, int& R, int& C) { const int st = b / 1024, sb = b % 1024, swz = sb ^ (((sb >> 9) & 1) << 5); R = (st >> 1) * 16 + swz / 64; C = (st & 1) * 32 + (swz % 64) / 2; }
__host__ __device__ __forceinline__ int perm32(int rho) { const int n = rho >> 4, i = rho & 15; return 8 * (i >> 2) + 4 * n + (i & 3); }

struct Unit { int pm, pn; };
struct Gemm { const bf16_t* A; const bf16_t* Bt; int M, N, K; int wscale; int lda; };
typedef int i32x4 __attribute__((ext_vector_type(4))); typedef int i32x8 __attribute__((ext_vector_type(8)));
typedef _Float16 f16x8 __attribute__((ext_vector_type(8)));

struct StaticOrder {
    int nM, nN, nwg, G, c;
    __host__ __device__ void init(int M, int N, int G_, int c_) { nM = M / BM; nN = N / BM; nwg = nM * nN; G = G_; c = c_; }
    __host__ __device__ bool next(int i, Unit& u) const {
        const long L = (long)i * G + c; if (L >= nwg) return false;
        int wgid = (int)L; { const int q = nwg / NXCD, r = nwg % NXCD, xcd = wgid % NXCD, off = wgid / NXCD; wgid = (xcd < r ? xcd * (q + 1) : r * (q + 1) + (xcd - r) * q) + off; }
        const int nig = WGM * nN, gid = wgid / nig, fm = gid * WGM, gsz = (nM - fm) < WGM ? (nM - fm) : WGM;
        u.pm = fm + ((wgid % nig) % gsz); u.pn = (wgid % nig) / gsz;
        { const int x = u.pm >> 3, s = u.pm & 7; u.pm = s < 4 ? x + 8 * s : 32 + (7 - x) + 8 * (s - 4); }
        return true;
    }
    __device__ __forceinline__ void a_ready(const Unit&) const {}
    __device__ __forceinline__ void done(const Unit&) const {}
};
struct PEOrder {
    int c;
    __host__ __device__ void init(int c_) { c = c_; }
    __host__ __device__ bool next(int i, Unit& u) const {
        const int x = c & 7, r = c >> 3; if (r < 8 || r >= 24 || i >= 4) return false;
        const int w = 4 * (r - 8) + i, s = w & 7; u.pm = s < 4 ? x + 8 * s : 32 + (7 - x) + 8 * (s - 4); u.pn = w >> 3;
        return true;
    }
    __device__ __forceinline__ void a_ready(const Unit&) const {}
    __device__ __forceinline__ void done(const Unit&) const {}
};

typedef float f32x2c_t __attribute__((ext_vector_type(2))); typedef __bf16 bf16x2c_t __attribute__((ext_vector_type(2)));
__device__ __forceinline__ unsigned cvt_pk_bf16(float lo, float hi) { const f32x2c_t v = {lo, hi}; const bf16x2c_t b = __builtin_convertvector(v, bf16x2c_t); return __builtin_bit_cast(unsigned, b); }
typedef float f32x2 __attribute__((ext_vector_type(2)));
template <class Epi, class Sched, bool ALIGN_EPI = false, bool SP2 = false, int DT = 0  >
__device__ __forceinline__ void gemm_phase(PG8_LAS unsigned char* lds, const Gemm g, const Sched& S, const Epi& E) {
    int tid_o_ = threadIdx.x; asm volatile("" : "+v"(tid_o_));
    const int tid = tid_o_, wid = __builtin_amdgcn_readfirstlane(tid >> 6), lane = tid & 63, wr = wid >> 2, wc = wid & 3, fr = lane & 15, fq = lane >> 4;
    const int K = g.K, nt = K / BK, lda = g.lda ? g.lda : g.K;
    unsigned voffA[2], voffB[2];
#pragma unroll
    for (int i = 0; i < 2; ++i) { int R, C; stage_rc(tid * 16 + i * 8192, R, C); const int Rb = Epi::PERM ? ((R & ~31) + perm32(R & 31)) : R;
        voffA[i] = (unsigned)(R * lda + C) * 2u; voffB[i] = (unsigned)(Rb * K + C) * 2u; }
    const size_t kstep = (size_t)(BK * 2);
    const size_t hstep = (size_t)HALF * K * 2;
    const size_t tstep = 2 * hstep;
    const size_t hstepA = (size_t)HALF * lda * 2, tstepA = 2 * hstepA;
    const unsigned ldsw = (unsigned)wid * 1024u;
    const int aoff = lds_byte(wr * 64 + fr, fq * 8), boff = lds_byte(wc * 32 + fr, fq * 8);
#define PG8_SA(b, h) (((b) * 2 + (h)) * HTB)
#define PG8_SB(b, h) ((4 + (b) * 2 + (h)) * HTB)
#define PG8_STAGE(bufoff, gbase, voff) do { _Pragma("unroll") for (int _i = 0; _i < 2; ++_i) \
        __builtin_amdgcn_global_load_lds((const unsigned*)((const char*)(gbase) + (voff)[_i]), (PG8_LAS unsigned*)(lds + (bufoff) + ldsw + _i * 8192), 16, 0, 0); } while (0)
#define PG8_LD16A(off_) (*(const PG8_LAS i32x4*)(abase8 + (off_)))
#define PG8_LD16B(off_) (*(const PG8_LAS i32x4*)(bbase8 + ((off_) - 65536)))
#define PG8_LDA(dst, b, h) do { if constexpr (DT == 2) { _Pragma("unroll") for (int m = 0; m < 4; ++m) dst##8[m] = __builtin_shufflevector(PG8_LD16A(PG8_SA(b, h) + m * 2048), PG8_LD16A(PG8_SA(b, h) + m * 2048 + 1024), 0, 1, 2, 3, 4, 5, 6, 7); } \
        else { _Pragma("unroll") for (int m = 0; m < 4; ++m) _Pragma("unroll") for (int k = 0; k < 2; ++k) dst[m][k] = *(const PG8_LAS bf16x8*)(lds + PG8_SA(b, h) + aoff + m * 2048 + k * 1024); } } while (0)
#define PG8_LDB(dst, b, h) do { if constexpr (DT == 2) { _Pragma("unroll") for (int n = 0; n < 2; ++n) dst##8[n] = __builtin_shufflevector(PG8_LD16B(PG8_SB(b, h) + n * 2048), PG8_LD16B(PG8_SB(b, h) + n * 2048 + 1024), 0, 1, 2, 3, 4, 5, 6, 7); } \
        else { _Pragma("unroll") for (int n = 0; n < 2; ++n) _Pragma("unroll") for (int k = 0; k < 2; ++k) dst[n][k] = *(const PG8_LAS bf16x8*)(lds + PG8_SB(b, h) + boff + n * 2048 + k * 1024); } } while (0)
#define PG8_MMA(ai, bj, At, Bt) do { __builtin_amdgcn_s_setprio(1); _Pragma("unroll") for (int m = 0; m < 4; ++m) _Pragma("unroll") for (int n = 0; n < 2; ++n) { \
        if constexpr (DT == 2) asm volatile("v_mfma_scale_f32_16x16x128_f8f6f4 %0, %1, %2, %0, %3, %4 op_sel_hi:[0,0,0]" : "+v"(acc[ai][bj][m][n]) : "v"(Bt##8[n]), "v"(At##8[m]), "v"(sclw), "v"(scla));   \
        else { _Pragma("unroll") for (int k = 0; k < 2; ++k) { \
        if constexpr (DT == 1) acc[ai][bj][m][n] = __builtin_amdgcn_mfma_f32_16x16x32_f16(__builtin_bit_cast(f16x8, Bt[n][k]), __builtin_bit_cast(f16x8, At[m][k]), acc[ai][bj][m][n], 0, 0, 0); \
        else acc[ai][bj][m][n] = __builtin_amdgcn_mfma_f32_16x16x32_bf16(Bt[n][k], At[m][k], acc[ai][bj][m][n], 0, 0, 0); } } } __builtin_amdgcn_s_setprio(0); } while (0)
#define PG8_WAIT_V(n) asm volatile("s_waitcnt vmcnt(" #n ")" ::: "memory")
#define PG8_WAIT_L(n) asm volatile("s_waitcnt lgkmcnt(" #n ")" ::: "memory")
#define PG8_BAR __builtin_amdgcn_s_barrier()
#define PG8_SCHED __builtin_amdgcn_sched_barrier(0)
    Unit cur, nxt; int ui = 0;
    if (!S.next(0, cur)) return;
    f32x4 acc[2][2][4][2];
#pragma unroll
    for (int a = 0; a < 2; ++a)
#pragma unroll
        for (int b = 0; b < 2; ++b)
#pragma unroll
            for (int m = 0; m < 4; ++m)
#pragma unroll
                for (int n = 0; n < 2; ++n) acc[a][b][m][n] = (f32x4){0.f, 0.f, 0.f, 0.f};
    const int sclw = g.wscale, scla = 127;
    unsigned abi_ = (unsigned)(uintptr_t)lds + (unsigned)aoff, bbi_ = (unsigned)(uintptr_t)lds + 65536u + (unsigned)boff; asm volatile("" : "+v"(abi_), "+v"(bbi_));
    const PG8_LAS unsigned char* abase8 = (const PG8_LAS unsigned char*)(uintptr_t)abi_; const PG8_LAS unsigned char* bbase8 = (const PG8_LAS unsigned char*)(uintptr_t)bbi_;
    bf16x8 At[4][2], B0[2][2], B1[2][2]; i32x8 At8[4], B08[2], B18[2];
    const char* cA = (const char*)g.A + (size_t)cur.pm * tstepA; const char* cB = (const char*)g.Bt + (size_t)cur.pn * tstep;
    S.a_ready(cur);
    if constexpr (SP2) {
        PG8_STAGE(PG8_SB(0, 0), cB, voffB); PG8_STAGE(PG8_SB(0, 1), cB + hstep, voffB); PG8_STAGE(PG8_SA(0, 0), cA, voffA); PG8_STAGE(PG8_SA(0, 1), cA + hstepA, voffA);
        if (wr == 1) PG8_BAR;
        PG8_WAIT_V(2); PG8_BAR;
        PG8_STAGE(PG8_SB(1, 0), cB + kstep, voffB); PG8_STAGE(PG8_SA(1, 0), cA + kstep, voffA); PG8_STAGE(PG8_SB(1, 1), cB + hstep + kstep, voffB);
        PG8_WAIT_V(6); PG8_BAR;
    } else {
        PG8_STAGE(PG8_SB(0, 0), cB, voffB); PG8_STAGE(PG8_SA(0, 0), cA, voffA); PG8_STAGE(PG8_SB(0, 1), cB + hstep, voffB); PG8_STAGE(PG8_SA(0, 1), cA + hstepA, voffA);
        if (wr == 1) PG8_BAR;
        PG8_WAIT_V(4); PG8_BAR;
        PG8_STAGE(PG8_SB(1, 0), cB + kstep, voffB); PG8_STAGE(PG8_SA(1, 0), cA + kstep, voffA); PG8_STAGE(PG8_SB(1, 1), cB + hstep + kstep, voffB);
        PG8_WAIT_V(6); PG8_BAR;
    }
    for (;;) {
        const bool has_next = S.next(ui + 1, nxt);
        const char* nA = has_next ? (const char*)g.A + (size_t)nxt.pm * tstepA : cA; const char* nB = has_next ? (const char*)g.Bt + (size_t)nxt.pn * tstep : cB;
        for (int t = 0; t < nt; t += 2) {
            const bool last = (t == nt - 2);
            const char* a1 = cA + (size_t)(t + 1) * kstep;
            const char* a2 = last ? nA : cA + (size_t)(t + 2) * kstep; const char* b2 = last ? nB : cB + (size_t)(t + 2) * kstep;
            const char* a3 = a2 + kstep; const char* b3 = b2 + kstep;
            if (last && has_next) S.a_ready(nxt);
            if constexpr (SP2) {
            PG8_LDB(B0, 0, 0); PG8_LDB(B1, 0, 1); PG8_SCHED; PG8_LDA(At, 0, 0); PG8_STAGE(PG8_SA(1, 1), a1 + hstepA, voffA);
            PG8_WAIT_V(8); PG8_WAIT_L(0); PG8_BAR; PG8_MMA(0, 0, At, B0); PG8_MMA(0, 1, At, B1); PG8_BAR; PG8_SCHED;
            PG8_LDA(At, 0, 1); PG8_STAGE(PG8_SB(0, 0), b2, voffB); PG8_STAGE(PG8_SB(0, 1), b2 + hstep, voffB); PG8_STAGE(PG8_SA(0, 0), a2, voffA);
            PG8_WAIT_V(8); PG8_WAIT_L(0); PG8_BAR; PG8_MMA(1, 0, At, B0); PG8_MMA(1, 1, At, B1); PG8_BAR; PG8_SCHED;
            PG8_LDB(B0, 1, 0); PG8_LDB(B1, 1, 1); PG8_SCHED; PG8_LDA(At, 1, 0); PG8_STAGE(PG8_SA(0, 1), a2 + hstepA, voffA);
            PG8_WAIT_V(8); PG8_WAIT_L(0); PG8_BAR; PG8_MMA(0, 0, At, B0); PG8_MMA(0, 1, At, B1); PG8_BAR; PG8_SCHED;
            PG8_LDA(At, 1, 1); PG8_STAGE(PG8_SB(1, 0), b3, voffB); PG8_STAGE(PG8_SB(1, 1), b3 + hstep, voffB); PG8_STAGE(PG8_SA(1, 0), a3, voffA);
            PG8_WAIT_V(8); PG8_WAIT_L(0); PG8_BAR; PG8_MMA(1, 0, At, B0); PG8_MMA(1, 1, At, B1); PG8_BAR; PG8_SCHED;
            } else {
            PG8_LDB(B0, 0, 0); PG8_SCHED; PG8_LDA(At, 0, 0); PG8_STAGE(PG8_SA(1, 1), a1 + hstepA, voffA);
            PG8_WAIT_L(8); PG8_BAR; PG8_WAIT_L(0); PG8_MMA(0, 0, At, B0); PG8_BAR; PG8_SCHED;
            PG8_LDB(B1, 0, 1); PG8_STAGE(PG8_SB(0, 0), b2, voffB);
            PG8_BAR; PG8_WAIT_L(0); PG8_MMA(0, 1, At, B1); PG8_BAR;
            PG8_LDA(At, 0, 1); PG8_STAGE(PG8_SA(0, 0), a2, voffA);
            PG8_BAR; PG8_WAIT_L(0); PG8_MMA(1, 0, At, B0); PG8_BAR; PG8_SCHED;
            PG8_STAGE(PG8_SB(0, 1), b2 + hstep, voffB);
            PG8_WAIT_V(6); PG8_BAR; PG8_MMA(1, 1, At, B1); PG8_BAR;
            PG8_LDB(B0, 1, 0); PG8_SCHED; PG8_LDA(At, 1, 0); PG8_STAGE(PG8_SA(0, 1), a2 + hstepA, voffA);
            PG8_WAIT_L(8); PG8_BAR; PG8_WAIT_L(0); PG8_MMA(0, 0, At, B0); PG8_BAR; PG8_SCHED;
            PG8_LDB(B1, 1, 1); PG8_STAGE(PG8_SB(1, 0), b3, voffB);
            PG8_BAR; PG8_WAIT_L(0); PG8_MMA(0, 1, At, B1); PG8_BAR;
            PG8_LDA(At, 1, 1); PG8_STAGE(PG8_SA(1, 0), a3, voffA);
            PG8_BAR; PG8_WAIT_L(0); PG8_MMA(1, 0, At, B0); PG8_BAR; PG8_SCHED;
            PG8_STAGE(PG8_SB(1, 1), b3 + hstep, voffB);
            PG8_WAIT_V(6); PG8_BAR; PG8_MMA(1, 1, At, B1); PG8_BAR;
            }
        }
        if constexpr (ALIGN_EPI) { if (wr == 0) PG8_BAR; }
        if constexpr (!Epi::AFTER_DRAIN) { E(acc, cur, wr, wc, fr, fq); S.done(cur); }
        if (!has_next) break;
#pragma unroll
        for (int a = 0; a < 2; ++a)
#pragma unroll
            for (int b = 0; b < 2; ++b)
#pragma unroll
                for (int m = 0; m < 4; ++m)
#pragma unroll
                    for (int n = 0; n < 2; ++n) acc[a][b][m][n] = (f32x4){0.f, 0.f, 0.f, 0.f};
        cur = nxt; cA = nA; cB = nB; ++ui;
        if constexpr (ALIGN_EPI) { if (wr == 1) PG8_BAR; }
    }
    PG8_WAIT_V(0);
    if constexpr (!ALIGN_EPI) { if (wr == 0) PG8_BAR; }
    PG8_BAR;
    if constexpr (Epi::AFTER_DRAIN) { E.fused(acc, cur, wr, wc, fr, fq, lds, wid, lane); S.done(cur); }
#undef PG8_SA
#undef PG8_SB
#undef PG8_STAGE
#undef PG8_LDA
#undef PG8_LD16A
#undef PG8_LD16B
#undef PG8_LDB
#undef PG8_MMA
#undef PG8_WAIT_V
#undef PG8_WAIT_L
#undef PG8_BAR
#undef PG8_SCHED
}
}

constexpr int NWAVES = 8;
constexpr int BATCH = 2, SEQ = 8192, DM = 2048, M = BATCH * SEQ;
constexpr int DIN = 8592, NU = 8704, NU1 = 4608;
constexpr int DFF = 5632, NUP = 2 * DFF, PLE_DIM = 256;
constexpr float LN_EPS = 1e-5f, RMS_EPS = 1e-6f;
constexpr float ALPHA = 1.189207115002721f;
constexpr float LOG2E = 1.4426950408889634f;
constexpr float QA_SCALE = 0.08838834764831845f * LOG2E;
constexpr float QB_SCALE = 0.07216878364870323f * LOG2E;
constexpr int U_QA = 0, U_KA = 2048, U_VA = 2176, U_QI = 2304, U_KI = 3328, U_WI = 3392, U_CQ = 3408, U_CKV = 3920, U_KPE = 4432, U_G = 4496;

constexpr size_t MiB = 1u << 20;
constexpr size_t WS_CTL = 0, CTL_ZERO_BYTES = 1 * MiB;
constexpr size_t WS_ROPE = 2 * MiB;
constexpr size_t WS_WIN = 4 * MiB;
constexpr size_t WS_WIN8 = 12 * MiB;
constexpr int NU16 = 1280, NU8 = 3328;
constexpr size_t WS_WUQ = 38 * MiB;
constexpr size_t WS_WKV = 41 * MiB;
constexpr size_t WS_WPE = 45 * MiB;
constexpr size_t WS_PB = 46 * MiB;
constexpr size_t WS_XB = 54 * MiB;
constexpr size_t WS_QA = 118 * MiB;
constexpr size_t WS_WUP = 182 * MiB, WS_WDN = 204 * MiB, WS_WPG = 215 * MiB;
constexpr size_t WS_WA = 223 * MiB, WS_WB = 227 * MiB, WS_WO = 231 * MiB, WS_WG = 235 * MiB;
constexpr size_t WS_QN = 260 * MiB;
constexpr size_t WS_XF8 = 324 * MiB;
constexpr size_t WS_MG8 = 292 * MiB;
constexpr size_t WS_KN = 356 * MiB, WS_VB = 420 * MiB;
constexpr size_t WS_G = WS_XB;
constexpr size_t WS_MT = WS_QN, WS_X1B = WS_QA, WS_PEO = WS_XB;
constexpr size_t WS_ACT = 320 * MiB;
constexpr size_t WS_X1F8 = 260 * MiB;
constexpr size_t WS_HEAD = 292 * MiB, WS_TAIL = 484 * MiB;
constexpr size_t DO_AB8 = 0 * MiB;
constexpr size_t DO_QI = 0 * MiB, DO_CQ = 32 * MiB, DO_CKV = 48 * MiB, DO_KA = 64 * MiB, DO_VA = 68 * MiB, DO_KI = 72 * MiB, DO_WI = 74 * MiB, DO_KR = 75 * MiB, DO_QR = 80 * MiB;
constexpr size_t DO_PEO = 96 * MiB;
constexpr size_t WS_END = 506 * MiB;
constexpr int CW_TMO = 0, CW_CODE = 1, CW_BAR = 4096, CW_RANK = 32768, CW_JOB = 49152;
constexpr int CW_SSQ = 65536;

constexpr int RING_OFF = 0, RING_BYTES = 131072;
constexpr int IDL_OFF = 131072;
constexpr int LDSCTL_OFF = 147456, MISC_OFF = LDSCTL_OFF + 320;
constexpr int CWL_OFF = 148480;
constexpr int LDS_BYTES = 152576;
static_assert(MISC_OFF + 128 <= LDS_BYTES, "LDS map");
#define GAS __attribute__((address_space(1)))
#define LAS __attribute__((address_space(3)))
typedef unsigned short bf16;
typedef unsigned v4u __attribute__((ext_vector_type(4)));
typedef float f32x4 __attribute__((ext_vector_type(4)));
typedef short bf16x8 __attribute__((ext_vector_type(8)));
typedef GAS unsigned gu32;
typedef GAS unsigned long long gu64;
#define RLX_AGENT __ATOMIC_RELAXED, __HIP_MEMORY_SCOPE_AGENT
#define LDS_WAIT() asm volatile("s_waitcnt lgkmcnt(0)" ::: "memory")
#define VM_WAIT() asm volatile("s_waitcnt vmcnt(0)" ::: "memory")
__device__ __forceinline__ unsigned long long rt() { return __builtin_amdgcn_s_memrealtime(); }
__device__ __forceinline__ unsigned f2bf(float f) { unsigned u = __builtin_bit_cast(unsigned, f); return (u + 0x7fffu + ((u >> 16) & 1u)) >> 16; }
__device__ __forceinline__ unsigned pk2(float lo, float hi) { return f2bf(lo) | (f2bf(hi) << 16); }

#define XB_TMO      128
#define XB_XCNT(j)  (256  + 64 * (j))
#define XB_XSUB(j)  (1280 + 64 * (j))
#define XB_XGEN(j)  (2304 + 64 * (j))
#define XB_TOP      3328
#define XB_TOPGEN   3392
#define XCD_BAR_WORDS 3456
#define XB_SPIN_CAP (1u << 18)

__device__ __forceinline__ unsigned xb_ld(unsigned* p)              { return __hip_atomic_load(p, __ATOMIC_RELAXED, __HIP_MEMORY_SCOPE_AGENT); }
__device__ __forceinline__ unsigned xb_add(unsigned* p, unsigned v) { return __hip_atomic_fetch_add(p, v, __ATOMIC_RELAXED, __HIP_MEMORY_SCOPE_AGENT); }
__device__ __forceinline__ unsigned xb_xcc_id() { return (unsigned)__builtin_amdgcn_s_getreg((3 << 11) | 20) & 0xFu; }
#define XB_SPIN(cond, bar) do { unsigned _sp = 0; while (cond) { __builtin_amdgcn_s_sleep(1); \
    if ((++_sp & 255u) == 0u) { if (xb_ld(&(bar)[XB_TMO])) break; if (_sp > XB_SPIN_CAP) { atomicAdd(&(bar)[XB_TMO], 1u); break; } } } } while (0)

struct XcdBarrier {
    unsigned* bar; unsigned x;
    volatile LAS unsigned* st;
};

__device__ __forceinline__ XcdBarrier xcd_barrier_post(unsigned* bar, volatile LAS unsigned* st) {
    XcdBarrier b; b.bar = bar; b.x = xb_xcc_id(); b.st = st;
    if (threadIdx.x == 0) (void)xb_add(&bar[XB_XCNT(b.x)], 1u);
    return b;
}
__device__ __forceinline__ void xcd_barrier_complete(unsigned* bar, unsigned x, unsigned& nloc, unsigned& nx) {
    const unsigned G = gridDim.x * gridDim.y * gridDim.z;
    unsigned sum, cnt, mine, sp = 0u;
    for (;;) {
        sum = 0u; cnt = 0u; mine = 0u;
#pragma unroll
        for (unsigned j = 0; j < 16; ++j) { const unsigned c = xb_ld(&bar[XB_XCNT(j)]); sum += c; cnt += (c > 0u) ? 1u : 0u; mine = (j == x) ? c : mine; }
        if (sum == G) break;
        __builtin_amdgcn_s_sleep(1);
        if ((++sp & 255u) == 0u) { if (xb_ld(&bar[XB_TMO])) break; if (sp > XB_SPIN_CAP) { atomicAdd(&bar[XB_TMO], 1u); break; } }
    }
    nloc = mine > 0u ? mine : 1u; nx = cnt > 0u ? cnt : 1u;
}

__device__ __forceinline__ void xcd_barrier(const XcdBarrier& b) {
    asm volatile("s_waitcnt vmcnt(0)" ::: "memory");
    __syncthreads();
    if (threadIdx.x == 0) {
        unsigned* bar = b.bar;
        __builtin_amdgcn_s_waitcnt(0);
        unsigned nloc = b.st[0], nx = b.st[1];
        if (nloc == 0u) { xcd_barrier_complete(bar, b.x, nloc, nx); b.st[0] = nloc; b.st[1] = nx; }
        const unsigned old = xb_add(&bar[XB_XSUB(b.x)], 1u);
        const unsigned gen = old / nloc;
        if (old + 1u == (gen + 1u) * nloc) {
            __builtin_amdgcn_fence(__ATOMIC_RELEASE, "agent");
            asm volatile("s_waitcnt vmcnt(0)" ::: "memory");
            const unsigned og = xb_add(&bar[XB_TOP], 1u);
            const unsigned tg = og / nx;
            if (og + 1u == (tg + 1u) * nx) xb_add(&bar[XB_TOPGEN], 1u);
            else XB_SPIN(xb_ld(&bar[XB_TOPGEN]) == tg, bar);
            __builtin_amdgcn_fence(__ATOMIC_ACQUIRE, "agent");
            xb_add(&bar[XB_XGEN(b.x)], 1u);
            asm volatile("s_waitcnt vmcnt(0)" ::: "memory");
        } else {
            XB_SPIN(xb_ld(&bar[XB_XGEN(b.x)]) == gen, bar);
            __builtin_amdgcn_fence(__ATOMIC_ACQUIRE, "agent");
            asm volatile("s_waitcnt vmcnt(0)" ::: "memory");
        }
    }
    __syncthreads();
}

typedef unsigned u32x2 __attribute__((ext_vector_type(2)));
typedef float f32x16 __attribute__((ext_vector_type(16)));
typedef short s16x4 __attribute__((ext_vector_type(4)));
using pg8::cvt_pk_bf16;
__device__ __forceinline__ v4u pack8(f32x4 a, f32x4 b) { v4u w; w.x = cvt_pk_bf16(a[0], a[1]); w.y = cvt_pk_bf16(a[2], a[3]); w.z = cvt_pk_bf16(b[0], b[1]); w.w = cvt_pk_bf16(b[2], b[3]); return w; }
__device__ __forceinline__ u32x2 pack4(f32x4 a) { u32x2 w; w.x = cvt_pk_bf16(a[0], a[1]); w.y = cvt_pk_bf16(a[2], a[3]); return w; }
__device__ __forceinline__ float bflo(unsigned u) { return __uint_as_float(u << 16); }
__device__ __forceinline__ float bfhi(unsigned u) { return __uint_as_float(u & 0xffff0000u); }
__device__ __forceinline__ void unpack8(v4u w, f32x4& a, f32x4& b) { a = (f32x4){bflo(w.x), bfhi(w.x), bflo(w.y), bfhi(w.y)}; b = (f32x4){bflo(w.z), bfhi(w.z), bflo(w.w), bfhi(w.w)}; }
typedef _Float16 f16x2 __attribute__((ext_vector_type(2)));
using pg8::f16x8;
__device__ __forceinline__ unsigned pkh(float a, float b) { const f16x2 v = {(_Float16)a, (_Float16)b}; return __builtin_bit_cast(unsigned, v); }
__device__ __forceinline__ v4u pack8h(f32x4 a, f32x4 b) { v4u w; w.x = pkh(a[0], a[1]); w.y = pkh(a[2], a[3]); w.z = pkh(b[0], b[1]); w.w = pkh(b[2], b[3]); return w; }
__device__ __forceinline__ void unpack8h(v4u w, f32x4& a, f32x4& b) { const f16x8 h = __builtin_bit_cast(f16x8, w); a = (f32x4){(float)h[0], (float)h[1], (float)h[2], (float)h[3]}; b = (f32x4){(float)h[4], (float)h[5], (float)h[6], (float)h[7]}; }
__device__ __forceinline__ unsigned pkf8(float a, float b, float c, float d) { int w = 0; w = __builtin_amdgcn_cvt_pk_fp8_f32(a, b, w, false); w = __builtin_amdgcn_cvt_pk_fp8_f32(c, d, w, true); return (unsigned)w; }
__device__ __forceinline__ float sigmoidf_(float x) { return __builtin_amdgcn_rcpf(1.0f + __builtin_amdgcn_exp2f(-LOG2E * x)); }
__device__ __forceinline__ f32x4 sigmoid4(f32x4 x) { return (f32x4){sigmoidf_(x[0]), sigmoidf_(x[1]), sigmoidf_(x[2]), sigmoidf_(x[3])}; }
__device__ __forceinline__ float sum_x16(float v) { auto r = __builtin_amdgcn_permlane16_swap(__float_as_uint(v), __float_as_uint(v), false, false); return __uint_as_float(r[0]) + __uint_as_float(r[1]); }
__device__ __forceinline__ float sum_x32(float v) { auto r = __builtin_amdgcn_permlane32_swap(__float_as_uint(v), __float_as_uint(v), false, false); return __uint_as_float(r[0]) + __uint_as_float(r[1]); }
__device__ __forceinline__ float max_x16(float v) { auto r = __builtin_amdgcn_permlane16_swap(__float_as_uint(v), __float_as_uint(v), false, false); return fmaxf(__uint_as_float(r[0]), __uint_as_float(r[1])); }
__device__ __forceinline__ float max_x32(float v) { auto r = __builtin_amdgcn_permlane32_swap(__float_as_uint(v), __float_as_uint(v), false, false); return fmaxf(__uint_as_float(r[0]), __uint_as_float(r[1])); }
template <int CTRL> __device__ __forceinline__ float dppf(float v) { return __int_as_float(__builtin_amdgcn_update_dpp(0, __float_as_int(v), CTRL, 0xf, 0xf, false)); }
__device__ __forceinline__ float wave_sum(float v) {
    v += dppf<0xB1>(v); v += dppf<0x4E>(v); v += dppf<0x141>(v); v += dppf<0x140>(v);
    return sum_x32(sum_x16(v));
}
__device__ __forceinline__ int rope_perm(int pc) { const int g = pc >> 3, e = pc & 7; return e < 4 ? 4 * g + e : 32 + 4 * g + (e - 4); }
template <int MAP> __device__ __forceinline__ int srcmap(int n) {
    if (MAP == 0) return n;
    if (MAP == 1) {
        if (n < 2048) return U_QA + n;
        if (n < 3072) return U_QI + (n - 2048);
        if (n < 3200) return U_KA + (n - 3072);
        if (n < 3328) return U_VA + (n - 3200);
        if (n < 3584) { const int o = n - 3328; if (o < 64) return U_KI + o; if (o < 128) return U_KPE + rope_perm(o - 64); if (o < 144) return U_WI + (o - 128); return -1; }
        if (n < 4096) return U_CQ + (n - 3584);
        if (n < 4608) return U_CKV + (n - 4096);
        return U_G + (n - 4608);
    }
    if (MAP == 2) {
        if (n < 2048) return (n >> 7) * 192 + (n & 127);
        const int o = n - 2048; return (o >> 6) * 192 + 128 + rope_perm(o & 63);
    }
    { const int pn = n >> 8, o = n & 255; return o < 128 ? pn * 128 + o : DFF + pn * 128 + (o - 128); }
}
constexpr int TR_LDS = 64 * 68 * 4;
__device__ __forceinline__ void tr_item(const float* W, int ldw, const float* gk, bf16* WT, int K, int k0, int drow0, int srccol4, LAS float* scr, int lane, bool h16) {
    const int c4 = (lane & 15) * 4;
#pragma unroll 8
    for (int i = 0; i < 16; ++i) { const int kk = 4 * i + (lane >> 4); f32x4 v = (f32x4){0.f, 0.f, 0.f, 0.f};
        if (srccol4 >= 0) { v = *(const GAS f32x4*)(W + (size_t)(k0 + kk) * ldw + srccol4); if (gk) v = v * gk[k0 + kk]; }
        *(LAS f32x4*)(scr + kk * 68 + c4) = v; }
    LDS_WAIT(); asm volatile("" ::: "memory");
    bf16* orow = WT + (size_t)(drow0 + lane) * K + k0;
#pragma unroll
    for (int k8 = 0; k8 < 8; ++k8) { const LAS float* s = scr + (8 * k8) * 68 + lane;
        v4u o; if (h16) { o.x = pkh(s[0 * 68], s[1 * 68]); o.y = pkh(s[2 * 68], s[3 * 68]); o.z = pkh(s[4 * 68], s[5 * 68]); o.w = pkh(s[6 * 68], s[7 * 68]); }
        else { o.x = pk2(s[0 * 68], s[1 * 68]); o.y = pk2(s[2 * 68], s[3 * 68]); o.z = pk2(s[4 * 68], s[5 * 68]); o.w = pk2(s[6 * 68], s[7 * 68]); }
        *(GAS v4u*)(orow + 8 * k8) = o; }
    LDS_WAIT(); asm volatile("" ::: "memory");
}
struct TrIn { const float *w_in, *gq, *gkv, *w_uq, *w_uk, *w_uv, *w_a, *w_b, *w_o, *w_up, *w_dn, *w_pg, *w_pe; };
struct TrItem { const float* W; const float* gk; bf16* WT; int ldw, K, k0, drow0, srccol4, mode; float wmul; };
constexpr int TR_E0 = 32 * 72, TR_E1 = TR_E0 + 8 * 48, TR_E2 = TR_E1 + 8 * 32, TR_E3 = TR_E2 + 8 * 32, TR_E4 = TR_E3 + 4 * 32, TR_E5 = TR_E4 + 1024, TR_E6 = TR_E5 + 1024, TR_E7 = TR_E6 + 1024, TR_E8 = TR_E7 + 1024,
              TR_E9 = TR_E8 + 32 * 176, TR_E10 = TR_E9 + 88 * 32, TR_E11 = TR_E10 + 32 * 64;
__device__ __forceinline__ TrItem tr_decode(const TrIn& I, unsigned char* ws, int it, int lane) {
    TrItem t; int r, nblk, map = 0; t.gk = nullptr; t.mode = 0; t.wmul = 1.f; int rowoff = 0;
    if (it < 32 * 20) { r = it; nblk = 20; t.W = I.w_in; t.ldw = DIN; t.WT = (bf16*)(ws + WS_WIN); t.K = 2048; map = 5; t.mode = 1; }
    else if (it < TR_E0) { r = it - 32 * 20; nblk = 52; t.W = I.w_in; t.ldw = DIN; t.WT = (bf16*)(ws + WS_WIN8); t.K = 2048; map = 6; t.mode = 2; t.wmul = 64.f; }
    else if (it < TR_E1) { r = it - TR_E0; nblk = 48; t.W = I.w_uq; t.ldw = 3072; t.WT = (bf16*)(ws + WS_WUQ); t.K = 512; map = 2; t.gk = I.gq; t.mode = 2; t.wmul = 32.f; }
    else if (it < TR_E2) { r = it - TR_E1; nblk = 32; t.W = I.w_uk; t.ldw = 2048; t.WT = (bf16*)(ws + WS_WKV); t.K = 512; t.gk = I.gkv; t.mode = 2; t.wmul = 32.f; }
    else if (it < TR_E3) { r = it - TR_E2; nblk = 32; t.W = I.w_uv; t.ldw = 2048; t.WT = (bf16*)(ws + WS_WKV); t.K = 512; t.gk = I.gkv; rowoff = 2048; t.mode = 2; t.wmul = 32.f; }
    else if (it < TR_E4) { r = it - TR_E3; nblk = 32; t.W = I.w_pe; t.ldw = 2048; t.WT = (bf16*)(ws + WS_WPE); t.K = 256; }
    else if (it < TR_E5) { r = it - TR_E4; nblk = 32; t.W = I.w_a; t.ldw = 2048; t.WT = (bf16*)(ws + WS_WA); t.K = 2048; t.mode = 2; t.wmul = 64.f; }
    else if (it < TR_E6) { r = it - TR_E5; nblk = 32; t.W = I.w_b; t.ldw = 2048; t.WT = (bf16*)(ws + WS_WB); t.K = 2048; t.mode = 2; t.wmul = 64.f; }
    else if (it < TR_E7) { r = it - TR_E6; nblk = 32; t.W = I.w_o; t.ldw = 2048; t.WT = (bf16*)(ws + WS_WO); t.K = 2048; t.mode = 2; t.wmul = 64.f; }
    else if (it < TR_E8) { r = it - TR_E7; nblk = 32; t.W = I.w_pg; t.ldw = 2048; t.WT = (bf16*)(ws + WS_WPG); t.K = 2048; t.mode = 2; t.wmul = 64.f; }
    else if (it < TR_E9) { r = it - TR_E8; nblk = 176; t.W = I.w_up; t.ldw = NUP; t.WT = (bf16*)(ws + WS_WUP); t.K = 2048; map = 3; t.mode = 2; t.wmul = 64.f; }
    else if (it < TR_E10) { r = it - TR_E9; nblk = 32; t.W = I.w_dn; t.ldw = 2048; t.WT = (bf16*)(ws + WS_WDN); t.K = DFF; t.mode = 2; t.wmul = 128.f; }
    else { r = it - TR_E10; nblk = 64; t.W = I.w_in; t.ldw = DIN; t.WT = (bf16*)(ws + WS_WG); t.K = 2048; map = 4; t.mode = 2; t.wmul = 64.f; }
    const int kb = r / nblk, nb = r - kb * nblk, n0 = nb * 64, nl = n0 + 4 * (lane & 15);
    t.k0 = kb * 64; t.drow0 = rowoff + n0; t.srccol4 = map == 0 ? nl : map == 5 ? srcmap<1>(nl < 1024 ? 2048 + nl : 2304 + nl) : map == 6 ? srcmap<1>(nl < 2048 ? nl : nl < 2304 ? 1024 + nl : 1280 + nl) : map == 2 ? srcmap<2>(nl) : map == 3 ? srcmap<3>(nl) : U_G + nl;
    return t;
}
__device__ __forceinline__ void tr_load(const TrItem& t, f32x4 (&v)[16], int lane) {
#pragma unroll
    for (int i = 0; i < 16; ++i) { const int kk = 4 * i + (lane >> 4); v[i] = (f32x4){0.f, 0.f, 0.f, 0.f};
        if (t.srccol4 >= 0) { v[i] = *(const GAS f32x4*)(t.W + (size_t)(t.k0 + kk) * t.ldw + t.srccol4); if (t.gk) v[i] = v[i] * t.gk[t.k0 + kk]; } }
}
__device__ __forceinline__ void tr_all(const TrIn& I, unsigned char* ws, LAS float* scr, int gw, int NGW, int lane) {
    int it = gw; if (it >= TR_E11) return;
    TrItem cur = tr_decode(I, ws, it, lane); f32x4 v[16]; tr_load(cur, v, lane);
    for (;;) {
        const int c4 = (lane & 15) * 4;
#pragma unroll
        for (int i = 0; i < 16; ++i) *(LAS f32x4*)(scr + (4 * i + (lane >> 4)) * 68 + c4) = v[i];
        LDS_WAIT(); asm volatile("" ::: "memory");
        const int itn = it + NGW; const bool more = itn < TR_E11; TrItem nxt = cur;
        if (more) { nxt = tr_decode(I, ws, itn, lane); tr_load(nxt, v, lane); }
        if (cur.mode == 2) { unsigned char* orow = (unsigned char*)cur.WT + (size_t)(cur.drow0 + lane) * cur.K + cur.k0; const float wm = cur.wmul;
#pragma unroll
            for (int k16 = 0; k16 < 4; ++k16) { const LAS float* s = scr + (16 * k16) * 68 + lane; v4u o;
                o.x = pkf8(s[0 * 68] * wm, s[1 * 68] * wm, s[2 * 68] * wm, s[3 * 68] * wm); o.y = pkf8(s[4 * 68] * wm, s[5 * 68] * wm, s[6 * 68] * wm, s[7 * 68] * wm);
                o.z = pkf8(s[8 * 68] * wm, s[9 * 68] * wm, s[10 * 68] * wm, s[11 * 68] * wm); o.w = pkf8(s[12 * 68] * wm, s[13 * 68] * wm, s[14 * 68] * wm, s[15 * 68] * wm);
                *(GAS v4u*)(orow + 16 * k16) = o; } }
        else { bf16* orow = cur.WT + (size_t)(cur.drow0 + lane) * cur.K + cur.k0;
#pragma unroll
        for (int k8 = 0; k8 < 8; ++k8) { const LAS float* s = scr + (8 * k8) * 68 + lane;
            v4u o; if (cur.mode == 1) { o.x = pkh(s[0 * 68], s[1 * 68]); o.y = pkh(s[2 * 68], s[3 * 68]); o.z = pkh(s[4 * 68], s[5 * 68]); o.w = pkh(s[6 * 68], s[7 * 68]); }
            else { o.x = pk2(s[0 * 68], s[1 * 68]); o.y = pk2(s[2 * 68], s[3 * 68]); o.z = pk2(s[4 * 68], s[5 * 68]); o.w = pk2(s[6 * 68], s[7 * 68]); }
            *(GAS v4u*)(orow + 8 * k8) = o; } }
        LDS_WAIT(); asm volatile("" ::: "memory");
        if (!more) break;
        cur = nxt; it = itn;
    }
}
__device__ __forceinline__ void cvt_flat_h(const float* src, bf16* dst, unsigned char* dst8, size_t n8, size_t gt, size_t NT) {
    for (size_t i = gt; i < n8; i += 4 * NT) { f32x4 a[4], b[4];
#pragma unroll
        for (int u = 0; u < 4; ++u) { a[u] = *(const GAS f32x4*)(src + (i + u * NT) * 8); b[u] = *(const GAS f32x4*)(src + (i + u * NT) * 8 + 4); }
#pragma unroll
        for (int u = 0; u < 4; ++u) { *(GAS v4u*)(dst + (i + u * NT) * 8) = pack8h(a[u], b[u]);
            u32x2 w; w.x = pkf8(a[u][0], a[u][1], a[u][2], a[u][3]); w.y = pkf8(b[u][0], b[u][1], b[u][2], b[u][3]); *(GAS u32x2*)(dst8 + (i + u * NT) * 8) = w; } }
}
__device__ __forceinline__ void cvt_flat(const float* src, bf16* dst, size_t n8, size_t gt, size_t NT) {
    for (size_t i = gt; i < n8; i += 4 * NT) { f32x4 a[4], b[4];
#pragma unroll
        for (int u = 0; u < 4; ++u) { a[u] = *(const GAS f32x4*)(src + (i + u * NT) * 8); b[u] = *(const GAS f32x4*)(src + (i + u * NT) * 8 + 4); }
#pragma unroll
        for (int u = 0; u < 4; ++u) *(GAS v4u*)(dst + (i + u * NT) * 8) = pack8(a[u], b[u]); }
}

typedef const pg8::f32x4 (&AccRef)[2][2][4][2];
using pg8::f32x2;
using pg8::Unit;
#define EPI_ROWS(ai, m) for (int ai = 0; ai < 2; ++ai) _Pragma("unroll") for (int m = 0; m < 4; ++m)

template <int PM> struct EpiU {
    static constexpr bool PERM = true, AFTER_DRAIN = false;
    bf16 *QA, *QI, *KA, *VA, *KI, *KR, *CQ, *CKV; float* WI; float* SSQ; const float* ROPE;
    __device__ __forceinline__ void operator()(AccRef acc, const Unit& u, int wr, int wc, int fr, int fq) const {
        { int t_ = threadIdx.x; asm volatile("" : "+v"(t_)); fr = t_ & 15; fq = (t_ >> 4) & 3; }
        const int pn = PM == 1 ? (u.pn < 8 ? u.pn : u.pn == 8 ? 12 : u.pn + 5) : (u.pn < 4 ? 8 + u.pn : 13), rowb = u.pm * 256 + wr * 64 + fr, cw = wc * 32 + 8 * fq;
        if (pn < 12) {
            bf16* base = pn < 8 ? QA : QI; const int ldc = pn < 8 ? 2048 : 1024, colt = (pn < 8 ? pn : pn - 8) * 256; const float sc = pn < 8 ? QA_SCALE : 1.f;
#pragma unroll
            EPI_ROWS(ai, m) { bf16* rp = base + (size_t)(rowb + ai * 128 + m * 16) * ldc + colt + cw;
#pragma unroll
                for (int bj = 0; bj < 2; ++bj) *(GAS v4u*)(rp + bj * 128) = pn < 8 ? pack8(acc[ai][bj][m][0] * sc, acc[ai][bj][m][1] * sc) : pack8h(acc[ai][bj][m][0], acc[ai][bj][m][1]); }
        } else if (pn == 12) {
#pragma unroll
            EPI_ROWS(ai, m) { const size_t row = rowb + ai * 128 + m * 16;
                *(GAS v4u*)(KA + row * 128 + cw) = pack8(acc[ai][0][m][0], acc[ai][0][m][1]);
                *(GAS v4u*)(VA + row * 128 + cw) = pack8(acc[ai][1][m][0], acc[ai][1][m][1]); }
        } else if (pn == 13) {
#pragma unroll
            EPI_ROWS(ai, m) { const size_t row = rowb + ai * 128 + m * 16; const int pos = (int)(row & (SEQ - 1));
                const f32x4 v0 = acc[ai][0][m][0], v1 = acc[ai][0][m][1];
                if (wc < 2) { *(GAS v4u*)(KI + (row & ~(size_t)31) * 64 + (2 * wc + (fq >> 1)) * 512 + ((fq & 1) * 32 + (int)(row & 31)) * 8) = pack8h(v0, v1); }
                else { const int g = 4 * (wc - 2) + fq; const f32x4 c4 = *(const GAS f32x4*)(ROPE + pos * 32 + 4 * g), s4 = *(const GAS f32x4*)(ROPE + SEQ * 32 + pos * 32 + 4 * g);
                    const f32x4 y1 = v0 * c4 - v1 * s4, y2 = v0 * s4 + v1 * c4; GAS unsigned char* kr8 = (GAS unsigned char*)KR + row * 64 + 4 * g;
                    *(GAS unsigned*)kr8 = pkf8(y1[0], y1[1], y1[2], y1[3]); *(GAS unsigned*)(kr8 + 32) = pkf8(y2[0], y2[1], y2[2], y2[3]); }
                if (wc == 0 && fq < 2) { *(GAS f32x4*)(WI + row * 16 + 8 * fq) = acc[ai][1][m][0]; *(GAS f32x4*)(WI + row * 16 + 8 * fq + 4) = acc[ai][1][m][1]; } }
        } else {
            const int t = pn - 14; bf16* base = t < 2 ? CQ : CKV; float* ssq = SSQ + (t < 2 ? (size_t)0 : (size_t)M * 8); const int colt = (t & 1) * 256;
#pragma unroll
            EPI_ROWS(ai, m) { const size_t row = rowb + ai * 128 + m * 16; float s = 0.f;
#pragma unroll
                for (int bj = 0; bj < 2; ++bj) { const f32x4 v0 = acc[ai][bj][m][0], v1 = acc[ai][bj][m][1];
                    { u32x2 w8; w8.x = pkf8(v0[0], v0[1], v0[2], v0[3]); w8.y = pkf8(v1[0], v1[1], v1[2], v1[3]); *(GAS u32x2*)((GAS unsigned char*)base + row * 512 + colt + bj * 128 + cw) = w8; }
                    s += (v0[0] * v0[0] + v0[1] * v0[1]) + (v0[2] * v0[2] + v0[3] * v0[3]) + (v1[0] * v1[0] + v1[1] * v1[1]) + (v1[2] * v1[2] + v1[3] * v1[3]); }
                s = sum_x32(sum_x16(s));
                if (fq == 0) ssq[row * 8 + (t & 1) * 4 + wc] = s; }
        }
    }
};
struct EpiQ {
    static constexpr bool PERM = true, AFTER_DRAIN = false;
    bf16 *QN, *QR; const float* SSQ; const float* ROPE;
    __device__ __forceinline__ void operator()(AccRef acc, const Unit& u, int wr, int wc, int fr, int fq) const {
        { int t_ = threadIdx.x; asm volatile("" : "+v"(t_)); fr = t_ & 15; fq = (t_ >> 4) & 3; }
        const int pn = u.pn, rowb = u.pm * 256 + wr * 64 + fr, cw = wc * 32 + 8 * fq;
        float rs[8];
#pragma unroll
        for (int rb = 0; rb < 8; ++rb) { const size_t row = rowb + (rb >> 2) * 128 + (rb & 3) * 16; const f32x4 sa = *(const GAS f32x4*)(SSQ + row * 8), sb = *(const GAS f32x4*)(SSQ + row * 8 + 4);
            rs[rb] = (8.f * QB_SCALE) / sqrtf((((sa[0] + sa[1]) + (sa[2] + sa[3])) + ((sb[0] + sb[1]) + (sb[2] + sb[3]))) * (1.f / 512.f) + RMS_EPS); }
#pragma unroll
        EPI_ROWS(ai, m) { const size_t row = rowb + ai * 128 + m * 16; const float r = rs[ai * 4 + m];
            if (pn < 8) {
#pragma unroll
                for (int bj = 0; bj < 2; ++bj) { const f32x4 v0 = acc[ai][bj][m][0] * r, v1 = acc[ai][bj][m][1] * r; u32x2 w; w.x = pkf8(v0[0], v0[1], v0[2], v0[3]); w.y = pkf8(v1[0], v1[1], v1[2], v1[3]);
                    *(GAS u32x2*)((GAS unsigned char*)QN + row * 2048 + pn * 256 + bj * 128 + cw) = w; }
            } else { const int pos = (int)(row & (SEQ - 1)), g = 4 * (wc & 1) + fq;
                const f32x4 c4 = *(const GAS f32x4*)(ROPE + pos * 32 + 4 * g) * r, s4 = *(const GAS f32x4*)(ROPE + SEQ * 32 + pos * 32 + 4 * g) * r;
#pragma unroll
                for (int bj = 0; bj < 2; ++bj) { const int head = (pn - 8) * 4 + bj * 2 + (wc >> 1); const f32x4 v0 = acc[ai][bj][m][0], v1 = acc[ai][bj][m][1];
                    const f32x4 y1 = v0 * c4 - v1 * s4, y2 = v0 * s4 + v1 * c4; GAS unsigned char* q8 = (GAS unsigned char*)QR + row * 1024 + head * 64 + 4 * g;
                    *(GAS unsigned*)q8 = pkf8(y1[0], y1[1], y1[2], y1[3]); *(GAS unsigned*)(q8 + 32) = pkf8(y2[0], y2[1], y2[2], y2[3]); } } }
    }
};
struct EpiKV {
    static constexpr bool PERM = true, AFTER_DRAIN = false;
    bf16 *KN, *VB; const float* SSQ;
    __device__ __forceinline__ void operator()(AccRef acc, const Unit& u, int wr, int wc, int fr, int fq) const {
        { int t_ = threadIdx.x; asm volatile("" : "+v"(t_)); fr = t_ & 15; fq = (t_ >> 4) & 3; }
        const int pn = u.pn, rowb = u.pm * 256 + wr * 64 + fr, cw = wc * 32 + 8 * fq; bf16* base = pn < 8 ? KN : VB; const int colt = (pn & 7) * 256;
        float rs[8];
#pragma unroll
        for (int rb = 0; rb < 8; ++rb) { const size_t row = rowb + (rb >> 2) * 128 + (rb & 3) * 16; const f32x4 sa = *(const GAS f32x4*)(SSQ + row * 8), sb = *(const GAS f32x4*)(SSQ + row * 8 + 4);
            rs[rb] = 1.0f / sqrtf((((sa[0] + sa[1]) + (sa[2] + sa[3])) + ((sb[0] + sb[1]) + (sb[2] + sb[3]))) * (1.f / 512.f) + RMS_EPS); }
#pragma unroll
        EPI_ROWS(ai, m) { const size_t row = rowb + ai * 128 + m * 16; const float r = rs[ai * 4 + m];
#pragma unroll
            for (int bj = 0; bj < 2; ++bj) { const f32x4 v0 = acc[ai][bj][m][0] * r, v1 = acc[ai][bj][m][1] * r;
                if (pn < 8) { u32x2 w; w.x = pkf8(v0[0], v0[1], v0[2], v0[3]); w.y = pkf8(v1[0], v1[1], v1[2], v1[3]); *(GAS u32x2*)((GAS unsigned char*)KN + row * 2048 + colt + bj * 128 + cw) = w; }
                else *(GAS v4u*)(VB + row * 2048 + colt + bj * 128 + cw) = pack8(v0, v1); } }
    }
};
__device__ __forceinline__ void unpack8f8(const u32x2 w, f32x4& a, f32x4& b) {
    const f32x2 a0 = __builtin_amdgcn_cvt_pk_f32_fp8((int)w.x, false), a1 = __builtin_amdgcn_cvt_pk_f32_fp8((int)w.x, true), b0 = __builtin_amdgcn_cvt_pk_f32_fp8((int)w.y, false), b1 = __builtin_amdgcn_cvt_pk_f32_fp8((int)w.y, true);
    a = (f32x4){a0[0], a0[1], a1[0], a1[1]}; b = (f32x4){b0[0], b0[1], b1[0], b1[1]};
}
__device__ __forceinline__ u32x2 pack8f8(const f32x4 a, const f32x4 b) { u32x2 w; w.x = pkf8(a[0], a[1], a[2], a[3]); w.y = pkf8(b[0], b[1], b[2], b[3]); return w; }
template <int MODE> struct EpiB {
    static constexpr bool PERM = true, AFTER_DRAIN = false;
    bf16* O; int ldc; const bf16* gp; const float* bias; unsigned char* O8;
    __device__ __forceinline__ void operator()(AccRef acc, const Unit& u, int wr, int wc, int fr, int fq) const {
        { int t_ = threadIdx.x; asm volatile("" : "+v"(t_)); fr = t_ & 15; fq = (t_ >> 4) & 3; }
        const int rowb = u.pm * 256 + wr * 64 + fr, colb = u.pn * 256 + wc * 32 + 8 * fq;
        f32x4 bia[2][2];
        if (MODE == 4) {
#pragma unroll
            for (int bj = 0; bj < 2; ++bj) { bia[bj][0] = *(const GAS f32x4*)(bias + colb + bj * 128); bia[bj][1] = *(const GAS f32x4*)(bias + colb + bj * 128 + 4); } }
        u32x2 gq[4][2], oq[4][2];
#define EPIB_LD(rb_, bf_) do { const size_t row_ = rowb + ((rb_) >> 2) * 128 + ((rb_) & 3) * 16; _Pragma("unroll") for (int bj = 0; bj < 2; ++bj) { const int col_ = colb + bj * 128; \
            if (MODE == 2 || MODE == 5) gq[bf_][bj] = *(const GAS u32x2*)((const GAS unsigned char*)gp + row_ * 4096 + col_); \
            if (MODE == 4 || MODE == 5) oq[bf_][bj] = *(const GAS u32x2*)((const GAS unsigned char*)O + row_ * ldc + col_); } } while (0)
        if (MODE >= 2) {
#pragma unroll
            for (int rb = 0; rb < 4; ++rb) EPIB_LD(rb, rb);
            asm volatile("" ::: "memory"); }
#pragma unroll
        for (int rb = 0; rb < 8; ++rb) { const int ai = rb >> 2, m = rb & 3; const size_t row = rowb + ai * 128 + m * 16;
            u32x2 gc[2], oc[2];
            if (MODE >= 2) {
#pragma unroll
                for (int bj = 0; bj < 2; ++bj) { gc[bj] = gq[rb & 3][bj]; oc[bj] = oq[rb & 3][bj]; }
                if (rb + 4 < 8) { EPIB_LD(rb + 4 < 8 ? rb + 4 : 7, rb & 3); asm volatile("" ::: "memory"); } }
#pragma unroll
            for (int bj = 0; bj < 2; ++bj) { const int col = colb + bj * 128; f32x4 v0 = acc[ai][bj][m][0], v1 = acc[ai][bj][m][1]; GAS unsigned char* op = (GAS unsigned char*)O + row * ldc + col;
                if (MODE == 1) { v0 = sigmoid4(v0); v1 = sigmoid4(v1); }
                if (MODE == 2 || MODE == 5) { f32x4 g0, g1; unpack8f8(gc[bj], g0, g1); v0 = v0 * g0; v1 = v1 * g1; }
                if (MODE == 5) { f32x4 o0, o1; unpack8f8(oc[bj], o0, o1); v0 = v0 + o0; v1 = v1 + o1; }
                if (MODE == 4) { f32x4 o0, o1; unpack8f8(oc[bj], o0, o1); v0 = sigmoid4(v0 + bia[bj][0]) * o0; v1 = sigmoid4(v1 + bia[bj][1]) * o1; }
                if (MODE == 5) *(GAS u32x2*)(O8 + row * ldc + col) = pack8f8(v0, v1);
                else *(GAS u32x2*)op = pack8f8(v0, v1); }
            if (MODE >= 2) asm volatile("" ::: "memory"); }
#undef EPIB_LD
    }
};
template <int MODE> struct EpiF {
    static constexpr bool PERM = true, AFTER_DRAIN = false;
    bf16* zb; const float* xin; const bf16* ple;
    __device__ __forceinline__ void operator()(AccRef acc, const Unit& u, int wr, int wc, int fr, int fq) const {
        { int t_ = threadIdx.x; asm volatile("" : "+v"(t_)); fr = t_ & 15; fq = (t_ >> 4) & 3; }
        const int rowb = u.pm * 256 + wr * 64 + fr, colb = u.pn * 256 + wc * 32 + 8 * fq;
        f32x4 xq[4][2][2]; v4u zq[4][2]; u32x2 pq[4][2];
#define EPIF_LD(rb_, bf_) do { const size_t row_ = rowb + ((rb_) >> 2) * 128 + ((rb_) & 3) * 16; _Pragma("unroll") for (int bj = 0; bj < 2; ++bj) { const size_t off_ = row_ * 2048 + colb + bj * 128; \
            if (MODE == 0) { xq[bf_][bj][0] = *(const GAS f32x4*)(xin + off_); xq[bf_][bj][1] = *(const GAS f32x4*)(xin + off_ + 4); } \
            else { zq[bf_][bj] = *(const GAS v4u*)(zb + off_); pq[bf_][bj] = *(const GAS u32x2*)((const GAS unsigned char*)ple + off_); } } } while (0)
#pragma unroll
        for (int rb = 0; rb < 4; ++rb) EPIF_LD(rb, rb);
        asm volatile("" ::: "memory");
#pragma unroll
        for (int rb = 0; rb < 8; ++rb) { const int ai = rb >> 2, m = rb & 3; const size_t row = rowb + ai * 128 + m * 16;
            f32x4 xc[2][2]; v4u zc[2]; u32x2 pc[2];
#pragma unroll
            for (int bj = 0; bj < 2; ++bj) { if (MODE == 0) { xc[bj][0] = xq[rb & 3][bj][0]; xc[bj][1] = xq[rb & 3][bj][1]; } else { zc[bj] = zq[rb & 3][bj]; pc[bj] = pq[rb & 3][bj]; } }
            if (rb + 4 < 8) { EPIF_LD(rb + 4 < 8 ? rb + 4 : 7, rb & 3); asm volatile("" ::: "memory"); }
#pragma unroll
            for (int bj = 0; bj < 2; ++bj) { const size_t off = row * 2048 + colb + bj * 128; f32x4 v0 = acc[ai][bj][m][0], v1 = acc[ai][bj][m][1]; f32x4 x0, x1;
                if (MODE == 0) { x0 = xc[bj][0]; x1 = xc[bj][1]; } else unpack8(zc[bj], x0, x1);
                v0 = v0 + x0 * ALPHA; v1 = v1 + x1 * ALPHA;
                if (MODE == 1) { f32x4 p0, p1; unpack8f8(pc[bj], p0, p1); v0 = v0 + p0; v1 = v1 + p1; }
                *(GAS v4u*)(zb + off) = pack8(v0, v1); }
            asm volatile("" ::: "memory"); }
#undef EPIF_LD
    }
};
template <int CTRL> __device__ __forceinline__ f32x4 dpp4(f32x4 v) { return (f32x4){dppf<CTRL>(v[0]), dppf<CTRL>(v[1]), dppf<CTRL>(v[2]), dppf<CTRL>(v[3])}; }
__device__ __forceinline__ f32x4 sel4(bool c, f32x4 a, f32x4 b) { return (f32x4){c ? a[0] : b[0], c ? a[1] : b[1], c ? a[2] : b[2], c ? a[3] : b[3]}; }
struct EpiUp {
    static constexpr bool PERM = true, AFTER_DRAIN = false;
    unsigned char* ACT; float* HEADB; float* TAILB; const float* cw; const float* cb; LAS float* cwl;
    __device__ __forceinline__ void operator()(AccRef acc, const Unit& u, int wr, int wc, int fr, int fq) const {
        { int t_ = threadIdx.x; asm volatile("" : "+v"(t_)); fr = t_ & 15; fq = (t_ >> 4) & 3; }
        const unsigned ch0 = (unsigned)(u.pn * 128 + wc * 32 + 8 * fq), cp0 = (unsigned)(u.pn * 256 + wc * 32 + 8 * fq);
        { int t2_ = threadIdx.x; asm volatile("" : "+v"(t2_)); const int e_ = 2 * t2_, k_ = e_ >> 8, c_ = e_ & 255, bj_ = c_ >> 7, cl_ = c_ & 127;
          const float* src_ = k_ < 3 ? cw + (size_t)k_ * NUP + bj_ * DFF + u.pn * 128 + cl_ : cb + bj_ * DFF + u.pn * 128 + cl_;
          const f32x2 wv_ = *(const GAS f32x2*)src_; *(LAS f32x2*)(cwl + e_) = wv_; }
        __syncthreads();
        const unsigned cl0 = (unsigned)(wc * 32 + 8 * fq);
        const GAS unsigned char* cwb = (const GAS unsigned char*)cw; const GAS unsigned char* cbb = (const GAS unsigned char*)cb; GAS unsigned char* actb = (GAS unsigned char*)ACT;
#pragma unroll
        for (int ai = 0; ai < 2; ++ai) {
            const unsigned g = (unsigned)(u.pm * 4 + ai * 2 + wr), row0 = g * 64u + (unsigned)fr;
            if (fr < 2) { GAS unsigned char* hp = (GAS unsigned char*)HEADB + ((g * 2u + (unsigned)fr) * (unsigned)NUP + cp0) * 4u;
#pragma unroll
                for (int bj = 0; bj < 2; ++bj)
#pragma unroll
                    for (int n = 0; n < 2; ++n) *(GAS f32x4*)(hp + (bj * 128 + 4 * n) * 4) = acc[ai][bj][0][n]; }
            if (fr >= 14) { GAS unsigned char* hp = (GAS unsigned char*)TAILB + ((g * 2u + (unsigned)(fr - 14)) * (unsigned)NUP + cp0) * 4u;
#pragma unroll
                for (int bj = 0; bj < 2; ++bj)
#pragma unroll
                    for (int n = 0; n < 2; ++n) *(GAS f32x4*)(hp + (bj * 128 + 4 * n) * 4) = acc[ai][bj][3][n]; }
            asm volatile("" ::: "memory"); __builtin_amdgcn_sched_barrier(0);
#pragma unroll
            for (int n = 0; n < 2; ++n) {
                unsigned pk[4];
#pragma unroll
                for (int hf = 0; hf < 2; ++hf) {
                    asm volatile("" ::: "memory"); __builtin_amdgcn_sched_barrier(0);
                    f32x2 yg[4];
#pragma unroll
                    for (int bj = 0; bj < 2; ++bj) { const LAS float* wl_ = cwl + (cl0 + (unsigned)(4 * n + 2 * hf + bj * 128));
                        const f32x2 w0 = *(const LAS f32x2*)wl_, w1 = *(const LAS f32x2*)(wl_ + 256), w2 = *(const LAS f32x2*)(wl_ + 512), bb = *(const LAS f32x2*)(wl_ + 768);
                        f32x2 pr1 = (f32x2){0.f, 0.f}, pr2 = pr1;
#pragma unroll
                        for (int m = 0; m < 4; ++m) { const f32x4 v4 = acc[ai][bj][m][n]; const f32x2 v = hf ? (f32x2){v4[2], v4[3]} : (f32x2){v4[0], v4[1]};
                            const f32x2 r1 = (f32x2){dppf<0x121>(v[0]), dppf<0x121>(v[1])}, r2 = (f32x2){dppf<0x122>(v[0]), dppf<0x122>(v[1])};
                            const f32x2 p1 = fr >= 1 ? r1 : pr1, p2 = fr >= 2 ? r2 : pr2;
                            const f32x2 y = bb + w2 * v + w1 * p1 + w0 * p2; pr1 = r1; pr2 = r2;
                            if (bj == 0) yg[m] = y;
                            else { const f32x2 sg = (f32x2){sigmoidf_(yg[m][0]), sigmoidf_(yg[m][1])}; const f32x2 a = yg[m] * sg * y;
                                if (hf == 0) pk[m] = (unsigned)__builtin_amdgcn_cvt_pk_fp8_f32(a[0], a[1], 0, false);
                                else { const unsigned w = (unsigned)__builtin_amdgcn_cvt_pk_fp8_f32(a[0], a[1], (int)pk[m], true); if (!(m == 0 && fr < 2)) *(GAS unsigned*)(actb + ((row0 + (unsigned)(m * 16)) * (unsigned)DFF + ch0 + (unsigned)(4 * n))) = w; } } }
                        asm volatile("" ::: "memory"); __builtin_amdgcn_sched_barrier(0); }
                }
            }
        }
    }
};

namespace dsa {
constexpr int CAP = 512, TOPK = 256;
typedef unsigned long long u64;
typedef unsigned short u16;
__device__ __forceinline__ unsigned fkey(float f) { const unsigned u = __float_as_uint(f); return u ^ ((unsigned)((int)u >> 31) | 0x80000000u); }
__device__ __forceinline__ float keyf(unsigned k) { const unsigned u = (k & 0x80000000u) ? (k ^ 0x80000000u) : ~k; return __uint_as_float(u); }
__device__ __forceinline__ int mbcnt64(u64 m) { return (int)__builtin_amdgcn_mbcnt_hi((unsigned)(m >> 32), __builtin_amdgcn_mbcnt_lo((unsigned)m, 0u)); }

__device__ __forceinline__ unsigned wave_umax(unsigned v) {
#define DSA_UDPP(c_) (unsigned)__builtin_amdgcn_update_dpp(0, (int)v, c_, 0xf, 0xf, false)
    v = max(v, DSA_UDPP(0xB1)); v = max(v, DSA_UDPP(0x4E)); v = max(v, DSA_UDPP(0x141)); v = max(v, DSA_UDPP(0x140));
#undef DSA_UDPP
    { auto r = __builtin_amdgcn_permlane16_swap(v, v, false, false); v = max(r[0], r[1]); }
    { auto r = __builtin_amdgcn_permlane32_swap(v, v, false, false); v = max(r[0], r[1]); }
    return v;
}
__device__ __forceinline__ unsigned compact(LAS u64* buf, int n, int lane, unsigned lowk, bool exact, int& nout) {
    unsigned key[8], idx[8];
#pragma unroll
    for (int e = 0; e < 8; ++e) { const int i = lane + 64 * e; u64 v = 0ull; if (i < n) v = buf[i]; key[e] = (unsigned)(v >> 32); idx[e] = (unsigned)v; }
    unsigned mx = key[0];
#pragma unroll
    for (int e = 1; e < 8; ++e) mx = max(mx, key[e]);
    mx = (unsigned)__builtin_amdgcn_readfirstlane((int)wave_umax(mx));
    const unsigned diff = lowk ^ mx; unsigned P = lowk;
    if (diff) { const int hb = 31 - __builtin_clz(diff); P = hb == 31 ? 0u : (lowk >> (hb + 1)) << (hb + 1); const int lob = exact ? 0 : (hb > 15 ? hb - 15 : 0);
#pragma unroll 1
        for (int b = hb; b >= lob; --b) { const unsigned cand = P | (1u << b); int c = 0;
#pragma unroll
            for (int e = 0; e < 8; ++e) c += __builtin_popcountll(__ballot(key[e] >= cand));
            if (c >= TOPK) { P = cand; if (c == TOPK || (!exact && c <= TOPK + 48)) break; } } }
    int cgt = 0;
#pragma unroll
    for (int e = 0; e < 8; ++e) cgt += __builtin_popcountll(__ballot(key[e] > P));
    const int need = exact ? TOPK - cgt : CAP; int base = 0, eqbase = 0;
#pragma unroll
    for (int e = 0; e < 8; ++e) { const bool gt = key[e] > P, eq = key[e] == P && key[e] != 0u; const u64 beq = __ballot(eq); const bool sel = gt || (eq && (eqbase + mbcnt64(beq)) < need);
        const u64 bs = __ballot(sel); const int pos = base + mbcnt64(bs);
        if (sel) buf[pos] = ((u64)key[e] << 32) | idx[e];
        base += __builtin_popcountll(bs); eqbase += __builtin_popcountll(beq); }
    asm volatile("s_waitcnt lgkmcnt(0)" ::: "memory");
    nout = base;
    return P;
}

struct Ptrs { const bf16 *QI, *KI, *KA, *VA; const float* WI; const bf16* QA; bf16* O; unsigned short* SEL; };

__device__ __forceinline__ void attend(const Ptrs& P, int b, int t, const LAS u16* idl, LAS unsigned char* vbuf, int lane) {
    const int head = lane & 15, g = lane >> 4; const size_t m = (size_t)b * SEQ + t;
    bf16x8 Bq[4];
#pragma unroll
    for (int ks = 0; ks < 4; ++ks) Bq[ks] = *(const GAS bf16x8*)(P.QA + m * 2048 + head * 128 + 32 * ks + 8 * g);
    const float slope2 = __builtin_amdgcn_exp2f(-0.5f * (float)(head + 1)) * LOG2E;
    const bf16* vab = P.VA + (size_t)b * SEQ * 128;
    v4u st[8];
#define DSA_VLOAD(kk) do { _Pragma("unroll") for (int u_ = 0; u_ < 8; ++u_) { const int row_ = 4 * u_ + g; unsigned s_ = idl[32 * (kk) + row_]; s_ = s_ == 0xFFFFu ? 0u : s_; \
        const int cl_ = (lane & 15) ^ ((row_ & 7) << 1); st[u_] = *(const GAS v4u*)(vab + (size_t)s_ * 128 + cl_ * 8); } } while (0)
#define DSA_VWRITE(kk) do { _Pragma("unroll") for (int u_ = 0; u_ < 8; ++u_) *(LAS v4u*)(vbuf + ((kk) & 1) * 8192 + u_ * 1024 + lane * 16) = st[u_]; } while (0)
    DSA_VLOAD(0);
    const bf16* kab = P.KA + (size_t)b * SEQ * 128 + 8 * g;
    f32x4 L[16];
    bf16x8 Af[16][4];
#define DSA_KLD(i_) do { unsigned s_ = idl[16 * (i_) + head]; s_ = s_ == 0xFFFFu ? 0u : s_; const bf16* kp_ = kab + (size_t)s_ * 128; \
        _Pragma("unroll") for (int ks = 0; ks < 4; ++ks) Af[i_][ks] = *(const GAS bf16x8*)(kp_ + 32 * ks); } while (0)
    DSA_KLD(0); __builtin_amdgcn_sched_barrier(0); DSA_KLD(1); __builtin_amdgcn_sched_barrier(0); DSA_KLD(2); __builtin_amdgcn_sched_barrier(0);
#pragma unroll
    for (int i = 0; i < 16; ++i) {
        if (i + 3 < 16) { DSA_KLD(i + 3 < 16 ? i + 3 : 15); } __builtin_amdgcn_sched_barrier(0);
        f32x4 C = (f32x4){0.f, 0.f, 0.f, 0.f};
#pragma unroll
        for (int ks = 0; ks < 4; ++ks) C = __builtin_amdgcn_mfma_f32_16x16x32_bf16(Af[i][ks], Bq[ks], C, 0, 0, 0);
        const u32x2 idw = *(const LAS u32x2*)(idl + 16 * i + 4 * g);
        const unsigned i0 = idw.x & 0xffffu, i1 = idw.x >> 16, i2 = idw.y & 0xffffu, i3 = idw.y >> 16;
        L[i][0] = i0 == 0xFFFFu ? -__builtin_inff() : C[0] - slope2 * (float)(t - (int)i0);
        L[i][1] = i1 == 0xFFFFu ? -__builtin_inff() : C[1] - slope2 * (float)(t - (int)i1);
        L[i][2] = i2 == 0xFFFFu ? -__builtin_inff() : C[2] - slope2 * (float)(t - (int)i2);
        L[i][3] = i3 == 0xFFFFu ? -__builtin_inff() : C[3] - slope2 * (float)(t - (int)i3);
        __builtin_amdgcn_sched_barrier(0);
    }
#undef DSA_KLD
    float mx = -__builtin_inff();
#pragma unroll
    for (int i = 0; i < 16; ++i) mx = fmaxf(fmaxf(mx, fmaxf(L[i][0], L[i][1])), fmaxf(L[i][2], L[i][3]));
    mx = max_x32(max_x16(mx));
    float sum = 0.f;
#pragma unroll
    for (int i = 0; i < 16; ++i) {
#pragma unroll
        for (int r = 0; r < 4; ++r) { const float p = __builtin_amdgcn_exp2f(L[i][r] - mx); L[i][r] = p; sum += p; } }
    sum = sum_x32(sum_x16(sum));
    f32x4 O[8];
#pragma unroll
    for (int dt = 0; dt < 8; ++dt) O[dt] = (f32x4){0.f, 0.f, 0.f, 0.f};
    DSA_VWRITE(0); DSA_VLOAD(1);
    const int q4 = (lane >> 2) & 3, p4 = lane & 3, row1 = 4 * g + q4;
#pragma unroll
    for (int kk = 0; kk < 8; ++kk) {
        const v4u pw = pack8(L[2 * kk], L[2 * kk + 1]); const bf16x8 Pf = __builtin_bit_cast(bf16x8, pw);
        const LAS unsigned char* vb = vbuf + (kk & 1) * 8192 + row1 * 256 + 8 * p4;
        s16x4 lo[8], hi2[8];
#pragma unroll
        for (int dt = 0; dt < 8; ++dt) { const LAS unsigned char* a1 = vb + ((dt ^ (row1 & 7)) << 5);
            lo[dt] = __builtin_bit_cast(s16x4, __builtin_amdgcn_ds_read_tr16_b64_v4i16((LAS s16x4*)a1));
            hi2[dt] = __builtin_bit_cast(s16x4, __builtin_amdgcn_ds_read_tr16_b64_v4i16((LAS s16x4*)(a1 + 4096))); }
#pragma unroll
        for (int dt = 0; dt < 8; ++dt) {
            const bf16x8 Av = (bf16x8){lo[dt][0], lo[dt][1], lo[dt][2], lo[dt][3], hi2[dt][0], hi2[dt][1], hi2[dt][2], hi2[dt][3]};
            O[dt] = __builtin_amdgcn_mfma_f32_16x16x32_bf16(Av, Pf, O[dt], 0, 0, 0); }
        if (kk + 1 < 8) { DSA_VWRITE(kk + 1); if (kk + 2 < 8) DSA_VLOAD(kk + 2); }
    }
#undef DSA_VLOAD
#undef DSA_VWRITE
    const float inv = 1.0f / sum;
    unsigned char* op = (unsigned char*)P.O + m * 4096 + head * 128 + 4 * g;
#pragma unroll
    for (int dt = 0; dt < 8; ++dt) { const f32x4 o = O[dt] * inv; *(GAS unsigned*)(op + 16 * dt) = pkf8(o[0], o[1], o[2], o[3]); }
}

__device__ __forceinline__ void job(const Ptrs& P, int b, int t0, LAS unsigned char* wl, LAS u16* idl, int lane, volatile LAS unsigned* dbgp = nullptr) {
#if defined(DBG_SPIN)
    unsigned long long tcomp = 0ull, tatt = 0ull; const unsigned long long tj0 = __builtin_amdgcn_s_memrealtime();
#endif
    const int r32 = lane & 31, hi = lane >> 5;
    const int qsel = (r32 >> 2) & 1, headA = (r32 & 3) + 4 * (r32 >> 3);
    bf16x8 A[2][4]; float sg[2][16];
#pragma unroll
    for (int a = 0; a < 2; ++a) {
        const size_t mA = (size_t)b * SEQ + t0 + 2 * a + qsel; const float aw = P.WI[mA * 16 + headA];
#pragma unroll
        for (int d0 = 0; d0 < 4; ++d0) { f32x4 x0, x1; unpack8h(*(const GAS v4u*)(P.QI + mA * 1024 + headA * 64 + 16 * d0 + 8 * hi), x0, x1); A[a][d0] = __builtin_bit_cast(bf16x8, pack8h(x0 * aw, x1 * aw)); }
        const size_t mC = (size_t)b * SEQ + t0 + 2 * a + hi;
#pragma unroll
        for (int r4 = 0; r4 < 4; ++r4) { const f32x4 w4 = *(const GAS f32x4*)(P.WI + mC * 16 + 4 * r4);
#pragma unroll
            for (int j = 0; j < 4; ++j) sg[a][4 * r4 + j] = w4[j] < 0.f ? -__builtin_inff() : __builtin_inff(); }
    }
    LAS u64* cand = (LAS u64*)wl;
    int c0 = 0, c1 = 0, c2 = 0, c3 = 0; unsigned l0 = 0u, l1 = 0u, l2 = 0u, l3 = 0u; float tau0 = -__builtin_inff(), tau1 = -__builtin_inff();
    const int ntile = (t0 + 3) / 32 + 1;
    const bf16* kib = P.KI + (size_t)b * SEQ * 64 + 8 * lane;
    bf16x8 B0[4], B1[4], B2[4], B3[4];
#define DSA_LDK(B_, JN_) do { const int jn_ = (JN_) < ntile ? (JN_) : ntile - 1; _Pragma("unroll") for (int d0 = 0; d0 < 4; ++d0) B_[d0] = *(const GAS bf16x8*)(kib + (size_t)jn_ * 2048 + 512 * d0); } while (0)
    DSA_LDK(B0, 0); asm volatile("" ::: "memory"); DSA_LDK(B1, 1); asm volatile("" ::: "memory"); DSA_LDK(B2, 2); asm volatile("" ::: "memory"); DSA_LDK(B3, 3); asm volatile("" ::: "memory");
#if defined(DBG_SPIN)
#define DSA_TC0 const unsigned long long tc0 = __builtin_amdgcn_s_memrealtime();
#define DSA_TC1 tcomp += __builtin_amdgcn_s_memrealtime() - tc0;
#else
#define DSA_TC0
#define DSA_TC1
#endif
#define DSA_TILE(JT_, Bf) do { const int jt = (JT_); const int s = jt * 32 + r32; \
        f32x16 C0 = {}, C1 = {}; \
        _Pragma("unroll") for (int d0 = 0; d0 < 4; ++d0) C0 = __builtin_amdgcn_mfma_f32_32x32x16_f16(__builtin_bit_cast(f16x8, A[0][d0]), __builtin_bit_cast(f16x8, Bf[d0]), C0, 0, 0, 0); \
        _Pragma("unroll") for (int d0 = 0; d0 < 4; ++d0) C1 = __builtin_amdgcn_mfma_f32_32x32x16_f16(__builtin_bit_cast(f16x8, A[1][d0]), __builtin_bit_cast(f16x8, Bf[d0]), C1, 0, 0, 0); \
        DSA_LDK(Bf, jt + 4); \
        float scv[2]; \
        _Pragma("unroll") for (int a = 0; a < 2; ++a) { float s_ = 0.f;                                                    \
            _Pragma("unroll") for (int r = 0; r < 16; ++r) { s_ += __builtin_amdgcn_fmed3f(a == 0 ? C0[r] : C1[r], 0.f, sg[a][r]); if ((r & 3) == 3) asm volatile("" : "+v"(s_)); } \
            scv[a] = s_; } \
        _Pragma("unroll") for (int a = 0; a < 2; ++a) { \
            const float sc = scv[a]; \
            const int tq = t0 + 2 * a + hi; const float tau = a == 0 ? tau0 : tau1; \
            const bool pass = (s <= tq) && (sc > tau); \
            const u64 bal = __ballot(pass); \
            if (bal) { const unsigned blo = (unsigned)bal, bhi = (unsigned)(bal >> 32); \
                const int pre = hi ? (int)__builtin_amdgcn_mbcnt_hi(bhi, 0u) : (int)__builtin_amdgcn_mbcnt_lo(blo, 0u); \
                const int cq = a == 0 ? (hi ? c1 : c0) : (hi ? c3 : c2); \
                if (pass) cand[(2 * a + hi) * CAP + cq + pre] = ((u64)fkey(sc) << 32) | (unsigned)s; \
                if (a == 0) { c0 += __builtin_popcount(blo); c1 += __builtin_popcount(bhi); } else { c2 += __builtin_popcount(blo); c3 += __builtin_popcount(bhi); } } \
        } \
        const int lim = (jt == ntile - 1) ? TOPK : CAP - 32; \
        _Pragma("unroll 1") for (;;) { \
            const int q = c0 > lim ? 0 : c1 > lim ? 1 : c2 > lim ? 2 : c3 > lim ? 3 : -1; \
            if (q < 0) break; \
            int n = q == 0 ? c0 : q == 1 ? c1 : q == 2 ? c2 : c3; unsigned lowk = q == 0 ? l0 : q == 1 ? l1 : q == 2 ? l2 : l3; \
            asm volatile("s_waitcnt lgkmcnt(0)" ::: "memory"); \
            DSA_TC0 \
            bool ex = jt == ntile - 1; int nout; unsigned T; \
            _Pragma("unroll 1") for (;;) { T = compact(cand + q * CAP, n, lane, lowk, ex, nout); if (ex || nout <= lim) break; ex = true; n = nout; lowk = T; } \
            const float tf = keyf(T); \
            DSA_TC1 \
            if (q == 0) { c0 = nout; l0 = T; } else if (q == 1) { c1 = nout; l1 = T; } else if (q == 2) { c2 = nout; l2 = T; } else { c3 = nout; l3 = T; } \
            if ((q >> 1) == 0) { if (hi == (q & 1)) tau0 = tf; } else { if (hi == (q & 1)) tau1 = tf; } \
        } } while (0)
#pragma unroll 1
    for (int jt0 = 0; jt0 < ntile; jt0 += 4) { DSA_TILE(jt0, B0); DSA_TILE(jt0 + 1, B1); DSA_TILE(jt0 + 2, B2); DSA_TILE(jt0 + 3, B3); }
#undef DSA_TILE
#undef DSA_LDK
#undef DSA_TC0
#undef DSA_TC1
    asm volatile("s_waitcnt lgkmcnt(0)" ::: "memory");
#pragma unroll
    for (int q = 0; q < 4; ++q) { const int n = q == 0 ? c0 : q == 1 ? c1 : q == 2 ? c2 : c3;
#pragma unroll
        for (int e = 0; e < 4; ++e) { const int i = lane + 64 * e; unsigned v = 0xFFFFu; if (i < n) v = (unsigned)cand[q * CAP + i] & 0xFFFFu;
#if defined(DBG_FIXED_SEL)
            v = (t0 + q - i) >= 0 ? (unsigned)(t0 + q - i) : 0xFFFFu;
#endif
            idl[q * TOPK + i] = (u16)v; if (P.SEL) P.SEL[((size_t)b * SEQ + t0 + q) * TOPK + i] = (u16)v; } }
    asm volatile("s_waitcnt lgkmcnt(0)" ::: "memory");
#if defined(DBG_SPIN)
    const unsigned long long ta0 = __builtin_amdgcn_s_memrealtime();
#endif
#pragma unroll 1
    for (int q = 0; q < 4; ++q) attend(P, b, t0 + q, idl + q * TOPK, wl, lane);
#if defined(DBG_SPIN)
    tatt = __builtin_amdgcn_s_memrealtime() - ta0;
    if (dbgp && lane == 0) { dbgp[0] += (unsigned)tcomp; dbgp[1] += (unsigned)tatt; dbgp[2] += (unsigned)(__builtin_amdgcn_s_memrealtime() - tj0); }
#endif
}
}

namespace mla {
constexpr int NW = 8, QBLK = 32, KVBLK = 64, QB = 256;
constexpr int SHM_V = 16384, SHM_K = 8192, SHM_R = 4096;
constexpr int OFF_V = 0, OFF_K = 3 * SHM_V, OFF_R = OFF_K + 4 * SHM_K, OFF_WS = OFF_R + 4 * SHM_R, LDS_NEED = OFF_WS + NW * 64 * 4;
constexpr float THR = 8.f;
#define MLA_KSWZ(row, colB) ((row) * 256 + ((colB) ^ (((row) & 7) << 4)))
#define MLA_RSWZ(row, colB) ((row) * 128 + ((colB) ^ ((((row) >> 1) & 7) << 4)))
#define MLA_SBAR() __builtin_amdgcn_sched_barrier(0)
__device__ __forceinline__ int v_st(int k, int c) { const int kk = (k & ~0xC) | ((k & 4) << 1) | ((k & 8) >> 1); return ((kk >> 3) * 4 + (c >> 5)) * 512 + ((kk & 7) * 32 + (c & 31)) * 2; }
__device__ __forceinline__ int v_rd_base(int lane) { return ((lane & 3) << 3) | (((lane >> 2) & 3) << 6) | (((lane >> 4) & 1) << 5) | (((lane >> 5) & 1) << 8); }
constexpr int v_rd_off(int d0, int ks, int half) { return d0 * 512 + ks * 4096 + half * 2048; }
__device__ __forceinline__ int crow(int r, int hi) { return (r & 3) + 8 * (r >> 2) + 4 * hi; }
__device__ __forceinline__ unsigned cvtpk(float lo, float hi) { return pg8::cvt_pk_bf16(lo, hi); }

__device__ __forceinline__ void mask_tile(f32x16& p0, f32x16& p1, int dq) {
    const float NEG = -__builtin_inff();
#pragma unroll
    for (int r = 0; r < 16; ++r) { const int c = (r & 3) + 8 * (r >> 2);
        if (dq - c < 0) p0[r] = NEG;
        if (dq - c - 32 < 0) p1[r] = NEG; }
}
__device__ __forceinline__ void softmax_tile(f32x16& p0, f32x16& p1, float& m_reg, float& l_reg, float& alpha, bf16x8& pa0, bf16x8& pa1, bf16x8& pa2, bf16x8& pa3) {
    float pmax = p0[0];
#pragma unroll
    for (int r = 1; r < 16; ++r) pmax = fmaxf(pmax, p0[r]);
#pragma unroll
    for (int r = 0; r < 16; ++r) pmax = fmaxf(pmax, p1[r]);
    { auto rr = __builtin_amdgcn_permlane32_swap(__float_as_uint(pmax), __float_as_uint(pmax), false, false); pmax = fmaxf(__uint_as_float(rr[0]), __uint_as_float(rr[1])); }
    float mn;
    if (__builtin_expect(__all((pmax - m_reg) <= THR), 1)) { mn = m_reg; alpha = 1.f; }
    else { mn = fmaxf(m_reg, pmax); alpha = __builtin_amdgcn_exp2f(m_reg - mn); m_reg = mn; }
#pragma unroll
    for (int r = 0; r < 16; ++r) { p0[r] = __builtin_amdgcn_exp2f(p0[r] - mn); p1[r] = __builtin_amdgcn_exp2f(p1[r] - mn); }
    float ps = 0.f;
#pragma unroll
    for (int r = 0; r < 16; ++r) ps += p0[r];
#pragma unroll
    for (int r = 0; r < 16; ++r) ps += p1[r];
    { auto rr = __builtin_amdgcn_permlane32_swap(__float_as_uint(ps), __float_as_uint(ps), false, false); ps = __uint_as_float(rr[0]) + __uint_as_float(rr[1]); }
    l_reg = l_reg * alpha + ps;
#define MLA_PK4(P, B_, OUT) do { unsigned a0 = cvtpk(P[B_ + 0], P[B_ + 1]), a1 = cvtpk(P[B_ + 2], P[B_ + 3]); unsigned b0 = cvtpk(P[B_ + 4], P[B_ + 5]), b1 = cvtpk(P[B_ + 6], P[B_ + 7]); \
        auto r0 = __builtin_amdgcn_permlane32_swap(a0, b0, false, false); auto r1 = __builtin_amdgcn_permlane32_swap(a1, b1, false, false); \
        v4u w = {r0[0], r1[0], r0[1], r1[1]}; OUT = __builtin_bit_cast(bf16x8, w); } while (0)
    MLA_PK4(p0, 0, pa0); MLA_PK4(p0, 8, pa1); MLA_PK4(p1, 0, pa2); MLA_PK4(p1, 8, pa3);
#undef MLA_PK4
}
typedef int i32x8q __attribute__((ext_vector_type(8))); typedef int i32x4q __attribute__((ext_vector_type(4)));
template <int KB>
__device__ __forceinline__ void qkt(f32x16& p0, f32x16& p1, const LAS unsigned char* lds, int r32, int hi, const i32x8q* q8) {
    p0 = f32x16{}; p1 = f32x16{};
    const LAS unsigned char* kr = lds + OFF_K + KB * SHM_K + r32 * 128; const int kx = (r32 >> 1) & 7;
    const LAS unsigned char* rr = lds + OFF_R + KB * SHM_R + r32 * 64; const int rx = (r32 >> 2) & 3;
#define MLA_LD32(base_, c_, x_, step_) __builtin_shufflevector(*(const LAS i32x4q*)((base_) + ((((c_)) ^ (x_)) << 4) + (step_)), *(const LAS i32x4q*)((base_) + ((((c_) + 1) ^ (x_)) << 4) + (step_)), 0, 1, 2, 3, 4, 5, 6, 7)
#pragma unroll
    for (int j = 0; j < 2; ++j) { const int c = 4 * j + 2 * hi;
        const i32x8q a0 = MLA_LD32(kr, c, kx, 0), a1 = MLA_LD32(kr, c, kx, 32 * 128);
        p0 = __builtin_amdgcn_mfma_scale_f32_32x32x64_f8f6f4(a0, q8[j], p0, 0, 0, 0, 127, 0, 127 - 3);
        p1 = __builtin_amdgcn_mfma_scale_f32_32x32x64_f8f6f4(a1, q8[j], p1, 0, 0, 0, 127, 0, 127 - 3); }
    { const int c = 2 * hi;
        const i32x8q a0 = MLA_LD32(rr, c, rx, 0), a1 = MLA_LD32(rr, c, rx, 32 * 64);
        p0 = __builtin_amdgcn_mfma_scale_f32_32x32x64_f8f6f4(a0, q8[2], p0, 0, 0, 0, 127, 0, 127 - 3);
        p1 = __builtin_amdgcn_mfma_scale_f32_32x32x64_f8f6f4(a1, q8[2], p1, 0, 0, 0, 127, 0, 127 - 3); }
#undef MLA_LD32
}
template <int VB>
__device__ __forceinline__ void pv_tile(f32x16* o, int vb0, bf16x8 pa0, bf16x8 pa1, bf16x8 pa2, bf16x8 pa3) {
#define MLA_TRRD(dst, off) asm volatile("ds_read_b64_tr_b16 %0, %1 offset:%2" : "=&v"(dst) : "v"(vb0), "i"(off) : "memory")
#define MLA_PV_D0(d0) do { s16x4 l0, l1, l2, l3, h0, h1, h2, h3; constexpr int b_ = OFF_V + VB * SHM_V + v_rd_off(d0, 0, 0); \
        MLA_TRRD(l0, b_); MLA_TRRD(h0, b_ + 2048); MLA_TRRD(l1, b_ + 4096); MLA_TRRD(h1, b_ + 6144); MLA_TRRD(l2, b_ + 8192); MLA_TRRD(h2, b_ + 10240); MLA_TRRD(l3, b_ + 12288); MLA_TRRD(h3, b_ + 14336); \
        asm volatile("s_waitcnt lgkmcnt(0)" ::: "memory"); MLA_SBAR(); \
        o[d0] = __builtin_amdgcn_mfma_f32_32x32x16_bf16(pa0, (bf16x8){l0[0], l0[1], l0[2], l0[3], h0[0], h0[1], h0[2], h0[3]}, o[d0], 0, 0, 0); \
        o[d0] = __builtin_amdgcn_mfma_f32_32x32x16_bf16(pa1, (bf16x8){l1[0], l1[1], l1[2], l1[3], h1[0], h1[1], h1[2], h1[3]}, o[d0], 0, 0, 0); \
        o[d0] = __builtin_amdgcn_mfma_f32_32x32x16_bf16(pa2, (bf16x8){l2[0], l2[1], l2[2], l2[3], h2[0], h2[1], h2[2], h2[3]}, o[d0], 0, 0, 0); \
        o[d0] = __builtin_amdgcn_mfma_f32_32x32x16_bf16(pa3, (bf16x8){l3[0], l3[1], l3[2], l3[3], h3[0], h3[1], h3[2], h3[3]}, o[d0], 0, 0, 0); } while (0)
    MLA_PV_D0(0); MLA_PV_D0(1); MLA_PV_D0(2); MLA_PV_D0(3);
#undef MLA_PV_D0
#undef MLA_TRRD
}
struct Tensors { const bf16* QN; const bf16* QR; const bf16* KN; const bf16* KR; const bf16* VB; bf16* O; };

__device__ __forceinline__ s16x4 vtr(const LAS unsigned char* p) { return __builtin_bit_cast(s16x4, __builtin_amdgcn_ds_read_tr16_b64_v4i16((LAS s16x4*)p)); }
template <int N> __device__ __forceinline__ i32x8q kfrag(const LAS unsigned char* kr, const LAS unsigned char* rr, int hi, int kx, int rx) {
    if (N < 4) { const int c = 4 * (N >> 1) + 2 * hi; const LAS unsigned char* b_ = kr + (N & 1) * 32 * 128;
        return __builtin_shufflevector(*(const LAS i32x4q*)(b_ + ((c ^ kx) << 4)), *(const LAS i32x4q*)(b_ + (((c + 1) ^ kx) << 4)), 0, 1, 2, 3, 4, 5, 6, 7); }
    const int c = 2 * hi; const LAS unsigned char* b_ = rr + (N & 1) * 32 * 64;
    return __builtin_shufflevector(*(const LAS i32x4q*)(b_ + ((c ^ rx) << 4)), *(const LAS i32x4q*)(b_ + (((c + 1) ^ rx) << 4)), 0, 1, 2, 3, 4, 5, 6, 7);
}
__device__ __forceinline__ float rowmax(const f32x16& p0, const f32x16& p1) {
    float pmax = p0[0];
#pragma unroll
    for (int r = 1; r < 16; ++r) pmax = fmaxf(pmax, p0[r]);
#pragma unroll
    for (int r = 0; r < 16; ++r) pmax = fmaxf(pmax, p1[r]);
    auto rr = __builtin_amdgcn_permlane32_swap(__float_as_uint(pmax), __float_as_uint(pmax), false, false); return fmaxf(__uint_as_float(rr[0]), __uint_as_float(rr[1]));
}

__device__ __forceinline__ void unit(const Tensors& T, int b, int h, int qb, LAS unsigned char* lds) {
    const int tid = threadIdx.x, wid = __builtin_amdgcn_readfirstlane(tid >> 6), lane = tid & 63, r32 = lane & 31, hi = lane >> 5;
    const size_t rowq = (size_t)b * SEQ + qb * QB + wid * QBLK + r32;
    i32x8q qr[3];
    { const GAS unsigned char* qn8 = (const GAS unsigned char*)T.QN + rowq * 2048 + h * 128 + 32 * hi; const GAS unsigned char* qr8 = (const GAS unsigned char*)T.QR + rowq * 1024 + h * 64 + 32 * hi;
#pragma unroll
      for (int j = 0; j < 2; ++j) qr[j] = __builtin_shufflevector(*(const GAS i32x4q*)(qn8 + 64 * j), *(const GAS i32x4q*)(qn8 + 64 * j + 16), 0, 1, 2, 3, 4, 5, 6, 7);
      qr[2] = __builtin_shufflevector(*(const GAS i32x4q*)qr8, *(const GAS i32x4q*)(qr8 + 16), 0, 1, 2, 3, 4, 5, 6, 7); }
    const int NT = 4 * (qb + 1);
    const int qlo = qb * QB + wid * QBLK, qm = qlo + r32 - 4 * hi;
    LAS float* ws = (LAS float*)(lds + OFF_WS) + wid * 64; LAS float* li_l = ws; LAS float* al_l = ws + 32;
    float mhat = 0.f, l_reg = 0.f; f32x16 o[4] = {}; bool resc = false;
    const LAS unsigned char* vp0 = lds + OFF_V + v_rd_base(lane);
    const LAS unsigned char* kr0 = lds + OFF_K + r32 * 128; const LAS unsigned char* rr0 = lds + OFF_R + r32 * 64; const int kx = (r32 >> 1) & 7, rx = (r32 >> 2) & 3;
    int voff[2], koff, roff;
#pragma unroll
    for (int i = 0; i < 2; ++i) { const int G_ = (wid + 8 * i) * 64 + lane;
        { const int st = G_ >> 5, w_ = G_ & 31, kk = (st >> 2) * 8 + (w_ >> 2), c = (st & 3) * 32 + (w_ & 3) * 8, k = (kk & ~0xC) | ((kk & 4) << 1) | ((kk & 8) >> 1); voff[i] = (k * 2048 + c) * 2; } }
    { const int G_ = wid * 64 + lane, row = G_ >> 3, slot = G_ & 7; koff = row * 2048 + 16 * (slot ^ ((row >> 1) & 7)); }
    { const int G_ = (wid & 3) * 64 + lane, row = G_ >> 2, slot = G_ & 3; roff = row * 64 + 16 * (slot ^ ((row >> 2) & 3)); }
    const unsigned char* Kh = (const unsigned char*)T.KN + (size_t)b * SEQ * 2048 + h * 128; const bf16* Vh = T.VB + (size_t)b * SEQ * 2048 + h * 128; const unsigned char* Rh = (const unsigned char*)T.KR + (size_t)b * SEQ * 64;
#define MLA_GLDS(base_, off_, dst_) do { unsigned sv_; const void* g_ = (const void*)(base_); const unsigned o_ = (unsigned)(off_); const unsigned d_ = (unsigned)__builtin_amdgcn_readfirstlane((int)(unsigned)(uintptr_t)(dst_)); \
        asm volatile("s_mov_b32 %0, m0\n\ts_mov_b32 m0, %3\n\ts_nop 0\n\tglobal_load_lds_dwordx4 %1, %2\n\ts_mov_b32 m0, %0" : "=&s"(sv_) : "v"(o_), "s"(g_), "s"(d_) : "memory"); } while (0)
#define MLA_DMA_V(k0, bf) do { _Pragma("unroll") for (int i_ = 0; i_ < 2; ++i_) MLA_GLDS((const unsigned char*)Vh + (size_t)(k0) * 4096, voff[i_], lds + OFF_V + (bf) * SHM_V + (wid + 8 * i_) * 1024); } while (0)
#define MLA_DMA_K(k0, bf) do { MLA_GLDS(Kh + (size_t)(k0) * 2048, koff, lds + OFF_K + (bf) * SHM_K + wid * 1024); \
        if (wid < 4) MLA_GLDS(Rh + (size_t)(k0) * 64, roff, lds + OFF_R + (bf) * SHM_R + wid * 1024); } while (0)
#define MLA_WAITBAR() do { asm volatile("s_waitcnt vmcnt(0)" ::: "memory"); __syncthreads(); } while (0)
#define MLA_WAITBAR_C() do { if (wid < 4) asm volatile("s_waitcnt vmcnt(4)" ::: "memory"); else asm volatile("s_waitcnt vmcnt(3)" ::: "memory"); __syncthreads(); } while (0)
#define MLA_PIN(x) asm volatile("" : "+v"(x))
#define MLA_RESC() do { if (resc) { _Pragma("unroll") for (int d_ = 0; d_ < 4; ++d_) _Pragma("unroll") for (int r = 0; r < 16; ++r) o[d_][r] *= al_l[crow(r, hi)]; } } while (0)
#define MLA_QMF(C_, a_, j_, I_) C_ = __builtin_amdgcn_mfma_scale_f32_32x32x64_f8f6f4(a_, qr[j_], I_, 0, 0, 0, 127, 0, 127 - 3)
#define MLA_KF(N_) kfrag<N_>(kr_, rr_, hi, kx, rx)
#define MLA_PK4(P, B_, OUT) do { unsigned a0 = cvtpk(P[B_ + 0], P[B_ + 1]), a1 = cvtpk(P[B_ + 2], P[B_ + 3]); unsigned b0 = cvtpk(P[B_ + 4], P[B_ + 5]), b1 = cvtpk(P[B_ + 6], P[B_ + 7]); \
        auto r0 = __builtin_amdgcn_permlane32_swap(a0, b0, false, false); auto r1 = __builtin_amdgcn_permlane32_swap(a1, b1, false, false); \
        OUT = (v4u){r0[0], r1[0], r0[1], r1[1]}; } while (0)
#define MLA_S2(P, i) do { sa0 += P[i]; sa1 += P[(i) + 1]; } while (0)
#define MLA_EX2S(X, i) do { X[i] = __builtin_amdgcn_exp2f(X[i] - mhat); X[(i) + 1] = __builtin_amdgcn_exp2f(X[(i) + 1] - mhat); } while (0)
#define MLA_EX2(X, i) do { X[i] = __builtin_amdgcn_exp2f(X[i]); X[(i) + 1] = __builtin_amdgcn_exp2f(X[(i) + 1]); } while (0)
#define MLA_VRD(n) do { vlo[n] = vtr(vp_ + (((n) & 3) * 512 + ((n) >> 2) * 4096)); vhi[n] = vtr(vp_ + (((n) & 3) * 512 + ((n) >> 2) * 4096 + 2048)); } while (0)
#define MLA_VFR(n) (bf16x8){vlo[n][0], vlo[n][1], vlo[n][2], vlo[n][3], vhi[n][0], vhi[n][1], vhi[n][2], vhi[n][3]}
#define MLA_PAF(k) __builtin_bit_cast(bf16x8, pw##k)
#define MLA_GAPB(n, k, X, i) do { o[(n) & 3] = __builtin_amdgcn_mfma_f32_32x32x16_bf16(MLA_PAF(k), MLA_VFR(n), o[(n) & 3], 0, 0, 0); if ((n) + 2 < 16) MLA_VRD((n) + 2 < 16 ? (n) + 2 : 15); \
        MLA_EX2(X, i); MLA_PIN(X); MLA_SBAR(); } while (0)
    f32x16 pA0, pA1, pB0, pB1; v4u pw0, pw1, pw2, pw3; s16x4 vlo[16], vhi[16]; i32x8q kf0, kf1;
    int ks_cur = 0, ks_nxt = 1, ks_n2 = 2, ks_n3 = 3, vs_rd = 2, vs_mid = 0, vs_wr = 1;
#define MLA_ROT() do { const int o_ = ks_cur; ks_cur = ks_nxt; ks_nxt = ks_n2; ks_n2 = ks_n3; ks_n3 = o_; const int p_ = vs_rd; vs_rd = vs_mid; vs_mid = vs_wr; vs_wr = p_; } while (0)
    MLA_DMA_K(0, 0); MLA_DMA_K(KVBLK, 1); MLA_DMA_K(2 * KVBLK, 2); MLA_DMA_V(0, 0); MLA_WAITBAR();
    MLA_DMA_K(3 * KVBLK, 3); MLA_DMA_V(KVBLK, 1);
    qkt<0>(pA0, pA1, lds, r32, hi, qr);
    if (NT == 4) mask_tile(pA0, pA1, qm);
    mhat = rowmax(pA0, pA1);
#pragma unroll
    for (int r = 0; r < 16; r += 2) { MLA_EX2S(pA0, r); MLA_EX2S(pA1, r); }
#define MLA_SEED(X) do { const float nm_ = -mhat; _Pragma("unroll") for (int r_ = 0; r_ < 16; ++r_) X[r_] = nm_; MLA_PIN(X); } while (0)
    MLA_SEED(pB0); MLA_SEED(pB1);
    MLA_ROT();
    { const LAS unsigned char* kr_ = kr0 + ks_cur * SHM_K; const LAS unsigned char* rr_ = rr0 + ks_cur * SHM_R; kf0 = MLA_KF(0); kf1 = MLA_KF(1); }
    MLA_WAITBAR_C();
#define MLA_MX(X, i) fmaxf(fmaxf(X[i], X[(i) + 1]), fmaxf(X[(i) + 2], X[(i) + 3]))
#define MLA_PV(n, k) o[(n) & 3] = __builtin_amdgcn_mfma_f32_32x32x16_bf16(MLA_PAF(k), MLA_VFR(n), o[(n) & 3], 0, 0, 0)
#define MLA_VN(n) do { if ((n) + 4 < 16) MLA_VRD((n) + 4 < 16 ? (n) + 4 : 15); } while (0)
#define MLA_STEP(C0, C1, P0, P1, t, MASK, GK, GN) do { MLA_SBAR(); \
    const LAS unsigned char* kr_ = kr0 + ks_cur * SHM_K; const LAS unsigned char* rr_ = rr0 + ks_cur * SHM_R; const LAS unsigned char* vp_ = vp0 + vs_rd * SHM_V; \
    i32x8q kf2, kf3, kf4, kf5; \
    float sa0 = P0[0], sa1 = P0[1]; \
    MLA_QMF(C0, kf0, 0, C0); kf2 = MLA_KF(2); MLA_S2(P0, 2); MLA_S2(P0, 4); MLA_S2(P0, 6); MLA_PK4(P0, 0, pw0); MLA_PIN(pw0); MLA_PIN(sa0); MLA_PIN(sa1); MLA_SBAR(); \
    MLA_QMF(C1, kf1, 0, C1); kf3 = MLA_KF(3); MLA_S2(P0, 8); MLA_S2(P0, 10); MLA_S2(P0, 12); MLA_S2(P0, 14); MLA_PK4(P0, 8, pw1); MLA_PIN(pw1); MLA_PIN(sa0); MLA_PIN(sa1); MLA_SBAR(); \
    if (GK) MLA_DMA_K(((t) + 3) * KVBLK, ks_n3); if (GN) MLA_DMA_V(((t) + 1) * KVBLK, vs_wr); MLA_SBAR();                          \
    MLA_QMF(C0, kf2, 1, C0); kf4 = MLA_KF(4); MLA_S2(P1, 0); MLA_S2(P1, 2); MLA_S2(P1, 4); MLA_S2(P1, 6); MLA_PK4(P1, 0, pw2); MLA_PIN(pw2); MLA_PIN(sa0); MLA_PIN(sa1); MLA_SBAR(); \
    MLA_QMF(C1, kf3, 1, C1); kf5 = MLA_KF(5); MLA_VRD(0); MLA_S2(P1, 8); MLA_S2(P1, 10); MLA_S2(P1, 12); MLA_S2(P1, 14); MLA_PK4(P1, 8, pw3); MLA_PIN(pw3); MLA_PIN(sa0); MLA_PIN(sa1); MLA_SBAR(); \
    MLA_QMF(C0, kf4, 2, C0); MLA_VRD(1); MLA_VRD(2); MLA_SBAR(); \
    MLA_QMF(C1, kf5, 2, C1); MLA_VRD(3); l_reg += sa0 + sa1; MLA_SBAR(); \
      \
    MLA_PV(0, 0); MLA_VN(0); MLA_SBAR(); \
    MLA_PV(1, 0); MLA_VN(1); if (MASK) mask_tile(C0, C1, qm - (t) * KVBLK); \
    float mx0 = C0[0]; _Pragma("unroll") for (int r_ = 1; r_ < 8; ++r_) mx0 = fmaxf(mx0, C0[r_]); MLA_SBAR(); \
    MLA_PV(2, 0); MLA_VN(2); _Pragma("unroll") for (int r_ = 8; r_ < 16; ++r_) mx0 = fmaxf(mx0, C0[r_]); MLA_SBAR(); \
    MLA_PV(3, 0); MLA_VN(3); _Pragma("unroll") for (int r_ = 0; r_ < 8; ++r_) mx0 = fmaxf(mx0, C1[r_]); MLA_SBAR(); \
    MLA_PV(4, 1); MLA_VN(4); _Pragma("unroll") for (int r_ = 8; r_ < 16; ++r_) mx0 = fmaxf(mx0, C1[r_]); \
    { auto rr_x = __builtin_amdgcn_permlane32_swap(__float_as_uint(mx0), __float_as_uint(mx0), false, false); mx0 = fmaxf(__uint_as_float(rr_x[0]), __uint_as_float(rr_x[1])); } \
    { resc = false;                                                                                                      \
      if (__builtin_expect(__any(mx0 > THR), 0)) { const float dl = fmaxf(mx0, 0.f); mhat += dl;                          \
          const float f = __builtin_amdgcn_exp2f(-dl); l_reg *= f; if (hi == 0) al_l[r32] = f; resc = true;                \
          _Pragma("unroll") for (int r_ = 0; r_ < 16; ++r_) { C0[r_] -= dl; C1[r_] -= dl; } } }                          \
    MLA_SBAR(); \
    MLA_PV(5, 1);  MLA_VN(5);  MLA_EX2(C0, 0);  MLA_EX2(C0, 2);  MLA_PIN(C0); MLA_SBAR(); \
    MLA_PV(6, 1);  MLA_VN(6);  MLA_EX2(C0, 4);  MLA_EX2(C0, 6);  MLA_PIN(C0); MLA_SBAR(); \
    MLA_PV(7, 1);  MLA_VN(7);  MLA_EX2(C0, 8);  MLA_EX2(C0, 10); MLA_PIN(C0); MLA_SBAR(); \
    MLA_PV(8, 2);  MLA_VN(8);  MLA_EX2(C0, 12); MLA_EX2(C0, 14); MLA_PIN(C0); MLA_SBAR(); \
    MLA_PV(9, 2);  MLA_VN(9);  MLA_EX2(C1, 0);  MLA_EX2(C1, 2);  MLA_PIN(C1); MLA_SBAR(); \
    MLA_PV(10, 2); MLA_VN(10); MLA_EX2(C1, 4);  MLA_PIN(C1); MLA_SBAR(); \
    MLA_PV(11, 2); MLA_VN(11); MLA_EX2(C1, 6);  MLA_PIN(C1); MLA_SBAR(); \
    MLA_ROT(); \
    MLA_PV(12, 3); MLA_EX2(C1, 8);  MLA_PIN(C1); if (GN) { const LAS unsigned char* kr_ = kr0 + ks_cur * SHM_K; const LAS unsigned char* rr_ = rr0 + ks_cur * SHM_R; kf0 = MLA_KF(0); } MLA_SBAR(); \
    MLA_PV(13, 3); MLA_EX2(C1, 10); MLA_PIN(C1); if (GN) { const LAS unsigned char* kr_ = kr0 + ks_cur * SHM_K; const LAS unsigned char* rr_ = rr0 + ks_cur * SHM_R; kf1 = MLA_KF(1); } MLA_SBAR(); \
    MLA_PV(14, 3); MLA_EX2(C1, 12); MLA_PIN(C1); MLA_SEED(P0); MLA_SBAR(); \
    MLA_PV(15, 3); MLA_EX2(C1, 14); MLA_PIN(C1); MLA_SEED(P1); MLA_SBAR();                            \
    } while (0)
    int t = 1;
#pragma unroll 1
    for (; t + 5 < NT; t += 2) {
        MLA_STEP(pB0, pB1, pA0, pA1, t, false, true, true);     MLA_WAITBAR_C(); MLA_RESC();
        MLA_STEP(pA0, pA1, pB0, pB1, t + 1, false, true, true); MLA_WAITBAR_C(); MLA_RESC(); }
#pragma unroll 1
    for (; t + 1 < NT; t += 2) {
        MLA_STEP(pB0, pB1, pA0, pA1, t, true, (t + 3 < NT), true);     MLA_WAITBAR(); MLA_RESC();
        MLA_STEP(pA0, pA1, pB0, pB1, t + 1, true, (t + 4 < NT), true); MLA_WAITBAR(); MLA_RESC(); }
    MLA_STEP(pB0, pB1, pA0, pA1, NT - 1, true, false, false); MLA_WAITBAR(); MLA_RESC();
    { float sa0 = pB0[0], sa1 = pB0[1];
#pragma unroll
      for (int r = 2; r < 16; r += 2) MLA_S2(pB0, r);
#pragma unroll
      for (int r = 0; r < 16; r += 2) MLA_S2(pB1, r);
      l_reg += sa0 + sa1;
      MLA_PK4(pB0, 0, pw0); MLA_PK4(pB0, 8, pw1); MLA_PK4(pB1, 0, pw2); MLA_PK4(pB1, 8, pw3);
      const LAS unsigned char* vp_ = vp0 + vs_rd * SHM_V;
#pragma unroll
      for (int k = 0; k < 4; ++k) {
#pragma unroll
          for (int d0 = 0; d0 < 4; ++d0) { const s16x4 lo = vtr(vp_ + (d0 * 512 + k * 4096)), hh = vtr(vp_ + (d0 * 512 + k * 4096 + 2048));
              const bf16x8 vf = (bf16x8){lo[0], lo[1], lo[2], lo[3], hh[0], hh[1], hh[2], hh[3]};
              o[d0] = __builtin_amdgcn_mfma_f32_32x32x16_bf16(k == 0 ? MLA_PAF(0) : k == 1 ? MLA_PAF(1) : k == 2 ? MLA_PAF(2) : MLA_PAF(3), vf, o[d0], 0, 0, 0); } } }
    { auto rr = __builtin_amdgcn_permlane32_swap(__float_as_uint(l_reg), __float_as_uint(l_reg), false, false); l_reg = __uint_as_float(rr[0]) + __uint_as_float(rr[1]); }
    if (hi == 0) li_l[r32] = l_reg; asm volatile("s_waitcnt lgkmcnt(0)" ::: "memory");
    unsigned char* Ow = (unsigned char*)T.O + ((size_t)b * SEQ + qb * QB + wid * QBLK) * 2048 + h * 128;
    int hi_e = hi; asm volatile("" : "+v"(hi_e));
#pragma unroll
    for (int r = 0; r < 16; ++r) { const int orow = crow(r, hi_e); const float rl = __builtin_amdgcn_rcpf(li_l[orow]);
#pragma unroll
        for (int d0 = 0; d0 < 4; ++d0) { const float v = o[d0][r] * rl; const float v1 = dppf<0xB1>(v), v2 = dppf<0x4E>(v), v3 = dppf<0x1B>(v);
            if ((r32 & 3) == 0) *(GAS unsigned*)(Ow + (size_t)orow * 2048 + d0 * 32 + r32) = pkf8(v, v1, v2, v3); } }
    __syncthreads();
#undef MLA_DMA_V
#undef MLA_GLDS
#undef MLA_DMA_K
#undef MLA_WAITBAR
#undef MLA_WAITBAR_C
#undef MLA_PIN
#undef MLA_RESC
#undef MLA_QMF
#undef MLA_KF
#undef MLA_PK4
#undef MLA_S2
#undef MLA_EX2
#undef MLA_EX2S
#undef MLA_SEED
#undef MLA_VRD
#undef MLA_VFR
#undef MLA_PAF
#undef MLA_GAPB
#undef MLA_STEP
#undef MLA_ROT
#undef MLA_MX
#undef MLA_PV
#undef MLA_VN
}
}

#if defined(DBG_CHECK)
#ifndef DBG_WORD
#define DBG_WORD 0
#endif
namespace chk {
__device__ __forceinline__ float bsum(float v, LAS float* red, int tid) { red[tid] = v; __syncthreads(); for (int o = 256; o > 0; o >>= 1) { if (tid < o) red[tid] += red[tid + o]; __syncthreads(); } const float r = red[0]; __syncthreads(); return r; }
__device__ __forceinline__ float bmax(float v, LAS float* red, int tid) { red[tid] = v; __syncthreads(); for (int o = 256; o > 0; o >>= 1) { if (tid < o) red[tid] = fmaxf(red[tid], red[tid + o]); __syncthreads(); } const float r = red[0]; __syncthreads(); return r; }
__device__ __forceinline__ float bf(const bf16* p) { return __uint_as_float((unsigned)(*p) << 16); }
__device__ __forceinline__ float hf(const bf16* p) { return (float)__builtin_bit_cast(_Float16, *p); }
__device__ __forceinline__ int sample_t(int smp) { const int k = smp >> 5; const int edge[16] = {0, 1, 31, 32, 63, 64, 255, 256, 257, 511, 512, 4095, 4096, 8190, 8191, 300}; return k < 1 ? edge[smp & 15] : (int)(((unsigned)smp * 2654435761u) >> 13) & 8191; }
__device__ __forceinline__ void amax(float* w, float v) { if (v == v) atomicMax((int*)w, __float_as_int(v)); else atomicMax((int*)w, 0x7f000000); }
__device__ __forceinline__ void mla(const bf16* QN, const bf16* QR, const bf16* KN, const bf16* KR, const bf16* VB, const bf16* O, int smp, LAS float* lg, LAS float* red, LAS float* q, float* dbg, int tid) {
    const int b = smp & 1, h = (smp >> 1) & 15, t = sample_t(smp); const size_t row = (size_t)b * SEQ + t;
    if (tid < 128) q[tid] = bf(QN + row * 2048 + h * 128 + tid); else if (tid < 192) q[tid] = bf(QR + row * 1024 + h * 64 + (tid - 128));
    __syncthreads();
    float mx = -1e30f;
    for (int s = tid; s <= t; s += 512) { const bf16* kn = KN + ((size_t)b * SEQ + s) * 2048 + h * 128; const bf16* kr = KR + ((size_t)b * SEQ + s) * 64; float d = 0.f;
        for (int i = 0; i < 128; ++i) d += q[i] * bf(kn + i); for (int i = 0; i < 64; ++i) d += q[128 + i] * bf(kr + i); lg[s] = d; mx = fmaxf(mx, d); }
    mx = bmax(mx, red, tid); float sm = 0.f;
    for (int s = tid; s <= t; s += 512) { const float p = exp2f(lg[s] - mx); lg[s] = p; sm += p; }
    sm = bsum(sm, red, tid);
    float o = 0.f;
    if (tid < 128) { for (int s = 0; s <= t; ++s) o += lg[s] * bf(VB + ((size_t)b * SEQ + s) * 2048 + h * 128 + tid); o /= sm; }
    const float rms = sqrtf(bsum(tid < 128 ? o * o : 0.f, red, tid) / 128.f) + 1e-20f;
    const float e = tid < 128 ? fabsf(o - bf(O + row * 2048 + h * 128 + tid)) / rms : 0.f;
    const float em = bmax(e, red, tid);
    if (tid == 0) amax(dbg + 0, em);
    __syncthreads();
}
template <bool TRUE_SC> __device__ __forceinline__ void dsa(const float* x, const float* w_in, const bf16* QI, const bf16* KI, const float* WI, const bf16* QA, const bf16* KA, const bf16* VA, const bf16* O, const unsigned short* SEL, int smp, LAS float* sc, LAS float* red, LAS float* aux, float* dbg, int tid) {
    const int b = smp & 1, t = sample_t(smp >> 1 << 1 | 0) ; const size_t row = (size_t)b * SEQ + t;
    LAS float* qi = aux;
    LAS unsigned* sel = (LAS unsigned*)(aux + 1024);
    LAS float* pr = aux + 2048;
    LAS unsigned* cnt = (LAS unsigned*)(aux + 2048 + 4096);
    LAS float* wt = aux + 2048 + 4096 + 64;
    if (TRUE_SC) {
        for (int i = tid; i < 1024 + 16; i += 512) { const int c = i < 1024 ? U_QI + i : U_WI + (i - 1024); float d = 0.f; for (int k = 0; k < 2048; ++k) d += x[row * 2048 + k] * w_in[(size_t)k * DIN + c]; if (i < 1024) qi[i] = d; else wt[i - 1024] = d; }
        __syncthreads();
        for (int s = tid; s <= t; s += 512) { float kk[64];
#pragma unroll
            for (int c = 0; c < 64; ++c) kk[c] = 0.f;
            const float* xs = x + ((size_t)b * SEQ + s) * 2048;
            for (int k = 0; k < 2048; ++k) { const float xv = xs[k]; const float* wr = w_in + (size_t)k * DIN + U_KI;
#pragma unroll
                for (int c = 0; c < 64; ++c) kk[c] += xv * wr[c]; }
            float tot = 0.f;
#pragma unroll
            for (int hh = 0; hh < 16; ++hh) { float d = 0.f;
#pragma unroll
                for (int i = 0; i < 64; ++i) d += qi[hh * 64 + i] * kk[i];
                tot += wt[hh] * fmaxf(d, 0.f); }
            sc[s] = tot; }
    } else {
    for (int i = tid; i < 1024; i += 512) qi[i] = hf(QI + row * 1024 + i);
    __syncthreads();
    for (int s = tid; s <= t; s += 512) { const bf16* k = KI + ((size_t)b * SEQ + s) * 64; float tot = 0.f;
        for (int hh = 0; hh < 16; ++hh) { float d = 0.f; for (int i = 0; i < 64; ++i) d += qi[hh * 64 + i] * hf(k + i); tot += WI[row * 16 + hh] * fmaxf(d, 0.f); }
        sc[s] = tot; }
    }
    __syncthreads();
    const int n = t + 1, want = n < 256 ? n : 256;
    unsigned T = 0u;
    for (int bit = 31; bit >= 0; --bit) { const unsigned cand = T | (1u << bit); if (tid == 0) cnt[0] = 0u; __syncthreads(); unsigned c = 0u;
        for (int s = tid; s <= t; s += 512) c += (dsa::fkey(sc[s]) >= cand) ? 1u : 0u;
        if (c) atomicAdd((unsigned*)cnt, c); __syncthreads(); if (cnt[0] >= (unsigned)want) T = cand; __syncthreads(); }
    if (tid == 0) { cnt[0] = 0u; cnt[1] = 0u; } __syncthreads();
    { unsigned c = 0u; for (int s = tid; s <= t; s += 512) c += (dsa::fkey(sc[s]) > T) ? 1u : 0u; if (c) atomicAdd((unsigned*)cnt + 1, c); }
    __syncthreads();
    const unsigned cgt = cnt[1]; __syncthreads(); if (tid == 0) cnt[1] = 0u;
    for (int s = tid; s <= t; s += 512) { const unsigned ky = dsa::fkey(sc[s]); bool take = ky > T;
        if (ky == T) { unsigned rk = 0u; for (int s2 = 0; s2 < s; ++s2) rk += (dsa::fkey(sc[s2]) == T) ? 1u : 0u; take = cgt + rk < (unsigned)want; }
        if (take) { const unsigned p = atomicAdd((unsigned*)cnt, 1u); if (p < 256u) sel[p] = (unsigned)s; } }
    __syncthreads();
    const int nref = (int)(cnt[0] < 256u ? cnt[0] : 256u);
    if (tid < 256) sel[256 + tid] = SEL[row * 256 + tid];
    __syncthreads();
    { float miss = 0.f; if (tid < 256) { const unsigned s = sel[256 + tid]; if (s != 0xFFFFu) { bool found = false; for (int j = 0; j < nref; ++j) found |= (sel[j] == s); miss = found ? 0.f : 1.f; } }
      const float tm = bsum(miss, red, tid); if (tid == 0) { amax(dbg + 1, tm / (float)want); atomicAdd(dbg + 13, tm); } }
    for (int pass = 0; pass < 2; ++pass) {
        const int ns = pass == 0 ? nref : 256; LAS unsigned* sl = sel + pass * 256;
        for (int e = tid; e < 16 * 256; e += 512) { const int hh = e >> 8, j = e & 255; float v = -1e30f;
            if (j < ns && sl[j] != 0xFFFFu) { const unsigned s = sl[j]; const bf16* k = KA + ((size_t)b * SEQ + s) * 128; float d = 0.f; for (int i = 0; i < 128; ++i) d += bf(QA + row * 2048 + hh * 128 + i) * bf(k + i);
                v = d - exp2f(-0.5f * (float)(hh + 1)) * LOG2E * (float)(t - (int)s); }
            pr[e] = v; }
        __syncthreads();
        if (tid < 16) { float mx = -1e30f; for (int j = 0; j < 256; ++j) mx = fmaxf(mx, pr[tid * 256 + j]); float sm = 0.f; for (int j = 0; j < 256; ++j) { const float p = pr[tid * 256 + j] <= -1e29f ? 0.f : exp2f(pr[tid * 256 + j] - mx); pr[tid * 256 + j] = p; sm += p; }
            for (int j = 0; j < 256; ++j) pr[tid * 256 + j] /= sm; }
        __syncthreads();
        float e4 = 0.f, q4 = 0.f, s4 = 0.f;
        for (int e = tid; e < 2048; e += 512) { const int hh = e >> 7, d = e & 127; float o = 0.f;
            for (int j = 0; j < ns; ++j) { const unsigned s = sl[j]; if (s != 0xFFFFu) o += pr[hh * 256 + j] * bf(VA + ((size_t)b * SEQ + s) * 128 + d); }
            q4 += o * o; const float df = o - bf(O + row * 2048 + e); e4 = fmaxf(e4, fabsf(df)); s4 += df * df; }
        const float rms = sqrtf(bsum(q4, red, tid) / 2048.f) + 1e-20f; const float em = bmax(e4, red, tid); const float esq = bsum(s4, red, tid);
        if (tid == 0) { amax(dbg + (pass == 0 ? 0 : 2), em / rms); if (pass == 0) atomicAdd(dbg + 14, esq / (rms * rms * 2048.f)); }
        __syncthreads();
    }
}
__device__ __forceinline__ void p1(const float* x, const float* w_in, const bf16* QA, const bf16* QI, const bf16* KA, const bf16* VA, const bf16* KI, const float* WI, const bf16* CQ, const bf16* CKV, const bf16* KR, int smp, LAS float* xr, LAS float* red, LAS float* tru, float* dbg, int tid) {
    const size_t row = (size_t)(((unsigned)smp * 2654435761u) >> 9) % M; const int pos = (int)(row & (SEQ - 1));
    for (int i = tid; i < 2048; i += 512) xr[i] = x[row * 2048 + i];
    __syncthreads();
    for (int c = tid; c < U_G; c += 512) { float d = 0.f; for (int k = 0; k < 2048; ++k) d += xr[k] * w_in[(size_t)k * DIN + c]; tru[c] = d; }
    __syncthreads();
    for (int ty = 0; ty < 9; ++ty) {
        const int c0 = ty == 0 ? U_QA : ty == 1 ? U_QI : ty == 2 ? U_KA : ty == 3 ? U_VA : ty == 4 ? U_KI : ty == 5 ? U_WI : ty == 6 ? U_CQ : ty == 7 ? U_CKV : U_KPE;
        const int nc = ty == 0 ? 2048 : ty == 1 ? 1024 : ty == 2 ? 128 : ty == 3 ? 128 : ty == 4 ? 64 : ty == 5 ? 16 : ty == 6 ? 512 : ty == 7 ? 512 : 64;
        float q = 0.f, e = 0.f;
        for (int c = tid; c < nc; c += 512) { float tv = tru[c0 + c], sv;
            if (ty == 0) { tv *= QA_SCALE; sv = bf(QA + row * 2048 + c); } else if (ty == 1) sv = hf(QI + row * 1024 + c); else if (ty == 2) sv = bf(KA + row * 128 + c); else if (ty == 3) sv = bf(VA + row * 128 + c);
            else if (ty == 4) sv = hf(KI + row * 64 + c); else if (ty == 5) sv = WI[row * 16 + c]; else if (ty == 6) sv = bf(CQ + row * 512 + c); else if (ty == 7) sv = bf(CKV + row * 512 + c);
            else { const int i = c & 31; const float ang = (float)pos * exp2f(-(float)i * (13.287712379549449f / 32.f)), cs = cosf(ang), sn = sinf(ang); const float x1 = tru[c0 + i], x2 = tru[c0 + 32 + i]; tv = c < 32 ? x1 * cs - x2 * sn : x1 * sn + x2 * cs; sv = bf(KR + row * 64 + c); }
            q += tv * tv; e = fmaxf(e, fabsf(tv - sv)); }
        const float rms = sqrtf(bsum(q, red, tid) / (float)nc) + 1e-20f; const float em = bmax(e, red, tid) / rms;
        if (tid == 0) { amax(dbg + 3 + ty, em); amax(dbg + 12, em); }
        __syncthreads();
    }
}
__device__ __forceinline__ void p2(const bf16* CQ, const bf16* CKV, const float* gq, const float* gkv, const float* w_uq, const float* w_uk, const float* w_uv, const bf16* QN, const bf16* QR, const bf16* KN, const bf16* VB,
                                   int smp, LAS float* cr, LAS float* red, LAS float* tru, float* dbg, int tid) {
    const size_t row = (size_t)(((unsigned)smp * 2654435761u) >> 9) % M; const int pos = (int)(row & (SEQ - 1));
    for (int i = tid; i < 1024; i += 512) cr[i] = i < 512 ? bf(CQ + row * 512 + i) : bf(CKV + row * 512 + (i - 512));
    __syncthreads();
    const float ssq = bsum(cr[tid] * cr[tid], red, tid), ssk = bsum(cr[512 + tid] * cr[512 + tid], red, tid);
    const float rq = 1.f / sqrtf(ssq / 512.f + RMS_EPS), rk = 1.f / sqrtf(ssk / 512.f + RMS_EPS);
    for (int n = tid; n < 3072 + 4096; n += 512) { float d = 0.f;
        if (n < 3072) { for (int k = 0; k < 512; ++k) d += cr[k] * gq[k] * w_uq[(size_t)k * 3072 + n]; d *= rq * QB_SCALE; }
        else if (n < 3072 + 2048) { for (int k = 0; k < 512; ++k) d += cr[512 + k] * gkv[k] * w_uk[(size_t)k * 2048 + (n - 3072)]; d *= rk; }
        else { for (int k = 0; k < 512; ++k) d += cr[512 + k] * gkv[k] * w_uv[(size_t)k * 2048 + (n - 5120)]; d *= rk; }
        tru[n] = d; }
    __syncthreads();
    float q = 0.f, e = 0.f;
    for (int n = tid; n < 2048; n += 512) { const int h = n >> 7, d = n & 127; const float tv = tru[h * 192 + d]; q += tv * tv; e = fmaxf(e, fabsf(tv - bf(QN + row * 2048 + n))); }
    { const float rms = sqrtf(bsum(q, red, tid) / 2048.f) + 1e-20f; const float em = bmax(e, red, tid) / rms; if (tid == 0) { amax(dbg + 0, em); amax(dbg + 1, em); } }
    q = 0.f; e = 0.f;
    for (int n = tid; n < 1024; n += 512) { const int h = n >> 6, c = n & 63, i = c & 31; const float ang = (float)pos * exp2f(-(float)i * (13.287712379549449f / 32.f)), cs = cosf(ang), sn = sinf(ang);
        const float x1 = tru[h * 192 + 128 + i], x2 = tru[h * 192 + 160 + i], tv = c < 32 ? x1 * cs - x2 * sn : x1 * sn + x2 * cs; q += tv * tv; e = fmaxf(e, fabsf(tv - bf(QR + row * 1024 + n))); }
    { const float rms = sqrtf(bsum(q, red, tid) / 1024.f) + 1e-20f; const float em = bmax(e, red, tid) / rms; if (tid == 0) { amax(dbg + 0, em); amax(dbg + 2, em); } }
    q = 0.f; e = 0.f;
    for (int n = tid; n < 2048; n += 512) { const float tv = tru[3072 + n]; q += tv * tv; e = fmaxf(e, fabsf(tv - bf(KN + row * 2048 + n))); }
    { const float rms = sqrtf(bsum(q, red, tid) / 2048.f) + 1e-20f; const float em = bmax(e, red, tid) / rms; if (tid == 0) { amax(dbg + 0, em); amax(dbg + 3, em); } }
    q = 0.f; e = 0.f;
    for (int n = tid; n < 2048; n += 512) { const float tv = tru[5120 + n]; q += tv * tv; e = fmaxf(e, fabsf(tv - bf(VB + row * 2048 + n))); }
    { const float rms = sqrtf(bsum(q, red, tid) / 2048.f) + 1e-20f; const float em = bmax(e, red, tid) / rms; if (tid == 0) { amax(dbg + 0, em); amax(dbg + 4, em); } }
    __syncthreads();
}
__device__ __forceinline__ void gchk(const float* x, const float* w_in, const bf16* GS, const bf16* XHS, size_t row, LAS float* xr, LAS float* red, float* dbg, int tid) {
    for (int i = tid; i < 2048; i += 512) xr[i] = x[row * 2048 + i];
    __syncthreads();
    float eg = 0.f;
    for (int c = tid; c < 4096; c += 512) { float l0 = 0.f; for (int k = 0; k < 2048; ++k) l0 += xr[k] * w_in[(size_t)k * DIN + U_G + c]; eg = fmaxf(eg, fabsf(1.f / (1.f + expf(-l0)) - bf(GS + row * 4096 + c))); }
    const float egm = bmax(eg, red, tid);
    float ex = 0.f; for (int i = tid; i < 2048; i += 512) ex = fmaxf(ex, fabsf(xr[i] - hf(XHS + row * 2048 + i))); const float exm = bmax(ex, red, tid);
    int nb = 0; for (int c = tid; c < 4096; c += 512) { float l0 = 0.f; for (int k = 0; k < 2048; ++k) l0 += xr[k] * w_in[(size_t)k * DIN + U_G + c]; nb += fabsf(1.f / (1.f + expf(-l0)) - bf(GS + row * 4096 + c)) > 0.05f ? 1 : 0; }
    const float nbt = bsum((float)nb, red, tid);
    if (tid == 0) { amax(dbg + 0, egm); if (egm > 0.05f) { atomicAdd(dbg + 1, 1.0f); amax(dbg + 3, nbt); amax(dbg + 4, 4097.f - nbt); } amax(dbg + 2, exm); }
    __syncthreads();
}
__device__ __forceinline__ void mid(const float* x, const float* w_in, const float* wa, const float* wb, const float* wo, const bf16* AA, const bf16* AB, const bf16* GS, const bf16* MTS, const float* Z, size_t row, int vtag, LAS float* va, LAS float* red, LAS float* mg, float* dbg, int tid) {
    LAS float* vb = va + 2048; LAS float* xr = va + 4096;
    for (int i = tid; i < 2048; i += 512) { va[i] = bf(AA + row * 2048 + i); vb[i] = bf(AB + row * 2048 + i); xr[i] = x[row * 2048 + i]; }
    __syncthreads();
    float eg = 0.f, qm = 0.f, emt = 0.f; int cmx = -1, cmn = 1 << 20;
    for (int c = tid; c < 2048; c += 512) { float l0 = 0.f, l1 = 0.f, ma = 0.f, mb = 0.f;
        for (int k = 0; k < 2048; ++k) { const float xv = xr[k]; l0 += xv * w_in[(size_t)k * DIN + U_G + c]; l1 += xv * w_in[(size_t)k * DIN + U_G + 2048 + c]; ma += va[k] * wa[(size_t)k * 2048 + c]; mb += vb[k] * wb[(size_t)k * 2048 + c]; }
        const float g0 = 1.f / (1.f + expf(-l0)), g1 = 1.f / (1.f + expf(-l1)); mg[c] = ma * g0 + mb * g1;
        { const float e0 = fabsf(g0 - bf(GS + row * 4096 + c)), e1 = fabsf(g1 - bf(GS + row * 4096 + 2048 + c)); eg = fmaxf(eg, fmaxf(e0, e1)); if (e0 > 0.05f) { cmx = max(cmx, c); cmn = min(cmn, c); } if (e1 > 0.05f) { cmx = max(cmx, 2048 + c); cmn = min(cmn, 2048 + c); } } qm += mg[c] * mg[c]; emt = fmaxf(emt, fabsf(mg[c] - bf(MTS + row * 2048 + c))); }
    { const float egm = bmax(eg, red, tid); const float rm = sqrtf(bsum(qm, red, tid) / 2048.f) + 1e-20f; const float emm = bmax(emt, red, tid) / rm; if (tid == 0) { amax(dbg + 17, egm); amax(dbg + 18, emm); if (egm > 0.05f) { amax(dbg + 19, (float)(row & 255) + 1.0f); amax(dbg + 20, (float)(255 - (row & 255)) + 1.0f); atomicAdd(dbg + 21, 1.0f); amax(dbg + 22, (float)vtag + 1.0f); amax(dbg + 23, (float)(255 - vtag) + 1.0f); } }
      const float fx = bmax((float)cmx, red, tid), fn = bmax((float)(4096 - cmn), red, tid); if (tid == 0 && fx >= 0.f) { amax(dbg + 24, fx + 1.0f); amax(dbg + 25, fn + 1.0f); } }
    __syncthreads();
    float q = 0.f, e = 0.f;
    for (int c = tid; c < 2048; c += 512) { float d = 0.f; for (int k = 0; k < 2048; ++k) d += mg[k] * wo[(size_t)k * 2048 + c]; q += d * d; e = fmaxf(e, fabsf(ALPHA * xr[c] + d - Z[row * 2048 + c])); }
    const float rms = sqrtf(bsum(q, red, tid) / 2048.f) + 1e-20f; const float em = bmax(e, red, tid) / rms;
    if (tid == 0) { amax(dbg + 0, em); if (em > 0.25f) { atomicAdd(dbg + 13, 1.0f); amax(dbg + 15, (float)(row & 255) + 1.0f); amax(dbg + 16, (float)(row >> 8) + 1.0f); } }
    __syncthreads();
}
__device__ __forceinline__ void endp(const bf16* X1B, const float* x1f_unused, const float* p, const float* w_up, const float* cw, const float* cb, const float* w_down, const float* w_pg, const float* b_pg, const float* w_pe, const float* g2, const float* b2,
                                     const float* OUT, int smp, LAS float* xs, LAS float* red, LAS float* act, float* dbg, int tid) {
    const int k6 = smp & 7; const size_t rbase = (size_t)(((unsigned)smp * 2654435761u) >> 9) % M; const size_t row = k6 == 0 ? (rbase & ~(size_t)63) : k6 == 1 ? (rbase & ~(size_t)63) + 1 : k6 == 2 ? (rbase & ~(size_t)8191) : rbase; const int t = (int)(row & (SEQ - 1));
    LAS float* z = act + 5632; LAS float* pr = act + 5632 + 2048;
    for (int i = tid; i < 3 * 2048; i += 512) { const int j = i >> 11, c = i & 2047; const int tt = t - 2 + j; xs[i] = tt >= 0 ? bf(X1B + (row - 2 + j) * 2048 + c) : 0.f; }
    for (int i = tid; i < 256; i += 512) pr[i] = p[row * 256 + i];
    __syncthreads();
    for (int ch = tid; ch < DFF; ch += 512) { float hg[3] = {0.f, 0.f, 0.f}, hv[3] = {0.f, 0.f, 0.f};
        for (int k = 0; k < 2048; ++k) { const float wg = w_up[(size_t)k * NUP + ch], wv = w_up[(size_t)k * NUP + DFF + ch];
#pragma unroll
            for (int j = 0; j < 3; ++j) { hg[j] += xs[j * 2048 + k] * wg; hv[j] += xs[j * 2048 + k] * wv; } }
        float yg = cb[ch], yv = cb[DFF + ch];
#pragma unroll
        for (int j = 0; j < 3; ++j) { yg += cw[(size_t)j * NUP + ch] * hg[j]; yv += cw[(size_t)j * NUP + DFF + ch] * hv[j]; }
        act[ch] = yg / (1.f + expf(-yg)) * yv; }
    __syncthreads();
    for (int c = tid; c < 2048; c += 512) { float f = 0.f, lg = b_pg[c], pe = 0.f;
        for (int k = 0; k < DFF; ++k) f += act[k] * w_down[(size_t)k * 2048 + c];
        for (int k = 0; k < 2048; ++k) lg += xs[2 * 2048 + k] * w_pg[(size_t)k * 2048 + c];
        for (int k = 0; k < 256; ++k) pe += pr[k] * w_pe[(size_t)k * 2048 + c];
        z[c] = ALPHA * xs[2 * 2048 + c] + f + pe / (1.f + expf(-lg)); }
    __syncthreads();
    float s = 0.f; for (int c = tid; c < 2048; c += 512) s += z[c];
    const float mean = bsum(s, red, tid) / 2048.f; float s2 = 0.f; for (int c = tid; c < 2048; c += 512) s2 += (z[c] - mean) * (z[c] - mean);
    const float rstd = 1.f / sqrtf(bsum(s2, red, tid) / 2048.f + LN_EPS); float e = 0.f;
    for (int c = tid; c < 2048; c += 512) e = fmaxf(e, fabsf((z[c] - mean) * rstd * g2[c] + b2[c] - OUT[row * 2048 + c]));
    const float em = bmax(e, red, tid);
    if (tid == 0) { amax(dbg + 0, em); amax(dbg + 1 + (k6 < 3 ? k6 : 3), em); }
    __syncthreads();
}
}
#endif

__device__ __forceinline__ int own_panel(int x, int s) { return s < 4 ? x + 8 * s : 32 + (7 - x) + 8 * (s - 4); }
__device__ __forceinline__ void ln_pass(const bf16* zin, float* fout, bf16* bout, unsigned char* xf8, const float* g, const float* b, int vcu, int wave, int lane) {
    f32x4 gg[8], bb[8];
#pragma unroll
    for (int j = 0; j < 4; ++j) { const int e0 = 8 * (lane + 64 * j); gg[2 * j] = *(const GAS f32x4*)(g + e0); gg[2 * j + 1] = *(const GAS f32x4*)(g + e0 + 4); bb[2 * j] = *(const GAS f32x4*)(b + e0); bb[2 * j + 1] = *(const GAS f32x4*)(b + e0 + 4); }
    v4u zn[4];
    { const int m0 = 256 * own_panel(vcu >> 5, 0) + 8 * (vcu & 31) + wave; const GAS v4u* zr = (const GAS v4u*)(zin + (size_t)m0 * DM) + lane;
#pragma unroll
      for (int j = 0; j < 4; ++j) zn[j] = zr[64 * j]; }
#pragma unroll 1
    for (int s_ = 0; s_ < 8; ++s_) { const int m = 256 * own_panel(vcu >> 5, s_) + 8 * (vcu & 31) + wave;
        f32x4 v[8]; float s = 0.f;
#pragma unroll
        for (int j = 0; j < 4; ++j) { unpack8(zn[j], v[2 * j], v[2 * j + 1]); s += ((v[2 * j][0] + v[2 * j][1]) + (v[2 * j][2] + v[2 * j][3])) + ((v[2 * j + 1][0] + v[2 * j + 1][1]) + (v[2 * j + 1][2] + v[2 * j + 1][3])); }
        { const int mn = 256 * own_panel(vcu >> 5, s_ + 1 < 8 ? s_ + 1 : 7) + 8 * (vcu & 31) + wave; const GAS v4u* zr = (const GAS v4u*)(zin + (size_t)mn * DM) + lane;
#pragma unroll
          for (int j = 0; j < 4; ++j) zn[j] = zr[64 * j]; }
        asm volatile("" ::: "memory");
        const float mean = wave_sum(s) * (1.f / DM); float s2 = 0.f;
#pragma unroll
        for (int j = 0; j < 8; ++j) { v[j] = v[j] - mean; s2 += (v[j][0] * v[j][0] + v[j][1] * v[j][1]) + (v[j][2] * v[j][2] + v[j][3] * v[j][3]); }
        const float rstd = 1.f / sqrtf(wave_sum(s2) * (1.f / DM) + LN_EPS);
#pragma unroll
        for (int j = 0; j < 4; ++j) { const int e0 = 8 * (lane + 64 * j);
            const f32x4 y0 = v[2 * j] * rstd * gg[2 * j] + bb[2 * j], y1 = v[2 * j + 1] * rstd * gg[2 * j + 1] + bb[2 * j + 1];
            if (fout) { *(GAS f32x4*)(fout + (size_t)m * DM + e0) = y0; *(GAS f32x4*)(fout + (size_t)m * DM + e0 + 4) = y1; }
            if (bout) *(GAS v4u*)(bout + (size_t)m * DM + e0) = pack8(y0, y1);
            if (xf8) { u32x2 w; w.x = pkf8(y0[0], y0[1], y0[2], y0[3]); w.y = pkf8(y1[0], y1[1], y1[2], y1[3]); *(GAS u32x2*)(xf8 + (size_t)m * DM + e0) = w; } }
    }
}
__device__ __forceinline__ void conv_fixup(unsigned char* ACT, const float* HEADB, const float* TAILB, const float* cw, const float* cb, int vcu, int tid) {
    constexpr int CH8 = DFF / 8;
    for (int it = (vcu & 31) * 512 + tid; it < 8 * 4 * 2 * CH8; it += 32 * 512) {
        const int c8 = it % CH8, rr = (it / CH8) & 1, g4 = (it / (2 * CH8)) & 3, s_ = it / (8 * CH8); const int g = own_panel(vcu >> 5, s_) * 4 + g4;
        const int ch = 8 * c8, pg = 256 * (ch >> 7) + (ch & 127); const bool first = (g & 127) == 0;
        f32x4 res[2][2];
#pragma unroll
        for (int bj = 0; bj < 2; ++bj) { const int pc = pg + bj * 128, c = ch + bj * DFF;
#pragma unroll
            for (int n = 0; n < 2; ++n) { const f32x4 z = (f32x4){0.f, 0.f, 0.f, 0.f};
                const f32x4 u0 = *(const GAS f32x4*)(HEADB + ((size_t)g * 2 + rr) * NUP + pc + 4 * n);
                const f32x4 t1 = first ? z : *(const GAS f32x4*)(TAILB + ((size_t)(g - 1) * 2 + 1) * NUP + pc + 4 * n);
                const f32x4 t0 = first ? z : *(const GAS f32x4*)(TAILB + ((size_t)(g - 1) * 2 + 0) * NUP + pc + 4 * n);
                const f32x4 h0 = *(const GAS f32x4*)(HEADB + ((size_t)g * 2 + 0) * NUP + pc + 4 * n);
                const f32x4 u1 = rr ? h0 : t1, u2 = rr ? t1 : t0;
                const f32x4 w0 = *(const GAS f32x4*)(cw + c + 4 * n), w1 = *(const GAS f32x4*)(cw + NUP + c + 4 * n), w2 = *(const GAS f32x4*)(cw + 2 * NUP + c + 4 * n), bb = *(const GAS f32x4*)(cb + c + 4 * n);
                res[bj][n] = bb + w2 * u0 + w1 * u1 + w0 * u2; } }
        const f32x4 a0 = res[0][0] * sigmoid4(res[0][0]) * res[1][0], a1 = res[0][1] * sigmoid4(res[0][1]) * res[1][1];
        { u32x2 w; w.x = pkf8(a0[0], a0[1], a0[2], a0[3]); w.y = pkf8(a1[0], a1[1], a1[2], a1[3]); *(GAS u32x2*)(ACT + ((size_t)g * 64 + rr) * DFF + ch) = w; }
    }
}

struct Args { const float* in[22]; float* out; unsigned char* ws; };
#define GEMM_PHASE_LC(EPI, A_, B_, N_, K_, E_, DT_, WS_, LDA_, C_) do { int kk_ = (K_); asm volatile("" : "+s"(kk_)); pg8::Gemm g_{(const pg8::bf16_t*)(A_), (const pg8::bf16_t*)(B_), M, (N_), kk_, (WS_), (LDA_)}; pg8::StaticOrder S_; S_.init(M, (N_), G, (C_)); \
        pg8::gemm_phase<EPI, pg8::StaticOrder, true, true, DT_>(lds, g_, S_, (E_)); } while (0)
#define GEMM_PHASE_L(EPI, A_, B_, N_, K_, E_, DT_, WS_, LDA_) do { int kk_ = (K_); asm volatile("" : "+s"(kk_)); pg8::Gemm g_{(const pg8::bf16_t*)(A_), (const pg8::bf16_t*)(B_), M, (N_), kk_, (WS_), (LDA_)}; pg8::StaticOrder S_; S_.init(M, (N_), G, bx); \
        pg8::gemm_phase<EPI, pg8::StaticOrder, true, true, DT_>(lds, g_, S_, (E_)); } while (0)
#define GEMM_PHASE_X(EPI, A_, B_, N_, K_, E_, DT_, WS_) GEMM_PHASE_L(EPI, A_, B_, N_, K_, E_, DT_, WS_, 0)
#define GEMM_PHASE_T(EPI, A_, B_, N_, K_, E_, F16_) GEMM_PHASE_X(EPI, A_, B_, N_, K_, E_, ((F16_) ? 1 : 0), 127)
#define GEMM_PHASE(EPI, A_, B_, N_, K_, E_) GEMM_PHASE_X(EPI, A_, B_, N_, K_, E_, 0, 127)

__global__ void __launch_bounds__(NWAVES * 64, 2) fwd_kernel(Args args) {
    extern __shared__ __attribute__((aligned(16))) unsigned char lds_raw[];
    LAS unsigned char* lds = (LAS unsigned char*)lds_raw;
    volatile LAS unsigned* MISC = (volatile LAS unsigned*)(lds + MISC_OFF);
    const int tid0 = threadIdx.x, wave = __builtin_amdgcn_readfirstlane(tid0 >> 6);
#define TID() ({ int t_ = threadIdx.x; asm volatile("" : "+v"(t_)); t_; })
#define LANE() (TID() & 63)
#define GT() ((size_t)bx * (NWAVES * 64) + TID())
    for (int u = threadIdx.x; u < (LDS_BYTES - LDSCTL_OFF) / 4; u += NWAVES * 64) ((LAS unsigned*)(lds + LDSCTL_OFF))[u] = 0u;
    __syncthreads();
    if (threadIdx.x == 0) { const unsigned xcc = xb_xcc_id() & 7u; const unsigned rk = __hip_atomic_fetch_add((gu32*)(args.ws + WS_CTL) + CW_RANK + 64 * xcc, 1u, RLX_AGENT); MISC[12] = (rk & 31u) * 8u + xcc; }
    __syncthreads();
    const int G = gridDim.x, bx = __builtin_amdgcn_readfirstlane((int)MISC[12]), vcu = (bx % 8) * (G / 8) + bx / 8;
    const int gw = vcu * NWAVES + wave, NGW = G * NWAVES; const size_t NT = (size_t)G * NWAVES * 64;
#define WSP(T_, off_) ((T_*)(wsb() + (off_)))
#define INP(k_) inb(k_)
#define DOP(T_, off_) ((T_*)((unsigned char*)outb() + (off_)))
    auto wsb = [&]() __attribute__((always_inline)) { unsigned char* w_ = args.ws; asm volatile("" : "+s"(w_)); return w_; };
    auto inb = [&](int k_) __attribute__((always_inline)) { const float* p_ = args.in[k_]; asm volatile("" : "+s"(p_)); return p_; };
    auto outb = [&]() __attribute__((always_inline)) { float* p_ = args.out; asm volatile("" : "+s"(p_)); return p_; };

    XcdBarrier bar = xcd_barrier_post((unsigned*)((gu32*)(args.ws + WS_CTL) + CW_BAR), MISC + 8);
#if defined(DBG_CKPT)
#define CKPT(id_, lo_, hi_) do { if (DBG_CKPT == (id_)) { unsigned* cw_ = WSP(unsigned, WS_CTL) + 200100; const unsigned* p_ = (const unsigned*)(wsb() + (size_t)(lo_) * MiB); unsigned c_ = 0u; \
        for (size_t i = GT(); i < (size_t)((hi_) - (lo_)) * MiB / 4; i += NT) c_ += p_[i] * 2654435761u + (unsigned)i; \
        c_ += __shfl_xor(c_, 32); c_ += __shfl_xor(c_, 16); c_ += __shfl_xor(c_, 8); c_ += __shfl_xor(c_, 4); c_ += __shfl_xor(c_, 2); c_ += __shfl_xor(c_, 1); \
        if ((TID() & 63) == 0) atomicAdd(cw_, c_); xcd_barrier(bar); \
        const float X = (float)(__hip_atomic_load(cw_, RLX_AGENT) & 0xFFFFFFu) + 1.0f; float* o_ = outb(); \
        for (size_t i = GT(); i < (size_t)M * DM / 4; i += NT) *((GAS f32x4*)o_ + i) = (f32x4){X, X, X, X}; return; } } while (0)
#else
#define CKPT(id_, lo_, hi_) do { } while (0)
#endif
#if defined(DBG_SPIN)
#define STAMP(i_) do { if (threadIdx.x == 0) { const unsigned long long t_ = __builtin_amdgcn_s_memrealtime(); MISC[16 + 2 * (i_)] = (unsigned)t_; MISC[17 + 2 * (i_)] = (unsigned)(t_ >> 32); const unsigned long long c_ = __builtin_amdgcn_s_memtime(); MISC[100 + 2 * (i_)] = (unsigned)c_; MISC[101 + 2 * (i_)] = (unsigned)(c_ >> 32); } } while (0)
#else
#define STAMP(i_) do { } while (0)
#endif
#define SCR() ((LAS float*)(lds + RING_OFF + wave * TR_LDS))
#define SSQP() ((float*)(wsb() + WS_CTL + MiB))

#if defined(DBG_CHECK)
#define DBG_OA ((DBG_CHECK == 1 || DBG_CHECK == 4) ? WS_XB : WS_QA)
#define DBG_OB (DBG_CHECK == 2 ? WS_XB : WS_QN)
#define DBG_SEL ((DBG_CHECK == 1 || DBG_CHECK == 4) ? (unsigned short*)(wsb() + WS_END) : (unsigned short*)nullptr)
#else
#define DBG_OA WS_QA
#define DBG_OB WS_QN
#define DBG_SEL ((unsigned short*)nullptr)
#endif
#ifndef ONLY
#define ONLY -1
#endif
#ifndef SKIPMASK
#define SKIPMASK 0
#endif
#define PH(k) ((ONLY < 0 || ONLY == (k)) && !((SKIPMASK >> (k)) & 1))
    STAMP(0);
    if (PH(0)) {
    { const TrIn I{INP(2), INP(3), INP(4), INP(5), INP(6), INP(7), INP(8), INP(9), INP(10), INP(13), INP(16), INP(17), INP(19)}; tr_all(I, wsb(), SCR(), gw, NGW, LANE()); }
    cvt_flat_h(INP(0), WSP(bf16, WS_XB), WSP(unsigned char, WS_XF8), (size_t)M * DM / 8, GT(), NT);
    cvt_flat(INP(1), WSP(bf16, WS_PB), (size_t)M * PLE_DIM / 8, GT(), NT);
    { float* ROPE = WSP(float, WS_ROPE);
    for (size_t i = GT(); i < (size_t)SEQ * 32; i += NT) { const int pos = (int)(i >> 5), j = (int)(i & 31);
        const double f = exp2(-(double)j * (13.287712379549449 / 32.0)), turns = (double)pos * f * 0.15915494309189535, fr = turns - floor(turns);
        ROPE[i] = __builtin_amdgcn_cosf((float)fr); ROPE[(size_t)SEQ * 32 + i] = __builtin_amdgcn_sinf((float)fr); } }
    }
    xcd_barrier(bar);

    STAMP(1);
    if (PH(1)) { EpiU<1> E{WSP(bf16, WS_QA), DOP(bf16, DO_QI), DOP(bf16, DO_KA), DOP(bf16, DO_VA), DOP(bf16, DO_KI), DOP(bf16, DO_KR), DOP(bf16, DO_CQ), DOP(bf16, DO_CKV), DOP(float, DO_WI), SSQP(), WSP(float, WS_ROPE)};
        GEMM_PHASE_X(EpiU<1>, WSP(bf16, WS_XF8), WSP(bf16, WS_WIN8), NU8, 1024, E, 2, 127 - 6); }
    if (PH(1)) { EpiU<2> E{WSP(bf16, WS_QA), DOP(bf16, DO_QI), DOP(bf16, DO_KA), DOP(bf16, DO_VA), DOP(bf16, DO_KI), DOP(bf16, DO_KR), DOP(bf16, DO_CQ), DOP(bf16, DO_CKV), DOP(float, DO_WI), SSQP(), WSP(float, WS_ROPE)};
        GEMM_PHASE_LC(EpiU<2>, WSP(bf16, WS_XB), WSP(bf16, WS_WIN), NU16, 2048, E, 1, 127, 0, (bx + 64) % G); }
    if (PH(12)) { EpiB<0> E{DOP(bf16, DO_PEO), 2048, nullptr, nullptr, nullptr};
        { int kk_ = 256; asm volatile("" : "+s"(kk_)); pg8::Gemm g_{(const pg8::bf16_t*)WSP(bf16, WS_PB), (const pg8::bf16_t*)WSP(bf16, WS_WPE), M, 2048, kk_, 127, 0}; pg8::PEOrder S_; S_.init(bx);
          pg8::gemm_phase<EpiB<0>, pg8::PEOrder, true, true, 0>(lds, g_, S_, E); } }
    xcd_barrier(bar);
    CKPT(1, 118, 260);

#if defined(DBG_CHECK) && DBG_CHECK == 3
    {   float* dbgw = (float*)(WSP(unsigned, WS_CTL) + 200000);
        LAS float* xr = (LAS float*)lds; LAS float* red = (LAS float*)(lds + 65536); LAS float* tru = (LAS float*)(lds + 69632);
        for (int smp = bx; smp < 256; smp += G) chk::p1(INP(0), INP(2), WSP(bf16, WS_QA), DOP(bf16, DO_QI), DOP(bf16, DO_KA), DOP(bf16, DO_VA), DOP(bf16, DO_KI), DOP(float, DO_WI), DOP(bf16, DO_CQ), DOP(bf16, DO_CKV), DOP(bf16, DO_KR), smp, xr, red, tru, dbgw, TID());
        xcd_barrier(bar);
        const float X = __hip_atomic_load(dbgw + DBG_WORD, RLX_AGENT) * 1e8f; float* o_ = outb();
        for (size_t i = GT(); i < (size_t)M * DM / 4; i += NT) *((GAS f32x4*)o_ + i) = (f32x4){X, X, X, X};
        return;
    }
#endif
#if defined(DBG_CHECK) && DBG_CHECK == 5
    {
        float* dbgw = (float*)(WSP(unsigned, WS_CTL) + 200000);
        for (int rep = 0; rep < 2; ++rep) {
            const dsa::Ptrs P{DOP(bf16, DO_QI), DOP(bf16, DO_KI), DOP(bf16, DO_KA), DOP(bf16, DO_VA), DOP(float, DO_WI), WSP(bf16, WS_QA), rep == 0 ? WSP(bf16, WS_XB) : WSP(bf16, WS_QN), (unsigned short*)(wsb() + WS_END + (size_t)rep * 8 * MiB)};
            LAS unsigned char* wl = lds + RING_OFF + wave * 16384; LAS dsa::u16* idl = (LAS dsa::u16*)(lds + IDL_OFF + wave * 2048);
            const int x_ = vcu >> 5, wv = (vcu & 31) * NWAVES + wave, j_ = wv >> 6, i_ = wv & 63;
#pragma unroll 1
            for (int jb = 0; jb < 2; ++jb) dsa::job(P, jb, jb == 0 ? 256 * (x_ + 8 * j_) + 4 * i_ : 256 * ((7 - x_) + 8 * (3 - j_)) + 4 * (63 - i_), wl, idl, LANE());
            xcd_barrier(bar);
        }
        { const unsigned short* sa = (const unsigned short*)(wsb() + WS_END); const unsigned short* sb = sa + (size_t)4 * MiB; unsigned c = 0u;
          for (size_t i = GT(); i < (size_t)M * 256; i += NT) c += sa[i] != sb[i] ? 1u : 0u;
          if (c) atomicAdd((unsigned*)dbgw + 20, c);
          const unsigned* oa = (const unsigned*)WSP(bf16, WS_XB); const unsigned* ob = (const unsigned*)WSP(bf16, WS_QN); unsigned c2 = 0u;
          for (size_t i = GT(); i < (size_t)M * 1024; i += NT) c2 += oa[i] != ob[i] ? 1u : 0u;
          if (c2) atomicAdd((unsigned*)dbgw + 21, c2); }
        xcd_barrier(bar);
        const float X = ((float)__hip_atomic_load((unsigned*)dbgw + 20 + DBG_WORD, RLX_AGENT) + 1.0f) * 1e8f; float* o_ = outb();
        for (size_t i = GT(); i < (size_t)M * DM / 4; i += NT) *((GAS f32x4*)o_ + i) = (f32x4){X, X, X, X};
        return;
    }
#endif
    STAMP(2);
    if (PH(3)) { const dsa::Ptrs P{DOP(bf16, DO_QI), DOP(bf16, DO_KI), DOP(bf16, DO_KA), DOP(bf16, DO_VA), DOP(float, DO_WI), WSP(bf16, WS_QA), WSP(bf16, DBG_OA), DBG_SEL};
      LAS unsigned char* wl = lds + RING_OFF + wave * 16384; LAS dsa::u16* idl = (LAS dsa::u16*)(lds + IDL_OFF + wave * 2048);
      const int x_ = vcu >> 5, j_ = wave & 3, i_ = (vcu & 31) * 2 + (wave >> 2);
#pragma unroll 1
      for (int jb = 0; jb < 2; ++jb) dsa::job(P, jb, jb == 0 ? 256 * (x_ + 8 * j_) + 4 * i_ : 256 * ((7 - x_) + 8 * (3 - j_)) + 4 * (63 - i_), wl, idl, LANE(), wave == 0 ? MISC + 64 : nullptr); }
    __syncthreads();
    STAMP(3);
    if (PH(2)) { EpiQ E{WSP(bf16, WS_QN), DOP(bf16, DO_QR), SSQP(), WSP(float, WS_ROPE)}; GEMM_PHASE_X(EpiQ, DOP(bf16, DO_CQ), WSP(bf16, WS_WUQ), 3072, 256, E, 2, 127 - 5); }
    if (PH(2)) { EpiKV E{WSP(bf16, WS_KN), WSP(bf16, WS_VB), SSQP() + (size_t)M * 8}; GEMM_PHASE_X(EpiKV, DOP(bf16, DO_CKV), WSP(bf16, WS_WKV), 4096, 256, E, 2, 127 - 5); }
    xcd_barrier(bar);
    CKPT(2, 118, 182); CKPT(3, 260, 484);
#if defined(DBG_CHECK) && DBG_CHECK == 6
    {   float* dbgw = (float*)(WSP(unsigned, WS_CTL) + 200000);
        LAS float* cr = (LAS float*)lds; LAS float* red = (LAS float*)(lds + 65536); LAS float* tru = (LAS float*)(lds + 69632);
        for (int smp = bx; smp < 256; smp += G) chk::p2(DOP(bf16, DO_CQ), DOP(bf16, DO_CKV), INP(3), INP(4), INP(5), INP(6), INP(7), WSP(bf16, WS_QN), DOP(bf16, DO_QR), WSP(bf16, WS_KN), WSP(bf16, WS_VB), smp, cr, red, tru, dbgw, TID());
        xcd_barrier(bar);
        const float X = __hip_atomic_load(dbgw + DBG_WORD, RLX_AGENT) * 1e8f; float* o_ = outb();
        for (size_t i = GT(); i < (size_t)M * DM / 4; i += NT) *((GAS f32x4*)o_ + i) = (f32x4){X, X, X, X};
        return;
    }
#endif

    STAMP(4);
    if (PH(4)) { const mla::Tensors T{WSP(bf16, WS_QN), DOP(bf16, DO_QR), WSP(bf16, WS_KN), DOP(bf16, DO_KR), WSP(bf16, WS_VB), DOP(bf16, DO_AB8)};
#pragma unroll 1
      for (int r_ = 0; r_ < 2; ++r_) { const int x_ = vcu >> 5, q_ = (vcu & 31) * 2 + r_, j_ = q_ >> 4, h_ = q_ & 15;
#pragma unroll 1
          for (int ps = 0; ps < 2; ++ps) mla::unit(T, ps, h_, ps == 0 ? x_ + 8 * j_ : (7 - x_) + 8 * (3 - j_), lds + RING_OFF); } }
    CKPT(4, 260, 324);

#if defined(DBG_CHECK) && (DBG_CHECK == 1 || DBG_CHECK == 2 || DBG_CHECK == 4)
    {
        float* dbgw = (float*)(WSP(unsigned, WS_CTL) + 200000);
        LAS float* lgs = (LAS float*)lds; LAS float* red = (LAS float*)(lds + 65536); LAS float* aux = (LAS float*)(lds + 69632);
        for (int smp = bx; smp < (DBG_CHECK == 4 ? 256 : 512); smp += G) {
#if DBG_CHECK == 2
            chk::mla(WSP(bf16, WS_QN), DOP(bf16, DO_QR), WSP(bf16, WS_KN), DOP(bf16, DO_KR), WSP(bf16, WS_VB), WSP(bf16, DBG_OB), smp, lgs, red, aux, dbgw, TID());
#else
            chk::dsa<(DBG_CHECK == 4)>(INP(0), INP(2), DOP(bf16, DO_QI), DOP(bf16, DO_KI), DOP(float, DO_WI), WSP(bf16, WS_QA), DOP(bf16, DO_KA), DOP(bf16, DO_VA), WSP(bf16, DBG_OA), DBG_SEL, smp, lgs, red, aux, dbgw, TID());
#endif
        }
        xcd_barrier(bar);
        const float X = __hip_atomic_load(dbgw + DBG_WORD, RLX_AGENT) * 1e8f; float* o_ = outb();
        for (size_t i = GT(); i < (size_t)M * DM / 4; i += NT) *((GAS f32x4*)o_ + i) = (f32x4){X, X, X, X};
        return;
    }
#endif
    STAMP(5);
    if (PH(5)) { EpiB<1> E{WSP(bf16, WS_G), 4096, nullptr, nullptr, nullptr}; GEMM_PHASE_X(EpiB<1>, WSP(bf16, WS_XF8), WSP(bf16, WS_WG), 4096, 1024, E, 2, 127 - 6); }
    xcd_barrier(bar);
    CKPT(5, 356, 484); CKPT(6, 182, 256); CKPT(7, 324, 348);
#if defined(DBG_CHECK) && DBG_CHECK == 10
    {
        unsigned* dw = WSP(unsigned, WS_CTL) + 200000; const bf16* Gp = WSP(bf16, WS_G);
        unsigned cntb = 0u, rmax = 0u, rmin = 255u, pnmax = 0u, pnmin = 15u, r16 = 0u, nnan = 0u, pmaxb = 0u, pminb = 63u; float vmax = 0.f;
        for (int s_ = 0; s_ < 8; ++s_) { const int pnl = own_panel(vcu >> 5, s_);
            for (int e = (vcu & 31) * 512 + (int)TID(); e < 256 * 4096 / 8; e += 32 * 512) { const int r = e / 512, c8 = e % 512; const v4u w = *(const GAS v4u*)(Gp + ((size_t)pnl * 256 + r) * 4096 + c8 * 8); f32x4 a, b; unpack8(w, a, b);
                bool bad = false;
#pragma unroll
                for (int j = 0; j < 4; ++j) { bad |= !(a[j] >= 0.f && a[j] <= 1.001f); bad |= !(b[j] >= 0.f && b[j] <= 1.001f); }
                if (bad) { for (int j = 0; j < 4; ++j) { if (a[j] == a[j] && fabsf(a[j]) < 1e30f) vmax = fmaxf(vmax, fabsf(a[j])); else ++nnan; if (b[j] == b[j] && fabsf(b[j]) < 1e30f) vmax = fmaxf(vmax, fabsf(b[j])); else ++nnan; } pmaxb = max(pmaxb, (unsigned)pnl); pminb = min(pminb, (unsigned)pnl);
                    ++cntb; rmax = max(rmax, (unsigned)r); rmin = min(rmin, (unsigned)r); pnmax = max(pnmax, (unsigned)(c8 / 32)); pnmin = min(pnmin, (unsigned)(c8 / 32)); r16 |= 1u << (r & 15); } } }
        if (cntb) { atomicAdd(dw + 0, cntb); atomicMax(dw + 1, rmax + 1u); atomicMax(dw + 2, 256u - rmin); atomicMax(dw + 3, pnmax + 1u); atomicMax(dw + 4, 16u - pnmin); atomicOr(dw + 5, r16); atomicMax(dw + 6, (unsigned)vmax); atomicAdd(dw + 7, nnan); atomicMax(dw + 8, pmaxb + 1u); atomicMax(dw + 9, 64u - pminb); }
        xcd_barrier(bar);
        const float X = (float)__hip_atomic_load(dw + DBG_WORD, RLX_AGENT) * 1e8f; float* o_ = outb();
        for (size_t i = GT(); i < (size_t)M * DM / 4; i += NT) *((GAS f32x4*)o_ + i) = (f32x4){X, X, X, X};
        return;
    }
#endif
#if defined(DBG_CHECK) && DBG_CHECK == 9
    {   float* dbgw = (float*)(WSP(unsigned, WS_CTL) + 200000);
        LAS float* xr = (LAS float*)lds; LAS float* red = (LAS float*)(lds + 65536);
        { const size_t row_ = (size_t)256 * own_panel(vcu >> 5, vcu & 7) + (((unsigned)vcu * 2654435761u) >> 9) % 256;
          chk::gchk(INP(0), INP(2), WSP(bf16, WS_G), WSP(bf16, WS_XB), row_, xr, red, dbgw, TID()); }
        xcd_barrier(bar);
        const float X = __hip_atomic_load(dbgw + DBG_WORD, RLX_AGENT) * 1e8f; float* o_ = outb();
        for (size_t i = GT(); i < (size_t)M * DM / 4; i += NT) *((GAS f32x4*)o_ + i) = (f32x4){X, X, X, X};
        return;
    }
#endif

    STAMP(6);
    if (PH(7)) { EpiB<2> E{WSP(bf16, WS_MT), 2048, WSP(bf16, WS_G), nullptr, nullptr}; GEMM_PHASE_L(EpiB<2>, WSP(bf16, WS_QA), WSP(bf16, WS_WA), 2048, 1024, E, 2, 127 - 6, 2048); }
    if (PH(7)) { EpiB<5> E{WSP(bf16, WS_MT), 2048, (const bf16*)(WSP(unsigned char, WS_G) + 2048), nullptr, WSP(unsigned char, WS_MG8)}; GEMM_PHASE_X(EpiB<5>, DOP(bf16, DO_AB8), WSP(bf16, WS_WB), 2048, 1024, E, 2, 127 - 6); }
    xcd_barrier(bar);
    CKPT(8, 54, 118);

    STAMP(7);
    if (PH(8)) { EpiF<0> E{WSP(bf16, WS_X1B), INP(0), nullptr}; GEMM_PHASE_X(EpiF<0>, WSP(bf16, WS_MG8), WSP(bf16, WS_WO), 2048, 1024, E, 2, 127 - 6); }
    xcd_barrier(bar);
#if defined(DBG_CHECK) && DBG_CHECK == 7
    {   float* dbgw = (float*)(WSP(unsigned, WS_CTL) + 200000);
        LAS float* va = (LAS float*)lds; LAS float* red = (LAS float*)(lds + 65536); LAS float* mg = (LAS float*)(lds + 69632);
        { const size_t row_ = (size_t)256 * own_panel(vcu >> 5, vcu & 7) + (((unsigned)vcu * 2654435761u) >> 9) % 256;
          chk::mid(INP(0), INP(2), INP(8), INP(9), INP(10), WSP(bf16, WS_QA), WSP(bf16, WS_QN), WSP(bf16, WS_G), WSP(bf16, WS_MT), outb(), row_, vcu, va, red, mg, dbgw, TID()); }
        xcd_barrier(bar);
        const float X = __hip_atomic_load(dbgw + DBG_WORD, RLX_AGENT) * 1e8f; float* o_ = outb();
        for (size_t i = GT(); i < (size_t)M * DM / 4; i += NT) *((GAS f32x4*)o_ + i) = (f32x4){X, X, X, X};
        return;
    }
#endif
    if (PH(9)) { bf16* z_ = WSP(bf16, WS_X1B); ln_pass(z_, nullptr, z_, WSP(unsigned char, WS_X1F8), INP(11), INP(12), vcu, wave, LANE()); }
    xcd_barrier(bar);
    CKPT(9, 118, 182);

    STAMP(8);
    if (PH(10)) { EpiUp E{WSP(unsigned char, WS_ACT), WSP(float, WS_HEAD), WSP(float, WS_TAIL), INP(14), INP(15), (LAS float*)(lds + CWL_OFF)}; GEMM_PHASE_X(EpiUp, WSP(bf16, WS_X1F8), WSP(bf16, WS_WUP), NUP, 1024, E, 2, 127 - 6); }
    xcd_barrier(bar);
    CKPT(10, 260, 484);

    STAMP(9);
    if (PH(11)) conv_fixup(WSP(unsigned char, WS_ACT), WSP(float, WS_HEAD), WSP(float, WS_TAIL), INP(14), INP(15), vcu, TID());
    if (PH(15)) { EpiB<4> E{DOP(bf16, DO_PEO), 2048, nullptr, INP(18), nullptr}; GEMM_PHASE_X(EpiB<4>, WSP(bf16, WS_X1F8), WSP(bf16, WS_WPG), 2048, 1024, E, 2, 127 - 6); }
    xcd_barrier(bar);
    CKPT(11, 54, 118); CKPT(12, 308, 484);

    STAMP(10);
    if (PH(13)) { EpiF<1> E{WSP(bf16, WS_X1B), nullptr, DOP(bf16, DO_PEO)}; GEMM_PHASE_X(EpiF<1>, WSP(bf16, WS_ACT), WSP(bf16, WS_WDN), 2048, DFF / 2, E, 2, 127 - 7); }
    xcd_barrier(bar);
    if (PH(14)) { ln_pass(WSP(bf16, WS_X1B), outb(), nullptr, nullptr, INP(20), INP(21), vcu, wave, LANE()); }
#if defined(DBG_SPIN)
    STAMP(11);
    if (threadIdx.x == 0 && vcu == DBG_VCU) { const unsigned long long a_ = ((unsigned long long)MISC[17 + 2 * (DBG_SPIN % 100)] << 32) | MISC[16 + 2 * (DBG_SPIN % 100)], b_ = ((unsigned long long)MISC[17 + 2 * (DBG_SPIN % 100 + DBG_SPAN)] << 32) | MISC[16 + 2 * (DBG_SPIN % 100 + DBG_SPAN)];
        const unsigned long long ca_ = ((unsigned long long)MISC[101 + 2 * (DBG_SPIN % 100)] << 32) | MISC[100 + 2 * (DBG_SPIN % 100)], cb_ = ((unsigned long long)MISC[101 + 2 * (DBG_SPIN % 100 + DBG_SPAN)] << 32) | MISC[100 + 2 * (DBG_SPIN % 100 + DBG_SPAN)];
        const unsigned long long t0_ = __builtin_amdgcn_s_memrealtime(), w_ = DBG_SPIN >= 200 ? (cb_ - ca_) / 20ull : DBG_SPIN >= 100 ? 4ull * MISC[64 + (DBG_SPIN - 100)] : 4ull * (b_ - a_); while (__builtin_amdgcn_s_memrealtime() - t0_ < w_) __builtin_amdgcn_s_sleep(8); }
#endif
#if defined(DBG_CHECK) && DBG_CHECK == 8
    {   xcd_barrier(bar);
        float* dbgw = (float*)(WSP(unsigned, WS_CTL) + 200000);
        LAS float* xs = (LAS float*)lds; LAS float* red = (LAS float*)(lds + 65536); LAS float* act = (LAS float*)(lds + 69632);
        for (int smp = bx; smp < 256; smp += G) chk::endp(WSP(bf16, WS_X1B), nullptr, INP(1), INP(13), INP(14), INP(15), INP(16), INP(17), INP(18), INP(19), INP(20), INP(21), outb(), smp, xs, red, act, dbgw, TID());
        xcd_barrier(bar);
        const float X = __hip_atomic_load(dbgw + DBG_WORD, RLX_AGENT) * 1e8f; float* o_ = outb();
        for (size_t i = GT(); i < (size_t)M * DM / 4; i += NT) *((GAS f32x4*)o_ + i) = (f32x4){X, X, X, X};
    }
#endif
}

extern "C" void kernel_launch(void* const* d_in, const int* in_sizes, int n_in, void* d_out, int out_size, void* d_ws, size_t ws_size, hipStream_t stream) {
    static int grid = 0;
    if (grid == 0) {
        if (n_in != 22 || in_sizes[0] != M * DM || out_size != M * DM || ws_size < WS_END) { fprintf(stderr, "kernel_launch: unexpected shapes (n_in %d, in0 %d, out %d, ws %zu); nothing launched\n", n_in, n_in > 0 ? in_sizes[0] : -1, out_size, ws_size); grid = -1; return; }
        int dev = 0, cus = 0, per_cu = 0;
        if (hipGetDevice(&dev) != hipSuccess || hipDeviceGetAttribute(&cus, hipDeviceAttributeMultiprocessorCount, dev) != hipSuccess) { grid = -1; return; }
        if (hipFuncSetAttribute((const void*)fwd_kernel, hipFuncAttributeMaxDynamicSharedMemorySize, LDS_BYTES) != hipSuccess) { fprintf(stderr, "kernel_launch: hipFuncSetAttribute failed\n"); grid = -1; return; }
        if (hipOccupancyMaxActiveBlocksPerMultiprocessor(&per_cu, (const void*)fwd_kernel, NWAVES * 64, LDS_BYTES) != hipSuccess || per_cu < 1) { fprintf(stderr, "kernel_launch: occupancy query reports %d workgroups per CU\n", per_cu); }
        (void)hipGetLastError();
        grid = cus;
    }
    if (grid < 0) return;
    if (hipMemsetAsync((char*)d_ws + WS_CTL, 0, CTL_ZERO_BYTES, stream) != hipSuccess) return;
    Args a{};
    for (int i = 0; i < 22; ++i) a.in[i] = (const float*)d_in[i];
    a.out = (float*)d_out; a.ws = (unsigned char*)d_ws;
    hipLaunchKernelGGL(fwd_kernel, dim3(grid), dim3(NWAVES * 64), LDS_BYTES, stream, a);
}
```
